# Optimizing an MI355X kernel written in HIP

```python
import math
import jax, jax.numpy as jnp
from jax import lax
import numpy as np


D_MODEL = 2048
BATCH = 2
SEQ = 8192
DEPTH = 2

HEAD_DIM = 128
N_MEM = 256
MEM_HEADS = 4
MEM_WIDTH = MEM_HEADS * HEAD_DIM
MIX_WIDTH = D_MODEL - MEM_WIDTH
MOBA_HEADS = MIX_WIDTH // HEAD_DIM
MOBA_BLOCK = 256
MOBA_TOPK = 3
MOBA_QCHUNK = 32
DIFF_HEADS = MIX_WIDTH // (2 * HEAD_DIM)
DIFF_VDIM = 2 * HEAD_DIM
DENSE_QBLOCK = 128
REL_BUCKETS = 32
REL_MAX_DIST = 128
N_BIAS_MAPS = MOBA_HEADS
N_GROUPS = 8
EXPERTS_PER_GROUP = 8
N_EXPERTS = N_GROUPS * EXPERTS_PER_GROUP
TOPK_IN_GROUP = 2
EXPERT_FF = D_MODEL // 4
MOE_BLOCK = 256
N_A = DEPTH // 2
N_B = DEPTH - N_A
RMS_EPS = 1e-6

kernel_name = 'yoco_moba_diffattn_hmoe'


def rmsnorm(x, g):
    xf = x.astype(jnp.float32)
    y = xf * lax.rsqrt(jnp.mean(xf * xf, axis=-1, keepdims=True) + RMS_EPS)
    return (y * g.astype(jnp.float32)).astype(x.dtype)


def split_heads(t, n_heads):
    b, s, _ = t.shape
    return t.reshape(b, s, n_heads, -1).transpose(0, 2, 1, 3)


def merge_heads(t):
    b, h, s, d = t.shape
    return t.transpose(0, 2, 1, 3).reshape(b, s, h * d)


def t5_bucket(dist):
    n = jnp.maximum(dist, 0)
    max_exact = REL_BUCKETS // 2
    large = max_exact + (jnp.log(jnp.maximum(n, 1).astype(jnp.float32) / max_exact)
                         / math.log(REL_MAX_DIST / max_exact)
                         * (REL_BUCKETS - max_exact)).astype(jnp.int32)
    large = jnp.minimum(large, REL_BUCKETS - 1)
    return jnp.where(n < max_exact, n, large)


def moba_attention(q, k, v, rel_bias):
    bsz, n_heads, seq, hd = q.shape
    nb = -(-seq // MOBA_BLOCK)
    pad = nb * MOBA_BLOCK - seq
    k_blk = jnp.pad(k, ((0, 0), (0, 0), (0, pad), (0, 0))).reshape(bsz, n_heads, nb, MOBA_BLOCK, hd)
    v_blk = jnp.pad(v, ((0, 0), (0, 0), (0, pad), (0, 0))).reshape(bsz, n_heads, nb, MOBA_BLOCK, hd)
    k_mean = jnp.mean(k_blk.astype(jnp.float32), axis=3).astype(q.dtype)
    topk = min(MOBA_TOPK, nb)
    n_chunks = seq // MOBA_QCHUNK
    q_chunks = q.reshape(bsz, n_heads, n_chunks, MOBA_QCHUNK, hd).transpose(2, 0, 1, 3, 4)
    bias_tab = rel_bias.T
    head_idx = jnp.arange(n_heads)[None, :, None, None, None]
    blk_ids = jnp.arange(nb)
    offs = jnp.arange(MOBA_BLOCK)
    gather_blocks = jax.vmap(jax.vmap(lambda blocks, ix: blocks[ix]))
    scale = hd ** -0.5

    def one_chunk(args):
        c, qc = args
        start = c * MOBA_QCHUNK
        qpos = start + jnp.arange(MOBA_QCHUNK)
        own = start // MOBA_BLOCK
        gate = jnp.einsum('bhqd,bhnd->bhqn', qc, k_mean).astype(jnp.float32)
        gate = jnp.where(blk_ids < own, gate, -jnp.inf)
        _, idx = lax.top_k(gate, topk)
        valid = jnp.arange(topk) < own
        k_sel = gather_blocks(k_blk, idx)
        v_sel = gather_blocks(v_blk, idx)
        kpos_sel = idx[..., None] * MOBA_BLOCK + offs
        s_sel = jnp.einsum('bhqd,bhqjud->bhqju', qc, k_sel).astype(jnp.float32) * scale
        s_sel = s_sel + bias_tab[head_idx, t5_bucket(qpos[:, None, None] - kpos_sel)]
        s_sel = jnp.where(valid[:, None], s_sel, -jnp.inf).reshape(bsz, n_heads, MOBA_QCHUNK, topk * MOBA_BLOCK)
        k_own = lax.dynamic_index_in_dim(k_blk, own, axis=2, keepdims=False)
        v_own = lax.dynamic_index_in_dim(v_blk, own, axis=2, keepdims=False)
        kpos_own = own * MOBA_BLOCK + offs
        s_own = jnp.einsum('bhqd,bhud->bhqu', qc, k_own).astype(jnp.float32) * scale
        s_own = s_own + bias_tab[:, t5_bucket(qpos[:, None] - kpos_own[None, :])]
        s_own = jnp.where(kpos_own[None, :] <= qpos[:, None], s_own, -jnp.inf)
        p = jax.nn.softmax(jnp.concatenate([s_sel, s_own], axis=-1), axis=-1).astype(v.dtype)
        p_sel = p[..., :topk * MOBA_BLOCK].reshape(bsz, n_heads, MOBA_QCHUNK, topk, MOBA_BLOCK)
        p_own = p[..., topk * MOBA_BLOCK:]
        return (jnp.einsum('bhqju,bhqjud->bhqd', p_sel, v_sel)
                + jnp.einsum('bhqu,bhud->bhqd', p_own, v_own))

    out = lax.map(one_chunk, (jnp.arange(n_chunks), q_chunks))
    return out.transpose(1, 2, 0, 3, 4).reshape(bsz, n_heads, seq, hd)


def diff_attention(q1, q2, k1, k2, v, rel_bias, lam):
    bsz, n_heads, seq, hd = q1.shape
    nblk = seq // DENSE_QBLOCK
    scale = hd ** -0.5
    bias_tab = rel_bias.T.reshape(DIFF_HEADS, 2, REL_BUCKETS)
    kpos = jnp.arange(seq)
    qb1 = q1.reshape(bsz, n_heads, nblk, DENSE_QBLOCK, hd).transpose(2, 0, 1, 3, 4)
    qb2 = q2.reshape(bsz, n_heads, nblk, DENSE_QBLOCK, hd).transpose(2, 0, 1, 3, 4)

    def one_block(args):
        i, a1q, a2q = args
        qpos = i * DENSE_QBLOCK + jnp.arange(DENSE_QBLOCK)
        bias = bias_tab[:, :, t5_bucket(qpos[:, None] - kpos[None, :])]
        causal = kpos[None, :] <= qpos[:, None]
        s1 = jnp.einsum('bhqd,bhkd->bhqk', a1q, k1).astype(jnp.float32) * scale + bias[:, 0]
        s2 = jnp.einsum('bhqd,bhkd->bhqk', a2q, k2).astype(jnp.float32) * scale + bias[:, 1]
        a1 = jax.nn.softmax(jnp.where(causal, s1, -jnp.inf), axis=-1)
        a2 = jax.nn.softmax(jnp.where(causal, s2, -jnp.inf), axis=-1)
        a = (a1 - lam * a2).astype(v.dtype)
        return jnp.einsum('bhqk,bhkv->bhqv', a, v)

    out = lax.map(one_block, (jnp.arange(nblk), qb1, qb2))
    return out.transpose(1, 2, 0, 3, 4).reshape(bsz, n_heads, seq, -1)


def memory_attention(qm, mem, g_mem, w_mkv, gk):
    kv = rmsnorm(mem, g_mem) @ w_mkv
    km = rmsnorm(split_heads(kv[..., :MEM_WIDTH], MEM_HEADS), gk)
    vm = split_heads(kv[..., MEM_WIDTH:], MEM_HEADS)
    s = jnp.einsum('bhqd,bhmd->bhqm', qm, km).astype(jnp.float32) * (HEAD_DIM ** -0.5)
    p = jax.nn.softmax(s, axis=-1).astype(vm.dtype)
    return merge_heads(jnp.einsum('bhqm,bhmd->bhqd', p, vm))


def hier_moe(x, w_rg, b_rg, w_re, b_re, w_gate, w_up, w_down):
    bsz, seq, dm = x.shape
    xt = x.reshape(-1, dm)
    n_tok = xt.shape[0]
    g_logits = (xt @ w_rg).astype(jnp.float32) + b_rg.astype(jnp.float32)
    g_prob = jax.nn.softmax(g_logits, axis=-1)
    g_idx = jnp.argmax(g_logits, axis=-1)
    p_g = jnp.take_along_axis(g_prob, g_idx[:, None], axis=-1)[:, 0]
    e_logits = ((xt @ w_re).astype(jnp.float32) + b_re.astype(jnp.float32)).reshape(n_tok, N_GROUPS, EXPERTS_PER_GROUP)
    e_logits_g = jnp.take_along_axis(e_logits, g_idx[:, None, None], axis=1)[:, 0]
    top_v, top_i = lax.top_k(e_logits_g, TOPK_IN_GROUP)
    gates = p_g[:, None] * jax.nn.softmax(top_v, axis=-1)
    expert = g_idx[:, None] * EXPERTS_PER_GROUP + top_i
    n_asg = n_tok * TOPK_IN_GROUP
    e_flat = expert.reshape(-1)
    t_flat = jnp.repeat(jnp.arange(n_tok), TOPK_IN_GROUP)
    w_flat = gates.reshape(-1)
    order = jnp.argsort(e_flat)
    e_s, t_s, w_s = e_flat[order], t_flat[order], w_flat[order]
    counts = jnp.bincount(e_flat, length=N_EXPERTS)
    starts = jnp.cumsum(counts) - counts
    padded = (counts + MOE_BLOCK - 1) // MOE_BLOCK * MOE_BLOCK
    pends = jnp.cumsum(padded)
    pstarts = pends - padded
    dest = pstarts[e_s] + (jnp.arange(n_asg) - starts[e_s])
    n_blocks = -(-n_asg // MOE_BLOCK) + N_EXPERTS
    n_rows = n_blocks * MOE_BLOCK
    buf_tok = jnp.zeros((n_rows,), jnp.int32).at[dest].set(t_s)
    buf_w = jnp.zeros((n_rows,), jnp.float32).at[dest].set(w_s)
    blk_e = jnp.minimum(jnp.searchsorted(pends, jnp.arange(n_blocks) * MOE_BLOCK, side='right'), N_EXPERTS - 1)
    xs = xt[buf_tok].reshape(n_blocks, MOE_BLOCK, dm)

    def expert_block(args):
        xb, e = args
        hdn = jax.nn.silu(xb @ w_gate[e]) * (xb @ w_up[e])
        return hdn @ w_down[e]

    ys = lax.map(expert_block, (xs, blk_e)).reshape(n_rows, dm)
    out = jnp.zeros((n_tok, dm), jnp.float32).at[buf_tok].add(ys.astype(jnp.float32) * buf_w[:, None])
    return out.astype(x.dtype).reshape(bsz, seq, dm)


def setup_inputs(seed: int = 0) -> dict:
    key = jax.random.key(seed)
    ks = iter(jax.random.split(key, 40))
    f32 = jnp.float32
    sd = D_MODEL ** -0.5

    def nrm(shape, scale):
        return jax.random.normal(next(ks), shape, f32) * scale

    def gain(shape):
        return 1.0 + nrm(shape, 0.02)

    kv_width = 2 * DIFF_HEADS * HEAD_DIM + DIFF_HEADS * DIFF_VDIM
    return {
        'x': nrm((BATCH, SEQ, D_MODEL), 1.0),
        'mem': nrm((BATCH, N_MEM, D_MODEL), 1.0),
        'rel_bias': nrm((REL_BUCKETS, N_BIAS_MAPS), 0.5),
        'attn_norm_g': gain((DEPTH, D_MODEL)),
        'ffn_norm_g': gain((DEPTH, D_MODEL)),
        'mem_norm_g': gain((DEPTH, D_MODEL)),
        'w_mem_kv': nrm((DEPTH, D_MODEL, 2 * MEM_WIDTH), sd),
        'q_norm_mem': gain((DEPTH, HEAD_DIM)),
        'k_norm_mem': gain((DEPTH, HEAD_DIM)),
        'w_out': nrm((DEPTH, D_MODEL, D_MODEL), sd),
        'w_in_a': nrm((N_A, D_MODEL, 3 * MIX_WIDTH + MEM_WIDTH), sd),
        'q_norm_a': gain((N_A, HEAD_DIM)),
        'k_norm_a': gain((N_A, HEAD_DIM)),
        'kv_norm_g': gain((D_MODEL,)),
        'w_kv_b': nrm((D_MODEL, kv_width), sd),
        'k_norm_b': gain((2, HEAD_DIM)),
        'w_in_b': nrm((N_B, D_MODEL, 2 * DIFF_HEADS * HEAD_DIM + MEM_WIDTH), sd),
        'q_norm_b': gain((N_B, 2, HEAD_DIM)),
        'lambda_b': nrm((N_B, 4, HEAD_DIM), 0.1),
        'subln_g': gain((N_B, DIFF_VDIM)),
        'w_router_group': nrm((DEPTH, D_MODEL, N_GROUPS), sd),
        'b_router_group': nrm((DEPTH, N_GROUPS), 0.01),
        'w_router_expert': nrm((DEPTH, D_MODEL, N_EXPERTS), sd),
        'b_router_expert': nrm((DEPTH, N_EXPERTS), 0.01),
        'w_gate': nrm((DEPTH, N_EXPERTS, D_MODEL, EXPERT_FF), sd),
        'w_up': nrm((DEPTH, N_EXPERTS, D_MODEL, EXPERT_FF), sd),
        'w_down': nrm((DEPTH, N_EXPERTS, EXPERT_FF, D_MODEL), EXPERT_FF ** -0.5),
    }


def reference(x, mem, rel_bias, attn_norm_g, ffn_norm_g, mem_norm_g, w_mem_kv, q_norm_mem, k_norm_mem,
              w_out, w_in_a, q_norm_a, k_norm_a, kv_norm_g, w_kv_b, k_norm_b, w_in_b, q_norm_b,
              lambda_b, subln_g, w_router_group, b_router_group, w_router_expert, b_router_expert,
              w_gate, w_up, w_down):
    qk_w = DIFF_HEADS * HEAD_DIM
    h = x
    k1s = k2s = vs = None
    for l in range(DEPTH):
        xn = rmsnorm(h, attn_norm_g[l])
        if l < N_A:
            proj = xn @ w_in_a[l]
            q = rmsnorm(split_heads(proj[..., :MIX_WIDTH], MOBA_HEADS), q_norm_a[l])
            k = rmsnorm(split_heads(proj[..., MIX_WIDTH:2 * MIX_WIDTH], MOBA_HEADS), k_norm_a[l])
            v = split_heads(proj[..., 2 * MIX_WIDTH:3 * MIX_WIDTH], MOBA_HEADS)
            qm = proj[..., 3 * MIX_WIDTH:]
            o_mix = merge_heads(moba_attention(q, k, v, rel_bias))
        else:
            j = l - N_A
            proj = xn @ w_in_b[j]
            q1 = rmsnorm(split_heads(proj[..., :qk_w], DIFF_HEADS), q_norm_b[j, 0])
            q2 = rmsnorm(split_heads(proj[..., qk_w:2 * qk_w], DIFF_HEADS), q_norm_b[j, 1])
            qm = proj[..., 2 * qk_w:]
            lam_init = 0.8 - 0.6 * math.exp(-0.3 * l)
            lam_vec = lambda_b[j].astype(jnp.float32)
            lam = (jnp.exp(jnp.sum(lam_vec[0] * lam_vec[1])) - jnp.exp(jnp.sum(lam_vec[2] * lam_vec[3]))
                   + lam_init)
            o = diff_attention(q1, q2, k1s, k2s, vs, rel_bias, lam)
            o_mix = merge_heads(rmsnorm(o, subln_g[j]) * (1.0 - lam_init))
        qm = rmsnorm(split_heads(qm, MEM_HEADS), q_norm_mem[l])
        o_mem = memory_attention(qm, mem, mem_norm_g[l], w_mem_kv[l], k_norm_mem[l])
        h = h + jnp.concatenate([o_mix, o_mem], axis=-1) @ w_out[l]
        h = h + hier_moe(rmsnorm(h, ffn_norm_g[l]), w_router_group[l], b_router_group[l],
                         w_router_expert[l], b_router_expert[l], w_gate[l], w_up[l], w_down[l])
        if l == N_A - 1:
            kv = rmsnorm(h, kv_norm_g) @ w_kv_b
            k1s = rmsnorm(split_heads(kv[..., :qk_w], DIFF_HEADS), k_norm_b[0])
            k2s = rmsnorm(split_heads(kv[..., qk_w:2 * qk_w], DIFF_HEADS), k_norm_b[1])
            vs = split_heads(kv[..., 2 * qk_w:], DIFF_HEADS)
    return h
```

```cpp
#include <hip/hip_runtime.h>
#include <cstdio>
#include <cstdint>

#ifndef MK_N_LAUNCHES
#define MK_N_LAUNCHES 1
#endif
#ifndef MK_CHECK
#define MK_CHECK 0
#endif

constexpr int NB = 2, SEQ = 8192, T = NB * SEQ, DM = 2048, HD = 128;
constexpr int NMEM = 256, MEMH = 4, MEMW = 512, MIXW = 1536, MOBA_H = 12, DIFF_H = 6, DV = 256;
constexpr int NEXP = 64, NGRP = 8, EPG = 8, EFF = 512, NRT = 72, NRTP = 80;
constexpr int PROJW = 5120;
constexpr float RMS_EPS = 1e-6f;
constexpr float LOG2E = 1.4426950408889634f;
constexpr float QSCALE = 0.08838834764831845f * LOG2E;
constexpr float LAM_INIT = 0.35550906759096926f;
constexpr int MAXRB = 192;
constexpr float SC_W1 = 64.f, SC_W2 = 32.f, SC_HID = 8.f, SC_O = 16.f;

constexpr size_t MiB = 1u << 20;
constexpr size_t WS_CTL = 0, CTL_ZERO_BYTES = 1 * MiB;
constexpr size_t WS_W_INA = 1 * MiB;
constexpr size_t WS_W_INB = 21 * MiB;
constexpr size_t WS_W_OUT = 41 * MiB;
constexpr size_t WS_W_MKV = 57 * MiB;
constexpr size_t WS_W_RT  = 65 * MiB;
constexpr size_t WS_W_E1  = 67 * MiB;
constexpr size_t WS_HB8   = 323 * MiB;
constexpr size_t WS_W_E2  = 579 * MiB;
constexpr size_t WS_SMALL = 835 * MiB;
constexpr size_t WS_HB    = 851 * MiB;
constexpr size_t WS_PROJ  = 915 * MiB;
constexpr size_t WS_QH    = 1075 * MiB;
constexpr size_t WS_KH    = 1139 * MiB;
constexpr size_t WS_VH    = 1187 * MiB;
constexpr size_t WS_XS    = WS_PROJ;
constexpr size_t WS_OCAT  = 1235 * MiB;
constexpr size_t WS_HID   = 1299 * MiB;
constexpr size_t WS_YS    = 1347 * MiB;
constexpr size_t WS_HA    = 1539 * MiB;
constexpr size_t WS_H2    = 1667 * MiB;
constexpr size_t WS_LISTF = 1795 * MiB;
constexpr size_t WS_LISTA = 1821 * MiB;
constexpr size_t WS_PM    = 1822 * MiB;
constexpr size_t WS_PO    = WS_PROJ;
constexpr size_t WS_END   = 1827 * MiB;
static_assert(WS_XS + (size_t)MAXRB * 256 * 2048 * 2 <= WS_VH, "XS alias");
constexpr size_t SM_RSTD  = 0;
constexpr size_t SM_PART  = 1 * MiB;
constexpr size_t SM_TOKR  = 3 * MiB;
constexpr size_t SM_DEST  = 4 * MiB;
constexpr size_t SM_CNT   = 5 * MiB;
constexpr size_t SM_BLKE  = 5 * MiB + 128 * 1024;
constexpr size_t SM_KMEAN = 6 * MiB;
constexpr size_t SM_SEL   = 7 * MiB;
constexpr size_t SM_MEMN  = 8 * MiB;
constexpr size_t SM_KVM   = 10 * MiB;
constexpr size_t SM_KM    = 12 * MiB;
constexpr size_t SM_VM    = 13 * MiB;
constexpr size_t SM_GAINTAB = 15 * MiB;
constexpr size_t SM_ROWTOK = 14 * MiB;
constexpr int CW_BAR = 4096;
constexpr int CW_Q = 8192;
constexpr int CW_MC = 16384;

constexpr int RING_OFF = 0, RING_BYTES = 131072;
constexpr int LDSX_OFF = RING_BYTES;
constexpr int LDSCTL_OFF = RING_BYTES + 12288, MISC_OFF = LDSCTL_OFF + 320;
constexpr int LDS_BYTES = 147456;
static_assert(MISC_OFF + 128 <= LDS_BYTES, "LDS map");

#define GAS __attribute__((address_space(1)))
#define LAS __attribute__((address_space(3)))
typedef unsigned short bf16;
typedef unsigned v4u __attribute__((ext_vector_type(4)));
typedef unsigned v2u __attribute__((ext_vector_type(2)));
typedef float f32x4 __attribute__((ext_vector_type(4)));
typedef float f32x16 __attribute__((ext_vector_type(16)));
typedef short bf16x8 __attribute__((ext_vector_type(8)));
typedef short s16x4 __attribute__((ext_vector_type(4)));
typedef GAS unsigned gu32;
#define RLX_AGENT __ATOMIC_RELAXED, __HIP_MEMORY_SCOPE_AGENT
#define LDS_WAIT() asm volatile("s_waitcnt lgkmcnt(0)" ::: "memory")
#define VM_WAIT() asm volatile("s_waitcnt vmcnt(0)" ::: "memory")
__device__ __forceinline__ unsigned f2bf(float f) { unsigned u = __builtin_bit_cast(unsigned, f); return (u + 0x7fffu + ((u >> 16) & 1u)) >> 16; }
__device__ __forceinline__ unsigned pk2(float lo, float hi) { return f2bf(lo) | (f2bf(hi) << 16); }
__device__ __forceinline__ float bf2f(unsigned short b) { return __builtin_bit_cast(float, (unsigned)b << 16); }
__device__ __forceinline__ float bflo(unsigned w) { return __builtin_bit_cast(float, w << 16); }
__device__ __forceinline__ float bfhi(unsigned w) { return __builtin_bit_cast(float, w & 0xffff0000u); }
template <int M> __device__ __forceinline__ float swz_xor(float v) { return __builtin_bit_cast(float, __builtin_amdgcn_ds_swizzle(__builtin_bit_cast(int, v), (M << 10) | 0x1F)); }
__device__ __forceinline__ float add_xor32(float v) {
    auto r = __builtin_amdgcn_permlane32_swap(__float_as_uint(v), __float_as_uint(v), false, false);
    return __uint_as_float(r[0]) + __uint_as_float(r[1]); }
__device__ __forceinline__ float wave_sum(float v) {
    v += swz_xor<1>(v); v += swz_xor<2>(v); v += swz_xor<4>(v); v += swz_xor<8>(v); v += swz_xor<16>(v);
    return add_xor32(v);
}
__device__ const unsigned char T5_BUCKET[128] = {
 0, 1, 2, 3, 4, 5, 6, 7, 8, 9, 10, 11, 12, 13, 14, 15, 16, 16, 16, 17, 17, 18, 18, 18, 19, 19, 19, 20, 20, 20, 20, 21, 21, 21, 21, 22, 22, 22, 22, 22, 23, 23, 23, 23, 23, 23, 24, 24, 24, 24, 24, 24, 25, 25, 25, 25, 25, 25, 25, 26, 26, 26, 26, 26, 26, 26, 26, 27, 27, 27, 27, 27, 27, 27, 27, 27, 27, 28, 28, 28, 28, 28, 28, 28, 28, 28, 28, 29, 29, 29, 29, 29, 29, 29, 29, 29, 29, 29, 29, 30, 30, 30, 30, 30, 30, 30, 30, 30, 30, 30, 30, 30, 30, 31, 31, 31, 31, 31, 31, 31, 31, 31, 31, 31, 31, 31, 31, 31};

__device__ __forceinline__ int opaque_tid() { int t = threadIdx.x; asm volatile("" : "+v"(t)); return t; }

__device__ __forceinline__ unsigned char* opaque_ws(unsigned char* p) { asm volatile("" : "+s"(p)); return p; }
namespace pg8 {
#define PG8_LAS __attribute__((address_space(3)))
typedef unsigned short bf16_t;
typedef short bf16x8 __attribute__((ext_vector_type(8)));
typedef float f32x4 __attribute__((ext_vector_type(4)));
typedef unsigned u32x4 __attribute__((ext_vector_type(4)));
constexpr int BM = 256, BK = 64, HALF = 128, HTB = HALF * BK * 2  , STAGE_BYTES = 8 * HTB, NXCD = 8, WGM = 8;

__host__ __device__ __forceinline__ int lds_byte(int r, int c) { const int st = (r >> 4) * 2 + (c >> 5), rr = r & 15, cc = c & 31, ob = rr * 64 + cc * 2; return st * 1024 + (ob ^ (((ob >> 9) & 1) << 5)); }
__host__ __device__ __forceinline__ void stage_rc(int b, int& R, int& C) { const int st = b / 1024, sb = b % 1024, swz = sb ^ (((sb >> 9) & 1) << 5); R = (st >> 1) * 16 + swz / 64; C = (st & 1) * 32 + (swz % 64) / 2; }
__host__ __device__ __forceinline__ int perm32(int rho) { const int n = rho >> 4, i = rho & 15; return 8 * (i >> 2) + 4 * n + (i & 3); }

struct Unit { int pm, pn; };
struct Gemm { const bf16_t* A; const bf16_t* Bt; int M, N, K; const int* rowtok; };

struct StaticOrder {
    int nM, nN, nwg, G, c;
    __host__ __device__ void init(int M, int N, int G_, int c_) { nM = M / BM; nN = N / BM; nwg = nM * nN; G = G_; c = c_; }
    __host__ __device__ bool next(int i, Unit& u) const {
        const long L = (long)i * G + c; if (L >= nwg) return false;
        int wgid = (int)L; { const int q = nwg / NXCD, r = nwg % NXCD, xcd = wgid % NXCD, off = wgid / NXCD; wgid = (xcd < r ? xcd * (q + 1) : r * (q + 1) + (xcd - r) * q) + off; }
        const int nig = WGM * nN, gid = wgid / nig, fm = gid * WGM, gsz = (nM - fm) < WGM ? (nM - fm) : WGM;
        u.pm = fm + ((wgid % nig) % gsz); u.pn = (wgid % nig) / gsz; return true;
    }
    __device__ __forceinline__ void a_ready(const Unit&) const {}
    __device__ __forceinline__ void done(const Unit&) const {}
};

__device__ __forceinline__ unsigned cvt_pk_bf16(float lo, float hi) { unsigned r; asm volatile("v_cvt_pk_bf16_f32 %0, %1, %2" : "=v"(r) : "v"(lo), "v"(hi)); return r; }
typedef float f32x2 __attribute__((ext_vector_type(2)));
template <class Epi, class Sched, bool ALIGN_EPI = false, bool SP2 = false, bool GATHER = false, bool FP8 = false>
__device__ __forceinline__ void gemm_phase(PG8_LAS unsigned char* lds, const Gemm g, const Sched& S, const Epi& E) {
    const int tid = opaque_tid(), wid = __builtin_amdgcn_readfirstlane(tid >> 6), lane = tid & 63, wr = wid >> 2, wc = wid & 3, fr = lane & 15, fq = lane >> 4;
    const int K = g.K, nt = K / BK;
    unsigned voffA[2], voffB[2]; int RA[2]; unsigned CA2[2];
#pragma unroll
    for (int i = 0; i < 2; ++i) { int R, C; stage_rc(tid * 16 + i * 8192, R, C); const int Rb = Epi::PERM ? ((R & ~31) + perm32(R & 31)) : R;
        voffA[i] = (unsigned)(R * K + C) * 2u; voffB[i] = (unsigned)(Rb * K + C) * 2u; RA[i] = R; CA2[i] = (unsigned)C * 2u; }
    const size_t kstep = (size_t)(BK * 2);
    const size_t hstep = (size_t)HALF * K * 2;
    const size_t tstep = 2 * hstep;
    const unsigned ldsw = (unsigned)wid * 1024u;
    const int aoff = lds_byte(wr * 64 + fr, fq * 8), boff = lds_byte(wc * 32 + fr, fq * 8);
#define PG8_SA(b, h) (((b) * 2 + (h)) * HTB)
#define PG8_SB(b, h) ((4 + (b) * 2 + (h)) * HTB)
#define PG8_STAGE(bufoff, gbase, voff) do { _Pragma("unroll") for (int _i = 0; _i < 2; ++_i) \
        __builtin_amdgcn_global_load_lds((const unsigned*)((const char*)(gbase) + (voff)[_i]), (PG8_LAS unsigned*)(lds + (bufoff) + ldsw + _i * 8192), 16, 0, 0); } while (0)
    unsigned gc[2][2], gn[2][2];
#define PG8_GOFF(dst, pm_) do { _Pragma("unroll") for (int _h = 0; _h < 2; ++_h) _Pragma("unroll") for (int _i = 0; _i < 2; ++_i) \
        dst[_h][_i] = (unsigned)g.rowtok[(pm_) * BM + _h * HALF + RA[_i]] * (unsigned)(K * 2) + CA2[_i]; } while (0)
#define PG8_STAGE_A(bufoff, ptr, half, usenext) do { if constexpr (GATHER) { _Pragma("unroll") for (int _i = 0; _i < 2; ++_i) \
        __builtin_amdgcn_global_load_lds((const unsigned*)((const char*)(ptr) + ((usenext) ? gn[half][_i] : gc[half][_i])), (PG8_LAS unsigned*)(lds + (bufoff) + ldsw + _i * 8192), 16, 0, 0); } \
        else { PG8_STAGE(bufoff, (ptr) + (half) * hstep, voffA); } } while (0)
#define PG8_LDA(dst, b, h) do { if constexpr (FP8) { _Pragma("unroll") for (int m = 0; m < 4; ++m) dst##8[m] = PG8_CAT(*(const PG8_LAS bf16x8*)(lds + PG8_SA(b, h) + aoff + m * 2048), *(const PG8_LAS bf16x8*)(lds + PG8_SA(b, h) + aoff + m * 2048 + 1024)); } \
        else { _Pragma("unroll") for (int m = 0; m < 4; ++m) _Pragma("unroll") for (int k = 0; k < 2; ++k) dst[m][k] = *(const PG8_LAS bf16x8*)(lds + PG8_SA(b, h) + aoff + m * 2048 + k * 1024); } } while (0)
#define PG8_LDB(dst, b, h) do { if constexpr (FP8) { _Pragma("unroll") for (int n = 0; n < 2; ++n) dst##8[n] = PG8_CAT(*(const PG8_LAS bf16x8*)(lds + PG8_SB(b, h) + boff + n * 2048), *(const PG8_LAS bf16x8*)(lds + PG8_SB(b, h) + boff + n * 2048 + 1024)); } \
        else { _Pragma("unroll") for (int n = 0; n < 2; ++n) _Pragma("unroll") for (int k = 0; k < 2; ++k) dst[n][k] = *(const PG8_LAS bf16x8*)(lds + PG8_SB(b, h) + boff + n * 2048 + k * 1024); } } while (0)
typedef int pg8_v8i __attribute__((ext_vector_type(8))); typedef int pg8_v4i __attribute__((ext_vector_type(4)));
#define PG8_CAT(x0, x1) __builtin_shufflevector(__builtin_bit_cast(pg8_v4i, x0), __builtin_bit_cast(pg8_v4i, x1), 0, 1, 2, 3, 4, 5, 6, 7)
#define PG8_MMA(ai, bj, At, Bt) do { __builtin_amdgcn_s_setprio(1); if constexpr (FP8) { _Pragma("unroll") for (int m = 0; m < 4; ++m) _Pragma("unroll") for (int n = 0; n < 2; ++n) \
        asm volatile("v_mfma_scale_f32_16x16x128_f8f6f4 %0, %1, %2, %0, %3, %3 op_sel_hi:[0,0,0]" : "+v"(acc[ai][bj][m][n]) : "v"(Bt##8[n]), "v"(At##8[m]), "v"(pg8_scale1)); } \
        else { _Pragma("unroll") for (int m = 0; m < 4; ++m) _Pragma("unroll") for (int n = 0; n < 2; ++n) _Pragma("unroll") for (int k = 0; k < 2; ++k) \
        acc[ai][bj][m][n] = __builtin_amdgcn_mfma_f32_16x16x32_bf16(Bt[n][k], At[m][k], acc[ai][bj][m][n], 0, 0, 0); } __builtin_amdgcn_s_setprio(0); } while (0)
#define PG8_WAIT_V(n) asm volatile("s_waitcnt vmcnt(" #n ")" ::: "memory")
#define PG8_WAIT_L(n) asm volatile("s_waitcnt lgkmcnt(" #n ")" ::: "memory")
#define PG8_BAR __builtin_amdgcn_s_barrier()
#define PG8_SCHED __builtin_amdgcn_sched_barrier(0)
    Unit cur, nxt; int ui = 0;
    if (!S.next(0, cur)) return;
    f32x4 acc[2][2][4][2];
#pragma unroll
    for (int a = 0; a < 2; ++a)
#pragma unroll
        for (int b = 0; b < 2; ++b)
#pragma unroll
            for (int m = 0; m < 4; ++m)
#pragma unroll
                for (int n = 0; n < 2; ++n) acc[a][b][m][n] = (f32x4){0.f, 0.f, 0.f, 0.f};
    int pg8_scale1 = 0x7F7F7F7F; asm volatile("" : "+v"(pg8_scale1));
    bf16x8 At[4][2], B0[2][2], B1[2][2]; pg8_v8i At8[4], B08[2], B18[2];
    const char* cA = GATHER ? (const char*)g.A : (const char*)g.A + (size_t)cur.pm * tstep; const char* cB = (const char*)g.Bt + (size_t)cur.pn * tstep;
    if constexpr (GATHER) { PG8_GOFF(gc, cur.pm); }
    S.a_ready(cur);
    if constexpr (SP2) {
        PG8_STAGE(PG8_SB(0, 0), cB, voffB); PG8_STAGE(PG8_SB(0, 1), cB + hstep, voffB); PG8_STAGE_A(PG8_SA(0, 0), cA, 0, false); PG8_STAGE_A(PG8_SA(0, 1), cA, 1, false);
        if (wr == 1) PG8_BAR;
        PG8_WAIT_V(2); PG8_BAR;
        PG8_STAGE(PG8_SB(1, 0), cB + kstep, voffB); PG8_STAGE_A(PG8_SA(1, 0), cA + kstep, 0, false); PG8_STAGE(PG8_SB(1, 1), cB + hstep + kstep, voffB);
        PG8_WAIT_V(6); PG8_BAR;
    } else {
        PG8_STAGE(PG8_SB(0, 0), cB, voffB); PG8_STAGE_A(PG8_SA(0, 0), cA, 0, false); PG8_STAGE(PG8_SB(0, 1), cB + hstep, voffB); PG8_STAGE_A(PG8_SA(0, 1), cA, 1, false);
        if (wr == 1) PG8_BAR;
        PG8_WAIT_V(4); PG8_BAR;
        PG8_STAGE(PG8_SB(1, 0), cB + kstep, voffB); PG8_STAGE_A(PG8_SA(1, 0), cA + kstep, 0, false); PG8_STAGE(PG8_SB(1, 1), cB + hstep + kstep, voffB);
        PG8_WAIT_V(6); PG8_BAR;
    }
    for (;;) {
        const bool has_next = S.next(ui + 1, nxt);
        const char* nA = GATHER ? (const char*)g.A : (has_next ? (const char*)g.A + (size_t)nxt.pm * tstep : cA);
        if constexpr (GATHER) { if (has_next) { PG8_GOFF(gn, nxt.pm); } else { _Pragma("unroll") for (int _h = 0; _h < 2; ++_h) _Pragma("unroll") for (int _i = 0; _i < 2; ++_i) gn[_h][_i] = gc[_h][_i]; } } const char* nB = has_next ? (const char*)g.Bt + (size_t)nxt.pn * tstep : cB;
#pragma nounroll
        for (int t = 0; t < nt; t += 2) {
            const bool last = (t == nt - 2);
            const char* a1 = cA + (size_t)(t + 1) * kstep;
            const char* a2 = last ? nA : cA + (size_t)(t + 2) * kstep; const char* b2 = last ? nB : cB + (size_t)(t + 2) * kstep;
            const char* a3 = a2 + kstep; const char* b3 = b2 + kstep;
            if (last && has_next) S.a_ready(nxt);
            if constexpr (SP2) {
            PG8_LDB(B0, 0, 0); PG8_LDB(B1, 0, 1); PG8_SCHED; PG8_LDA(At, 0, 0); PG8_STAGE_A(PG8_SA(1, 1), a1, 1, false);
            PG8_WAIT_V(8); PG8_WAIT_L(0); PG8_BAR; PG8_MMA(0, 0, At, B0); PG8_MMA(0, 1, At, B1); PG8_BAR; PG8_SCHED;
            PG8_LDA(At, 0, 1); PG8_STAGE(PG8_SB(0, 0), b2, voffB); PG8_STAGE(PG8_SB(0, 1), b2 + hstep, voffB); PG8_STAGE_A(PG8_SA(0, 0), a2, 0, last);
            PG8_WAIT_V(8); PG8_WAIT_L(0); PG8_BAR; PG8_MMA(1, 0, At, B0); PG8_MMA(1, 1, At, B1); PG8_BAR; PG8_SCHED;
            PG8_LDB(B0, 1, 0); PG8_LDB(B1, 1, 1); PG8_SCHED; PG8_LDA(At, 1, 0); PG8_STAGE_A(PG8_SA(0, 1), a2, 1, last);
            PG8_WAIT_V(8); PG8_WAIT_L(0); PG8_BAR; PG8_MMA(0, 0, At, B0); PG8_MMA(0, 1, At, B1); PG8_BAR; PG8_SCHED;
            PG8_LDA(At, 1, 1); PG8_STAGE(PG8_SB(1, 0), b3, voffB); PG8_STAGE(PG8_SB(1, 1), b3 + hstep, voffB); PG8_STAGE_A(PG8_SA(1, 0), a3, 0, last);
            PG8_WAIT_V(8); PG8_WAIT_L(0); PG8_BAR; PG8_MMA(1, 0, At, B0); PG8_MMA(1, 1, At, B1); PG8_BAR; PG8_SCHED;
            } else {
            PG8_LDB(B0, 0, 0); PG8_SCHED; PG8_LDA(At, 0, 0); PG8_STAGE_A(PG8_SA(1, 1), a1, 1, false);
            PG8_WAIT_L(8); PG8_BAR; PG8_WAIT_L(0); PG8_MMA(0, 0, At, B0); PG8_BAR; PG8_SCHED;
            PG8_LDB(B1, 0, 1); PG8_STAGE(PG8_SB(0, 0), b2, voffB);
            PG8_BAR; PG8_WAIT_L(0); PG8_MMA(0, 1, At, B1); PG8_BAR;
            PG8_LDA(At, 0, 1); PG8_STAGE_A(PG8_SA(0, 0), a2, 0, last);
            PG8_BAR; PG8_WAIT_L(0); PG8_MMA(1, 0, At, B0); PG8_BAR; PG8_SCHED;
            PG8_STAGE(PG8_SB(0, 1), b2 + hstep, voffB);
            PG8_WAIT_V(6); PG8_BAR; PG8_MMA(1, 1, At, B1); PG8_BAR;
            PG8_LDB(B0, 1, 0); PG8_SCHED; PG8_LDA(At, 1, 0); PG8_STAGE_A(PG8_SA(0, 1), a2, 1, last);
            PG8_WAIT_L(8); PG8_BAR; PG8_WAIT_L(0); PG8_MMA(0, 0, At, B0); PG8_BAR; PG8_SCHED;
            PG8_LDB(B1, 1, 1); PG8_STAGE(PG8_SB(1, 0), b3, voffB);
            PG8_BAR; PG8_WAIT_L(0); PG8_MMA(0, 1, At, B1); PG8_BAR;
            PG8_LDA(At, 1, 1); PG8_STAGE_A(PG8_SA(1, 0), a3, 0, last);
            PG8_BAR; PG8_WAIT_L(0); PG8_MMA(1, 0, At, B0); PG8_BAR; PG8_SCHED;
            PG8_STAGE(PG8_SB(1, 1), b3 + hstep, voffB);
            PG8_WAIT_V(6); PG8_BAR; PG8_MMA(1, 1, At, B1); PG8_BAR;
            }
        }
        if constexpr (FP8) asm volatile("s_nop 15\n\ts_nop 15" ::: "memory");
        if constexpr (ALIGN_EPI) { if (wr == 0) PG8_BAR; }
        if constexpr (!Epi::AFTER_DRAIN) { E(acc, cur, wr, wc, fr, fq); S.done(cur); }
        if (!has_next) break;
#pragma unroll
        for (int a = 0; a < 2; ++a)
#pragma unroll
            for (int b = 0; b < 2; ++b)
#pragma unroll
                for (int m = 0; m < 4; ++m)
#pragma unroll
                    for (int n = 0; n < 2; ++n) acc[a][b][m][n] = (f32x4){0.f, 0.f, 0.f, 0.f};
        cur = nxt; cA = nA; cB = nB; ++ui;
        if constexpr (GATHER) { _Pragma("unroll") for (int _h = 0; _h < 2; ++_h) _Pragma("unroll") for (int _i = 0; _i < 2; ++_i) gc[_h][_i] = gn[_h][_i]; }
        if constexpr (ALIGN_EPI) { if (wr == 1) PG8_BAR; }
    }
    PG8_WAIT_V(0);
    if constexpr (!ALIGN_EPI) { if (wr == 0) PG8_BAR; }
    PG8_BAR;
    if constexpr (Epi::AFTER_DRAIN) { E.fused(acc, cur, wr, wc, fr, fq, lds, wid, lane); S.done(cur); }
#undef PG8_SA
#undef PG8_SB
#undef PG8_STAGE
#undef PG8_STAGE_A
#undef PG8_GOFF
#undef PG8_LDA
#undef PG8_LDB
#undef PG8_MMA
#undef PG8_CAT
#undef PG8_WAIT_V
#undef PG8_WAIT_L
#undef PG8_BAR
#undef PG8_SCHED
}
}
#define XB_TMO      128
#define XB_XCNT(j)  (256  + 64 * (j))
#define XB_XSUB(j)  (1280 + 64 * (j))
#define XB_XGEN(j)  (2304 + 64 * (j))
#define XB_TOP      3328
#define XB_TOPGEN   3392
#define XCD_BAR_WORDS 3456
#define XB_SPIN_CAP (1u << 18)

__device__ __forceinline__ unsigned xb_ld(unsigned* p)              { return __hip_atomic_load(p, __ATOMIC_RELAXED, __HIP_MEMORY_SCOPE_AGENT); }
__device__ __forceinline__ unsigned xb_add(unsigned* p, unsigned v) { return __hip_atomic_fetch_add(p, v, __ATOMIC_RELAXED, __HIP_MEMORY_SCOPE_AGENT); }
__device__ __forceinline__ unsigned xb_xcc_id() { return (unsigned)__builtin_amdgcn_s_getreg((3 << 11) | 20) & 0xFu; }
#define XB_SPIN(cond, bar) do { unsigned _sp = 0; while (cond) { __builtin_amdgcn_s_sleep(1); \
    if ((++_sp & 255u) == 0u) { if (xb_ld(&(bar)[XB_TMO])) break; if (_sp > XB_SPIN_CAP) { atomicAdd(&(bar)[XB_TMO], 1u); break; } } } } while (0)

struct XcdBarrier {
    unsigned* bar; unsigned x;
    volatile LAS unsigned* st;
};

__device__ __forceinline__ XcdBarrier xcd_barrier_post(unsigned* bar, volatile LAS unsigned* st) {
    XcdBarrier b; b.bar = bar; b.x = xb_xcc_id(); b.st = st;
    if (threadIdx.x == 0) (void)xb_add(&bar[XB_XCNT(b.x)], 1u);
    return b;
}
__device__ __forceinline__ void xcd_barrier_complete(unsigned* bar, unsigned x, unsigned& nloc, unsigned& nx) {
    const unsigned G = gridDim.x * gridDim.y * gridDim.z;
    unsigned sum, cnt, mine, sp = 0u;
    for (;;) {
        sum = 0u; cnt = 0u; mine = 0u;
#pragma unroll
        for (unsigned j = 0; j < 16; ++j) { const unsigned c = xb_ld(&bar[XB_XCNT(j)]); sum += c; cnt += (c > 0u) ? 1u : 0u; mine = (j == x) ? c : mine; }
        if (sum == G) break;
        __builtin_amdgcn_s_sleep(1);
        if ((++sp & 255u) == 0u) { if (xb_ld(&bar[XB_TMO])) break; if (sp > XB_SPIN_CAP) { atomicAdd(&bar[XB_TMO], 1u); break; } }
    }
    nloc = mine > 0u ? mine : 1u; nx = cnt > 0u ? cnt : 1u;
}

__device__ __forceinline__ void xcd_barrier(const XcdBarrier& b) {
    asm volatile("s_waitcnt vmcnt(0)" ::: "memory");
    __syncthreads();
    if (threadIdx.x == 0) {
        unsigned* bar = b.bar;
        __builtin_amdgcn_s_waitcnt(0);
        unsigned nloc = b.st[0], nx = b.st[1];
        if (nloc == 0u) { xcd_barrier_complete(bar, b.x, nloc, nx); b.st[0] = nloc; b.st[1] = nx; }
        const unsigned old = xb_add(&bar[XB_XSUB(b.x)], 1u);
        const unsigned gen = old / nloc;
        if (old + 1u == (gen + 1u) * nloc) {
            __builtin_amdgcn_fence(__ATOMIC_RELEASE, "agent");
            asm volatile("s_waitcnt vmcnt(0)" ::: "memory");
            const unsigned og = xb_add(&bar[XB_TOP], 1u);
            const unsigned tg = og / nx;
            if (og + 1u == (tg + 1u) * nx) xb_add(&bar[XB_TOPGEN], 1u);
            else XB_SPIN(xb_ld(&bar[XB_TOPGEN]) == tg, bar);
            __builtin_amdgcn_fence(__ATOMIC_ACQUIRE, "agent");
            xb_add(&bar[XB_XGEN(b.x)], 1u);
            asm volatile("s_waitcnt vmcnt(0)" ::: "memory");
        } else {
            XB_SPIN(xb_ld(&bar[XB_XGEN(b.x)]) == gen, bar);
            __builtin_amdgcn_fence(__ATOMIC_ACQUIRE, "agent");
            asm volatile("s_waitcnt vmcnt(0)" ::: "memory");
        }
    }
    __syncthreads();
}

enum InIdx { I_X = 0, I_MEM, I_RELB, I_ATTN_G, I_FFN_G, I_MEM_G, I_W_MKV, I_QN_MEM, I_KN_MEM, I_W_OUT, I_W_INA, I_QN_A, I_KN_A, I_KV_G, I_W_KVB, I_KN_B, I_W_INB, I_QN_B,
             I_LAMBDA, I_SUBLN, I_W_RG, I_B_RG, I_W_RE, I_B_RE, I_W_GATE, I_W_UP, I_W_DOWN, N_IN };
struct Args { const float* in[N_IN]; float* out; unsigned char* ws; int ph_lo, ph_hi; };
static_assert(sizeof(Args) == N_IN * 8 + 8 + 8 + 8, "Args has no padding");

using pg8::cvt_pk_bf16;
struct EpiRowScale {
    static constexpr bool PERM = true, AFTER_DRAIN = false;
    bf16* O; int ldc; const float* rs; int ntn; float cs;
    __device__ __forceinline__ void operator()(const f32x4 (&acc)[2][2][4][2], const pg8::Unit& u, int wr, int wc, int fr, int fq) const {
        const int colt = ntn ? (u.pn % ntn) : u.pn;
        const int row0 = u.pm * 256 + wr * 64 + fr, col0 = colt * 256 + wc * 32 + 8 * fq;
#pragma unroll
        for (int ai = 0; ai < 2; ++ai)
#pragma unroll
            for (int m = 0; m < 4; ++m) { const int row = row0 + ai * 128 + m * 16; const float s = (rs ? rs[row] : 1.f) * cs; bf16* rowp = O + (size_t)row * ldc + col0;
#pragma unroll
                for (int bj = 0; bj < 2; ++bj) { const f32x4 v0 = acc[ai][bj][m][0] * s, v1 = acc[ai][bj][m][1] * s;
                    v4u w; w.x = cvt_pk_bf16(v0[0], v0[1]); w.y = cvt_pk_bf16(v0[2], v0[3]); w.z = cvt_pk_bf16(v1[0], v1[1]); w.w = cvt_pk_bf16(v1[2], v1[3]);
                    *(v4u*)(rowp + bj * 128) = w; } }
    }
};
template <bool RES_F32>
struct EpiOutProj {
    static constexpr bool PERM = false, AFTER_DRAIN = false;
    const float* resid; float* part; bf16* HB; unsigned char* HB8; float cs;
    __device__ __forceinline__ void operator()(const f32x4 (&acc)[2][2][4][2], const pg8::Unit& u, int wr, int wc, int fr, int fq) const {
        const int row0 = u.pm * 256 + wr * 64 + fr, col0 = u.pn * 256 + wc * 32 + 4 * fq;
#pragma unroll
        for (int ai = 0; ai < 2; ++ai)
#pragma unroll
            for (int m = 0; m < 4; ++m) { const int row = row0 + ai * 128 + m * 16; const size_t off = (size_t)row * DM + col0; float ss = 0.f;
#pragma unroll
                for (int bj = 0; bj < 2; ++bj)
#pragma unroll
                    for (int n = 0; n < 2; ++n) { f32x4 r4;
                        if (RES_F32) r4 = *(const f32x4*)(resid + off + bj * 128 + n * 16);
                        else { const v2u rb = *(const v2u*)(HB + off + bj * 128 + n * 16); r4 = (f32x4){bflo(rb.x), bfhi(rb.x), bflo(rb.y), bfhi(rb.y)}; }
                        const f32x4 v = r4 + acc[ai][bj][m][n] * cs;
                        ss += (v[0] * v[0] + v[1] * v[1]) + (v[2] * v[2] + v[3] * v[3]);
                        v2u hb; hb.x = cvt_pk_bf16(v[0], v[1]); hb.y = cvt_pk_bf16(v[2], v[3]); *(v2u*)(HB + off + bj * 128 + n * 16) = hb;
                        unsigned w8 = 0u; w8 = __builtin_amdgcn_cvt_pk_fp8_f32(v[0], v[1], w8, false); w8 = __builtin_amdgcn_cvt_pk_fp8_f32(v[2], v[3], w8, true); *(unsigned*)(HB8 + off + bj * 128 + n * 16) = w8; }
                ss += swz_xor<16>(ss); ss = add_xor32(ss);
                if (fq == 0) part[(size_t)row * 32 + u.pn * 4 + wc] = ss; }
    }
};
struct EpiSiluMul {
    static constexpr bool PERM = true, AFTER_DRAIN = false;
    bf16* O; const float* rstd; const int* rowtok;
    __device__ __forceinline__ void operator()(const f32x4 (&acc)[2][2][4][2], const pg8::Unit& u, int wr, int wc, int fr, int fq) const {
        const int row0 = u.pm * 256 + wr * 64 + fr, col0 = (u.pn & 3) * 128 + wc * 32 + 8 * fq;
#pragma unroll
        for (int ai = 0; ai < 2; ++ai)
#pragma unroll
            for (int m = 0; m < 4; ++m) { const int row = row0 + ai * 128 + m * 16; float h[8]; const float rs = rstd[rowtok[row]] * (1.f / SC_W1);
#pragma unroll
                for (int n = 0; n < 2; ++n)
#pragma unroll
                    for (int e = 0; e < 4; ++e) { const float g = acc[ai][0][m][n][e] * rs, up = acc[ai][1][m][n][e] * (rs * SC_HID);
                        h[n * 4 + e] = g * up * __builtin_amdgcn_rcpf(1.f + __builtin_amdgcn_exp2f(-g * LOG2E)); }
                unsigned w0 = 0u, w1 = 0u; w0 = __builtin_amdgcn_cvt_pk_fp8_f32(h[0], h[1], w0, false); w0 = __builtin_amdgcn_cvt_pk_fp8_f32(h[2], h[3], w0, true);
                w1 = __builtin_amdgcn_cvt_pk_fp8_f32(h[4], h[5], w1, false); w1 = __builtin_amdgcn_cvt_pk_fp8_f32(h[6], h[7], w1, true);
                *(v2u*)((unsigned char*)O + (size_t)row * EFF + col0) = (v2u){w0, w1}; }
    }
};
struct MoeOrder {
    const int* blk_e; int nunits, ntn, G, c;
    __device__ __forceinline__ bool next(int i, pg8::Unit& u) const {
        const int L = i * G + c; if (L >= nunits) return false;
        const int rb = L / ntn; u.pm = rb; u.pn = blk_e[rb] * ntn + (L - rb * ntn); return true;
    }
    __device__ __forceinline__ void a_ready(const pg8::Unit&) const {}
    __device__ __forceinline__ void done(const pg8::Unit&) const {}
};

struct TrDesc { const float* src; int N; bf16* dst; int dstK; const float* gain; float f8; };
__device__ __forceinline__ TrDesc tr_decode(const Args& a, int r) {
    unsigned char* ws = opaque_ws(a.ws); TrDesc d; d.f8 = 0.f;
    constexpr int R0 = 2560, R1 = 1024, R2 = 1536, R3 = 2048, R4 = 1024, R5 = 32768, R6 = 32768;
    if (r < R0) { const int kb = r / 160, nb = r % 160; d.src = a.in[I_W_INA] + (size_t)(128 * kb) * 5120 + 32 * nb; d.N = 5120; d.dst = (bf16*)(ws + WS_W_INA + (size_t)(32 * nb) * DM + 128 * kb); d.dstK = DM; d.gain = a.in[I_ATTN_G] + 128 * kb; d.f8 = SC_W1; return d; } r -= R0;
    if (r < R1) { const int kb = r / 64, nb = r % 64; d.src = a.in[I_W_INB] + (size_t)(128 * kb) * 2048 + 32 * nb; d.N = 2048; d.dst = (bf16*)(ws + WS_W_INB) + (size_t)(32 * nb) * DM + 128 * kb; d.dstK = DM; d.gain = a.in[I_ATTN_G] + DM + 128 * kb; return d; } r -= R1;
    if (r < R2) { const int kb = r / 96, nb = r % 96; d.src = a.in[I_W_KVB] + (size_t)(128 * kb) * 3072 + 32 * nb; d.N = 3072; d.dst = (bf16*)(ws + WS_W_INB) + (size_t)(2048 + 32 * nb) * DM + 128 * kb; d.dstK = DM; d.gain = a.in[I_KV_G] + 128 * kb; return d; } r -= R2;
    if (r < R3) { const int l = r / 1024, rr = r % 1024, kb = rr / 64, nb = rr % 64; d.src = a.in[I_W_OUT] + (size_t)l * DM * DM + (size_t)(128 * kb) * 2048 + 32 * nb; d.N = 2048;
        if (l == 0) { d.dst = (bf16*)(ws + WS_W_OUT + (size_t)(32 * nb) * DM + 128 * kb); d.f8 = SC_W1; }
        else d.dst = (bf16*)(ws + WS_W_OUT) + (size_t)l * DM * DM + (size_t)(32 * nb) * DM + 128 * kb;
        d.dstK = DM; d.gain = nullptr; return d; } r -= R3;
    if (r < R4) { const int l = r / 512, rr = r % 512, kb = rr / 32, nb = rr % 32; d.src = a.in[I_W_MKV] + (size_t)l * DM * 1024 + (size_t)(128 * kb) * 1024 + 32 * nb; d.N = 1024;
        d.dst = (bf16*)(ws + WS_W_MKV) + (size_t)l * 1024 * DM + (size_t)(32 * nb) * DM + 128 * kb; d.dstK = DM; d.gain = a.in[I_MEM_G] + l * DM + 128 * kb; return d; } r -= R4;
    if (r < R5 + R6) { const int up = r >= R5 ? 1 : 0; if (up) r -= R5;
        const int le = r / 256, rr = r % 256, kb = rr / 16, nb = rr % 16, n0 = 32 * nb, drow = (n0 >> 7) * 256 + (n0 & 127) + up * 128;
        d.src = (up ? a.in[I_W_UP] : a.in[I_W_GATE]) + (size_t)le * DM * EFF + (size_t)(128 * kb) * EFF + n0; d.N = EFF;
        d.dst = (bf16*)(ws + WS_W_E1 + ((size_t)le * 1024 + drow) * DM + 128 * kb); d.dstK = DM; d.gain = a.in[I_FFN_G] + (le >> 6) * DM + 128 * kb; d.f8 = SC_W1; return d; } r -= R5 + R6;
    { const int le = r / 256, rr = r % 256, kb = rr / 64, nb = rr % 64; d.src = a.in[I_W_DOWN] + (size_t)le * EFF * DM + (size_t)(128 * kb) * DM + 32 * nb; d.N = DM;
        d.dst = (bf16*)(ws + WS_W_E2 + ((size_t)le * DM + 32 * nb) * EFF + 128 * kb); d.dstK = EFF; d.gain = nullptr; d.f8 = SC_W2; return d; }
}
__device__ __forceinline__ float row_to_fp8(const float* xrow, unsigned char* orow, int lane) {
    const GAS f32x4* xr = (const GAS f32x4*)xrow + lane;
    f32x4 v[8]; float s = 0.f;
#pragma unroll
    for (int j = 0; j < 8; ++j) { v[j] = xr[64 * j]; s += (v[j].x * v[j].x + v[j].y * v[j].y) + (v[j].z * v[j].z + v[j].w * v[j].w); }
    const float rstd = 1.0f / sqrtf(wave_sum(s) * (1.f / DM) + RMS_EPS);
    GAS unsigned* o4 = (GAS unsigned*)orow + lane;
#pragma unroll
    for (int j = 0; j < 8; ++j) { unsigned w = 0u; w = __builtin_amdgcn_cvt_pk_fp8_f32(v[j].x, v[j].y, w, false); w = __builtin_amdgcn_cvt_pk_fp8_f32(v[j].z, v[j].w, w, true); o4[64 * j] = w; }
    return rstd;
}
__device__ __forceinline__ float row_to_bf16(const float* xrow, bf16* orow, bool normalise, int lane) {
    const GAS f32x4* xr = (const GAS f32x4*)xrow + lane;
    f32x4 v[8]; float s = 0.f;
#pragma unroll
    for (int j = 0; j < 8; ++j) { v[j] = xr[64 * j]; s += (v[j].x * v[j].x + v[j].y * v[j].y) + (v[j].z * v[j].z + v[j].w * v[j].w); }
    const float rstd = 1.0f / sqrtf(wave_sum(s) * (1.f / DM) + RMS_EPS);
    const float f = normalise ? rstd : 1.f;
    GAS unsigned long long* o8 = (GAS unsigned long long*)orow + lane;
#pragma unroll
    for (int j = 0; j < 8; ++j) o8[64 * j] = (unsigned long long)pk2(v[j].x * f, v[j].y * f) | ((unsigned long long)pk2(v[j].z * f, v[j].w * f) << 32);
    return rstd;
}
#define TR_IDX(i) (layer < 0 ? (i) : 8192 + ((i) / 16384) * 32768 + layer * 16384 + ((i) % 16384))
__device__ __forceinline__ void tr_loop(const Args& a, LAS float* scr, int lane, int it, int end, int stride, int layer) {
    const int first0 = it < end ? it : 0;
    {
        float v[64];
        const int lr = lane >> 5, lc = lane & 31;
        TrDesc cur = tr_decode(a, TR_IDX(it < end ? it : first0));
        if (it < end) {
#pragma unroll
            for (int i = 0; i < 64; ++i) v[i] = __builtin_nontemporal_load(cur.src + (size_t)(2 * i + lr) * cur.N + lc);
        }
        for (; it < end; it += stride) {
#pragma unroll
            for (int i = 0; i < 64; ++i) scr[(2 * i + lr) * 33 + lc] = v[i];
            LDS_WAIT(); asm volatile("" ::: "memory");
            const int nx = it + stride; const bool has_next = nx < end;
            const TrDesc nd = tr_decode(a, TR_IDX(has_next ? nx : it));
            if (has_next) {
#pragma unroll
                for (int i = 0; i < 64; ++i) v[i] = __builtin_nontemporal_load(nd.src + (size_t)(2 * i + lr) * nd.N + lc);
            }
            if (cur.f8 != 0.f) {
                const int c = lane & 7, nq = lane >> 3; const float f = cur.f8;
                f32x4 g[4];
#pragma unroll
                for (int q = 0; q < 4; ++q) g[q] = cur.gain ? *(const f32x4*)(cur.gain + 16 * c + 4 * q) * f : (f32x4){f, f, f, f};
#pragma unroll
                for (int j = 0; j < 4; ++j) { const int n = nq + 8 * j; const LAS float* sp = scr + (16 * c) * 33 + n; v4u o;
#pragma unroll
                    for (int q = 0; q < 4; ++q) { unsigned w = 0u;
                        w = __builtin_amdgcn_cvt_pk_fp8_f32(sp[(4 * q + 0) * 33] * g[q][0], sp[(4 * q + 1) * 33] * g[q][1], w, false);
                        w = __builtin_amdgcn_cvt_pk_fp8_f32(sp[(4 * q + 2) * 33] * g[q][2], sp[(4 * q + 3) * 33] * g[q][3], w, true); o[q] = w; }
                    *(GAS v4u*)((unsigned char*)cur.dst + (size_t)n * cur.dstK + 16 * c) = o; }
            } else {
                const int c = lane & 15, nq = lane >> 4;
                f32x4 g0 = (f32x4){1.f, 1.f, 1.f, 1.f}, g1 = g0;
                if (cur.gain) { g0 = *(const f32x4*)(cur.gain + 8 * c); g1 = *(const f32x4*)(cur.gain + 8 * c + 4); }
#pragma unroll
                for (int j = 0; j < 8; ++j) { const int n = nq + 4 * j; const LAS float* sp = scr + (8 * c) * 33 + n;
                    v4u o; o.x = pk2(sp[0 * 33] * g0[0], sp[1 * 33] * g0[1]); o.y = pk2(sp[2 * 33] * g0[2], sp[3 * 33] * g0[3]); o.z = pk2(sp[4 * 33] * g1[0], sp[5 * 33] * g1[1]); o.w = pk2(sp[6 * 33] * g1[2], sp[7 * 33] * g1[3]);
                    *(GAS v4u*)(cur.dst + (size_t)n * cur.dstK + 8 * c) = o; }
            }
            LDS_WAIT(); asm volatile("" ::: "memory");
            cur = nd;
        }
    }
}
#undef TR_IDX
constexpr int EXP_ITEMS = 49152, CONV_CH = 48, CONV_NCH = EXP_ITEMS / CONV_CH;
__device__ __forceinline__ void conv_chunk(const Args& a, LAS unsigned char* lds, int layer, int c) {
    const int tid = opaque_tid(), lane = tid & 63, wave = __builtin_amdgcn_readfirstlane(tid >> 6);
    tr_loop(a, (LAS float*)(lds + RING_OFF + wave * 16896), lane, c * CONV_CH + wave, (c + 1) * CONV_CH, 8, layer);
    __syncthreads();
}
struct Mix { bool conv; int idx; };
__device__ __forceinline__ Mix mix_decode(int u, int NA, int NC) {
    const long U = NA + NC; const int cb = (int)(((long)u * NC) / U), cb1 = (int)(((long)(u + 1) * NC) / U);
    Mix m; m.conv = cb1 != cb; m.idx = m.conv ? cb : u - cb; return m;
}
__device__ __forceinline__ void phase_prep(const Args& a, LAS unsigned char* lds, int G, int vb) {
    const int tid = opaque_tid(), lane = tid & 63, wave = __builtin_amdgcn_readfirstlane(tid >> 6);
    unsigned char* ws = opaque_ws(a.ws);
    LAS float* scr = (LAS float*)(lds + RING_OFF + wave * 16896);
    const int gw = vb * 8 + wave, NGW = G * 8;
    tr_loop(a, scr, lane, gw, 8192, NGW, -1);
    for (int idx = vb * 512 + tid; idx < 2 * NRTP * DM; idx += G * 512) {
        const int l = idx / (NRTP * DM), j = (idx / DM) % NRTP, k = idx % DM;
        float v = 0.f;
        if (j < 8) v = a.in[I_W_RG][((size_t)l * DM + k) * 8 + j]; else if (j < NRT) v = a.in[I_W_RE][((size_t)l * DM + k) * 64 + (j - 8)];
        v *= a.in[I_FFN_G][l * DM + k];
        const unsigned hi = f2bf(v); const float lo = v - bf2f((unsigned short)hi);
        bf16* wr = (bf16*)(ws + WS_W_RT) + (size_t)l * 2 * NRTP * DM;
        wr[(size_t)j * DM + k] = (bf16)hi; wr[(size_t)(NRTP + j) * DM + k] = (bf16)f2bf(lo);
    }
    for (int idx = vb * 512 + tid; idx < 2 * 5 * HD; idx += G * 512) { const int l = idx / (5 * HD), w = (idx / HD) % 5, i = idx % HD; float v;
        if (l == 0) v = (w < 2) ? a.in[I_QN_A][i] : (w == 2) ? a.in[I_QN_MEM][i] : a.in[I_KN_A][i];
        else v = (w == 0) ? a.in[I_QN_B][i] : (w == 1) ? a.in[I_QN_B][HD + i] : (w == 2) ? a.in[I_QN_MEM][HD + i] : (w == 3) ? a.in[I_KN_B][i] : a.in[I_KN_B][HD + i];
        ((float*)(ws + WS_SMALL + SM_GAINTAB))[idx] = v; }
    float* rstd = (float*)(ws + WS_SMALL + SM_RSTD);
    for (int m = gw; m < T; m += NGW) { const float rs = row_to_fp8(a.in[I_X] + (size_t)m * DM, ws + WS_HB8 + (size_t)m * DM, lane); if (lane == 0) rstd[m] = rs; }
    for (int m = gw; m < NB * NMEM; m += NGW) (void)row_to_bf16(a.in[I_MEM] + (size_t)m * DM, (bf16*)(ws + WS_SMALL + SM_MEMN) + (size_t)m * DM, true, lane);
}

struct PostDesc { const bf16* src; int sp; bf16* dst; int dp; const float* gain; float scale; float* kmean; };
__device__ __forceinline__ void post_unit(const PostDesc& d, LAS unsigned char* lds) {
    const int tid = opaque_tid(), lane = tid & 63, wave = __builtin_amdgcn_readfirstlane(tid >> 6), c = lane & 15, rg = lane >> 4;
    float g8[8]; float cs[8];
#pragma unroll
    for (int i = 0; i < 8; ++i) { g8[i] = d.gain ? d.gain[8 * c + i] * d.scale : 1.f; cs[i] = 0.f; }
    v4u wv[8];
#pragma unroll
    for (int it = 0; it < 8; ++it) wv[it] = *(const v4u*)(d.src + (size_t)(wave * 32 + it * 4 + rg) * d.sp + 8 * c);
#pragma unroll
    for (int it = 0; it < 8; ++it) {
        const int row = wave * 32 + it * 4 + rg;
        const v4u w = wv[it];
        float f[8] = {bflo(w.x), bfhi(w.x), bflo(w.y), bfhi(w.y), bflo(w.z), bfhi(w.z), bflo(w.w), bfhi(w.w)};
        if (d.gain) {
            float ss = 0.f;
#pragma unroll
            for (int i = 0; i < 8; ++i) ss += f[i] * f[i];
            ss += swz_xor<1>(ss); ss += swz_xor<2>(ss); ss += swz_xor<4>(ss); ss += swz_xor<8>(ss);
            const float rstd = 1.0f / sqrtf(ss * (1.f / HD) + RMS_EPS);
#pragma unroll
            for (int i = 0; i < 8; ++i) { f[i] = f[i] * rstd * g8[i]; cs[i] += f[i]; }
        }
        v4u o; o.x = pk2(f[0], f[1]); o.y = pk2(f[2], f[3]); o.z = pk2(f[4], f[5]); o.w = pk2(f[6], f[7]);
        *(v4u*)(d.dst + (size_t)row * d.dp + 8 * c) = o;
    }
    if (d.kmean) {
        LAS float* ks = (LAS float*)(lds + RING_OFF);
#pragma unroll
        for (int i = 0; i < 8; ++i) { cs[i] += swz_xor<16>(cs[i]); cs[i] = add_xor32(cs[i]); }
        if (lane < 16) {
#pragma unroll
            for (int i = 0; i < 8; ++i) ks[wave * 128 + 8 * c + i] = cs[i]; }
        __syncthreads();
        if (tid < 128) { float s = 0.f;
#pragma unroll
            for (int w = 0; w < 8; ++w) s += ks[w * 128 + tid];
            d.kmean[tid] = s * (1.f / 256.f); }
        __syncthreads();
    }
}
__device__ __forceinline__ void phase_post_mem(const Args& a, LAS unsigned char* lds, int G, int vb) {
    unsigned char* ws = opaque_ws(a.ws);
    for (int v = vb; v < 32; v += G) {
        PostDesc d; d.kmean = nullptr; d.scale = 1.f; d.gain = nullptr;
        const int l = v >> 4, b = (v >> 3) & 1, s8 = v & 7;
        const bf16* srow = (const bf16*)(ws + WS_SMALL + SM_KVM) + ((size_t)b * 256) * 2048 + l * 1024; d.sp = 2048; d.dp = HD;
        if (s8 < 4) { d.src = srow + s8 * 128; d.dst = (bf16*)(ws + WS_SMALL + SM_KM) + ((size_t)((l * 2 + b) * 4 + s8) * NMEM) * HD; d.gain = a.in[I_KN_MEM] + l * HD; }
        else { d.src = srow + 512 + (s8 - 4) * 128; d.dst = (bf16*)(ws + WS_SMALL + SM_VM) + ((size_t)((l * 2 + b) * 4 + (s8 - 4)) * NMEM) * HD; }
        post_unit(d, lds);
    }
}
struct SlotDesc { bf16* dst; int dp; const float* gain; float scale; float* kmean; };
__device__ __forceinline__ SlotDesc slot_desc(unsigned char* ws, int layer, int sl, int pm) {
    const float* gt = (const float*)(ws + WS_SMALL + SM_GAINTAB) + layer * 5 * HD;
    bf16* QH = (bf16*)(ws + WS_QH); bf16* KH = (bf16*)(ws + WS_KH); bf16* VH = (bf16*)(ws + WS_VH);
    const int t0 = pm * 256, b = pm >> 5, s0 = (pm & 31) * 256;
    SlotDesc d; d.kmean = nullptr; d.scale = 1.f; d.gain = nullptr;
    if (layer == 0) {
        if (sl < 12) { d.dst = QH + (size_t)t0 * DM + sl * 128; d.dp = DM; d.gain = gt; d.scale = QSCALE; }
        else if (sl < 24) { const int h = sl - 12; d.dst = KH + ((size_t)(b * 12 + h) * SEQ + s0) * HD; d.dp = HD; d.gain = gt + 3 * HD;
            d.kmean = (float*)(ws + WS_SMALL + SM_KMEAN) + ((size_t)(b * 12 + h) * 32 + (pm & 31)) * HD; }
        else if (sl < 36) { const int h = sl - 24; d.dst = VH + ((size_t)(b * 12 + h) * SEQ + s0) * HD; d.dp = HD; }
        else { const int h = sl - 36; d.dst = QH + (size_t)t0 * DM + (12 + h) * 128; d.dp = DM; d.gain = gt + 2 * HD; d.scale = QSCALE; }
    } else {
        if (sl < 6) { d.dst = QH + (size_t)t0 * DM + sl * 128; d.dp = DM; d.gain = gt; d.scale = QSCALE; }
        else if (sl < 12) { d.dst = QH + (size_t)t0 * DM + sl * 128; d.dp = DM; d.gain = gt + HD; d.scale = QSCALE; }
        else if (sl < 16) { d.dst = QH + (size_t)t0 * DM + sl * 128; d.dp = DM; d.gain = gt + 2 * HD; d.scale = QSCALE; }
        else if (sl < 22) { const int h = sl - 16; d.dst = KH + ((size_t)(b * 12 + h) * SEQ + s0) * HD; d.dp = HD; d.gain = gt + 3 * HD; }
        else if (sl < 28) { const int h = sl - 22; d.dst = KH + ((size_t)(b * 12 + 6 + h) * SEQ + s0) * HD; d.dp = HD; d.gain = gt + 4 * HD; }
        else { const int vh = sl - 28, h = vh >> 1, cc = vh & 1; d.dst = VH + ((size_t)(b * 6 + h) * SEQ + s0) * DV + cc * 128; d.dp = DV; }
    }
    return d;
}
struct EpiHeadNorm {
    static constexpr bool PERM = true, AFTER_DRAIN = false;
    unsigned char* ws; int layer; float cs;
    __device__ __forceinline__ void operator()(const f32x4 (&acc)[2][2][4][2], const pg8::Unit& u, int wr, int wc, int fr_in, int fq_in) const {
        int fr = fr_in, fq = fq_in; asm volatile("" : "+v"(fr), "+v"(fq));
        LAS float* P = (LAS float*)(uintptr_t)LDSX_OFF;
        LAS float* KS = (LAS float*)(uintptr_t)(LDSX_OFF + 8192);
        const float* rs = (const float*)(ws + WS_SMALL + SM_RSTD);
        const SlotDesc d0 = slot_desc(ws, layer, 2 * u.pn, u.pm), d1 = slot_desc(ws, layer, 2 * u.pn + 1, u.pm);
        const int rowl = wr * 64 + fr, coll = wc * 32 + 8 * fq;
        const float* rsr = rs + u.pm * 256 + rowl;
#pragma unroll
        for (int ai = 0; ai < 2; ++ai)
#pragma unroll
            for (int m = 0; m < 4; ++m) { const int row = rowl + ai * 128 + m * 16; const float rtv = rsr[ai * 128 + m * 16] * cs;
#pragma unroll
                for (int bj = 0; bj < 2; ++bj) { if ((bj == 0 ? d0.gain : d1.gain) != nullptr) {
                    const f32x4 v0 = acc[ai][bj][m][0] * rtv, v1 = acc[ai][bj][m][1] * rtv;
                    float ss = (v0[0] * v0[0] + v0[1] * v0[1]) + (v0[2] * v0[2] + v0[3] * v0[3]) + (v1[0] * v1[0] + v1[1] * v1[1]) + (v1[2] * v1[2] + v1[3] * v1[3]);
                    ss += swz_xor<16>(ss); ss = add_xor32(ss);
                    if (fq == 0) P[(row * 2 + bj) * 4 + wc] = ss; } } }
        asm volatile("s_waitcnt lgkmcnt(0)" ::: "memory"); __builtin_amdgcn_s_barrier(); asm volatile("" ::: "memory");
#pragma unroll
        for (int bj = 0; bj < 2; ++bj) { const SlotDesc& d = bj == 0 ? d0 : d1;
            f32x4 g0 = (f32x4){1.f, 1.f, 1.f, 1.f}, g1 = g0;
            if (d.gain) { g0 = *(const f32x4*)(d.gain + coll) * d.scale; g1 = *(const f32x4*)(d.gain + coll + 4) * d.scale; }
            f32x4 c0 = (f32x4){0.f, 0.f, 0.f, 0.f}, c1 = c0;
#pragma unroll
            for (int ai = 0; ai < 2; ++ai)
#pragma unroll
                for (int m = 0; m < 4; ++m) { const int row = rowl + ai * 128 + m * 16; float f = rsr[ai * 128 + m * 16] * cs;
                    if (d.gain) { const f32x4 p4 = *(const LAS f32x4*)(P + (row * 2 + bj) * 4); f *= 1.0f / sqrtf(((p4[0] + p4[1]) + (p4[2] + p4[3])) * (1.f / HD) + RMS_EPS); }
                    const f32x4 v0 = acc[ai][bj][m][0] * f * g0, v1 = acc[ai][bj][m][1] * f * g1;
                    if (d.kmean) { c0 += v0; c1 += v1; }
                    v4u w; w.x = cvt_pk_bf16(v0[0], v0[1]); w.y = cvt_pk_bf16(v0[2], v0[3]); w.z = cvt_pk_bf16(v1[0], v1[1]); w.w = cvt_pk_bf16(v1[2], v1[3]);
                    *(v4u*)(d.dst + (size_t)row * d.dp + coll) = w; }
            if (d.kmean) {
#pragma unroll
                for (int i = 0; i < 4; ++i) { float v = c0[i]; v += swz_xor<1>(v); v += swz_xor<2>(v); v += swz_xor<4>(v); v += swz_xor<8>(v); if (fr == 0) KS[wr * 256 + bj * 128 + coll + i] = v;
                                              float w_ = c1[i]; w_ += swz_xor<1>(w_); w_ += swz_xor<2>(w_); w_ += swz_xor<4>(w_); w_ += swz_xor<8>(w_); if (fr == 0) KS[wr * 256 + bj * 128 + coll + 4 + i] = w_; } } }
        if (d0.kmean) {
            asm volatile("s_waitcnt lgkmcnt(0)" ::: "memory"); __builtin_amdgcn_s_barrier(); asm volatile("" ::: "memory");
            const int t = (wr * 4 + wc) * 64 + fq * 16 + fr;
            if (t < 256) { const float mean = (KS[t] + KS[256 + t]) * (1.f / 256.f); float* km = (t < 128) ? d0.kmean : d1.kmean; km[t & 127] = mean; }
        }
    }
};
__device__ __forceinline__ void phase_gate(const Args& a, LAS unsigned char* lds, int G, int vb) {
    unsigned char* ws = opaque_ws(a.ws);
    const bf16* QH = (const bf16*)(ws + WS_QH); const float* KMEAN = (const float*)(ws + WS_SMALL + SM_KMEAN); unsigned* SEL = (unsigned*)(ws + WS_SMALL + SM_SEL);
    gu32* MC = (gu32*)(ws + WS_CTL) + CW_MC; unsigned* LISTF = (unsigned*)(ws + WS_LISTF); unsigned* LISTA = (unsigned*)(ws + WS_LISTA);
    const int tid_g = opaque_tid();
    LAS float* kml = (LAS float*)(lds + RING_OFF);
    for (int idx = vb * 512 + tid_g; idx < NB * MOBA_H * SEQ; idx += G * 512) {
        const int bh = idx / SEQ, s = idx % SEQ, b = bh / MOBA_H, h = bh % MOBA_H, own = s >> 8;
        __syncthreads();
        { const f32x4* src = (const f32x4*)(KMEAN + (size_t)bh * 32 * HD); ((LAS f32x4*)kml)[tid_g] = src[tid_g]; ((LAS f32x4*)kml)[512 + tid_g] = src[512 + tid_g]; }
        __syncthreads();
        unsigned mask = 0u;
        if (own <= 3) { mask = (1u << own) - 1u; }
        else {
            float acc[31];
#pragma unroll
            for (int j = 0; j < 31; ++j) acc[j] = 0.f;
            const bf16* q = QH + ((size_t)b * SEQ + s) * DM + h * HD;
            for (int c = 0; c < 16; ++c) {
                const v4u w = *(const v4u*)(q + 8 * c);
                const float f0 = bflo(w.x), f1 = bfhi(w.x), f2 = bflo(w.y), f3 = bfhi(w.y), f4 = bflo(w.z), f5 = bfhi(w.z), f6 = bflo(w.w), f7 = bfhi(w.w);
#pragma unroll
                for (int j = 0; j < 31; ++j) if (j < own) {
                    const f32x4 k0 = *(const LAS f32x4*)(kml + j * HD + 8 * c), k1 = *(const LAS f32x4*)(kml + j * HD + 8 * c + 4);
                    acc[j] += (f0 * k0[0] + f1 * k0[1]) + (f2 * k0[2] + f3 * k0[3]) + (f4 * k1[0] + f5 * k1[1]) + (f6 * k1[2] + f7 * k1[3]); }
            }
#pragma unroll
            for (int rnd = 0; rnd < 3; ++rnd) { float best = -__builtin_inff(); int bi = 0;
#pragma unroll
                for (int j = 0; j < 31; ++j) if (j < own && !((mask >> j) & 1u) && acc[j] > best) { best = acc[j]; bi = j; }
                mask |= 1u << bi; }
        }
        SEL[idx] = mask;
        { const int lane_ = tid_g & 63; const unsigned long long lt = (1ull << lane_) - 1ull;
          for (int j = 0; j < own; ++j) {
              const bool selj = (mask >> j) & 1u; const unsigned long long bal = __ballot(selj);
              if (bal == 0ull) continue;
              const int far = (j == own - 1) ? 0 : 1; const int lead = __builtin_ctzll(bal);
              unsigned base = 0u; if (lane_ == lead) base = __hip_atomic_fetch_add(MC + (bh * 32 + j) * 2 + far, (unsigned)__builtin_popcountll(bal), RLX_AGENT);
              base = __shfl(base, lead);
              if (selj) { const unsigned pos = base + (unsigned)__builtin_popcountll(bal & lt); const int slot = __builtin_popcount(mask & ((1u << j) - 1u));
                  const unsigned ent = (unsigned)s | ((unsigned)slot << 16);
                  if (far) LISTF[((size_t)bh * 32 + j) * 8192 + pos] = ent; else LISTA[((size_t)bh * 32 + j) * 256 + pos] = ent; } } }
    }
}

namespace att {
constexpr int SHM_T = 16384;
#define KSWZ(row, colB) ((row) * 256 + ((colB) ^ (((row) & 7) << 4)))
#define SBAR() __builtin_amdgcn_sched_barrier(0)
__device__ __forceinline__ int v_rd_base(int lane) { return ((lane & 3) << 3) | (((lane >> 2) & 3) << 6) | (((lane >> 4) & 1) << 5) | (((lane >> 5) & 1) << 8); }
__device__ __forceinline__ int crow(int r, int hi) { return (r & 3) + 8 * (r >> 2) + 4 * hi; }
__device__ __forceinline__ unsigned cvtpk(float lo, float hi) { unsigned r; asm volatile("v_cvt_pk_bf16_f32 %0, %1, %2" : "=v"(r) : "v"(lo), "v"(hi)); return r; }
__device__ __forceinline__ int swap23(int k) { return (k & ~0xC) | ((k & 4) << 1) | ((k & 8) >> 1); }
__device__ __forceinline__ void glds16(const void* sbase  , unsigned voff, unsigned lds_dst) { unsigned keep;
    asm volatile("s_mov_b32 %0, m0\n\ts_mov_b32 m0, %3\n\ts_nop 0\n\tglobal_load_lds_dwordx4 %1, %2\n\ts_mov_b32 m0, %0" : "=&s"(keep) : "v"(voff), "s"(sbase), "s"(lds_dst) : "memory"); }
#define WAIT_BAR0() asm volatile("s_waitcnt vmcnt(0) lgkmcnt(0)\n\ts_barrier" ::: "memory")
constexpr float THR2 = 11.5f;

__device__ __forceinline__ void qkt(f32x16& p0, f32x16& p1, const LAS char* Kt, int r32, int hi, const bf16x8* qr) {
#pragma unroll
    for (int r = 0; r < 16; ++r) { p0[r] = 0.f; p1[r] = 0.f; }
    const LAS char* kb0 = Kt + KSWZ(r32, (0 * 16 + hi * 8) * 2);
    const LAS char* kb1 = Kt + KSWZ(r32, (1 * 16 + hi * 8) * 2);
    const LAS char* kb2 = Kt + KSWZ(r32, (2 * 16 + hi * 8) * 2);
    const LAS char* kb3 = Kt + KSWZ(r32, (3 * 16 + hi * 8) * 2);
#pragma unroll
    for (int d0 = 0; d0 < 8; ++d0) { const LAS char* a = ((d0 & 3) == 0 ? kb0 : (d0 & 3) == 1 ? kb1 : (d0 & 3) == 2 ? kb2 : kb3) + (d0 >> 2) * 128;
        const bf16x8 b0 = *(const LAS bf16x8*)a;
        const bf16x8 b1 = *(const LAS bf16x8*)(a + 32 * 256);
        p0 = __builtin_amdgcn_mfma_f32_32x32x16_bf16(b0, qr[d0], p0, 0, 0, 0);
        p1 = __builtin_amdgcn_mfma_f32_32x32x16_bf16(b1, qr[d0], p1, 0, 0, 0); }
}
__device__ __forceinline__ void pv_tile(f32x16* o, int vb, bf16x8 pa0, bf16x8 pa1, bf16x8 pa2, bf16x8 pa3) {
#define TRRD(dst, off) asm volatile("ds_read_b64_tr_b16 %0, %1 offset:%2" : "=&v"(dst) : "v"(vb), "i"(off) : "memory")
#define PV_RD(S_, d0) do { constexpr int b_ = (d0) * 512; TRRD(S_##l0, b_); TRRD(S_##h0, b_ + 2048); TRRD(S_##l1, b_ + 4096); TRRD(S_##h1, b_ + 6144); \
        TRRD(S_##l2, b_ + 8192); TRRD(S_##h2, b_ + 10240); TRRD(S_##l3, b_ + 12288); TRRD(S_##h3, b_ + 14336); } while (0)
#define PV_MM(S_, d0) do { \
        o[d0] = __builtin_amdgcn_mfma_f32_32x32x16_bf16(pa0, (bf16x8){S_##l0[0], S_##l0[1], S_##l0[2], S_##l0[3], S_##h0[0], S_##h0[1], S_##h0[2], S_##h0[3]}, o[d0], 0, 0, 0); \
        o[d0] = __builtin_amdgcn_mfma_f32_32x32x16_bf16(pa1, (bf16x8){S_##l1[0], S_##l1[1], S_##l1[2], S_##l1[3], S_##h1[0], S_##h1[1], S_##h1[2], S_##h1[3]}, o[d0], 0, 0, 0); \
        o[d0] = __builtin_amdgcn_mfma_f32_32x32x16_bf16(pa2, (bf16x8){S_##l2[0], S_##l2[1], S_##l2[2], S_##l2[3], S_##h2[0], S_##h2[1], S_##h2[2], S_##h2[3]}, o[d0], 0, 0, 0); \
        o[d0] = __builtin_amdgcn_mfma_f32_32x32x16_bf16(pa3, (bf16x8){S_##l3[0], S_##l3[1], S_##l3[2], S_##l3[3], S_##h3[0], S_##h3[1], S_##h3[2], S_##h3[3]}, o[d0], 0, 0, 0); } while (0)
#define WL(n) asm volatile("s_waitcnt lgkmcnt(" #n ")" ::: "memory")
    s16x4 Al0, Al1, Al2, Al3, Ah0, Ah1, Ah2, Ah3, Bl0, Bl1, Bl2, Bl3, Bh0, Bh1, Bh2, Bh3;
    PV_RD(A, 0); SBAR();
    PV_RD(B, 1); WL(8); SBAR(); PV_MM(A, 0); SBAR();
    PV_RD(A, 2); WL(8); SBAR(); PV_MM(B, 1); SBAR();
    PV_RD(B, 3); WL(8); SBAR(); PV_MM(A, 2); SBAR();
    WL(0); SBAR(); PV_MM(B, 3);
#undef PV_RD
#undef PV_MM
#undef TRRD
}
__device__ __forceinline__ void softmax_tile(f32x16& p0, f32x16& p1, float& m_reg, float& l_reg, float& alpha, bf16x8& pa0, bf16x8& pa1, bf16x8& pa2, bf16x8& pa3) {
    float pmax = p0[0];
#pragma unroll
    for (int r = 1; r < 16; ++r) pmax = fmaxf(pmax, p0[r]);
#pragma unroll
    for (int r = 0; r < 16; ++r) pmax = fmaxf(pmax, p1[r]);
    { auto rr = __builtin_amdgcn_permlane32_swap(__float_as_uint(pmax), __float_as_uint(pmax), false, false);
      pmax = fmaxf(__uint_as_float(rr[0]), __uint_as_float(rr[1])); }
    const float mn = (pmax - m_reg <= THR2) ? m_reg : fmaxf(m_reg, pmax);
    alpha = __builtin_amdgcn_exp2f(m_reg - mn); m_reg = mn;
#pragma unroll
    for (int r = 0; r < 16; ++r) { p0[r] = __builtin_amdgcn_exp2f(p0[r] - mn); p1[r] = __builtin_amdgcn_exp2f(p1[r] - mn); }
    float ps = 0.f;
#pragma unroll
    for (int r = 0; r < 16; ++r) ps += p0[r] + p1[r];
    { auto rr = __builtin_amdgcn_permlane32_swap(__float_as_uint(ps), __float_as_uint(ps), false, false);
      ps = __uint_as_float(rr[0]) + __uint_as_float(rr[1]); }
    l_reg = l_reg * alpha + ps;
#define PK4(P, B_, OUT) do { unsigned a0 = cvtpk(P[B_+0], P[B_+1]), a1 = cvtpk(P[B_+2], P[B_+3]); \
        unsigned b0 = cvtpk(P[B_+4], P[B_+5]), b1 = cvtpk(P[B_+6], P[B_+7]); \
        auto r0 = __builtin_amdgcn_permlane32_swap(a0, b0, false, false); auto r1 = __builtin_amdgcn_permlane32_swap(a1, b1, false, false); \
        v4u w = {r0[0], r1[0], r0[1], r1[1]}; OUT = __builtin_bit_cast(bf16x8, w); } while (0)
    PK4(p0, 0, pa0); PK4(p0, 8, pa1); PK4(p1, 0, pa2); PK4(p1, 8, pa3);
#undef PK4
}
__device__ __forceinline__ void bias_mask_tile(f32x16& p0, f32x16& p1, int dq, bool on, bool far, const LAS float* lut) {
    const float NEG = -__builtin_inff();
    if (far) {
        const float c = on ? lut[128] : NEG;
#pragma unroll
        for (int r = 0; r < 16; ++r) { p0[r] += c; p1[r] += c; }
    } else {
#pragma unroll
        for (int r = 0; r < 16; ++r) { const int c = (r & 3) + 8 * (r >> 2); const int d0 = dq - c, d1 = dq - c - 32;
            const float b0 = lut[min(max(d0, 0), 128)], b1 = lut[min(max(d1, 0), 128)];
            p0[r] = (on && d0 >= 0) ? p0[r] + b0 : NEG; p1[r] = (on && d1 >= 0) ? p1[r] + b1 : NEG; }
    }
}

__device__ __forceinline__ void qkt_half(f32x16& p, const LAS char* Kt  , int r32, int hi, const bf16x8* qr) {
#pragma unroll
    for (int r = 0; r < 16; ++r) p[r] = 0.f;
    const LAS char* kb0 = Kt + KSWZ(r32, (0 * 16 + hi * 8) * 2);
    const LAS char* kb1 = Kt + KSWZ(r32, (1 * 16 + hi * 8) * 2);
    const LAS char* kb2 = Kt + KSWZ(r32, (2 * 16 + hi * 8) * 2);
    const LAS char* kb3 = Kt + KSWZ(r32, (3 * 16 + hi * 8) * 2);
#pragma unroll
    for (int d0 = 0; d0 < 8; ++d0) { const LAS char* a = ((d0 & 3) == 0 ? kb0 : (d0 & 3) == 1 ? kb1 : (d0 & 3) == 2 ? kb2 : kb3) + (d0 >> 2) * 128;
        const bf16x8 b0 = *(const LAS bf16x8*)a;
        p = __builtin_amdgcn_mfma_f32_32x32x16_bf16(b0, qr[d0], p, 0, 0, 0); }
}
template <int HALF>
__device__ __forceinline__ void pv_half8(f32x16* o, int vb, bf16x8 pa0, bf16x8 pa1) {
#define TRRD(dst, off) asm volatile("ds_read_b64_tr_b16 %0, %1 offset:%2" : "=&v"(dst) : "v"(vb), "i"(off) : "memory")
#define PV_RD(S_, d0) do { constexpr int b_ = ((d0) & 3) * 512 + ((d0) >> 2) * SHM_T + HALF * 8192; TRRD(S_##l0, b_); TRRD(S_##h0, b_ + 2048); TRRD(S_##l1, b_ + 4096); TRRD(S_##h1, b_ + 6144); } while (0)
#define PV_MM(S_, d0) do { \
        o[d0] = __builtin_amdgcn_mfma_f32_32x32x16_bf16(pa0, (bf16x8){S_##l0[0], S_##l0[1], S_##l0[2], S_##l0[3], S_##h0[0], S_##h0[1], S_##h0[2], S_##h0[3]}, o[d0], 0, 0, 0); \
        o[d0] = __builtin_amdgcn_mfma_f32_32x32x16_bf16(pa1, (bf16x8){S_##l1[0], S_##l1[1], S_##l1[2], S_##l1[3], S_##h1[0], S_##h1[1], S_##h1[2], S_##h1[3]}, o[d0], 0, 0, 0); } while (0)
#define WL(n) asm volatile("s_waitcnt lgkmcnt(" #n ")" ::: "memory")
    s16x4 Al0, Al1, Ah0, Ah1, Bl0, Bl1, Bh0, Bh1;
    PV_RD(A, 0); SBAR();
    PV_RD(B, 1); WL(4); SBAR(); PV_MM(A, 0); SBAR();
    PV_RD(A, 2); WL(4); SBAR(); PV_MM(B, 1); SBAR();
    PV_RD(B, 3); WL(4); SBAR(); PV_MM(A, 2); SBAR();
    PV_RD(A, 4); WL(4); SBAR(); PV_MM(B, 3); SBAR();
    PV_RD(B, 5); WL(4); SBAR(); PV_MM(A, 4); SBAR();
    PV_RD(A, 6); WL(4); SBAR(); PV_MM(B, 5); SBAR();
    PV_RD(B, 7); WL(4); SBAR(); PV_MM(A, 6); SBAR();
    WL(0); SBAR(); PV_MM(B, 7);
#undef PV_RD
#undef PV_MM
#undef WL
#undef TRRD
}
__device__ __forceinline__ void softmax_half(f32x16& p0, float& m_reg, float& l_reg, float& alpha, bf16x8& pa0, bf16x8& pa1) {
    float pmax = p0[0];
#pragma unroll
    for (int r = 1; r < 16; ++r) pmax = fmaxf(pmax, p0[r]);
    { auto rr = __builtin_amdgcn_permlane32_swap(__float_as_uint(pmax), __float_as_uint(pmax), false, false);
      pmax = fmaxf(__uint_as_float(rr[0]), __uint_as_float(rr[1])); }
    const float mn = (pmax - m_reg <= THR2) ? m_reg : fmaxf(m_reg, pmax);
    alpha = __builtin_amdgcn_exp2f(m_reg - mn); m_reg = mn;
#pragma unroll
    for (int r = 0; r < 16; ++r) p0[r] = __builtin_amdgcn_exp2f(p0[r] - mn);
    float ps = 0.f;
#pragma unroll
    for (int r = 0; r < 16; ++r) ps += p0[r];
    { auto rr = __builtin_amdgcn_permlane32_swap(__float_as_uint(ps), __float_as_uint(ps), false, false);
      ps = __uint_as_float(rr[0]) + __uint_as_float(rr[1]); }
    l_reg = l_reg * alpha + ps;
#define PK4(P, B_, OUT) do { unsigned a0 = cvtpk(P[B_+0], P[B_+1]), a1 = cvtpk(P[B_+2], P[B_+3]); \
        unsigned b0 = cvtpk(P[B_+4], P[B_+5]), b1 = cvtpk(P[B_+6], P[B_+7]); \
        auto r0 = __builtin_amdgcn_permlane32_swap(a0, b0, false, false); auto r1 = __builtin_amdgcn_permlane32_swap(a1, b1, false, false); \
        v4u w = {r0[0], r1[0], r0[1], r1[1]}; OUT = __builtin_bit_cast(bf16x8, w); } while (0)
    PK4(p0, 0, pa0); PK4(p0, 8, pa1);
#undef PK4
}
__device__ __forceinline__ void bias_mask_half(f32x16& p0, int dq, bool far, const LAS float* lut) {
    const float NEG = -__builtin_inff();
    if (far) { const float c = lut[128];
#pragma unroll
        for (int r = 0; r < 16; ++r) p0[r] += c;
    } else {
#pragma unroll
        for (int r = 0; r < 16; ++r) { const int c = (r & 3) + 8 * (r >> 2); const int d0 = dq - c;
            const float b0 = lut[min(max(d0, 0), 128)]; p0[r] = (d0 >= 0) ? p0[r] + b0 : NEG; }
    }
}
#define RESC(o_, nd_, al_l_, alpha_) do { if (__any((alpha_) < 1.f)) { if (hi == 0) (al_l_)[r32] = (alpha_); asm volatile("s_waitcnt lgkmcnt(0)" ::: "memory"); \
        _Pragma("unroll") for (int r = 0; r < 16; ++r) { const float f_ = (al_l_)[crow(r, hi)]; _Pragma("unroll") for (int d_ = 0; d_ < (nd_); ++d_) (o_)[d_][r] *= f_; } } } while (0)

template <int MODE, bool F8OUT = false>
__device__ __forceinline__ void attn128_unit(LAS unsigned char* lds, const bf16* Qrow0, const bf16* Kh, const bf16* Vh, bf16* Orow0, int NT, int qb, const unsigned* selrow, const float* relb, int h) {
    const int tid = opaque_tid(), wid = __builtin_amdgcn_readfirstlane(tid >> 6), lane = tid & 63, r32 = lane & 31, hi = lane >> 5;
    LAS float* wsf = (LAS float*)(lds + LDSX_OFF) + wid * 64; LAS float* li_l = wsf; LAS float* al_l = wsf + 32;
    LAS float* lut = (LAS float*)(lds + LDSX_OFF + 2048);
    if (MODE == 0 && tid <= 128) lut[tid] = relb[(tid < 128 ? (int)T5_BUCKET[tid] : 31) * 12 + h] * LOG2E;
    bf16x8 qr[8];
#pragma unroll
    for (int d0 = 0; d0 < 8; ++d0) qr[d0] = *(const bf16x8*)(Qrow0 + (size_t)(wid * 32 + r32) * DM + d0 * 16 + hi * 8);
    unsigned sel = 0u; if (MODE == 0) sel = selrow[wid * 32 + r32];
    const int krow = 4 * wid + (lane >> 4); const unsigned ksrc = (unsigned) krow * 256 + ((16 * (lane & 15)) ^ ((krow & 7) << 4));
    const int vkk = 8 * (wid >> 1) + ((lane & 31) >> 2); const unsigned vsrc = (unsigned) swap23(vkk) * 256 + (32 * (2 * (wid & 1) + (lane >> 5)) + 8 * (lane & 3)) * 2;
    const unsigned lds0 = (unsigned)(uintptr_t)(lds + RING_OFF);
    const char* Kg = (const char*)Kh; const char* Vg = (const char*)Vh;
#define ISSUE(t, s) do { const unsigned base_ = (unsigned)__builtin_amdgcn_readfirstlane(lds0 + (s) * 32768 + wid * 1024); const size_t tb_ = (size_t)(t) * SHM_T; \
        glds16(Kg + tb_, ksrc, base_); glds16(Kg + tb_ + 8192, ksrc, base_ + 8192); glds16(Vg + tb_, vsrc, base_ + SHM_T); glds16(Vg + tb_ + 8192, vsrc, base_ + SHM_T + 8192); } while (0)
    const int vb0 = (int)lds0 + SHM_T + v_rd_base(lane);
    float m_reg = -1e30f, l_reg = 0.f; f32x16 o[4];
#pragma unroll
    for (int d = 0; d < 4; ++d)
#pragma unroll
        for (int r = 0; r < 16; ++r) o[d][r] = 0.f;
    const int q0w = qb * 256 + wid * 32, qpos = q0w + r32;
    ISSUE(0, 0);
    for (int t = 0; t < NT; ++t) {
        WAIT_BAR0();
        if (t + 1 < NT) ISSUE(t + 1, (t + 1) & 1);
        const int s = t & 1;
        f32x16 p0, p1;
        qkt(p0, p1, (const LAS char*)(lds + RING_OFF + s * 32768), r32, hi, qr);
        if (MODE == 0) { const int jb = t >> 2, tk0 = t * 64; const bool on = (jb >= qb) || ((sel >> jb) & 1u); const bool far = (q0w - (tk0 + 63)) >= 128;
            bias_mask_tile(p0, p1, qpos - tk0 - 4 * hi, on, far, lut); }
        float alpha; bf16x8 pa0, pa1, pa2, pa3;
        softmax_tile(p0, p1, m_reg, l_reg, alpha, pa0, pa1, pa2, pa3);
        RESC(o, 4, al_l, alpha);
        pv_tile(o, vb0 + s * 32768, pa0, pa1, pa2, pa3);
    }
#undef ISSUE
    if (hi == 0) li_l[r32] = l_reg; asm volatile("s_waitcnt lgkmcnt(0)" ::: "memory");
    int r32o = r32, hio = hi; asm volatile("" : "+v"(r32o), "+v"(hio));
    bf16* Ow = Orow0 + (size_t)(wid * 32) * DM + r32o;
#pragma unroll
    for (int r = 0; r < 16; ++r) { const int orow = crow(r, hio); const float rli = __builtin_amdgcn_rcpf(li_l[orow]);
#pragma unroll
        for (int d0 = 0; d0 < 4; ++d0) { const float v = o[d0][r] * rli; const float vn = swz_xor<1>(v);
            if (F8OUT) { if ((r32 & 1) == 0) *(unsigned short*)((unsigned char*)Orow0 + (size_t)(wid * 32 + orow) * DM + d0 * 32 + r32o) = (unsigned short)__builtin_amdgcn_cvt_pk_fp8_f32(v * SC_O, vn * SC_O, 0u, false); }
            else if ((r32 & 1) == 0) *(unsigned*)(Ow + (size_t)orow * DM + d0 * 32) = cvtpk(v, vn); } }
    WAIT_BAR0();
}

#define PK4X(P, B_, OUT) do { unsigned a0 = cvtpk(P[B_+0], P[B_+1]), a1 = cvtpk(P[B_+2], P[B_+3]); unsigned b0 = cvtpk(P[B_+4], P[B_+5]), b1 = cvtpk(P[B_+6], P[B_+7]); \
        auto r0 = __builtin_amdgcn_permlane32_swap(a0, b0, false, false); auto r1 = __builtin_amdgcn_permlane32_swap(a1, b1, false, false); v4u w = {r0[0], r1[0], r0[1], r1[1]}; OUT = __builtin_bit_cast(bf16x8, w); } while (0)
template <int VAR>
__device__ __forceinline__ void diff_unit(LAS unsigned char* lds, const bf16* Qrow0  , const bf16* K1h, const bf16* K2h, const bf16* Vh, bf16* Orow0  ,
                                          int qblk, const float* relb, int h, float lam, const float* subln) {
    const int tid = opaque_tid(), wid = __builtin_amdgcn_readfirstlane(tid >> 6), lane = tid & 63, r32 = lane & 31, hi = lane >> 5, mp = wid >> 2, w4 = wid & 3;
    LAS float* wsf = (LAS float*)(lds + LDSX_OFF) + wid * 64; LAS float* li_l = wsf; LAS float* al_l = wsf + 32;
    LAS float* lut2 = (LAS float*)(lds + LDSX_OFF + 2048);
    if (tid < 2 * 132) { const int m_ = tid / 132, i_ = tid % 132; if (i_ <= 128) lut2[tid] = relb[(i_ < 128 ? (int)T5_BUCKET[i_] : 31) * 12 + 2 * h + m_] * LOG2E; }
    const LAS float* lut = lut2 + mp * 132;
    bf16x8 qr[8];
#pragma unroll
    for (int d0 = 0; d0 < 8; ++d0) qr[d0] = *(const bf16x8*)(Qrow0 + (size_t)(w4 * 32 + r32) * DM + (h + 6 * mp) * HD + d0 * 16 + hi * 8);
    const int krow = 4 * wid + (lane >> 4); const unsigned ksrc = (unsigned) krow * 256 + ((16 * (lane & 15)) ^ ((krow & 7) << 4));
    const int vkk = 8 * (wid >> 1) + ((lane & 31) >> 2); const unsigned vsrc = (unsigned) swap23(vkk) * 512 + (32 * (2 * (wid & 1) + (lane >> 5)) + 8 * (lane & 3)) * 2;
    const unsigned lds0 = (unsigned)(uintptr_t)(lds + RING_OFF);
    const char* K1g = (const char*)K1h; const char* K2g = (const char*)K2h; const char* Vg = (const char*)Vh;
#define ISSUE(t, s) do { const unsigned base_ = (unsigned)__builtin_amdgcn_readfirstlane(lds0 + (s) * 65536 + wid * 1024); const size_t tb_ = (size_t)(t) * SHM_T; \
        glds16(K1g + tb_, ksrc, base_); glds16(K1g + tb_ + 8192, ksrc, base_ + 8192); glds16(K2g + tb_, ksrc, base_ + SHM_T); glds16(K2g + tb_ + 8192, ksrc, base_ + SHM_T + 8192); \
        glds16(Vg + 2 * tb_, vsrc, base_ + 2 * SHM_T); glds16(Vg + 2 * tb_ + 16384, vsrc, base_ + 2 * SHM_T + 8192); \
        glds16(Vg + 2 * tb_ + 256, vsrc, base_ + 3 * SHM_T); glds16(Vg + 2 * tb_ + 256 + 16384, vsrc, base_ + 3 * SHM_T + 8192); } while (0)
#define ISSUE_K(t, s) do { const unsigned base_ = (unsigned)__builtin_amdgcn_readfirstlane(lds0 + (s) * 65536 + wid * 1024); const size_t tb_ = (size_t)(t) * SHM_T; \
        glds16(K1g + tb_, ksrc, base_); glds16(K1g + tb_ + 8192, ksrc, base_ + 8192); glds16(K2g + tb_, ksrc, base_ + SHM_T); glds16(K2g + tb_ + 8192, ksrc, base_ + SHM_T + 8192); } while (0)
#define ISSUE_V(t, s) do { const unsigned base_ = (unsigned)__builtin_amdgcn_readfirstlane(lds0 + (s) * 65536 + wid * 1024); const size_t tb_ = (size_t)(t) * SHM_T; \
        glds16(Vg + 2 * tb_, vsrc, base_ + 2 * SHM_T); glds16(Vg + 2 * tb_ + 16384, vsrc, base_ + 2 * SHM_T + 8192); \
        glds16(Vg + 2 * tb_ + 256, vsrc, base_ + 3 * SHM_T); glds16(Vg + 2 * tb_ + 256 + 16384, vsrc, base_ + 3 * SHM_T + 8192); } while (0)
    const int vb0 = (int)lds0 + 2 * SHM_T + v_rd_base(lane);
    float m_reg = -1e30f, l_reg = 0.f; f32x16 o[8];
#pragma unroll
    for (int d = 0; d < 8; ++d)
#pragma unroll
        for (int r = 0; r < 16; ++r) o[d][r] = 0.f;
    const int q0w = qblk * 128 + w4 * 32, qpos = q0w + r32, NT = 2 * (qblk + 1);
    if (!(VAR & 1)) ISSUE(0, 0);
    for (int t = 0; t < NT; ++t) {
        WAIT_BAR0();
        if (!(VAR & 1)) if (t + 1 < NT) ISSUE(t + 1, (t + 1) & 1);
        const int s = t & 1, tk0 = t * 64;
        if (VAR & 2) continue;
        const bool far = (q0w - (tk0 + 63)) >= 128;
        { f32x16 p; float alpha; bf16x8 pa0, pa1;
          qkt_half(p, (const LAS char*)(lds + RING_OFF + s * 65536 + mp * SHM_T), r32, hi, qr);
          bias_mask_half(p, qpos - tk0 - 4 * hi, far, lut);
          if (VAR & 4) { alpha = 1.f; l_reg += p[0]; PK4X(p, 0, pa0); PK4X(p, 8, pa1); } else { softmax_half(p, m_reg, l_reg, alpha, pa0, pa1);
          RESC(o, 8, al_l, alpha); }
          pv_half8<0>(o, vb0 + s * 65536, pa0, pa1); }
        SBAR();
        { f32x16 p; float alpha; bf16x8 pa0, pa1;
          qkt_half(p, (const LAS char*)(lds + RING_OFF + s * 65536 + mp * SHM_T + 32 * 256), r32, hi, qr);
          bias_mask_half(p, qpos - tk0 - 32 - 4 * hi, far, lut);
          if (VAR & 4) { alpha = 1.f; l_reg += p[0]; PK4X(p, 0, pa0); PK4X(p, 8, pa1); } else { softmax_half(p, m_reg, l_reg, alpha, pa0, pa1);
          RESC(o, 8, al_l, alpha); }
          pv_half8<1>(o, vb0 + s * 65536, pa0, pa1); }
        SBAR();
    }
#undef ISSUE
#undef ISSUE_K
#undef ISSUE_V
    if (hi == 0) li_l[r32] = l_reg;
    WAIT_BAR0();
    int laneo = lane; asm volatile("" : "+v"(laneo));
    LAS float* X = (LAS float*)(lds + RING_OFF) + (w4 * 8 * 16 * 64 + laneo);
    if (mp == 1) {
#pragma unroll
        for (int r = 0; r < 16; ++r) { const float f = lam * __builtin_amdgcn_rcpf(li_l[crow(r, hi)]);
#pragma unroll
            for (int d0 = 0; d0 < 8; ++d0) X[(d0 * 16 + r) * 64] = o[d0][r] * f; }
    }
    WAIT_BAR0();
    if (mp == 0) {
        int r32o = r32, hio = hi; asm volatile("" : "+v"(r32o), "+v"(hio));
        bf16* Ow = Orow0 + (size_t)(w4 * 32) * DM + r32o; const float* sg = subln + r32o;
#pragma unroll
        for (int r = 0; r < 16; ++r) { const float rli = __builtin_amdgcn_rcpf(li_l[crow(r, hi)]); float ss = 0.f;
#pragma unroll
            for (int d0 = 0; d0 < 8; ++d0) { const float v = o[d0][r] * rli - X[(d0 * 16 + r) * 64]; o[d0][r] = v; ss += v * v; }
            ss += swz_xor<1>(ss); ss += swz_xor<2>(ss); ss += swz_xor<4>(ss); ss += swz_xor<8>(ss); ss += swz_xor<16>(ss);
            const float rs = (1.0f / sqrtf(ss * (1.f / DV) + RMS_EPS)) * (1.f - LAM_INIT); const int orow = crow(r, hio);
#pragma unroll
            for (int d0 = 0; d0 < 8; ++d0) { const float v = o[d0][r] * rs * sg[d0 * 32]; const float vn = swz_xor<1>(v);
                if ((r32 & 1) == 0) *(unsigned*)(Ow + (size_t)orow * DM + d0 * 32) = cvtpk(v, vn); } }
    }
    WAIT_BAR0();
}

__device__ __forceinline__ void moba_sparse_unit(LAS unsigned char* lds, const bf16* QHb, const bf16* Kblk, const bf16* Vblk, const unsigned* listF, int cntF, const unsigned* listA, int cntA, int j,
                                                 bf16* PO, float* PM, const float* relb, int h) {
    const int tid = opaque_tid(), wid = __builtin_amdgcn_readfirstlane(tid >> 6), lane = tid & 63, r32 = lane & 31, hi = lane >> 5;
    LAS float* wsf = (LAS float*)(lds + LDSX_OFF) + wid * 64; LAS float* li_l = wsf; LAS float* al_l = wsf + 32;
    LAS float* lut = (LAS float*)(lds + LDSX_OFF + 2048);
    if (tid <= 128) lut[tid] = relb[(tid < 128 ? (int)T5_BUCKET[tid] : 31) * 12 + h] * LOG2E;
    const int krow = 4 * wid + (lane >> 4); const unsigned ksrc = (unsigned) krow * 256 + ((16 * (lane & 15)) ^ ((krow & 7) << 4));
    const int vkk = 8 * (wid >> 1) + ((lane & 31) >> 2); const unsigned vsrc = (unsigned) swap23(vkk) * 256 + (32 * (2 * (wid & 1) + (lane >> 5)) + 8 * (lane & 3)) * 2;
    const unsigned lds0 = (unsigned)(uintptr_t)(lds + RING_OFF);
    const char* Kg = (const char*)Kblk; const char* Vg = (const char*)Vblk;
    { const unsigned base_ = (unsigned)__builtin_amdgcn_readfirstlane(lds0 + wid * 1024);
#pragma unroll
      for (int t = 0; t < 4; ++t) { glds16(Kg + t * SHM_T, ksrc, base_ + t * SHM_T); glds16(Kg + t * SHM_T + 8192, ksrc, base_ + t * SHM_T + 8192);
                                    glds16(Vg + t * SHM_T, vsrc, base_ + 65536 + t * SHM_T); glds16(Vg + t * SHM_T + 8192, vsrc, base_ + 65536 + t * SHM_T + 8192); } }
    const int vb0 = (int)lds0 + 65536 + v_rd_base(lane);
    const int gF = (cntF + 31) >> 5, ng = gF + ((cntA + 31) >> 5);
    const float c31 = relb[31 * 12 + h] * LOG2E;
#define GRP_ENT(g_, ent_, val_) do { const bool fr_ = (g_) < gF; const int b0_ = fr_ ? (g_) * 32 : ((g_) - gF) * 32; const int n_ = fr_ ? cntF : cntA; const unsigned* l_ = fr_ ? listF : listA; \
        val_ = (b0_ + r32) < n_; ent_ = l_[val_ ? b0_ + r32 : b0_]; } while (0)
#define LOADQ(dst_, ent_) do { const bf16* qp_ = QHb + (size_t)((ent_) & 0xffffu) * DM + hi * 8; _Pragma("unroll") for (int d0 = 0; d0 < 8; ++d0) dst_[d0] = *(const bf16x8*)(qp_ + d0 * 16); } while (0)
    int g = wid; unsigned ent = 0u, entn = 0u; bool valid = false, validn = false; bf16x8 qr[8], qn[8];
    if (g < ng) { GRP_ENT(g, ent, valid); LOADQ(qr, ent); }
    if (g + 8 < ng) GRP_ENT(g + 8, entn, validn);
    WAIT_BAR0();
    for (; g < ng; g += 8) {
        const bool adj = g >= gF;
        unsigned entnn = 0u; bool validnn = false;
        if (g + 8 < ng) LOADQ(qn, entn);
        if (g + 16 < ng) GRP_ENT(g + 16, entnn, validnn);
        const int srow = (int)(ent & 0xffffu), slot = (int)(ent >> 16);
        float m_reg = -1e30f, l_reg = 0.f; f32x16 o[4];
#pragma unroll
        for (int d = 0; d < 4; ++d)
#pragma unroll
            for (int r = 0; r < 16; ++r) o[d][r] = 0.f;
#pragma unroll 1
        for (int t = 0; t < 4; ++t) {
            f32x16 p0, p1;
            qkt(p0, p1, (const LAS char*)(lds + RING_OFF + t * SHM_T), r32, hi, qr);
            if (adj) bias_mask_tile(p0, p1, srow - (j * 256 + t * 64) - 4 * hi, true, false, lut);
            float alpha; bf16x8 pa0, pa1, pa2, pa3;
            softmax_tile(p0, p1, m_reg, l_reg, alpha, pa0, pa1, pa2, pa3);
            RESC(o, 4, al_l, alpha);
            pv_tile(o, vb0 + t * SHM_T, pa0, pa1, pa2, pa3);
        }
        LAS int* rd = (LAS int*)al_l;
        const int rec = srow * 3 + slot;
        if (hi == 0) { li_l[r32] = l_reg; rd[r32] = valid ? rec : -1;
            if (valid) { PM[(size_t)rec * 2] = m_reg + (adj ? 0.f : c31); PM[(size_t)rec * 2 + 1] = l_reg; } }
        asm volatile("s_waitcnt lgkmcnt(0)" ::: "memory");
        int r32o = r32, hio = hi; asm volatile("" : "+v"(r32o), "+v"(hio));
#pragma unroll
        for (int r = 0; r < 16; ++r) { const int orow = crow(r, hio); const float rli = __builtin_amdgcn_rcpf(li_l[orow]); const int dst = rd[orow];
#pragma unroll
            for (int d0 = 0; d0 < 4; ++d0) { const float v = o[d0][r] * rli; const float vn = swz_xor<1>(v);
                if ((r32 & 1) == 0 && dst >= 0) *(unsigned*)(PO + (size_t)dst * HD + d0 * 32 + r32o) = cvtpk(v, vn); } }
        asm volatile("s_waitcnt lgkmcnt(0)" ::: "memory");
#pragma unroll
        for (int d0 = 0; d0 < 8; ++d0) qr[d0] = qn[d0];
        ent = entn; valid = validn; entn = entnn; validn = validnn;
    }
#undef GRP_ENT
#undef LOADQ
    WAIT_BAR0();
}

__device__ __forceinline__ void moba_final_unit(LAS unsigned char* lds, const bf16* Qrow0, const bf16* Kh, const bf16* Vh, bf16* Orow0, int qb, const unsigned* selrow, const float* relb, int h, const bf16* PO, const float* PM) {
    const int tid = opaque_tid(), wid = __builtin_amdgcn_readfirstlane(tid >> 6), lane = tid & 63, r32 = lane & 31, hi = lane >> 5;
    LAS float* wsf = (LAS float*)(lds + LDSX_OFF) + wid * 64; LAS float* al_l = wsf + 32;
    LAS float* lut = (LAS float*)(lds + LDSX_OFF + 2048);
    LAS float* ftab = (LAS float*)(lds + LDSX_OFF + 4352) + wid * 128;
    if (tid <= 128) lut[tid] = relb[(tid < 128 ? (int)T5_BUCKET[tid] : 31) * 12 + h] * LOG2E;
    bf16x8 qr[8];
#pragma unroll
    for (int d0 = 0; d0 < 8; ++d0) qr[d0] = *(const bf16x8*)(Qrow0 + (size_t)(wid * 32 + r32) * DM + d0 * 16 + hi * 8);
    const unsigned sel = selrow[wid * 32 + r32];
    const int krow = 4 * wid + (lane >> 4); const unsigned ksrc = (unsigned) krow * 256 + ((16 * (lane & 15)) ^ ((krow & 7) << 4));
    const int vkk = 8 * (wid >> 1) + ((lane & 31) >> 2); const unsigned vsrc = (unsigned) swap23(vkk) * 256 + (32 * (2 * (wid & 1) + (lane >> 5)) + 8 * (lane & 3)) * 2;
    const unsigned lds0 = (unsigned)(uintptr_t)(lds + RING_OFF);
    const char* Kg = (const char*)(Kh + (size_t)qb * 256 * HD); const char* Vg = (const char*)(Vh + (size_t)qb * 256 * HD);
    { const unsigned base_ = (unsigned)__builtin_amdgcn_readfirstlane(lds0 + wid * 1024);
#pragma unroll
      for (int t = 0; t < 4; ++t) { glds16(Kg + t * SHM_T, ksrc, base_ + t * SHM_T); glds16(Kg + t * SHM_T + 8192, ksrc, base_ + t * SHM_T + 8192);
                                    glds16(Vg + t * SHM_T, vsrc, base_ + 65536 + t * SHM_T); glds16(Vg + t * SHM_T + 8192, vsrc, base_ + 65536 + t * SHM_T + 8192); } }
    const int vb0 = (int)lds0 + 65536 + v_rd_base(lane);
    float m_reg = -1e30f, l_reg = 0.f; f32x16 o[4];
#pragma unroll
    for (int d = 0; d < 4; ++d)
#pragma unroll
        for (int r = 0; r < 16; ++r) o[d][r] = 0.f;
    const int qrel = wid * 32 + r32;
    WAIT_BAR0();
#pragma unroll 1
    for (int t = 0; t <= (wid >> 1); ++t) {
        f32x16 p0, p1;
        qkt(p0, p1, (const LAS char*)(lds + RING_OFF + t * SHM_T), r32, hi, qr);
        bias_mask_tile(p0, p1, qrel - t * 64 - 4 * hi, true, false, lut);
        float alpha; bf16x8 pa0, pa1, pa2, pa3;
        softmax_tile(p0, p1, m_reg, l_reg, alpha, pa0, pa1, pa2, pa3);
        RESC(o, 4, al_l, alpha);
        pv_tile(o, vb0 + t * SHM_T, pa0, pa1, pa2, pa3);
    }
    const int nsel = __builtin_popcount(sel); const size_t rec0 = (size_t)(qb * 256 + qrel) * 3;
    float mi[3], li[3]; float M = m_reg;
#pragma unroll
    for (int i = 0; i < 3; ++i) { mi[i] = -1e30f; li[i] = 0.f; if (i < nsel) { mi[i] = PM[(rec0 + i) * 2]; li[i] = PM[(rec0 + i) * 2 + 1]; } M = fmaxf(M, mi[i]); }
    const float wo = __builtin_amdgcn_exp2f(m_reg - M); float L = l_reg * wo; float wi[3];
#pragma unroll
    for (int i = 0; i < 3; ++i) { wi[i] = (i < nsel) ? li[i] * __builtin_amdgcn_exp2f(mi[i] - M) : 0.f; L += wi[i]; }
    const float rL = 1.f / L;
    if (hi == 0) { ftab[r32] = wo * rL; ftab[32 + r32] = wi[0] * rL; ftab[64 + r32] = wi[1] * rL; ftab[96 + r32] = wi[2] * rL; }
    WAIT_BAR0();
    int r32o = r32, hio = hi, laneo = lane; asm volatile("" : "+v"(r32o), "+v"(hio), "+v"(laneo));
    LAS float* X = (LAS float*)(lds + RING_OFF) + wid * 4096;
#pragma unroll
    for (int r = 0; r < 16; ++r) { const int orow = crow(r, hio); const float fo = ftab[orow];
#pragma unroll
        for (int d0 = 0; d0 < 4; ++d0) X[orow * 128 + d0 * 32 + r32o] = o[d0][r] * fo; }
    asm volatile("s_waitcnt lgkmcnt(0)" ::: "memory");
    { const int rg = laneo >> 4, c = laneo & 15;
      unsigned char* Ow = (unsigned char*)Orow0 + (size_t)(wid * 32) * DM + 8 * c;
      const bf16* Pw = PO + ((size_t)(qb * 256 + wid * 32) * 3) * HD + 8 * c;
#pragma unroll 2
      for (int it = 0; it < 8; ++it) { const int row = it * 4 + rg;
          const f32x4 x0 = *(const LAS f32x4*)(X + row * 128 + 8 * c), x1 = *(const LAS f32x4*)(X + row * 128 + 8 * c + 4);
          float v[8] = {x0[0], x0[1], x0[2], x0[3], x1[0], x1[1], x1[2], x1[3]};
#pragma unroll
          for (int i = 0; i < 3; ++i) { const float f = ftab[32 * (i + 1) + row];
              if (f != 0.f) { const v4u w = *(const v4u*)(Pw + ((size_t)row * 3 + i) * HD);
                  v[0] += f * bflo(w.x); v[1] += f * bfhi(w.x); v[2] += f * bflo(w.y); v[3] += f * bfhi(w.y); v[4] += f * bflo(w.z); v[5] += f * bfhi(w.z); v[6] += f * bflo(w.w); v[7] += f * bfhi(w.w); } }
          unsigned w0 = 0u, w1 = 0u;
          w0 = __builtin_amdgcn_cvt_pk_fp8_f32(v[0] * SC_O, v[1] * SC_O, w0, false); w0 = __builtin_amdgcn_cvt_pk_fp8_f32(v[2] * SC_O, v[3] * SC_O, w0, true);
          w1 = __builtin_amdgcn_cvt_pk_fp8_f32(v[4] * SC_O, v[5] * SC_O, w1, false); w1 = __builtin_amdgcn_cvt_pk_fp8_f32(v[6] * SC_O, v[7] * SC_O, w1, true);
          *(v2u*)(Ow + (size_t)row * DM) = (v2u){w0, w1}; } }
    WAIT_BAR0();
}
#undef RESC
}

__device__ __forceinline__ int queue_next(gu32* ctr, LAS unsigned char* lds) {
    volatile LAS int* slot = (volatile LAS int*)(lds + LDSX_OFF + 4096);
    if (threadIdx.x == 0) slot[0] = (int)__hip_atomic_fetch_add(ctr, 1u, RLX_AGENT);
    __syncthreads();
    return __builtin_amdgcn_readfirstlane(slot[0]);
}

__device__ __forceinline__ void phase_moba_sparse(const Args& a, LAS unsigned char* lds, gu32* qctr) {
    unsigned char* ws = opaque_ws(a.ws);
    const bf16* QH = (const bf16*)(ws + WS_QH); const bf16* KH = (const bf16*)(ws + WS_KH); const bf16* VH = (const bf16*)(ws + WS_VH);
    const unsigned* MC = (const unsigned*)(ws + WS_CTL) + CW_MC;
    for (;;) {
        const int uq = queue_next(qctr, lds);
        if (uq >= 744 + CONV_NCH / 2) break;
        const Mix mx = mix_decode(uq, 744, CONV_NCH / 2);
        if (mx.conv) { conv_chunk(a, lds, 0, mx.idx); continue; }
        const int u = mx.idx;
        const int j = u / 24, bh = u % 24, b = bh / 12, h = bh % 12;
        const int cntA = (int)MC[(bh * 32 + j) * 2], cntF = (int)MC[(bh * 32 + j) * 2 + 1];
        const bf16* QHb = QH + (size_t)b * SEQ * DM + h * HD; const bf16* Kblk = KH + ((size_t)bh * SEQ + j * 256) * HD; const bf16* Vblk = VH + ((size_t)bh * SEQ + j * 256) * HD;
        bf16* PO = (bf16*)(ws + WS_PO) + (size_t)bh * SEQ * 3 * HD; float* PM = (float*)(ws + WS_PM) + (size_t)bh * SEQ * 3 * 2;
        att::moba_sparse_unit(lds, QHb, Kblk, Vblk, (const unsigned*)(ws + WS_LISTF) + ((size_t)bh * 32 + j) * 8192, cntF, (const unsigned*)(ws + WS_LISTA) + ((size_t)bh * 32 + j) * 256, cntA, j, PO, PM, a.in[I_RELB], h);
    }
}
__device__ __forceinline__ void phase_attn_a(const Args& a, LAS unsigned char* lds, gu32* qctr) {
    unsigned char* ws = opaque_ws(a.ws);
    const bf16* QH = (const bf16*)(ws + WS_QH); const bf16* KH = (const bf16*)(ws + WS_KH); const bf16* VH = (const bf16*)(ws + WS_VH); bf16* OC = (bf16*)(ws + WS_OCAT);
    const unsigned* SEL = (const unsigned*)(ws + WS_SMALL + SM_SEL);
    for (;;) {
        const int uq = queue_next(qctr, lds);
        if (uq >= 768 + 256 + CONV_NCH / 2) break;
        const Mix mx = mix_decode(uq, 768 + 256, CONV_NCH / 2);
        if (mx.conv) { conv_chunk(a, lds, 0, CONV_NCH / 2 + mx.idx); continue; }
        const int u = mx.idx;
        if (u < 768) { const int qb = 31 - u / 24, bh = u % 24, b = bh / 12, h = bh % 12; const size_t row0 = (size_t)b * SEQ + qb * 256;
            att::moba_final_unit(lds, QH + row0 * DM + h * HD, KH + (size_t)bh * SEQ * HD, VH + (size_t)bh * SEQ * HD, (bf16*)((unsigned char*)OC + row0 * DM + h * HD), qb,
                                 SEL + (size_t)bh * SEQ + qb * 256, a.in[I_RELB], h, (const bf16*)(ws + WS_PO) + (size_t)bh * SEQ * 3 * HD, (const float*)(ws + WS_PM) + (size_t)bh * SEQ * 3 * 2);
        } else { const int v = u - 768, b = v >> 7, hm = (v >> 5) & 3, qb = v & 31; const size_t row0 = (size_t)b * SEQ + qb * 256;
            const size_t mo = (size_t)((0 * 2 + b) * 4 + hm) * NMEM * HD;
            att::attn128_unit<1, true>(lds, QH + row0 * DM + (12 + hm) * HD, (const bf16*)(ws + WS_SMALL + SM_KM) + mo, (const bf16*)(ws + WS_SMALL + SM_VM) + mo, (bf16*)((unsigned char*)OC + row0 * DM + MIXW + hm * HD), 4, 0, nullptr, nullptr, 0);
        }
    }
}
template <int VAR>
__device__ __forceinline__ void phase_attn_b(const Args& a, LAS unsigned char* lds, gu32* qctr, bf16* OC) {
    unsigned char* ws = opaque_ws(a.ws);
    const bf16* QH = (const bf16*)(ws + WS_QH); const bf16* KH = (const bf16*)(ws + WS_KH); const bf16* VH = (const bf16*)(ws + WS_VH);
    float lam;
    { const float* lb = a.in[I_LAMBDA]; const int lane = opaque_tid() & 63;
      float s1 = lb[lane] * lb[128 + lane] + lb[64 + lane] * lb[128 + 64 + lane], s2 = lb[256 + lane] * lb[384 + lane] + lb[256 + 64 + lane] * lb[384 + 64 + lane];
      s1 = wave_sum(s1); s2 = wave_sum(s2); lam = expf(s1) - expf(s2) + LAM_INIT; }
    for (;;) {
        const int uq = queue_next(qctr, lds);
        if (uq >= 768 + 256 + CONV_NCH) break;
        const Mix mx = mix_decode(uq, 768 + 256, CONV_NCH);
        if (mx.conv) { conv_chunk(a, lds, 1, mx.idx); continue; }
        const int u = mx.idx;
        if (u < 768) { const int qblk = 63 - u / 12, bh = u % 12, b = bh / 6, h = bh % 6; const size_t row0 = (size_t)b * SEQ + qblk * 128;
            att::diff_unit<VAR>(lds, QH + row0 * DM, KH + (size_t)(b * 12 + h) * SEQ * HD, KH + (size_t)(b * 12 + 6 + h) * SEQ * HD, VH + (size_t)(b * 6 + h) * SEQ * DV, OC + row0 * DM + h * DV,
                           qblk, a.in[I_RELB], h, lam, a.in[I_SUBLN]);
        } else { const int v = u - 768, b = v >> 7, hm = (v >> 5) & 3, qb = v & 31; const size_t row0 = (size_t)b * SEQ + qb * 256;
            const size_t mo = (size_t)((1 * 2 + b) * 4 + hm) * NMEM * HD;
            att::attn128_unit<1>(lds, QH + row0 * DM + (12 + hm) * HD, (const bf16*)(ws + WS_SMALL + SM_KM) + mo, (const bf16*)(ws + WS_SMALL + SM_VM) + mo, OC + row0 * DM + MIXW + hm * HD, 4, 0, nullptr, nullptr, 0);
        }
    }
}

__device__ __forceinline__ void phase_router(const Args& a, LAS unsigned char* lds, int G, int vb, int layer) {
    unsigned char* ws = opaque_ws(a.ws);
    const int tid = opaque_tid(), lane = tid & 63, wave = __builtin_amdgcn_readfirstlane(tid >> 6), i16 = lane & 15, g4 = lane >> 4, tg = wave & 1, kq = wave >> 1;
    const bf16* H = (const bf16*)(ws + WS_HB);
    const bf16* WRh = (const bf16*)(ws + WS_W_RT) + (size_t)layer * 2 * NRTP * DM;
    LAS float* L = (LAS float*)(lds + RING_OFF);
    LAS int* cnt = (LAS int*)(lds + RING_OFF + 4 * 64 * NRTP * 4);
    for (int blk = vb; blk < T / 64; blk += G) {
        if (tid < 64) cnt[tid] = 0;
        f32x4 acc[2][5];
#pragma unroll
        for (int t2 = 0; t2 < 2; ++t2)
#pragma unroll
            for (int j = 0; j < 5; ++j) acc[t2][j] = (f32x4){0.f, 0.f, 0.f, 0.f};
        const bf16* hrow = H + (size_t)(blk * 64 + tg * 32 + i16) * DM + kq * 512 + 8 * g4;
        const bf16* wh = WRh + (size_t)i16 * DM + kq * 512 + 8 * g4;
#pragma unroll 4
        for (int ks = 0; ks < 16; ++ks) {
            bf16x8 fa[2];
#pragma unroll
            for (int t2 = 0; t2 < 2; ++t2) fa[t2] = *(const bf16x8*)(hrow + (size_t)t2 * 16 * DM + ks * 32);
#pragma unroll
            for (int jt = 0; jt < 5; ++jt) {
                const bf16x8 bh = *(const bf16x8*)(wh + (size_t)jt * 16 * DM + ks * 32);
#pragma unroll
                for (int t2 = 0; t2 < 2; ++t2) acc[t2][jt] = __builtin_amdgcn_mfma_f32_16x16x32_bf16(fa[t2], bh, acc[t2][jt], 0, 0, 0);
            }
        }
#pragma unroll
        for (int t2 = 0; t2 < 2; ++t2)
#pragma unroll
            for (int jt = 0; jt < 5; ++jt)
#pragma unroll
                for (int r = 0; r < 4; ++r) L[(kq * 64 + tg * 32 + t2 * 16 + 4 * g4 + r) * NRTP + jt * 16 + i16] = acc[t2][jt][r];
        __syncthreads();
        if (tid < 64) {
            const int tok = blk * 64 + tid;
            const float* part = (const float*)(ws + WS_SMALL + SM_PART) + (size_t)tok * 32;
            float ss = 0.f;
#pragma unroll
            for (int i = 0; i < 32; ++i) ss += part[i];
            const float rstd = 1.0f / sqrtf(ss * (1.f / DM) + RMS_EPS);
            const LAS float* l0 = L + tid * NRTP;
            const float* brg = a.in[I_B_RG] + layer * 8; const float* bre = a.in[I_B_RE] + layer * 64;
            float gmax = -__builtin_inff(); int gi = 0; float gl[8];
#pragma unroll
            for (int j = 0; j < 8; ++j) { gl[j] = ((l0[j] + l0[64 * NRTP + j]) + (l0[128 * NRTP + j] + l0[192 * NRTP + j])) * rstd + brg[j]; if (gl[j] > gmax) { gmax = gl[j]; gi = j; } }
            float gs = 0.f;
#pragma unroll
            for (int j = 0; j < 8; ++j) gs += expf(gl[j] - gmax);
            const float pg = 1.f / gs;
            float v0 = -__builtin_inff(), v1 = -__builtin_inff(); int i0 = 0, i1 = 0;
#pragma unroll
            for (int j = 0; j < 8; ++j) { const int ix = 8 + gi * 8 + j; const float e = ((l0[ix] + l0[64 * NRTP + ix]) + (l0[128 * NRTP + ix] + l0[192 * NRTP + ix])) * rstd + bre[gi * 8 + j];
                if (e > v0) { v1 = v0; i1 = i0; v0 = e; i0 = j; } else if (e > v1) { v1 = e; i1 = j; } }
            const float dd = expf(v1 - v0), w0 = pg / (1.f + dd), w1 = pg * dd / (1.f + dd);
            const int e0 = gi * 8 + i0, e1 = gi * 8 + i1;
            v4u tr; tr.x = (unsigned)e0; tr.y = (unsigned)e1; tr.z = __float_as_uint(w0); tr.w = __float_as_uint(w1);
            *(v4u*)(ws + WS_SMALL + SM_TOKR + (size_t)tok * 16) = tr;
            ((float*)(ws + WS_SMALL + SM_RSTD))[tok] = rstd;
            __hip_atomic_fetch_add(cnt + e0, 1, __ATOMIC_RELAXED, __HIP_MEMORY_SCOPE_WORKGROUP);
            __hip_atomic_fetch_add(cnt + e1, 1, __ATOMIC_RELAXED, __HIP_MEMORY_SCOPE_WORKGROUP);
        }
        __syncthreads();
        if (tid < 64) ((int*)(ws + WS_SMALL + SM_CNT))[blk * 64 + tid] = cnt[tid];
        __syncthreads();
    }
}

__device__ __forceinline__ void phase_gather(const Args& a, LAS unsigned char* lds, int G, int vb) {
    unsigned char* ws = opaque_ws(a.ws);
    const int tid = opaque_tid(), lane = tid & 63, wave = __builtin_amdgcn_readfirstlane(tid >> 6);
    const int* CNT = (const int*)(ws + WS_SMALL + SM_CNT); int* BLKE = (int*)(ws + WS_SMALL + SM_BLKE); int* DEST = (int*)(ws + WS_SMALL + SM_DEST);
    const unsigned* TOKR = (const unsigned*)(ws + WS_SMALL + SM_TOKR);
    int* ROWTOK = (int*)(ws + WS_SMALL + SM_ROWTOK);
    LAS int* tot = (LAS int*)(lds + RING_OFF); LAS int* pre = tot + 64; LAS int* pst = tot + 128; LAS int* destl = tot + 192;
    LAS int* part8 = tot + 320;
    LAS int* tokl = tot + 320 + 1024;
    for (int blk = vb; blk < T / 64; blk += G) {
        { const int e = tid & 63, p8 = tid >> 6; int t_ = 0, p_ = 0;
#pragma unroll 8
          for (int b2 = p8 * 32; b2 < p8 * 32 + 32; ++b2) { const int c = CNT[b2 * 64 + e]; t_ += c; p_ += (b2 < blk) ? c : 0; }
          part8[(p8 * 64 + e) * 2] = t_; part8[(p8 * 64 + e) * 2 + 1] = p_;
          if (tid < 128) tokl[tid] = (int)TOKR[(size_t)(blk * 64 + (tid >> 1)) * 4 + (tid & 1)]; }
        __syncthreads();
        if (tid < 64) { int t_ = 0, p_ = 0;
#pragma unroll
            for (int p8 = 0; p8 < 8; ++p8) { t_ += part8[(p8 * 64 + tid) * 2]; p_ += part8[(p8 * 64 + tid) * 2 + 1]; }
            tot[tid] = t_; pre[tid] = p_;
            const int padded = ((t_ + 255) >> 8) << 8; int incl = padded;
#pragma unroll
            for (int o = 1; o < 64; o <<= 1) { const int up = __shfl_up(incl, o); if (tid >= o) incl += up; }
            pst[tid] = incl - padded;
            if (blk == 0 && tid == 63) BLKE[MAXRB] = incl >> 8; }
        __syncthreads();
        if (tid < 64) {
            if (blk == 0) { const int rb0 = pst[tid] >> 8, rb1 = (pst[tid] + (((tot[tid] + 255) >> 8) << 8)) >> 8; for (int rb = rb0; rb < rb1; ++rb) BLKE[rb] = tid; }
            int r = pst[tid] + pre[tid];
            for (int as = 0; as < 128; ++as) { if (tokl[as] == tid) destl[as] = r++; }
        }
        __syncthreads();
        if (tid < 128) { const int tok = blk * 64 + (tid >> 1), dest = destl[tid]; DEST[tok * 2 + (tid & 1)] = dest; ROWTOK[dest] = tok; }
        if (blk < 64) {
            const int r0 = pst[blk] + tot[blk], r1 = pst[blk] + (((tot[blk] + 255) >> 8) << 8);
            for (int r = r0 + tid; r < r1; r += 512) ROWTOK[r] = 0;
        }
        __syncthreads();
    }
}

__device__ __forceinline__ void phase_combine(const Args& a, int G, int vb, float* Fout  ) {
    unsigned char* ws = opaque_ws(a.ws);
    const int tid = opaque_tid(), lane = tid & 63, wave = __builtin_amdgcn_readfirstlane(tid >> 6);
    const int gw = vb * 8 + wave, NGW = G * 8;
    const bf16* YS = (const bf16*)(ws + WS_YS); const int* DEST = (const int*)(ws + WS_SMALL + SM_DEST); float* RSTD = (float*)(ws + WS_SMALL + SM_RSTD); bf16* HB = (bf16*)(ws + WS_HB);
    for (int tok = gw; tok < T; tok += NGW) {
        const v4u tr = *(const v4u*)(ws + WS_SMALL + SM_TOKR + (size_t)tok * 16); const float w0 = __uint_as_float(tr.z), w1 = __uint_as_float(tr.w);
        const int d0 = DEST[tok * 2], d1 = DEST[tok * 2 + 1];
        GAS v2u* hr = (GAS v2u*)(HB + (size_t)tok * DM) + lane;
        const GAS v2u* y0 = (const GAS v2u*)(YS + (size_t)d0 * DM) + lane; const GAS v2u* y1 = (const GAS v2u*)(YS + (size_t)d1 * DM) + lane;
        v2u hv[8], a0[8], a1[8];
#pragma unroll
        for (int j = 0; j < 8; ++j) { hv[j] = hr[64 * j]; a0[j] = y0[64 * j]; a1[j] = y1[64 * j]; }
        float ss = 0.f;
#pragma unroll
        for (int j = 0; j < 8; ++j) { f32x4 v;
            v.x = bflo(hv[j].x) + (w0 * bflo(a0[j].x) + w1 * bflo(a1[j].x)); v.y = bfhi(hv[j].x) + (w0 * bfhi(a0[j].x) + w1 * bfhi(a1[j].x));
            v.z = bflo(hv[j].y) + (w0 * bflo(a0[j].y) + w1 * bflo(a1[j].y)); v.w = bfhi(hv[j].y) + (w0 * bfhi(a0[j].y) + w1 * bfhi(a1[j].y));
            ss += (v.x * v.x + v.y * v.y) + (v.z * v.z + v.w * v.w);
            if (Fout) ((GAS f32x4*)(Fout + (size_t)tok * DM) + lane)[64 * j] = v;
            else { v2u o; o.x = pk2(v.x, v.y); o.y = pk2(v.z, v.w); hr[64 * j] = o; } }
        if (!Fout) { const float rstd = 1.0f / sqrtf(wave_sum(ss) * (1.f / DM) + RMS_EPS); if (lane == 0) RSTD[tok] = rstd; }
    }
}

#ifndef MK_DUP
#define MK_DUP -1
#endif
#define DUP(k) (MK_DUP == (k))
#ifndef MK_VAR
#define MK_VAR 0
#endif
#ifndef FP8IN_SP2
#define FP8IN_SP2 true
#endif
constexpr int NPH = 21;
__global__ void __launch_bounds__(512, 2) yoco_fwd(Args args) {
    extern __shared__ __attribute__((aligned(16))) unsigned char lds_raw[];
    LAS unsigned char* lds = (LAS unsigned char*)lds_raw;
    const int tid = opaque_tid();
    const int G = gridDim.x; const int bx0 = blockIdx.x; const int vb = (G % 8 == 0) ? (bx0 % 8) * (G / 8) + bx0 / 8 : bx0;
    unsigned char* ws = args.ws;
    gu32* ctl = (gu32*)(ws + WS_CTL);
    for (int u = tid; u < (LDS_BYTES - LDSCTL_OFF) / 4; u += 512) ((LAS unsigned*)(lds + LDSCTL_OFF))[u] = 0u;
    __syncthreads();
    volatile LAS unsigned* MISC = (volatile LAS unsigned*)(lds + MISC_OFF);
#if MK_N_LAUNCHES == 1
    constexpr int lo = 0, hi = NPH; constexpr bool one = true;
#else
    const int lo = args.ph_lo, hi = args.ph_hi;
    const bool one = (hi - lo) > 1;
#endif
    XcdBarrier bar; bar.bar = (unsigned*)(ctl + CW_BAR); bar.x = 0; bar.st = nullptr;
    if (one) bar = xcd_barrier_post((unsigned*)(ctl + CW_BAR), MISC + 8);
#define GBAR() do { XcdBarrier b2_ = bar; b2_.bar = (unsigned*)opaque_ws((unsigned char*)bar.bar); { unsigned x_ = bar.x; asm volatile("" : "+s"(x_)); b2_.x = x_; } xcd_barrier(b2_); } while (0)
#define IN(k) (lo <= (k) && (k) < hi)
#define SEAM(k) do { if (IN(k) && IN((k) + 1)) GBAR(); } while (0)

#define RUN(k, ...) do { if (IN(k)) { __VA_ARGS__ if (DUP(k)) { __syncthreads(); __VA_ARGS__ } } } while (0)
    RUN(0, phase_prep(args, lds, G, vb););
    SEAM(0);
    for (int l = 0; l < 2; ++l) {
        const int pb = 1 + 10 * l;
        int bx = bx0; asm volatile("" : "+s"(bx));
        RUN(pb + 0,
            if (l == 0) { pg8::Gemm g{(const bf16*)(ws + WS_HB8), (const bf16*)(ws + WS_W_INA), T, PROJW, DM / 2}; pg8::StaticOrder S; S.init(T, PROJW, G, bx);
              EpiHeadNorm E{ws, 0, 1.f / SC_W1};
              pg8::gemm_phase<EpiHeadNorm, pg8::StaticOrder, true, FP8IN_SP2, false, true>(lds + RING_OFF, g, S, E); }
            else { pg8::Gemm g{(const bf16*)(ws + WS_HB), (const bf16*)(ws + WS_W_INB), T, PROJW, DM}; pg8::StaticOrder S; S.init(T, PROJW, G, bx);
              EpiHeadNorm E{ws, 1, 1.f};
              pg8::gemm_phase<EpiHeadNorm, pg8::StaticOrder, true, true>(lds + RING_OFF, g, S, E); }
            );
        if (one) GBAR();
        if (l == 0) { if (IN(pb + 2)) {
                if (bx < 16) { pg8::Gemm g{(const bf16*)(ws + WS_SMALL + SM_MEMN), (const bf16*)(ws + WS_W_MKV), NB * NMEM, 2048, DM}; pg8::StaticOrder S; S.init(NB * NMEM, 2048, G, bx);
                    EpiRowScale E{(bf16*)(ws + WS_SMALL + SM_KVM), 2048, nullptr, 0, 1.f};
                    pg8::gemm_phase<EpiRowScale, pg8::StaticOrder, true, true>(lds + RING_OFF, g, S, E); }
                else phase_gate(args, lds, G - 16, bx - 16); }
            if (one) GBAR(); }
        if (IN(pb + 3)) { if (l == 0) { phase_post_mem(args, lds, G, vb); phase_moba_sparse(args, lds, ctl + CW_Q + 256); if (DUP(40)) { __syncthreads(); phase_moba_sparse(args, lds, ctl + CW_Q + 320); } if (one) GBAR(); phase_attn_a(args, lds, ctl + CW_Q); if (DUP(41)) { __syncthreads(); phase_attn_a(args, lds, ctl + CW_Q + 128); } }
            else { phase_attn_b<0>(args, lds, ctl + CW_Q + 64, (bf16*)(ws + WS_OCAT)); if (DUP(14)) { __syncthreads(); phase_attn_b<MK_VAR>(args, lds, ctl + CW_Q + 192, (bf16*)(ws + WS_YS)); } } }
        SEAM(pb + 3);
        RUN(pb + 4,
            { pg8::Gemm g{(const bf16*)(ws + WS_OCAT), (const bf16*)(ws + WS_W_OUT) + (size_t)l * DM * DM, T, DM, DM}; pg8::StaticOrder S; S.init(T, DM, G, bx);
              if (l == 0) { pg8::Gemm g8{(const bf16*)(ws + WS_OCAT), (const bf16*)(ws + WS_W_OUT), T, DM, DM / 2};
                EpiOutProj<true> E{args.in[I_X], (float*)(ws + WS_SMALL + SM_PART), (bf16*)(ws + WS_HB), ws + WS_HB8, 1.f / (SC_O * SC_W1)}; pg8::gemm_phase<EpiOutProj<true>, pg8::StaticOrder, true, true, false, true>(lds + RING_OFF, g8, S, E); }
              else { EpiOutProj<false> E{nullptr, (float*)(ws + WS_SMALL + SM_PART), (bf16*)(ws + WS_HB), ws + WS_HB8, 1.f}; pg8::gemm_phase<EpiOutProj<false>, pg8::StaticOrder, true, true>(lds + RING_OFF, g, S, E); } });
        SEAM(pb + 4);
        RUN(pb + 5, phase_router(args, lds, G, vb, l););
        SEAM(pb + 5);
        RUN(pb + 6, phase_gather(args, lds, G, vb););
        SEAM(pb + 6);
        RUN(pb + 7,
            { const int* blke = (const int*)(ws + WS_SMALL + SM_BLKE);
              const int* rowtok = (const int*)(ws + WS_SMALL + SM_ROWTOK);
              pg8::Gemm g{(const bf16*)(ws + WS_HB8), (const bf16*)(ws + WS_W_E1 + (size_t)l * NEXP * 1024 * DM), MAXRB * 256, 1024, DM / 2, rowtok};
              MoeOrder S{blke, blke[MAXRB] * 4, 4, G, bx}; EpiSiluMul E{(bf16*)(ws + WS_HID), (const float*)(ws + WS_SMALL + SM_RSTD), rowtok};
              pg8::gemm_phase<EpiSiluMul, MoeOrder, true, true, true, true>(lds + RING_OFF, g, S, E); });
        SEAM(pb + 7);
        RUN(pb + 8,
            { const int* blke = (const int*)(ws + WS_SMALL + SM_BLKE);
              pg8::Gemm g{(const bf16*)(ws + WS_HID), (const bf16*)(ws + WS_W_E2 + (size_t)l * NEXP * DM * EFF), MAXRB * 256, DM, EFF / 2};
              MoeOrder S{blke, blke[MAXRB] * 8, 8, G, bx}; EpiRowScale E{(bf16*)(ws + WS_YS), DM, nullptr, 8, 1.f / (SC_HID * SC_W2)};
              pg8::gemm_phase<EpiRowScale, MoeOrder, true, true, false, true>(lds + RING_OFF, g, S, E); });
        SEAM(pb + 8);
        if (IN(pb + 9)) phase_combine(args, G, vb, l == 0 ? nullptr : args.out);
        if (l == 0) SEAM(pb + 9);
    }
#undef RUN
#undef IN
#undef SEAM
}

extern "C" void kernel_launch(void* const* d_in, const int* in_sizes, int n_in, void* d_out, int out_size, void* d_ws, size_t ws_size, hipStream_t stream) {
    static int grid = 0;
    if (grid == 0) {
        if (n_in != N_IN || out_size != T * DM || ws_size < WS_END) { fprintf(stderr, "kernel_launch: unexpected shapes (n_in %d out %d ws %zu)\n", n_in, out_size, ws_size); grid = -1; return; }
        int dev = 0, cus = 0;
        if (hipGetDevice(&dev) != hipSuccess || hipDeviceGetAttribute(&cus, hipDeviceAttributeMultiprocessorCount, dev) != hipSuccess) { grid = -1; return; }
        if (hipFuncSetAttribute((const void*)yoco_fwd, hipFuncAttributeMaxDynamicSharedMemorySize, LDS_BYTES) != hipSuccess) { fprintf(stderr, "kernel_launch: hipFuncSetAttribute failed\n"); grid = -1; return; }
        int per_cu = 0;
        if (hipOccupancyMaxActiveBlocksPerMultiprocessor(&per_cu, (const void*)yoco_fwd, 512, LDS_BYTES) != hipSuccess || per_cu < 1) fprintf(stderr, "kernel_launch: occupancy query reports %d\n", per_cu);
        (void)hipGetLastError();
        grid = cus;
    }
    if (grid < 0) return;
    (void)hipMemsetAsync((char*)d_ws + WS_CTL, 0, CTL_ZERO_BYTES, stream);
    Args a{};
    for (int i = 0; i < N_IN; ++i) a.in[i] = (const float*)d_in[i];
    a.out = (float*)d_out; a.ws = (unsigned char*)d_ws;
#if MK_N_LAUNCHES == 1
    a.ph_lo = 0; a.ph_hi = NPH;
    hipLaunchKernelGGL(yoco_fwd, dim3(grid), dim3(512), LDS_BYTES, stream, a);
#else
    for (int p = 0; p < NPH; ++p) { if (p == 13) continue; a.ph_lo = p; a.ph_hi = p + 1; hipLaunchKernelGGL(yoco_fwd, dim3(grid), dim3(512), LDS_BYTES, stream, a); }
#endif
}
```

```cpp
#include <hip/hip_runtime.h>
#include <cstdio>
#include <cstdint>

#ifndef MK_N_LAUNCHES
#define MK_N_LAUNCHES 1
#endif
#ifndef MK_CHECK
#define MK_CHECK 0
#endif

constexpr int NB = 2, SEQ = 8192, T = NB * SEQ, DM = 2048, HD = 128;
constexpr int NMEM = 256, MEMH = 4, MEMW = 512, MIXW = 1536, MOBA_H = 12, DIFF_H = 6, DV = 256;
constexpr int NEXP = 64, NGRP = 8, EPG = 8, EFF = 512, NRT = 72, NRTP = 80;
constexpr int PROJW = 5120;
constexpr float RMS_EPS = 1e-6f;
constexpr float LOG2E = 1.4426950408889634f;
constexpr float QSCALE = 0.08838834764831845f * LOG2E;
constexpr float LAM_INIT = 0.35550906759096926f;
constexpr int MAXRB = 192;
constexpr float SC_W1 = 64.f, SC_W2 = 32.f, SC_HID = 8.f, SC_O = 16.f;

constexpr size_t MiB = 1u << 20;
constexpr size_t WS_CTL = 0, CTL_ZERO_BYTES = 1 * MiB;
constexpr size_t WS_W_INA = 1 * MiB;
constexpr size_t WS_W_INB = 21 * MiB;
constexpr size_t WS_W_OUT = 41 * MiB;
constexpr size_t WS_W_MKV = 57 * MiB;
constexpr size_t WS_W_RT  = 65 * MiB;
constexpr size_t WS_W_E1  = 67 * MiB;
constexpr size_t WS_HB8   = 323 * MiB;
constexpr size_t WS_W_E2  = 579 * MiB;
constexpr size_t WS_SMALL = 835 * MiB;
constexpr size_t WS_HB    = 851 * MiB;
constexpr size_t WS_PROJ  = 915 * MiB;
constexpr size_t WS_QH    = 1075 * MiB;
constexpr size_t WS_KH    = 1139 * MiB;
constexpr size_t WS_VH    = 1187 * MiB;
constexpr size_t WS_XS    = WS_PROJ;
constexpr size_t WS_OCAT  = 1235 * MiB;
constexpr size_t WS_HID   = 1299 * MiB;
constexpr size_t WS_YS    = 1347 * MiB;
constexpr size_t WS_HA    = 1539 * MiB;
constexpr size_t WS_H2    = 1667 * MiB;
constexpr size_t WS_LISTF = 1795 * MiB;
constexpr size_t WS_LISTA = 1821 * MiB;
constexpr size_t WS_PM    = 1822 * MiB;
constexpr size_t WS_PO    = WS_PROJ;
constexpr size_t WS_END   = 1827 * MiB;
static_assert(WS_XS + (size_t)MAXRB * 256 * 2048 * 2 <= WS_VH, "XS alias");
constexpr size_t SM_RSTD  = 0;
constexpr size_t SM_PART  = 1 * MiB;
constexpr size_t SM_TOKR  = 3 * MiB;
constexpr size_t SM_DEST  = 4 * MiB;
constexpr size_t SM_CNT   = 5 * MiB;
constexpr size_t SM_BLKE  = 5 * MiB + 128 * 1024;
constexpr size_t SM_KMEAN = 6 * MiB;
constexpr size_t SM_SEL   = 7 * MiB;
constexpr size_t SM_MEMN  = 8 * MiB;
constexpr size_t SM_KVM   = 10 * MiB;
constexpr size_t SM_KM    = 12 * MiB;
constexpr size_t SM_VM    = 13 * MiB;
constexpr size_t SM_GAINTAB = 15 * MiB;
constexpr size_t SM_ROWTOK = 14 * MiB;
constexpr int CW_BAR = 4096;
constexpr int CW_Q = 8192;
constexpr int CW_MC = 16384;

constexpr int RING_OFF = 0, RING_BYTES = 131072;
constexpr int LDSX_OFF = RING_BYTES;
constexpr int LDSCTL_OFF = RING_BYTES + 12288, MISC_OFF = LDSCTL_OFF + 320;
constexpr int LDS_BYTES = 147456;
static_assert(MISC_OFF + 128 <= LDS_BYTES, "LDS map");

#define GAS __attribute__((address_space(1)))
#define LAS __attribute__((address_space(3)))
typedef unsigned short bf16;
typedef unsigned v4u __attribute__((ext_vector_type(4)));
typedef unsigned v2u __attribute__((ext_vector_type(2)));
typedef float f32x4 __attribute__((ext_vector_type(4)));
typedef float f32x16 __attribute__((ext_vector_type(16)));
typedef short bf16x8 __attribute__((ext_vector_type(8)));
typedef short s16x4 __attribute__((ext_vector_type(4)));
typedef GAS unsigned gu32;
#define RLX_AGENT __ATOMIC_RELAXED, __HIP_MEMORY_SCOPE_AGENT
#define LDS_WAIT() asm volatile("s_waitcnt lgkmcnt(0)" ::: "memory")
#define VM_WAIT() asm volatile("s_waitcnt vmcnt(0)" ::: "memory")
__device__ __forceinline__ unsigned f2bf(float f) { unsigned u = __builtin_bit_cast(unsigned, f); return (u + 0x7fffu + ((u >> 16) & 1u)) >> 16; }
__device__ __forceinline__ unsigned pk2(float lo, float hi) { return f2bf(lo) | (f2bf(hi) << 16); }
__device__ __forceinline__ float bf2f(unsigned short b) { return __builtin_bit_cast(float, (unsigned)b << 16); }
__device__ __forceinline__ float bflo(unsigned w) { return __builtin_bit_cast(float, w << 16); }
__device__ __forceinline__ float bfhi(unsigned w) { return __builtin_bit_cast(float, w & 0xffff0000u); }
template <int M> __device__ __forceinline__ float swz_xor(float v) { return __builtin_bit_cast(float, __builtin_amdgcn_ds_swizzle(__builtin_bit_cast(int, v), (M << 10) | 0x1F)); }
__device__ __forceinline__ float add_xor32(float v) {
    auto r = __builtin_amdgcn_permlane32_swap(__float_as_uint(v), __float_as_uint(v), false, false);
    return __uint_as_float(r[0]) + __uint_as_float(r[1]); }
__device__ __forceinline__ float wave_sum(float v) {
    v += swz_xor<1>(v); v += swz_xor<2>(v); v += swz_xor<4>(v); v += swz_xor<8>(v); v += swz_xor<16>(v);
    return add_xor32(v);
}
__device__ const unsigned char T5_BUCKET[128] = {
 0, 1, 2, 3, 4, 5, 6, 7, 8, 9, 10, 11, 12, 13, 14, 15, 16, 16, 16, 17, 17, 18, 18, 18, 19, 19, 19, 20, 20, 20, 20, 21, 21, 21, 21, 22, 22, 22, 22, 22, 23, 23, 23, 23, 23, 23, 24, 24, 24, 24, 24, 24, 25, 25, 25, 25, 25, 25, 25, 26, 26, 26, 26, 26, 26, 26, 26, 27, 27, 27, 27, 27, 27, 27, 27, 27, 27, 28, 28, 28, 28, 28, 28, 28, 28, 28, 28, 29, 29, 29, 29, 29, 29, 29, 29, 29, 29, 29, 29, 30, 30, 30, 30, 30, 30, 30, 30, 30, 30, 30, 30, 30, 30, 31, 31, 31, 31, 31, 31, 31, 31, 31, 31, 31, 31, 31, 31, 31};

__device__ __forceinline__ int opaque_tid() { int t = threadIdx.x; asm volatile("" : "+v"(t)); return t; }

__device__ __forceinline__ unsigned char* opaque_ws(unsigned char* p) { asm volatile("" : "+s"(p)); return p; }
namespace pg8 {
#define PG8_LAS __attribute__((address_space(3)))
typedef unsigned short bf16_t;
typedef short bf16x8 __attribute__((ext_vector_type(8)));
typedef float f32x4 __attribute__((ext_vector_type(4)));
typedef unsigned u32x4 __attribute__((ext_vector_type(4)));
constexpr int BM = 256, BK = 64, HALF = 128, HTB = HALF * BK * 2  , STAGE_BYTES = 8 * HTB, NXCD = 8, WGM = 8;

__host__ __device__ __forceinline__ int lds_byte(int r, int c) { const int st = (r >> 4) * 2 + (c >> 5), rr = r & 15, cc = c & 31, ob = rr * 64 + cc * 2; return st * 1024 + (ob ^ (((ob >> 9) & 1) << 5)); }
__host__ __device__ __forceinline__ void stage_rc(int b, int& R, int& C) { const int st = b / 1024, sb = b % 1024, swz = sb ^ (((sb >> 9) & 1) << 5); R = (st >> 1) * 16 + swz / 64; C = (st & 1) * 32 + (swz % 64) / 2; }
__host__ __device__ __forceinline__ int perm32(int rho) { const int n = rho >> 4, i = rho & 15; return 8 * (i >> 2) + 4 * n + (i & 3); }

struct Unit { int pm, pn; };
struct Gemm { const bf16_t* A; const bf16_t* Bt; int M, N, K; const int* rowtok; };

struct StaticOrder {
    int nM, nN, nwg, G, c;
    __host__ __device__ void init(int M, int N, int G_, int c_) { nM = M / BM; nN = N / BM; nwg = nM * nN; G = G_; c = c_; }
    __host__ __device__ bool next(int i, Unit& u) const {
        const long L = (long)i * G + c; if (L >= nwg) return false;
        int wgid = (int)L; { const int q = nwg / NXCD, r = nwg % NXCD, xcd = wgid % NXCD, off = wgid / NXCD; wgid = (xcd < r ? xcd * (q + 1) : r * (q + 1) + (xcd - r) * q) + off; }
        const int nig = WGM * nN, gid = wgid / nig, fm = gid * WGM, gsz = (nM - fm) < WGM ? (nM - fm) : WGM;
        u.pm = fm + ((wgid % nig) % gsz); u.pn = (wgid % nig) / gsz; return true;
    }
    __device__ __forceinline__ void a_ready(const Unit&) const {}
    __device__ __forceinline__ void done(const Unit&) const {}
};

__device__ __forceinline__ unsigned cvt_pk_bf16(float lo, float hi) { unsigned r; asm volatile("v_cvt_pk_bf16_f32 %0, %1, %2" : "=v"(r) : "v"(lo), "v"(hi)); return r; }
typedef float f32x2 __attribute__((ext_vector_type(2)));
template <class Epi, class Sched, bool ALIGN_EPI = false, bool SP2 = false, bool GATHER = false, bool FP8 = false>
__device__ __forceinline__ void gemm_phase(PG8_LAS unsigned char* lds, const Gemm g, const Sched& S, const Epi& E) {
    const int tid = opaque_tid(), wid = __builtin_amdgcn_readfirstlane(tid >> 6), lane = tid & 63, wr = wid >> 2, wc = wid & 3, fr = lane & 15, fq = lane >> 4;
    const int K = g.K, nt = K / BK;
    unsigned voffA[2], voffB[2]; int RA[2]; unsigned CA2[2];
#pragma unroll
    for (int i = 0; i < 2; ++i) { int R, C; stage_rc(tid * 16 + i * 8192, R, C); const int Rb = Epi::PERM ? ((R & ~31) + perm32(R & 31)) : R;
        voffA[i] = (unsigned)(R * K + C) * 2u; voffB[i] = (unsigned)(Rb * K + C) * 2u; RA[i] = R; CA2[i] = (unsigned)C * 2u; }
    const size_t kstep = (size_t)(BK * 2);
    const size_t hstep = (size_t)HALF * K * 2;
    const size_t tstep = 2 * hstep;
    const unsigned ldsw = (unsigned)wid * 1024u;
    const int aoff = lds_byte(wr * 64 + fr, fq * 8), boff = lds_byte(wc * 32 + fr, fq * 8);
#define PG8_SA(b, h) (((b) * 2 + (h)) * HTB)
#define PG8_SB(b, h) ((4 + (b) * 2 + (h)) * HTB)
#define PG8_STAGE(bufoff, gbase, voff) do { _Pragma("unroll") for (int _i = 0; _i < 2; ++_i) \
        __builtin_amdgcn_global_load_lds((const unsigned*)((const char*)(gbase) + (voff)[_i]), (PG8_LAS unsigned*)(lds + (bufoff) + ldsw + _i * 8192), 16, 0, 0); } while (0)
    unsigned gc[2][2], gn[2][2];
#define PG8_GOFF(dst, pm_) do { _Pragma("unroll") for (int _h = 0; _h < 2; ++_h) _Pragma("unroll") for (int _i = 0; _i < 2; ++_i) \
        dst[_h][_i] = (unsigned)g.rowtok[(pm_) * BM + _h * HALF + RA[_i]] * (unsigned)(K * 2) + CA2[_i]; } while (0)
#define PG8_STAGE_A(bufoff, ptr, half, usenext) do { if constexpr (GATHER) { _Pragma("unroll") for (int _i = 0; _i < 2; ++_i) \
        __builtin_amdgcn_global_load_lds((const unsigned*)((const char*)(ptr) + ((usenext) ? gn[half][_i] : gc[half][_i])), (PG8_LAS unsigned*)(lds + (bufoff) + ldsw + _i * 8192), 16, 0, 0); } \
        else { PG8_STAGE(bufoff, (ptr) + (half) * hstep, voffA); } } while (0)
#define PG8_LDA(dst, b, h) do { if constexpr (FP8) { _Pragma("unroll") for (int m = 0; m < 4; ++m) dst##8[m] = PG8_CAT(*(const PG8_LAS bf16x8*)(lds + PG8_SA(b, h) + aoff + m * 2048), *(const PG8_LAS bf16x8*)(lds + PG8_SA(b, h) + aoff + m * 2048 + 1024)); } \
        else { _Pragma("unroll") for (int m = 0; m < 4; ++m) _Pragma("unroll") for (int k = 0; k < 2; ++k) dst[m][k] = *(const PG8_LAS bf16x8*)(lds + PG8_SA(b, h) + aoff + m * 2048 + k * 1024); } } while (0)
#define PG8_LDB(dst, b, h) do { if constexpr (FP8) { _Pragma("unroll") for (int n = 0; n < 2; ++n) dst##8[n] = PG8_CAT(*(const PG8_LAS bf16x8*)(lds + PG8_SB(b, h) + boff + n * 2048), *(const PG8_LAS bf16x8*)(lds + PG8_SB(b, h) + boff + n * 2048 + 1024)); } \
        else { _Pragma("unroll") for (int n = 0; n < 2; ++n) _Pragma("unroll") for (int k = 0; k < 2; ++k) dst[n][k] = *(const PG8_LAS bf16x8*)(lds + PG8_SB(b, h) + boff + n * 2048 + k * 1024); } } while (0)
typedef int pg8_v8i __attribute__((ext_vector_type(8))); typedef int pg8_v4i __attribute__((ext_vector_type(4)));
#define PG8_CAT(x0, x1) __builtin_shufflevector(__builtin_bit_cast(pg8_v4i, x0), __builtin_bit_cast(pg8_v4i, x1), 0, 1, 2, 3, 4, 5, 6, 7)
#define PG8_MMA(ai, bj, At, Bt) do { __builtin_amdgcn_s_setprio(1); if constexpr (FP8) { _Pragma("unroll") for (int m = 0; m < 4; ++m) _Pragma("unroll") for (int n = 0; n < 2; ++n) \
        asm volatile("v_mfma_scale_f32_16x16x128_f8f6f4 %0, %1, %2, %0, %3, %3 op_sel_hi:[0,0,0]" : "+v"(acc[ai][bj][m][n]) : "v"(Bt##8[n]), "v"(At##8[m]), "v"(pg8_scale1)); } \
        else { _Pragma("unroll") for (int m = 0; m < 4; ++m) _Pragma("unroll") for (int n = 0; n < 2; ++n) _Pragma("unroll") for (int k = 0; k < 2; ++k) \
        acc[ai][bj][m][n] = __builtin_amdgcn_mfma_f32_16x16x32_bf16(Bt[n][k], At[m][k], acc[ai][bj][m][n], 0, 0, 0); } __builtin_amdgcn_s_setprio(0); } while (0)
#define PG8_WAIT_V(n) asm volatile("s_waitcnt vmcnt(" #n ")" ::: "memory")
#define PG8_WAIT_L(n) asm volatile("s_waitcnt lgkmcnt(" #n ")" ::: "memory")
#define PG8_BAR __builtin_amdgcn_s_barrier()
#define PG8_SCHED __builtin_amdgcn_sched_barrier(0)
    Unit cur, nxt; int ui = 0;
    if (!S.next(0, cur)) return;
    f32x4 acc[2][2][4][2];
#pragma unroll
    for (int a = 0; a < 2; ++a)
#pragma unroll
        for (int b = 0; b < 2; ++b)
#pragma unroll
            for (int m = 0; m < 4; ++m)
#pragma unroll
                for (int n = 0; n < 2; ++n) acc[a][b][m][n] = (f32x4){0.f, 0.f, 0.f, 0.f};
    int pg8_scale1 = 0x7F7F7F7F; asm volatile("" : "+v"(pg8_scale1));
    bf16x8 At[4][2], B0[2][2], B1[2][2]; pg8_v8i At8[4], B08[2], B18[2];
    const char* cA = GATHER ? (const char*)g.A : (const char*)g.A + (size_t)cur.pm * tstep; const char* cB = (const char*)g.Bt + (size_t)cur.pn * tstep;
    if constexpr (GATHER) { PG8_GOFF(gc, cur.pm); }
    S.a_ready(cur);
    if constexpr (SP2) {
        PG8_STAGE(PG8_SB(0, 0), cB, voffB); PG8_STAGE(PG8_SB(0, 1), cB + hstep, voffB); PG8_STAGE_A(PG8_SA(0, 0), cA, 0, false); PG8_STAGE_A(PG8_SA(0, 1), cA, 1, false);
        if (wr == 1) PG8_BAR;
        PG8_WAIT_V(2); PG8_BAR;
        PG8_STAGE(PG8_SB(1, 0), cB + kstep, voffB); PG8_STAGE_A(PG8_SA(1, 0), cA + kstep, 0, false); PG8_STAGE(PG8_SB(1, 1), cB + hstep + kstep, voffB);
        PG8_WAIT_V(6); PG8_BAR;
    } else {
        PG8_STAGE(PG8_SB(0, 0), cB, voffB); PG8_STAGE_A(PG8_SA(0, 0), cA, 0, false); PG8_STAGE(PG8_SB(0, 1), cB + hstep, voffB); PG8_STAGE_A(PG8_SA(0, 1), cA, 1, false);
        if (wr == 1) PG8_BAR;
        PG8_WAIT_V(4); PG8_BAR;
        PG8_STAGE(PG8_SB(1, 0), cB + kstep, voffB); PG8_STAGE_A(PG8_SA(1, 0), cA + kstep, 0, false); PG8_STAGE(PG8_SB(1, 1), cB + hstep + kstep, voffB);
        PG8_WAIT_V(6); PG8_BAR;
    }
    for (;;) {
        const bool has_next = S.next(ui + 1, nxt);
        const char* nA = GATHER ? (const char*)g.A : (has_next ? (const char*)g.A + (size_t)nxt.pm * tstep : cA);
        if constexpr (GATHER) { if (has_next) { PG8_GOFF(gn, nxt.pm); } else { _Pragma("unroll") for (int _h = 0; _h < 2; ++_h) _Pragma("unroll") for (int _i = 0; _i < 2; ++_i) gn[_h][_i] = gc[_h][_i]; } } const char* nB = has_next ? (const char*)g.Bt + (size_t)nxt.pn * tstep : cB;
#pragma nounroll
        for (int t = 0; t < nt; t += 2) {
            const bool last = (t == nt - 2);
            const char* a1 = cA + (size_t)(t + 1) * kstep;
            const char* a2 = last ? nA : cA + (size_t)(t + 2) * kstep; const char* b2 = last ? nB : cB + (size_t)(t + 2) * kstep;
            const char* a3 = a2 + kstep; const char* b3 = b2 + kstep;
            if (last && has_next) S.a_ready(nxt);
            if constexpr (SP2) {
            PG8_LDB(B0, 0, 0); PG8_LDB(B1, 0, 1); PG8_SCHED; PG8_LDA(At, 0, 0); PG8_STAGE_A(PG8_SA(1, 1), a1, 1, false);
            PG8_WAIT_V(8); PG8_WAIT_L(0); PG8_BAR; PG8_MMA(0, 0, At, B0); PG8_MMA(0, 1, At, B1); PG8_BAR; PG8_SCHED;
            PG8_LDA(At, 0, 1); PG8_STAGE(PG8_SB(0, 0), b2, voffB); PG8_STAGE(PG8_SB(0, 1), b2 + hstep, voffB); PG8_STAGE_A(PG8_SA(0, 0), a2, 0, last);
            PG8_WAIT_V(8); PG8_WAIT_L(0); PG8_BAR; PG8_MMA(1, 0, At, B0); PG8_MMA(1, 1, At, B1); PG8_BAR; PG8_SCHED;
            PG8_LDB(B0, 1, 0); PG8_LDB(B1, 1, 1); PG8_SCHED; PG8_LDA(At, 1, 0); PG8_STAGE_A(PG8_SA(0, 1), a2, 1, last);
            PG8_WAIT_V(8); PG8_WAIT_L(0); PG8_BAR; PG8_MMA(0, 0, At, B0); PG8_MMA(0, 1, At, B1); PG8_BAR; PG8_SCHED;
            PG8_LDA(At, 1, 1); PG8_STAGE(PG8_SB(1, 0), b3, voffB); PG8_STAGE(PG8_SB(1, 1), b3 + hstep, voffB); PG8_STAGE_A(PG8_SA(1, 0), a3, 0, last);
            PG8_WAIT_V(8); PG8_WAIT_L(0); PG8_BAR; PG8_MMA(1, 0, At, B0); PG8_MMA(1, 1, At, B1); PG8_BAR; PG8_SCHED;
            } else {
            PG8_LDB(B0, 0, 0); PG8_SCHED; PG8_LDA(At, 0, 0); PG8_STAGE_A(PG8_SA(1, 1), a1, 1, false);
            PG8_WAIT_L(8); PG8_BAR; PG8_WAIT_L(0); PG8_MMA(0, 0, At, B0); PG8_BAR; PG8_SCHED;
            PG8_LDB(B1, 0, 1); PG8_STAGE(PG8_SB(0, 0), b2, voffB);
            PG8_BAR; PG8_WAIT_L(0); PG8_MMA(0, 1, At, B1); PG8_BAR;
            PG8_LDA(At, 0, 1); PG8_STAGE_A(PG8_SA(0, 0), a2, 0, last);
            PG8_BAR; PG8_WAIT_L(0); PG8_MMA(1, 0, At, B0); PG8_BAR; PG8_SCHED;
            PG8_STAGE(PG8_SB(0, 1), b2 + hstep, voffB);
            PG8_WAIT_V(6); PG8_BAR; PG8_MMA(1, 1, At, B1); PG8_BAR;
            PG8_LDB(B0, 1, 0); PG8_SCHED; PG8_LDA(At, 1, 0); PG8_STAGE_A(PG8_SA(0, 1), a2, 1, last);
            PG8_WAIT_L(8); PG8_BAR; PG8_WAIT_L(0); PG8_MMA(0, 0, At, B0); PG8_BAR; PG8_SCHED;
            PG8_LDB(B1, 1, 1); PG8_STAGE(PG8_SB(1, 0), b3, voffB);
            PG8_BAR; PG8_WAIT_L(0); PG8_MMA(0, 1, At, B1); PG8_BAR;
            PG8_LDA(At, 1, 1); PG8_STAGE_A(PG8_SA(1, 0), a3, 0, last);
            PG8_BAR; PG8_WAIT_L(0); PG8_MMA(1, 0, At, B0); PG8_BAR; PG8_SCHED;
            PG8_STAGE(PG8_SB(1, 1), b3 + hstep, voffB);
            PG8_WAIT_V(6); PG8_BAR; PG8_MMA(1, 1, At, B1); PG8_BAR;
            }
        }
        if constexpr (FP8) asm volatile("s_nop 15\n\ts_nop 15" ::: "memory");
        if constexpr (ALIGN_EPI) { if (wr == 0) PG8_BAR; }
        if constexpr (!Epi::AFTER_DRAIN) { E(acc, cur, wr, wc, fr, fq); S.done(cur); }
        if (!has_next) break;
#pragma unroll
        for (int a = 0; a < 2; ++a)
#pragma unroll
            for (int b = 0; b < 2; ++b)
#pragma unroll
                for (int m = 0; m < 4; ++m)
#pragma unroll
                    for (int n = 0; n < 2; ++n) acc[a][b][m][n] = (f32x4){0.f, 0.f, 0.f, 0.f};
        cur = nxt; cA = nA; cB = nB; ++ui;
        if constexpr (GATHER) { _Pragma("unroll") for (int _h = 0; _h < 2; ++_h) _Pragma("unroll") for (int _i = 0; _i < 2; ++_i) gc[_h][_i] = gn[_h][_i]; }
        if constexpr (ALIGN_EPI) { if (wr == 1) PG8_BAR; }
    }
    PG8_WAIT_V(0);
    if constexpr (!ALIGN_EPI) { if (wr == 0) PG8_BAR; }
    PG8_BAR;
    if constexpr (Epi::AFTER_DRAIN) { E.fused(acc, cur, wr, wc, fr, fq, lds, wid, lane); S.done(cur); }
#undef PG8_SA
#undef PG8_SB
#undef PG8_STAGE
#undef PG8_STAGE_A
#undef PG8_GOFF
#undef PG8_LDA
#undef PG8_LDB
#undef PG8_MMA
#undef PG8_CAT
#undef PG8_WAIT_V
#undef PG8_WAIT_L
#undef PG8_BAR
#undef PG8_SCHED
}
}
#define XB_TMO      128
#define XB_XCNT(j)  (256  + 64 * (j))
#define XB_XSUB(j)  (1280 + 64 * (j))
#define XB_XGEN(j)  (2304 + 64 * (j))
#define XB_TOP      3328
#define XB_TOPGEN   3392
#define XCD_BAR_WORDS 3456
#define XB_SPIN_CAP (1u << 18)

__device__ __forceinline__ unsigned xb_ld(unsigned* p)              { return __hip_atomic_load(p, __ATOMIC_RELAXED, __HIP_MEMORY_SCOPE_AGENT); }
__device__ __forceinline__ unsigned xb_add(unsigned* p, unsigned v) { return __hip_atomic_fetch_add(p, v, __ATOMIC_RELAXED, __HIP_MEMORY_SCOPE_AGENT); }
__device__ __forceinline__ unsigned xb_xcc_id() { return (unsigned)__builtin_amdgcn_s_getreg((3 << 11) | 20) & 0xFu; }
#define XB_SPIN(cond, bar) do { unsigned _sp = 0; while (cond) { __builtin_amdgcn_s_sleep(1); \
    if ((++_sp & 255u) == 0u) { if (xb_ld(&(bar)[XB_TMO])) break; if (_sp > XB_SPIN_CAP) { atomicAdd(&(bar)[XB_TMO], 1u); break; } } } } while (0)

struct XcdBarrier {
    unsigned* bar; unsigned x;
    volatile LAS unsigned* st;
};

__device__ __forceinline__ XcdBarrier xcd_barrier_post(unsigned* bar, volatile LAS unsigned* st) {
    XcdBarrier b; b.bar = bar; b.x = xb_xcc_id(); b.st = st;
    if (threadIdx.x == 0) (void)xb_add(&bar[XB_XCNT(b.x)], 1u);
    return b;
}
__device__ __forceinline__ void xcd_barrier_complete(unsigned* bar, unsigned x, unsigned& nloc, unsigned& nx) {
    const unsigned G = gridDim.x * gridDim.y * gridDim.z;
    unsigned sum, cnt, mine, sp = 0u;
    for (;;) {
        sum = 0u; cnt = 0u; mine = 0u;
#pragma unroll
        for (unsigned j = 0; j < 16; ++j) { const unsigned c = xb_ld(&bar[XB_XCNT(j)]); sum += c; cnt += (c > 0u) ? 1u : 0u; mine = (j == x) ? c : mine; }
        if (sum == G) break;
        __builtin_amdgcn_s_sleep(1);
        if ((++sp & 255u) == 0u) { if (xb_ld(&bar[XB_TMO])) break; if (sp > XB_SPIN_CAP) { atomicAdd(&bar[XB_TMO], 1u); break; } }
    }
    nloc = mine > 0u ? mine : 1u; nx = cnt > 0u ? cnt : 1u;
}

__device__ __forceinline__ void xcd_barrier(const XcdBarrier& b) {
    asm volatile("s_waitcnt vmcnt(0)" ::: "memory");
    __syncthreads();
    if (threadIdx.x == 0) {
        unsigned* bar = b.bar;
        __builtin_amdgcn_s_waitcnt(0);
        unsigned nloc = b.st[0], nx = b.st[1];
        if (nloc == 0u) { xcd_barrier_complete(bar, b.x, nloc, nx); b.st[0] = nloc; b.st[1] = nx; }
        const unsigned old = xb_add(&bar[XB_XSUB(b.x)], 1u);
        const unsigned gen = old / nloc;
        if (old + 1u == (gen + 1u) * nloc) {
            __builtin_amdgcn_fence(__ATOMIC_RELEASE, "agent");
            asm volatile("s_waitcnt vmcnt(0)" ::: "memory");
            const unsigned og = xb_add(&bar[XB_TOP], 1u);
            const unsigned tg = og / nx;
            if (og + 1u == (tg + 1u) * nx) xb_add(&bar[XB_TOPGEN], 1u);
            else XB_SPIN(xb_ld(&bar[XB_TOPGEN]) == tg, bar);
            __builtin_amdgcn_fence(__ATOMIC_ACQUIRE, "agent");
            xb_add(&bar[XB_XGEN(b.x)], 1u);
            asm volatile("s_waitcnt vmcnt(0)" ::: "memory");
        } else {
            XB_SPIN(xb_ld(&bar[XB_XGEN(b.x)]) == gen, bar);
            __builtin_amdgcn_fence(__ATOMIC_ACQUIRE, "agent");
            asm volatile("s_waitcnt vmcnt(0)" ::: "memory");
        }
    }
    __syncthreads();
}

enum InIdx { I_X = 0, I_MEM, I_RELB, I_ATTN_G, I_FFN_G, I_MEM_G, I_W_MKV, I_QN_MEM, I_KN_MEM, I_W_OUT, I_W_INA, I_QN_A, I_KN_A, I_KV_G, I_W_KVB, I_KN_B, I_W_INB, I_QN_B,
             I_LAMBDA, I_SUBLN, I_W_RG, I_B_RG, I_W_RE, I_B_RE, I_W_GATE, I_W_UP, I_W_DOWN, N_IN };
struct Args { const float* in[N_IN]; float* out; unsigned char* ws; int ph_lo, ph_hi; };
static_assert(sizeof(Args) == N_IN * 8 + 8 + 8 + 8, "Args has no padding");

using pg8::cvt_pk_bf16;
struct EpiRowScale {
    static constexpr bool PERM = true, AFTER_DRAIN = false;
    bf16* O; int ldc; const float* rs; int ntn; float cs;
    __device__ __forceinline__ void operator()(const f32x4 (&acc)[2][2][4][2], const pg8::Unit& u, int wr, int wc, int fr, int fq) const {
        const int colt = ntn ? (u.pn % ntn) : u.pn;
        const int row0 = u.pm * 256 + wr * 64 + fr, col0 = colt * 256 + wc * 32 + 8 * fq;
#pragma unroll
        for (int ai = 0; ai < 2; ++ai)
#pragma unroll
            for (int m = 0; m < 4; ++m) { const int row = row0 + ai * 128 + m * 16; const float s = (rs ? rs[row] : 1.f) * cs; bf16* rowp = O + (size_t)row * ldc + col0;
#pragma unroll
                for (int bj = 0; bj < 2; ++bj) { const f32x4 v0 = acc[ai][bj][m][0] * s, v1 = acc[ai][bj][m][1] * s;
                    v4u w; w.x = cvt_pk_bf16(v0[0], v0[1]); w.y = cvt_pk_bf16(v0[2], v0[3]); w.z = cvt_pk_bf16(v1[0], v1[1]); w.w = cvt_pk_bf16(v1[2], v1[3]);
                    *(v4u*)(rowp + bj * 128) = w; } }
    }
};
template <bool RES_F32>
struct EpiOutProj {
    static constexpr bool PERM = false, AFTER_DRAIN = false;
    const float* resid; float* part; bf16* HB; unsigned char* HB8; float cs;
    __device__ __forceinline__ void operator()(const f32x4 (&acc)[2][2][4][2], const pg8::Unit& u, int wr, int wc, int fr, int fq) const {
        const int row0 = u.pm * 256 + wr * 64 + fr, col0 = u.pn * 256 + wc * 32 + 4 * fq;
#pragma unroll
        for (int ai = 0; ai < 2; ++ai)
#pragma unroll
            for (int m = 0; m < 4; ++m) { const int row = row0 + ai * 128 + m * 16; const size_t off = (size_t)row * DM + col0; float ss = 0.f;
#pragma unroll
                for (int bj = 0; bj < 2; ++bj)
#pragma unroll
                    for (int n = 0; n < 2; ++n) { f32x4 r4;
                        if (RES_F32) r4 = *(const f32x4*)(resid + off + bj * 128 + n * 16);
                        else { const v2u rb = *(const v2u*)(HB + off + bj * 128 + n * 16); r4 = (f32x4){bflo(rb.x), bfhi(rb.x), bflo(rb.y), bfhi(rb.y)}; }
                        const f32x4 v = r4 + acc[ai][bj][m][n] * cs;
                        ss += (v[0] * v[0] + v[1] * v[1]) + (v[2] * v[2] + v[3] * v[3]);
                        v2u hb; hb.x = cvt_pk_bf16(v[0], v[1]); hb.y = cvt_pk_bf16(v[2], v[3]); *(v2u*)(HB + off + bj * 128 + n * 16) = hb;
                        unsigned w8 = 0u; w8 = __builtin_amdgcn_cvt_pk_fp8_f32(v[0], v[1], w8, false); w8 = __builtin_amdgcn_cvt_pk_fp8_f32(v[2], v[3], w8, true); *(unsigned*)(HB8 + off + bj * 128 + n * 16) = w8; }
                ss += swz_xor<16>(ss); ss = add_xor32(ss);
                if (fq == 0) part[(size_t)row * 32 + u.pn * 4 + wc] = ss; }
    }
};
struct EpiSiluMul {
    static constexpr bool PERM = true, AFTER_DRAIN = false;
    bf16* O; const float* rstd; const int* rowtok;
    __device__ __forceinline__ void operator()(const f32x4 (&acc)[2][2][4][2], const pg8::Unit& u, int wr, int wc, int fr, int fq) const {
        const int row0 = u.pm * 256 + wr * 64 + fr, col0 = (u.pn & 3) * 128 + wc * 32 + 8 * fq;
#pragma unroll
        for (int ai = 0; ai < 2; ++ai)
#pragma unroll
            for (int m = 0; m < 4; ++m) { const int row = row0 + ai * 128 + m * 16; float h[8]; const float rs = rstd[rowtok[row]] * (1.f / SC_W1);
#pragma unroll
                for (int n = 0; n < 2; ++n)
#pragma unroll
                    for (int e = 0; e < 4; ++e) { const float g = acc[ai][0][m][n][e] * rs, up = acc[ai][1][m][n][e] * (rs * SC_HID);
                        h[n * 4 + e] = g * up * __builtin_amdgcn_rcpf(1.f + __builtin_amdgcn_exp2f(-g * LOG2E)); }
                unsigned w0 = 0u, w1 = 0u; w0 = __builtin_amdgcn_cvt_pk_fp8_f32(h[0], h[1], w0, false); w0 = __builtin_amdgcn_cvt_pk_fp8_f32(h[2], h[3], w0, true);
                w1 = __builtin_amdgcn_cvt_pk_fp8_f32(h[4], h[5], w1, false); w1 = __builtin_amdgcn_cvt_pk_fp8_f32(h[6], h[7], w1, true);
                *(v2u*)((unsigned char*)O + (size_t)row * EFF + col0) = (v2u){w0, w1}; }
    }
};
struct MoeOrder {
    const int* blk_e; int nunits, ntn, G, c;
    __device__ __forceinline__ bool next(int i, pg8::Unit& u) const {
        const int L = i * G + c; if (L >= nunits) return false;
        const int rb = L / ntn; u.pm = rb; u.pn = blk_e[rb] * ntn + (L - rb * ntn); return true;
    }
    __device__ __forceinline__ void a_ready(const pg8::Unit&) const {}
    __device__ __forceinline__ void done(const pg8::Unit&) const {}
};

struct TrDesc { const float* src; int N; bf16* dst; int dstK; const float* gain; float f8; };
__device__ __forceinline__ TrDesc tr_decode(const Args& a, int r) {
    unsigned char* ws = opaque_ws(a.ws); TrDesc d; d.f8 = 0.f;
    constexpr int R0 = 2560, R1 = 1024, R2 = 1536, R3 = 2048, R4 = 1024, R5 = 32768, R6 = 32768;
    if (r < R0) { const int kb = r / 160, nb = r % 160; d.src = a.in[I_W_INA] + (size_t)(128 * kb) * 5120 + 32 * nb; d.N = 5120; d.dst = (bf16*)(ws + WS_W_INA + (size_t)(32 * nb) * DM + 128 * kb); d.dstK = DM; d.gain = a.in[I_ATTN_G] + 128 * kb; d.f8 = SC_W1; return d; } r -= R0;
    if (r < R1) { const int kb = r / 64, nb = r % 64; d.src = a.in[I_W_INB] + (size_t)(128 * kb) * 2048 + 32 * nb; d.N = 2048; d.dst = (bf16*)(ws + WS_W_INB + (size_t)(32 * nb) * DM + 128 * kb); d.dstK = DM; d.gain = a.in[I_ATTN_G] + DM + 128 * kb; d.f8 = SC_W1; return d; } r -= R1;
    if (r < R2) { const int kb = r / 96, nb = r % 96; d.src = a.in[I_W_KVB] + (size_t)(128 * kb) * 3072 + 32 * nb; d.N = 3072; d.dst = (bf16*)(ws + WS_W_INB + (size_t)(2048 + 32 * nb) * DM + 128 * kb); d.dstK = DM; d.gain = a.in[I_KV_G] + 128 * kb; d.f8 = SC_W1; return d; } r -= R2;
    if (r < R3) { const int l = r / 1024, rr = r % 1024, kb = rr / 64, nb = rr % 64; d.src = a.in[I_W_OUT] + (size_t)l * DM * DM + (size_t)(128 * kb) * 2048 + 32 * nb; d.N = 2048;
        if (l == 0) { d.dst = (bf16*)(ws + WS_W_OUT + (size_t)(32 * nb) * DM + 128 * kb); d.f8 = SC_W1; }
        else d.dst = (bf16*)(ws + WS_W_OUT) + (size_t)l * DM * DM + (size_t)(32 * nb) * DM + 128 * kb;
        d.dstK = DM; d.gain = nullptr; return d; } r -= R3;
    if (r < R4) { const int l = r / 512, rr = r % 512, kb = rr / 32, nb = rr % 32; d.src = a.in[I_W_MKV] + (size_t)l * DM * 1024 + (size_t)(128 * kb) * 1024 + 32 * nb; d.N = 1024;
        d.dst = (bf16*)(ws + WS_W_MKV) + (size_t)l * 1024 * DM + (size_t)(32 * nb) * DM + 128 * kb; d.dstK = DM; d.gain = a.in[I_MEM_G] + l * DM + 128 * kb; return d; } r -= R4;
    if (r < R5 + R6) { const int up = r >= R5 ? 1 : 0; if (up) r -= R5;
        const int le = r / 256, rr = r % 256, kb = rr / 16, nb = rr % 16, n0 = 32 * nb, drow = (n0 >> 7) * 256 + (n0 & 127) + up * 128;
        d.src = (up ? a.in[I_W_UP] : a.in[I_W_GATE]) + (size_t)le * DM * EFF + (size_t)(128 * kb) * EFF + n0; d.N = EFF;
        d.dst = (bf16*)(ws + WS_W_E1 + ((size_t)le * 1024 + drow) * DM + 128 * kb); d.dstK = DM; d.gain = a.in[I_FFN_G] + (le >> 6) * DM + 128 * kb; d.f8 = SC_W1; return d; } r -= R5 + R6;
    { const int le = r / 256, rr = r % 256, kb = rr / 64, nb = rr % 64; d.src = a.in[I_W_DOWN] + (size_t)le * EFF * DM + (size_t)(128 * kb) * DM + 32 * nb; d.N = DM;
        d.dst = (bf16*)(ws + WS_W_E2 + ((size_t)le * DM + 32 * nb) * EFF + 128 * kb); d.dstK = EFF; d.gain = nullptr; d.f8 = SC_W2; return d; }
}
__device__ __forceinline__ float row_to_fp8(const float* xrow, unsigned char* orow, int lane) {
    const GAS f32x4* xr = (const GAS f32x4*)xrow + lane;
    f32x4 v[8]; float s = 0.f;
#pragma unroll
    for (int j = 0; j < 8; ++j) { v[j] = xr[64 * j]; s += (v[j].x * v[j].x + v[j].y * v[j].y) + (v[j].z * v[j].z + v[j].w * v[j].w); }
    const float rstd = 1.0f / sqrtf(wave_sum(s) * (1.f / DM) + RMS_EPS);
    GAS unsigned* o4 = (GAS unsigned*)orow + lane;
#pragma unroll
    for (int j = 0; j < 8; ++j) { unsigned w = 0u; w = __builtin_amdgcn_cvt_pk_fp8_f32(v[j].x, v[j].y, w, false); w = __builtin_amdgcn_cvt_pk_fp8_f32(v[j].z, v[j].w, w, true); o4[64 * j] = w; }
    return rstd;
}
__device__ __forceinline__ float row_to_bf16(const float* xrow, bf16* orow, bool normalise, int lane) {
    const GAS f32x4* xr = (const GAS f32x4*)xrow + lane;
    f32x4 v[8]; float s = 0.f;
#pragma unroll
    for (int j = 0; j < 8; ++j) { v[j] = xr[64 * j]; s += (v[j].x * v[j].x + v[j].y * v[j].y) + (v[j].z * v[j].z + v[j].w * v[j].w); }
    const float rstd = 1.0f / sqrtf(wave_sum(s) * (1.f / DM) + RMS_EPS);
    const float f = normalise ? rstd : 1.f;
    GAS unsigned long long* o8 = (GAS unsigned long long*)orow + lane;
#pragma unroll
    for (int j = 0; j < 8; ++j) o8[64 * j] = (unsigned long long)pk2(v[j].x * f, v[j].y * f) | ((unsigned long long)pk2(v[j].z * f, v[j].w * f) << 32);
    return rstd;
}
#define TR_IDX(i) (layer < 0 ? (i) : 8192 + ((i) / 16384) * 32768 + layer * 16384 + ((i) % 16384))
__device__ __forceinline__ void tr_loop(const Args& a, LAS float* scr, int lane, int it, int end, int stride, int layer) {
    const int first0 = it < end ? it : 0;
    {
        float v[64];
        const int lr = lane >> 5, lc = lane & 31;
        TrDesc cur = tr_decode(a, TR_IDX(it < end ? it : first0));
        if (it < end) {
#pragma unroll
            for (int i = 0; i < 64; ++i) v[i] = __builtin_nontemporal_load(cur.src + (size_t)(2 * i + lr) * cur.N + lc);
        }
        for (; it < end; it += stride) {
#pragma unroll
            for (int i = 0; i < 64; ++i) scr[(2 * i + lr) * 33 + lc] = v[i];
            LDS_WAIT(); asm volatile("" ::: "memory");
            const int nx = it + stride; const bool has_next = nx < end;
            const TrDesc nd = tr_decode(a, TR_IDX(has_next ? nx : it));
            if (has_next) {
#pragma unroll
                for (int i = 0; i < 64; ++i) v[i] = __builtin_nontemporal_load(nd.src + (size_t)(2 * i + lr) * nd.N + lc);
            }
            if (cur.f8 != 0.f) {
                const int c = lane & 7, nq = lane >> 3; const float f = cur.f8;
                f32x4 g[4];
#pragma unroll
                for (int q = 0; q < 4; ++q) g[q] = cur.gain ? *(const f32x4*)(cur.gain + 16 * c + 4 * q) * f : (f32x4){f, f, f, f};
#pragma unroll
                for (int j = 0; j < 4; ++j) { const int n = nq + 8 * j; const LAS float* sp = scr + (16 * c) * 33 + n; v4u o;
#pragma unroll
                    for (int q = 0; q < 4; ++q) { unsigned w = 0u;
                        w = __builtin_amdgcn_cvt_pk_fp8_f32(sp[(4 * q + 0) * 33] * g[q][0], sp[(4 * q + 1) * 33] * g[q][1], w, false);
                        w = __builtin_amdgcn_cvt_pk_fp8_f32(sp[(4 * q + 2) * 33] * g[q][2], sp[(4 * q + 3) * 33] * g[q][3], w, true); o[q] = w; }
                    *(GAS v4u*)((unsigned char*)cur.dst + (size_t)n * cur.dstK + 16 * c) = o; }
            } else {
                const int c = lane & 15, nq = lane >> 4;
                f32x4 g0 = (f32x4){1.f, 1.f, 1.f, 1.f}, g1 = g0;
                if (cur.gain) { g0 = *(const f32x4*)(cur.gain + 8 * c); g1 = *(const f32x4*)(cur.gain + 8 * c + 4); }
#pragma unroll
                for (int j = 0; j < 8; ++j) { const int n = nq + 4 * j; const LAS float* sp = scr + (8 * c) * 33 + n;
                    v4u o; o.x = pk2(sp[0 * 33] * g0[0], sp[1 * 33] * g0[1]); o.y = pk2(sp[2 * 33] * g0[2], sp[3 * 33] * g0[3]); o.z = pk2(sp[4 * 33] * g1[0], sp[5 * 33] * g1[1]); o.w = pk2(sp[6 * 33] * g1[2], sp[7 * 33] * g1[3]);
                    *(GAS v4u*)(cur.dst + (size_t)n * cur.dstK + 8 * c) = o; }
            }
            LDS_WAIT(); asm volatile("" ::: "memory");
            cur = nd;
        }
    }
}
#undef TR_IDX
constexpr int EXP_ITEMS = 49152, CONV_CH = 48, CONV_NCH = EXP_ITEMS / CONV_CH;
__device__ __forceinline__ void conv_chunk(const Args& a, LAS unsigned char* lds, int layer, int c) {
    const int tid = opaque_tid(), lane = tid & 63, wave = __builtin_amdgcn_readfirstlane(tid >> 6);
    tr_loop(a, (LAS float*)(lds + RING_OFF + wave * 16896), lane, c * CONV_CH + wave, (c + 1) * CONV_CH, 8, layer);
    __syncthreads();
}
struct Mix { bool conv; int idx; };
__device__ __forceinline__ Mix mix_decode(int u, int NA, int NC) {
    const long U = NA + NC; const int cb = (int)(((long)u * NC) / U), cb1 = (int)(((long)(u + 1) * NC) / U);
    Mix m; m.conv = cb1 != cb; m.idx = m.conv ? cb : u - cb; return m;
}
__device__ __forceinline__ void phase_prep(const Args& a, LAS unsigned char* lds, int G, int vb) {
    const int tid = opaque_tid(), lane = tid & 63, wave = __builtin_amdgcn_readfirstlane(tid >> 6);
    unsigned char* ws = opaque_ws(a.ws);
    LAS float* scr = (LAS float*)(lds + RING_OFF + wave * 16896);
    const int gw = vb * 8 + wave, NGW = G * 8;
    tr_loop(a, scr, lane, gw, 8192, NGW, -1);
    for (int idx = vb * 512 + tid; idx < 2 * NRTP * DM; idx += G * 512) {
        const int l = idx / (NRTP * DM), j = (idx / DM) % NRTP, k = idx % DM;
        float v = 0.f;
        if (j < 8) v = a.in[I_W_RG][((size_t)l * DM + k) * 8 + j]; else if (j < NRT) v = a.in[I_W_RE][((size_t)l * DM + k) * 64 + (j - 8)];
        v *= a.in[I_FFN_G][l * DM + k];
        const unsigned hi = f2bf(v); const float lo = v - bf2f((unsigned short)hi);
        bf16* wr = (bf16*)(ws + WS_W_RT) + (size_t)l * 2 * NRTP * DM;
        wr[(size_t)j * DM + k] = (bf16)hi; wr[(size_t)(NRTP + j) * DM + k] = (bf16)f2bf(lo);
    }
    for (int idx = vb * 512 + tid; idx < 2 * 5 * HD; idx += G * 512) { const int l = idx / (5 * HD), w = (idx / HD) % 5, i = idx % HD; float v;
        if (l == 0) v = (w < 2) ? a.in[I_QN_A][i] : (w == 2) ? a.in[I_QN_MEM][i] : a.in[I_KN_A][i];
        else v = (w == 0) ? a.in[I_QN_B][i] : (w == 1) ? a.in[I_QN_B][HD + i] : (w == 2) ? a.in[I_QN_MEM][HD + i] : (w == 3) ? a.in[I_KN_B][i] : a.in[I_KN_B][HD + i];
        ((float*)(ws + WS_SMALL + SM_GAINTAB))[idx] = v; }
    float* rstd = (float*)(ws + WS_SMALL + SM_RSTD);
    for (int m = gw; m < T; m += NGW) { const float rs = row_to_fp8(a.in[I_X] + (size_t)m * DM, ws + WS_HB8 + (size_t)m * DM, lane); if (lane == 0) rstd[m] = rs; }
    for (int m = gw; m < NB * NMEM; m += NGW) (void)row_to_bf16(a.in[I_MEM] + (size_t)m * DM, (bf16*)(ws + WS_SMALL + SM_MEMN) + (size_t)m * DM, true, lane);
}

struct PostDesc { const bf16* src; int sp; bf16* dst; int dp; const float* gain; float scale; float* kmean; };
__device__ __forceinline__ void post_unit(const PostDesc& d, LAS unsigned char* lds) {
    const int tid = opaque_tid(), lane = tid & 63, wave = __builtin_amdgcn_readfirstlane(tid >> 6), c = lane & 15, rg = lane >> 4;
    float g8[8]; float cs[8];
#pragma unroll
    for (int i = 0; i < 8; ++i) { g8[i] = d.gain ? d.gain[8 * c + i] * d.scale : 1.f; cs[i] = 0.f; }
    v4u wv[8];
#pragma unroll
    for (int it = 0; it < 8; ++it) wv[it] = *(const v4u*)(d.src + (size_t)(wave * 32 + it * 4 + rg) * d.sp + 8 * c);
#pragma unroll
    for (int it = 0; it < 8; ++it) {
        const int row = wave * 32 + it * 4 + rg;
        const v4u w = wv[it];
        float f[8] = {bflo(w.x), bfhi(w.x), bflo(w.y), bfhi(w.y), bflo(w.z), bfhi(w.z), bflo(w.w), bfhi(w.w)};
        if (d.gain) {
            float ss = 0.f;
#pragma unroll
            for (int i = 0; i < 8; ++i) ss += f[i] * f[i];
            ss += swz_xor<1>(ss); ss += swz_xor<2>(ss); ss += swz_xor<4>(ss); ss += swz_xor<8>(ss);
            const float rstd = 1.0f / sqrtf(ss * (1.f / HD) + RMS_EPS);
#pragma unroll
            for (int i = 0; i < 8; ++i) { f[i] = f[i] * rstd * g8[i]; cs[i] += f[i]; }
        }
        v4u o; o.x = pk2(f[0], f[1]); o.y = pk2(f[2], f[3]); o.z = pk2(f[4], f[5]); o.w = pk2(f[6], f[7]);
        *(v4u*)(d.dst + (size_t)row * d.dp + 8 * c) = o;
    }
    if (d.kmean) {
        LAS float* ks = (LAS float*)(lds + RING_OFF);
#pragma unroll
        for (int i = 0; i < 8; ++i) { cs[i] += swz_xor<16>(cs[i]); cs[i] = add_xor32(cs[i]); }
        if (lane < 16) {
#pragma unroll
            for (int i = 0; i < 8; ++i) ks[wave * 128 + 8 * c + i] = cs[i]; }
        __syncthreads();
        if (tid < 128) { float s = 0.f;
#pragma unroll
            for (int w = 0; w < 8; ++w) s += ks[w * 128 + tid];
            d.kmean[tid] = s * (1.f / 256.f); }
        __syncthreads();
    }
}
__device__ __forceinline__ void phase_post_mem(const Args& a, LAS unsigned char* lds, int G, int vb) {
    unsigned char* ws = opaque_ws(a.ws);
    for (int v = vb; v < 32; v += G) {
        PostDesc d; d.kmean = nullptr; d.scale = 1.f; d.gain = nullptr;
        const int l = v >> 4, b = (v >> 3) & 1, s8 = v & 7;
        const bf16* srow = (const bf16*)(ws + WS_SMALL + SM_KVM) + ((size_t)b * 256) * 2048 + l * 1024; d.sp = 2048; d.dp = HD;
        if (s8 < 4) { d.src = srow + s8 * 128; d.dst = (bf16*)(ws + WS_SMALL + SM_KM) + ((size_t)((l * 2 + b) * 4 + s8) * NMEM) * HD; d.gain = a.in[I_KN_MEM] + l * HD; }
        else { d.src = srow + 512 + (s8 - 4) * 128; d.dst = (bf16*)(ws + WS_SMALL + SM_VM) + ((size_t)((l * 2 + b) * 4 + (s8 - 4)) * NMEM) * HD; }
        post_unit(d, lds);
    }
}
struct SlotDesc { bf16* dst; int dp; const float* gain; float scale; float* kmean; };
__device__ __forceinline__ SlotDesc slot_desc(unsigned char* ws, int layer, int sl, int pm) {
    const float* gt = (const float*)(ws + WS_SMALL + SM_GAINTAB) + layer * 5 * HD;
    bf16* QH = (bf16*)(ws + WS_QH); bf16* KH = (bf16*)(ws + WS_KH); bf16* VH = (bf16*)(ws + WS_VH);
    const int t0 = pm * 256, b = pm >> 5, s0 = (pm & 31) * 256;
    SlotDesc d; d.kmean = nullptr; d.scale = 1.f; d.gain = nullptr;
    if (layer == 0) {
        if (sl < 12) { d.dst = QH + (size_t)t0 * DM + sl * 128; d.dp = DM; d.gain = gt; d.scale = QSCALE; }
        else if (sl < 24) { const int h = sl - 12; d.dst = KH + ((size_t)(b * 12 + h) * SEQ + s0) * HD; d.dp = HD; d.gain = gt + 3 * HD;
            d.kmean = (float*)(ws + WS_SMALL + SM_KMEAN) + ((size_t)(b * 12 + h) * 32 + (pm & 31)) * HD; }
        else if (sl < 36) { const int h = sl - 24; d.dst = VH + ((size_t)(b * 12 + h) * SEQ + s0) * HD; d.dp = HD; }
        else { const int h = sl - 36; d.dst = QH + (size_t)t0 * DM + (12 + h) * 128; d.dp = DM; d.gain = gt + 2 * HD; d.scale = QSCALE; }
    } else {
        if (sl < 6) { d.dst = QH + (size_t)t0 * DM + sl * 128; d.dp = DM; d.gain = gt; d.scale = QSCALE; }
        else if (sl < 12) { d.dst = QH + (size_t)t0 * DM + sl * 128; d.dp = DM; d.gain = gt + HD; d.scale = QSCALE; }
        else if (sl < 16) { d.dst = QH + (size_t)t0 * DM + sl * 128; d.dp = DM; d.gain = gt + 2 * HD; d.scale = QSCALE; }
        else if (sl < 22) { const int h = sl - 16; d.dst = KH + ((size_t)(b * 12 + h) * SEQ + s0) * HD; d.dp = HD; d.gain = gt + 3 * HD; }
        else if (sl < 28) { const int h = sl - 22; d.dst = KH + ((size_t)(b * 12 + 6 + h) * SEQ + s0) * HD; d.dp = HD; d.gain = gt + 4 * HD; }
        else { const int vh = sl - 28, h = vh >> 1, cc = vh & 1; d.dst = VH + ((size_t)(b * 6 + h) * SEQ + s0) * DV + cc * 128; d.dp = DV; }
    }
    return d;
}
struct EpiHeadNorm {
    static constexpr bool PERM = true, AFTER_DRAIN = false;
    unsigned char* ws; int layer; float cs;
    __device__ __forceinline__ void operator()(const f32x4 (&acc)[2][2][4][2], const pg8::Unit& u, int wr, int wc, int fr_in, int fq_in) const {
        int fr = fr_in, fq = fq_in; asm volatile("" : "+v"(fr), "+v"(fq));
        LAS float* P = (LAS float*)(uintptr_t)LDSX_OFF;
        LAS float* KS = (LAS float*)(uintptr_t)(LDSX_OFF + 8192);
        const float* rs = (const float*)(ws + WS_SMALL + SM_RSTD);
        const SlotDesc d0 = slot_desc(ws, layer, 2 * u.pn, u.pm), d1 = slot_desc(ws, layer, 2 * u.pn + 1, u.pm);
        const int rowl = wr * 64 + fr, coll = wc * 32 + 8 * fq;
        const float* rsr = rs + u.pm * 256 + rowl;
#pragma unroll
        for (int ai = 0; ai < 2; ++ai)
#pragma unroll
            for (int m = 0; m < 4; ++m) { const int row = rowl + ai * 128 + m * 16; const float rtv = rsr[ai * 128 + m * 16] * cs;
#pragma unroll
                for (int bj = 0; bj < 2; ++bj) { if ((bj == 0 ? d0.gain : d1.gain) != nullptr) {
                    const f32x4 v0 = acc[ai][bj][m][0] * rtv, v1 = acc[ai][bj][m][1] * rtv;
                    float ss = (v0[0] * v0[0] + v0[1] * v0[1]) + (v0[2] * v0[2] + v0[3] * v0[3]) + (v1[0] * v1[0] + v1[1] * v1[1]) + (v1[2] * v1[2] + v1[3] * v1[3]);
                    ss += swz_xor<16>(ss); ss = add_xor32(ss);
                    if (fq == 0) P[(row * 2 + bj) * 4 + wc] = ss; } } }
        asm volatile("s_waitcnt lgkmcnt(0)" ::: "memory"); __builtin_amdgcn_s_barrier(); asm volatile("" ::: "memory");
#pragma unroll
        for (int bj = 0; bj < 2; ++bj) { const SlotDesc& d = bj == 0 ? d0 : d1;
            f32x4 g0 = (f32x4){1.f, 1.f, 1.f, 1.f}, g1 = g0;
            if (d.gain) { g0 = *(const f32x4*)(d.gain + coll) * d.scale; g1 = *(const f32x4*)(d.gain + coll + 4) * d.scale; }
            f32x4 c0 = (f32x4){0.f, 0.f, 0.f, 0.f}, c1 = c0;
#pragma unroll
            for (int ai = 0; ai < 2; ++ai)
#pragma unroll
                for (int m = 0; m < 4; ++m) { const int row = rowl + ai * 128 + m * 16; float f = rsr[ai * 128 + m * 16] * cs;
                    if (d.gain) { const f32x4 p4 = *(const LAS f32x4*)(P + (row * 2 + bj) * 4); f *= 1.0f / sqrtf(((p4[0] + p4[1]) + (p4[2] + p4[3])) * (1.f / HD) + RMS_EPS); }
                    const f32x4 v0 = acc[ai][bj][m][0] * f * g0, v1 = acc[ai][bj][m][1] * f * g1;
                    if (d.kmean) { c0 += v0; c1 += v1; }
                    v4u w; w.x = cvt_pk_bf16(v0[0], v0[1]); w.y = cvt_pk_bf16(v0[2], v0[3]); w.z = cvt_pk_bf16(v1[0], v1[1]); w.w = cvt_pk_bf16(v1[2], v1[3]);
                    *(v4u*)(d.dst + (size_t)row * d.dp + coll) = w; }
            if (d.kmean) {
#pragma unroll
                for (int i = 0; i < 4; ++i) { float v = c0[i]; v += swz_xor<1>(v); v += swz_xor<2>(v); v += swz_xor<4>(v); v += swz_xor<8>(v); if (fr == 0) KS[wr * 256 + bj * 128 + coll + i] = v;
                                              float w_ = c1[i]; w_ += swz_xor<1>(w_); w_ += swz_xor<2>(w_); w_ += swz_xor<4>(w_); w_ += swz_xor<8>(w_); if (fr == 0) KS[wr * 256 + bj * 128 + coll + 4 + i] = w_; } } }
        if (d0.kmean) {
            asm volatile("s_waitcnt lgkmcnt(0)" ::: "memory"); __builtin_amdgcn_s_barrier(); asm volatile("" ::: "memory");
            const int t = (wr * 4 + wc) * 64 + fq * 16 + fr;
            if (t < 256) { const float mean = (KS[t] + KS[256 + t]) * (1.f / 256.f); float* km = (t < 128) ? d0.kmean : d1.kmean; km[t & 127] = mean; }
        }
    }
};
__device__ __forceinline__ void phase_gate(const Args& a, LAS unsigned char* lds, int G, int vb) {
    unsigned char* ws = opaque_ws(a.ws);
    const bf16* QH = (const bf16*)(ws + WS_QH); const float* KMEAN = (const float*)(ws + WS_SMALL + SM_KMEAN); unsigned* SEL = (unsigned*)(ws + WS_SMALL + SM_SEL);
    gu32* MC = (gu32*)(ws + WS_CTL) + CW_MC; unsigned* LISTF = (unsigned*)(ws + WS_LISTF); unsigned* LISTA = (unsigned*)(ws + WS_LISTA);
    const int tid_g = opaque_tid();
    LAS float* kml = (LAS float*)(lds + RING_OFF);
    for (int idx = vb * 512 + tid_g; idx < NB * MOBA_H * SEQ; idx += G * 512) {
        const int bh = idx / SEQ, s = idx % SEQ, b = bh / MOBA_H, h = bh % MOBA_H, own = s >> 8;
        __syncthreads();
        { const f32x4* src = (const f32x4*)(KMEAN + (size_t)bh * 32 * HD); ((LAS f32x4*)kml)[tid_g] = src[tid_g]; ((LAS f32x4*)kml)[512 + tid_g] = src[512 + tid_g]; }
        __syncthreads();
        unsigned mask = 0u;
        if (own <= 3) { mask = (1u << own) - 1u; }
        else {
            float acc[31];
#pragma unroll
            for (int j = 0; j < 31; ++j) acc[j] = 0.f;
            const bf16* q = QH + ((size_t)b * SEQ + s) * DM + h * HD;
            for (int c = 0; c < 16; ++c) {
                const v4u w = *(const v4u*)(q + 8 * c);
                const float f0 = bflo(w.x), f1 = bfhi(w.x), f2 = bflo(w.y), f3 = bfhi(w.y), f4 = bflo(w.z), f5 = bfhi(w.z), f6 = bflo(w.w), f7 = bfhi(w.w);
#pragma unroll
                for (int j = 0; j < 31; ++j) if (j < own) {
                    const f32x4 k0 = *(const LAS f32x4*)(kml + j * HD + 8 * c), k1 = *(const LAS f32x4*)(kml + j * HD + 8 * c + 4);
                    acc[j] += (f0 * k0[0] + f1 * k0[1]) + (f2 * k0[2] + f3 * k0[3]) + (f4 * k1[0] + f5 * k1[1]) + (f6 * k1[2] + f7 * k1[3]); }
            }
#pragma unroll
            for (int rnd = 0; rnd < 3; ++rnd) { float best = -__builtin_inff(); int bi = 0;
#pragma unroll
                for (int j = 0; j < 31; ++j) if (j < own && !((mask >> j) & 1u) && acc[j] > best) { best = acc[j]; bi = j; }
                mask |= 1u << bi; }
        }
        SEL[idx] = mask;
        { const int lane_ = tid_g & 63; const unsigned long long lt = (1ull << lane_) - 1ull;
          for (int j = 0; j < own; ++j) {
              const bool selj = (mask >> j) & 1u; const unsigned long long bal = __ballot(selj);
              if (bal == 0ull) continue;
              const int far = (j == own - 1) ? 0 : 1; const int lead = __builtin_ctzll(bal);
              unsigned base = 0u; if (lane_ == lead) base = __hip_atomic_fetch_add(MC + (bh * 32 + j) * 2 + far, (unsigned)__builtin_popcountll(bal), RLX_AGENT);
              base = __shfl(base, lead);
              if (selj) { const unsigned pos = base + (unsigned)__builtin_popcountll(bal & lt); const int slot = __builtin_popcount(mask & ((1u << j) - 1u));
                  const unsigned ent = (unsigned)s | ((unsigned)slot << 16);
                  if (far) LISTF[((size_t)bh * 32 + j) * 8192 + pos] = ent; else LISTA[((size_t)bh * 32 + j) * 256 + pos] = ent; } } }
    }
}

namespace att {
constexpr int SHM_T = 16384;
#define KSWZ(row, colB) ((row) * 256 + ((colB) ^ (((row) & 7) << 4)))
#define SBAR() __builtin_amdgcn_sched_barrier(0)
__device__ __forceinline__ int v_rd_base(int lane) { return ((lane & 3) << 3) | (((lane >> 2) & 3) << 6) | (((lane >> 4) & 1) << 5) | (((lane >> 5) & 1) << 8); }
__device__ __forceinline__ int crow(int r, int hi) { return (r & 3) + 8 * (r >> 2) + 4 * hi; }
__device__ __forceinline__ unsigned cvtpk(float lo, float hi) { unsigned r; asm volatile("v_cvt_pk_bf16_f32 %0, %1, %2" : "=v"(r) : "v"(lo), "v"(hi)); return r; }
__device__ __forceinline__ int swap23(int k) { return (k & ~0xC) | ((k & 4) << 1) | ((k & 8) >> 1); }
__device__ __forceinline__ void glds16(const void* sbase  , unsigned voff, unsigned lds_dst) { unsigned keep;
    asm volatile("s_mov_b32 %0, m0\n\ts_mov_b32 m0, %3\n\ts_nop 0\n\tglobal_load_lds_dwordx4 %1, %2\n\ts_mov_b32 m0, %0" : "=&s"(keep) : "v"(voff), "s"(sbase), "s"(lds_dst) : "memory"); }
#define WAIT_BAR0() asm volatile("s_waitcnt vmcnt(0) lgkmcnt(0)\n\ts_barrier" ::: "memory")
constexpr float THR2 = 11.5f;

__device__ __forceinline__ void qkt(f32x16& p0, f32x16& p1, const LAS char* Kt, int r32, int hi, const bf16x8* qr) {
#pragma unroll
    for (int r = 0; r < 16; ++r) { p0[r] = 0.f; p1[r] = 0.f; }
    const LAS char* kb0 = Kt + KSWZ(r32, (0 * 16 + hi * 8) * 2);
    const LAS char* kb1 = Kt + KSWZ(r32, (1 * 16 + hi * 8) * 2);
    const LAS char* kb2 = Kt + KSWZ(r32, (2 * 16 + hi * 8) * 2);
    const LAS char* kb3 = Kt + KSWZ(r32, (3 * 16 + hi * 8) * 2);
#pragma unroll
    for (int d0 = 0; d0 < 8; ++d0) { const LAS char* a = ((d0 & 3) == 0 ? kb0 : (d0 & 3) == 1 ? kb1 : (d0 & 3) == 2 ? kb2 : kb3) + (d0 >> 2) * 128;
        const bf16x8 b0 = *(const LAS bf16x8*)a;
        const bf16x8 b1 = *(const LAS bf16x8*)(a + 32 * 256);
        p0 = __builtin_amdgcn_mfma_f32_32x32x16_bf16(b0, qr[d0], p0, 0, 0, 0);
        p1 = __builtin_amdgcn_mfma_f32_32x32x16_bf16(b1, qr[d0], p1, 0, 0, 0); }
}
__device__ __forceinline__ void pv_tile(f32x16* o, int vb, bf16x8 pa0, bf16x8 pa1, bf16x8 pa2, bf16x8 pa3) {
#define TRRD(dst, off) asm volatile("ds_read_b64_tr_b16 %0, %1 offset:%2" : "=&v"(dst) : "v"(vb), "i"(off) : "memory")
#define PV_RD(S_, d0) do { constexpr int b_ = (d0) * 512; TRRD(S_##l0, b_); TRRD(S_##h0, b_ + 2048); TRRD(S_##l1, b_ + 4096); TRRD(S_##h1, b_ + 6144); \
        TRRD(S_##l2, b_ + 8192); TRRD(S_##h2, b_ + 10240); TRRD(S_##l3, b_ + 12288); TRRD(S_##h3, b_ + 14336); } while (0)
#define PV_MM(S_, d0) do { \
        o[d0] = __builtin_amdgcn_mfma_f32_32x32x16_bf16(pa0, (bf16x8){S_##l0[0], S_##l0[1], S_##l0[2], S_##l0[3], S_##h0[0], S_##h0[1], S_##h0[2], S_##h0[3]}, o[d0], 0, 0, 0); \
        o[d0] = __builtin_amdgcn_mfma_f32_32x32x16_bf16(pa1, (bf16x8){S_##l1[0], S_##l1[1], S_##l1[2], S_##l1[3], S_##h1[0], S_##h1[1], S_##h1[2], S_##h1[3]}, o[d0], 0, 0, 0); \
        o[d0] = __builtin_amdgcn_mfma_f32_32x32x16_bf16(pa2, (bf16x8){S_##l2[0], S_##l2[1], S_##l2[2], S_##l2[3], S_##h2[0], S_##h2[1], S_##h2[2], S_##h2[3]}, o[d0], 0, 0, 0); \
        o[d0] = __builtin_amdgcn_mfma_f32_32x32x16_bf16(pa3, (bf16x8){S_##l3[0], S_##l3[1], S_##l3[2], S_##l3[3], S_##h3[0], S_##h3[1], S_##h3[2], S_##h3[3]}, o[d0], 0, 0, 0); } while (0)
#define WL(n) asm volatile("s_waitcnt lgkmcnt(" #n ")" ::: "memory")
    s16x4 Al0, Al1, Al2, Al3, Ah0, Ah1, Ah2, Ah3, Bl0, Bl1, Bl2, Bl3, Bh0, Bh1, Bh2, Bh3;
    PV_RD(A, 0); SBAR();
    PV_RD(B, 1); WL(8); SBAR(); PV_MM(A, 0); SBAR();
    PV_RD(A, 2); WL(8); SBAR(); PV_MM(B, 1); SBAR();
    PV_RD(B, 3); WL(8); SBAR(); PV_MM(A, 2); SBAR();
    WL(0); SBAR(); PV_MM(B, 3);
#undef PV_RD
#undef PV_MM
#undef TRRD
}
__device__ __forceinline__ void softmax_tile(f32x16& p0, f32x16& p1, float& m_reg, float& l_reg, float& alpha, bf16x8& pa0, bf16x8& pa1, bf16x8& pa2, bf16x8& pa3) {
    float pmax = p0[0];
#pragma unroll
    for (int r = 1; r < 16; ++r) pmax = fmaxf(pmax, p0[r]);
#pragma unroll
    for (int r = 0; r < 16; ++r) pmax = fmaxf(pmax, p1[r]);
    { auto rr = __builtin_amdgcn_permlane32_swap(__float_as_uint(pmax), __float_as_uint(pmax), false, false);
      pmax = fmaxf(__uint_as_float(rr[0]), __uint_as_float(rr[1])); }
    const float mn = (pmax - m_reg <= THR2) ? m_reg : fmaxf(m_reg, pmax);
    alpha = __builtin_amdgcn_exp2f(m_reg - mn); m_reg = mn;
#pragma unroll
    for (int r = 0; r < 16; ++r) { p0[r] = __builtin_amdgcn_exp2f(p0[r] - mn); p1[r] = __builtin_amdgcn_exp2f(p1[r] - mn); }
    float ps = 0.f;
#pragma unroll
    for (int r = 0; r < 16; ++r) ps += p0[r] + p1[r];
    { auto rr = __builtin_amdgcn_permlane32_swap(__float_as_uint(ps), __float_as_uint(ps), false, false);
      ps = __uint_as_float(rr[0]) + __uint_as_float(rr[1]); }
    l_reg = l_reg * alpha + ps;
#define PK4(P, B_, OUT) do { unsigned a0 = cvtpk(P[B_+0], P[B_+1]), a1 = cvtpk(P[B_+2], P[B_+3]); \
        unsigned b0 = cvtpk(P[B_+4], P[B_+5]), b1 = cvtpk(P[B_+6], P[B_+7]); \
        auto r0 = __builtin_amdgcn_permlane32_swap(a0, b0, false, false); auto r1 = __builtin_amdgcn_permlane32_swap(a1, b1, false, false); \
        v4u w = {r0[0], r1[0], r0[1], r1[1]}; OUT = __builtin_bit_cast(bf16x8, w); } while (0)
    PK4(p0, 0, pa0); PK4(p0, 8, pa1); PK4(p1, 0, pa2); PK4(p1, 8, pa3);
#undef PK4
}
__device__ __forceinline__ void bias_mask_tile(f32x16& p0, f32x16& p1, int dq, bool on, bool far, const LAS float* lut) {
    const float NEG = -__builtin_inff();
    if (far) {
        const float c = on ? lut[128] : NEG;
#pragma unroll
        for (int r = 0; r < 16; ++r) { p0[r] += c; p1[r] += c; }
    } else {
#pragma unroll
        for (int r = 0; r < 16; ++r) { const int c = (r & 3) + 8 * (r >> 2); const int d0 = dq - c, d1 = dq - c - 32;
            const float b0 = lut[min(max(d0, 0), 128)], b1 = lut[min(max(d1, 0), 128)];
            p0[r] = (on && d0 >= 0) ? p0[r] + b0 : NEG; p1[r] = (on && d1 >= 0) ? p1[r] + b1 : NEG; }
    }
}

__device__ __forceinline__ void qkt_half(f32x16& p, const LAS char* Kt  , int r32, int hi, const bf16x8* qr) {
#pragma unroll
    for (int r = 0; r < 16; ++r) p[r] = 0.f;
    const LAS char* kb0 = Kt + KSWZ(r32, (0 * 16 + hi * 8) * 2);
    const LAS char* kb1 = Kt + KSWZ(r32, (1 * 16 + hi * 8) * 2);
    const LAS char* kb2 = Kt + KSWZ(r32, (2 * 16 + hi * 8) * 2);
    const LAS char* kb3 = Kt + KSWZ(r32, (3 * 16 + hi * 8) * 2);
#pragma unroll
    for (int d0 = 0; d0 < 8; ++d0) { const LAS char* a = ((d0 & 3) == 0 ? kb0 : (d0 & 3) == 1 ? kb1 : (d0 & 3) == 2 ? kb2 : kb3) + (d0 >> 2) * 128;
        const bf16x8 b0 = *(const LAS bf16x8*)a;
        p = __builtin_amdgcn_mfma_f32_32x32x16_bf16(b0, qr[d0], p, 0, 0, 0); }
}
template <int HALF>
__device__ __forceinline__ void pv_half8(f32x16* o, int vb, bf16x8 pa0, bf16x8 pa1) {
#define TRRD(dst, off) asm volatile("ds_read_b64_tr_b16 %0, %1 offset:%2" : "=&v"(dst) : "v"(vb), "i"(off) : "memory")
#define PV_RD(S_, d0) do { constexpr int b_ = ((d0) & 3) * 512 + ((d0) >> 2) * SHM_T + HALF * 8192; TRRD(S_##l0, b_); TRRD(S_##h0, b_ + 2048); TRRD(S_##l1, b_ + 4096); TRRD(S_##h1, b_ + 6144); } while (0)
#define PV_MM(S_, d0) do { \
        o[d0] = __builtin_amdgcn_mfma_f32_32x32x16_bf16(pa0, (bf16x8){S_##l0[0], S_##l0[1], S_##l0[2], S_##l0[3], S_##h0[0], S_##h0[1], S_##h0[2], S_##h0[3]}, o[d0], 0, 0, 0); \
        o[d0] = __builtin_amdgcn_mfma_f32_32x32x16_bf16(pa1, (bf16x8){S_##l1[0], S_##l1[1], S_##l1[2], S_##l1[3], S_##h1[0], S_##h1[1], S_##h1[2], S_##h1[3]}, o[d0], 0, 0, 0); } while (0)
#define WL(n) asm volatile("s_waitcnt lgkmcnt(" #n ")" ::: "memory")
    s16x4 Al0, Al1, Ah0, Ah1, Bl0, Bl1, Bh0, Bh1;
    PV_RD(A, 0); SBAR();
    PV_RD(B, 1); WL(4); SBAR(); PV_MM(A, 0); SBAR();
    PV_RD(A, 2); WL(4); SBAR(); PV_MM(B, 1); SBAR();
    PV_RD(B, 3); WL(4); SBAR(); PV_MM(A, 2); SBAR();
    PV_RD(A, 4); WL(4); SBAR(); PV_MM(B, 3); SBAR();
    PV_RD(B, 5); WL(4); SBAR(); PV_MM(A, 4); SBAR();
    PV_RD(A, 6); WL(4); SBAR(); PV_MM(B, 5); SBAR();
    PV_RD(B, 7); WL(4); SBAR(); PV_MM(A, 6); SBAR();
    WL(0); SBAR(); PV_MM(B, 7);
#undef PV_RD
#undef PV_MM
#undef WL
#undef TRRD
}
__device__ __forceinline__ void softmax_half(f32x16& p0, float& m_reg, float& l_reg, float& alpha, bf16x8& pa0, bf16x8& pa1) {
    float pmax = p0[0];
#pragma unroll
    for (int r = 1; r < 16; ++r) pmax = fmaxf(pmax, p0[r]);
    { auto rr = __builtin_amdgcn_permlane32_swap(__float_as_uint(pmax), __float_as_uint(pmax), false, false);
      pmax = fmaxf(__uint_as_float(rr[0]), __uint_as_float(rr[1])); }
    const float mn = (pmax - m_reg <= THR2) ? m_reg : fmaxf(m_reg, pmax);
    alpha = __builtin_amdgcn_exp2f(m_reg - mn); m_reg = mn;
#pragma unroll
    for (int r = 0; r < 16; ++r) p0[r] = __builtin_amdgcn_exp2f(p0[r] - mn);
    float ps = 0.f;
#pragma unroll
    for (int r = 0; r < 16; ++r) ps += p0[r];
    { auto rr = __builtin_amdgcn_permlane32_swap(__float_as_uint(ps), __float_as_uint(ps), false, false);
      ps = __uint_as_float(rr[0]) + __uint_as_float(rr[1]); }
    l_reg = l_reg * alpha + ps;
#define PK4(P, B_, OUT) do { unsigned a0 = cvtpk(P[B_+0], P[B_+1]), a1 = cvtpk(P[B_+2], P[B_+3]); \
        unsigned b0 = cvtpk(P[B_+4], P[B_+5]), b1 = cvtpk(P[B_+6], P[B_+7]); \
        auto r0 = __builtin_amdgcn_permlane32_swap(a0, b0, false, false); auto r1 = __builtin_amdgcn_permlane32_swap(a1, b1, false, false); \
        v4u w = {r0[0], r1[0], r0[1], r1[1]}; OUT = __builtin_bit_cast(bf16x8, w); } while (0)
    PK4(p0, 0, pa0); PK4(p0, 8, pa1);
#undef PK4
}
__device__ __forceinline__ void bias_mask_half(f32x16& p0, int dq, bool far, const LAS float* lut) {
    const float NEG = -__builtin_inff();
    if (far) { const float c = lut[128];
#pragma unroll
        for (int r = 0; r < 16; ++r) p0[r] += c;
    } else {
#pragma unroll
        for (int r = 0; r < 16; ++r) { const int c = (r & 3) + 8 * (r >> 2); const int d0 = dq - c;
            const float b0 = lut[min(max(d0, 0), 128)]; p0[r] = (d0 >= 0) ? p0[r] + b0 : NEG; }
    }
}
#define RESC(o_, nd_, al_l_, alpha_) do { if (__any((alpha_) < 1.f)) { if (hi == 0) (al_l_)[r32] = (alpha_); asm volatile("s_waitcnt lgkmcnt(0)" ::: "memory"); \
        _Pragma("unroll") for (int r = 0; r < 16; ++r) { const float f_ = (al_l_)[crow(r, hi)]; _Pragma("unroll") for (int d_ = 0; d_ < (nd_); ++d_) (o_)[d_][r] *= f_; } } } while (0)

template <int MODE, bool F8OUT = false>
__device__ __forceinline__ void attn128_unit(LAS unsigned char* lds, const bf16* Qrow0, const bf16* Kh, const bf16* Vh, bf16* Orow0, int NT, int qb, const unsigned* selrow, const float* relb, int h) {
    const int tid = opaque_tid(), wid = __builtin_amdgcn_readfirstlane(tid >> 6), lane = tid & 63, r32 = lane & 31, hi = lane >> 5;
    LAS float* wsf = (LAS float*)(lds + LDSX_OFF) + wid * 64; LAS float* li_l = wsf; LAS float* al_l = wsf + 32;
    LAS float* lut = (LAS float*)(lds + LDSX_OFF + 2048);
    if (MODE == 0 && tid <= 128) lut[tid] = relb[(tid < 128 ? (int)T5_BUCKET[tid] : 31) * 12 + h] * LOG2E;
    bf16x8 qr[8];
#pragma unroll
    for (int d0 = 0; d0 < 8; ++d0) qr[d0] = *(const bf16x8*)(Qrow0 + (size_t)(wid * 32 + r32) * DM + d0 * 16 + hi * 8);
    unsigned sel = 0u; if (MODE == 0) sel = selrow[wid * 32 + r32];
    const int krow = 4 * wid + (lane >> 4); const unsigned ksrc = (unsigned) krow * 256 + ((16 * (lane & 15)) ^ ((krow & 7) << 4));
    const int vkk = 8 * (wid >> 1) + ((lane & 31) >> 2); const unsigned vsrc = (unsigned) swap23(vkk) * 256 + (32 * (2 * (wid & 1) + (lane >> 5)) + 8 * (lane & 3)) * 2;
    const unsigned lds0 = (unsigned)(uintptr_t)(lds + RING_OFF);
    const char* Kg = (const char*)Kh; const char* Vg = (const char*)Vh;
#define ISSUE(t, s) do { const unsigned base_ = (unsigned)__builtin_amdgcn_readfirstlane(lds0 + (s) * 32768 + wid * 1024); const size_t tb_ = (size_t)(t) * SHM_T; \
        glds16(Kg + tb_, ksrc, base_); glds16(Kg + tb_ + 8192, ksrc, base_ + 8192); glds16(Vg + tb_, vsrc, base_ + SHM_T); glds16(Vg + tb_ + 8192, vsrc, base_ + SHM_T + 8192); } while (0)
    const int vb0 = (int)lds0 + SHM_T + v_rd_base(lane);
    float m_reg = -1e30f, l_reg = 0.f; f32x16 o[4];
#pragma unroll
    for (int d = 0; d < 4; ++d)
#pragma unroll
        for (int r = 0; r < 16; ++r) o[d][r] = 0.f;
    const int q0w = qb * 256 + wid * 32, qpos = q0w + r32;
    ISSUE(0, 0);
    for (int t = 0; t < NT; ++t) {
        WAIT_BAR0();
        if (t + 1 < NT) ISSUE(t + 1, (t + 1) & 1);
        const int s = t & 1;
        f32x16 p0, p1;
        qkt(p0, p1, (const LAS char*)(lds + RING_OFF + s * 32768), r32, hi, qr);
        if (MODE == 0) { const int jb = t >> 2, tk0 = t * 64; const bool on = (jb >= qb) || ((sel >> jb) & 1u); const bool far = (q0w - (tk0 + 63)) >= 128;
            bias_mask_tile(p0, p1, qpos - tk0 - 4 * hi, on, far, lut); }
        float alpha; bf16x8 pa0, pa1, pa2, pa3;
        softmax_tile(p0, p1, m_reg, l_reg, alpha, pa0, pa1, pa2, pa3);
        RESC(o, 4, al_l, alpha);
        pv_tile(o, vb0 + s * 32768, pa0, pa1, pa2, pa3);
    }
#undef ISSUE
    if (hi == 0) li_l[r32] = l_reg; asm volatile("s_waitcnt lgkmcnt(0)" ::: "memory");
    int r32o = r32, hio = hi; asm volatile("" : "+v"(r32o), "+v"(hio));
    bf16* Ow = Orow0 + (size_t)(wid * 32) * DM + r32o;
#pragma unroll
    for (int r = 0; r < 16; ++r) { const int orow = crow(r, hio); const float rli = __builtin_amdgcn_rcpf(li_l[orow]);
#pragma unroll
        for (int d0 = 0; d0 < 4; ++d0) { const float v = o[d0][r] * rli; const float vn = swz_xor<1>(v);
            if (F8OUT) { if ((r32 & 1) == 0) *(unsigned short*)((unsigned char*)Orow0 + (size_t)(wid * 32 + orow) * DM + d0 * 32 + r32o) = (unsigned short)__builtin_amdgcn_cvt_pk_fp8_f32(v * SC_O, vn * SC_O, 0u, false); }
            else if ((r32 & 1) == 0) *(unsigned*)(Ow + (size_t)orow * DM + d0 * 32) = cvtpk(v, vn); } }
    WAIT_BAR0();
}

#define PK4X(P, B_, OUT) do { unsigned a0 = cvtpk(P[B_+0], P[B_+1]), a1 = cvtpk(P[B_+2], P[B_+3]); unsigned b0 = cvtpk(P[B_+4], P[B_+5]), b1 = cvtpk(P[B_+6], P[B_+7]); \
        auto r0 = __builtin_amdgcn_permlane32_swap(a0, b0, false, false); auto r1 = __builtin_amdgcn_permlane32_swap(a1, b1, false, false); v4u w = {r0[0], r1[0], r0[1], r1[1]}; OUT = __builtin_bit_cast(bf16x8, w); } while (0)
template <int VAR>
__device__ __forceinline__ void diff_unit(LAS unsigned char* lds, const bf16* Qrow0  , const bf16* K1h, const bf16* K2h, const bf16* Vh, bf16* Orow0  ,
                                          int qblk, const float* relb, int h, float lam, const float* subln) {
    const int tid = opaque_tid(), wid = __builtin_amdgcn_readfirstlane(tid >> 6), lane = tid & 63, r32 = lane & 31, hi = lane >> 5, mp = wid >> 2, w4 = wid & 3;
    LAS float* wsf = (LAS float*)(lds + LDSX_OFF) + wid * 64; LAS float* li_l = wsf; LAS float* al_l = wsf + 32;
    LAS float* lut2 = (LAS float*)(lds + LDSX_OFF + 2048);
    if (tid < 2 * 132) { const int m_ = tid / 132, i_ = tid % 132; if (i_ <= 128) lut2[tid] = relb[(i_ < 128 ? (int)T5_BUCKET[i_] : 31) * 12 + 2 * h + m_] * LOG2E; }
    const LAS float* lut = lut2 + mp * 132;
    bf16x8 qr[8];
#pragma unroll
    for (int d0 = 0; d0 < 8; ++d0) qr[d0] = *(const bf16x8*)(Qrow0 + (size_t)(w4 * 32 + r32) * DM + (h + 6 * mp) * HD + d0 * 16 + hi * 8);
    const int krow = 4 * wid + (lane >> 4); const unsigned ksrc = (unsigned) krow * 256 + ((16 * (lane & 15)) ^ ((krow & 7) << 4));
    const int vkk = 8 * (wid >> 1) + ((lane & 31) >> 2); const unsigned vsrc = (unsigned) swap23(vkk) * 512 + (32 * (2 * (wid & 1) + (lane >> 5)) + 8 * (lane & 3)) * 2;
    const unsigned lds0 = (unsigned)(uintptr_t)(lds + RING_OFF);
    const char* K1g = (const char*)K1h; const char* K2g = (const char*)K2h; const char* Vg = (const char*)Vh;
#define ISSUE(t, s) do { const unsigned base_ = (unsigned)__builtin_amdgcn_readfirstlane(lds0 + (s) * 65536 + wid * 1024); const size_t tb_ = (size_t)(t) * SHM_T; \
        glds16(K1g + tb_, ksrc, base_); glds16(K1g + tb_ + 8192, ksrc, base_ + 8192); glds16(K2g + tb_, ksrc, base_ + SHM_T); glds16(K2g + tb_ + 8192, ksrc, base_ + SHM_T + 8192); \
        glds16(Vg + 2 * tb_, vsrc, base_ + 2 * SHM_T); glds16(Vg + 2 * tb_ + 16384, vsrc, base_ + 2 * SHM_T + 8192); \
        glds16(Vg + 2 * tb_ + 256, vsrc, base_ + 3 * SHM_T); glds16(Vg + 2 * tb_ + 256 + 16384, vsrc, base_ + 3 * SHM_T + 8192); } while (0)
#define ISSUE_K(t, s) do { const unsigned base_ = (unsigned)__builtin_amdgcn_readfirstlane(lds0 + (s) * 65536 + wid * 1024); const size_t tb_ = (size_t)(t) * SHM_T; \
        glds16(K1g + tb_, ksrc, base_); glds16(K1g + tb_ + 8192, ksrc, base_ + 8192); glds16(K2g + tb_, ksrc, base_ + SHM_T); glds16(K2g + tb_ + 8192, ksrc, base_ + SHM_T + 8192); } while (0)
#define ISSUE_V(t, s) do { const unsigned base_ = (unsigned)__builtin_amdgcn_readfirstlane(lds0 + (s) * 65536 + wid * 1024); const size_t tb_ = (size_t)(t) * SHM_T; \
        glds16(Vg + 2 * tb_, vsrc, base_ + 2 * SHM_T); glds16(Vg + 2 * tb_ + 16384, vsrc, base_ + 2 * SHM_T + 8192); \
        glds16(Vg + 2 * tb_ + 256, vsrc, base_ + 3 * SHM_T); glds16(Vg + 2 * tb_ + 256 + 16384, vsrc, base_ + 3 * SHM_T + 8192); } while (0)
    const int vb0 = (int)lds0 + 2 * SHM_T + v_rd_base(lane);
    float m_reg = -1e30f, l_reg = 0.f; f32x16 o[8];
#pragma unroll
    for (int d = 0; d < 8; ++d)
#pragma unroll
        for (int r = 0; r < 16; ++r) o[d][r] = 0.f;
    const int q0w = qblk * 128 + w4 * 32, qpos = q0w + r32, NT = 2 * (qblk + 1);
    if (!(VAR & 1)) ISSUE(0, 0);
    for (int t = 0; t < NT; ++t) {
        WAIT_BAR0();
        if (!(VAR & 1)) if (t + 1 < NT) ISSUE(t + 1, (t + 1) & 1);
        const int s = t & 1, tk0 = t * 64;
        if (VAR & 2) continue;
        const bool far = (q0w - (tk0 + 63)) >= 128;
        { f32x16 p; float alpha; bf16x8 pa0, pa1;
          qkt_half(p, (const LAS char*)(lds + RING_OFF + s * 65536 + mp * SHM_T), r32, hi, qr);
          bias_mask_half(p, qpos - tk0 - 4 * hi, far, lut);
          if (VAR & 4) { alpha = 1.f; l_reg += p[0]; PK4X(p, 0, pa0); PK4X(p, 8, pa1); } else { softmax_half(p, m_reg, l_reg, alpha, pa0, pa1);
          RESC(o, 8, al_l, alpha); }
          pv_half8<0>(o, vb0 + s * 65536, pa0, pa1); }
        SBAR();
        { f32x16 p; float alpha; bf16x8 pa0, pa1;
          qkt_half(p, (const LAS char*)(lds + RING_OFF + s * 65536 + mp * SHM_T + 32 * 256), r32, hi, qr);
          bias_mask_half(p, qpos - tk0 - 32 - 4 * hi, far, lut);
          if (VAR & 4) { alpha = 1.f; l_reg += p[0]; PK4X(p, 0, pa0); PK4X(p, 8, pa1); } else { softmax_half(p, m_reg, l_reg, alpha, pa0, pa1);
          RESC(o, 8, al_l, alpha); }
          pv_half8<1>(o, vb0 + s * 65536, pa0, pa1); }
        SBAR();
    }
#undef ISSUE
#undef ISSUE_K
#undef ISSUE_V
    if (hi == 0) li_l[r32] = l_reg;
    WAIT_BAR0();
    int laneo = lane; asm volatile("" : "+v"(laneo));
    LAS float* X = (LAS float*)(lds + RING_OFF) + (w4 * 8 * 16 * 64 + laneo);
    if (mp == 1) {
#pragma unroll
        for (int r = 0; r < 16; ++r) { const float f = lam * __builtin_amdgcn_rcpf(li_l[crow(r, hi)]);
#pragma unroll
            for (int d0 = 0; d0 < 8; ++d0) X[(d0 * 16 + r) * 64] = o[d0][r] * f; }
    }
    WAIT_BAR0();
    if (mp == 0) {
        int r32o = r32, hio = hi; asm volatile("" : "+v"(r32o), "+v"(hio));
        bf16* Ow = Orow0 + (size_t)(w4 * 32) * DM + r32o; const float* sg = subln + r32o;
#pragma unroll
        for (int r = 0; r < 16; ++r) { const float rli = __builtin_amdgcn_rcpf(li_l[crow(r, hi)]); float ss = 0.f;
#pragma unroll
            for (int d0 = 0; d0 < 8; ++d0) { const float v = o[d0][r] * rli - X[(d0 * 16 + r) * 64]; o[d0][r] = v; ss += v * v; }
            ss += swz_xor<1>(ss); ss += swz_xor<2>(ss); ss += swz_xor<4>(ss); ss += swz_xor<8>(ss); ss += swz_xor<16>(ss);
            const float rs = (1.0f / sqrtf(ss * (1.f / DV) + RMS_EPS)) * (1.f - LAM_INIT); const int orow = crow(r, hio);
#pragma unroll
            for (int d0 = 0; d0 < 8; ++d0) { const float v = o[d0][r] * rs * sg[d0 * 32]; const float vn = swz_xor<1>(v);
                if ((r32 & 1) == 0) *(unsigned*)(Ow + (size_t)orow * DM + d0 * 32) = cvtpk(v, vn); } }
    }
    WAIT_BAR0();
}

__device__ __forceinline__ void moba_sparse_unit(LAS unsigned char* lds, const bf16* QHb, const bf16* Kblk, const bf16* Vblk, const unsigned* listF, int cntF, const unsigned* listA, int cntA, int j,
                                                 bf16* PO, float* PM, const float* relb, int h) {
    const int tid = opaque_tid(), wid = __builtin_amdgcn_readfirstlane(tid >> 6), lane = tid & 63, r32 = lane & 31, hi = lane >> 5;
    LAS float* wsf = (LAS float*)(lds + LDSX_OFF) + wid * 64; LAS float* li_l = wsf; LAS float* al_l = wsf + 32;
    LAS float* lut = (LAS float*)(lds + LDSX_OFF + 2048);
    if (tid <= 128) lut[tid] = relb[(tid < 128 ? (int)T5_BUCKET[tid] : 31) * 12 + h] * LOG2E;
    const int krow = 4 * wid + (lane >> 4); const unsigned ksrc = (unsigned) krow * 256 + ((16 * (lane & 15)) ^ ((krow & 7) << 4));
    const int vkk = 8 * (wid >> 1) + ((lane & 31) >> 2); const unsigned vsrc = (unsigned) swap23(vkk) * 256 + (32 * (2 * (wid & 1) + (lane >> 5)) + 8 * (lane & 3)) * 2;
    const unsigned lds0 = (unsigned)(uintptr_t)(lds + RING_OFF);
    const char* Kg = (const char*)Kblk; const char* Vg = (const char*)Vblk;
    { const unsigned base_ = (unsigned)__builtin_amdgcn_readfirstlane(lds0 + wid * 1024);
#pragma unroll
      for (int t = 0; t < 4; ++t) { glds16(Kg + t * SHM_T, ksrc, base_ + t * SHM_T); glds16(Kg + t * SHM_T + 8192, ksrc, base_ + t * SHM_T + 8192);
                                    glds16(Vg + t * SHM_T, vsrc, base_ + 65536 + t * SHM_T); glds16(Vg + t * SHM_T + 8192, vsrc, base_ + 65536 + t * SHM_T + 8192); } }
    const int vb0 = (int)lds0 + 65536 + v_rd_base(lane);
    const int gF = (cntF + 31) >> 5, ng = gF + ((cntA + 31) >> 5);
    const float c31 = relb[31 * 12 + h] * LOG2E;
#define GRP_ENT(g_, ent_, val_) do { const bool fr_ = (g_) < gF; const int b0_ = fr_ ? (g_) * 32 : ((g_) - gF) * 32; const int n_ = fr_ ? cntF : cntA; const unsigned* l_ = fr_ ? listF : listA; \
        val_ = (b0_ + r32) < n_; ent_ = l_[val_ ? b0_ + r32 : b0_]; } while (0)
#define LOADQ(dst_, ent_) do { const bf16* qp_ = QHb + (size_t)((ent_) & 0xffffu) * DM + hi * 8; _Pragma("unroll") for (int d0 = 0; d0 < 8; ++d0) dst_[d0] = *(const bf16x8*)(qp_ + d0 * 16); } while (0)
    int g = wid; unsigned ent = 0u, entn = 0u; bool valid = false, validn = false; bf16x8 qr[8], qn[8];
    if (g < ng) { GRP_ENT(g, ent, valid); LOADQ(qr, ent); }
    if (g + 8 < ng) GRP_ENT(g + 8, entn, validn);
    WAIT_BAR0();
    for (; g < ng; g += 8) {
        const bool adj = g >= gF;
        unsigned entnn = 0u; bool validnn = false;
        if (g + 8 < ng) LOADQ(qn, entn);
        if (g + 16 < ng) GRP_ENT(g + 16, entnn, validnn);
        const int srow = (int)(ent & 0xffffu), slot = (int)(ent >> 16);
        float m_reg = -1e30f, l_reg = 0.f; f32x16 o[4];
#pragma unroll
        for (int d = 0; d < 4; ++d)
#pragma unroll
            for (int r = 0; r < 16; ++r) o[d][r] = 0.f;
#pragma unroll 1
        for (int t = 0; t < 4; ++t) {
            f32x16 p0, p1;
            qkt(p0, p1, (const LAS char*)(lds + RING_OFF + t * SHM_T), r32, hi, qr);
            if (adj) bias_mask_tile(p0, p1, srow - (j * 256 + t * 64) - 4 * hi, true, false, lut);
            float alpha; bf16x8 pa0, pa1, pa2, pa3;
            softmax_tile(p0, p1, m_reg, l_reg, alpha, pa0, pa1, pa2, pa3);
            RESC(o, 4, al_l, alpha);
            pv_tile(o, vb0 + t * SHM_T, pa0, pa1, pa2, pa3);
        }
        LAS int* rd = (LAS int*)al_l;
        const int rec = srow * 3 + slot;
        if (hi == 0) { li_l[r32] = l_reg; rd[r32] = valid ? rec : -1;
            if (valid) { PM[(size_t)rec * 2] = m_reg + (adj ? 0.f : c31); PM[(size_t)rec * 2 + 1] = l_reg; } }
        asm volatile("s_waitcnt lgkmcnt(0)" ::: "memory");
        int r32o = r32, hio = hi; asm volatile("" : "+v"(r32o), "+v"(hio));
#pragma unroll
        for (int r = 0; r < 16; ++r) { const int orow = crow(r, hio); const float rli = __builtin_amdgcn_rcpf(li_l[orow]); const int dst = rd[orow];
#pragma unroll
            for (int d0 = 0; d0 < 4; ++d0) { const float v = o[d0][r] * rli; const float vn = swz_xor<1>(v);
                if ((r32 & 1) == 0 && dst >= 0) *(unsigned*)(PO + (size_t)dst * HD + d0 * 32 + r32o) = cvtpk(v, vn); } }
        asm volatile("s_waitcnt lgkmcnt(0)" ::: "memory");
#pragma unroll
        for (int d0 = 0; d0 < 8; ++d0) qr[d0] = qn[d0];
        ent = entn; valid = validn; entn = entnn; validn = validnn;
    }
#undef GRP_ENT
#undef LOADQ
    WAIT_BAR0();
}

__device__ __forceinline__ void moba_final_unit(LAS unsigned char* lds, const bf16* Qrow0, const bf16* Kh, const bf16* Vh, bf16* Orow0, int qb, const unsigned* selrow, const float* relb, int h, const bf16* PO, const float* PM) {
    const int tid = opaque_tid(), wid = __builtin_amdgcn_readfirstlane(tid >> 6), lane = tid & 63, r32 = lane & 31, hi = lane >> 5;
    LAS float* wsf = (LAS float*)(lds + LDSX_OFF) + wid * 64; LAS float* al_l = wsf + 32;
    LAS float* lut = (LAS float*)(lds + LDSX_OFF + 2048);
    LAS float* ftab = (LAS float*)(lds + LDSX_OFF + 4352) + wid * 128;
    if (tid <= 128) lut[tid] = relb[(tid < 128 ? (int)T5_BUCKET[tid] : 31) * 12 + h] * LOG2E;
    bf16x8 qr[8];
#pragma unroll
    for (int d0 = 0; d0 < 8; ++d0) qr[d0] = *(const bf16x8*)(Qrow0 + (size_t)(wid * 32 + r32) * DM + d0 * 16 + hi * 8);
    const unsigned sel = selrow[wid * 32 + r32];
    const int krow = 4 * wid + (lane >> 4); const unsigned ksrc = (unsigned) krow * 256 + ((16 * (lane & 15)) ^ ((krow & 7) << 4));
    const int vkk = 8 * (wid >> 1) + ((lane & 31) >> 2); const unsigned vsrc = (unsigned) swap23(vkk) * 256 + (32 * (2 * (wid & 1) + (lane >> 5)) + 8 * (lane & 3)) * 2;
    const unsigned lds0 = (unsigned)(uintptr_t)(lds + RING_OFF);
    const char* Kg = (const char*)(Kh + (size_t)qb * 256 * HD); const char* Vg = (const char*)(Vh + (size_t)qb * 256 * HD);
    { const unsigned base_ = (unsigned)__builtin_amdgcn_readfirstlane(lds0 + wid * 1024);
#pragma unroll
      for (int t = 0; t < 4; ++t) { glds16(Kg + t * SHM_T, ksrc, base_ + t * SHM_T); glds16(Kg + t * SHM_T + 8192, ksrc, base_ + t * SHM_T + 8192);
                                    glds16(Vg + t * SHM_T, vsrc, base_ + 65536 + t * SHM_T); glds16(Vg + t * SHM_T + 8192, vsrc, base_ + 65536 + t * SHM_T + 8192); } }
    const int vb0 = (int)lds0 + 65536 + v_rd_base(lane);
    float m_reg = -1e30f, l_reg = 0.f; f32x16 o[4];
#pragma unroll
    for (int d = 0; d < 4; ++d)
#pragma unroll
        for (int r = 0; r < 16; ++r) o[d][r] = 0.f;
    const int qrel = wid * 32 + r32;
    WAIT_BAR0();
#pragma unroll 1
    for (int t = 0; t <= (wid >> 1); ++t) {
        f32x16 p0, p1;
        qkt(p0, p1, (const LAS char*)(lds + RING_OFF + t * SHM_T), r32, hi, qr);
        bias_mask_tile(p0, p1, qrel - t * 64 - 4 * hi, true, false, lut);
        float alpha; bf16x8 pa0, pa1, pa2, pa3;
        softmax_tile(p0, p1, m_reg, l_reg, alpha, pa0, pa1, pa2, pa3);
        RESC(o, 4, al_l, alpha);
        pv_tile(o, vb0 + t * SHM_T, pa0, pa1, pa2, pa3);
    }
    const int nsel = __builtin_popcount(sel); const size_t rec0 = (size_t)(qb * 256 + qrel) * 3;
    float mi[3], li[3]; float M = m_reg;
#pragma unroll
    for (int i = 0; i < 3; ++i) { mi[i] = -1e30f; li[i] = 0.f; if (i < nsel) { mi[i] = PM[(rec0 + i) * 2]; li[i] = PM[(rec0 + i) * 2 + 1]; } M = fmaxf(M, mi[i]); }
    const float wo = __builtin_amdgcn_exp2f(m_reg - M); float L = l_reg * wo; float wi[3];
#pragma unroll
    for (int i = 0; i < 3; ++i) { wi[i] = (i < nsel) ? li[i] * __builtin_amdgcn_exp2f(mi[i] - M) : 0.f; L += wi[i]; }
    const float rL = 1.f / L;
    if (hi == 0) { ftab[r32] = wo * rL; ftab[32 + r32] = wi[0] * rL; ftab[64 + r32] = wi[1] * rL; ftab[96 + r32] = wi[2] * rL; }
    WAIT_BAR0();
    int r32o = r32, hio = hi, laneo = lane; asm volatile("" : "+v"(r32o), "+v"(hio), "+v"(laneo));
    LAS float* X = (LAS float*)(lds + RING_OFF) + wid * 4096;
#pragma unroll
    for (int r = 0; r < 16; ++r) { const int orow = crow(r, hio); const float fo = ftab[orow];
#pragma unroll
        for (int d0 = 0; d0 < 4; ++d0) X[orow * 128 + d0 * 32 + r32o] = o[d0][r] * fo; }
    asm volatile("s_waitcnt lgkmcnt(0)" ::: "memory");
    { const int rg = laneo >> 4, c = laneo & 15;
      unsigned char* Ow = (unsigned char*)Orow0 + (size_t)(wid * 32) * DM + 8 * c;
      const bf16* Pw = PO + ((size_t)(qb * 256 + wid * 32) * 3) * HD + 8 * c;
#pragma unroll 2
      for (int it = 0; it < 8; ++it) { const int row = it * 4 + rg;
          const f32x4 x0 = *(const LAS f32x4*)(X + row * 128 + 8 * c), x1 = *(const LAS f32x4*)(X + row * 128 + 8 * c + 4);
          float v[8] = {x0[0], x0[1], x0[2], x0[3], x1[0], x1[1], x1[2], x1[3]};
#pragma unroll
          for (int i = 0; i < 3; ++i) { const float f = ftab[32 * (i + 1) + row];
              if (f != 0.f) { const v4u w = *(const v4u*)(Pw + ((size_t)row * 3 + i) * HD);
                  v[0] += f * bflo(w.x); v[1] += f * bfhi(w.x); v[2] += f * bflo(w.y); v[3] += f * bfhi(w.y); v[4] += f * bflo(w.z); v[5] += f * bfhi(w.z); v[6] += f * bflo(w.w); v[7] += f * bfhi(w.w); } }
          unsigned w0 = 0u, w1 = 0u;
          w0 = __builtin_amdgcn_cvt_pk_fp8_f32(v[0] * SC_O, v[1] * SC_O, w0, false); w0 = __builtin_amdgcn_cvt_pk_fp8_f32(v[2] * SC_O, v[3] * SC_O, w0, true);
          w1 = __builtin_amdgcn_cvt_pk_fp8_f32(v[4] * SC_O, v[5] * SC_O, w1, false); w1 = __builtin_amdgcn_cvt_pk_fp8_f32(v[6] * SC_O, v[7] * SC_O, w1, true);
          *(v2u*)(Ow + (size_t)row * DM) = (v2u){w0, w1}; } }
    WAIT_BAR0();
}
#undef RESC
}

__device__ __forceinline__ int queue_next(gu32* ctr, LAS unsigned char* lds) {
    volatile LAS int* slot = (volatile LAS int*)(lds + LDSX_OFF + 4096);
    if (threadIdx.x == 0) slot[0] = (int)__hip_atomic_fetch_add(ctr, 1u, RLX_AGENT);
    __syncthreads();
    return __builtin_amdgcn_readfirstlane(slot[0]);
}

__device__ __forceinline__ void phase_moba_sparse(const Args& a, LAS unsigned char* lds, gu32* qctr) {
    unsigned char* ws = opaque_ws(a.ws);
    const bf16* QH = (const bf16*)(ws + WS_QH); const bf16* KH = (const bf16*)(ws + WS_KH); const bf16* VH = (const bf16*)(ws + WS_VH);
    const unsigned* MC = (const unsigned*)(ws + WS_CTL) + CW_MC;
    for (;;) {
        const int uq = queue_next(qctr, lds);
        if (uq >= 744 + CONV_NCH / 2) break;
        const Mix mx = mix_decode(uq, 744, CONV_NCH / 2);
        if (mx.conv) { conv_chunk(a, lds, 0, mx.idx); continue; }
        const int u = mx.idx;
        const int j = u / 24, bh = u % 24, b = bh / 12, h = bh % 12;
        const int cntA = (int)MC[(bh * 32 + j) * 2], cntF = (int)MC[(bh * 32 + j) * 2 + 1];
        const bf16* QHb = QH + (size_t)b * SEQ * DM + h * HD; const bf16* Kblk = KH + ((size_t)bh * SEQ + j * 256) * HD; const bf16* Vblk = VH + ((size_t)bh * SEQ + j * 256) * HD;
        bf16* PO = (bf16*)(ws + WS_PO) + (size_t)bh * SEQ * 3 * HD; float* PM = (float*)(ws + WS_PM) + (size_t)bh * SEQ * 3 * 2;
        att::moba_sparse_unit(lds, QHb, Kblk, Vblk, (const unsigned*)(ws + WS_LISTF) + ((size_t)bh * 32 + j) * 8192, cntF, (const unsigned*)(ws + WS_LISTA) + ((size_t)bh * 32 + j) * 256, cntA, j, PO, PM, a.in[I_RELB], h);
    }
}
__device__ __forceinline__ void phase_attn_a(const Args& a, LAS unsigned char* lds, gu32* qctr) {
    unsigned char* ws = opaque_ws(a.ws);
    const bf16* QH = (const bf16*)(ws + WS_QH); const bf16* KH = (const bf16*)(ws + WS_KH); const bf16* VH = (const bf16*)(ws + WS_VH); bf16* OC = (bf16*)(ws + WS_OCAT);
    const unsigned* SEL = (const unsigned*)(ws + WS_SMALL + SM_SEL);
    for (;;) {
        const int uq = queue_next(qctr, lds);
        if (uq >= 768 + 256 + CONV_NCH / 2) break;
        const Mix mx = mix_decode(uq, 768 + 256, CONV_NCH / 2);
        if (mx.conv) { conv_chunk(a, lds, 0, CONV_NCH / 2 + mx.idx); continue; }
        const int u = mx.idx;
        if (u < 768) { const int qb = 31 - u / 24, bh = u % 24, b = bh / 12, h = bh % 12; const size_t row0 = (size_t)b * SEQ + qb * 256;
            att::moba_final_unit(lds, QH + row0 * DM + h * HD, KH + (size_t)bh * SEQ * HD, VH + (size_t)bh * SEQ * HD, (bf16*)((unsigned char*)OC + row0 * DM + h * HD), qb,
                                 SEL + (size_t)bh * SEQ + qb * 256, a.in[I_RELB], h, (const bf16*)(ws + WS_PO) + (size_t)bh * SEQ * 3 * HD, (const float*)(ws + WS_PM) + (size_t)bh * SEQ * 3 * 2);
        } else { const int v = u - 768, b = v >> 7, hm = (v >> 5) & 3, qb = v & 31; const size_t row0 = (size_t)b * SEQ + qb * 256;
            const size_t mo = (size_t)((0 * 2 + b) * 4 + hm) * NMEM * HD;
            att::attn128_unit<1, true>(lds, QH + row0 * DM + (12 + hm) * HD, (const bf16*)(ws + WS_SMALL + SM_KM) + mo, (const bf16*)(ws + WS_SMALL + SM_VM) + mo, (bf16*)((unsigned char*)OC + row0 * DM + MIXW + hm * HD), 4, 0, nullptr, nullptr, 0);
        }
    }
}
template <int VAR>
__device__ __forceinline__ void phase_attn_b(const Args& a, LAS unsigned char* lds, gu32* qctr, bf16* OC) {
    unsigned char* ws = opaque_ws(a.ws);
    const bf16* QH = (const bf16*)(ws + WS_QH); const bf16* KH = (const bf16*)(ws + WS_KH); const bf16* VH = (const bf16*)(ws + WS_VH);
    float lam;
    { const float* lb = a.in[I_LAMBDA]; const int lane = opaque_tid() & 63;
      float s1 = lb[lane] * lb[128 + lane] + lb[64 + lane] * lb[128 + 64 + lane], s2 = lb[256 + lane] * lb[384 + lane] + lb[256 + 64 + lane] * lb[384 + 64 + lane];
      s1 = wave_sum(s1); s2 = wave_sum(s2); lam = expf(s1) - expf(s2) + LAM_INIT; }
    for (;;) {
        const int uq = queue_next(qctr, lds);
        if (uq >= 768 + 256 + CONV_NCH) break;
        const Mix mx = mix_decode(uq, 768 + 256, CONV_NCH);
        if (mx.conv) { conv_chunk(a, lds, 1, mx.idx); continue; }
        const int u = mx.idx;
        if (u < 768) { const int qblk = 63 - u / 12, bh = u % 12, b = bh / 6, h = bh % 6; const size_t row0 = (size_t)b * SEQ + qblk * 128;
            att::diff_unit<VAR>(lds, QH + row0 * DM, KH + (size_t)(b * 12 + h) * SEQ * HD, KH + (size_t)(b * 12 + 6 + h) * SEQ * HD, VH + (size_t)(b * 6 + h) * SEQ * DV, OC + row0 * DM + h * DV,
                           qblk, a.in[I_RELB], h, lam, a.in[I_SUBLN]);
        } else { const int v = u - 768, b = v >> 7, hm = (v >> 5) & 3, qb = v & 31; const size_t row0 = (size_t)b * SEQ + qb * 256;
            const size_t mo = (size_t)((1 * 2 + b) * 4 + hm) * NMEM * HD;
            att::attn128_unit<1>(lds, QH + row0 * DM + (12 + hm) * HD, (const bf16*)(ws + WS_SMALL + SM_KM) + mo, (const bf16*)(ws + WS_SMALL + SM_VM) + mo, OC + row0 * DM + MIXW + hm * HD, 4, 0, nullptr, nullptr, 0);
        }
    }
}

template <int RV>
__device__ __forceinline__ void phase_router(const Args& a, LAS unsigned char* lds, int G, int vb, int layer) {
    unsigned char* ws = opaque_ws(a.ws);
    const int tid = opaque_tid(), lane = tid & 63, wave = __builtin_amdgcn_readfirstlane(tid >> 6), i16 = lane & 15, g4 = lane >> 4, tg = wave & 1, kq = wave >> 1;
    const bf16* H = (const bf16*)(ws + WS_HB);
    const bf16* WRh = (const bf16*)(ws + WS_W_RT) + (size_t)layer * 2 * NRTP * DM;
    LAS float* L = (LAS float*)(lds + RING_OFF);
    LAS int* cnt = (LAS int*)(lds + RING_OFF + 4 * 64 * NRTP * 4);
    for (int blk = vb; blk < T / 64; blk += G) {
        if (tid < 64) cnt[tid] = 0;
        f32x4 acc[2][5];
#pragma unroll
        for (int t2 = 0; t2 < 2; ++t2)
#pragma unroll
            for (int j = 0; j < 5; ++j) acc[t2][j] = (f32x4){0.f, 0.f, 0.f, 0.f};
        const bf16* hrow = H + (size_t)(blk * 64 + tg * 32 + i16) * DM + kq * 512 + 8 * g4;
        const bf16* wh = WRh + (size_t)i16 * DM + kq * 512 + 8 * g4;
#pragma unroll 4
        for (int ks = 0; ks < ((RV & 1) ? 0 : 16); ++ks) {
            bf16x8 fa[2];
#pragma unroll
            for (int t2 = 0; t2 < 2; ++t2) fa[t2] = *(const bf16x8*)(hrow + (size_t)t2 * 16 * DM + ks * 32);
#pragma unroll
            for (int jt = 0; jt < 5; ++jt) {
                const bf16x8 bh = *(const bf16x8*)(wh + (size_t)jt * 16 * DM + ks * 32);
#pragma unroll
                for (int t2 = 0; t2 < 2; ++t2) acc[t2][jt] = __builtin_amdgcn_mfma_f32_16x16x32_bf16(fa[t2], bh, acc[t2][jt], 0, 0, 0);
            }
        }
#pragma unroll
        for (int t2 = 0; t2 < 2; ++t2)
#pragma unroll
            for (int jt = 0; jt < 5; ++jt)
#pragma unroll
                for (int r = 0; r < 4; ++r) L[(kq * 64 + tg * 32 + t2 * 16 + 4 * g4 + r) * NRTP + jt * 16 + i16] = acc[t2][jt][r];
        __syncthreads();
        if (tid < 64 && !(RV & 2)) {
            const int tok = blk * 64 + tid;
            const float* part = (const float*)(ws + WS_SMALL + SM_PART) + (size_t)tok * 32;
            float ss = 0.f;
#pragma unroll
            for (int i = 0; i < 32; ++i) ss += part[i];
            const float rstd = 1.0f / sqrtf(ss * (1.f / DM) + RMS_EPS);
            const LAS float* l0 = L + tid * NRTP;
            const float* brg = a.in[I_B_RG] + layer * 8; const float* bre = a.in[I_B_RE] + layer * 64;
            float gmax = -__builtin_inff(); int gi = 0; float gl[8];
#pragma unroll
            for (int j = 0; j < 8; ++j) { gl[j] = ((l0[j] + l0[64 * NRTP + j]) + (l0[128 * NRTP + j] + l0[192 * NRTP + j])) * rstd + brg[j]; if (gl[j] > gmax) { gmax = gl[j]; gi = j; } }
            float gs = 0.f;
#pragma unroll
            for (int j = 0; j < 8; ++j) gs += expf(gl[j] - gmax);
            const float pg = 1.f / gs;
            float v0 = -__builtin_inff(), v1 = -__builtin_inff(); int i0 = 0, i1 = 0;
#pragma unroll
            for (int j = 0; j < 8; ++j) { const int ix = 8 + gi * 8 + j; const float e = ((l0[ix] + l0[64 * NRTP + ix]) + (l0[128 * NRTP + ix] + l0[192 * NRTP + ix])) * rstd + bre[gi * 8 + j];
                if (e > v0) { v1 = v0; i1 = i0; v0 = e; i0 = j; } else if (e > v1) { v1 = e; i1 = j; } }
            const float dd = expf(v1 - v0), w0 = pg / (1.f + dd), w1 = pg * dd / (1.f + dd);
            const int e0 = gi * 8 + i0, e1 = gi * 8 + i1;
            v4u tr; tr.x = (unsigned)e0; tr.y = (unsigned)e1; tr.z = __float_as_uint(w0); tr.w = __float_as_uint(w1);
            *(v4u*)(ws + WS_SMALL + SM_TOKR + (size_t)tok * 16) = tr;
            ((float*)(ws + WS_SMALL + SM_RSTD))[tok] = rstd;
            __hip_atomic_fetch_add(cnt + e0, 1, __ATOMIC_RELAXED, __HIP_MEMORY_SCOPE_WORKGROUP);
            __hip_atomic_fetch_add(cnt + e1, 1, __ATOMIC_RELAXED, __HIP_MEMORY_SCOPE_WORKGROUP);
        }
        __syncthreads();
        if (tid < 64 && !(RV & 2)) ((int*)(ws + WS_SMALL + SM_CNT))[blk * 64 + tid] = cnt[tid];
        __syncthreads();
    }
}

__device__ __forceinline__ void phase_gather(const Args& a, LAS unsigned char* lds, int G, int vb) {
    unsigned char* ws = opaque_ws(a.ws);
    const int tid = opaque_tid(), lane = tid & 63, wave = __builtin_amdgcn_readfirstlane(tid >> 6);
    const int* CNT = (const int*)(ws + WS_SMALL + SM_CNT); int* BLKE = (int*)(ws + WS_SMALL + SM_BLKE); int* DEST = (int*)(ws + WS_SMALL + SM_DEST);
    const unsigned* TOKR = (const unsigned*)(ws + WS_SMALL + SM_TOKR);
    int* ROWTOK = (int*)(ws + WS_SMALL + SM_ROWTOK);
    LAS int* tot = (LAS int*)(lds + RING_OFF); LAS int* pre = tot + 64; LAS int* pst = tot + 128; LAS int* destl = tot + 192;
    LAS int* part8 = tot + 320;
    LAS int* tokl = tot + 320 + 1024;
    for (int blk = vb; blk < T / 64; blk += G) {
        { const int e = tid & 63, p8 = tid >> 6; int t_ = 0, p_ = 0;
#pragma unroll 8
          for (int b2 = p8 * 32; b2 < p8 * 32 + 32; ++b2) { const int c = CNT[b2 * 64 + e]; t_ += c; p_ += (b2 < blk) ? c : 0; }
          part8[(p8 * 64 + e) * 2] = t_; part8[(p8 * 64 + e) * 2 + 1] = p_;
          if (tid < 128) tokl[tid] = (int)TOKR[(size_t)(blk * 64 + (tid >> 1)) * 4 + (tid & 1)]; }
        __syncthreads();
        if (tid < 64) { int t_ = 0, p_ = 0;
#pragma unroll
            for (int p8 = 0; p8 < 8; ++p8) { t_ += part8[(p8 * 64 + tid) * 2]; p_ += part8[(p8 * 64 + tid) * 2 + 1]; }
            tot[tid] = t_; pre[tid] = p_;
            const int padded = ((t_ + 255) >> 8) << 8; int incl = padded;
#pragma unroll
            for (int o = 1; o < 64; o <<= 1) { const int up = __shfl_up(incl, o); if (tid >= o) incl += up; }
            pst[tid] = incl - padded;
            if (blk == 0 && tid == 63) BLKE[MAXRB] = incl >> 8; }
        __syncthreads();
        if (tid < 64) {
            if (blk == 0) { const int rb0 = pst[tid] >> 8, rb1 = (pst[tid] + (((tot[tid] + 255) >> 8) << 8)) >> 8; for (int rb = rb0; rb < rb1; ++rb) BLKE[rb] = tid; }
            int r = pst[tid] + pre[tid];
            for (int as = 0; as < 128; ++as) { if (tokl[as] == tid) destl[as] = r++; }
        }
        __syncthreads();
        if (tid < 128) { const int tok = blk * 64 + (tid >> 1), dest = destl[tid]; DEST[tok * 2 + (tid & 1)] = dest; ROWTOK[dest] = tok; }
        if (blk < 64) {
            const int r0 = pst[blk] + tot[blk], r1 = pst[blk] + (((tot[blk] + 255) >> 8) << 8);
            for (int r = r0 + tid; r < r1; r += 512) ROWTOK[r] = 0;
        }
        __syncthreads();
    }
}

__device__ __forceinline__ void phase_combine(const Args& a, int G, int vb, float* Fout  ) {
    unsigned char* ws = opaque_ws(a.ws);
    const int tid = opaque_tid(), lane = tid & 63, wave = __builtin_amdgcn_readfirstlane(tid >> 6);
    const int gw = vb * 8 + wave, NGW = G * 8;
    const bf16* YS = (const bf16*)(ws + WS_YS); const int* DEST = (const int*)(ws + WS_SMALL + SM_DEST); float* RSTD = (float*)(ws + WS_SMALL + SM_RSTD); bf16* HB = (bf16*)(ws + WS_HB);
    for (int tok = gw; tok < T; tok += NGW) {
        const v4u tr = *(const v4u*)(ws + WS_SMALL + SM_TOKR + (size_t)tok * 16); const float w0 = __uint_as_float(tr.z), w1 = __uint_as_float(tr.w);
        const int d0 = DEST[tok * 2], d1 = DEST[tok * 2 + 1];
        GAS v2u* hr = (GAS v2u*)(HB + (size_t)tok * DM) + lane;
        const GAS v2u* y0 = (const GAS v2u*)(YS + (size_t)d0 * DM) + lane; const GAS v2u* y1 = (const GAS v2u*)(YS + (size_t)d1 * DM) + lane;
        v2u hv[8], a0[8], a1[8];
#pragma unroll
        for (int j = 0; j < 8; ++j) { hv[j] = hr[64 * j]; a0[j] = y0[64 * j]; a1[j] = y1[64 * j]; }
        float ss = 0.f;
#pragma unroll
        for (int j = 0; j < 8; ++j) { f32x4 v;
            v.x = bflo(hv[j].x) + (w0 * bflo(a0[j].x) + w1 * bflo(a1[j].x)); v.y = bfhi(hv[j].x) + (w0 * bfhi(a0[j].x) + w1 * bfhi(a1[j].x));
            v.z = bflo(hv[j].y) + (w0 * bflo(a0[j].y) + w1 * bflo(a1[j].y)); v.w = bfhi(hv[j].y) + (w0 * bfhi(a0[j].y) + w1 * bfhi(a1[j].y));
            ss += (v.x * v.x + v.y * v.y) + (v.z * v.z + v.w * v.w);
            if (Fout) ((GAS f32x4*)(Fout + (size_t)tok * DM) + lane)[64 * j] = v;
            else { v2u o; o.x = pk2(v.x, v.y); o.y = pk2(v.z, v.w); hr[64 * j] = o;
                   unsigned w8 = 0u; w8 = __builtin_amdgcn_cvt_pk_fp8_f32(v.x, v.y, w8, false); w8 = __builtin_amdgcn_cvt_pk_fp8_f32(v.z, v.w, w8, true); ((GAS unsigned*)(ws + WS_HB8 + (size_t)tok * DM) + lane)[64 * j] = w8; } }
        if (!Fout) { const float rstd = 1.0f / sqrtf(wave_sum(ss) * (1.f / DM) + RMS_EPS); if (lane == 0) RSTD[tok] = rstd; }
    }
}

#ifndef MK_DUP
#define MK_DUP -1
#endif
#define DUP(k) (MK_DUP == (k))
#ifndef MK_VAR
#define MK_VAR 0
#endif
#ifndef FP8IN_SP2
#define FP8IN_SP2 true
#endif
constexpr int NPH = 21;
__global__ void __launch_bounds__(512, 2) yoco_fwd(Args args) {
    extern __shared__ __attribute__((aligned(16))) unsigned char lds_raw[];
    LAS unsigned char* lds = (LAS unsigned char*)lds_raw;
    const int tid = opaque_tid();
    const int G = gridDim.x; const int bx0 = blockIdx.x; const int vb = (G % 8 == 0) ? (bx0 % 8) * (G / 8) + bx0 / 8 : bx0;
    unsigned char* ws = args.ws;
    gu32* ctl = (gu32*)(ws + WS_CTL);
    for (int u = tid; u < (LDS_BYTES - LDSCTL_OFF) / 4; u += 512) ((LAS unsigned*)(lds + LDSCTL_OFF))[u] = 0u;
    __syncthreads();
    volatile LAS unsigned* MISC = (volatile LAS unsigned*)(lds + MISC_OFF);
#if MK_N_LAUNCHES == 1
    constexpr int lo = 0, hi = NPH; constexpr bool one = true;
#else
    const int lo = args.ph_lo, hi = args.ph_hi;
    const bool one = (hi - lo) > 1;
#endif
    XcdBarrier bar; bar.bar = (unsigned*)(ctl + CW_BAR); bar.x = 0; bar.st = nullptr;
    if (one) bar = xcd_barrier_post((unsigned*)(ctl + CW_BAR), MISC + 8);
#define GBAR() do { XcdBarrier b2_ = bar; b2_.bar = (unsigned*)opaque_ws((unsigned char*)bar.bar); { unsigned x_ = bar.x; asm volatile("" : "+s"(x_)); b2_.x = x_; } xcd_barrier(b2_); } while (0)
#define IN(k) (lo <= (k) && (k) < hi)
#define SEAM(k) do { if (IN(k) && IN((k) + 1)) GBAR(); } while (0)

#define RUN(k, ...) do { if (IN(k)) { __VA_ARGS__ if (DUP(k)) { __syncthreads(); __VA_ARGS__ } } } while (0)
    RUN(0, phase_prep(args, lds, G, vb););
    SEAM(0);
    for (int l = 0; l < 2; ++l) {
        const int pb = 1 + 10 * l;
        int bx = bx0; asm volatile("" : "+s"(bx));
        RUN(pb + 0,
            { pg8::Gemm g{(const bf16*)(ws + WS_HB8), (const bf16*)(ws + (l == 0 ? WS_W_INA : WS_W_INB)), T, PROJW, DM / 2}; pg8::StaticOrder S; S.init(T, PROJW, G, bx);
              EpiHeadNorm E{ws, l, 1.f / SC_W1};
              pg8::gemm_phase<EpiHeadNorm, pg8::StaticOrder, true, FP8IN_SP2, false, true>(lds + RING_OFF, g, S, E); }
            );
        if (one) GBAR();
        if (l == 0) { if (IN(pb + 2)) {
                if (bx < 16) { pg8::Gemm g{(const bf16*)(ws + WS_SMALL + SM_MEMN), (const bf16*)(ws + WS_W_MKV), NB * NMEM, 2048, DM}; pg8::StaticOrder S; S.init(NB * NMEM, 2048, G, bx);
                    EpiRowScale E{(bf16*)(ws + WS_SMALL + SM_KVM), 2048, nullptr, 0, 1.f};
                    pg8::gemm_phase<EpiRowScale, pg8::StaticOrder, true, true>(lds + RING_OFF, g, S, E); }
                else phase_gate(args, lds, G - 16, bx - 16); }
            if (one) GBAR(); }
        if (IN(pb + 3)) { if (l == 0) { phase_post_mem(args, lds, G, vb); phase_moba_sparse(args, lds, ctl + CW_Q + 256); if (DUP(40)) { __syncthreads(); phase_moba_sparse(args, lds, ctl + CW_Q + 320); } if (one) GBAR(); phase_attn_a(args, lds, ctl + CW_Q); if (DUP(41)) { __syncthreads(); phase_attn_a(args, lds, ctl + CW_Q + 128); } }
            else { phase_attn_b<0>(args, lds, ctl + CW_Q + 64, (bf16*)(ws + WS_OCAT)); if (DUP(14)) { __syncthreads(); phase_attn_b<MK_VAR>(args, lds, ctl + CW_Q + 192, (bf16*)(ws + WS_YS)); } } }
        SEAM(pb + 3);
        RUN(pb + 4,
            { pg8::Gemm g{(const bf16*)(ws + WS_OCAT), (const bf16*)(ws + WS_W_OUT) + (size_t)l * DM * DM, T, DM, DM}; pg8::StaticOrder S; S.init(T, DM, G, bx);
              if (l == 0) { pg8::Gemm g8{(const bf16*)(ws + WS_OCAT), (const bf16*)(ws + WS_W_OUT), T, DM, DM / 2};
                EpiOutProj<true> E{args.in[I_X], (float*)(ws + WS_SMALL + SM_PART), (bf16*)(ws + WS_HB), ws + WS_HB8, 1.f / (SC_O * SC_W1)}; pg8::gemm_phase<EpiOutProj<true>, pg8::StaticOrder, true, true, false, true>(lds + RING_OFF, g8, S, E); }
              else { EpiOutProj<false> E{nullptr, (float*)(ws + WS_SMALL + SM_PART), (bf16*)(ws + WS_HB), ws + WS_HB8, 1.f}; pg8::gemm_phase<EpiOutProj<false>, pg8::StaticOrder, true, true>(lds + RING_OFF, g, S, E); } });
        SEAM(pb + 4);
        if (IN(pb + 5)) { phase_router<0>(args, lds, G, vb, l); if (DUP(pb + 5)) { __syncthreads(); phase_router<MK_VAR>(args, lds, G, vb, l); } }
        SEAM(pb + 5);
        RUN(pb + 6, phase_gather(args, lds, G, vb););
        SEAM(pb + 6);
        RUN(pb + 7,
            { const int* blke = (const int*)(ws + WS_SMALL + SM_BLKE);
              const int* rowtok = (const int*)(ws + WS_SMALL + SM_ROWTOK);
              pg8::Gemm g{(const bf16*)(ws + WS_HB8), (const bf16*)(ws + WS_W_E1 + (size_t)l * NEXP * 1024 * DM), MAXRB * 256, 1024, DM / 2, rowtok};
              MoeOrder S{blke, blke[MAXRB] * 4, 4, G, bx}; EpiSiluMul E{(bf16*)(ws + WS_HID), (const float*)(ws + WS_SMALL + SM_RSTD), rowtok};
              pg8::gemm_phase<EpiSiluMul, MoeOrder, true, true, true, true>(lds + RING_OFF, g, S, E); });
        SEAM(pb + 7);
        RUN(pb + 8,
            { const int* blke = (const int*)(ws + WS_SMALL + SM_BLKE);
              pg8::Gemm g{(const bf16*)(ws + WS_HID), (const bf16*)(ws + WS_W_E2 + (size_t)l * NEXP * DM * EFF), MAXRB * 256, DM, EFF / 2};
              MoeOrder S{blke, blke[MAXRB] * 8, 8, G, bx}; EpiRowScale E{(bf16*)(ws + WS_YS), DM, nullptr, 8, 1.f / (SC_HID * SC_W2)};
              pg8::gemm_phase<EpiRowScale, MoeOrder, true, true, false, true>(lds + RING_OFF, g, S, E); });
        SEAM(pb + 8);
        if (IN(pb + 9)) phase_combine(args, G, vb, l == 0 ? nullptr : args.out);
        if (l == 0) SEAM(pb + 9);
    }
#undef RUN
#undef IN
#undef SEAM
}

extern "C" void kernel_launch(void* const* d_in, const int* in_sizes, int n_in, void* d_out, int out_size, void* d_ws, size_t ws_size, hipStream_t stream) {
    static int grid = 0;
    if (grid == 0) {
        if (n_in != N_IN || out_size != T * DM || ws_size < WS_END) { fprintf(stderr, "kernel_launch: unexpected shapes (n_in %d out %d ws %zu)\n", n_in, out_size, ws_size); grid = -1; return; }
        int dev = 0, cus = 0;
        if (hipGetDevice(&dev) != hipSuccess || hipDeviceGetAttribute(&cus, hipDeviceAttributeMultiprocessorCount, dev) != hipSuccess) { grid = -1; return; }
        if (hipFuncSetAttribute((const void*)yoco_fwd, hipFuncAttributeMaxDynamicSharedMemorySize, LDS_BYTES) != hipSuccess) { fprintf(stderr, "kernel_launch: hipFuncSetAttribute failed\n"); grid = -1; return; }
        int per_cu = 0;
        if (hipOccupancyMaxActiveBlocksPerMultiprocessor(&per_cu, (const void*)yoco_fwd, 512, LDS_BYTES) != hipSuccess || per_cu < 1) fprintf(stderr, "kernel_launch: occupancy query reports %d\n", per_cu);
        (void)hipGetLastError();
        grid = cus;
    }
    if (grid < 0) return;
    (void)hipMemsetAsync((char*)d_ws + WS_CTL, 0, CTL_ZERO_BYTES, stream);
    Args a{};
    for (int i = 0; i < N_IN; ++i) a.in[i] = (const float*)d_in[i];
    a.out = (float*)d_out; a.ws = (unsigned char*)d_ws;
#if MK_N_LAUNCHES == 1
    a.ph_lo = 0; a.ph_hi = NPH;
    hipLaunchKernelGGL(yoco_fwd, dim3(grid), dim3(512), LDS_BYTES, stream, a);
#else
    for (int p = 0; p < NPH; ++p) { if (p == 13) continue; a.ph_lo = p; a.ph_hi = p + 1; hipLaunchKernelGGL(yoco_fwd, dim3(grid), dim3(512), LDS_BYTES, stream, a); }
#endif
}
```

```cpp
#include <hip/hip_runtime.h>
#include <cstdio>
#include <cstdint>

#ifndef MK_N_LAUNCHES
#define MK_N_LAUNCHES 1
#endif
#ifndef MK_CHECK
#define MK_CHECK 0
#endif

constexpr int NB = 2, SEQ = 8192, T = NB * SEQ, DM = 2048, HD = 128;
constexpr int NMEM = 256, MEMH = 4, MEMW = 512, MIXW = 1536, MOBA_H = 12, DIFF_H = 6, DV = 256;
constexpr int NEXP = 64, NGRP = 8, EPG = 8, EFF = 512, NRT = 72, NRTP = 80;
constexpr int PROJW = 5120;
constexpr float RMS_EPS = 1e-6f;
constexpr float LOG2E = 1.4426950408889634f;
constexpr float QSCALE = 0.08838834764831845f * LOG2E;
constexpr float LAM_INIT = 0.35550906759096926f;
constexpr int MAXRB = 192;
constexpr float SC_W1 = 64.f, SC_W2 = 32.f, SC_HID = 8.f, SC_O = 16.f;

constexpr size_t MiB = 1u << 20;
constexpr size_t WS_CTL = 0, CTL_ZERO_BYTES = 1 * MiB;
constexpr size_t WS_W_INA = 1 * MiB;
constexpr size_t WS_W_INB = 21 * MiB;
constexpr size_t WS_W_OUT = 41 * MiB;
constexpr size_t WS_W_MKV = 57 * MiB;
constexpr size_t WS_W_RT  = 65 * MiB;
constexpr size_t WS_W_E1  = 67 * MiB;
constexpr size_t WS_HB8   = 323 * MiB;
constexpr size_t WS_W_E2  = 579 * MiB;
constexpr size_t WS_SMALL = 835 * MiB;
constexpr size_t WS_HB    = 851 * MiB;
constexpr size_t WS_PROJ  = 915 * MiB;
constexpr size_t WS_QH    = 1075 * MiB;
constexpr size_t WS_KH    = 1139 * MiB;
constexpr size_t WS_VH    = 1187 * MiB;
constexpr size_t WS_XS    = WS_PROJ;
constexpr size_t WS_OCAT  = 1235 * MiB;
constexpr size_t WS_HID   = 1299 * MiB;
constexpr size_t WS_YS    = 1347 * MiB;
constexpr size_t WS_HA    = 1539 * MiB;
constexpr size_t WS_H2    = 1667 * MiB;
constexpr size_t WS_LISTF = 1795 * MiB;
constexpr size_t WS_LISTA = 1821 * MiB;
constexpr size_t WS_PM    = 1822 * MiB;
constexpr size_t WS_PO    = WS_PROJ;
constexpr size_t WS_END   = 1827 * MiB;
static_assert(WS_XS + (size_t)MAXRB * 256 * 2048 * 2 <= WS_VH, "XS alias");
constexpr size_t SM_RSTD  = 0;
constexpr size_t SM_PART  = 1 * MiB;
constexpr size_t SM_TOKR  = 3 * MiB;
constexpr size_t SM_DEST  = 4 * MiB;
constexpr size_t SM_CNT   = 5 * MiB;
constexpr size_t SM_BLKE  = 5 * MiB + 128 * 1024;
constexpr size_t SM_KMEAN = 6 * MiB;
constexpr size_t SM_SEL   = 7 * MiB;
constexpr size_t SM_MEMN  = 8 * MiB;
constexpr size_t SM_KVM   = 10 * MiB;
constexpr size_t SM_KM    = 12 * MiB;
constexpr size_t SM_VM    = 13 * MiB;
constexpr size_t SM_GAINTAB = 15 * MiB;
constexpr size_t SM_ROWTOK = 14 * MiB;
constexpr int CW_BAR = 4096;
constexpr int CW_Q = 8192;
constexpr int CW_MC = 16384;

constexpr int RING_OFF = 0, RING_BYTES = 131072;
constexpr int LDSX_OFF = RING_BYTES;
constexpr int LDSCTL_OFF = RING_BYTES + 12288, MISC_OFF = LDSCTL_OFF + 320;
constexpr int LDS_BYTES = 147456;
static_assert(MISC_OFF + 128 <= LDS_BYTES, "LDS map");

#define GAS __attribute__((address_space(1)))
#define LAS __attribute__((address_space(3)))
typedef unsigned short bf16;
typedef unsigned v4u __attribute__((ext_vector_type(4)));
typedef unsigned v2u __attribute__((ext_vector_type(2)));
typedef float f32x4 __attribute__((ext_vector_type(4)));
typedef float f32x16 __attribute__((ext_vector_type(16)));
typedef short bf16x8 __attribute__((ext_vector_type(8)));
typedef short s16x4 __attribute__((ext_vector_type(4)));
typedef GAS unsigned gu32;
#define RLX_AGENT __ATOMIC_RELAXED, __HIP_MEMORY_SCOPE_AGENT
#define LDS_WAIT() asm volatile("s_waitcnt lgkmcnt(0)" ::: "memory")
#define VM_WAIT() asm volatile("s_waitcnt vmcnt(0)" ::: "memory")
__device__ __forceinline__ unsigned f2bf(float f) { unsigned u = __builtin_bit_cast(unsigned, f); return (u + 0x7fffu + ((u >> 16) & 1u)) >> 16; }
__device__ __forceinline__ unsigned pk2(float lo, float hi) { return f2bf(lo) | (f2bf(hi) << 16); }
__device__ __forceinline__ float bf2f(unsigned short b) { return __builtin_bit_cast(float, (unsigned)b << 16); }
__device__ __forceinline__ float bflo(unsigned w) { return __builtin_bit_cast(float, w << 16); }
__device__ __forceinline__ float bfhi(unsigned w) { return __builtin_bit_cast(float, w & 0xffff0000u); }
template <int M> __device__ __forceinline__ float swz_xor(float v) { return __builtin_bit_cast(float, __builtin_amdgcn_ds_swizzle(__builtin_bit_cast(int, v), (M << 10) | 0x1F)); }
__device__ __forceinline__ float add_xor32(float v) {
    auto r = __builtin_amdgcn_permlane32_swap(__float_as_uint(v), __float_as_uint(v), false, false);
    return __uint_as_float(r[0]) + __uint_as_float(r[1]); }
__device__ __forceinline__ float wave_sum(float v) {
    v += swz_xor<1>(v); v += swz_xor<2>(v); v += swz_xor<4>(v); v += swz_xor<8>(v); v += swz_xor<16>(v);
    return add_xor32(v);
}
__device__ const unsigned char T5_BUCKET[128] = {
 0, 1, 2, 3, 4, 5, 6, 7, 8, 9, 10, 11, 12, 13, 14, 15, 16, 16, 16, 17, 17, 18, 18, 18, 19, 19, 19, 20, 20, 20, 20, 21, 21, 21, 21, 22, 22, 22, 22, 22, 23, 23, 23, 23, 23, 23, 24, 24, 24, 24, 24, 24, 25, 25, 25, 25, 25, 25, 25, 26, 26, 26, 26, 26, 26, 26, 26, 27, 27, 27, 27, 27, 27, 27, 27, 27, 27, 28, 28, 28, 28, 28, 28, 28, 28, 28, 28, 29, 29, 29, 29, 29, 29, 29, 29, 29, 29, 29, 29, 30, 30, 30, 30, 30, 30, 30, 30, 30, 30, 30, 30, 30, 30, 31, 31, 31, 31, 31, 31, 31, 31, 31, 31, 31, 31, 31, 31, 31};

__device__ __forceinline__ int opaque_tid() { int t = threadIdx.x; asm volatile("" : "+v"(t)); return t; }

__device__ __forceinline__ unsigned char* opaque_ws(unsigned char* p) { asm volatile("" : "+s"(p)); return p; }
namespace pg8 {
#define PG8_LAS __attribute__((address_space(3)))
typedef unsigned short bf16_t;
typedef short bf16x8 __attribute__((ext_vector_type(8)));
typedef float f32x4 __attribute__((ext_vector_type(4)));
typedef unsigned u32x4 __attribute__((ext_vector_type(4)));
constexpr int BM = 256, BK = 64, HALF = 128, HTB = HALF * BK * 2  , STAGE_BYTES = 8 * HTB, NXCD = 8, WGM = 8;

__host__ __device__ __forceinline__ int lds_byte(int r, int c) { const int st = (r >> 4) * 2 + (c >> 5), rr = r & 15, cc = c & 31, ob = rr * 64 + cc * 2; return st * 1024 + (ob ^ (((ob >> 9) & 1) << 5)); }
__host__ __device__ __forceinline__ void stage_rc(int b, int& R, int& C) { const int st = b / 1024, sb = b % 1024, swz = sb ^ (((sb >> 9) & 1) << 5); R = (st >> 1) * 16 + swz / 64; C = (st & 1) * 32 + (swz % 64) / 2; }
__host__ __device__ __forceinline__ int perm32(int rho) { const int n = rho >> 4, i = rho & 15; return 8 * (i >> 2) + 4 * n + (i & 3); }

struct Unit { int pm, pn; };
struct Gemm { const bf16_t* A; const bf16_t* Bt; int M, N, K; const int* rowtok; };

struct StaticOrder {
    int nM, nN, nwg, G, c;
    __host__ __device__ void init(int M, int N, int G_, int c_) { nM = M / BM; nN = N / BM; nwg = nM * nN; G = G_; c = c_; }
    __host__ __device__ bool next(int i, Unit& u) const {
        const long L = (long)i * G + c; if (L >= nwg) return false;
        int wgid = (int)L; { const int q = nwg / NXCD, r = nwg % NXCD, xcd = wgid % NXCD, off = wgid / NXCD; wgid = (xcd < r ? xcd * (q + 1) : r * (q + 1) + (xcd - r) * q) + off; }
        const int nig = WGM * nN, gid = wgid / nig, fm = gid * WGM, gsz = (nM - fm) < WGM ? (nM - fm) : WGM;
        u.pm = fm + ((wgid % nig) % gsz); u.pn = (wgid % nig) / gsz; return true;
    }
    __device__ __forceinline__ void a_ready(const Unit&) const {}
    __device__ __forceinline__ void done(const Unit&) const {}
};

__device__ __forceinline__ unsigned cvt_pk_bf16(float lo, float hi) { unsigned r; asm volatile("v_cvt_pk_bf16_f32 %0, %1, %2" : "=v"(r) : "v"(lo), "v"(hi)); return r; }
typedef float f32x2 __attribute__((ext_vector_type(2)));
template <class Epi, class Sched, bool ALIGN_EPI = false, bool SP2 = false, bool GATHER = false, bool FP8 = false>
__device__ __forceinline__ void gemm_phase(PG8_LAS unsigned char* lds, const Gemm g, const Sched& S, const Epi& E) {
    const int tid = opaque_tid(), wid = __builtin_amdgcn_readfirstlane(tid >> 6), lane = tid & 63, wr = wid >> 2, wc = wid & 3, fr = lane & 15, fq = lane >> 4;
    const int K = g.K, nt = K / BK;
    unsigned voffA[2], voffB[2]; int RA[2]; unsigned CA2[2];
#pragma unroll
    for (int i = 0; i < 2; ++i) { int R, C; stage_rc(tid * 16 + i * 8192, R, C); const int Rb = Epi::PERM ? ((R & ~31) + perm32(R & 31)) : R;
        voffA[i] = (unsigned)(R * K + C) * 2u; voffB[i] = (unsigned)(Rb * K + C) * 2u; RA[i] = R; CA2[i] = (unsigned)C * 2u; }
    const size_t kstep = (size_t)(BK * 2);
    const size_t hstep = (size_t)HALF * K * 2;
    const size_t tstep = 2 * hstep;
    const unsigned ldsw = (unsigned)wid * 1024u;
    const int aoff = lds_byte(wr * 64 + fr, fq * 8), boff = lds_byte(wc * 32 + fr, fq * 8);
#define PG8_SA(b, h) (((b) * 2 + (h)) * HTB)
#define PG8_SB(b, h) ((4 + (b) * 2 + (h)) * HTB)
#define PG8_STAGE(bufoff, gbase, voff) do { _Pragma("unroll") for (int _i = 0; _i < 2; ++_i) \
        __builtin_amdgcn_global_load_lds((const unsigned*)((const char*)(gbase) + (voff)[_i]), (PG8_LAS unsigned*)(lds + (bufoff) + ldsw + _i * 8192), 16, 0, 0); } while (0)
    unsigned gc[2][2], gn[2][2];
#define PG8_GOFF(dst, pm_) do { _Pragma("unroll") for (int _h = 0; _h < 2; ++_h) _Pragma("unroll") for (int _i = 0; _i < 2; ++_i) \
        dst[_h][_i] = (unsigned)g.rowtok[(pm_) * BM + _h * HALF + RA[_i]] * (unsigned)(K * 2) + CA2[_i]; } while (0)
#define PG8_STAGE_A(bufoff, ptr, half, usenext) do { if constexpr (GATHER) { _Pragma("unroll") for (int _i = 0; _i < 2; ++_i) \
        __builtin_amdgcn_global_load_lds((const unsigned*)((const char*)(ptr) + ((usenext) ? gn[half][_i] : gc[half][_i])), (PG8_LAS unsigned*)(lds + (bufoff) + ldsw + _i * 8192), 16, 0, 0); } \
        else { PG8_STAGE(bufoff, (ptr) + (half) * hstep, voffA); } } while (0)
#define PG8_LDA(dst, b, h) do { if constexpr (FP8) { _Pragma("unroll") for (int m = 0; m < 4; ++m) dst##8[m] = PG8_CAT(*(const PG8_LAS bf16x8*)(lds + PG8_SA(b, h) + aoff + m * 2048), *(const PG8_LAS bf16x8*)(lds + PG8_SA(b, h) + aoff + m * 2048 + 1024)); } \
        else { _Pragma("unroll") for (int m = 0; m < 4; ++m) _Pragma("unroll") for (int k = 0; k < 2; ++k) dst[m][k] = *(const PG8_LAS bf16x8*)(lds + PG8_SA(b, h) + aoff + m * 2048 + k * 1024); } } while (0)
#define PG8_LDB(dst, b, h) do { if constexpr (FP8) { _Pragma("unroll") for (int n = 0; n < 2; ++n) dst##8[n] = PG8_CAT(*(const PG8_LAS bf16x8*)(lds + PG8_SB(b, h) + boff + n * 2048), *(const PG8_LAS bf16x8*)(lds + PG8_SB(b, h) + boff + n * 2048 + 1024)); } \
        else { _Pragma("unroll") for (int n = 0; n < 2; ++n) _Pragma("unroll") for (int k = 0; k < 2; ++k) dst[n][k] = *(const PG8_LAS bf16x8*)(lds + PG8_SB(b, h) + boff + n * 2048 + k * 1024); } } while (0)
typedef int pg8_v8i __attribute__((ext_vector_type(8))); typedef int pg8_v4i __attribute__((ext_vector_type(4)));
#define PG8_CAT(x0, x1) __builtin_shufflevector(__builtin_bit_cast(pg8_v4i, x0), __builtin_bit_cast(pg8_v4i, x1), 0, 1, 2, 3, 4, 5, 6, 7)
#define PG8_MMA(ai, bj, At, Bt) do { __builtin_amdgcn_s_setprio(1); if constexpr (FP8) { _Pragma("unroll") for (int m = 0; m < 4; ++m) _Pragma("unroll") for (int n = 0; n < 2; ++n) \
        asm volatile("v_mfma_scale_f32_16x16x128_f8f6f4 %0, %1, %2, %0, %3, %3 op_sel_hi:[0,0,0]" : "+v"(acc[ai][bj][m][n]) : "v"(Bt##8[n]), "v"(At##8[m]), "v"(pg8_scale1)); } \
        else { _Pragma("unroll") for (int m = 0; m < 4; ++m) _Pragma("unroll") for (int n = 0; n < 2; ++n) _Pragma("unroll") for (int k = 0; k < 2; ++k) \
        acc[ai][bj][m][n] = __builtin_amdgcn_mfma_f32_16x16x32_bf16(Bt[n][k], At[m][k], acc[ai][bj][m][n], 0, 0, 0); } __builtin_amdgcn_s_setprio(0); } while (0)
#define PG8_WAIT_V(n) asm volatile("s_waitcnt vmcnt(" #n ")" ::: "memory")
#define PG8_WAIT_L(n) asm volatile("s_waitcnt lgkmcnt(" #n ")" ::: "memory")
#define PG8_BAR __builtin_amdgcn_s_barrier()
#define PG8_SCHED __builtin_amdgcn_sched_barrier(0)
    Unit cur, nxt; int ui = 0;
    if (!S.next(0, cur)) return;
    f32x4 acc[2][2][4][2];
#pragma unroll
    for (int a = 0; a < 2; ++a)
#pragma unroll
        for (int b = 0; b < 2; ++b)
#pragma unroll
            for (int m = 0; m < 4; ++m)
#pragma unroll
                for (int n = 0; n < 2; ++n) acc[a][b][m][n] = (f32x4){0.f, 0.f, 0.f, 0.f};
    int pg8_scale1 = 0x7F7F7F7F; asm volatile("" : "+v"(pg8_scale1));
    bf16x8 At[4][2], B0[2][2], B1[2][2]; pg8_v8i At8[4], B08[2], B18[2];
    const char* cA = GATHER ? (const char*)g.A : (const char*)g.A + (size_t)cur.pm * tstep; const char* cB = (const char*)g.Bt + (size_t)cur.pn * tstep;
    if constexpr (GATHER) { PG8_GOFF(gc, cur.pm); }
    S.a_ready(cur);
    if constexpr (SP2) {
        PG8_STAGE(PG8_SB(0, 0), cB, voffB); PG8_STAGE(PG8_SB(0, 1), cB + hstep, voffB); PG8_STAGE_A(PG8_SA(0, 0), cA, 0, false); PG8_STAGE_A(PG8_SA(0, 1), cA, 1, false);
        if (wr == 1) PG8_BAR;
        PG8_WAIT_V(2); PG8_BAR;
        PG8_STAGE(PG8_SB(1, 0), cB + kstep, voffB); PG8_STAGE_A(PG8_SA(1, 0), cA + kstep, 0, false); PG8_STAGE(PG8_SB(1, 1), cB + hstep + kstep, voffB);
        PG8_WAIT_V(6); PG8_BAR;
    } else {
        PG8_STAGE(PG8_SB(0, 0), cB, voffB); PG8_STAGE_A(PG8_SA(0, 0), cA, 0, false); PG8_STAGE(PG8_SB(0, 1), cB + hstep, voffB); PG8_STAGE_A(PG8_SA(0, 1), cA, 1, false);
        if (wr == 1) PG8_BAR;
        PG8_WAIT_V(4); PG8_BAR;
        PG8_STAGE(PG8_SB(1, 0), cB + kstep, voffB); PG8_STAGE_A(PG8_SA(1, 0), cA + kstep, 0, false); PG8_STAGE(PG8_SB(1, 1), cB + hstep + kstep, voffB);
        PG8_WAIT_V(6); PG8_BAR;
    }
    for (;;) {
        const bool has_next = S.next(ui + 1, nxt);
        const char* nA = GATHER ? (const char*)g.A : (has_next ? (const char*)g.A + (size_t)nxt.pm * tstep : cA);
        if constexpr (GATHER) { if (has_next) { PG8_GOFF(gn, nxt.pm); } else { _Pragma("unroll") for (int _h = 0; _h < 2; ++_h) _Pragma("unroll") for (int _i = 0; _i < 2; ++_i) gn[_h][_i] = gc[_h][_i]; } } const char* nB = has_next ? (const char*)g.Bt + (size_t)nxt.pn * tstep : cB;
#pragma nounroll
        for (int t = 0; t < nt; t += 2) {
            const bool last = (t == nt - 2);
            const char* a1 = cA + (size_t)(t + 1) * kstep;
            const char* a2 = last ? nA : cA + (size_t)(t + 2) * kstep; const char* b2 = last ? nB : cB + (size_t)(t + 2) * kstep;
            const char* a3 = a2 + kstep; const char* b3 = b2 + kstep;
            if (last && has_next) S.a_ready(nxt);
            if constexpr (SP2) {
            PG8_LDB(B0, 0, 0); PG8_LDB(B1, 0, 1); PG8_SCHED; PG8_LDA(At, 0, 0); PG8_STAGE_A(PG8_SA(1, 1), a1, 1, false);
            PG8_WAIT_V(8); PG8_WAIT_L(0); PG8_BAR; PG8_MMA(0, 0, At, B0); PG8_MMA(0, 1, At, B1); PG8_BAR; PG8_SCHED;
            PG8_LDA(At, 0, 1); PG8_STAGE(PG8_SB(0, 0), b2, voffB); PG8_STAGE(PG8_SB(0, 1), b2 + hstep, voffB); PG8_STAGE_A(PG8_SA(0, 0), a2, 0, last);
            PG8_WAIT_V(8); PG8_WAIT_L(0); PG8_BAR; PG8_MMA(1, 0, At, B0); PG8_MMA(1, 1, At, B1); PG8_BAR; PG8_SCHED;
            PG8_LDB(B0, 1, 0); PG8_LDB(B1, 1, 1); PG8_SCHED; PG8_LDA(At, 1, 0); PG8_STAGE_A(PG8_SA(0, 1), a2, 1, last);
            PG8_WAIT_V(8); PG8_WAIT_L(0); PG8_BAR; PG8_MMA(0, 0, At, B0); PG8_MMA(0, 1, At, B1); PG8_BAR; PG8_SCHED;
            PG8_LDA(At, 1, 1); PG8_STAGE(PG8_SB(1, 0), b3, voffB); PG8_STAGE(PG8_SB(1, 1), b3 + hstep, voffB); PG8_STAGE_A(PG8_SA(1, 0), a3, 0, last);
            PG8_WAIT_V(8); PG8_WAIT_L(0); PG8_BAR; PG8_MMA(1, 0, At, B0); PG8_MMA(1, 1, At, B1); PG8_BAR; PG8_SCHED;
            } else {
            PG8_LDB(B0, 0, 0); PG8_SCHED; PG8_LDA(At, 0, 0); PG8_STAGE_A(PG8_SA(1, 1), a1, 1, false);
            PG8_WAIT_L(8); PG8_BAR; PG8_WAIT_L(0); PG8_MMA(0, 0, At, B0); PG8_BAR; PG8_SCHED;
            PG8_LDB(B1, 0, 1); PG8_STAGE(PG8_SB(0, 0), b2, voffB);
            PG8_BAR; PG8_WAIT_L(0); PG8_MMA(0, 1, At, B1); PG8_BAR;
            PG8_LDA(At, 0, 1); PG8_STAGE_A(PG8_SA(0, 0), a2, 0, last);
            PG8_BAR; PG8_WAIT_L(0); PG8_MMA(1, 0, At, B0); PG8_BAR; PG8_SCHED;
            PG8_STAGE(PG8_SB(0, 1), b2 + hstep, voffB);
            PG8_WAIT_V(6); PG8_BAR; PG8_MMA(1, 1, At, B1); PG8_BAR;
            PG8_LDB(B0, 1, 0); PG8_SCHED; PG8_LDA(At, 1, 0); PG8_STAGE_A(PG8_SA(0, 1), a2, 1, last);
            PG8_WAIT_L(8); PG8_BAR; PG8_WAIT_L(0); PG8_MMA(0, 0, At, B0); PG8_BAR; PG8_SCHED;
            PG8_LDB(B1, 1, 1); PG8_STAGE(PG8_SB(1, 0), b3, voffB);
            PG8_BAR; PG8_WAIT_L(0); PG8_MMA(0, 1, At, B1); PG8_BAR;
            PG8_LDA(At, 1, 1); PG8_STAGE_A(PG8_SA(1, 0), a3, 0, last);
            PG8_BAR; PG8_WAIT_L(0); PG8_MMA(1, 0, At, B0); PG8_BAR; PG8_SCHED;
            PG8_STAGE(PG8_SB(1, 1), b3 + hstep, voffB);
            PG8_WAIT_V(6); PG8_BAR; PG8_MMA(1, 1, At, B1); PG8_BAR;
            }
        }
        if constexpr (FP8) asm volatile("s_nop 15\n\ts_nop 15" ::: "memory");
        if constexpr (ALIGN_EPI) { if (wr == 0) PG8_BAR; }
        if constexpr (!Epi::AFTER_DRAIN) { E(acc, cur, wr, wc, fr, fq); S.done(cur); }
        if (!has_next) break;
#pragma unroll
        for (int a = 0; a < 2; ++a)
#pragma unroll
            for (int b = 0; b < 2; ++b)
#pragma unroll
                for (int m = 0; m < 4; ++m)
#pragma unroll
                    for (int n = 0; n < 2; ++n) acc[a][b][m][n] = (f32x4){0.f, 0.f, 0.f, 0.f};
        cur = nxt; cA = nA; cB = nB; ++ui;
        if constexpr (GATHER) { _Pragma("unroll") for (int _h = 0; _h < 2; ++_h) _Pragma("unroll") for (int _i = 0; _i < 2; ++_i) gc[_h][_i] = gn[_h][_i]; }
        if constexpr (ALIGN_EPI) { if (wr == 1) PG8_BAR; }
    }
    PG8_WAIT_V(0);
    if constexpr (!ALIGN_EPI) { if (wr == 0) PG8_BAR; }
    PG8_BAR;
    if constexpr (Epi::AFTER_DRAIN) { E.fused(acc, cur, wr, wc, fr, fq, lds, wid, lane); S.done(cur); }
#undef PG8_SA
#undef PG8_SB
#undef PG8_STAGE
#undef PG8_STAGE_A
#undef PG8_GOFF
#undef PG8_LDA
#undef PG8_LDB
#undef PG8_MMA
#undef PG8_CAT
#undef PG8_WAIT_V
#undef PG8_WAIT_L
#undef PG8_BAR
#undef PG8_SCHED
}
}
#define XB_TMO      128
#define XB_XCNT(j)  (256  + 64 * (j))
#define XB_XSUB(j)  (1280 + 64 * (j))
#define XB_XGEN(j)  (2304 + 64 * (j))
#define XB_TOP      3328
#define XB_TOPGEN   3392
#define XCD_BAR_WORDS 3456
#define XB_SPIN_CAP (1u << 18)

__device__ __forceinline__ unsigned xb_ld(unsigned* p)              { return __hip_atomic_load(p, __ATOMIC_RELAXED, __HIP_MEMORY_SCOPE_AGENT); }
__device__ __forceinline__ unsigned xb_add(unsigned* p, unsigned v) { return __hip_atomic_fetch_add(p, v, __ATOMIC_RELAXED, __HIP_MEMORY_SCOPE_AGENT); }
__device__ __forceinline__ unsigned xb_xcc_id() { return (unsigned)__builtin_amdgcn_s_getreg((3 << 11) | 20) & 0xFu; }
#define XB_SPIN(cond, bar) do { unsigned _sp = 0; while (cond) { __builtin_amdgcn_s_sleep(1); \
    if ((++_sp & 255u) == 0u) { if (xb_ld(&(bar)[XB_TMO])) break; if (_sp > XB_SPIN_CAP) { atomicAdd(&(bar)[XB_TMO], 1u); break; } } } } while (0)

struct XcdBarrier {
    unsigned* bar; unsigned x;
    volatile LAS unsigned* st;
};

__device__ __forceinline__ XcdBarrier xcd_barrier_post(unsigned* bar, volatile LAS unsigned* st) {
    XcdBarrier b; b.bar = bar; b.x = xb_xcc_id(); b.st = st;
    if (threadIdx.x == 0) (void)xb_add(&bar[XB_XCNT(b.x)], 1u);
    return b;
}
__device__ __forceinline__ void xcd_barrier_complete(unsigned* bar, unsigned x, unsigned& nloc, unsigned& nx) {
    const unsigned G = gridDim.x * gridDim.y * gridDim.z;
    unsigned sum, cnt, mine, sp = 0u;
    for (;;) {
        sum = 0u; cnt = 0u; mine = 0u;
#pragma unroll
        for (unsigned j = 0; j < 16; ++j) { const unsigned c = xb_ld(&bar[XB_XCNT(j)]); sum += c; cnt += (c > 0u) ? 1u : 0u; mine = (j == x) ? c : mine; }
        if (sum == G) break;
        __builtin_amdgcn_s_sleep(1);
        if ((++sp & 255u) == 0u) { if (xb_ld(&bar[XB_TMO])) break; if (sp > XB_SPIN_CAP) { atomicAdd(&bar[XB_TMO], 1u); break; } }
    }
    nloc = mine > 0u ? mine : 1u; nx = cnt > 0u ? cnt : 1u;
}

__device__ __forceinline__ void xcd_barrier(const XcdBarrier& b) {
    asm volatile("s_waitcnt vmcnt(0)" ::: "memory");
    __syncthreads();
    if (threadIdx.x == 0) {
        unsigned* bar = b.bar;
        __builtin_amdgcn_s_waitcnt(0);
        unsigned nloc = b.st[0], nx = b.st[1];
        if (nloc == 0u) { xcd_barrier_complete(bar, b.x, nloc, nx); b.st[0] = nloc; b.st[1] = nx; }
        const unsigned old = xb_add(&bar[XB_XSUB(b.x)], 1u);
        const unsigned gen = old / nloc;
        if (old + 1u == (gen + 1u) * nloc) {
            __builtin_amdgcn_fence(__ATOMIC_RELEASE, "agent");
            asm volatile("s_waitcnt vmcnt(0)" ::: "memory");
            const unsigned og = xb_add(&bar[XB_TOP], 1u);
            const unsigned tg = og / nx;
            if (og + 1u == (tg + 1u) * nx) xb_add(&bar[XB_TOPGEN], 1u);
            else XB_SPIN(xb_ld(&bar[XB_TOPGEN]) == tg, bar);
            __builtin_amdgcn_fence(__ATOMIC_ACQUIRE, "agent");
            xb_add(&bar[XB_XGEN(b.x)], 1u);
            asm volatile("s_waitcnt vmcnt(0)" ::: "memory");
        } else {
            XB_SPIN(xb_ld(&bar[XB_XGEN(b.x)]) == gen, bar);
            __builtin_amdgcn_fence(__ATOMIC_ACQUIRE, "agent");
            asm volatile("s_waitcnt vmcnt(0)" ::: "memory");
        }
    }
    __syncthreads();
}

enum InIdx { I_X = 0, I_MEM, I_RELB, I_ATTN_G, I_FFN_G, I_MEM_G, I_W_MKV, I_QN_MEM, I_KN_MEM, I_W_OUT, I_W_INA, I_QN_A, I_KN_A, I_KV_G, I_W_KVB, I_KN_B, I_W_INB, I_QN_B,
             I_LAMBDA, I_SUBLN, I_W_RG, I_B_RG, I_W_RE, I_B_RE, I_W_GATE, I_W_UP, I_W_DOWN, N_IN };
struct Args { const float* in[N_IN]; float* out; unsigned char* ws; int ph_lo, ph_hi; };
static_assert(sizeof(Args) == N_IN * 8 + 8 + 8 + 8, "Args has no padding");

using pg8::cvt_pk_bf16;
struct EpiRowScale {
    static constexpr bool PERM = true, AFTER_DRAIN = false;
    bf16* O; int ldc; const float* rs; int ntn; float cs;
    __device__ __forceinline__ void operator()(const f32x4 (&acc)[2][2][4][2], const pg8::Unit& u, int wr, int wc, int fr, int fq) const {
        const int colt = ntn ? (u.pn % ntn) : u.pn;
        const int row0 = u.pm * 256 + wr * 64 + fr, col0 = colt * 256 + wc * 32 + 8 * fq;
#pragma unroll
        for (int ai = 0; ai < 2; ++ai)
#pragma unroll
            for (int m = 0; m < 4; ++m) { const int row = row0 + ai * 128 + m * 16; const float s = (rs ? rs[row] : 1.f) * cs; bf16* rowp = O + (size_t)row * ldc + col0;
#pragma unroll
                for (int bj = 0; bj < 2; ++bj) { const f32x4 v0 = acc[ai][bj][m][0] * s, v1 = acc[ai][bj][m][1] * s;
                    v4u w; w.x = cvt_pk_bf16(v0[0], v0[1]); w.y = cvt_pk_bf16(v0[2], v0[3]); w.z = cvt_pk_bf16(v1[0], v1[1]); w.w = cvt_pk_bf16(v1[2], v1[3]);
                    *(v4u*)(rowp + bj * 128) = w; } }
    }
};
template <bool RES_F32>
struct EpiOutProj {
    static constexpr bool PERM = false, AFTER_DRAIN = false;
    const float* resid; float* part; bf16* HB; unsigned char* HB8; float cs;
    __device__ __forceinline__ void operator()(const f32x4 (&acc)[2][2][4][2], const pg8::Unit& u, int wr, int wc, int fr, int fq) const {
        const int row0 = u.pm * 256 + wr * 64 + fr, col0 = u.pn * 256 + wc * 32 + 4 * fq;
#pragma unroll
        for (int ai = 0; ai < 2; ++ai)
#pragma unroll
            for (int m = 0; m < 4; ++m) { const int row = row0 + ai * 128 + m * 16; const size_t off = (size_t)row * DM + col0; float ss = 0.f;
#pragma unroll
                for (int bj = 0; bj < 2; ++bj)
#pragma unroll
                    for (int n = 0; n < 2; ++n) { f32x4 r4;
                        if (RES_F32) r4 = *(const f32x4*)(resid + off + bj * 128 + n * 16);
                        else { const v2u rb = *(const v2u*)(HB + off + bj * 128 + n * 16); r4 = (f32x4){bflo(rb.x), bfhi(rb.x), bflo(rb.y), bfhi(rb.y)}; }
                        const f32x4 v = r4 + acc[ai][bj][m][n] * cs;
                        ss += (v[0] * v[0] + v[1] * v[1]) + (v[2] * v[2] + v[3] * v[3]);
                        v2u hb; hb.x = cvt_pk_bf16(v[0], v[1]); hb.y = cvt_pk_bf16(v[2], v[3]); *(v2u*)(HB + off + bj * 128 + n * 16) = hb;
                        unsigned w8 = 0u; w8 = __builtin_amdgcn_cvt_pk_fp8_f32(v[0], v[1], w8, false); w8 = __builtin_amdgcn_cvt_pk_fp8_f32(v[2], v[3], w8, true); *(unsigned*)(HB8 + off + bj * 128 + n * 16) = w8; }
                ss += swz_xor<16>(ss); ss = add_xor32(ss);
                if (fq == 0) part[(size_t)row * 32 + u.pn * 4 + wc] = ss; }
    }
};
struct EpiSiluMul {
    static constexpr bool PERM = true, AFTER_DRAIN = false;
    bf16* O; const float* rstd; const int* rowtok;
    __device__ __forceinline__ void operator()(const f32x4 (&acc)[2][2][4][2], const pg8::Unit& u, int wr, int wc, int fr, int fq) const {
        const int row0 = u.pm * 256 + wr * 64 + fr, col0 = (u.pn & 3) * 128 + wc * 32 + 8 * fq;
#pragma unroll
        for (int ai = 0; ai < 2; ++ai)
#pragma unroll
            for (int m = 0; m < 4; ++m) { const int row = row0 + ai * 128 + m * 16; float h[8]; const float rs = rstd[rowtok[row]] * (1.f / SC_W1);
#pragma unroll
                for (int n = 0; n < 2; ++n)
#pragma unroll
                    for (int e = 0; e < 4; ++e) { const float g = acc[ai][0][m][n][e] * rs, up = acc[ai][1][m][n][e] * (rs * SC_HID);
                        h[n * 4 + e] = g * up * __builtin_amdgcn_rcpf(1.f + __builtin_amdgcn_exp2f(-g * LOG2E)); }
                unsigned w0 = 0u, w1 = 0u; w0 = __builtin_amdgcn_cvt_pk_fp8_f32(h[0], h[1], w0, false); w0 = __builtin_amdgcn_cvt_pk_fp8_f32(h[2], h[3], w0, true);
                w1 = __builtin_amdgcn_cvt_pk_fp8_f32(h[4], h[5], w1, false); w1 = __builtin_amdgcn_cvt_pk_fp8_f32(h[6], h[7], w1, true);
                *(v2u*)((unsigned char*)O + (size_t)row * EFF + col0) = (v2u){w0, w1}; }
    }
};
struct MoeOrder {
    const int* blk_e; int nunits, ntn, G, c;
    __device__ __forceinline__ bool next(int i, pg8::Unit& u) const {
        const int L = i * G + c; if (L >= nunits) return false;
        const int rb = L / ntn; u.pm = rb; u.pn = blk_e[rb] * ntn + (L - rb * ntn); return true;
    }
    __device__ __forceinline__ void a_ready(const pg8::Unit&) const {}
    __device__ __forceinline__ void done(const pg8::Unit&) const {}
};

struct TrDesc { const float* src; int N; bf16* dst; int dstK; const float* gain; float f8; };
__device__ __forceinline__ TrDesc tr_decode(const Args& a, int r) {
    unsigned char* ws = opaque_ws(a.ws); TrDesc d; d.f8 = 0.f;
    constexpr int R0 = 2560, R1 = 1024, R2 = 1536, R3 = 2048, R4 = 1024, R5 = 32768, R6 = 32768;
    if (r < R0) { const int kb = r / 160, nb = r % 160; d.src = a.in[I_W_INA] + (size_t)(128 * kb) * 5120 + 32 * nb; d.N = 5120; d.dst = (bf16*)(ws + WS_W_INA + (size_t)(32 * nb) * DM + 128 * kb); d.dstK = DM; d.gain = a.in[I_ATTN_G] + 128 * kb; d.f8 = SC_W1; return d; } r -= R0;
    if (r < R1) { const int kb = r / 64, nb = r % 64; d.src = a.in[I_W_INB] + (size_t)(128 * kb) * 2048 + 32 * nb; d.N = 2048; d.dst = (bf16*)(ws + WS_W_INB + (size_t)(32 * nb) * DM + 128 * kb); d.dstK = DM; d.gain = a.in[I_ATTN_G] + DM + 128 * kb; d.f8 = SC_W1; return d; } r -= R1;
    if (r < R2) { const int kb = r / 96, nb = r % 96; d.src = a.in[I_W_KVB] + (size_t)(128 * kb) * 3072 + 32 * nb; d.N = 3072; d.dst = (bf16*)(ws + WS_W_INB + (size_t)(2048 + 32 * nb) * DM + 128 * kb); d.dstK = DM; d.gain = a.in[I_KV_G] + 128 * kb; d.f8 = SC_W1; return d; } r -= R2;
    if (r < R3) { const int l = r / 1024, rr = r % 1024, kb = rr / 64, nb = rr % 64; d.src = a.in[I_W_OUT] + (size_t)l * DM * DM + (size_t)(128 * kb) * 2048 + 32 * nb; d.N = 2048;
        d.dst = (bf16*)(ws + WS_W_OUT + (size_t)l * DM * DM + (size_t)(32 * nb) * DM + 128 * kb); d.f8 = SC_W1;
        d.dstK = DM; d.gain = nullptr; return d; } r -= R3;
    if (r < R4) { const int l = r / 512, rr = r % 512, kb = rr / 32, nb = rr % 32; d.src = a.in[I_W_MKV] + (size_t)l * DM * 1024 + (size_t)(128 * kb) * 1024 + 32 * nb; d.N = 1024;
        d.dst = (bf16*)(ws + WS_W_MKV) + (size_t)l * 1024 * DM + (size_t)(32 * nb) * DM + 128 * kb; d.dstK = DM; d.gain = a.in[I_MEM_G] + l * DM + 128 * kb; return d; } r -= R4;
    if (r < R5 + R6) { const int up = r >= R5 ? 1 : 0; if (up) r -= R5;
        const int le = r / 256, rr = r % 256, kb = rr / 16, nb = rr % 16, n0 = 32 * nb, drow = (n0 >> 7) * 256 + (n0 & 127) + up * 128;
        d.src = (up ? a.in[I_W_UP] : a.in[I_W_GATE]) + (size_t)le * DM * EFF + (size_t)(128 * kb) * EFF + n0; d.N = EFF;
        d.dst = (bf16*)(ws + WS_W_E1 + ((size_t)le * 1024 + drow) * DM + 128 * kb); d.dstK = DM; d.gain = a.in[I_FFN_G] + (le >> 6) * DM + 128 * kb; d.f8 = SC_W1; return d; } r -= R5 + R6;
    { const int le = r / 256, rr = r % 256, kb = rr / 64, nb = rr % 64; d.src = a.in[I_W_DOWN] + (size_t)le * EFF * DM + (size_t)(128 * kb) * DM + 32 * nb; d.N = DM;
        d.dst = (bf16*)(ws + WS_W_E2 + ((size_t)le * DM + 32 * nb) * EFF + 128 * kb); d.dstK = EFF; d.gain = nullptr; d.f8 = SC_W2; return d; }
}
__device__ __forceinline__ float row_to_fp8(const float* xrow, unsigned char* orow, int lane) {
    const GAS f32x4* xr = (const GAS f32x4*)xrow + lane;
    f32x4 v[8]; float s = 0.f;
#pragma unroll
    for (int j = 0; j < 8; ++j) { v[j] = xr[64 * j]; s += (v[j].x * v[j].x + v[j].y * v[j].y) + (v[j].z * v[j].z + v[j].w * v[j].w); }
    const float rstd = 1.0f / sqrtf(wave_sum(s) * (1.f / DM) + RMS_EPS);
    GAS unsigned* o4 = (GAS unsigned*)orow + lane;
#pragma unroll
    for (int j = 0; j < 8; ++j) { unsigned w = 0u; w = __builtin_amdgcn_cvt_pk_fp8_f32(v[j].x, v[j].y, w, false); w = __builtin_amdgcn_cvt_pk_fp8_f32(v[j].z, v[j].w, w, true); o4[64 * j] = w; }
    return rstd;
}
__device__ __forceinline__ float row_to_bf16(const float* xrow, bf16* orow, bool normalise, int lane) {
    const GAS f32x4* xr = (const GAS f32x4*)xrow + lane;
    f32x4 v[8]; float s = 0.f;
#pragma unroll
    for (int j = 0; j < 8; ++j) { v[j] = xr[64 * j]; s += (v[j].x * v[j].x + v[j].y * v[j].y) + (v[j].z * v[j].z + v[j].w * v[j].w); }
    const float rstd = 1.0f / sqrtf(wave_sum(s) * (1.f / DM) + RMS_EPS);
    const float f = normalise ? rstd : 1.f;
    GAS unsigned long long* o8 = (GAS unsigned long long*)orow + lane;
#pragma unroll
    for (int j = 0; j < 8; ++j) o8[64 * j] = (unsigned long long)pk2(v[j].x * f, v[j].y * f) | ((unsigned long long)pk2(v[j].z * f, v[j].w * f) << 32);
    return rstd;
}
#define TR_IDX(i) (layer < 0 ? (i) : 8192 + ((i) / 16384) * 32768 + layer * 16384 + ((i) % 16384))
__device__ __forceinline__ void tr_loop(const Args& a, LAS float* scr, int lane, int it, int end, int stride, int layer) {
    const int first0 = it < end ? it : 0;
    {
        float v[64];
        const int lr = lane >> 5, lc = lane & 31;
        TrDesc cur = tr_decode(a, TR_IDX(it < end ? it : first0));
        if (it < end) {
#pragma unroll
            for (int i = 0; i < 64; ++i) v[i] = __builtin_nontemporal_load(cur.src + (size_t)(2 * i + lr) * cur.N + lc);
        }
        for (; it < end; it += stride) {
#pragma unroll
            for (int i = 0; i < 64; ++i) scr[(2 * i + lr) * 33 + lc] = v[i];
            LDS_WAIT(); asm volatile("" ::: "memory");
            const int nx = it + stride; const bool has_next = nx < end;
            const TrDesc nd = tr_decode(a, TR_IDX(has_next ? nx : it));
            if (has_next) {
#pragma unroll
                for (int i = 0; i < 64; ++i) v[i] = __builtin_nontemporal_load(nd.src + (size_t)(2 * i + lr) * nd.N + lc);
            }
            if (cur.f8 != 0.f) {
                const int c = lane & 7, nq = lane >> 3; const float f = cur.f8;
                f32x4 g[4];
#pragma unroll
                for (int q = 0; q < 4; ++q) g[q] = cur.gain ? *(const f32x4*)(cur.gain + 16 * c + 4 * q) * f : (f32x4){f, f, f, f};
#pragma unroll
                for (int j = 0; j < 4; ++j) { const int n = nq + 8 * j; const LAS float* sp = scr + (16 * c) * 33 + n; v4u o;
#pragma unroll
                    for (int q = 0; q < 4; ++q) { unsigned w = 0u;
                        w = __builtin_amdgcn_cvt_pk_fp8_f32(sp[(4 * q + 0) * 33] * g[q][0], sp[(4 * q + 1) * 33] * g[q][1], w, false);
                        w = __builtin_amdgcn_cvt_pk_fp8_f32(sp[(4 * q + 2) * 33] * g[q][2], sp[(4 * q + 3) * 33] * g[q][3], w, true); o[q] = w; }
                    *(GAS v4u*)((unsigned char*)cur.dst + (size_t)n * cur.dstK + 16 * c) = o; }
            } else {
                const int c = lane & 15, nq = lane >> 4;
                f32x4 g0 = (f32x4){1.f, 1.f, 1.f, 1.f}, g1 = g0;
                if (cur.gain) { g0 = *(const f32x4*)(cur.gain + 8 * c); g1 = *(const f32x4*)(cur.gain + 8 * c + 4); }
#pragma unroll
                for (int j = 0; j < 8; ++j) { const int n = nq + 4 * j; const LAS float* sp = scr + (8 * c) * 33 + n;
                    v4u o; o.x = pk2(sp[0 * 33] * g0[0], sp[1 * 33] * g0[1]); o.y = pk2(sp[2 * 33] * g0[2], sp[3 * 33] * g0[3]); o.z = pk2(sp[4 * 33] * g1[0], sp[5 * 33] * g1[1]); o.w = pk2(sp[6 * 33] * g1[2], sp[7 * 33] * g1[3]);
                    *(GAS v4u*)(cur.dst + (size_t)n * cur.dstK + 8 * c) = o; }
            }
            LDS_WAIT(); asm volatile("" ::: "memory");
            cur = nd;
        }
    }
}
#undef TR_IDX
constexpr int EXP_ITEMS = 49152, CONV_CH = 48, CONV_NCH = EXP_ITEMS / CONV_CH;
__device__ __forceinline__ void conv_chunk(const Args& a, LAS unsigned char* lds, int layer, int c) {
    const int tid = opaque_tid(), lane = tid & 63, wave = __builtin_amdgcn_readfirstlane(tid >> 6);
    tr_loop(a, (LAS float*)(lds + RING_OFF + wave * 16896), lane, c * CONV_CH + wave, (c + 1) * CONV_CH, 8, layer);
    __syncthreads();
}
struct Mix { bool conv; int idx; };
__device__ __forceinline__ Mix mix_decode(int u, int NA, int NC) {
    const long U = NA + NC; const int cb = (int)(((long)u * NC) / U), cb1 = (int)(((long)(u + 1) * NC) / U);
    Mix m; m.conv = cb1 != cb; m.idx = m.conv ? cb : u - cb; return m;
}
__device__ __forceinline__ void phase_prep(const Args& a, LAS unsigned char* lds, int G, int vb) {
    const int tid = opaque_tid(), lane = tid & 63, wave = __builtin_amdgcn_readfirstlane(tid >> 6);
    unsigned char* ws = opaque_ws(a.ws);
    LAS float* scr = (LAS float*)(lds + RING_OFF + wave * 16896);
    const int gw = vb * 8 + wave, NGW = G * 8;
    tr_loop(a, scr, lane, gw, 8192, NGW, -1);
    for (int idx = vb * 512 + tid; idx < 2 * NRTP * DM; idx += G * 512) {
        const int l = idx / (NRTP * DM), j = (idx / DM) % NRTP, k = idx % DM;
        float v = 0.f;
        if (j < 8) v = a.in[I_W_RG][((size_t)l * DM + k) * 8 + j]; else if (j < NRT) v = a.in[I_W_RE][((size_t)l * DM + k) * 64 + (j - 8)];
        v *= a.in[I_FFN_G][l * DM + k];
        const unsigned hi = f2bf(v); const float lo = v - bf2f((unsigned short)hi);
        bf16* wr = (bf16*)(ws + WS_W_RT) + (size_t)l * 2 * NRTP * DM;
        wr[(size_t)j * DM + k] = (bf16)hi; wr[(size_t)(NRTP + j) * DM + k] = (bf16)f2bf(lo);
    }
    for (int idx = vb * 512 + tid; idx < 2 * 5 * HD; idx += G * 512) { const int l = idx / (5 * HD), w = (idx / HD) % 5, i = idx % HD; float v;
        if (l == 0) v = (w < 2) ? a.in[I_QN_A][i] : (w == 2) ? a.in[I_QN_MEM][i] : a.in[I_KN_A][i];
        else v = (w == 0) ? a.in[I_QN_B][i] : (w == 1) ? a.in[I_QN_B][HD + i] : (w == 2) ? a.in[I_QN_MEM][HD + i] : (w == 3) ? a.in[I_KN_B][i] : a.in[I_KN_B][HD + i];
        ((float*)(ws + WS_SMALL + SM_GAINTAB))[idx] = v; }
    float* rstd = (float*)(ws + WS_SMALL + SM_RSTD);
    for (int m = gw; m < T; m += NGW) { const float rs = row_to_fp8(a.in[I_X] + (size_t)m * DM, ws + WS_HB8 + (size_t)m * DM, lane); if (lane == 0) rstd[m] = rs; }
    for (int m = gw; m < NB * NMEM; m += NGW) (void)row_to_bf16(a.in[I_MEM] + (size_t)m * DM, (bf16*)(ws + WS_SMALL + SM_MEMN) + (size_t)m * DM, true, lane);
}

struct PostDesc { const bf16* src; int sp; bf16* dst; int dp; const float* gain; float scale; float* kmean; };
__device__ __forceinline__ void post_unit(const PostDesc& d, LAS unsigned char* lds) {
    const int tid = opaque_tid(), lane = tid & 63, wave = __builtin_amdgcn_readfirstlane(tid >> 6), c = lane & 15, rg = lane >> 4;
    float g8[8]; float cs[8];
#pragma unroll
    for (int i = 0; i < 8; ++i) { g8[i] = d.gain ? d.gain[8 * c + i] * d.scale : 1.f; cs[i] = 0.f; }
    v4u wv[8];
#pragma unroll
    for (int it = 0; it < 8; ++it) wv[it] = *(const v4u*)(d.src + (size_t)(wave * 32 + it * 4 + rg) * d.sp + 8 * c);
#pragma unroll
    for (int it = 0; it < 8; ++it) {
        const int row = wave * 32 + it * 4 + rg;
        const v4u w = wv[it];
        float f[8] = {bflo(w.x), bfhi(w.x), bflo(w.y), bfhi(w.y), bflo(w.z), bfhi(w.z), bflo(w.w), bfhi(w.w)};
        if (d.gain) {
            float ss = 0.f;
#pragma unroll
            for (int i = 0; i < 8; ++i) ss += f[i] * f[i];
            ss += swz_xor<1>(ss); ss += swz_xor<2>(ss); ss += swz_xor<4>(ss); ss += swz_xor<8>(ss);
            const float rstd = 1.0f / sqrtf(ss * (1.f / HD) + RMS_EPS);
#pragma unroll
            for (int i = 0; i < 8; ++i) { f[i] = f[i] * rstd * g8[i]; cs[i] += f[i]; }
        }
        v4u o; o.x = pk2(f[0], f[1]); o.y = pk2(f[2], f[3]); o.z = pk2(f[4], f[5]); o.w = pk2(f[6], f[7]);
        *(v4u*)(d.dst + (size_t)row * d.dp + 8 * c) = o;
    }
    if (d.kmean) {
        LAS float* ks = (LAS float*)(lds + RING_OFF);
#pragma unroll
        for (int i = 0; i < 8; ++i) { cs[i] += swz_xor<16>(cs[i]); cs[i] = add_xor32(cs[i]); }
        if (lane < 16) {
#pragma unroll
            for (int i = 0; i < 8; ++i) ks[wave * 128 + 8 * c + i] = cs[i]; }
        __syncthreads();
        if (tid < 128) { float s = 0.f;
#pragma unroll
            for (int w = 0; w < 8; ++w) s += ks[w * 128 + tid];
            d.kmean[tid] = s * (1.f / 256.f); }
        __syncthreads();
    }
}
__device__ __forceinline__ void phase_post_mem(const Args& a, LAS unsigned char* lds, int G, int vb) {
    unsigned char* ws = opaque_ws(a.ws);
    for (int v = vb; v < 32; v += G) {
        PostDesc d; d.kmean = nullptr; d.scale = 1.f; d.gain = nullptr;
        const int l = v >> 4, b = (v >> 3) & 1, s8 = v & 7;
        const bf16* srow = (const bf16*)(ws + WS_SMALL + SM_KVM) + ((size_t)b * 256) * 2048 + l * 1024; d.sp = 2048; d.dp = HD;
        if (s8 < 4) { d.src = srow + s8 * 128; d.dst = (bf16*)(ws + WS_SMALL + SM_KM) + ((size_t)((l * 2 + b) * 4 + s8) * NMEM) * HD; d.gain = a.in[I_KN_MEM] + l * HD; }
        else { d.src = srow + 512 + (s8 - 4) * 128; d.dst = (bf16*)(ws + WS_SMALL + SM_VM) + ((size_t)((l * 2 + b) * 4 + (s8 - 4)) * NMEM) * HD; }
        post_unit(d, lds);
    }
}
struct SlotDesc { bf16* dst; int dp; const float* gain; float scale; float* kmean; };
__device__ __forceinline__ SlotDesc slot_desc(unsigned char* ws, int layer, int sl, int pm) {
    const float* gt = (const float*)(ws + WS_SMALL + SM_GAINTAB) + layer * 5 * HD;
    bf16* QH = (bf16*)(ws + WS_QH); bf16* KH = (bf16*)(ws + WS_KH); bf16* VH = (bf16*)(ws + WS_VH);
    const int t0 = pm * 256, b = pm >> 5, s0 = (pm & 31) * 256;
    SlotDesc d; d.kmean = nullptr; d.scale = 1.f; d.gain = nullptr;
    if (layer == 0) {
        if (sl < 12) { d.dst = QH + (size_t)t0 * DM + sl * 128; d.dp = DM; d.gain = gt; d.scale = QSCALE; }
        else if (sl < 24) { const int h = sl - 12; d.dst = KH + ((size_t)(b * 12 + h) * SEQ + s0) * HD; d.dp = HD; d.gain = gt + 3 * HD;
            d.kmean = (float*)(ws + WS_SMALL + SM_KMEAN) + ((size_t)(b * 12 + h) * 32 + (pm & 31)) * HD; }
        else if (sl < 36) { const int h = sl - 24; d.dst = VH + ((size_t)(b * 12 + h) * SEQ + s0) * HD; d.dp = HD; }
        else { const int h = sl - 36; d.dst = QH + (size_t)t0 * DM + (12 + h) * 128; d.dp = DM; d.gain = gt + 2 * HD; d.scale = QSCALE; }
    } else {
        if (sl < 6) { d.dst = QH + (size_t)t0 * DM + sl * 128; d.dp = DM; d.gain = gt; d.scale = QSCALE; }
        else if (sl < 12) { d.dst = QH + (size_t)t0 * DM + sl * 128; d.dp = DM; d.gain = gt + HD; d.scale = QSCALE; }
        else if (sl < 16) { d.dst = QH + (size_t)t0 * DM + sl * 128; d.dp = DM; d.gain = gt + 2 * HD; d.scale = QSCALE; }
        else if (sl < 22) { const int h = sl - 16; d.dst = KH + ((size_t)(b * 12 + h) * SEQ + s0) * HD; d.dp = HD; d.gain = gt + 3 * HD; }
        else if (sl < 28) { const int h = sl - 22; d.dst = KH + ((size_t)(b * 12 + 6 + h) * SEQ + s0) * HD; d.dp = HD; d.gain = gt + 4 * HD; }
        else { const int vh = sl - 28, h = vh >> 1, cc = vh & 1; d.dst = VH + ((size_t)(b * 6 + h) * SEQ + s0) * DV + cc * 128; d.dp = DV; }
    }
    return d;
}
struct EpiHeadNorm {
    static constexpr bool PERM = true, AFTER_DRAIN = false;
    unsigned char* ws; int layer; float cs;
    __device__ __forceinline__ void operator()(const f32x4 (&acc)[2][2][4][2], const pg8::Unit& u, int wr, int wc, int fr_in, int fq_in) const {
        int fr = fr_in, fq = fq_in; asm volatile("" : "+v"(fr), "+v"(fq));
        LAS float* P = (LAS float*)(uintptr_t)LDSX_OFF;
        LAS float* KS = (LAS float*)(uintptr_t)(LDSX_OFF + 8192);
        const float* rs = (const float*)(ws + WS_SMALL + SM_RSTD);
        const SlotDesc d0 = slot_desc(ws, layer, 2 * u.pn, u.pm), d1 = slot_desc(ws, layer, 2 * u.pn + 1, u.pm);
        const int rowl = wr * 64 + fr, coll = wc * 32 + 8 * fq;
        const float* rsr = rs + u.pm * 256 + rowl;
#pragma unroll
        for (int ai = 0; ai < 2; ++ai)
#pragma unroll
            for (int m = 0; m < 4; ++m) { const int row = rowl + ai * 128 + m * 16; const float rtv = rsr[ai * 128 + m * 16] * cs;
#pragma unroll
                for (int bj = 0; bj < 2; ++bj) { if ((bj == 0 ? d0.gain : d1.gain) != nullptr) {
                    const f32x4 v0 = acc[ai][bj][m][0] * rtv, v1 = acc[ai][bj][m][1] * rtv;
                    float ss = (v0[0] * v0[0] + v0[1] * v0[1]) + (v0[2] * v0[2] + v0[3] * v0[3]) + (v1[0] * v1[0] + v1[1] * v1[1]) + (v1[2] * v1[2] + v1[3] * v1[3]);
                    ss += swz_xor<16>(ss); ss = add_xor32(ss);
                    if (fq == 0) P[(row * 2 + bj) * 4 + wc] = ss; } } }
        asm volatile("s_waitcnt lgkmcnt(0)" ::: "memory"); __builtin_amdgcn_s_barrier(); asm volatile("" ::: "memory");
#pragma unroll
        for (int bj = 0; bj < 2; ++bj) { const SlotDesc& d = bj == 0 ? d0 : d1;
            f32x4 g0 = (f32x4){1.f, 1.f, 1.f, 1.f}, g1 = g0;
            if (d.gain) { g0 = *(const f32x4*)(d.gain + coll) * d.scale; g1 = *(const f32x4*)(d.gain + coll + 4) * d.scale; }
            f32x4 c0 = (f32x4){0.f, 0.f, 0.f, 0.f}, c1 = c0;
#pragma unroll
            for (int ai = 0; ai < 2; ++ai)
#pragma unroll
                for (int m = 0; m < 4; ++m) { const int row = rowl + ai * 128 + m * 16; float f = rsr[ai * 128 + m * 16] * cs;
                    if (d.gain) { const f32x4 p4 = *(const LAS f32x4*)(P + (row * 2 + bj) * 4); f *= 1.0f / sqrtf(((p4[0] + p4[1]) + (p4[2] + p4[3])) * (1.f / HD) + RMS_EPS); }
                    const f32x4 v0 = acc[ai][bj][m][0] * f * g0, v1 = acc[ai][bj][m][1] * f * g1;
                    if (d.kmean) { c0 += v0; c1 += v1; }
                    v4u w; w.x = cvt_pk_bf16(v0[0], v0[1]); w.y = cvt_pk_bf16(v0[2], v0[3]); w.z = cvt_pk_bf16(v1[0], v1[1]); w.w = cvt_pk_bf16(v1[2], v1[3]);
                    *(v4u*)(d.dst + (size_t)row * d.dp + coll) = w; }
            if (d.kmean) {
#pragma unroll
                for (int i = 0; i < 4; ++i) { float v = c0[i]; v += swz_xor<1>(v); v += swz_xor<2>(v); v += swz_xor<4>(v); v += swz_xor<8>(v); if (fr == 0) KS[wr * 256 + bj * 128 + coll + i] = v;
                                              float w_ = c1[i]; w_ += swz_xor<1>(w_); w_ += swz_xor<2>(w_); w_ += swz_xor<4>(w_); w_ += swz_xor<8>(w_); if (fr == 0) KS[wr * 256 + bj * 128 + coll + 4 + i] = w_; } } }
        if (d0.kmean) {
            asm volatile("s_waitcnt lgkmcnt(0)" ::: "memory"); __builtin_amdgcn_s_barrier(); asm volatile("" ::: "memory");
            const int t = (wr * 4 + wc) * 64 + fq * 16 + fr;
            if (t < 256) { const float mean = (KS[t] + KS[256 + t]) * (1.f / 256.f); float* km = (t < 128) ? d0.kmean : d1.kmean; km[t & 127] = mean; }
        }
    }
};
__device__ __forceinline__ void phase_gate(const Args& a, LAS unsigned char* lds, int G, int vb) {
    unsigned char* ws = opaque_ws(a.ws);
    const bf16* QH = (const bf16*)(ws + WS_QH); const float* KMEAN = (const float*)(ws + WS_SMALL + SM_KMEAN); unsigned* SEL = (unsigned*)(ws + WS_SMALL + SM_SEL);
    gu32* MC = (gu32*)(ws + WS_CTL) + CW_MC; unsigned* LISTF = (unsigned*)(ws + WS_LISTF); unsigned* LISTA = (unsigned*)(ws + WS_LISTA);
    const int tid_g = opaque_tid();
    LAS float* kml = (LAS float*)(lds + RING_OFF);
    for (int idx = vb * 512 + tid_g; idx < NB * MOBA_H * SEQ; idx += G * 512) {
        const int bh = idx / SEQ, s = idx % SEQ, b = bh / MOBA_H, h = bh % MOBA_H, own = s >> 8;
        __syncthreads();
        { const f32x4* src = (const f32x4*)(KMEAN + (size_t)bh * 32 * HD); ((LAS f32x4*)kml)[tid_g] = src[tid_g]; ((LAS f32x4*)kml)[512 + tid_g] = src[512 + tid_g]; }
        __syncthreads();
        unsigned mask = 0u;
        if (own <= 3) { mask = (1u << own) - 1u; }
        else {
            float acc[31];
#pragma unroll
            for (int j = 0; j < 31; ++j) acc[j] = 0.f;
            const bf16* q = QH + ((size_t)b * SEQ + s) * DM + h * HD;
            for (int c = 0; c < 16; ++c) {
                const v4u w = *(const v4u*)(q + 8 * c);
                const float f0 = bflo(w.x), f1 = bfhi(w.x), f2 = bflo(w.y), f3 = bfhi(w.y), f4 = bflo(w.z), f5 = bfhi(w.z), f6 = bflo(w.w), f7 = bfhi(w.w);
#pragma unroll
                for (int j = 0; j < 31; ++j) if (j < own) {
                    const f32x4 k0 = *(const LAS f32x4*)(kml + j * HD + 8 * c), k1 = *(const LAS f32x4*)(kml + j * HD + 8 * c + 4);
                    acc[j] += (f0 * k0[0] + f1 * k0[1]) + (f2 * k0[2] + f3 * k0[3]) + (f4 * k1[0] + f5 * k1[1]) + (f6 * k1[2] + f7 * k1[3]); }
            }
#pragma unroll
            for (int rnd = 0; rnd < 3; ++rnd) { float best = -__builtin_inff(); int bi = 0;
#pragma unroll
                for (int j = 0; j < 31; ++j) if (j < own && !((mask >> j) & 1u) && acc[j] > best) { best = acc[j]; bi = j; }
                mask |= 1u << bi; }
        }
        SEL[idx] = mask;
        { const int lane_ = tid_g & 63; const unsigned long long lt = (1ull << lane_) - 1ull;
          for (int j = 0; j < own; ++j) {
              const bool selj = (mask >> j) & 1u; const unsigned long long bal = __ballot(selj);
              if (bal == 0ull) continue;
              const int far = (j == own - 1) ? 0 : 1; const int lead = __builtin_ctzll(bal);
              unsigned base = 0u; if (lane_ == lead) base = __hip_atomic_fetch_add(MC + (bh * 32 + j) * 2 + far, (unsigned)__builtin_popcountll(bal), RLX_AGENT);
              base = __shfl(base, lead);
              if (selj) { const unsigned pos = base + (unsigned)__builtin_popcountll(bal & lt); const int slot = __builtin_popcount(mask & ((1u << j) - 1u));
                  const unsigned ent = (unsigned)s | ((unsigned)slot << 16);
                  if (far) LISTF[((size_t)bh * 32 + j) * 8192 + pos] = ent; else LISTA[((size_t)bh * 32 + j) * 256 + pos] = ent; } } }
    }
}

namespace att {
constexpr int SHM_T = 16384;
#define KSWZ(row, colB) ((row) * 256 + ((colB) ^ (((row) & 7) << 4)))
#define SBAR() __builtin_amdgcn_sched_barrier(0)
__device__ __forceinline__ int v_rd_base(int lane) { return ((lane & 3) << 3) | (((lane >> 2) & 3) << 6) | (((lane >> 4) & 1) << 5) | (((lane >> 5) & 1) << 8); }
__device__ __forceinline__ int crow(int r, int hi) { return (r & 3) + 8 * (r >> 2) + 4 * hi; }
__device__ __forceinline__ unsigned cvtpk(float lo, float hi) { unsigned r; asm volatile("v_cvt_pk_bf16_f32 %0, %1, %2" : "=v"(r) : "v"(lo), "v"(hi)); return r; }
__device__ __forceinline__ int swap23(int k) { return (k & ~0xC) | ((k & 4) << 1) | ((k & 8) >> 1); }
__device__ __forceinline__ void glds16(const void* sbase  , unsigned voff, unsigned lds_dst) { unsigned keep;
    asm volatile("s_mov_b32 %0, m0\n\ts_mov_b32 m0, %3\n\ts_nop 0\n\tglobal_load_lds_dwordx4 %1, %2\n\ts_mov_b32 m0, %0" : "=&s"(keep) : "v"(voff), "s"(sbase), "s"(lds_dst) : "memory"); }
#define WAIT_BAR0() asm volatile("s_waitcnt vmcnt(0) lgkmcnt(0)\n\ts_barrier" ::: "memory")
constexpr float THR2 = 11.5f;

__device__ __forceinline__ void qkt(f32x16& p0, f32x16& p1, const LAS char* Kt, int r32, int hi, const bf16x8* qr) {
#pragma unroll
    for (int r = 0; r < 16; ++r) { p0[r] = 0.f; p1[r] = 0.f; }
    const LAS char* kb0 = Kt + KSWZ(r32, (0 * 16 + hi * 8) * 2);
    const LAS char* kb1 = Kt + KSWZ(r32, (1 * 16 + hi * 8) * 2);
    const LAS char* kb2 = Kt + KSWZ(r32, (2 * 16 + hi * 8) * 2);
    const LAS char* kb3 = Kt + KSWZ(r32, (3 * 16 + hi * 8) * 2);
#pragma unroll
    for (int d0 = 0; d0 < 8; ++d0) { const LAS char* a = ((d0 & 3) == 0 ? kb0 : (d0 & 3) == 1 ? kb1 : (d0 & 3) == 2 ? kb2 : kb3) + (d0 >> 2) * 128;
        const bf16x8 b0 = *(const LAS bf16x8*)a;
        const bf16x8 b1 = *(const LAS bf16x8*)(a + 32 * 256);
        p0 = __builtin_amdgcn_mfma_f32_32x32x16_bf16(b0, qr[d0], p0, 0, 0, 0);
        p1 = __builtin_amdgcn_mfma_f32_32x32x16_bf16(b1, qr[d0], p1, 0, 0, 0); }
}
__device__ __forceinline__ void pv_tile(f32x16* o, int vb, bf16x8 pa0, bf16x8 pa1, bf16x8 pa2, bf16x8 pa3) {
#define TRRD(dst, off) asm volatile("ds_read_b64_tr_b16 %0, %1 offset:%2" : "=&v"(dst) : "v"(vb), "i"(off) : "memory")
#define PV_RD(S_, d0) do { constexpr int b_ = (d0) * 512; TRRD(S_##l0, b_); TRRD(S_##h0, b_ + 2048); TRRD(S_##l1, b_ + 4096); TRRD(S_##h1, b_ + 6144); \
        TRRD(S_##l2, b_ + 8192); TRRD(S_##h2, b_ + 10240); TRRD(S_##l3, b_ + 12288); TRRD(S_##h3, b_ + 14336); } while (0)
#define PV_MM(S_, d0) do { \
        o[d0] = __builtin_amdgcn_mfma_f32_32x32x16_bf16(pa0, (bf16x8){S_##l0[0], S_##l0[1], S_##l0[2], S_##l0[3], S_##h0[0], S_##h0[1], S_##h0[2], S_##h0[3]}, o[d0], 0, 0, 0); \
        o[d0] = __builtin_amdgcn_mfma_f32_32x32x16_bf16(pa1, (bf16x8){S_##l1[0], S_##l1[1], S_##l1[2], S_##l1[3], S_##h1[0], S_##h1[1], S_##h1[2], S_##h1[3]}, o[d0], 0, 0, 0); \
        o[d0] = __builtin_amdgcn_mfma_f32_32x32x16_bf16(pa2, (bf16x8){S_##l2[0], S_##l2[1], S_##l2[2], S_##l2[3], S_##h2[0], S_##h2[1], S_##h2[2], S_##h2[3]}, o[d0], 0, 0, 0); \
        o[d0] = __builtin_amdgcn_mfma_f32_32x32x16_bf16(pa3, (bf16x8){S_##l3[0], S_##l3[1], S_##l3[2], S_##l3[3], S_##h3[0], S_##h3[1], S_##h3[2], S_##h3[3]}, o[d0], 0, 0, 0); } while (0)
#define WL(n) asm volatile("s_waitcnt lgkmcnt(" #n ")" ::: "memory")
    s16x4 Al0, Al1, Al2, Al3, Ah0, Ah1, Ah2, Ah3, Bl0, Bl1, Bl2, Bl3, Bh0, Bh1, Bh2, Bh3;
    PV_RD(A, 0); SBAR();
    PV_RD(B, 1); WL(8); SBAR(); PV_MM(A, 0); SBAR();
    PV_RD(A, 2); WL(8); SBAR(); PV_MM(B, 1); SBAR();
    PV_RD(B, 3); WL(8); SBAR(); PV_MM(A, 2); SBAR();
    WL(0); SBAR(); PV_MM(B, 3);
#undef PV_RD
#undef PV_MM
#undef TRRD
}
__device__ __forceinline__ void softmax_tile(f32x16& p0, f32x16& p1, float& m_reg, float& l_reg, float& alpha, bf16x8& pa0, bf16x8& pa1, bf16x8& pa2, bf16x8& pa3) {
    float pmax = p0[0];
#pragma unroll
    for (int r = 1; r < 16; ++r) pmax = fmaxf(pmax, p0[r]);
#pragma unroll
    for (int r = 0; r < 16; ++r) pmax = fmaxf(pmax, p1[r]);
    { auto rr = __builtin_amdgcn_permlane32_swap(__float_as_uint(pmax), __float_as_uint(pmax), false, false);
      pmax = fmaxf(__uint_as_float(rr[0]), __uint_as_float(rr[1])); }
    const float mn = (pmax - m_reg <= THR2) ? m_reg : fmaxf(m_reg, pmax);
    alpha = __builtin_amdgcn_exp2f(m_reg - mn); m_reg = mn;
#pragma unroll
    for (int r = 0; r < 16; ++r) { p0[r] = __builtin_amdgcn_exp2f(p0[r] - mn); p1[r] = __builtin_amdgcn_exp2f(p1[r] - mn); }
    float ps = 0.f;
#pragma unroll
    for (int r = 0; r < 16; ++r) ps += p0[r] + p1[r];
    { auto rr = __builtin_amdgcn_permlane32_swap(__float_as_uint(ps), __float_as_uint(ps), false, false);
      ps = __uint_as_float(rr[0]) + __uint_as_float(rr[1]); }
    l_reg = l_reg * alpha + ps;
#define PK4(P, B_, OUT) do { unsigned a0 = cvtpk(P[B_+0], P[B_+1]), a1 = cvtpk(P[B_+2], P[B_+3]); \
        unsigned b0 = cvtpk(P[B_+4], P[B_+5]), b1 = cvtpk(P[B_+6], P[B_+7]); \
        auto r0 = __builtin_amdgcn_permlane32_swap(a0, b0, false, false); auto r1 = __builtin_amdgcn_permlane32_swap(a1, b1, false, false); \
        v4u w = {r0[0], r1[0], r0[1], r1[1]}; OUT = __builtin_bit_cast(bf16x8, w); } while (0)
    PK4(p0, 0, pa0); PK4(p0, 8, pa1); PK4(p1, 0, pa2); PK4(p1, 8, pa3);
#undef PK4
}
__device__ __forceinline__ void bias_mask_tile(f32x16& p0, f32x16& p1, int dq, bool on, bool far, const LAS float* lut) {
    const float NEG = -__builtin_inff();
    if (far) {
        const float c = on ? lut[128] : NEG;
#pragma unroll
        for (int r = 0; r < 16; ++r) { p0[r] += c; p1[r] += c; }
    } else {
#pragma unroll
        for (int r = 0; r < 16; ++r) { const int c = (r & 3) + 8 * (r >> 2); const int d0 = dq - c, d1 = dq - c - 32;
            const float b0 = lut[min(max(d0, 0), 128)], b1 = lut[min(max(d1, 0), 128)];
            p0[r] = (on && d0 >= 0) ? p0[r] + b0 : NEG; p1[r] = (on && d1 >= 0) ? p1[r] + b1 : NEG; }
    }
}

__device__ __forceinline__ void qkt_half(f32x16& p, const LAS char* Kt  , int r32, int hi, const bf16x8* qr) {
#pragma unroll
    for (int r = 0; r < 16; ++r) p[r] = 0.f;
    const LAS char* kb0 = Kt + KSWZ(r32, (0 * 16 + hi * 8) * 2);
    const LAS char* kb1 = Kt + KSWZ(r32, (1 * 16 + hi * 8) * 2);
    const LAS char* kb2 = Kt + KSWZ(r32, (2 * 16 + hi * 8) * 2);
    const LAS char* kb3 = Kt + KSWZ(r32, (3 * 16 + hi * 8) * 2);
#pragma unroll
    for (int d0 = 0; d0 < 8; ++d0) { const LAS char* a = ((d0 & 3) == 0 ? kb0 : (d0 & 3) == 1 ? kb1 : (d0 & 3) == 2 ? kb2 : kb3) + (d0 >> 2) * 128;
        const bf16x8 b0 = *(const LAS bf16x8*)a;
        p = __builtin_amdgcn_mfma_f32_32x32x16_bf16(b0, qr[d0], p, 0, 0, 0); }
}
template <int HALF>
__device__ __forceinline__ void pv_half8(f32x16* o, int vb, bf16x8 pa0, bf16x8 pa1) {
#define TRRD(dst, off) asm volatile("ds_read_b64_tr_b16 %0, %1 offset:%2" : "=&v"(dst) : "v"(vb), "i"(off) : "memory")
#define PV_RD(S_, d0) do { constexpr int b_ = ((d0) & 3) * 512 + ((d0) >> 2) * SHM_T + HALF * 8192; TRRD(S_##l0, b_); TRRD(S_##h0, b_ + 2048); TRRD(S_##l1, b_ + 4096); TRRD(S_##h1, b_ + 6144); } while (0)
#define PV_MM(S_, d0) do { \
        o[d0] = __builtin_amdgcn_mfma_f32_32x32x16_bf16(pa0, (bf16x8){S_##l0[0], S_##l0[1], S_##l0[2], S_##l0[3], S_##h0[0], S_##h0[1], S_##h0[2], S_##h0[3]}, o[d0], 0, 0, 0); \
        o[d0] = __builtin_amdgcn_mfma_f32_32x32x16_bf16(pa1, (bf16x8){S_##l1[0], S_##l1[1], S_##l1[2], S_##l1[3], S_##h1[0], S_##h1[1], S_##h1[2], S_##h1[3]}, o[d0], 0, 0, 0); } while (0)
#define WL(n) asm volatile("s_waitcnt lgkmcnt(" #n ")" ::: "memory")
    s16x4 Al0, Al1, Ah0, Ah1, Bl0, Bl1, Bh0, Bh1;
    PV_RD(A, 0); SBAR();
    PV_RD(B, 1); WL(4); SBAR(); PV_MM(A, 0); SBAR();
    PV_RD(A, 2); WL(4); SBAR(); PV_MM(B, 1); SBAR();
    PV_RD(B, 3); WL(4); SBAR(); PV_MM(A, 2); SBAR();
    PV_RD(A, 4); WL(4); SBAR(); PV_MM(B, 3); SBAR();
    PV_RD(B, 5); WL(4); SBAR(); PV_MM(A, 4); SBAR();
    PV_RD(A, 6); WL(4); SBAR(); PV_MM(B, 5); SBAR();
    PV_RD(B, 7); WL(4); SBAR(); PV_MM(A, 6); SBAR();
    WL(0); SBAR(); PV_MM(B, 7);
#undef PV_RD
#undef PV_MM
#undef WL
#undef TRRD
}
__device__ __forceinline__ void softmax_half(f32x16& p0, float& m_reg, float& l_reg, float& alpha, bf16x8& pa0, bf16x8& pa1) {
    float pmax = p0[0];
#pragma unroll
    for (int r = 1; r < 16; ++r) pmax = fmaxf(pmax, p0[r]);
    { auto rr = __builtin_amdgcn_permlane32_swap(__float_as_uint(pmax), __float_as_uint(pmax), false, false);
      pmax = fmaxf(__uint_as_float(rr[0]), __uint_as_float(rr[1])); }
    const float mn = (pmax - m_reg <= THR2) ? m_reg : fmaxf(m_reg, pmax);
    alpha = __builtin_amdgcn_exp2f(m_reg - mn); m_reg = mn;
#pragma unroll
    for (int r = 0; r < 16; ++r) p0[r] = __builtin_amdgcn_exp2f(p0[r] - mn);
    float ps = 0.f;
#pragma unroll
    for (int r = 0; r < 16; ++r) ps += p0[r];
    { auto rr = __builtin_amdgcn_permlane32_swap(__float_as_uint(ps), __float_as_uint(ps), false, false);
      ps = __uint_as_float(rr[0]) + __uint_as_float(rr[1]); }
    l_reg = l_reg * alpha + ps;
#define PK4(P, B_, OUT) do { unsigned a0 = cvtpk(P[B_+0], P[B_+1]), a1 = cvtpk(P[B_+2], P[B_+3]); \
        unsigned b0 = cvtpk(P[B_+4], P[B_+5]), b1 = cvtpk(P[B_+6], P[B_+7]); \
        auto r0 = __builtin_amdgcn_permlane32_swap(a0, b0, false, false); auto r1 = __builtin_amdgcn_permlane32_swap(a1, b1, false, false); \
        v4u w = {r0[0], r1[0], r0[1], r1[1]}; OUT = __builtin_bit_cast(bf16x8, w); } while (0)
    PK4(p0, 0, pa0); PK4(p0, 8, pa1);
#undef PK4
}
__device__ __forceinline__ void bias_mask_half(f32x16& p0, int dq, bool far, const LAS float* lut) {
    const float NEG = -__builtin_inff();
    if (far) { const float c = lut[128];
#pragma unroll
        for (int r = 0; r < 16; ++r) p0[r] += c;
    } else {
#pragma unroll
        for (int r = 0; r < 16; ++r) { const int c = (r & 3) + 8 * (r >> 2); const int d0 = dq - c;
            const float b0 = lut[min(max(d0, 0), 128)]; p0[r] = (d0 >= 0) ? p0[r] + b0 : NEG; }
    }
}
#define RESC(o_, nd_, al_l_, alpha_) do { if (__any((alpha_) < 1.f)) { if (hi == 0) (al_l_)[r32] = (alpha_); asm volatile("s_waitcnt lgkmcnt(0)" ::: "memory"); \
        _Pragma("unroll") for (int r = 0; r < 16; ++r) { const float f_ = (al_l_)[crow(r, hi)]; _Pragma("unroll") for (int d_ = 0; d_ < (nd_); ++d_) (o_)[d_][r] *= f_; } } } while (0)

template <int MODE, bool F8OUT = false>
__device__ __forceinline__ void attn128_unit(LAS unsigned char* lds, const bf16* Qrow0, const bf16* Kh, const bf16* Vh, bf16* Orow0, int NT, int qb, const unsigned* selrow, const float* relb, int h) {
    const int tid = opaque_tid(), wid = __builtin_amdgcn_readfirstlane(tid >> 6), lane = tid & 63, r32 = lane & 31, hi = lane >> 5;
    LAS float* wsf = (LAS float*)(lds + LDSX_OFF) + wid * 64; LAS float* li_l = wsf; LAS float* al_l = wsf + 32;
    LAS float* lut = (LAS float*)(lds + LDSX_OFF + 2048);
    if (MODE == 0 && tid <= 128) lut[tid] = relb[(tid < 128 ? (int)T5_BUCKET[tid] : 31) * 12 + h] * LOG2E;
    bf16x8 qr[8];
#pragma unroll
    for (int d0 = 0; d0 < 8; ++d0) qr[d0] = *(const bf16x8*)(Qrow0 + (size_t)(wid * 32 + r32) * DM + d0 * 16 + hi * 8);
    unsigned sel = 0u; if (MODE == 0) sel = selrow[wid * 32 + r32];
    const int krow = 4 * wid + (lane >> 4); const unsigned ksrc = (unsigned) krow * 256 + ((16 * (lane & 15)) ^ ((krow & 7) << 4));
    const int vkk = 8 * (wid >> 1) + ((lane & 31) >> 2); const unsigned vsrc = (unsigned) swap23(vkk) * 256 + (32 * (2 * (wid & 1) + (lane >> 5)) + 8 * (lane & 3)) * 2;
    const unsigned lds0 = (unsigned)(uintptr_t)(lds + RING_OFF);
    const char* Kg = (const char*)Kh; const char* Vg = (const char*)Vh;
#define ISSUE(t, s) do { const unsigned base_ = (unsigned)__builtin_amdgcn_readfirstlane(lds0 + (s) * 32768 + wid * 1024); const size_t tb_ = (size_t)(t) * SHM_T; \
        glds16(Kg + tb_, ksrc, base_); glds16(Kg + tb_ + 8192, ksrc, base_ + 8192); glds16(Vg + tb_, vsrc, base_ + SHM_T); glds16(Vg + tb_ + 8192, vsrc, base_ + SHM_T + 8192); } while (0)
    const int vb0 = (int)lds0 + SHM_T + v_rd_base(lane);
    float m_reg = -1e30f, l_reg = 0.f; f32x16 o[4];
#pragma unroll
    for (int d = 0; d < 4; ++d)
#pragma unroll
        for (int r = 0; r < 16; ++r) o[d][r] = 0.f;
    const int q0w = qb * 256 + wid * 32, qpos = q0w + r32;
    ISSUE(0, 0);
    for (int t = 0; t < NT; ++t) {
        WAIT_BAR0();
        if (t + 1 < NT) ISSUE(t + 1, (t + 1) & 1);
        const int s = t & 1;
        f32x16 p0, p1;
        qkt(p0, p1, (const LAS char*)(lds + RING_OFF + s * 32768), r32, hi, qr);
        if (MODE == 0) { const int jb = t >> 2, tk0 = t * 64; const bool on = (jb >= qb) || ((sel >> jb) & 1u); const bool far = (q0w - (tk0 + 63)) >= 128;
            bias_mask_tile(p0, p1, qpos - tk0 - 4 * hi, on, far, lut); }
        float alpha; bf16x8 pa0, pa1, pa2, pa3;
        softmax_tile(p0, p1, m_reg, l_reg, alpha, pa0, pa1, pa2, pa3);
        RESC(o, 4, al_l, alpha);
        pv_tile(o, vb0 + s * 32768, pa0, pa1, pa2, pa3);
    }
#undef ISSUE
    if (hi == 0) li_l[r32] = l_reg; asm volatile("s_waitcnt lgkmcnt(0)" ::: "memory");
    int r32o = r32, hio = hi; asm volatile("" : "+v"(r32o), "+v"(hio));
    bf16* Ow = Orow0 + (size_t)(wid * 32) * DM + r32o;
#pragma unroll
    for (int r = 0; r < 16; ++r) { const int orow = crow(r, hio); const float rli = __builtin_amdgcn_rcpf(li_l[orow]);
#pragma unroll
        for (int d0 = 0; d0 < 4; ++d0) { const float v = o[d0][r] * rli; const float vn = swz_xor<1>(v);
            if (F8OUT) { if ((r32 & 1) == 0) *(unsigned short*)((unsigned char*)Orow0 + (size_t)(wid * 32 + orow) * DM + d0 * 32 + r32o) = (unsigned short)__builtin_amdgcn_cvt_pk_fp8_f32(v * SC_O, vn * SC_O, 0u, false); }
            else if ((r32 & 1) == 0) *(unsigned*)(Ow + (size_t)orow * DM + d0 * 32) = cvtpk(v, vn); } }
    WAIT_BAR0();
}

#define PK4X(P, B_, OUT) do { unsigned a0 = cvtpk(P[B_+0], P[B_+1]), a1 = cvtpk(P[B_+2], P[B_+3]); unsigned b0 = cvtpk(P[B_+4], P[B_+5]), b1 = cvtpk(P[B_+6], P[B_+7]); \
        auto r0 = __builtin_amdgcn_permlane32_swap(a0, b0, false, false); auto r1 = __builtin_amdgcn_permlane32_swap(a1, b1, false, false); v4u w = {r0[0], r1[0], r0[1], r1[1]}; OUT = __builtin_bit_cast(bf16x8, w); } while (0)
template <int VAR>
__device__ __forceinline__ void diff_unit(LAS unsigned char* lds, const bf16* Qrow0  , const bf16* K1h, const bf16* K2h, const bf16* Vh, bf16* Orow0  ,
                                          int qblk, const float* relb, int h, float lam, const float* subln) {
    const int tid = opaque_tid(), wid = __builtin_amdgcn_readfirstlane(tid >> 6), lane = tid & 63, r32 = lane & 31, hi = lane >> 5, mp = wid >> 2, w4 = wid & 3;
    LAS float* wsf = (LAS float*)(lds + LDSX_OFF) + wid * 64; LAS float* li_l = wsf; LAS float* al_l = wsf + 32;
    LAS float* lut2 = (LAS float*)(lds + LDSX_OFF + 2048);
    if (tid < 2 * 132) { const int m_ = tid / 132, i_ = tid % 132; if (i_ <= 128) lut2[tid] = relb[(i_ < 128 ? (int)T5_BUCKET[i_] : 31) * 12 + 2 * h + m_] * LOG2E; }
    const LAS float* lut = lut2 + mp * 132;
    bf16x8 qr[8];
#pragma unroll
    for (int d0 = 0; d0 < 8; ++d0) qr[d0] = *(const bf16x8*)(Qrow0 + (size_t)(w4 * 32 + r32) * DM + (h + 6 * mp) * HD + d0 * 16 + hi * 8);
    const int krow = 4 * wid + (lane >> 4); const unsigned ksrc = (unsigned) krow * 256 + ((16 * (lane & 15)) ^ ((krow & 7) << 4));
    const int vkk = 8 * (wid >> 1) + ((lane & 31) >> 2); const unsigned vsrc = (unsigned) swap23(vkk) * 512 + (32 * (2 * (wid & 1) + (lane >> 5)) + 8 * (lane & 3)) * 2;
    const unsigned lds0 = (unsigned)(uintptr_t)(lds + RING_OFF);
    const char* K1g = (const char*)K1h; const char* K2g = (const char*)K2h; const char* Vg = (const char*)Vh;
#define ISSUE(t, s) do { const unsigned base_ = (unsigned)__builtin_amdgcn_readfirstlane(lds0 + (s) * 65536 + wid * 1024); const size_t tb_ = (size_t)(t) * SHM_T; \
        glds16(K1g + tb_, ksrc, base_); glds16(K1g + tb_ + 8192, ksrc, base_ + 8192); glds16(K2g + tb_, ksrc, base_ + SHM_T); glds16(K2g + tb_ + 8192, ksrc, base_ + SHM_T + 8192); \
        glds16(Vg + 2 * tb_, vsrc, base_ + 2 * SHM_T); glds16(Vg + 2 * tb_ + 16384, vsrc, base_ + 2 * SHM_T + 8192); \
        glds16(Vg + 2 * tb_ + 256, vsrc, base_ + 3 * SHM_T); glds16(Vg + 2 * tb_ + 256 + 16384, vsrc, base_ + 3 * SHM_T + 8192); } while (0)
#define ISSUE_K(t, s) do { const unsigned base_ = (unsigned)__builtin_amdgcn_readfirstlane(lds0 + (s) * 65536 + wid * 1024); const size_t tb_ = (size_t)(t) * SHM_T; \
        glds16(K1g + tb_, ksrc, base_); glds16(K1g + tb_ + 8192, ksrc, base_ + 8192); glds16(K2g + tb_, ksrc, base_ + SHM_T); glds16(K2g + tb_ + 8192, ksrc, base_ + SHM_T + 8192); } while (0)
#define ISSUE_V(t, s) do { const unsigned base_ = (unsigned)__builtin_amdgcn_readfirstlane(lds0 + (s) * 65536 + wid * 1024); const size_t tb_ = (size_t)(t) * SHM_T; \
        glds16(Vg + 2 * tb_, vsrc, base_ + 2 * SHM_T); glds16(Vg + 2 * tb_ + 16384, vsrc, base_ + 2 * SHM_T + 8192); \
        glds16(Vg + 2 * tb_ + 256, vsrc, base_ + 3 * SHM_T); glds16(Vg + 2 * tb_ + 256 + 16384, vsrc, base_ + 3 * SHM_T + 8192); } while (0)
    const int vb0 = (int)lds0 + 2 * SHM_T + v_rd_base(lane);
    float m_reg = -1e30f, l_reg = 0.f; f32x16 o[8];
#pragma unroll
    for (int d = 0; d < 8; ++d)
#pragma unroll
        for (int r = 0; r < 16; ++r) o[d][r] = 0.f;
    const int q0w = qblk * 128 + w4 * 32, qpos = q0w + r32, NT = 2 * (qblk + 1);
    if (!(VAR & 1)) ISSUE(0, 0);
    for (int t = 0; t < NT; ++t) {
        WAIT_BAR0();
        if (!(VAR & 1)) if (t + 1 < NT) ISSUE(t + 1, (t + 1) & 1);
        const int s = t & 1, tk0 = t * 64;
        if (VAR & 2) continue;
        const bool far = (q0w - (tk0 + 63)) >= 128;
        { f32x16 p; float alpha; bf16x8 pa0, pa1;
          qkt_half(p, (const LAS char*)(lds + RING_OFF + s * 65536 + mp * SHM_T), r32, hi, qr);
          bias_mask_half(p, qpos - tk0 - 4 * hi, far, lut);
          if (VAR & 4) { alpha = 1.f; l_reg += p[0]; PK4X(p, 0, pa0); PK4X(p, 8, pa1); } else { softmax_half(p, m_reg, l_reg, alpha, pa0, pa1);
          RESC(o, 8, al_l, alpha); }
          pv_half8<0>(o, vb0 + s * 65536, pa0, pa1); }
        SBAR();
        { f32x16 p; float alpha; bf16x8 pa0, pa1;
          qkt_half(p, (const LAS char*)(lds + RING_OFF + s * 65536 + mp * SHM_T + 32 * 256), r32, hi, qr);
          bias_mask_half(p, qpos - tk0 - 32 - 4 * hi, far, lut);
          if (VAR & 4) { alpha = 1.f; l_reg += p[0]; PK4X(p, 0, pa0); PK4X(p, 8, pa1); } else { softmax_half(p, m_reg, l_reg, alpha, pa0, pa1);
          RESC(o, 8, al_l, alpha); }
          pv_half8<1>(o, vb0 + s * 65536, pa0, pa1); }
        SBAR();
    }
#undef ISSUE
#undef ISSUE_K
#undef ISSUE_V
    if (hi == 0) li_l[r32] = l_reg;
    WAIT_BAR0();
    int laneo = lane; asm volatile("" : "+v"(laneo));
    LAS float* X = (LAS float*)(lds + RING_OFF) + (w4 * 8 * 16 * 64 + laneo);
    if (mp == 1) {
#pragma unroll
        for (int r = 0; r < 16; ++r) { const float f = lam * __builtin_amdgcn_rcpf(li_l[crow(r, hi)]);
#pragma unroll
            for (int d0 = 0; d0 < 8; ++d0) X[(d0 * 16 + r) * 64] = o[d0][r] * f; }
    }
    WAIT_BAR0();
    if (mp == 0) {
        int r32o = r32, hio = hi; asm volatile("" : "+v"(r32o), "+v"(hio));
        unsigned char* Ow = (unsigned char*)Orow0 + (size_t)(w4 * 32) * DM + r32o; const float* sg = subln + r32o;
#pragma unroll
        for (int r = 0; r < 16; ++r) { const float rli = __builtin_amdgcn_rcpf(li_l[crow(r, hi)]); float ss = 0.f;
#pragma unroll
            for (int d0 = 0; d0 < 8; ++d0) { const float v = o[d0][r] * rli - X[(d0 * 16 + r) * 64]; o[d0][r] = v; ss += v * v; }
            ss += swz_xor<1>(ss); ss += swz_xor<2>(ss); ss += swz_xor<4>(ss); ss += swz_xor<8>(ss); ss += swz_xor<16>(ss);
            const float rs = (1.0f / sqrtf(ss * (1.f / DV) + RMS_EPS)) * (1.f - LAM_INIT); const int orow = crow(r, hio);
#pragma unroll
            for (int d0 = 0; d0 < 8; ++d0) { const float v = o[d0][r] * rs * sg[d0 * 32]; const float vn = swz_xor<1>(v);
                if ((r32 & 1) == 0) *(unsigned short*)(Ow + (size_t)orow * DM + d0 * 32) = (unsigned short)__builtin_amdgcn_cvt_pk_fp8_f32(v * SC_O, vn * SC_O, 0u, false); } }
    }
    WAIT_BAR0();
}

__device__ __forceinline__ void moba_sparse_unit(LAS unsigned char* lds, const bf16* QHb, const bf16* Kblk, const bf16* Vblk, const unsigned* listF, int cntF, const unsigned* listA, int cntA, int j,
                                                 bf16* PO, float* PM, const float* relb, int h) {
    const int tid = opaque_tid(), wid = __builtin_amdgcn_readfirstlane(tid >> 6), lane = tid & 63, r32 = lane & 31, hi = lane >> 5;
    LAS float* wsf = (LAS float*)(lds + LDSX_OFF) + wid * 64; LAS float* li_l = wsf; LAS float* al_l = wsf + 32;
    LAS float* lut = (LAS float*)(lds + LDSX_OFF + 2048);
    if (tid <= 128) lut[tid] = relb[(tid < 128 ? (int)T5_BUCKET[tid] : 31) * 12 + h] * LOG2E;
    const int krow = 4 * wid + (lane >> 4); const unsigned ksrc = (unsigned) krow * 256 + ((16 * (lane & 15)) ^ ((krow & 7) << 4));
    const int vkk = 8 * (wid >> 1) + ((lane & 31) >> 2); const unsigned vsrc = (unsigned) swap23(vkk) * 256 + (32 * (2 * (wid & 1) + (lane >> 5)) + 8 * (lane & 3)) * 2;
    const unsigned lds0 = (unsigned)(uintptr_t)(lds + RING_OFF);
    const char* Kg = (const char*)Kblk; const char* Vg = (const char*)Vblk;
    { const unsigned base_ = (unsigned)__builtin_amdgcn_readfirstlane(lds0 + wid * 1024);
#pragma unroll
      for (int t = 0; t < 4; ++t) { glds16(Kg + t * SHM_T, ksrc, base_ + t * SHM_T); glds16(Kg + t * SHM_T + 8192, ksrc, base_ + t * SHM_T + 8192);
                                    glds16(Vg + t * SHM_T, vsrc, base_ + 65536 + t * SHM_T); glds16(Vg + t * SHM_T + 8192, vsrc, base_ + 65536 + t * SHM_T + 8192); } }
    const int vb0 = (int)lds0 + 65536 + v_rd_base(lane);
    const int gF = (cntF + 31) >> 5, ng = gF + ((cntA + 31) >> 5);
    const float c31 = relb[31 * 12 + h] * LOG2E;
#define GRP_ENT(g_, ent_, val_) do { const bool fr_ = (g_) < gF; const int b0_ = fr_ ? (g_) * 32 : ((g_) - gF) * 32; const int n_ = fr_ ? cntF : cntA; const unsigned* l_ = fr_ ? listF : listA; \
        val_ = (b0_ + r32) < n_; ent_ = l_[val_ ? b0_ + r32 : b0_]; } while (0)
#define LOADQ(dst_, ent_) do { const bf16* qp_ = QHb + (size_t)((ent_) & 0xffffu) * DM + hi * 8; _Pragma("unroll") for (int d0 = 0; d0 < 8; ++d0) dst_[d0] = *(const bf16x8*)(qp_ + d0 * 16); } while (0)
    int g = wid; unsigned ent = 0u, entn = 0u; bool valid = false, validn = false; bf16x8 qr[8], qn[8];
    if (g < ng) { GRP_ENT(g, ent, valid); LOADQ(qr, ent); }
    if (g + 8 < ng) GRP_ENT(g + 8, entn, validn);
    WAIT_BAR0();
    for (; g < ng; g += 8) {
        const bool adj = g >= gF;
        unsigned entnn = 0u; bool validnn = false;
        if (g + 8 < ng) LOADQ(qn, entn);
        if (g + 16 < ng) GRP_ENT(g + 16, entnn, validnn);
        const int srow = (int)(ent & 0xffffu), slot = (int)(ent >> 16);
        float m_reg = -1e30f, l_reg = 0.f; f32x16 o[4];
#pragma unroll
        for (int d = 0; d < 4; ++d)
#pragma unroll
            for (int r = 0; r < 16; ++r) o[d][r] = 0.f;
#pragma unroll 1
        for (int t = 0; t < 4; ++t) {
            f32x16 p0, p1;
            qkt(p0, p1, (const LAS char*)(lds + RING_OFF + t * SHM_T), r32, hi, qr);
            if (adj) bias_mask_tile(p0, p1, srow - (j * 256 + t * 64) - 4 * hi, true, false, lut);
            float alpha; bf16x8 pa0, pa1, pa2, pa3;
            softmax_tile(p0, p1, m_reg, l_reg, alpha, pa0, pa1, pa2, pa3);
            RESC(o, 4, al_l, alpha);
            pv_tile(o, vb0 + t * SHM_T, pa0, pa1, pa2, pa3);
        }
        LAS int* rd = (LAS int*)al_l;
        const int rec = srow * 3 + slot;
        if (hi == 0) { li_l[r32] = l_reg; rd[r32] = valid ? rec : -1;
            if (valid) { PM[(size_t)rec * 2] = m_reg + (adj ? 0.f : c31); PM[(size_t)rec * 2 + 1] = l_reg; } }
        asm volatile("s_waitcnt lgkmcnt(0)" ::: "memory");
        int r32o = r32, hio = hi; asm volatile("" : "+v"(r32o), "+v"(hio));
#pragma unroll
        for (int r = 0; r < 16; ++r) { const int orow = crow(r, hio); const float rli = __builtin_amdgcn_rcpf(li_l[orow]); const int dst = rd[orow];
#pragma unroll
            for (int d0 = 0; d0 < 4; ++d0) { const float v = o[d0][r] * rli; const float vn = swz_xor<1>(v);
                if ((r32 & 1) == 0 && dst >= 0) *(unsigned*)(PO + (size_t)dst * HD + d0 * 32 + r32o) = cvtpk(v, vn); } }
        asm volatile("s_waitcnt lgkmcnt(0)" ::: "memory");
#pragma unroll
        for (int d0 = 0; d0 < 8; ++d0) qr[d0] = qn[d0];
        ent = entn; valid = validn; entn = entnn; validn = validnn;
    }
#undef GRP_ENT
#undef LOADQ
    WAIT_BAR0();
}

__device__ __forceinline__ void moba_final_unit(LAS unsigned char* lds, const bf16* Qrow0, const bf16* Kh, const bf16* Vh, bf16* Orow0, int qb, const unsigned* selrow, const float* relb, int h, const bf16* PO, const float* PM) {
    const int tid = opaque_tid(), wid = __builtin_amdgcn_readfirstlane(tid >> 6), lane = tid & 63, r32 = lane & 31, hi = lane >> 5;
    LAS float* wsf = (LAS float*)(lds + LDSX_OFF) + wid * 64; LAS float* al_l = wsf + 32;
    LAS float* lut = (LAS float*)(lds + LDSX_OFF + 2048);
    LAS float* ftab = (LAS float*)(lds + LDSX_OFF + 4352) + wid * 128;
    if (tid <= 128) lut[tid] = relb[(tid < 128 ? (int)T5_BUCKET[tid] : 31) * 12 + h] * LOG2E;
    bf16x8 qr[8];
#pragma unroll
    for (int d0 = 0; d0 < 8; ++d0) qr[d0] = *(const bf16x8*)(Qrow0 + (size_t)(wid * 32 + r32) * DM + d0 * 16 + hi * 8);
    const unsigned sel = selrow[wid * 32 + r32];
    const int krow = 4 * wid + (lane >> 4); const unsigned ksrc = (unsigned) krow * 256 + ((16 * (lane & 15)) ^ ((krow & 7) << 4));
    const int vkk = 8 * (wid >> 1) + ((lane & 31) >> 2); const unsigned vsrc = (unsigned) swap23(vkk) * 256 + (32 * (2 * (wid & 1) + (lane >> 5)) + 8 * (lane & 3)) * 2;
    const unsigned lds0 = (unsigned)(uintptr_t)(lds + RING_OFF);
    const char* Kg = (const char*)(Kh + (size_t)qb * 256 * HD); const char* Vg = (const char*)(Vh + (size_t)qb * 256 * HD);
    { const unsigned base_ = (unsigned)__builtin_amdgcn_readfirstlane(lds0 + wid * 1024);
#pragma unroll
      for (int t = 0; t < 4; ++t) { glds16(Kg + t * SHM_T, ksrc, base_ + t * SHM_T); glds16(Kg + t * SHM_T + 8192, ksrc, base_ + t * SHM_T + 8192);
                                    glds16(Vg + t * SHM_T, vsrc, base_ + 65536 + t * SHM_T); glds16(Vg + t * SHM_T + 8192, vsrc, base_ + 65536 + t * SHM_T + 8192); } }
    const int vb0 = (int)lds0 + 65536 + v_rd_base(lane);
    float m_reg = -1e30f, l_reg = 0.f; f32x16 o[4];
#pragma unroll
    for (int d = 0; d < 4; ++d)
#pragma unroll
        for (int r = 0; r < 16; ++r) o[d][r] = 0.f;
    const int qrel = wid * 32 + r32;
    WAIT_BAR0();
#pragma unroll 1
    for (int t = 0; t <= (wid >> 1); ++t) {
        f32x16 p0, p1;
        qkt(p0, p1, (const LAS char*)(lds + RING_OFF + t * SHM_T), r32, hi, qr);
        bias_mask_tile(p0, p1, qrel - t * 64 - 4 * hi, true, false, lut);
        float alpha; bf16x8 pa0, pa1, pa2, pa3;
        softmax_tile(p0, p1, m_reg, l_reg, alpha, pa0, pa1, pa2, pa3);
        RESC(o, 4, al_l, alpha);
        pv_tile(o, vb0 + t * SHM_T, pa0, pa1, pa2, pa3);
    }
    const int nsel = __builtin_popcount(sel); const size_t rec0 = (size_t)(qb * 256 + qrel) * 3;
    float mi[3], li[3]; float M = m_reg;
#pragma unroll
    for (int i = 0; i < 3; ++i) { mi[i] = -1e30f; li[i] = 0.f; if (i < nsel) { mi[i] = PM[(rec0 + i) * 2]; li[i] = PM[(rec0 + i) * 2 + 1]; } M = fmaxf(M, mi[i]); }
    const float wo = __builtin_amdgcn_exp2f(m_reg - M); float L = l_reg * wo; float wi[3];
#pragma unroll
    for (int i = 0; i < 3; ++i) { wi[i] = (i < nsel) ? li[i] * __builtin_amdgcn_exp2f(mi[i] - M) : 0.f; L += wi[i]; }
    const float rL = 1.f / L;
    if (hi == 0) { ftab[r32] = wo * rL; ftab[32 + r32] = wi[0] * rL; ftab[64 + r32] = wi[1] * rL; ftab[96 + r32] = wi[2] * rL; }
    WAIT_BAR0();
    int r32o = r32, hio = hi, laneo = lane; asm volatile("" : "+v"(r32o), "+v"(hio), "+v"(laneo));
    LAS float* X = (LAS float*)(lds + RING_OFF) + wid * 4096;
#pragma unroll
    for (int r = 0; r < 16; ++r) { const int orow = crow(r, hio); const float fo = ftab[orow];
#pragma unroll
        for (int d0 = 0; d0 < 4; ++d0) X[orow * 128 + d0 * 32 + r32o] = o[d0][r] * fo; }
    asm volatile("s_waitcnt lgkmcnt(0)" ::: "memory");
    { const int rg = laneo >> 4, c = laneo & 15;
      unsigned char* Ow = (unsigned char*)Orow0 + (size_t)(wid * 32) * DM + 8 * c;
      const bf16* Pw = PO + ((size_t)(qb * 256 + wid * 32) * 3) * HD + 8 * c;
#pragma unroll 2
      for (int it = 0; it < 8; ++it) { const int row = it * 4 + rg;
          const f32x4 x0 = *(const LAS f32x4*)(X + row * 128 + 8 * c), x1 = *(const LAS f32x4*)(X + row * 128 + 8 * c + 4);
          float v[8] = {x0[0], x0[1], x0[2], x0[3], x1[0], x1[1], x1[2], x1[3]};
#pragma unroll
          for (int i = 0; i < 3; ++i) { const float f = ftab[32 * (i + 1) + row];
              if (f != 0.f) { const v4u w = *(const v4u*)(Pw + ((size_t)row * 3 + i) * HD);
                  v[0] += f * bflo(w.x); v[1] += f * bfhi(w.x); v[2] += f * bflo(w.y); v[3] += f * bfhi(w.y); v[4] += f * bflo(w.z); v[5] += f * bfhi(w.z); v[6] += f * bflo(w.w); v[7] += f * bfhi(w.w); } }
          unsigned w0 = 0u, w1 = 0u;
          w0 = __builtin_amdgcn_cvt_pk_fp8_f32(v[0] * SC_O, v[1] * SC_O, w0, false); w0 = __builtin_amdgcn_cvt_pk_fp8_f32(v[2] * SC_O, v[3] * SC_O, w0, true);
          w1 = __builtin_amdgcn_cvt_pk_fp8_f32(v[4] * SC_O, v[5] * SC_O, w1, false); w1 = __builtin_amdgcn_cvt_pk_fp8_f32(v[6] * SC_O, v[7] * SC_O, w1, true);
          *(v2u*)(Ow + (size_t)row * DM) = (v2u){w0, w1}; } }
    WAIT_BAR0();
}
#undef RESC
}

__device__ __forceinline__ int queue_next(gu32* ctr, LAS unsigned char* lds) {
    volatile LAS int* slot = (volatile LAS int*)(lds + LDSX_OFF + 4096);
    if (threadIdx.x == 0) slot[0] = (int)__hip_atomic_fetch_add(ctr, 1u, RLX_AGENT);
    __syncthreads();
    return __builtin_amdgcn_readfirstlane(slot[0]);
}

__device__ __forceinline__ void phase_moba_sparse(const Args& a, LAS unsigned char* lds, gu32* qctr) {
    unsigned char* ws = opaque_ws(a.ws);
    const bf16* QH = (const bf16*)(ws + WS_QH); const bf16* KH = (const bf16*)(ws + WS_KH); const bf16* VH = (const bf16*)(ws + WS_VH);
    const unsigned* MC = (const unsigned*)(ws + WS_CTL) + CW_MC;
    for (;;) {
        const int uq = queue_next(qctr, lds);
        if (uq >= 744 + CONV_NCH / 2) break;
        const Mix mx = mix_decode(uq, 744, CONV_NCH / 2);
        if (mx.conv) { conv_chunk(a, lds, 0, mx.idx); continue; }
        const int u = mx.idx;
        const int j = u / 24, bh = u % 24, b = bh / 12, h = bh % 12;
        const int cntA = (int)MC[(bh * 32 + j) * 2], cntF = (int)MC[(bh * 32 + j) * 2 + 1];
        const bf16* QHb = QH + (size_t)b * SEQ * DM + h * HD; const bf16* Kblk = KH + ((size_t)bh * SEQ + j * 256) * HD; const bf16* Vblk = VH + ((size_t)bh * SEQ + j * 256) * HD;
        bf16* PO = (bf16*)(ws + WS_PO) + (size_t)bh * SEQ * 3 * HD; float* PM = (float*)(ws + WS_PM) + (size_t)bh * SEQ * 3 * 2;
        att::moba_sparse_unit(lds, QHb, Kblk, Vblk, (const unsigned*)(ws + WS_LISTF) + ((size_t)bh * 32 + j) * 8192, cntF, (const unsigned*)(ws + WS_LISTA) + ((size_t)bh * 32 + j) * 256, cntA, j, PO, PM, a.in[I_RELB], h);
    }
}
__device__ __forceinline__ void phase_attn_a(const Args& a, LAS unsigned char* lds, gu32* qctr) {
    unsigned char* ws = opaque_ws(a.ws);
    const bf16* QH = (const bf16*)(ws + WS_QH); const bf16* KH = (const bf16*)(ws + WS_KH); const bf16* VH = (const bf16*)(ws + WS_VH); bf16* OC = (bf16*)(ws + WS_OCAT);
    const unsigned* SEL = (const unsigned*)(ws + WS_SMALL + SM_SEL);
    for (;;) {
        const int uq = queue_next(qctr, lds);
        if (uq >= 768 + 256 + CONV_NCH / 2) break;
        const Mix mx = mix_decode(uq, 768 + 256, CONV_NCH / 2);
        if (mx.conv) { conv_chunk(a, lds, 0, CONV_NCH / 2 + mx.idx); continue; }
        const int u = mx.idx;
        if (u < 768) { const int qb = 31 - u / 24, bh = u % 24, b = bh / 12, h = bh % 12; const size_t row0 = (size_t)b * SEQ + qb * 256;
            att::moba_final_unit(lds, QH + row0 * DM + h * HD, KH + (size_t)bh * SEQ * HD, VH + (size_t)bh * SEQ * HD, (bf16*)((unsigned char*)OC + row0 * DM + h * HD), qb,
                                 SEL + (size_t)bh * SEQ + qb * 256, a.in[I_RELB], h, (const bf16*)(ws + WS_PO) + (size_t)bh * SEQ * 3 * HD, (const float*)(ws + WS_PM) + (size_t)bh * SEQ * 3 * 2);
        } else { const int v = u - 768, b = v >> 7, hm = (v >> 5) & 3, qb = v & 31; const size_t row0 = (size_t)b * SEQ + qb * 256;
            const size_t mo = (size_t)((0 * 2 + b) * 4 + hm) * NMEM * HD;
            att::attn128_unit<1, true>(lds, QH + row0 * DM + (12 + hm) * HD, (const bf16*)(ws + WS_SMALL + SM_KM) + mo, (const bf16*)(ws + WS_SMALL + SM_VM) + mo, (bf16*)((unsigned char*)OC + row0 * DM + MIXW + hm * HD), 4, 0, nullptr, nullptr, 0);
        }
    }
}
template <int VAR>
__device__ __forceinline__ void phase_attn_b(const Args& a, LAS unsigned char* lds, gu32* qctr, bf16* OC) {
    unsigned char* ws = opaque_ws(a.ws);
    const bf16* QH = (const bf16*)(ws + WS_QH); const bf16* KH = (const bf16*)(ws + WS_KH); const bf16* VH = (const bf16*)(ws + WS_VH);
    float lam;
    { const float* lb = a.in[I_LAMBDA]; const int lane = opaque_tid() & 63;
      float s1 = lb[lane] * lb[128 + lane] + lb[64 + lane] * lb[128 + 64 + lane], s2 = lb[256 + lane] * lb[384 + lane] + lb[256 + 64 + lane] * lb[384 + 64 + lane];
      s1 = wave_sum(s1); s2 = wave_sum(s2); lam = expf(s1) - expf(s2) + LAM_INIT; }
    for (;;) {
        const int uq = queue_next(qctr, lds);
        if (uq >= 768 + 256 + CONV_NCH) break;
        const Mix mx = mix_decode(uq, 768 + 256, CONV_NCH);
        if (mx.conv) { conv_chunk(a, lds, 1, mx.idx); continue; }
        const int u = mx.idx;
        if (u < 768) { const int qblk = 63 - u / 12, bh = u % 12, b = bh / 6, h = bh % 6; const size_t row0 = (size_t)b * SEQ + qblk * 128;
            att::diff_unit<VAR>(lds, QH + row0 * DM, KH + (size_t)(b * 12 + h) * SEQ * HD, KH + (size_t)(b * 12 + 6 + h) * SEQ * HD, VH + (size_t)(b * 6 + h) * SEQ * DV, (bf16*)((unsigned char*)OC + row0 * DM + h * DV),
                           qblk, a.in[I_RELB], h, lam, a.in[I_SUBLN]);
        } else { const int v = u - 768, b = v >> 7, hm = (v >> 5) & 3, qb = v & 31; const size_t row0 = (size_t)b * SEQ + qb * 256;
            const size_t mo = (size_t)((1 * 2 + b) * 4 + hm) * NMEM * HD;
            att::attn128_unit<1, true>(lds, QH + row0 * DM + (12 + hm) * HD, (const bf16*)(ws + WS_SMALL + SM_KM) + mo, (const bf16*)(ws + WS_SMALL + SM_VM) + mo, (bf16*)((unsigned char*)OC + row0 * DM + MIXW + hm * HD), 4, 0, nullptr, nullptr, 0);
        }
    }
}

template <int RV>
__device__ __forceinline__ void phase_router(const Args& a, LAS unsigned char* lds, int G, int vb, int layer) {
    unsigned char* ws = opaque_ws(a.ws);
    const int tid = opaque_tid(), lane = tid & 63, wave = __builtin_amdgcn_readfirstlane(tid >> 6), i16 = lane & 15, g4 = lane >> 4, tg = wave & 1, kq = wave >> 1;
    const bf16* H = (const bf16*)(ws + WS_HB);
    const bf16* WRh = (const bf16*)(ws + WS_W_RT) + (size_t)layer * 2 * NRTP * DM;
    LAS float* L = (LAS float*)(lds + RING_OFF);
    LAS int* cnt = (LAS int*)(lds + RING_OFF + 4 * 64 * NRTP * 4);
    for (int blk = vb; blk < T / 64; blk += G) {
        if (tid < 64) cnt[tid] = 0;
        f32x4 acc[2][5];
#pragma unroll
        for (int t2 = 0; t2 < 2; ++t2)
#pragma unroll
            for (int j = 0; j < 5; ++j) acc[t2][j] = (f32x4){0.f, 0.f, 0.f, 0.f};
        const bf16* hrow = H + (size_t)(blk * 64 + tg * 32 + i16) * DM + kq * 512 + 8 * g4;
        const bf16* wh = WRh + (size_t)i16 * DM + kq * 512 + 8 * g4;
#pragma unroll 4
        for (int ks = 0; ks < ((RV & 1) ? 0 : 16); ++ks) {
            bf16x8 fa[2];
#pragma unroll
            for (int t2 = 0; t2 < 2; ++t2) fa[t2] = *(const bf16x8*)(hrow + (size_t)t2 * 16 * DM + ks * 32);
#pragma unroll
            for (int jt = 0; jt < 5; ++jt) {
                const bf16x8 bh = *(const bf16x8*)(wh + (size_t)jt * 16 * DM + ks * 32);
#pragma unroll
                for (int t2 = 0; t2 < 2; ++t2) acc[t2][jt] = __builtin_amdgcn_mfma_f32_16x16x32_bf16(fa[t2], bh, acc[t2][jt], 0, 0, 0);
            }
        }
#pragma unroll
        for (int t2 = 0; t2 < 2; ++t2)
#pragma unroll
            for (int jt = 0; jt < 5; ++jt)
#pragma unroll
                for (int r = 0; r < 4; ++r) L[(kq * 64 + tg * 32 + t2 * 16 + 4 * g4 + r) * NRTP + jt * 16 + i16] = acc[t2][jt][r];
        __syncthreads();
        if (tid < 64 && !(RV & 2)) {
            const int tok = blk * 64 + tid;
            const float* part = (const float*)(ws + WS_SMALL + SM_PART) + (size_t)tok * 32;
            float ss = 0.f;
#pragma unroll
            for (int i = 0; i < 32; ++i) ss += part[i];
            const float rstd = 1.0f / sqrtf(ss * (1.f / DM) + RMS_EPS);
            const LAS float* l0 = L + tid * NRTP;
            const float* brg = a.in[I_B_RG] + layer * 8; const float* bre = a.in[I_B_RE] + layer * 64;
            float gmax = -__builtin_inff(); int gi = 0; float gl[8];
#pragma unroll
            for (int j = 0; j < 8; ++j) { gl[j] = ((l0[j] + l0[64 * NRTP + j]) + (l0[128 * NRTP + j] + l0[192 * NRTP + j])) * rstd + brg[j]; if (gl[j] > gmax) { gmax = gl[j]; gi = j; } }
            float gs = 0.f;
#pragma unroll
            for (int j = 0; j < 8; ++j) gs += expf(gl[j] - gmax);
            const float pg = 1.f / gs;
            float v0 = -__builtin_inff(), v1 = -__builtin_inff(); int i0 = 0, i1 = 0;
#pragma unroll
            for (int j = 0; j < 8; ++j) { const int ix = 8 + gi * 8 + j; const float e = ((l0[ix] + l0[64 * NRTP + ix]) + (l0[128 * NRTP + ix] + l0[192 * NRTP + ix])) * rstd + bre[gi * 8 + j];
                if (e > v0) { v1 = v0; i1 = i0; v0 = e; i0 = j; } else if (e > v1) { v1 = e; i1 = j; } }
            const float dd = expf(v1 - v0), w0 = pg / (1.f + dd), w1 = pg * dd / (1.f + dd);
            const int e0 = gi * 8 + i0, e1 = gi * 8 + i1;
            v4u tr; tr.x = (unsigned)e0; tr.y = (unsigned)e1; tr.z = __float_as_uint(w0); tr.w = __float_as_uint(w1);
            *(v4u*)(ws + WS_SMALL + SM_TOKR + (size_t)tok * 16) = tr;
            ((float*)(ws + WS_SMALL + SM_RSTD))[tok] = rstd;
            __hip_atomic_fetch_add(cnt + e0, 1, __ATOMIC_RELAXED, __HIP_MEMORY_SCOPE_WORKGROUP);
            __hip_atomic_fetch_add(cnt + e1, 1, __ATOMIC_RELAXED, __HIP_MEMORY_SCOPE_WORKGROUP);
        }
        __syncthreads();
        if (tid < 64 && !(RV & 2)) ((int*)(ws + WS_SMALL + SM_CNT))[blk * 64 + tid] = cnt[tid];
        __syncthreads();
    }
}

__device__ __forceinline__ void phase_gather(const Args& a, LAS unsigned char* lds, int G, int vb) {
    unsigned char* ws = opaque_ws(a.ws);
    const int tid = opaque_tid(), lane = tid & 63, wave = __builtin_amdgcn_readfirstlane(tid >> 6);
    const int* CNT = (const int*)(ws + WS_SMALL + SM_CNT); int* BLKE = (int*)(ws + WS_SMALL + SM_BLKE); int* DEST = (int*)(ws + WS_SMALL + SM_DEST);
    const unsigned* TOKR = (const unsigned*)(ws + WS_SMALL + SM_TOKR);
    int* ROWTOK = (int*)(ws + WS_SMALL + SM_ROWTOK);
    LAS int* tot = (LAS int*)(lds + RING_OFF); LAS int* pre = tot + 64; LAS int* pst = tot + 128; LAS int* destl = tot + 192;
    LAS int* part8 = tot + 320;
    LAS int* tokl = tot + 320 + 1024;
    for (int blk = vb; blk < T / 64; blk += G) {
        { const int e = tid & 63, p8 = tid >> 6; int t_ = 0, p_ = 0;
#pragma unroll 8
          for (int b2 = p8 * 32; b2 < p8 * 32 + 32; ++b2) { const int c = CNT[b2 * 64 + e]; t_ += c; p_ += (b2 < blk) ? c : 0; }
          part8[(p8 * 64 + e) * 2] = t_; part8[(p8 * 64 + e) * 2 + 1] = p_;
          if (tid < 128) tokl[tid] = (int)TOKR[(size_t)(blk * 64 + (tid >> 1)) * 4 + (tid & 1)]; }
        __syncthreads();
        if (tid < 64) { int t_ = 0, p_ = 0;
#pragma unroll
            for (int p8 = 0; p8 < 8; ++p8) { t_ += part8[(p8 * 64 + tid) * 2]; p_ += part8[(p8 * 64 + tid) * 2 + 1]; }
            tot[tid] = t_; pre[tid] = p_;
            const int padded = ((t_ + 255) >> 8) << 8; int incl = padded;
#pragma unroll
            for (int o = 1; o < 64; o <<= 1) { const int up = __shfl_up(incl, o); if (tid >= o) incl += up; }
            pst[tid] = incl - padded;
            if (blk == 0 && tid == 63) BLKE[MAXRB] = incl >> 8; }
        __syncthreads();
        if (tid < 64) {
            if (blk == 0) { const int rb0 = pst[tid] >> 8, rb1 = (pst[tid] + (((tot[tid] + 255) >> 8) << 8)) >> 8; for (int rb = rb0; rb < rb1; ++rb) BLKE[rb] = tid; }
            int r = pst[tid] + pre[tid];
            for (int as = 0; as < 128; ++as) { if (tokl[as] == tid) destl[as] = r++; }
        }
        __syncthreads();
        if (tid < 128) { const int tok = blk * 64 + (tid >> 1), dest = destl[tid]; DEST[tok * 2 + (tid & 1)] = dest; ROWTOK[dest] = tok; }
        if (blk < 64) {
            const int r0 = pst[blk] + tot[blk], r1 = pst[blk] + (((tot[blk] + 255) >> 8) << 8);
            for (int r = r0 + tid; r < r1; r += 512) ROWTOK[r] = 0;
        }
        __syncthreads();
    }
}

__device__ __forceinline__ void phase_combine(const Args& a, int G, int vb, float* Fout  ) {
    unsigned char* ws = opaque_ws(a.ws);
    const int tid = opaque_tid(), lane = tid & 63, wave = __builtin_amdgcn_readfirstlane(tid >> 6);
    const int gw = vb * 8 + wave, NGW = G * 8;
    const bf16* YS = (const bf16*)(ws + WS_YS); const int* DEST = (const int*)(ws + WS_SMALL + SM_DEST); float* RSTD = (float*)(ws + WS_SMALL + SM_RSTD); bf16* HB = (bf16*)(ws + WS_HB);
    for (int tok = gw; tok < T; tok += NGW) {
        const v4u tr = *(const v4u*)(ws + WS_SMALL + SM_TOKR + (size_t)tok * 16); const float w0 = __uint_as_float(tr.z), w1 = __uint_as_float(tr.w);
        const int d0 = DEST[tok * 2], d1 = DEST[tok * 2 + 1];
        GAS v2u* hr = (GAS v2u*)(HB + (size_t)tok * DM) + lane;
        const GAS v2u* y0 = (const GAS v2u*)(YS + (size_t)d0 * DM) + lane; const GAS v2u* y1 = (const GAS v2u*)(YS + (size_t)d1 * DM) + lane;
        v2u hv[8], a0[8], a1[8];
#pragma unroll
        for (int j = 0; j < 8; ++j) { hv[j] = hr[64 * j]; a0[j] = y0[64 * j]; a1[j] = y1[64 * j]; }
        float ss = 0.f;
#pragma unroll
        for (int j = 0; j < 8; ++j) { f32x4 v;
            v.x = bflo(hv[j].x) + (w0 * bflo(a0[j].x) + w1 * bflo(a1[j].x)); v.y = bfhi(hv[j].x) + (w0 * bfhi(a0[j].x) + w1 * bfhi(a1[j].x));
            v.z = bflo(hv[j].y) + (w0 * bflo(a0[j].y) + w1 * bflo(a1[j].y)); v.w = bfhi(hv[j].y) + (w0 * bfhi(a0[j].y) + w1 * bfhi(a1[j].y));
            ss += (v.x * v.x + v.y * v.y) + (v.z * v.z + v.w * v.w);
            if (Fout) ((GAS f32x4*)(Fout + (size_t)tok * DM) + lane)[64 * j] = v;
            else { v2u o; o.x = pk2(v.x, v.y); o.y = pk2(v.z, v.w); hr[64 * j] = o;
                   unsigned w8 = 0u; w8 = __builtin_amdgcn_cvt_pk_fp8_f32(v.x, v.y, w8, false); w8 = __builtin_amdgcn_cvt_pk_fp8_f32(v.z, v.w, w8, true); ((GAS unsigned*)(ws + WS_HB8 + (size_t)tok * DM) + lane)[64 * j] = w8; } }
        if (!Fout) { const float rstd = 1.0f / sqrtf(wave_sum(ss) * (1.f / DM) + RMS_EPS); if (lane == 0) RSTD[tok] = rstd; }
    }
}

#ifndef MK_DUP
#define MK_DUP -1
#endif
#define DUP(k) (MK_DUP == (k))
#ifndef MK_VAR
#define MK_VAR 0
#endif
#ifndef FP8IN_SP2
#define FP8IN_SP2 true
#endif
constexpr int NPH = 21;
__global__ void __launch_bounds__(512, 2) yoco_fwd(Args args) {
    extern __shared__ __attribute__((aligned(16))) unsigned char lds_raw[];
    LAS unsigned char* lds = (LAS unsigned char*)lds_raw;
    const int tid = opaque_tid();
    const int G = gridDim.x; const int bx0 = blockIdx.x; const int vb = (G % 8 == 0) ? (bx0 % 8) * (G / 8) + bx0 / 8 : bx0;
    unsigned char* ws = args.ws;
    gu32* ctl = (gu32*)(ws + WS_CTL);
    for (int u = tid; u < (LDS_BYTES - LDSCTL_OFF) / 4; u += 512) ((LAS unsigned*)(lds + LDSCTL_OFF))[u] = 0u;
    __syncthreads();
    volatile LAS unsigned* MISC = (volatile LAS unsigned*)(lds + MISC_OFF);
#if MK_N_LAUNCHES == 1
    constexpr int lo = 0, hi = NPH; constexpr bool one = true;
#else
    const int lo = args.ph_lo, hi = args.ph_hi;
    const bool one = (hi - lo) > 1;
#endif
    XcdBarrier bar; bar.bar = (unsigned*)(ctl + CW_BAR); bar.x = 0; bar.st = nullptr;
    if (one) bar = xcd_barrier_post((unsigned*)(ctl + CW_BAR), MISC + 8);
#define GBAR() do { XcdBarrier b2_ = bar; b2_.bar = (unsigned*)opaque_ws((unsigned char*)bar.bar); { unsigned x_ = bar.x; asm volatile("" : "+s"(x_)); b2_.x = x_; } xcd_barrier(b2_); } while (0)
#define IN(k) (lo <= (k) && (k) < hi)
#define SEAM(k) do { if (IN(k) && IN((k) + 1)) GBAR(); } while (0)

#define RUN(k, ...) do { if (IN(k)) { __VA_ARGS__ if (DUP(k)) { __syncthreads(); __VA_ARGS__ } } } while (0)
    RUN(0, phase_prep(args, lds, G, vb););
    SEAM(0);
    for (int l = 0; l < 2; ++l) {
        const int pb = 1 + 10 * l;
        int bx = bx0; asm volatile("" : "+s"(bx));
        RUN(pb + 0,
            { pg8::Gemm g{(const bf16*)(ws + WS_HB8), (const bf16*)(ws + (l == 0 ? WS_W_INA : WS_W_INB)), T, PROJW, DM / 2}; pg8::StaticOrder S; S.init(T, PROJW, G, bx);
              EpiHeadNorm E{ws, l, 1.f / SC_W1};
              pg8::gemm_phase<EpiHeadNorm, pg8::StaticOrder, true, FP8IN_SP2, false, true>(lds + RING_OFF, g, S, E); }
            );
        if (one) GBAR();
        if (l == 0) { if (IN(pb + 2)) {
                if (bx < 16) { pg8::Gemm g{(const bf16*)(ws + WS_SMALL + SM_MEMN), (const bf16*)(ws + WS_W_MKV), NB * NMEM, 2048, DM}; pg8::StaticOrder S; S.init(NB * NMEM, 2048, G, bx);
                    EpiRowScale E{(bf16*)(ws + WS_SMALL + SM_KVM), 2048, nullptr, 0, 1.f};
                    pg8::gemm_phase<EpiRowScale, pg8::StaticOrder, true, true>(lds + RING_OFF, g, S, E); }
                else phase_gate(args, lds, G - 16, bx - 16); }
            if (one) GBAR(); }
        if (IN(pb + 3)) { if (l == 0) { phase_post_mem(args, lds, G, vb); phase_moba_sparse(args, lds, ctl + CW_Q + 256); if (DUP(40)) { __syncthreads(); phase_moba_sparse(args, lds, ctl + CW_Q + 320); } if (one) GBAR(); phase_attn_a(args, lds, ctl + CW_Q); if (DUP(41)) { __syncthreads(); phase_attn_a(args, lds, ctl + CW_Q + 128); } }
            else { phase_attn_b<0>(args, lds, ctl + CW_Q + 64, (bf16*)(ws + WS_OCAT)); if (DUP(14)) { __syncthreads(); phase_attn_b<MK_VAR>(args, lds, ctl + CW_Q + 192, (bf16*)(ws + WS_YS)); } } }
        SEAM(pb + 3);
        RUN(pb + 4,
            { pg8::Gemm g8{(const bf16*)(ws + WS_OCAT), (const bf16*)(ws + WS_W_OUT + (size_t)l * DM * DM), T, DM, DM / 2}; pg8::StaticOrder S; S.init(T, DM, G, bx);
              if (l == 0) { EpiOutProj<true> E{args.in[I_X], (float*)(ws + WS_SMALL + SM_PART), (bf16*)(ws + WS_HB), ws + WS_HB8, 1.f / (SC_O * SC_W1)}; pg8::gemm_phase<EpiOutProj<true>, pg8::StaticOrder, true, true, false, true>(lds + RING_OFF, g8, S, E); }
              else { EpiOutProj<false> E{nullptr, (float*)(ws + WS_SMALL + SM_PART), (bf16*)(ws + WS_HB), ws + WS_HB8, 1.f / (SC_O * SC_W1)}; pg8::gemm_phase<EpiOutProj<false>, pg8::StaticOrder, true, true, false, true>(lds + RING_OFF, g8, S, E); } });
        SEAM(pb + 4);
        if (IN(pb + 5)) { phase_router<0>(args, lds, G, vb, l); if (DUP(pb + 5)) { __syncthreads(); phase_router<MK_VAR>(args, lds, G, vb, l); } }
        SEAM(pb + 5);
        RUN(pb + 6, phase_gather(args, lds, G, vb););
        SEAM(pb + 6);
        RUN(pb + 7,
            { const int* blke = (const int*)(ws + WS_SMALL + SM_BLKE);
              const int* rowtok = (const int*)(ws + WS_SMALL + SM_ROWTOK);
              pg8::Gemm g{(const bf16*)(ws + WS_HB8), (const bf16*)(ws + WS_W_E1 + (size_t)l * NEXP * 1024 * DM), MAXRB * 256, 1024, DM / 2, rowtok};
              MoeOrder S{blke, blke[MAXRB] * 4, 4, G, bx}; EpiSiluMul E{(bf16*)(ws + WS_HID), (const float*)(ws + WS_SMALL + SM_RSTD), rowtok};
              pg8::gemm_phase<EpiSiluMul, MoeOrder, true, true, true, true>(lds + RING_OFF, g, S, E); });
        SEAM(pb + 7);
        RUN(pb + 8,
            { const int* blke = (const int*)(ws + WS_SMALL + SM_BLKE);
              pg8::Gemm g{(const bf16*)(ws + WS_HID), (const bf16*)(ws + WS_W_E2 + (size_t)l * NEXP * DM * EFF), MAXRB * 256, DM, EFF / 2};
              MoeOrder S{blke, blke[MAXRB] * 8, 8, G, bx}; EpiRowScale E{(bf16*)(ws + WS_YS), DM, nullptr, 8, 1.f / (SC_HID * SC_W2)};
              pg8::gemm_phase<EpiRowScale, MoeOrder, true, true, false, true>(lds + RING_OFF, g, S, E); });
        SEAM(pb + 8);
        if (IN(pb + 9)) phase_combine(args, G, vb, l == 0 ? nullptr : args.out);
        if (l == 0) SEAM(pb + 9);
    }
#undef RUN
#undef IN
#undef SEAM
}

extern "C" void kernel_launch(void* const* d_in, const int* in_sizes, int n_in, void* d_out, int out_size, void* d_ws, size_t ws_size, hipStream_t stream) {
    static int grid = 0;
    if (grid == 0) {
        if (n_in != N_IN || out_size != T * DM || ws_size < WS_END) { fprintf(stderr, "kernel_launch: unexpected shapes (n_in %d out %d ws %zu)\n", n_in, out_size, ws_size); grid = -1; return; }
        int dev = 0, cus = 0;
        if (hipGetDevice(&dev) != hipSuccess || hipDeviceGetAttribute(&cus, hipDeviceAttributeMultiprocessorCount, dev) != hipSuccess) { grid = -1; return; }
        if (hipFuncSetAttribute((const void*)yoco_fwd, hipFuncAttributeMaxDynamicSharedMemorySize, LDS_BYTES) != hipSuccess) { fprintf(stderr, "kernel_launch: hipFuncSetAttribute failed\n"); grid = -1; return; }
        int per_cu = 0;
        if (hipOccupancyMaxActiveBlocksPerMultiprocessor(&per_cu, (const void*)yoco_fwd, 512, LDS_BYTES) != hipSuccess || per_cu < 1) fprintf(stderr, "kernel_launch: occupancy query reports %d\n", per_cu);
        (void)hipGetLastError();
        grid = cus;
    }
    if (grid < 0) return;
    (void)hipMemsetAsync((char*)d_ws + WS_CTL, 0, CTL_ZERO_BYTES, stream);
    Args a{};
    for (int i = 0; i < N_IN; ++i) a.in[i] = (const float*)d_in[i];
    a.out = (float*)d_out; a.ws = (unsigned char*)d_ws;
#if MK_N_LAUNCHES == 1
    a.ph_lo = 0; a.ph_hi = NPH;
    hipLaunchKernelGGL(yoco_fwd, dim3(grid), dim3(512), LDS_BYTES, stream, a);
#else
    for (int p = 0; p < NPH; ++p) { if (p == 13) continue; a.ph_lo = p; a.ph_hi = p + 1; hipLaunchKernelGGL(yoco_fwd, dim3(grid), dim3(512), LDS_BYTES, stream, a); }
#endif
}
```

```cpp
#include <hip/hip_runtime.h>
#include <cstdio>
#include <cstdint>

#ifndef MK_N_LAUNCHES
#define MK_N_LAUNCHES 1
#endif
#ifndef MK_CHECK
#define MK_CHECK 0
#endif

constexpr int NB = 2, SEQ = 8192, T = NB * SEQ, DM = 2048, HD = 128;
constexpr int NMEM = 256, MEMH = 4, MEMW = 512, MIXW = 1536, MOBA_H = 12, DIFF_H = 6, DV = 256;
constexpr int NEXP = 64, NGRP = 8, EPG = 8, EFF = 512, NRT = 72, NRTP = 80;
constexpr int PROJW = 5120;
constexpr float RMS_EPS = 1e-6f;
constexpr float LOG2E = 1.4426950408889634f;
constexpr float QSCALE = 0.08838834764831845f * LOG2E;
constexpr float LAM_INIT = 0.35550906759096926f;
constexpr int MAXRB = 192;
constexpr float SC_W1 = 64.f, SC_W2 = 32.f, SC_HID = 8.f, SC_O = 16.f;

constexpr size_t MiB = 1u << 20;
constexpr size_t WS_CTL = 0, CTL_ZERO_BYTES = 1 * MiB;
constexpr size_t WS_W_INA = 1 * MiB;
constexpr size_t WS_W_INB = 21 * MiB;
constexpr size_t WS_W_OUT = 41 * MiB;
constexpr size_t WS_W_MKV = 57 * MiB;
constexpr size_t WS_W_RT  = 65 * MiB;
constexpr size_t WS_W_E1  = 67 * MiB;
constexpr size_t WS_HB8   = 323 * MiB;
constexpr size_t WS_W_E2  = 579 * MiB;
constexpr size_t WS_SMALL = 835 * MiB;
constexpr size_t WS_HB    = 851 * MiB;
constexpr size_t WS_PROJ  = 915 * MiB;
constexpr size_t WS_QH    = 1075 * MiB;
constexpr size_t WS_KH    = 1139 * MiB;
constexpr size_t WS_VH    = 1187 * MiB;
constexpr size_t WS_XS    = WS_PROJ;
constexpr size_t WS_OCAT  = 1235 * MiB;
constexpr size_t WS_HID   = 1299 * MiB;
constexpr size_t WS_YS    = 1347 * MiB;
constexpr size_t WS_HA    = 1539 * MiB;
constexpr size_t WS_H2    = 1667 * MiB;
constexpr size_t WS_LISTF = 1795 * MiB;
constexpr size_t WS_LISTA = 1821 * MiB;
constexpr size_t WS_PM    = 1822 * MiB;
constexpr size_t WS_PO    = WS_PROJ;
constexpr size_t WS_END   = 1827 * MiB;
static_assert(WS_XS + (size_t)MAXRB * 256 * 2048 * 2 <= WS_VH, "XS alias");
constexpr size_t SM_RSTD  = 0;
constexpr size_t SM_PART  = 1 * MiB;
constexpr size_t SM_TOKR  = 3 * MiB;
constexpr size_t SM_DEST  = 4 * MiB;
constexpr size_t SM_CNT   = 5 * MiB;
constexpr size_t SM_BLKE  = 5 * MiB + 128 * 1024;
constexpr size_t SM_KMEAN = 6 * MiB;
constexpr size_t SM_SEL   = 7 * MiB;
constexpr size_t SM_MEMN  = 8 * MiB;
constexpr size_t SM_KVM   = 10 * MiB;
constexpr size_t SM_KM    = 12 * MiB;
constexpr size_t SM_VM    = 13 * MiB;
constexpr size_t SM_GAINTAB = 15 * MiB;
constexpr size_t SM_ROWTOK = 14 * MiB;
constexpr int CW_BAR = 4096;
constexpr int CW_Q = 8192;
constexpr int CW_MC = 16384;

constexpr int RING_OFF = 0, RING_BYTES = 131072;
constexpr int LDSX_OFF = RING_BYTES;
constexpr int LDSCTL_OFF = RING_BYTES + 12288, MISC_OFF = LDSCTL_OFF + 320;
constexpr int LDS_BYTES = 147456;
static_assert(MISC_OFF + 128 <= LDS_BYTES, "LDS map");

#define GAS __attribute__((address_space(1)))
#define LAS __attribute__((address_space(3)))
typedef unsigned short bf16;
typedef unsigned v4u __attribute__((ext_vector_type(4)));
typedef unsigned v2u __attribute__((ext_vector_type(2)));
typedef float f32x4 __attribute__((ext_vector_type(4)));
typedef float f32x16 __attribute__((ext_vector_type(16)));
typedef short bf16x8 __attribute__((ext_vector_type(8)));
typedef short s16x4 __attribute__((ext_vector_type(4)));
typedef GAS unsigned gu32;
#define RLX_AGENT __ATOMIC_RELAXED, __HIP_MEMORY_SCOPE_AGENT
#define LDS_WAIT() asm volatile("s_waitcnt lgkmcnt(0)" ::: "memory")
#define VM_WAIT() asm volatile("s_waitcnt vmcnt(0)" ::: "memory")
__device__ __forceinline__ unsigned f2bf(float f) { unsigned u = __builtin_bit_cast(unsigned, f); return (u + 0x7fffu + ((u >> 16) & 1u)) >> 16; }
__device__ __forceinline__ unsigned pk2(float lo, float hi) { return f2bf(lo) | (f2bf(hi) << 16); }
__device__ __forceinline__ float bf2f(unsigned short b) { return __builtin_bit_cast(float, (unsigned)b << 16); }
__device__ __forceinline__ float bflo(unsigned w) { return __builtin_bit_cast(float, w << 16); }
__device__ __forceinline__ float bfhi(unsigned w) { return __builtin_bit_cast(float, w & 0xffff0000u); }
template <int M> __device__ __forceinline__ float swz_xor(float v) { return __builtin_bit_cast(float, __builtin_amdgcn_ds_swizzle(__builtin_bit_cast(int, v), (M << 10) | 0x1F)); }
__device__ __forceinline__ float add_xor32(float v) {
    auto r = __builtin_amdgcn_permlane32_swap(__float_as_uint(v), __float_as_uint(v), false, false);
    return __uint_as_float(r[0]) + __uint_as_float(r[1]); }
__device__ __forceinline__ float wave_sum(float v) {
    v += swz_xor<1>(v); v += swz_xor<2>(v); v += swz_xor<4>(v); v += swz_xor<8>(v); v += swz_xor<16>(v);
    return add_xor32(v);
}
__device__ const unsigned char T5_BUCKET[128] = {
 0, 1, 2, 3, 4, 5, 6, 7, 8, 9, 10, 11, 12, 13, 14, 15, 16, 16, 16, 17, 17, 18, 18, 18, 19, 19, 19, 20, 20, 20, 20, 21, 21, 21, 21, 22, 22, 22, 22, 22, 23, 23, 23, 23, 23, 23, 24, 24, 24, 24, 24, 24, 25, 25, 25, 25, 25, 25, 25, 26, 26, 26, 26, 26, 26, 26, 26, 27, 27, 27, 27, 27, 27, 27, 27, 27, 27, 28, 28, 28, 28, 28, 28, 28, 28, 28, 28, 29, 29, 29, 29, 29, 29, 29, 29, 29, 29, 29, 29, 30, 30, 30, 30, 30, 30, 30, 30, 30, 30, 30, 30, 30, 30, 31, 31, 31, 31, 31, 31, 31, 31, 31, 31, 31, 31, 31, 31, 31};

__device__ __forceinline__ int opaque_tid() { int t = threadIdx.x; asm volatile("" : "+v"(t)); return t; }

__device__ __forceinline__ unsigned char* opaque_ws(unsigned char* p) { asm volatile("" : "+s"(p)); return p; }
namespace pg8 {
#define PG8_LAS __attribute__((address_space(3)))
typedef unsigned short bf16_t;
typedef short bf16x8 __attribute__((ext_vector_type(8)));
typedef float f32x4 __attribute__((ext_vector_type(4)));
typedef unsigned u32x4 __attribute__((ext_vector_type(4)));
constexpr int BM = 256, BK = 64, HALF = 128, HTB = HALF * BK * 2  , STAGE_BYTES = 8 * HTB, NXCD = 8, WGM = 8;

__host__ __device__ __forceinline__ int lds_byte(int r, int c) { const int st = (r >> 4) * 2 + (c >> 5), rr = r & 15, cc = c & 31, ob = rr * 64 + cc * 2; return st * 1024 + (ob ^ (((ob >> 9) & 1) << 5)); }
__host__ __device__ __forceinline__ void stage_rc(int b, int& R, int& C) { const int st = b / 1024, sb = b % 1024, swz = sb ^ (((sb >> 9) & 1) << 5); R = (st >> 1) * 16 + swz / 64; C = (st & 1) * 32 + (swz % 64) / 2; }
__host__ __device__ __forceinline__ int perm32(int rho) { const int n = rho >> 4, i = rho & 15; return 8 * (i >> 2) + 4 * n + (i & 3); }

struct Unit { int pm, pn; };
struct Gemm { const bf16_t* A; const bf16_t* Bt; int M, N, K; const int* rowtok; };

struct StaticOrder {
    int nM, nN, nwg, G, c;
    __host__ __device__ void init(int M, int N, int G_, int c_) { nM = M / BM; nN = N / BM; nwg = nM * nN; G = G_; c = c_; }
    __host__ __device__ bool next(int i, Unit& u) const {
        const long L = (long)i * G + c; if (L >= nwg) return false;
        int wgid = (int)L; { const int q = nwg / NXCD, r = nwg % NXCD, xcd = wgid % NXCD, off = wgid / NXCD; wgid = (xcd < r ? xcd * (q + 1) : r * (q + 1) + (xcd - r) * q) + off; }
        const int nig = WGM * nN, gid = wgid / nig, fm = gid * WGM, gsz = (nM - fm) < WGM ? (nM - fm) : WGM;
        u.pm = fm + ((wgid % nig) % gsz); u.pn = (wgid % nig) / gsz; return true;
    }
    __device__ __forceinline__ void a_ready(const Unit&) const {}
    __device__ __forceinline__ void done(const Unit&) const {}
};

__device__ __forceinline__ unsigned cvt_pk_bf16(float lo, float hi) { unsigned r; asm volatile("v_cvt_pk_bf16_f32 %0, %1, %2" : "=v"(r) : "v"(lo), "v"(hi)); return r; }
typedef float f32x2 __attribute__((ext_vector_type(2)));
template <class Epi, class Sched, bool ALIGN_EPI = false, bool SP2 = false, bool GATHER = false, bool FP8 = false>
__device__ __forceinline__ void gemm_phase(PG8_LAS unsigned char* lds, const Gemm g, const Sched& S, const Epi& E) {
    const int tid = opaque_tid(), wid = __builtin_amdgcn_readfirstlane(tid >> 6), lane = tid & 63, wr = wid >> 2, wc = wid & 3, fr = lane & 15, fq = lane >> 4;
    const int K = g.K, nt = K / BK;
    unsigned voffA[2], voffB[2]; int RA[2]; unsigned CA2[2];
#pragma unroll
    for (int i = 0; i < 2; ++i) { int R, C; stage_rc(tid * 16 + i * 8192, R, C); const int Rb = Epi::PERM ? ((R & ~31) + perm32(R & 31)) : R;
        voffA[i] = (unsigned)(R * K + C) * 2u; voffB[i] = (unsigned)(Rb * K + C) * 2u; RA[i] = R; CA2[i] = (unsigned)C * 2u; }
    const size_t kstep = (size_t)(BK * 2);
    const size_t hstep = (size_t)HALF * K * 2;
    const size_t tstep = 2 * hstep;
    const unsigned ldsw = (unsigned)wid * 1024u;
    const int aoff = lds_byte(wr * 64 + fr, fq * 8), boff = lds_byte(wc * 32 + fr, fq * 8);
#define PG8_SA(b, h) (((b) * 2 + (h)) * HTB)
#define PG8_SB(b, h) ((4 + (b) * 2 + (h)) * HTB)
#define PG8_STAGE(bufoff, gbase, voff) do { _Pragma("unroll") for (int _i = 0; _i < 2; ++_i) \
        __builtin_amdgcn_global_load_lds((const unsigned*)((const char*)(gbase) + (voff)[_i]), (PG8_LAS unsigned*)(lds + (bufoff) + ldsw + _i * 8192), 16, 0, 0); } while (0)
    unsigned gc[2][2], gn[2][2];
#define PG8_GOFF(dst, pm_) do { _Pragma("unroll") for (int _h = 0; _h < 2; ++_h) _Pragma("unroll") for (int _i = 0; _i < 2; ++_i) \
        dst[_h][_i] = (unsigned)g.rowtok[(pm_) * BM + _h * HALF + RA[_i]] * (unsigned)(K * 2) + CA2[_i]; } while (0)
#define PG8_STAGE_A(bufoff, ptr, half, usenext) do { if constexpr (GATHER) { _Pragma("unroll") for (int _i = 0; _i < 2; ++_i) \
        __builtin_amdgcn_global_load_lds((const unsigned*)((const char*)(ptr) + ((usenext) ? gn[half][_i] : gc[half][_i])), (PG8_LAS unsigned*)(lds + (bufoff) + ldsw + _i * 8192), 16, 0, 0); } \
        else { PG8_STAGE(bufoff, (ptr) + (half) * hstep, voffA); } } while (0)
#define PG8_LDA(dst, b, h) do { if constexpr (FP8) { _Pragma("unroll") for (int m = 0; m < 4; ++m) dst##8[m] = PG8_CAT(*(const PG8_LAS bf16x8*)(lds + PG8_SA(b, h) + aoff + m * 2048), *(const PG8_LAS bf16x8*)(lds + PG8_SA(b, h) + aoff + m * 2048 + 1024)); } \
        else { _Pragma("unroll") for (int m = 0; m < 4; ++m) _Pragma("unroll") for (int k = 0; k < 2; ++k) dst[m][k] = *(const PG8_LAS bf16x8*)(lds + PG8_SA(b, h) + aoff + m * 2048 + k * 1024); } } while (0)
#define PG8_LDB(dst, b, h) do { if constexpr (FP8) { _Pragma("unroll") for (int n = 0; n < 2; ++n) dst##8[n] = PG8_CAT(*(const PG8_LAS bf16x8*)(lds + PG8_SB(b, h) + boff + n * 2048), *(const PG8_LAS bf16x8*)(lds + PG8_SB(b, h) + boff + n * 2048 + 1024)); } \
        else { _Pragma("unroll") for (int n = 0; n < 2; ++n) _Pragma("unroll") for (int k = 0; k < 2; ++k) dst[n][k] = *(const PG8_LAS bf16x8*)(lds + PG8_SB(b, h) + boff + n * 2048 + k * 1024); } } while (0)
typedef int pg8_v8i __attribute__((ext_vector_type(8))); typedef int pg8_v4i __attribute__((ext_vector_type(4)));
#define PG8_CAT(x0, x1) __builtin_shufflevector(__builtin_bit_cast(pg8_v4i, x0), __builtin_bit_cast(pg8_v4i, x1), 0, 1, 2, 3, 4, 5, 6, 7)
#define PG8_MMA(ai, bj, At, Bt) do { __builtin_amdgcn_s_setprio(1); if constexpr (FP8) { _Pragma("unroll") for (int m = 0; m < 4; ++m) _Pragma("unroll") for (int n = 0; n < 2; ++n) \
        asm volatile("v_mfma_scale_f32_16x16x128_f8f6f4 %0, %1, %2, %0, %3, %3 op_sel_hi:[0,0,0]" : "+v"(acc[ai][bj][m][n]) : "v"(Bt##8[n]), "v"(At##8[m]), "v"(pg8_scale1)); } \
        else { _Pragma("unroll") for (int m = 0; m < 4; ++m) _Pragma("unroll") for (int n = 0; n < 2; ++n) _Pragma("unroll") for (int k = 0; k < 2; ++k) \
        acc[ai][bj][m][n] = __builtin_amdgcn_mfma_f32_16x16x32_bf16(Bt[n][k], At[m][k], acc[ai][bj][m][n], 0, 0, 0); } __builtin_amdgcn_s_setprio(0); } while (0)
#define PG8_WAIT_V(n) asm volatile("s_waitcnt vmcnt(" #n ")" ::: "memory")
#define PG8_WAIT_L(n) asm volatile("s_waitcnt lgkmcnt(" #n ")" ::: "memory")
#define PG8_BAR __builtin_amdgcn_s_barrier()
#define PG8_SCHED __builtin_amdgcn_sched_barrier(0)
    Unit cur, nxt; int ui = 0;
    if (!S.next(0, cur)) return;
    f32x4 acc[2][2][4][2];
#pragma unroll
    for (int a = 0; a < 2; ++a)
#pragma unroll
        for (int b = 0; b < 2; ++b)
#pragma unroll
            for (int m = 0; m < 4; ++m)
#pragma unroll
                for (int n = 0; n < 2; ++n) acc[a][b][m][n] = (f32x4){0.f, 0.f, 0.f, 0.f};
    int pg8_scale1 = 0x7F7F7F7F; asm volatile("" : "+v"(pg8_scale1));
    bf16x8 At[4][2], B0[2][2], B1[2][2]; pg8_v8i At8[4], B08[2], B18[2];
    const char* cA = GATHER ? (const char*)g.A : (const char*)g.A + (size_t)cur.pm * tstep; const char* cB = (const char*)g.Bt + (size_t)cur.pn * tstep;
    if constexpr (GATHER) { PG8_GOFF(gc, cur.pm); }
    S.a_ready(cur);
    if constexpr (SP2) {
        PG8_STAGE(PG8_SB(0, 0), cB, voffB); PG8_STAGE(PG8_SB(0, 1), cB + hstep, voffB); PG8_STAGE_A(PG8_SA(0, 0), cA, 0, false); PG8_STAGE_A(PG8_SA(0, 1), cA, 1, false);
        if (wr == 1) PG8_BAR;
        PG8_WAIT_V(2); PG8_BAR;
        PG8_STAGE(PG8_SB(1, 0), cB + kstep, voffB); PG8_STAGE_A(PG8_SA(1, 0), cA + kstep, 0, false); PG8_STAGE(PG8_SB(1, 1), cB + hstep + kstep, voffB);
        PG8_WAIT_V(6); PG8_BAR;
    } else {
        PG8_STAGE(PG8_SB(0, 0), cB, voffB); PG8_STAGE_A(PG8_SA(0, 0), cA, 0, false); PG8_STAGE(PG8_SB(0, 1), cB + hstep, voffB); PG8_STAGE_A(PG8_SA(0, 1), cA, 1, false);
        if (wr == 1) PG8_BAR;
        PG8_WAIT_V(4); PG8_BAR;
        PG8_STAGE(PG8_SB(1, 0), cB + kstep, voffB); PG8_STAGE_A(PG8_SA(1, 0), cA + kstep, 0, false); PG8_STAGE(PG8_SB(1, 1), cB + hstep + kstep, voffB);
        PG8_WAIT_V(6); PG8_BAR;
    }
    for (;;) {
        const bool has_next = S.next(ui + 1, nxt);
        const char* nA = GATHER ? (const char*)g.A : (has_next ? (const char*)g.A + (size_t)nxt.pm * tstep : cA);
        if constexpr (GATHER) { if (has_next) { PG8_GOFF(gn, nxt.pm); } else { _Pragma("unroll") for (int _h = 0; _h < 2; ++_h) _Pragma("unroll") for (int _i = 0; _i < 2; ++_i) gn[_h][_i] = gc[_h][_i]; } } const char* nB = has_next ? (const char*)g.Bt + (size_t)nxt.pn * tstep : cB;
#pragma nounroll
        for (int t = 0; t < nt; t += 2) {
            const bool last = (t == nt - 2);
            const char* a1 = cA + (size_t)(t + 1) * kstep;
            const char* a2 = last ? nA : cA + (size_t)(t + 2) * kstep; const char* b2 = last ? nB : cB + (size_t)(t + 2) * kstep;
            const char* a3 = a2 + kstep; const char* b3 = b2 + kstep;
            if (last && has_next) S.a_ready(nxt);
            if constexpr (SP2) {
            PG8_LDB(B0, 0, 0); PG8_LDB(B1, 0, 1); PG8_SCHED; PG8_LDA(At, 0, 0); PG8_STAGE_A(PG8_SA(1, 1), a1, 1, false);
            PG8_WAIT_V(8); PG8_WAIT_L(0); PG8_BAR; PG8_MMA(0, 0, At, B0); PG8_MMA(0, 1, At, B1); PG8_BAR; PG8_SCHED;
            PG8_LDA(At, 0, 1); PG8_STAGE(PG8_SB(0, 0), b2, voffB); PG8_STAGE(PG8_SB(0, 1), b2 + hstep, voffB); PG8_STAGE_A(PG8_SA(0, 0), a2, 0, last);
            PG8_WAIT_V(8); PG8_WAIT_L(0); PG8_BAR; PG8_MMA(1, 0, At, B0); PG8_MMA(1, 1, At, B1); PG8_BAR; PG8_SCHED;
            PG8_LDB(B0, 1, 0); PG8_LDB(B1, 1, 1); PG8_SCHED; PG8_LDA(At, 1, 0); PG8_STAGE_A(PG8_SA(0, 1), a2, 1, last);
            PG8_WAIT_V(8); PG8_WAIT_L(0); PG8_BAR; PG8_MMA(0, 0, At, B0); PG8_MMA(0, 1, At, B1); PG8_BAR; PG8_SCHED;
            PG8_LDA(At, 1, 1); PG8_STAGE(PG8_SB(1, 0), b3, voffB); PG8_STAGE(PG8_SB(1, 1), b3 + hstep, voffB); PG8_STAGE_A(PG8_SA(1, 0), a3, 0, last);
            PG8_WAIT_V(8); PG8_WAIT_L(0); PG8_BAR; PG8_MMA(1, 0, At, B0); PG8_MMA(1, 1, At, B1); PG8_BAR; PG8_SCHED;
            } else {
            PG8_LDB(B0, 0, 0); PG8_SCHED; PG8_LDA(At, 0, 0); PG8_STAGE_A(PG8_SA(1, 1), a1, 1, false);
            PG8_WAIT_L(8); PG8_BAR; PG8_WAIT_L(0); PG8_MMA(0, 0, At, B0); PG8_BAR; PG8_SCHED;
            PG8_LDB(B1, 0, 1); PG8_STAGE(PG8_SB(0, 0), b2, voffB);
            PG8_BAR; PG8_WAIT_L(0); PG8_MMA(0, 1, At, B1); PG8_BAR;
            PG8_LDA(At, 0, 1); PG8_STAGE_A(PG8_SA(0, 0), a2, 0, last);
            PG8_BAR; PG8_WAIT_L(0); PG8_MMA(1, 0, At, B0); PG8_BAR; PG8_SCHED;
            PG8_STAGE(PG8_SB(0, 1), b2 + hstep, voffB);
            PG8_WAIT_V(6); PG8_BAR; PG8_MMA(1, 1, At, B1); PG8_BAR;
            PG8_LDB(B0, 1, 0); PG8_SCHED; PG8_LDA(At, 1, 0); PG8_STAGE_A(PG8_SA(0, 1), a2, 1, last);
            PG8_WAIT_L(8); PG8_BAR; PG8_WAIT_L(0); PG8_MMA(0, 0, At, B0); PG8_BAR; PG8_SCHED;
            PG8_LDB(B1, 1, 1); PG8_STAGE(PG8_SB(1, 0), b3, voffB);
            PG8_BAR; PG8_WAIT_L(0); PG8_MMA(0, 1, At, B1); PG8_BAR;
            PG8_LDA(At, 1, 1); PG8_STAGE_A(PG8_SA(1, 0), a3, 0, last);
            PG8_BAR; PG8_WAIT_L(0); PG8_MMA(1, 0, At, B0); PG8_BAR; PG8_SCHED;
            PG8_STAGE(PG8_SB(1, 1), b3 + hstep, voffB);
            PG8_WAIT_V(6); PG8_BAR; PG8_MMA(1, 1, At, B1); PG8_BAR;
            }
        }
        if constexpr (FP8) asm volatile("s_nop 15\n\ts_nop 15" ::: "memory");
        if constexpr (ALIGN_EPI) { if (wr == 0) PG8_BAR; }
        if constexpr (!Epi::AFTER_DRAIN) { E(acc, cur, wr, wc, fr, fq); S.done(cur); }
        if (!has_next) break;
#pragma unroll
        for (int a = 0; a < 2; ++a)
#pragma unroll
            for (int b = 0; b < 2; ++b)
#pragma unroll
                for (int m = 0; m < 4; ++m)
#pragma unroll
                    for (int n = 0; n < 2; ++n) acc[a][b][m][n] = (f32x4){0.f, 0.f, 0.f, 0.f};
        cur = nxt; cA = nA; cB = nB; ++ui;
        if constexpr (GATHER) { _Pragma("unroll") for (int _h = 0; _h < 2; ++_h) _Pragma("unroll") for (int _i = 0; _i < 2; ++_i) gc[_h][_i] = gn[_h][_i]; }
        if constexpr (ALIGN_EPI) { if (wr == 1) PG8_BAR; }
    }
    PG8_WAIT_V(0);
    if constexpr (!ALIGN_EPI) { if (wr == 0) PG8_BAR; }
    PG8_BAR;
    if constexpr (Epi::AFTER_DRAIN) { E.fused(acc, cur, wr, wc, fr, fq, lds, wid, lane); S.done(cur); }
#undef PG8_SA
#undef PG8_SB
#undef PG8_STAGE
#undef PG8_STAGE_A
#undef PG8_GOFF
#undef PG8_LDA
#undef PG8_LDB
#undef PG8_MMA
#undef PG8_CAT
#undef PG8_WAIT_V
#undef PG8_WAIT_L
#undef PG8_BAR
#undef PG8_SCHED
}
}
#define XB_TMO      128
#define XB_XCNT(j)  (256  + 64 * (j))
#define XB_XSUB(j)  (1280 + 64 * (j))
#define XB_XGEN(j)  (2304 + 64 * (j))
#define XB_TOP      3328
#define XB_TOPGEN   3392
#define XCD_BAR_WORDS 3456
#define XB_SPIN_CAP (1u << 18)

__device__ __forceinline__ unsigned xb_ld(unsigned* p)              { return __hip_atomic_load(p, __ATOMIC_RELAXED, __HIP_MEMORY_SCOPE_AGENT); }
__device__ __forceinline__ unsigned xb_add(unsigned* p, unsigned v) { return __hip_atomic_fetch_add(p, v, __ATOMIC_RELAXED, __HIP_MEMORY_SCOPE_AGENT); }
__device__ __forceinline__ unsigned xb_xcc_id() { return (unsigned)__builtin_amdgcn_s_getreg((3 << 11) | 20) & 0xFu; }
#define XB_SPIN(cond, bar) do { unsigned _sp = 0; while (cond) { __builtin_amdgcn_s_sleep(1); \
    if ((++_sp & 255u) == 0u) { if (xb_ld(&(bar)[XB_TMO])) break; if (_sp > XB_SPIN_CAP) { atomicAdd(&(bar)[XB_TMO], 1u); break; } } } } while (0)

struct XcdBarrier {
    unsigned* bar; unsigned x;
    volatile LAS unsigned* st;
};

__device__ __forceinline__ XcdBarrier xcd_barrier_post(unsigned* bar, volatile LAS unsigned* st) {
    XcdBarrier b; b.bar = bar; b.x = xb_xcc_id(); b.st = st;
    if (threadIdx.x == 0) (void)xb_add(&bar[XB_XCNT(b.x)], 1u);
    return b;
}
__device__ __forceinline__ void xcd_barrier_complete(unsigned* bar, unsigned x, unsigned& nloc, unsigned& nx) {
    const unsigned G = gridDim.x * gridDim.y * gridDim.z;
    unsigned sum, cnt, mine, sp = 0u;
    for (;;) {
        sum = 0u; cnt = 0u; mine = 0u;
#pragma unroll
        for (unsigned j = 0; j < 16; ++j) { const unsigned c = xb_ld(&bar[XB_XCNT(j)]); sum += c; cnt += (c > 0u) ? 1u : 0u; mine = (j == x) ? c : mine; }
        if (sum == G) break;
        __builtin_amdgcn_s_sleep(1);
        if ((++sp & 255u) == 0u) { if (xb_ld(&bar[XB_TMO])) break; if (sp > XB_SPIN_CAP) { atomicAdd(&bar[XB_TMO], 1u); break; } }
    }
    nloc = mine > 0u ? mine : 1u; nx = cnt > 0u ? cnt : 1u;
}

__device__ __forceinline__ void xcd_barrier(const XcdBarrier& b) {
    asm volatile("s_waitcnt vmcnt(0)" ::: "memory");
    __syncthreads();
    if (threadIdx.x == 0) {
        unsigned* bar = b.bar;
        __builtin_amdgcn_s_waitcnt(0);
        unsigned nloc = b.st[0], nx = b.st[1];
        if (nloc == 0u) { xcd_barrier_complete(bar, b.x, nloc, nx); b.st[0] = nloc; b.st[1] = nx; }
        const unsigned old = xb_add(&bar[XB_XSUB(b.x)], 1u);
        const unsigned gen = old / nloc;
        if (old + 1u == (gen + 1u) * nloc) {
            __builtin_amdgcn_fence(__ATOMIC_RELEASE, "agent");
            asm volatile("s_waitcnt vmcnt(0)" ::: "memory");
            const unsigned og = xb_add(&bar[XB_TOP], 1u);
            const unsigned tg = og / nx;
            if (og + 1u == (tg + 1u) * nx) xb_add(&bar[XB_TOPGEN], 1u);
            else XB_SPIN(xb_ld(&bar[XB_TOPGEN]) == tg, bar);
            __builtin_amdgcn_fence(__ATOMIC_ACQUIRE, "agent");
            xb_add(&bar[XB_XGEN(b.x)], 1u);
            asm volatile("s_waitcnt vmcnt(0)" ::: "memory");
        } else {
            XB_SPIN(xb_ld(&bar[XB_XGEN(b.x)]) == gen, bar);
            __builtin_amdgcn_fence(__ATOMIC_ACQUIRE, "agent");
            asm volatile("s_waitcnt vmcnt(0)" ::: "memory");
        }
    }
    __syncthreads();
}

enum InIdx { I_X = 0, I_MEM, I_RELB, I_ATTN_G, I_FFN_G, I_MEM_G, I_W_MKV, I_QN_MEM, I_KN_MEM, I_W_OUT, I_W_INA, I_QN_A, I_KN_A, I_KV_G, I_W_KVB, I_KN_B, I_W_INB, I_QN_B,
             I_LAMBDA, I_SUBLN, I_W_RG, I_B_RG, I_W_RE, I_B_RE, I_W_GATE, I_W_UP, I_W_DOWN, N_IN };
struct Args { const float* in[N_IN]; float* out; unsigned char* ws; int ph_lo, ph_hi; };
static_assert(sizeof(Args) == N_IN * 8 + 8 + 8 + 8, "Args has no padding");

using pg8::cvt_pk_bf16;
struct EpiRowScale {
    static constexpr bool PERM = true, AFTER_DRAIN = false;
    bf16* O; int ldc; const float* rs; int ntn; float cs;
    __device__ __forceinline__ void operator()(const f32x4 (&acc)[2][2][4][2], const pg8::Unit& u, int wr, int wc, int fr, int fq) const {
        const int colt = ntn ? (u.pn % ntn) : u.pn;
        const int row0 = u.pm * 256 + wr * 64 + fr, col0 = colt * 256 + wc * 32 + 8 * fq;
#pragma unroll
        for (int ai = 0; ai < 2; ++ai)
#pragma unroll
            for (int m = 0; m < 4; ++m) { const int row = row0 + ai * 128 + m * 16; const float s = (rs ? rs[row] : 1.f) * cs; bf16* rowp = O + (size_t)row * ldc + col0;
#pragma unroll
                for (int bj = 0; bj < 2; ++bj) { const f32x4 v0 = acc[ai][bj][m][0] * s, v1 = acc[ai][bj][m][1] * s;
                    v4u w; w.x = cvt_pk_bf16(v0[0], v0[1]); w.y = cvt_pk_bf16(v0[2], v0[3]); w.z = cvt_pk_bf16(v1[0], v1[1]); w.w = cvt_pk_bf16(v1[2], v1[3]);
                    *(v4u*)(rowp + bj * 128) = w; } }
    }
};
template <bool RES_F32>
struct EpiOutProj {
    static constexpr bool PERM = false, AFTER_DRAIN = false;
    const float* resid; float* part; bf16* HB; unsigned char* HB8; float cs;
    __device__ __forceinline__ void operator()(const f32x4 (&acc)[2][2][4][2], const pg8::Unit& u, int wr, int wc, int fr, int fq) const {
        const int row0 = u.pm * 256 + wr * 64 + fr, col0 = u.pn * 256 + wc * 32 + 4 * fq;
#pragma unroll
        for (int ai = 0; ai < 2; ++ai)
#pragma unroll
            for (int mp = 0; mp < 2; ++mp) {
                f32x4 rf[2][2][2]; v2u rb[2][2][2];
#pragma unroll
                for (int mm = 0; mm < 2; ++mm) { const size_t off = (size_t)(row0 + ai * 128 + (2 * mp + mm) * 16) * DM + col0;
#pragma unroll
                    for (int bj = 0; bj < 2; ++bj)
#pragma unroll
                        for (int n = 0; n < 2; ++n) { if (RES_F32) rf[mm][bj][n] = *(const f32x4*)(resid + off + bj * 128 + n * 16); else rb[mm][bj][n] = *(const v2u*)(HB + off + bj * 128 + n * 16); } }
#pragma unroll
                for (int mm = 0; mm < 2; ++mm) { const int m = 2 * mp + mm; const int row = row0 + ai * 128 + m * 16; const size_t off = (size_t)row * DM + col0; float ss = 0.f;
#pragma unroll
                    for (int bj = 0; bj < 2; ++bj)
#pragma unroll
                        for (int n = 0; n < 2; ++n) { f32x4 r4;
                            if (RES_F32) r4 = rf[mm][bj][n];
                            else { const v2u q = rb[mm][bj][n]; r4 = (f32x4){bflo(q.x), bfhi(q.x), bflo(q.y), bfhi(q.y)}; }
                            const f32x4 v = r4 + acc[ai][bj][m][n] * cs;
                            ss += (v[0] * v[0] + v[1] * v[1]) + (v[2] * v[2] + v[3] * v[3]);
                            v2u hb; hb.x = cvt_pk_bf16(v[0], v[1]); hb.y = cvt_pk_bf16(v[2], v[3]); *(v2u*)(HB + off + bj * 128 + n * 16) = hb;
                            unsigned w8 = 0u; w8 = __builtin_amdgcn_cvt_pk_fp8_f32(v[0], v[1], w8, false); w8 = __builtin_amdgcn_cvt_pk_fp8_f32(v[2], v[3], w8, true); *(unsigned*)(HB8 + off + bj * 128 + n * 16) = w8; }
                    ss += swz_xor<16>(ss); ss = add_xor32(ss);
                    if (fq == 0) part[(size_t)row * 32 + u.pn * 4 + wc] = ss; } }
    }
};
struct EpiSiluMul {
    static constexpr bool PERM = true, AFTER_DRAIN = false;
    bf16* O; const float* rstd; const int* rowtok;
    __device__ __forceinline__ void operator()(const f32x4 (&acc)[2][2][4][2], const pg8::Unit& u, int wr, int wc, int fr, int fq) const {
        const int row0 = u.pm * 256 + wr * 64 + fr, col0 = (u.pn & 3) * 128 + wc * 32 + 8 * fq;
        int tk[2][4]; float rsv[2][4];
#pragma unroll
        for (int ai = 0; ai < 2; ++ai)
#pragma unroll
            for (int m = 0; m < 4; ++m) tk[ai][m] = rowtok[row0 + ai * 128 + m * 16];
#pragma unroll
        for (int ai = 0; ai < 2; ++ai)
#pragma unroll
            for (int m = 0; m < 4; ++m) rsv[ai][m] = rstd[tk[ai][m]] * (1.f / SC_W1);
#pragma unroll
        for (int ai = 0; ai < 2; ++ai)
#pragma unroll
            for (int m = 0; m < 4; ++m) { const int row = row0 + ai * 128 + m * 16; float h[8]; const float rs = rsv[ai][m];
#pragma unroll
                for (int n = 0; n < 2; ++n)
#pragma unroll
                    for (int e = 0; e < 4; ++e) { const float g = acc[ai][0][m][n][e] * rs, up = acc[ai][1][m][n][e] * (rs * SC_HID);
                        h[n * 4 + e] = g * up * __builtin_amdgcn_rcpf(1.f + __builtin_amdgcn_exp2f(-g * LOG2E)); }
                unsigned w0 = 0u, w1 = 0u; w0 = __builtin_amdgcn_cvt_pk_fp8_f32(h[0], h[1], w0, false); w0 = __builtin_amdgcn_cvt_pk_fp8_f32(h[2], h[3], w0, true);
                w1 = __builtin_amdgcn_cvt_pk_fp8_f32(h[4], h[5], w1, false); w1 = __builtin_amdgcn_cvt_pk_fp8_f32(h[6], h[7], w1, true);
                *(v2u*)((unsigned char*)O + (size_t)row * EFF + col0) = (v2u){w0, w1}; }
    }
};
struct MoeOrder {
    const int* blk_e; int nunits, ntn, G, c;
    __device__ __forceinline__ bool next(int i, pg8::Unit& u) const {
        const int L = i * G + c; if (L >= nunits) return false;
        const int rb = L / ntn; u.pm = rb; u.pn = blk_e[rb] * ntn + (L - rb * ntn); return true;
    }
    __device__ __forceinline__ void a_ready(const pg8::Unit&) const {}
    __device__ __forceinline__ void done(const pg8::Unit&) const {}
};

struct TrDesc { const float* src; int N; bf16* dst; int dstK; const float* gain; float f8; };
__device__ __forceinline__ TrDesc tr_decode(const Args& a, int r) {
    unsigned char* ws = opaque_ws(a.ws); TrDesc d; d.f8 = 0.f;
    constexpr int R0 = 2560, R1 = 1024, R2 = 1536, R3 = 2048, R4 = 1024, R5 = 32768, R6 = 32768;
    if (r < R0) { const int kb = r / 160, nb = r % 160; d.src = a.in[I_W_INA] + (size_t)(128 * kb) * 5120 + 32 * nb; d.N = 5120; d.dst = (bf16*)(ws + WS_W_INA + (size_t)(32 * nb) * DM + 128 * kb); d.dstK = DM; d.gain = a.in[I_ATTN_G] + 128 * kb; d.f8 = SC_W1; return d; } r -= R0;
    if (r < R1) { const int kb = r / 64, nb = r % 64; d.src = a.in[I_W_INB] + (size_t)(128 * kb) * 2048 + 32 * nb; d.N = 2048; d.dst = (bf16*)(ws + WS_W_INB + (size_t)(32 * nb) * DM + 128 * kb); d.dstK = DM; d.gain = a.in[I_ATTN_G] + DM + 128 * kb; d.f8 = SC_W1; return d; } r -= R1;
    if (r < R2) { const int kb = r / 96, nb = r % 96; d.src = a.in[I_W_KVB] + (size_t)(128 * kb) * 3072 + 32 * nb; d.N = 3072; d.dst = (bf16*)(ws + WS_W_INB + (size_t)(2048 + 32 * nb) * DM + 128 * kb); d.dstK = DM; d.gain = a.in[I_KV_G] + 128 * kb; d.f8 = SC_W1; return d; } r -= R2;
    if (r < R3) { const int l = r / 1024, rr = r % 1024, kb = rr / 64, nb = rr % 64; d.src = a.in[I_W_OUT] + (size_t)l * DM * DM + (size_t)(128 * kb) * 2048 + 32 * nb; d.N = 2048;
        d.dst = (bf16*)(ws + WS_W_OUT + (size_t)l * DM * DM + (size_t)(32 * nb) * DM + 128 * kb); d.f8 = SC_W1;
        d.dstK = DM; d.gain = nullptr; return d; } r -= R3;
    if (r < R4) { const int l = r / 512, rr = r % 512, kb = rr / 32, nb = rr % 32; d.src = a.in[I_W_MKV] + (size_t)l * DM * 1024 + (size_t)(128 * kb) * 1024 + 32 * nb; d.N = 1024;
        d.dst = (bf16*)(ws + WS_W_MKV) + (size_t)l * 1024 * DM + (size_t)(32 * nb) * DM + 128 * kb; d.dstK = DM; d.gain = a.in[I_MEM_G] + l * DM + 128 * kb; return d; } r -= R4;
    if (r < R5 + R6) { const int up = r >= R5 ? 1 : 0; if (up) r -= R5;
        const int le = r / 256, rr = r % 256, kb = rr / 16, nb = rr % 16, n0 = 32 * nb, drow = (n0 >> 7) * 256 + (n0 & 127) + up * 128;
        d.src = (up ? a.in[I_W_UP] : a.in[I_W_GATE]) + (size_t)le * DM * EFF + (size_t)(128 * kb) * EFF + n0; d.N = EFF;
        d.dst = (bf16*)(ws + WS_W_E1 + ((size_t)le * 1024 + drow) * DM + 128 * kb); d.dstK = DM; d.gain = a.in[I_FFN_G] + (le >> 6) * DM + 128 * kb; d.f8 = SC_W1; return d; } r -= R5 + R6;
    { const int le = r / 256, rr = r % 256, kb = rr / 64, nb = rr % 64; d.src = a.in[I_W_DOWN] + (size_t)le * EFF * DM + (size_t)(128 * kb) * DM + 32 * nb; d.N = DM;
        d.dst = (bf16*)(ws + WS_W_E2 + ((size_t)le * DM + 32 * nb) * EFF + 128 * kb); d.dstK = EFF; d.gain = nullptr; d.f8 = SC_W2; return d; }
}
__device__ __forceinline__ float row_to_fp8(const float* xrow, unsigned char* orow, int lane) {
    const GAS f32x4* xr = (const GAS f32x4*)xrow + lane;
    f32x4 v[8]; float s = 0.f;
#pragma unroll
    for (int j = 0; j < 8; ++j) { v[j] = xr[64 * j]; s += (v[j].x * v[j].x + v[j].y * v[j].y) + (v[j].z * v[j].z + v[j].w * v[j].w); }
    const float rstd = 1.0f / sqrtf(wave_sum(s) * (1.f / DM) + RMS_EPS);
    GAS unsigned* o4 = (GAS unsigned*)orow + lane;
#pragma unroll
    for (int j = 0; j < 8; ++j) { unsigned w = 0u; w = __builtin_amdgcn_cvt_pk_fp8_f32(v[j].x, v[j].y, w, false); w = __builtin_amdgcn_cvt_pk_fp8_f32(v[j].z, v[j].w, w, true); o4[64 * j] = w; }
    return rstd;
}
__device__ __forceinline__ float row_to_bf16(const float* xrow, bf16* orow, bool normalise, int lane) {
    const GAS f32x4* xr = (const GAS f32x4*)xrow + lane;
    f32x4 v[8]; float s = 0.f;
#pragma unroll
    for (int j = 0; j < 8; ++j) { v[j] = xr[64 * j]; s += (v[j].x * v[j].x + v[j].y * v[j].y) + (v[j].z * v[j].z + v[j].w * v[j].w); }
    const float rstd = 1.0f / sqrtf(wave_sum(s) * (1.f / DM) + RMS_EPS);
    const float f = normalise ? rstd : 1.f;
    GAS unsigned long long* o8 = (GAS unsigned long long*)orow + lane;
#pragma unroll
    for (int j = 0; j < 8; ++j) o8[64 * j] = (unsigned long long)pk2(v[j].x * f, v[j].y * f) | ((unsigned long long)pk2(v[j].z * f, v[j].w * f) << 32);
    return rstd;
}
#define TR_IDX(i) (layer < 0 ? (i) : 8192 + ((i) / 16384) * 32768 + layer * 16384 + ((i) % 16384))
__device__ __forceinline__ void tr_loop(const Args& a, LAS float* scr, int lane, int it, int end, int stride, int layer) {
    const int first0 = it < end ? it : 0;
    {
        float v[64];
        const int lr = lane >> 5, lc = lane & 31;
        TrDesc cur = tr_decode(a, TR_IDX(it < end ? it : first0));
        if (it < end) {
#pragma unroll
            for (int i = 0; i < 64; ++i) v[i] = __builtin_nontemporal_load(cur.src + (size_t)(2 * i + lr) * cur.N + lc);
        }
        for (; it < end; it += stride) {
#pragma unroll
            for (int i = 0; i < 64; ++i) scr[(2 * i + lr) * 33 + lc] = v[i];
            LDS_WAIT(); asm volatile("" ::: "memory");
            const int nx = it + stride; const bool has_next = nx < end;
            const TrDesc nd = tr_decode(a, TR_IDX(has_next ? nx : it));
            if (has_next) {
#pragma unroll
                for (int i = 0; i < 64; ++i) v[i] = __builtin_nontemporal_load(nd.src + (size_t)(2 * i + lr) * nd.N + lc);
            }
            if (cur.f8 != 0.f) {
                const int c = lane & 7, nq = lane >> 3; const float f = cur.f8;
                f32x4 g[4];
#pragma unroll
                for (int q = 0; q < 4; ++q) g[q] = cur.gain ? *(const f32x4*)(cur.gain + 16 * c + 4 * q) * f : (f32x4){f, f, f, f};
#pragma unroll
                for (int j = 0; j < 4; ++j) { const int n = nq + 8 * j; const LAS float* sp = scr + (16 * c) * 33 + n; v4u o;
#pragma unroll
                    for (int q = 0; q < 4; ++q) { unsigned w = 0u;
                        w = __builtin_amdgcn_cvt_pk_fp8_f32(sp[(4 * q + 0) * 33] * g[q][0], sp[(4 * q + 1) * 33] * g[q][1], w, false);
                        w = __builtin_amdgcn_cvt_pk_fp8_f32(sp[(4 * q + 2) * 33] * g[q][2], sp[(4 * q + 3) * 33] * g[q][3], w, true); o[q] = w; }
                    *(GAS v4u*)((unsigned char*)cur.dst + (size_t)n * cur.dstK + 16 * c) = o; }
            } else {
                const int c = lane & 15, nq = lane >> 4;
                f32x4 g0 = (f32x4){1.f, 1.f, 1.f, 1.f}, g1 = g0;
                if (cur.gain) { g0 = *(const f32x4*)(cur.gain + 8 * c); g1 = *(const f32x4*)(cur.gain + 8 * c + 4); }
#pragma unroll
                for (int j = 0; j < 8; ++j) { const int n = nq + 4 * j; const LAS float* sp = scr + (8 * c) * 33 + n;
                    v4u o; o.x = pk2(sp[0 * 33] * g0[0], sp[1 * 33] * g0[1]); o.y = pk2(sp[2 * 33] * g0[2], sp[3 * 33] * g0[3]); o.z = pk2(sp[4 * 33] * g1[0], sp[5 * 33] * g1[1]); o.w = pk2(sp[6 * 33] * g1[2], sp[7 * 33] * g1[3]);
                    *(GAS v4u*)(cur.dst + (size_t)n * cur.dstK + 8 * c) = o; }
            }
            LDS_WAIT(); asm volatile("" ::: "memory");
            cur = nd;
        }
    }
}
#undef TR_IDX
constexpr int EXP_ITEMS = 49152, CONV_CH = 48, CONV_NCH = EXP_ITEMS / CONV_CH;
__device__ __forceinline__ void conv_chunk(const Args& a, LAS unsigned char* lds, int layer, int c) {
    const int tid = opaque_tid(), lane = tid & 63, wave = __builtin_amdgcn_readfirstlane(tid >> 6);
    tr_loop(a, (LAS float*)(lds + RING_OFF + wave * 16896), lane, c * CONV_CH + wave, (c + 1) * CONV_CH, 8, layer);
    __syncthreads();
}
struct Mix { bool conv; int idx; };
__device__ __forceinline__ Mix mix_decode(int u, int NA, int NC) {
    const long U = NA + NC; const int cb = (int)(((long)u * NC) / U), cb1 = (int)(((long)(u + 1) * NC) / U);
    Mix m; m.conv = cb1 != cb; m.idx = m.conv ? cb : u - cb; return m;
}
__device__ __forceinline__ void phase_prep(const Args& a, LAS unsigned char* lds, int G, int vb) {
    const int tid = opaque_tid(), lane = tid & 63, wave = __builtin_amdgcn_readfirstlane(tid >> 6);
    unsigned char* ws = opaque_ws(a.ws);
    LAS float* scr = (LAS float*)(lds + RING_OFF + wave * 16896);
    const int gw = vb * 8 + wave, NGW = G * 8;
    tr_loop(a, scr, lane, gw, 8192, NGW, -1);
    for (int idx = vb * 512 + tid; idx < 2 * NRTP * DM; idx += G * 512) {
        const int l = idx / (NRTP * DM), j = (idx / DM) % NRTP, k = idx % DM;
        float v = 0.f;
        if (j < 8) v = a.in[I_W_RG][((size_t)l * DM + k) * 8 + j]; else if (j < NRT) v = a.in[I_W_RE][((size_t)l * DM + k) * 64 + (j - 8)];
        v *= a.in[I_FFN_G][l * DM + k];
        const unsigned hi = f2bf(v); const float lo = v - bf2f((unsigned short)hi);
        bf16* wr = (bf16*)(ws + WS_W_RT) + (size_t)l * 2 * NRTP * DM;
        wr[(size_t)j * DM + k] = (bf16)hi; wr[(size_t)(NRTP + j) * DM + k] = (bf16)f2bf(lo);
    }
    for (int idx = vb * 512 + tid; idx < 2 * 5 * HD; idx += G * 512) { const int l = idx / (5 * HD), w = (idx / HD) % 5, i = idx % HD; float v;
        if (l == 0) v = (w < 2) ? a.in[I_QN_A][i] : (w == 2) ? a.in[I_QN_MEM][i] : a.in[I_KN_A][i];
        else v = (w == 0) ? a.in[I_QN_B][i] : (w == 1) ? a.in[I_QN_B][HD + i] : (w == 2) ? a.in[I_QN_MEM][HD + i] : (w == 3) ? a.in[I_KN_B][i] : a.in[I_KN_B][HD + i];
        ((float*)(ws + WS_SMALL + SM_GAINTAB))[idx] = v; }
    float* rstd = (float*)(ws + WS_SMALL + SM_RSTD);
    for (int m = gw; m < T; m += NGW) { const float rs = row_to_fp8(a.in[I_X] + (size_t)m * DM, ws + WS_HB8 + (size_t)m * DM, lane); if (lane == 0) rstd[m] = rs; }
    for (int m = gw; m < NB * NMEM; m += NGW) (void)row_to_bf16(a.in[I_MEM] + (size_t)m * DM, (bf16*)(ws + WS_SMALL + SM_MEMN) + (size_t)m * DM, true, lane);
}

struct PostDesc { const bf16* src; int sp; bf16* dst; int dp; const float* gain; float scale; float* kmean; };
__device__ __forceinline__ void post_unit(const PostDesc& d, LAS unsigned char* lds) {
    const int tid = opaque_tid(), lane = tid & 63, wave = __builtin_amdgcn_readfirstlane(tid >> 6), c = lane & 15, rg = lane >> 4;
    float g8[8]; float cs[8];
#pragma unroll
    for (int i = 0; i < 8; ++i) { g8[i] = d.gain ? d.gain[8 * c + i] * d.scale : 1.f; cs[i] = 0.f; }
    v4u wv[8];
#pragma unroll
    for (int it = 0; it < 8; ++it) wv[it] = *(const v4u*)(d.src + (size_t)(wave * 32 + it * 4 + rg) * d.sp + 8 * c);
#pragma unroll
    for (int it = 0; it < 8; ++it) {
        const int row = wave * 32 + it * 4 + rg;
        const v4u w = wv[it];
        float f[8] = {bflo(w.x), bfhi(w.x), bflo(w.y), bfhi(w.y), bflo(w.z), bfhi(w.z), bflo(w.w), bfhi(w.w)};
        if (d.gain) {
            float ss = 0.f;
#pragma unroll
            for (int i = 0; i < 8; ++i) ss += f[i] * f[i];
            ss += swz_xor<1>(ss); ss += swz_xor<2>(ss); ss += swz_xor<4>(ss); ss += swz_xor<8>(ss);
            const float rstd = 1.0f / sqrtf(ss * (1.f / HD) + RMS_EPS);
#pragma unroll
            for (int i = 0; i < 8; ++i) { f[i] = f[i] * rstd * g8[i]; cs[i] += f[i]; }
        }
        v4u o; o.x = pk2(f[0], f[1]); o.y = pk2(f[2], f[3]); o.z = pk2(f[4], f[5]); o.w = pk2(f[6], f[7]);
        *(v4u*)(d.dst + (size_t)row * d.dp + 8 * c) = o;
    }
    if (d.kmean) {
        LAS float* ks = (LAS float*)(lds + RING_OFF);
#pragma unroll
        for (int i = 0; i < 8; ++i) { cs[i] += swz_xor<16>(cs[i]); cs[i] = add_xor32(cs[i]); }
        if (lane < 16) {
#pragma unroll
            for (int i = 0; i < 8; ++i) ks[wave * 128 + 8 * c + i] = cs[i]; }
        __syncthreads();
        if (tid < 128) { float s = 0.f;
#pragma unroll
            for (int w = 0; w < 8; ++w) s += ks[w * 128 + tid];
            d.kmean[tid] = s * (1.f / 256.f); }
        __syncthreads();
    }
}
__device__ __forceinline__ void phase_post_mem(const Args& a, LAS unsigned char* lds, int G, int vb) {
    unsigned char* ws = opaque_ws(a.ws);
    for (int v = vb; v < 32; v += G) {
        PostDesc d; d.kmean = nullptr; d.scale = 1.f; d.gain = nullptr;
        const int l = v >> 4, b = (v >> 3) & 1, s8 = v & 7;
        const bf16* srow = (const bf16*)(ws + WS_SMALL + SM_KVM) + ((size_t)b * 256) * 2048 + l * 1024; d.sp = 2048; d.dp = HD;
        if (s8 < 4) { d.src = srow + s8 * 128; d.dst = (bf16*)(ws + WS_SMALL + SM_KM) + ((size_t)((l * 2 + b) * 4 + s8) * NMEM) * HD; d.gain = a.in[I_KN_MEM] + l * HD; }
        else { d.src = srow + 512 + (s8 - 4) * 128; d.dst = (bf16*)(ws + WS_SMALL + SM_VM) + ((size_t)((l * 2 + b) * 4 + (s8 - 4)) * NMEM) * HD; }
        post_unit(d, lds);
    }
}
struct SlotDesc { bf16* dst; int dp; const float* gain; float scale; float* kmean; };
__device__ __forceinline__ SlotDesc slot_desc(unsigned char* ws, int layer, int sl, int pm) {
    const float* gt = (const float*)(ws + WS_SMALL + SM_GAINTAB) + layer * 5 * HD;
    bf16* QH = (bf16*)(ws + WS_QH); bf16* KH = (bf16*)(ws + WS_KH); bf16* VH = (bf16*)(ws + WS_VH);
    const int t0 = pm * 256, b = pm >> 5, s0 = (pm & 31) * 256;
    SlotDesc d; d.kmean = nullptr; d.scale = 1.f; d.gain = nullptr;
    if (layer == 0) {
        if (sl < 12) { d.dst = QH + (size_t)t0 * DM + sl * 128; d.dp = DM; d.gain = gt; d.scale = QSCALE; }
        else if (sl < 24) { const int h = sl - 12; d.dst = KH + ((size_t)(b * 12 + h) * SEQ + s0) * HD; d.dp = HD; d.gain = gt + 3 * HD;
            d.kmean = (float*)(ws + WS_SMALL + SM_KMEAN) + ((size_t)(b * 12 + h) * 32 + (pm & 31)) * HD; }
        else if (sl < 36) { const int h = sl - 24; d.dst = VH + ((size_t)(b * 12 + h) * SEQ + s0) * HD; d.dp = HD; }
        else { const int h = sl - 36; d.dst = QH + (size_t)t0 * DM + (12 + h) * 128; d.dp = DM; d.gain = gt + 2 * HD; d.scale = QSCALE; }
    } else {
        if (sl < 6) { d.dst = QH + (size_t)t0 * DM + sl * 128; d.dp = DM; d.gain = gt; d.scale = QSCALE; }
        else if (sl < 12) { d.dst = QH + (size_t)t0 * DM + sl * 128; d.dp = DM; d.gain = gt + HD; d.scale = QSCALE; }
        else if (sl < 16) { d.dst = QH + (size_t)t0 * DM + sl * 128; d.dp = DM; d.gain = gt + 2 * HD; d.scale = QSCALE; }
        else if (sl < 22) { const int h = sl - 16; d.dst = KH + ((size_t)(b * 12 + h) * SEQ + s0) * HD; d.dp = HD; d.gain = gt + 3 * HD; }
        else if (sl < 28) { const int h = sl - 22; d.dst = KH + ((size_t)(b * 12 + 6 + h) * SEQ + s0) * HD; d.dp = HD; d.gain = gt + 4 * HD; }
        else { const int vh = sl - 28, h = vh >> 1, cc = vh & 1; d.dst = VH + ((size_t)(b * 6 + h) * SEQ + s0) * DV + cc * 128; d.dp = DV; }
    }
    return d;
}
template <int PV>
struct EpiHeadNormT {
    static constexpr bool PERM = true, AFTER_DRAIN = false;
    unsigned char* ws; int layer; float cs;
    __device__ __forceinline__ void operator()(const f32x4 (&acc)[2][2][4][2], const pg8::Unit& u, int wr, int wc, int fr_in, int fq_in) const {
        int fr = fr_in, fq = fq_in; asm volatile("" : "+v"(fr), "+v"(fq));
        LAS float* P = (LAS float*)(uintptr_t)LDSX_OFF;
        LAS float* KS = (LAS float*)(uintptr_t)(LDSX_OFF + 8192);
        const float* rs = (const float*)(ws + WS_SMALL + SM_RSTD);
        const SlotDesc d0 = slot_desc(ws, layer, 2 * u.pn, u.pm), d1 = slot_desc(ws, layer, 2 * u.pn + 1, u.pm);
        const int rowl = wr * 64 + fr, coll = wc * 32 + 8 * fq;
        const float* rsr = rs + u.pm * 256 + rowl;
        float rt[2][4];
#pragma unroll
        for (int ai = 0; ai < 2; ++ai)
#pragma unroll
            for (int m = 0; m < 4; ++m) rt[ai][m] = rsr[ai * 128 + m * 16] * cs;
        f32x4 gg[2][2];
#pragma unroll
        for (int bj = 0; bj < 2; ++bj) { const SlotDesc& d = bj == 0 ? d0 : d1; gg[bj][0] = (f32x4){1.f, 1.f, 1.f, 1.f}; gg[bj][1] = gg[bj][0];
            if (d.gain) { gg[bj][0] = *(const f32x4*)(d.gain + coll) * d.scale; gg[bj][1] = *(const f32x4*)(d.gain + coll + 4) * d.scale; } }
#pragma unroll
        for (int ai = 0; ai < 2; ++ai)
#pragma unroll
            for (int m = 0; m < 4; ++m) { const int row = rowl + ai * 128 + m * 16; const float rtv = rt[ai][m];
#pragma unroll
                for (int bj = 0; bj < 2; ++bj) { if ((bj == 0 ? d0.gain : d1.gain) != nullptr) {
                    const f32x4 v0 = acc[ai][bj][m][0] * rtv, v1 = acc[ai][bj][m][1] * rtv;
                    float ss = (v0[0] * v0[0] + v0[1] * v0[1]) + (v0[2] * v0[2] + v0[3] * v0[3]) + (v1[0] * v1[0] + v1[1] * v1[1]) + (v1[2] * v1[2] + v1[3] * v1[3]);
                    ss += swz_xor<16>(ss); ss = add_xor32(ss);
                    if (fq == 0 && !(PV & 2)) P[(row * 2 + bj) * 4 + wc] = ss; } } }
        if (!(PV & 2)) { asm volatile("s_waitcnt lgkmcnt(0)" ::: "memory"); __builtin_amdgcn_s_barrier(); asm volatile("" ::: "memory"); }
#pragma unroll
        for (int bj = 0; bj < 2; ++bj) { const SlotDesc& d = bj == 0 ? d0 : d1;
            const f32x4 g0 = gg[bj][0], g1 = gg[bj][1];
            f32x4 c0 = (f32x4){0.f, 0.f, 0.f, 0.f}, c1 = c0;
#pragma unroll
            for (int ai = 0; ai < 2; ++ai)
#pragma unroll
                for (int m = 0; m < 4; ++m) { const int row = rowl + ai * 128 + m * 16; float f = rt[ai][m];
                    if (d.gain) { const f32x4 p4 = *(const LAS f32x4*)(P + (row * 2 + bj) * 4); f *= 1.0f / sqrtf(((p4[0] + p4[1]) + (p4[2] + p4[3])) * (1.f / HD) + RMS_EPS); }
                    const f32x4 v0 = acc[ai][bj][m][0] * f * g0, v1 = acc[ai][bj][m][1] * f * g1;
                    if (d.kmean) { c0 += v0; c1 += v1; }
                    v4u w; w.x = cvt_pk_bf16(v0[0], v0[1]); w.y = cvt_pk_bf16(v0[2], v0[3]); w.z = cvt_pk_bf16(v1[0], v1[1]); w.w = cvt_pk_bf16(v1[2], v1[3]);
                    if (!(PV & 1) || w.x == 0x12345u) *(v4u*)(d.dst + (size_t)row * d.dp + coll) = w; }
            if (d.kmean && !(PV & 4)) {
#pragma unroll
                for (int i = 0; i < 4; ++i) { float v = c0[i]; v += swz_xor<1>(v); v += swz_xor<2>(v); v += swz_xor<4>(v); v += swz_xor<8>(v); if (fr == 0) KS[wr * 256 + bj * 128 + coll + i] = v;
                                              float w_ = c1[i]; w_ += swz_xor<1>(w_); w_ += swz_xor<2>(w_); w_ += swz_xor<4>(w_); w_ += swz_xor<8>(w_); if (fr == 0) KS[wr * 256 + bj * 128 + coll + 4 + i] = w_; } } }
        if (d0.kmean && !(PV & 4)) {
            asm volatile("s_waitcnt lgkmcnt(0)" ::: "memory"); __builtin_amdgcn_s_barrier(); asm volatile("" ::: "memory");
            const int t = (wr * 4 + wc) * 64 + fq * 16 + fr;
            if (t < 256) { const float mean = (KS[t] + KS[256 + t]) * (1.f / 256.f); float* km = (t < 128) ? d0.kmean : d1.kmean; km[t & 127] = mean; }
        }
    }
};
using EpiHeadNorm = EpiHeadNormT<0>;
__device__ __forceinline__ void phase_gate(const Args& a, LAS unsigned char* lds, int G, int vb) {
    unsigned char* ws = opaque_ws(a.ws);
    const bf16* QH = (const bf16*)(ws + WS_QH); const float* KMEAN = (const float*)(ws + WS_SMALL + SM_KMEAN); unsigned* SEL = (unsigned*)(ws + WS_SMALL + SM_SEL);
    gu32* MC = (gu32*)(ws + WS_CTL) + CW_MC; unsigned* LISTF = (unsigned*)(ws + WS_LISTF); unsigned* LISTA = (unsigned*)(ws + WS_LISTA);
    const int tid_g = opaque_tid();
    LAS float* kml = (LAS float*)(lds + RING_OFF);
    for (int idx = vb * 512 + tid_g; idx < NB * MOBA_H * SEQ; idx += G * 512) {
        const int bh = idx / SEQ, s = idx % SEQ, b = bh / MOBA_H, h = bh % MOBA_H, own = s >> 8;
        __syncthreads();
        { const f32x4* src = (const f32x4*)(KMEAN + (size_t)bh * 32 * HD); ((LAS f32x4*)kml)[tid_g] = src[tid_g]; ((LAS f32x4*)kml)[512 + tid_g] = src[512 + tid_g]; }
        __syncthreads();
        unsigned mask = 0u;
        if (own <= 3) { mask = (1u << own) - 1u; }
        else {
            float acc[31];
#pragma unroll
            for (int j = 0; j < 31; ++j) acc[j] = 0.f;
            const bf16* q = QH + ((size_t)b * SEQ + s) * DM + h * HD;
            for (int c = 0; c < 16; ++c) {
                const v4u w = *(const v4u*)(q + 8 * c);
                const float f0 = bflo(w.x), f1 = bfhi(w.x), f2 = bflo(w.y), f3 = bfhi(w.y), f4 = bflo(w.z), f5 = bfhi(w.z), f6 = bflo(w.w), f7 = bfhi(w.w);
#pragma unroll
                for (int j = 0; j < 31; ++j) if (j < own) {
                    const f32x4 k0 = *(const LAS f32x4*)(kml + j * HD + 8 * c), k1 = *(const LAS f32x4*)(kml + j * HD + 8 * c + 4);
                    acc[j] += (f0 * k0[0] + f1 * k0[1]) + (f2 * k0[2] + f3 * k0[3]) + (f4 * k1[0] + f5 * k1[1]) + (f6 * k1[2] + f7 * k1[3]); }
            }
#pragma unroll
            for (int rnd = 0; rnd < 3; ++rnd) { float best = -__builtin_inff(); int bi = 0;
#pragma unroll
                for (int j = 0; j < 31; ++j) if (j < own && !((mask >> j) & 1u) && acc[j] > best) { best = acc[j]; bi = j; }
                mask |= 1u << bi; }
        }
        SEL[idx] = mask;
        { const int lane_ = tid_g & 63; const unsigned long long lt = (1ull << lane_) - 1ull;
          for (int j = 0; j < own; ++j) {
              const bool selj = (mask >> j) & 1u; const unsigned long long bal = __ballot(selj);
              if (bal == 0ull) continue;
              const int far = (j == own - 1) ? 0 : 1; const int lead = __builtin_ctzll(bal);
              unsigned base = 0u; if (lane_ == lead) base = __hip_atomic_fetch_add(MC + (bh * 32 + j) * 2 + far, (unsigned)__builtin_popcountll(bal), RLX_AGENT);
              base = __shfl(base, lead);
              if (selj) { const unsigned pos = base + (unsigned)__builtin_popcountll(bal & lt); const int slot = __builtin_popcount(mask & ((1u << j) - 1u));
                  const unsigned ent = (unsigned)s | ((unsigned)slot << 16);
                  if (far) LISTF[((size_t)bh * 32 + j) * 8192 + pos] = ent; else LISTA[((size_t)bh * 32 + j) * 256 + pos] = ent; } } }
    }
}

namespace att {
constexpr int SHM_T = 16384;
#define KSWZ(row, colB) ((row) * 256 + ((colB) ^ (((row) & 7) << 4)))
#define SBAR() __builtin_amdgcn_sched_barrier(0)
__device__ __forceinline__ int v_rd_base(int lane) { return ((lane & 3) << 3) | (((lane >> 2) & 3) << 6) | (((lane >> 4) & 1) << 5) | (((lane >> 5) & 1) << 8); }
__device__ __forceinline__ int crow(int r, int hi) { return (r & 3) + 8 * (r >> 2) + 4 * hi; }
__device__ __forceinline__ unsigned cvtpk(float lo, float hi) { unsigned r; asm volatile("v_cvt_pk_bf16_f32 %0, %1, %2" : "=v"(r) : "v"(lo), "v"(hi)); return r; }
__device__ __forceinline__ int swap23(int k) { return (k & ~0xC) | ((k & 4) << 1) | ((k & 8) >> 1); }
__device__ __forceinline__ void glds16(const void* sbase  , unsigned voff, unsigned lds_dst) { unsigned keep;
    asm volatile("s_mov_b32 %0, m0\n\ts_mov_b32 m0, %3\n\ts_nop 0\n\tglobal_load_lds_dwordx4 %1, %2\n\ts_mov_b32 m0, %0" : "=&s"(keep) : "v"(voff), "s"(sbase), "s"(lds_dst) : "memory"); }
#define WAIT_BAR0() asm volatile("s_waitcnt vmcnt(0) lgkmcnt(0)\n\ts_barrier" ::: "memory")
constexpr float THR2 = 11.5f;

__device__ __forceinline__ void qkt(f32x16& p0, f32x16& p1, const LAS char* Kt, int r32, int hi, const bf16x8* qr) {
#pragma unroll
    for (int r = 0; r < 16; ++r) { p0[r] = 0.f; p1[r] = 0.f; }
    const LAS char* kb0 = Kt + KSWZ(r32, (0 * 16 + hi * 8) * 2);
    const LAS char* kb1 = Kt + KSWZ(r32, (1 * 16 + hi * 8) * 2);
    const LAS char* kb2 = Kt + KSWZ(r32, (2 * 16 + hi * 8) * 2);
    const LAS char* kb3 = Kt + KSWZ(r32, (3 * 16 + hi * 8) * 2);
#pragma unroll
    for (int d0 = 0; d0 < 8; ++d0) { const LAS char* a = ((d0 & 3) == 0 ? kb0 : (d0 & 3) == 1 ? kb1 : (d0 & 3) == 2 ? kb2 : kb3) + (d0 >> 2) * 128;
        const bf16x8 b0 = *(const LAS bf16x8*)a;
        const bf16x8 b1 = *(const LAS bf16x8*)(a + 32 * 256);
        p0 = __builtin_amdgcn_mfma_f32_32x32x16_bf16(b0, qr[d0], p0, 0, 0, 0);
        p1 = __builtin_amdgcn_mfma_f32_32x32x16_bf16(b1, qr[d0], p1, 0, 0, 0); }
}
__device__ __forceinline__ void pv_tile(f32x16* o, int vb, bf16x8 pa0, bf16x8 pa1, bf16x8 pa2, bf16x8 pa3) {
#define TRRD(dst, off) asm volatile("ds_read_b64_tr_b16 %0, %1 offset:%2" : "=&v"(dst) : "v"(vb), "i"(off) : "memory")
#define PV_RD(S_, d0) do { constexpr int b_ = (d0) * 512; TRRD(S_##l0, b_); TRRD(S_##h0, b_ + 2048); TRRD(S_##l1, b_ + 4096); TRRD(S_##h1, b_ + 6144); \
        TRRD(S_##l2, b_ + 8192); TRRD(S_##h2, b_ + 10240); TRRD(S_##l3, b_ + 12288); TRRD(S_##h3, b_ + 14336); } while (0)
#define PV_MM(S_, d0) do { \
        o[d0] = __builtin_amdgcn_mfma_f32_32x32x16_bf16(pa0, (bf16x8){S_##l0[0], S_##l0[1], S_##l0[2], S_##l0[3], S_##h0[0], S_##h0[1], S_##h0[2], S_##h0[3]}, o[d0], 0, 0, 0); \
        o[d0] = __builtin_amdgcn_mfma_f32_32x32x16_bf16(pa1, (bf16x8){S_##l1[0], S_##l1[1], S_##l1[2], S_##l1[3], S_##h1[0], S_##h1[1], S_##h1[2], S_##h1[3]}, o[d0], 0, 0, 0); \
        o[d0] = __builtin_amdgcn_mfma_f32_32x32x16_bf16(pa2, (bf16x8){S_##l2[0], S_##l2[1], S_##l2[2], S_##l2[3], S_##h2[0], S_##h2[1], S_##h2[2], S_##h2[3]}, o[d0], 0, 0, 0); \
        o[d0] = __builtin_amdgcn_mfma_f32_32x32x16_bf16(pa3, (bf16x8){S_##l3[0], S_##l3[1], S_##l3[2], S_##l3[3], S_##h3[0], S_##h3[1], S_##h3[2], S_##h3[3]}, o[d0], 0, 0, 0); } while (0)
#define WL(n) asm volatile("s_waitcnt lgkmcnt(" #n ")" ::: "memory")
    s16x4 Al0, Al1, Al2, Al3, Ah0, Ah1, Ah2, Ah3, Bl0, Bl1, Bl2, Bl3, Bh0, Bh1, Bh2, Bh3;
    PV_RD(A, 0); SBAR();
    PV_RD(B, 1); WL(8); SBAR(); PV_MM(A, 0); SBAR();
    PV_RD(A, 2); WL(8); SBAR(); PV_MM(B, 1); SBAR();
    PV_RD(B, 3); WL(8); SBAR(); PV_MM(A, 2); SBAR();
    WL(0); SBAR(); PV_MM(B, 3);
#undef PV_RD
#undef PV_MM
#undef TRRD
}
__device__ __forceinline__ void softmax_tile(f32x16& p0, f32x16& p1, float& m_reg, float& l_reg, float& alpha, bf16x8& pa0, bf16x8& pa1, bf16x8& pa2, bf16x8& pa3) {
    float pmax = p0[0];
#pragma unroll
    for (int r = 1; r < 16; ++r) pmax = fmaxf(pmax, p0[r]);
#pragma unroll
    for (int r = 0; r < 16; ++r) pmax = fmaxf(pmax, p1[r]);
    { auto rr = __builtin_amdgcn_permlane32_swap(__float_as_uint(pmax), __float_as_uint(pmax), false, false);
      pmax = fmaxf(__uint_as_float(rr[0]), __uint_as_float(rr[1])); }
    const float mn = (pmax - m_reg <= THR2) ? m_reg : fmaxf(m_reg, pmax);
    alpha = __builtin_amdgcn_exp2f(m_reg - mn); m_reg = mn;
#pragma unroll
    for (int r = 0; r < 16; ++r) { p0[r] = __builtin_amdgcn_exp2f(p0[r] - mn); p1[r] = __builtin_amdgcn_exp2f(p1[r] - mn); }
    float ps = 0.f;
#pragma unroll
    for (int r = 0; r < 16; ++r) ps += p0[r] + p1[r];
    { auto rr = __builtin_amdgcn_permlane32_swap(__float_as_uint(ps), __float_as_uint(ps), false, false);
      ps = __uint_as_float(rr[0]) + __uint_as_float(rr[1]); }
    l_reg = l_reg * alpha + ps;
#define PK4(P, B_, OUT) do { unsigned a0 = cvtpk(P[B_+0], P[B_+1]), a1 = cvtpk(P[B_+2], P[B_+3]); \
        unsigned b0 = cvtpk(P[B_+4], P[B_+5]), b1 = cvtpk(P[B_+6], P[B_+7]); \
        auto r0 = __builtin_amdgcn_permlane32_swap(a0, b0, false, false); auto r1 = __builtin_amdgcn_permlane32_swap(a1, b1, false, false); \
        v4u w = {r0[0], r1[0], r0[1], r1[1]}; OUT = __builtin_bit_cast(bf16x8, w); } while (0)
    PK4(p0, 0, pa0); PK4(p0, 8, pa1); PK4(p1, 0, pa2); PK4(p1, 8, pa3);
#undef PK4
}
__device__ __forceinline__ void bias_mask_tile(f32x16& p0, f32x16& p1, int dq, bool on, bool far, const LAS float* lut) {
    const float NEG = -__builtin_inff();
    if (far) {
        const float c = on ? lut[128] : NEG;
#pragma unroll
        for (int r = 0; r < 16; ++r) { p0[r] += c; p1[r] += c; }
    } else {
#pragma unroll
        for (int r = 0; r < 16; ++r) { const int c = (r & 3) + 8 * (r >> 2); const int d0 = dq - c, d1 = dq - c - 32;
            const float b0 = lut[min(max(d0, 0), 128)], b1 = lut[min(max(d1, 0), 128)];
            p0[r] = (on && d0 >= 0) ? p0[r] + b0 : NEG; p1[r] = (on && d1 >= 0) ? p1[r] + b1 : NEG; }
    }
}

__device__ __forceinline__ void qkt_half(f32x16& p, const LAS char* Kt  , int r32, int hi, const bf16x8* qr) {
#pragma unroll
    for (int r = 0; r < 16; ++r) p[r] = 0.f;
    const LAS char* kb0 = Kt + KSWZ(r32, (0 * 16 + hi * 8) * 2);
    const LAS char* kb1 = Kt + KSWZ(r32, (1 * 16 + hi * 8) * 2);
    const LAS char* kb2 = Kt + KSWZ(r32, (2 * 16 + hi * 8) * 2);
    const LAS char* kb3 = Kt + KSWZ(r32, (3 * 16 + hi * 8) * 2);
#pragma unroll
    for (int d0 = 0; d0 < 8; ++d0) { const LAS char* a = ((d0 & 3) == 0 ? kb0 : (d0 & 3) == 1 ? kb1 : (d0 & 3) == 2 ? kb2 : kb3) + (d0 >> 2) * 128;
        const bf16x8 b0 = *(const LAS bf16x8*)a;
        p = __builtin_amdgcn_mfma_f32_32x32x16_bf16(b0, qr[d0], p, 0, 0, 0); }
}
template <int HALF>
__device__ __forceinline__ void pv_half8(f32x16* o, int vb, bf16x8 pa0, bf16x8 pa1) {
#define TRRD(dst, off) asm volatile("ds_read_b64_tr_b16 %0, %1 offset:%2" : "=&v"(dst) : "v"(vb), "i"(off) : "memory")
#define PV_RD(S_, d0) do { constexpr int b_ = ((d0) & 3) * 512 + ((d0) >> 2) * SHM_T + HALF * 8192; TRRD(S_##l0, b_); TRRD(S_##h0, b_ + 2048); TRRD(S_##l1, b_ + 4096); TRRD(S_##h1, b_ + 6144); } while (0)
#define PV_MM(S_, d0) do { \
        o[d0] = __builtin_amdgcn_mfma_f32_32x32x16_bf16(pa0, (bf16x8){S_##l0[0], S_##l0[1], S_##l0[2], S_##l0[3], S_##h0[0], S_##h0[1], S_##h0[2], S_##h0[3]}, o[d0], 0, 0, 0); \
        o[d0] = __builtin_amdgcn_mfma_f32_32x32x16_bf16(pa1, (bf16x8){S_##l1[0], S_##l1[1], S_##l1[2], S_##l1[3], S_##h1[0], S_##h1[1], S_##h1[2], S_##h1[3]}, o[d0], 0, 0, 0); } while (0)
#define WL(n) asm volatile("s_waitcnt lgkmcnt(" #n ")" ::: "memory")
    s16x4 Al0, Al1, Ah0, Ah1, Bl0, Bl1, Bh0, Bh1;
    PV_RD(A, 0); SBAR();
    PV_RD(B, 1); WL(4); SBAR(); PV_MM(A, 0); SBAR();
    PV_RD(A, 2); WL(4); SBAR(); PV_MM(B, 1); SBAR();
    PV_RD(B, 3); WL(4); SBAR(); PV_MM(A, 2); SBAR();
    PV_RD(A, 4); WL(4); SBAR(); PV_MM(B, 3); SBAR();
    PV_RD(B, 5); WL(4); SBAR(); PV_MM(A, 4); SBAR();
    PV_RD(A, 6); WL(4); SBAR(); PV_MM(B, 5); SBAR();
    PV_RD(B, 7); WL(4); SBAR(); PV_MM(A, 6); SBAR();
    WL(0); SBAR(); PV_MM(B, 7);
#undef PV_RD
#undef PV_MM
#undef WL
#undef TRRD
}
__device__ __forceinline__ void softmax_half(f32x16& p0, float& m_reg, float& l_reg, float& alpha, bf16x8& pa0, bf16x8& pa1) {
    float pmax = p0[0];
#pragma unroll
    for (int r = 1; r < 16; ++r) pmax = fmaxf(pmax, p0[r]);
    { auto rr = __builtin_amdgcn_permlane32_swap(__float_as_uint(pmax), __float_as_uint(pmax), false, false);
      pmax = fmaxf(__uint_as_float(rr[0]), __uint_as_float(rr[1])); }
    const float mn = (pmax - m_reg <= THR2) ? m_reg : fmaxf(m_reg, pmax);
    alpha = __builtin_amdgcn_exp2f(m_reg - mn); m_reg = mn;
#pragma unroll
    for (int r = 0; r < 16; ++r) p0[r] = __builtin_amdgcn_exp2f(p0[r] - mn);
    float ps = 0.f;
#pragma unroll
    for (int r = 0; r < 16; ++r) ps += p0[r];
    { auto rr = __builtin_amdgcn_permlane32_swap(__float_as_uint(ps), __float_as_uint(ps), false, false);
      ps = __uint_as_float(rr[0]) + __uint_as_float(rr[1]); }
    l_reg = l_reg * alpha + ps;
#define PK4(P, B_, OUT) do { unsigned a0 = cvtpk(P[B_+0], P[B_+1]), a1 = cvtpk(P[B_+2], P[B_+3]); \
        unsigned b0 = cvtpk(P[B_+4], P[B_+5]), b1 = cvtpk(P[B_+6], P[B_+7]); \
        auto r0 = __builtin_amdgcn_permlane32_swap(a0, b0, false, false); auto r1 = __builtin_amdgcn_permlane32_swap(a1, b1, false, false); \
        v4u w = {r0[0], r1[0], r0[1], r1[1]}; OUT = __builtin_bit_cast(bf16x8, w); } while (0)
    PK4(p0, 0, pa0); PK4(p0, 8, pa1);
#undef PK4
}
__device__ __forceinline__ void bias_mask_half(f32x16& p0, int dq, bool far, const LAS float* lut) {
    const float NEG = -__builtin_inff();
    if (far) { const float c = lut[128];
#pragma unroll
        for (int r = 0; r < 16; ++r) p0[r] += c;
    } else {
#pragma unroll
        for (int r = 0; r < 16; ++r) { const int c = (r & 3) + 8 * (r >> 2); const int d0 = dq - c;
            const float b0 = lut[min(max(d0, 0), 128)]; p0[r] = (d0 >= 0) ? p0[r] + b0 : NEG; }
    }
}
#define RESC(o_, nd_, al_l_, alpha_) do { if (__any((alpha_) < 1.f)) { if (hi == 0) (al_l_)[r32] = (alpha_); asm volatile("s_waitcnt lgkmcnt(0)" ::: "memory"); \
        _Pragma("unroll") for (int r = 0; r < 16; ++r) { const float f_ = (al_l_)[crow(r, hi)]; _Pragma("unroll") for (int d_ = 0; d_ < (nd_); ++d_) (o_)[d_][r] *= f_; } } } while (0)

template <int MODE, bool F8OUT = false>
__device__ __forceinline__ void attn128_unit(LAS unsigned char* lds, const bf16* Qrow0, const bf16* Kh, const bf16* Vh, bf16* Orow0, int NT, int qb, const unsigned* selrow, const float* relb, int h) {
    const int tid = opaque_tid(), wid = __builtin_amdgcn_readfirstlane(tid >> 6), lane = tid & 63, r32 = lane & 31, hi = lane >> 5;
    LAS float* wsf = (LAS float*)(lds + LDSX_OFF) + wid * 64; LAS float* li_l = wsf; LAS float* al_l = wsf + 32;
    LAS float* lut = (LAS float*)(lds + LDSX_OFF + 2048);
    if (MODE == 0 && tid <= 128) lut[tid] = relb[(tid < 128 ? (int)T5_BUCKET[tid] : 31) * 12 + h] * LOG2E;
    bf16x8 qr[8];
#pragma unroll
    for (int d0 = 0; d0 < 8; ++d0) qr[d0] = *(const bf16x8*)(Qrow0 + (size_t)(wid * 32 + r32) * DM + d0 * 16 + hi * 8);
    unsigned sel = 0u; if (MODE == 0) sel = selrow[wid * 32 + r32];
    const int krow = 4 * wid + (lane >> 4); const unsigned ksrc = (unsigned) krow * 256 + ((16 * (lane & 15)) ^ ((krow & 7) << 4));
    const int vkk = 8 * (wid >> 1) + ((lane & 31) >> 2); const unsigned vsrc = (unsigned) swap23(vkk) * 256 + (32 * (2 * (wid & 1) + (lane >> 5)) + 8 * (lane & 3)) * 2;
    const unsigned lds0 = (unsigned)(uintptr_t)(lds + RING_OFF);
    const char* Kg = (const char*)Kh; const char* Vg = (const char*)Vh;
#define ISSUE(t, s) do { const unsigned base_ = (unsigned)__builtin_amdgcn_readfirstlane(lds0 + (s) * 32768 + wid * 1024); const size_t tb_ = (size_t)(t) * SHM_T; \
        glds16(Kg + tb_, ksrc, base_); glds16(Kg + tb_ + 8192, ksrc, base_ + 8192); glds16(Vg + tb_, vsrc, base_ + SHM_T); glds16(Vg + tb_ + 8192, vsrc, base_ + SHM_T + 8192); } while (0)
    const int vb0 = (int)lds0 + SHM_T + v_rd_base(lane);
    float m_reg = -1e30f, l_reg = 0.f; f32x16 o[4];
#pragma unroll
    for (int d = 0; d < 4; ++d)
#pragma unroll
        for (int r = 0; r < 16; ++r) o[d][r] = 0.f;
    const int q0w = qb * 256 + wid * 32, qpos = q0w + r32;
    ISSUE(0, 0);
    for (int t = 0; t < NT; ++t) {
        WAIT_BAR0();
        if (t + 1 < NT) ISSUE(t + 1, (t + 1) & 1);
        const int s = t & 1;
        f32x16 p0, p1;
        qkt(p0, p1, (const LAS char*)(lds + RING_OFF + s * 32768), r32, hi, qr);
        if (MODE == 0) { const int jb = t >> 2, tk0 = t * 64; const bool on = (jb >= qb) || ((sel >> jb) & 1u); const bool far = (q0w - (tk0 + 63)) >= 128;
            bias_mask_tile(p0, p1, qpos - tk0 - 4 * hi, on, far, lut); }
        float alpha; bf16x8 pa0, pa1, pa2, pa3;
        softmax_tile(p0, p1, m_reg, l_reg, alpha, pa0, pa1, pa2, pa3);
        RESC(o, 4, al_l, alpha);
        pv_tile(o, vb0 + s * 32768, pa0, pa1, pa2, pa3);
    }
#undef ISSUE
    if (hi == 0) li_l[r32] = l_reg; asm volatile("s_waitcnt lgkmcnt(0)" ::: "memory");
    int r32o = r32, hio = hi; asm volatile("" : "+v"(r32o), "+v"(hio));
    bf16* Ow = Orow0 + (size_t)(wid * 32) * DM + r32o;
#pragma unroll
    for (int r = 0; r < 16; ++r) { const int orow = crow(r, hio); const float rli = __builtin_amdgcn_rcpf(li_l[orow]);
#pragma unroll
        for (int d0 = 0; d0 < 4; ++d0) { const float v = o[d0][r] * rli; const float vn = swz_xor<1>(v);
            if (F8OUT) { if ((r32 & 1) == 0) *(unsigned short*)((unsigned char*)Orow0 + (size_t)(wid * 32 + orow) * DM + d0 * 32 + r32o) = (unsigned short)__builtin_amdgcn_cvt_pk_fp8_f32(v * SC_O, vn * SC_O, 0u, false); }
            else if ((r32 & 1) == 0) *(unsigned*)(Ow + (size_t)orow * DM + d0 * 32) = cvtpk(v, vn); } }
    WAIT_BAR0();
}

#define PK4X(P, B_, OUT) do { unsigned a0 = cvtpk(P[B_+0], P[B_+1]), a1 = cvtpk(P[B_+2], P[B_+3]); unsigned b0 = cvtpk(P[B_+4], P[B_+5]), b1 = cvtpk(P[B_+6], P[B_+7]); \
        auto r0 = __builtin_amdgcn_permlane32_swap(a0, b0, false, false); auto r1 = __builtin_amdgcn_permlane32_swap(a1, b1, false, false); v4u w = {r0[0], r1[0], r0[1], r1[1]}; OUT = __builtin_bit_cast(bf16x8, w); } while (0)
template <int VAR>
__device__ __forceinline__ void diff_unit(LAS unsigned char* lds, const bf16* Qrow0  , const bf16* K1h, const bf16* K2h, const bf16* Vh, bf16* Orow0  ,
                                          int qblk, const float* relb, int h, float lam, const float* subln) {
    const int tid = opaque_tid(), wid = __builtin_amdgcn_readfirstlane(tid >> 6), lane = tid & 63, r32 = lane & 31, hi = lane >> 5, mp = wid >> 2, w4 = wid & 3;
    LAS float* wsf = (LAS float*)(lds + LDSX_OFF) + wid * 64; LAS float* li_l = wsf; LAS float* al_l = wsf + 32;
    LAS float* lut2 = (LAS float*)(lds + LDSX_OFF + 2048);
    if (tid < 2 * 132) { const int m_ = tid / 132, i_ = tid % 132; if (i_ <= 128) lut2[tid] = relb[(i_ < 128 ? (int)T5_BUCKET[i_] : 31) * 12 + 2 * h + m_] * LOG2E; }
    const LAS float* lut = lut2 + mp * 132;
    bf16x8 qr[8];
#pragma unroll
    for (int d0 = 0; d0 < 8; ++d0) qr[d0] = *(const bf16x8*)(Qrow0 + (size_t)(w4 * 32 + r32) * DM + (h + 6 * mp) * HD + d0 * 16 + hi * 8);
    const int krow = 4 * wid + (lane >> 4); const unsigned ksrc = (unsigned) krow * 256 + ((16 * (lane & 15)) ^ ((krow & 7) << 4));
    const int vkk = 8 * (wid >> 1) + ((lane & 31) >> 2); const unsigned vsrc = (unsigned) swap23(vkk) * 512 + (32 * (2 * (wid & 1) + (lane >> 5)) + 8 * (lane & 3)) * 2;
    const unsigned lds0 = (unsigned)(uintptr_t)(lds + RING_OFF);
    const char* K1g = (const char*)K1h; const char* K2g = (const char*)K2h; const char* Vg = (const char*)Vh;
#define ISSUE(t, s) do { const unsigned base_ = (unsigned)__builtin_amdgcn_readfirstlane(lds0 + (s) * 65536 + wid * 1024); const size_t tb_ = (size_t)(t) * SHM_T; \
        glds16(K1g + tb_, ksrc, base_); glds16(K1g + tb_ + 8192, ksrc, base_ + 8192); glds16(K2g + tb_, ksrc, base_ + SHM_T); glds16(K2g + tb_ + 8192, ksrc, base_ + SHM_T + 8192); \
        glds16(Vg + 2 * tb_, vsrc, base_ + 2 * SHM_T); glds16(Vg + 2 * tb_ + 16384, vsrc, base_ + 2 * SHM_T + 8192); \
        glds16(Vg + 2 * tb_ + 256, vsrc, base_ + 3 * SHM_T); glds16(Vg + 2 * tb_ + 256 + 16384, vsrc, base_ + 3 * SHM_T + 8192); } while (0)
#define ISSUE_K(t, s) do { const unsigned base_ = (unsigned)__builtin_amdgcn_readfirstlane(lds0 + (s) * 65536 + wid * 1024); const size_t tb_ = (size_t)(t) * SHM_T; \
        glds16(K1g + tb_, ksrc, base_); glds16(K1g + tb_ + 8192, ksrc, base_ + 8192); glds16(K2g + tb_, ksrc, base_ + SHM_T); glds16(K2g + tb_ + 8192, ksrc, base_ + SHM_T + 8192); } while (0)
#define ISSUE_V(t, s) do { const unsigned base_ = (unsigned)__builtin_amdgcn_readfirstlane(lds0 + (s) * 65536 + wid * 1024); const size_t tb_ = (size_t)(t) * SHM_T; \
        glds16(Vg + 2 * tb_, vsrc, base_ + 2 * SHM_T); glds16(Vg + 2 * tb_ + 16384, vsrc, base_ + 2 * SHM_T + 8192); \
        glds16(Vg + 2 * tb_ + 256, vsrc, base_ + 3 * SHM_T); glds16(Vg + 2 * tb_ + 256 + 16384, vsrc, base_ + 3 * SHM_T + 8192); } while (0)
    const int vb0 = (int)lds0 + 2 * SHM_T + v_rd_base(lane);
    float m_reg = -1e30f, l_reg = 0.f; f32x16 o[8];
#pragma unroll
    for (int d = 0; d < 8; ++d)
#pragma unroll
        for (int r = 0; r < 16; ++r) o[d][r] = 0.f;
    const int q0w = qblk * 128 + w4 * 32, qpos = q0w + r32, NT = 2 * (qblk + 1);
    if (!(VAR & 1)) ISSUE(0, 0);
    for (int t = 0; t < NT; ++t) {
        WAIT_BAR0();
        if (!(VAR & 1)) if (t + 1 < NT) ISSUE(t + 1, (t + 1) & 1);
        const int s = t & 1, tk0 = t * 64;
        if (VAR & 2) continue;
        const bool far = (q0w - (tk0 + 63)) >= 128;
        { f32x16 p; float alpha; bf16x8 pa0, pa1;
          qkt_half(p, (const LAS char*)(lds + RING_OFF + s * 65536 + mp * SHM_T), r32, hi, qr);
          bias_mask_half(p, qpos - tk0 - 4 * hi, far, lut);
          if (VAR & 4) { alpha = 1.f; l_reg += p[0]; PK4X(p, 0, pa0); PK4X(p, 8, pa1); } else { softmax_half(p, m_reg, l_reg, alpha, pa0, pa1);
          RESC(o, 8, al_l, alpha); }
          pv_half8<0>(o, vb0 + s * 65536, pa0, pa1); }
        SBAR();
        { f32x16 p; float alpha; bf16x8 pa0, pa1;
          qkt_half(p, (const LAS char*)(lds + RING_OFF + s * 65536 + mp * SHM_T + 32 * 256), r32, hi, qr);
          bias_mask_half(p, qpos - tk0 - 32 - 4 * hi, far, lut);
          if (VAR & 4) { alpha = 1.f; l_reg += p[0]; PK4X(p, 0, pa0); PK4X(p, 8, pa1); } else { softmax_half(p, m_reg, l_reg, alpha, pa0, pa1);
          RESC(o, 8, al_l, alpha); }
          pv_half8<1>(o, vb0 + s * 65536, pa0, pa1); }
        SBAR();
    }
#undef ISSUE
#undef ISSUE_K
#undef ISSUE_V
    if (hi == 0) li_l[r32] = l_reg;
    WAIT_BAR0();
    int laneo = lane; asm volatile("" : "+v"(laneo));
    LAS float* X = (LAS float*)(lds + RING_OFF) + (w4 * 8 * 16 * 64 + laneo);
    if (mp == 1) {
#pragma unroll
        for (int r = 0; r < 16; ++r) { const float f = lam * __builtin_amdgcn_rcpf(li_l[crow(r, hi)]);
#pragma unroll
            for (int d0 = 0; d0 < 8; ++d0) X[(d0 * 16 + r) * 64] = o[d0][r] * f; }
    }
    WAIT_BAR0();
    if (mp == 0) {
        int r32o = r32, hio = hi; asm volatile("" : "+v"(r32o), "+v"(hio));
        unsigned char* Ow = (unsigned char*)Orow0 + (size_t)(w4 * 32) * DM + r32o; const float* sg = subln + r32o;
#pragma unroll
        for (int r = 0; r < 16; ++r) { const float rli = __builtin_amdgcn_rcpf(li_l[crow(r, hi)]); float ss = 0.f;
#pragma unroll
            for (int d0 = 0; d0 < 8; ++d0) { const float v = o[d0][r] * rli - X[(d0 * 16 + r) * 64]; o[d0][r] = v; ss += v * v; }
            ss += swz_xor<1>(ss); ss += swz_xor<2>(ss); ss += swz_xor<4>(ss); ss += swz_xor<8>(ss); ss += swz_xor<16>(ss);
            const float rs = (1.0f / sqrtf(ss * (1.f / DV) + RMS_EPS)) * (1.f - LAM_INIT); const int orow = crow(r, hio);
#pragma unroll
            for (int d0 = 0; d0 < 8; ++d0) { const float v = o[d0][r] * rs * sg[d0 * 32]; const float vn = swz_xor<1>(v);
                if ((r32 & 1) == 0) *(unsigned short*)(Ow + (size_t)orow * DM + d0 * 32) = (unsigned short)__builtin_amdgcn_cvt_pk_fp8_f32(v * SC_O, vn * SC_O, 0u, false); } }
    }
    WAIT_BAR0();
}

__device__ __forceinline__ void moba_sparse_unit(LAS unsigned char* lds, const bf16* QHb, const bf16* Kblk, const bf16* Vblk, const unsigned* listF, int cntF, const unsigned* listA, int cntA, int j,
                                                 bf16* PO, float* PM, const float* relb, int h) {
    const int tid = opaque_tid(), wid = __builtin_amdgcn_readfirstlane(tid >> 6), lane = tid & 63, r32 = lane & 31, hi = lane >> 5;
    LAS float* wsf = (LAS float*)(lds + LDSX_OFF) + wid * 64; LAS float* li_l = wsf; LAS float* al_l = wsf + 32;
    LAS float* lut = (LAS float*)(lds + LDSX_OFF + 2048);
    if (tid <= 128) lut[tid] = relb[(tid < 128 ? (int)T5_BUCKET[tid] : 31) * 12 + h] * LOG2E;
    const int krow = 4 * wid + (lane >> 4); const unsigned ksrc = (unsigned) krow * 256 + ((16 * (lane & 15)) ^ ((krow & 7) << 4));
    const int vkk = 8 * (wid >> 1) + ((lane & 31) >> 2); const unsigned vsrc = (unsigned) swap23(vkk) * 256 + (32 * (2 * (wid & 1) + (lane >> 5)) + 8 * (lane & 3)) * 2;
    const unsigned lds0 = (unsigned)(uintptr_t)(lds + RING_OFF);
    const char* Kg = (const char*)Kblk; const char* Vg = (const char*)Vblk;
    { const unsigned base_ = (unsigned)__builtin_amdgcn_readfirstlane(lds0 + wid * 1024);
#pragma unroll
      for (int t = 0; t < 4; ++t) { glds16(Kg + t * SHM_T, ksrc, base_ + t * SHM_T); glds16(Kg + t * SHM_T + 8192, ksrc, base_ + t * SHM_T + 8192);
                                    glds16(Vg + t * SHM_T, vsrc, base_ + 65536 + t * SHM_T); glds16(Vg + t * SHM_T + 8192, vsrc, base_ + 65536 + t * SHM_T + 8192); } }
    const int vb0 = (int)lds0 + 65536 + v_rd_base(lane);
    const int gF = (cntF + 31) >> 5, ng = gF + ((cntA + 31) >> 5);
    const float c31 = relb[31 * 12 + h] * LOG2E;
#define GRP_ENT(g_, ent_, val_) do { const bool fr_ = (g_) < gF; const int b0_ = fr_ ? (g_) * 32 : ((g_) - gF) * 32; const int n_ = fr_ ? cntF : cntA; const unsigned* l_ = fr_ ? listF : listA; \
        val_ = (b0_ + r32) < n_; ent_ = l_[val_ ? b0_ + r32 : b0_]; } while (0)
#define LOADQ(dst_, ent_) do { const bf16* qp_ = QHb + (size_t)((ent_) & 0xffffu) * DM + hi * 8; _Pragma("unroll") for (int d0 = 0; d0 < 8; ++d0) dst_[d0] = *(const bf16x8*)(qp_ + d0 * 16); } while (0)
    int g = wid; unsigned ent = 0u, entn = 0u; bool valid = false, validn = false; bf16x8 qr[8], qn[8];
    if (g < ng) { GRP_ENT(g, ent, valid); LOADQ(qr, ent); }
    if (g + 8 < ng) GRP_ENT(g + 8, entn, validn);
    WAIT_BAR0();
    for (; g < ng; g += 8) {
        const bool adj = g >= gF;
        unsigned entnn = 0u; bool validnn = false;
        if (g + 8 < ng) LOADQ(qn, entn);
        if (g + 16 < ng) GRP_ENT(g + 16, entnn, validnn);
        const int srow = (int)(ent & 0xffffu), slot = (int)(ent >> 16);
        float m_reg = -1e30f, l_reg = 0.f; f32x16 o[4];
#pragma unroll
        for (int d = 0; d < 4; ++d)
#pragma unroll
            for (int r = 0; r < 16; ++r) o[d][r] = 0.f;
#pragma unroll 1
        for (int t = 0; t < 4; ++t) {
            f32x16 p0, p1;
            qkt(p0, p1, (const LAS char*)(lds + RING_OFF + t * SHM_T), r32, hi, qr);
            if (adj) bias_mask_tile(p0, p1, srow - (j * 256 + t * 64) - 4 * hi, true, false, lut);
            float alpha; bf16x8 pa0, pa1, pa2, pa3;
            softmax_tile(p0, p1, m_reg, l_reg, alpha, pa0, pa1, pa2, pa3);
            RESC(o, 4, al_l, alpha);
            pv_tile(o, vb0 + t * SHM_T, pa0, pa1, pa2, pa3);
        }
        LAS int* rd = (LAS int*)al_l;
        const int rec = srow * 3 + slot;
        if (hi == 0) { li_l[r32] = l_reg; rd[r32] = valid ? rec : -1;
            if (valid) { PM[(size_t)rec * 2] = m_reg + (adj ? 0.f : c31); PM[(size_t)rec * 2 + 1] = l_reg; } }
        asm volatile("s_waitcnt lgkmcnt(0)" ::: "memory");
        int r32o = r32, hio = hi; asm volatile("" : "+v"(r32o), "+v"(hio));
#pragma unroll
        for (int r = 0; r < 16; ++r) { const int orow = crow(r, hio); const float rli = __builtin_amdgcn_rcpf(li_l[orow]); const int dst = rd[orow];
#pragma unroll
            for (int d0 = 0; d0 < 4; ++d0) { const float v = o[d0][r] * rli; const float vn = swz_xor<1>(v);
                if ((r32 & 1) == 0 && dst >= 0) *(unsigned*)(PO + (size_t)dst * HD + d0 * 32 + r32o) = cvtpk(v, vn); } }
        asm volatile("s_waitcnt lgkmcnt(0)" ::: "memory");
#pragma unroll
        for (int d0 = 0; d0 < 8; ++d0) qr[d0] = qn[d0];
        ent = entn; valid = validn; entn = entnn; validn = validnn;
    }
#undef GRP_ENT
#undef LOADQ
    WAIT_BAR0();
}

__device__ __forceinline__ void moba_final_unit(LAS unsigned char* lds, const bf16* Qrow0, const bf16* Kh, const bf16* Vh, bf16* Orow0, int qb, const unsigned* selrow, const float* relb, int h, const bf16* PO, const float* PM) {
    const int tid = opaque_tid(), wid = __builtin_amdgcn_readfirstlane(tid >> 6), lane = tid & 63, r32 = lane & 31, hi = lane >> 5;
    LAS float* wsf = (LAS float*)(lds + LDSX_OFF) + wid * 64; LAS float* al_l = wsf + 32;
    LAS float* lut = (LAS float*)(lds + LDSX_OFF + 2048);
    LAS float* ftab = (LAS float*)(lds + LDSX_OFF + 4352) + wid * 128;
    if (tid <= 128) lut[tid] = relb[(tid < 128 ? (int)T5_BUCKET[tid] : 31) * 12 + h] * LOG2E;
    bf16x8 qr[8];
#pragma unroll
    for (int d0 = 0; d0 < 8; ++d0) qr[d0] = *(const bf16x8*)(Qrow0 + (size_t)(wid * 32 + r32) * DM + d0 * 16 + hi * 8);
    const unsigned sel = selrow[wid * 32 + r32];
    const int krow = 4 * wid + (lane >> 4); const unsigned ksrc = (unsigned) krow * 256 + ((16 * (lane & 15)) ^ ((krow & 7) << 4));
    const int vkk = 8 * (wid >> 1) + ((lane & 31) >> 2); const unsigned vsrc = (unsigned) swap23(vkk) * 256 + (32 * (2 * (wid & 1) + (lane >> 5)) + 8 * (lane & 3)) * 2;
    const unsigned lds0 = (unsigned)(uintptr_t)(lds + RING_OFF);
    const char* Kg = (const char*)(Kh + (size_t)qb * 256 * HD); const char* Vg = (const char*)(Vh + (size_t)qb * 256 * HD);
    { const unsigned base_ = (unsigned)__builtin_amdgcn_readfirstlane(lds0 + wid * 1024);
#pragma unroll
      for (int t = 0; t < 4; ++t) { glds16(Kg + t * SHM_T, ksrc, base_ + t * SHM_T); glds16(Kg + t * SHM_T + 8192, ksrc, base_ + t * SHM_T + 8192);
                                    glds16(Vg + t * SHM_T, vsrc, base_ + 65536 + t * SHM_T); glds16(Vg + t * SHM_T + 8192, vsrc, base_ + 65536 + t * SHM_T + 8192); } }
    const int vb0 = (int)lds0 + 65536 + v_rd_base(lane);
    float m_reg = -1e30f, l_reg = 0.f; f32x16 o[4];
#pragma unroll
    for (int d = 0; d < 4; ++d)
#pragma unroll
        for (int r = 0; r < 16; ++r) o[d][r] = 0.f;
    const int qrel = wid * 32 + r32;
    WAIT_BAR0();
#pragma unroll 1
    for (int t = 0; t <= (wid >> 1); ++t) {
        f32x16 p0, p1;
        qkt(p0, p1, (const LAS char*)(lds + RING_OFF + t * SHM_T), r32, hi, qr);
        bias_mask_tile(p0, p1, qrel - t * 64 - 4 * hi, true, false, lut);
        float alpha; bf16x8 pa0, pa1, pa2, pa3;
        softmax_tile(p0, p1, m_reg, l_reg, alpha, pa0, pa1, pa2, pa3);
        RESC(o, 4, al_l, alpha);
        pv_tile(o, vb0 + t * SHM_T, pa0, pa1, pa2, pa3);
    }
    const int nsel = __builtin_popcount(sel); const size_t rec0 = (size_t)(qb * 256 + qrel) * 3;
    float mi[3], li[3]; float M = m_reg;
#pragma unroll
    for (int i = 0; i < 3; ++i) { mi[i] = -1e30f; li[i] = 0.f; if (i < nsel) { mi[i] = PM[(rec0 + i) * 2]; li[i] = PM[(rec0 + i) * 2 + 1]; } M = fmaxf(M, mi[i]); }
    const float wo = __builtin_amdgcn_exp2f(m_reg - M); float L = l_reg * wo; float wi[3];
#pragma unroll
    for (int i = 0; i < 3; ++i) { wi[i] = (i < nsel) ? li[i] * __builtin_amdgcn_exp2f(mi[i] - M) : 0.f; L += wi[i]; }
    const float rL = 1.f / L;
    if (hi == 0) { ftab[r32] = wo * rL; ftab[32 + r32] = wi[0] * rL; ftab[64 + r32] = wi[1] * rL; ftab[96 + r32] = wi[2] * rL; }
    WAIT_BAR0();
    int r32o = r32, hio = hi, laneo = lane; asm volatile("" : "+v"(r32o), "+v"(hio), "+v"(laneo));
    LAS float* X = (LAS float*)(lds + RING_OFF) + wid * 4096;
#pragma unroll
    for (int r = 0; r < 16; ++r) { const int orow = crow(r, hio); const float fo = ftab[orow];
#pragma unroll
        for (int d0 = 0; d0 < 4; ++d0) X[orow * 128 + d0 * 32 + r32o] = o[d0][r] * fo; }
    asm volatile("s_waitcnt lgkmcnt(0)" ::: "memory");
    { const int rg = laneo >> 4, c = laneo & 15;
      unsigned char* Ow = (unsigned char*)Orow0 + (size_t)(wid * 32) * DM + 8 * c;
      const bf16* Pw = PO + ((size_t)(qb * 256 + wid * 32) * 3) * HD + 8 * c;
#pragma unroll 2
      for (int it = 0; it < 8; ++it) { const int row = it * 4 + rg;
          const f32x4 x0 = *(const LAS f32x4*)(X + row * 128 + 8 * c), x1 = *(const LAS f32x4*)(X + row * 128 + 8 * c + 4);
          float v[8] = {x0[0], x0[1], x0[2], x0[3], x1[0], x1[1], x1[2], x1[3]};
#pragma unroll
          for (int i = 0; i < 3; ++i) { const float f = ftab[32 * (i + 1) + row];
              if (f != 0.f) { const v4u w = *(const v4u*)(Pw + ((size_t)row * 3 + i) * HD);
                  v[0] += f * bflo(w.x); v[1] += f * bfhi(w.x); v[2] += f * bflo(w.y); v[3] += f * bfhi(w.y); v[4] += f * bflo(w.z); v[5] += f * bfhi(w.z); v[6] += f * bflo(w.w); v[7] += f * bfhi(w.w); } }
          unsigned w0 = 0u, w1 = 0u;
          w0 = __builtin_amdgcn_cvt_pk_fp8_f32(v[0] * SC_O, v[1] * SC_O, w0, false); w0 = __builtin_amdgcn_cvt_pk_fp8_f32(v[2] * SC_O, v[3] * SC_O, w0, true);
          w1 = __builtin_amdgcn_cvt_pk_fp8_f32(v[4] * SC_O, v[5] * SC_O, w1, false); w1 = __builtin_amdgcn_cvt_pk_fp8_f32(v[6] * SC_O, v[7] * SC_O, w1, true);
          *(v2u*)(Ow + (size_t)row * DM) = (v2u){w0, w1}; } }
    WAIT_BAR0();
}
#undef RESC
}

__device__ __forceinline__ int queue_next(gu32* ctr, LAS unsigned char* lds) {
    volatile LAS int* slot = (volatile LAS int*)(lds + LDSX_OFF + 4096);
    if (threadIdx.x == 0) slot[0] = (int)__hip_atomic_fetch_add(ctr, 1u, RLX_AGENT);
    __syncthreads();
    return __builtin_amdgcn_readfirstlane(slot[0]);
}

__device__ __forceinline__ void phase_moba_sparse(const Args& a, LAS unsigned char* lds, gu32* qctr) {
    unsigned char* ws = opaque_ws(a.ws);
    const bf16* QH = (const bf16*)(ws + WS_QH); const bf16* KH = (const bf16*)(ws + WS_KH); const bf16* VH = (const bf16*)(ws + WS_VH);
    const unsigned* MC = (const unsigned*)(ws + WS_CTL) + CW_MC;
    for (;;) {
        const int uq = queue_next(qctr, lds);
        if (uq >= 744 + CONV_NCH / 2) break;
        const Mix mx = mix_decode(uq, 744, CONV_NCH / 2);
        if (mx.conv) { conv_chunk(a, lds, 0, mx.idx); continue; }
        const int u = mx.idx;
        const int j = u / 24, bh = u % 24, b = bh / 12, h = bh % 12;
        const int cntA = (int)MC[(bh * 32 + j) * 2], cntF = (int)MC[(bh * 32 + j) * 2 + 1];
        const bf16* QHb = QH + (size_t)b * SEQ * DM + h * HD; const bf16* Kblk = KH + ((size_t)bh * SEQ + j * 256) * HD; const bf16* Vblk = VH + ((size_t)bh * SEQ + j * 256) * HD;
        bf16* PO = (bf16*)(ws + WS_PO) + (size_t)bh * SEQ * 3 * HD; float* PM = (float*)(ws + WS_PM) + (size_t)bh * SEQ * 3 * 2;
        att::moba_sparse_unit(lds, QHb, Kblk, Vblk, (const unsigned*)(ws + WS_LISTF) + ((size_t)bh * 32 + j) * 8192, cntF, (const unsigned*)(ws + WS_LISTA) + ((size_t)bh * 32 + j) * 256, cntA, j, PO, PM, a.in[I_RELB], h);
    }
}
__device__ __forceinline__ void phase_attn_a(const Args& a, LAS unsigned char* lds, gu32* qctr) {
    unsigned char* ws = opaque_ws(a.ws);
    const bf16* QH = (const bf16*)(ws + WS_QH); const bf16* KH = (const bf16*)(ws + WS_KH); const bf16* VH = (const bf16*)(ws + WS_VH); bf16* OC = (bf16*)(ws + WS_OCAT);
    const unsigned* SEL = (const unsigned*)(ws + WS_SMALL + SM_SEL);
    for (;;) {
        const int uq = queue_next(qctr, lds);
        if (uq >= 768 + 256 + CONV_NCH / 2) break;
        const Mix mx = mix_decode(uq, 768 + 256, CONV_NCH / 2);
        if (mx.conv) { conv_chunk(a, lds, 0, CONV_NCH / 2 + mx.idx); continue; }
        const int u = mx.idx;
        if (u < 768) { const int qb = 31 - u / 24, bh = u % 24, b = bh / 12, h = bh % 12; const size_t row0 = (size_t)b * SEQ + qb * 256;
            att::moba_final_unit(lds, QH + row0 * DM + h * HD, KH + (size_t)bh * SEQ * HD, VH + (size_t)bh * SEQ * HD, (bf16*)((unsigned char*)OC + row0 * DM + h * HD), qb,
                                 SEL + (size_t)bh * SEQ + qb * 256, a.in[I_RELB], h, (const bf16*)(ws + WS_PO) + (size_t)bh * SEQ * 3 * HD, (const float*)(ws + WS_PM) + (size_t)bh * SEQ * 3 * 2);
        } else { const int v = u - 768, b = v >> 7, hm = (v >> 5) & 3, qb = v & 31; const size_t row0 = (size_t)b * SEQ + qb * 256;
            const size_t mo = (size_t)((0 * 2 + b) * 4 + hm) * NMEM * HD;
            att::attn128_unit<1, true>(lds, QH + row0 * DM + (12 + hm) * HD, (const bf16*)(ws + WS_SMALL + SM_KM) + mo, (const bf16*)(ws + WS_SMALL + SM_VM) + mo, (bf16*)((unsigned char*)OC + row0 * DM + MIXW + hm * HD), 4, 0, nullptr, nullptr, 0);
        }
    }
}
template <int VAR>
__device__ __forceinline__ void phase_attn_b(const Args& a, LAS unsigned char* lds, gu32* qctr, bf16* OC) {
    unsigned char* ws = opaque_ws(a.ws);
    const bf16* QH = (const bf16*)(ws + WS_QH); const bf16* KH = (const bf16*)(ws + WS_KH); const bf16* VH = (const bf16*)(ws + WS_VH);
    float lam;
    { const float* lb = a.in[I_LAMBDA]; const int lane = opaque_tid() & 63;
      float s1 = lb[lane] * lb[128 + lane] + lb[64 + lane] * lb[128 + 64 + lane], s2 = lb[256 + lane] * lb[384 + lane] + lb[256 + 64 + lane] * lb[384 + 64 + lane];
      s1 = wave_sum(s1); s2 = wave_sum(s2); lam = expf(s1) - expf(s2) + LAM_INIT; }
    for (;;) {
        const int uq = queue_next(qctr, lds);
        if (uq >= 768 + 256 + CONV_NCH) break;
        const Mix mx = mix_decode(uq, 768 + 256, CONV_NCH);
        if (mx.conv) { conv_chunk(a, lds, 1, mx.idx); continue; }
        const int u = mx.idx;
        if (u < 768) { const int qblk = 63 - u / 12, bh = u % 12, b = bh / 6, h = bh % 6; const size_t row0 = (size_t)b * SEQ + qblk * 128;
            att::diff_unit<VAR>(lds, QH + row0 * DM, KH + (size_t)(b * 12 + h) * SEQ * HD, KH + (size_t)(b * 12 + 6 + h) * SEQ * HD, VH + (size_t)(b * 6 + h) * SEQ * DV, (bf16*)((unsigned char*)OC + row0 * DM + h * DV),
                           qblk, a.in[I_RELB], h, lam, a.in[I_SUBLN]);
        } else { const int v = u - 768, b = v >> 7, hm = (v >> 5) & 3, qb = v & 31; const size_t row0 = (size_t)b * SEQ + qb * 256;
            const size_t mo = (size_t)((1 * 2 + b) * 4 + hm) * NMEM * HD;
            att::attn128_unit<1, true>(lds, QH + row0 * DM + (12 + hm) * HD, (const bf16*)(ws + WS_SMALL + SM_KM) + mo, (const bf16*)(ws + WS_SMALL + SM_VM) + mo, (bf16*)((unsigned char*)OC + row0 * DM + MIXW + hm * HD), 4, 0, nullptr, nullptr, 0);
        }
    }
}

template <int RV>
__device__ __forceinline__ void phase_router(const Args& a, LAS unsigned char* lds, int G, int vb, int layer) {
    unsigned char* ws = opaque_ws(a.ws);
    const int tid = opaque_tid(), lane = tid & 63, wave = __builtin_amdgcn_readfirstlane(tid >> 6), i16 = lane & 15, g4 = lane >> 4, tg = wave & 1, kq = wave >> 1;
    const bf16* H = (const bf16*)(ws + WS_HB);
    const bf16* WRh = (const bf16*)(ws + WS_W_RT) + (size_t)layer * 2 * NRTP * DM;
    LAS float* L = (LAS float*)(lds + RING_OFF);
    LAS int* cnt = (LAS int*)(lds + RING_OFF + 4 * 64 * NRTP * 4);
    for (int blk = vb; blk < T / 64; blk += G) {
        if (tid < 64) cnt[tid] = 0;
        f32x4 acc[2][5];
#pragma unroll
        for (int t2 = 0; t2 < 2; ++t2)
#pragma unroll
            for (int j = 0; j < 5; ++j) acc[t2][j] = (f32x4){0.f, 0.f, 0.f, 0.f};
        const bf16* hrow = H + (size_t)(blk * 64 + tg * 32 + i16) * DM + kq * 512 + 8 * g4;
        const bf16* wh = WRh + (size_t)i16 * DM + kq * 512 + 8 * g4;
#pragma unroll 4
        for (int ks = 0; ks < ((RV & 1) ? 0 : 16); ++ks) {
            bf16x8 fa[2];
#pragma unroll
            for (int t2 = 0; t2 < 2; ++t2) fa[t2] = *(const bf16x8*)(hrow + (size_t)t2 * 16 * DM + ks * 32);
#pragma unroll
            for (int jt = 0; jt < 5; ++jt) {
                const bf16x8 bh = *(const bf16x8*)(wh + (size_t)jt * 16 * DM + ks * 32);
#pragma unroll
                for (int t2 = 0; t2 < 2; ++t2) acc[t2][jt] = __builtin_amdgcn_mfma_f32_16x16x32_bf16(fa[t2], bh, acc[t2][jt], 0, 0, 0);
            }
        }
#pragma unroll
        for (int t2 = 0; t2 < 2; ++t2)
#pragma unroll
            for (int jt = 0; jt < 5; ++jt)
#pragma unroll
                for (int r = 0; r < 4; ++r) L[(kq * 64 + tg * 32 + t2 * 16 + 4 * g4 + r) * NRTP + jt * 16 + i16] = acc[t2][jt][r];
        __syncthreads();
        if (tid < 64 && !(RV & 2)) {
            const int tok = blk * 64 + tid;
            const float* part = (const float*)(ws + WS_SMALL + SM_PART) + (size_t)tok * 32;
            float ss = 0.f;
#pragma unroll
            for (int i = 0; i < 32; ++i) ss += part[i];
            const float rstd = 1.0f / sqrtf(ss * (1.f / DM) + RMS_EPS);
            const LAS float* l0 = L + tid * NRTP;
            const float* brg = a.in[I_B_RG] + layer * 8; const float* bre = a.in[I_B_RE] + layer * 64;
            float gmax = -__builtin_inff(); int gi = 0; float gl[8];
#pragma unroll
            for (int j = 0; j < 8; ++j) { gl[j] = ((l0[j] + l0[64 * NRTP + j]) + (l0[128 * NRTP + j] + l0[192 * NRTP + j])) * rstd + brg[j]; if (gl[j] > gmax) { gmax = gl[j]; gi = j; } }
            float gs = 0.f;
#pragma unroll
            for (int j = 0; j < 8; ++j) gs += expf(gl[j] - gmax);
            const float pg = 1.f / gs;
            float v0 = -__builtin_inff(), v1 = -__builtin_inff(); int i0 = 0, i1 = 0;
#pragma unroll
            for (int j = 0; j < 8; ++j) { const int ix = 8 + gi * 8 + j; const float e = ((l0[ix] + l0[64 * NRTP + ix]) + (l0[128 * NRTP + ix] + l0[192 * NRTP + ix])) * rstd + bre[gi * 8 + j];
                if (e > v0) { v1 = v0; i1 = i0; v0 = e; i0 = j; } else if (e > v1) { v1 = e; i1 = j; } }
            const float dd = expf(v1 - v0), w0 = pg / (1.f + dd), w1 = pg * dd / (1.f + dd);
            const int e0 = gi * 8 + i0, e1 = gi * 8 + i1;
            v4u tr; tr.x = (unsigned)e0; tr.y = (unsigned)e1; tr.z = __float_as_uint(w0); tr.w = __float_as_uint(w1);
            *(v4u*)(ws + WS_SMALL + SM_TOKR + (size_t)tok * 16) = tr;
            ((float*)(ws + WS_SMALL + SM_RSTD))[tok] = rstd;
            __hip_atomic_fetch_add(cnt + e0, 1, __ATOMIC_RELAXED, __HIP_MEMORY_SCOPE_WORKGROUP);
            __hip_atomic_fetch_add(cnt + e1, 1, __ATOMIC_RELAXED, __HIP_MEMORY_SCOPE_WORKGROUP);
        }
        __syncthreads();
        if (tid < 64 && !(RV & 2)) ((int*)(ws + WS_SMALL + SM_CNT))[blk * 64 + tid] = cnt[tid];
        __syncthreads();
    }
}

__device__ __forceinline__ void phase_gather(const Args& a, LAS unsigned char* lds, int G, int vb) {
    unsigned char* ws = opaque_ws(a.ws);
    const int tid = opaque_tid(), lane = tid & 63, wave = __builtin_amdgcn_readfirstlane(tid >> 6);
    const int* CNT = (const int*)(ws + WS_SMALL + SM_CNT); int* BLKE = (int*)(ws + WS_SMALL + SM_BLKE); int* DEST = (int*)(ws + WS_SMALL + SM_DEST);
    const unsigned* TOKR = (const unsigned*)(ws + WS_SMALL + SM_TOKR);
    int* ROWTOK = (int*)(ws + WS_SMALL + SM_ROWTOK);
    LAS int* tot = (LAS int*)(lds + RING_OFF); LAS int* pre = tot + 64; LAS int* pst = tot + 128; LAS int* destl = tot + 192;
    LAS int* part8 = tot + 320;
    LAS int* tokl = tot + 320 + 1024;
    for (int blk = vb; blk < T / 64; blk += G) {
        { const int e = tid & 63, p8 = tid >> 6; int t_ = 0, p_ = 0;
#pragma unroll 8
          for (int b2 = p8 * 32; b2 < p8 * 32 + 32; ++b2) { const int c = CNT[b2 * 64 + e]; t_ += c; p_ += (b2 < blk) ? c : 0; }
          part8[(p8 * 64 + e) * 2] = t_; part8[(p8 * 64 + e) * 2 + 1] = p_;
          if (tid < 128) tokl[tid] = (int)TOKR[(size_t)(blk * 64 + (tid >> 1)) * 4 + (tid & 1)]; }
        __syncthreads();
        if (tid < 64) { int t_ = 0, p_ = 0;
#pragma unroll
            for (int p8 = 0; p8 < 8; ++p8) { t_ += part8[(p8 * 64 + tid) * 2]; p_ += part8[(p8 * 64 + tid) * 2 + 1]; }
            tot[tid] = t_; pre[tid] = p_;
            const int padded = ((t_ + 255) >> 8) << 8; int incl = padded;
#pragma unroll
            for (int o = 1; o < 64; o <<= 1) { const int up = __shfl_up(incl, o); if (tid >= o) incl += up; }
            pst[tid] = incl - padded;
            if (blk == 0 && tid == 63) BLKE[MAXRB] = incl >> 8; }
        __syncthreads();
        if (tid < 64) {
            if (blk == 0) { const int rb0 = pst[tid] >> 8, rb1 = (pst[tid] + (((tot[tid] + 255) >> 8) << 8)) >> 8; for (int rb = rb0; rb < rb1; ++rb) BLKE[rb] = tid; }
            int r = pst[tid] + pre[tid];
            for (int as = 0; as < 128; ++as) { if (tokl[as] == tid) destl[as] = r++; }
        }
        __syncthreads();
        if (tid < 128) { const int tok = blk * 64 + (tid >> 1), dest = destl[tid]; DEST[tok * 2 + (tid & 1)] = dest; ROWTOK[dest] = tok; }
        if (blk < 64) {
            const int r0 = pst[blk] + tot[blk], r1 = pst[blk] + (((tot[blk] + 255) >> 8) << 8);
            for (int r = r0 + tid; r < r1; r += 512) ROWTOK[r] = 0;
        }
        __syncthreads();
    }
}

__device__ __forceinline__ void phase_combine(const Args& a, int G, int vb, float* Fout  ) {
    unsigned char* ws = opaque_ws(a.ws);
    const int tid = opaque_tid(), lane = tid & 63, wave = __builtin_amdgcn_readfirstlane(tid >> 6);
    const int gw = vb * 8 + wave, NGW = G * 8;
    const bf16* YS = (const bf16*)(ws + WS_YS); const int* DEST = (const int*)(ws + WS_SMALL + SM_DEST); float* RSTD = (float*)(ws + WS_SMALL + SM_RSTD); bf16* HB = (bf16*)(ws + WS_HB);
    for (int tok = gw; tok < T; tok += NGW) {
        const v4u tr = *(const v4u*)(ws + WS_SMALL + SM_TOKR + (size_t)tok * 16); const float w0 = __uint_as_float(tr.z), w1 = __uint_as_float(tr.w);
        const int d0 = DEST[tok * 2], d1 = DEST[tok * 2 + 1];
        GAS v2u* hr = (GAS v2u*)(HB + (size_t)tok * DM) + lane;
        const GAS v2u* y0 = (const GAS v2u*)(YS + (size_t)d0 * DM) + lane; const GAS v2u* y1 = (const GAS v2u*)(YS + (size_t)d1 * DM) + lane;
        v2u hv[8], a0[8], a1[8];
#pragma unroll
        for (int j = 0; j < 8; ++j) { hv[j] = hr[64 * j]; a0[j] = y0[64 * j]; a1[j] = y1[64 * j]; }
        float ss = 0.f;
#pragma unroll
        for (int j = 0; j < 8; ++j) { f32x4 v;
            v.x = bflo(hv[j].x) + (w0 * bflo(a0[j].x) + w1 * bflo(a1[j].x)); v.y = bfhi(hv[j].x) + (w0 * bfhi(a0[j].x) + w1 * bfhi(a1[j].x));
            v.z = bflo(hv[j].y) + (w0 * bflo(a0[j].y) + w1 * bflo(a1[j].y)); v.w = bfhi(hv[j].y) + (w0 * bfhi(a0[j].y) + w1 * bfhi(a1[j].y));
            ss += (v.x * v.x + v.y * v.y) + (v.z * v.z + v.w * v.w);
            if (Fout) ((GAS f32x4*)(Fout + (size_t)tok * DM) + lane)[64 * j] = v;
            else { v2u o; o.x = pk2(v.x, v.y); o.y = pk2(v.z, v.w); hr[64 * j] = o;
                   unsigned w8 = 0u; w8 = __builtin_amdgcn_cvt_pk_fp8_f32(v.x, v.y, w8, false); w8 = __builtin_amdgcn_cvt_pk_fp8_f32(v.z, v.w, w8, true); ((GAS unsigned*)(ws + WS_HB8 + (size_t)tok * DM) + lane)[64 * j] = w8; } }
        if (!Fout) { const float rstd = 1.0f / sqrtf(wave_sum(ss) * (1.f / DM) + RMS_EPS); if (lane == 0) RSTD[tok] = rstd; }
    }
}

struct EpiNull { static constexpr bool PERM = false, AFTER_DRAIN = false;
    __device__ __forceinline__ void operator()(const f32x4 (&acc)[2][2][4][2], const pg8::Unit& u, int wr, int wc, int fr, int fq) const {} };
#ifndef MK_DUP
#define MK_DUP -1
#endif
#define DUP(k) (MK_DUP == (k))
#ifndef MK_VAR
#define MK_VAR 0
#endif
#ifndef FP8IN_SP2
#define FP8IN_SP2 true
#endif
constexpr int NPH = 21;
__global__ void __launch_bounds__(512, 2) yoco_fwd(Args args) {
    extern __shared__ __attribute__((aligned(16))) unsigned char lds_raw[];
    LAS unsigned char* lds = (LAS unsigned char*)lds_raw;
    const int tid = opaque_tid();
    const int G = gridDim.x; const int bx0 = blockIdx.x; const int vb = (G % 8 == 0) ? (bx0 % 8) * (G / 8) + bx0 / 8 : bx0;
    unsigned char* ws = args.ws;
    gu32* ctl = (gu32*)(ws + WS_CTL);
    for (int u = tid; u < (LDS_BYTES - LDSCTL_OFF) / 4; u += 512) ((LAS unsigned*)(lds + LDSCTL_OFF))[u] = 0u;
    __syncthreads();
    volatile LAS unsigned* MISC = (volatile LAS unsigned*)(lds + MISC_OFF);
#if MK_N_LAUNCHES == 1
    constexpr int lo = 0, hi = NPH; constexpr bool one = true;
#else
    const int lo = args.ph_lo, hi = args.ph_hi;
    const bool one = (hi - lo) > 1;
#endif
    XcdBarrier bar; bar.bar = (unsigned*)(ctl + CW_BAR); bar.x = 0; bar.st = nullptr;
    if (one) bar = xcd_barrier_post((unsigned*)(ctl + CW_BAR), MISC + 8);
#define GBAR() do { XcdBarrier b2_ = bar; b2_.bar = (unsigned*)opaque_ws((unsigned char*)bar.bar); { unsigned x_ = bar.x; asm volatile("" : "+s"(x_)); b2_.x = x_; } xcd_barrier(b2_); } while (0)
#define IN(k) (lo <= (k) && (k) < hi)
#define SEAM(k) do { if (IN(k) && IN((k) + 1)) GBAR(); } while (0)

#define RUN(k, ...) do { if (IN(k)) { __VA_ARGS__ if (DUP(k)) { __syncthreads(); __VA_ARGS__ } } } while (0)
    RUN(0, phase_prep(args, lds, G, vb););
    SEAM(0);
    for (int l = 0; l < 2; ++l) {
        const int pb = 1 + 10 * l;
        int bx = bx0; asm volatile("" : "+s"(bx));
        RUN(pb + 0,
            { pg8::Gemm g{(const bf16*)(ws + WS_HB8), (const bf16*)(ws + (l == 0 ? WS_W_INA : WS_W_INB)), T, PROJW, DM / 2}; pg8::StaticOrder S; S.init(T, PROJW, G, bx);
              EpiHeadNorm E{ws, l, 1.f / SC_W1};
              pg8::gemm_phase<EpiHeadNorm, pg8::StaticOrder, true, FP8IN_SP2, false, true>(lds + RING_OFF, g, S, E); }
            );
        if (one) GBAR();
        if (l == 0) { if (IN(pb + 2)) {
                if (bx < 16) { pg8::Gemm g{(const bf16*)(ws + WS_SMALL + SM_MEMN), (const bf16*)(ws + WS_W_MKV), NB * NMEM, 2048, DM}; pg8::StaticOrder S; S.init(NB * NMEM, 2048, G, bx);
                    EpiRowScale E{(bf16*)(ws + WS_SMALL + SM_KVM), 2048, nullptr, 0, 1.f};
                    pg8::gemm_phase<EpiRowScale, pg8::StaticOrder, true, true>(lds + RING_OFF, g, S, E); }
                else phase_gate(args, lds, G - 16, bx - 16); }
            if (one) GBAR(); }
        if (IN(pb + 3)) { if (l == 0) { phase_post_mem(args, lds, G, vb); phase_moba_sparse(args, lds, ctl + CW_Q + 256); if (DUP(40)) { __syncthreads(); phase_moba_sparse(args, lds, ctl + CW_Q + 320); } if (one) GBAR(); phase_attn_a(args, lds, ctl + CW_Q); if (DUP(41)) { __syncthreads(); phase_attn_a(args, lds, ctl + CW_Q + 128); } }
            else { phase_attn_b<0>(args, lds, ctl + CW_Q + 64, (bf16*)(ws + WS_OCAT)); if (DUP(14)) { __syncthreads(); phase_attn_b<MK_VAR>(args, lds, ctl + CW_Q + 192, (bf16*)(ws + WS_YS)); } } }
        SEAM(pb + 3);
        RUN(pb + 4,
            { pg8::Gemm g8{(const bf16*)(ws + WS_OCAT), (const bf16*)(ws + WS_W_OUT + (size_t)l * DM * DM), T, DM, DM / 2}; pg8::StaticOrder S; S.init(T, DM, G, bx);
              if (l == 0) { EpiOutProj<true> E{args.in[I_X], (float*)(ws + WS_SMALL + SM_PART), (bf16*)(ws + WS_HB), ws + WS_HB8, 1.f / (SC_O * SC_W1)}; pg8::gemm_phase<EpiOutProj<true>, pg8::StaticOrder, true, true, false, true>(lds + RING_OFF, g8, S, E); }
              else { EpiOutProj<false> E{nullptr, (float*)(ws + WS_SMALL + SM_PART), (bf16*)(ws + WS_HB), ws + WS_HB8, 1.f / (SC_O * SC_W1)}; pg8::gemm_phase<EpiOutProj<false>, pg8::StaticOrder, true, true, false, true>(lds + RING_OFF, g8, S, E); } });
#if MK_DUP == 52
        if (l == 0) { __syncthreads();
            pg8::Gemm g9{(const bf16*)(ws + WS_OCAT), (const bf16*)(ws + WS_W_INA), T, PROJW, DM / 2}; pg8::StaticOrder S9; S9.init(T, PROJW, G, bx);
            EpiHeadNormT<MK_VAR> E9{ws, 0, 1.f / SC_W1}; pg8::gemm_phase<EpiHeadNormT<MK_VAR>, pg8::StaticOrder, true, true, false, true>(lds + RING_OFF, g9, S9, E9); }
#endif
#if MK_DUP == 50 || MK_DUP == 51
        if (l == 0) { __syncthreads(); constexpr int NN9 = (MK_DUP == 50) ? DM : PROJW;
            pg8::Gemm g9{(const bf16*)(ws + WS_OCAT), (const bf16*)(ws + (MK_DUP == 50 ? WS_W_OUT : WS_W_INA)), T, NN9, DM / 2}; pg8::StaticOrder S9; S9.init(T, NN9, G, bx);
            EpiNull E9; pg8::gemm_phase<EpiNull, pg8::StaticOrder, false, true, false, true>(lds + RING_OFF, g9, S9, E9); }
#endif
        SEAM(pb + 4);
        if (IN(pb + 5)) { phase_router<0>(args, lds, G, vb, l); if (DUP(pb + 5)) { __syncthreads(); phase_router<MK_VAR>(args, lds, G, vb, l); } }
        SEAM(pb + 5);
        RUN(pb + 6, phase_gather(args, lds, G, vb););
        SEAM(pb + 6);
        RUN(pb + 7,
            { const int* blke = (const int*)(ws + WS_SMALL + SM_BLKE);
              const int* rowtok = (const int*)(ws + WS_SMALL + SM_ROWTOK);
              pg8::Gemm g{(const bf16*)(ws + WS_HB8), (const bf16*)(ws + WS_W_E1 + (size_t)l * NEXP * 1024 * DM), MAXRB * 256, 1024, DM / 2, rowtok};
              MoeOrder S{blke, blke[MAXRB] * 4, 4, G, bx}; EpiSiluMul E{(bf16*)(ws + WS_HID), (const float*)(ws + WS_SMALL + SM_RSTD), rowtok};
              pg8::gemm_phase<EpiSiluMul, MoeOrder, true, true, true, true>(lds + RING_OFF, g, S, E); });
        SEAM(pb + 7);
        RUN(pb + 8,
            { const int* blke = (const int*)(ws + WS_SMALL + SM_BLKE);
              pg8::Gemm g{(const bf16*)(ws + WS_HID), (const bf16*)(ws + WS_W_E2 + (size_t)l * NEXP * DM * EFF), MAXRB * 256, DM, EFF / 2};
              MoeOrder S{blke, blke[MAXRB] * 8, 8, G, bx}; EpiRowScale E{(bf16*)(ws + WS_YS), DM, nullptr, 8, 1.f / (SC_HID * SC_W2)};
              pg8::gemm_phase<EpiRowScale, MoeOrder, true, true, false, true>(lds + RING_OFF, g, S, E); });
        SEAM(pb + 8);
        if (IN(pb + 9)) phase_combine(args, G, vb, l == 0 ? nullptr : args.out);
        if (l == 0) SEAM(pb + 9);
    }
#undef RUN
#undef IN
#undef SEAM
}

extern "C" void kernel_launch(void* const* d_in, const int* in_sizes, int n_in, void* d_out, int out_size, void* d_ws, size_t ws_size, hipStream_t stream) {
    static int grid = 0;
    if (grid == 0) {
        if (n_in != N_IN || out_size != T * DM || ws_size < WS_END) { fprintf(stderr, "kernel_launch: unexpected shapes (n_in %d out %d ws %zu)\n", n_in, out_size, ws_size); grid = -1; return; }
        int dev = 0, cus = 0;
        if (hipGetDevice(&dev) != hipSuccess || hipDeviceGetAttribute(&cus, hipDeviceAttributeMultiprocessorCount, dev) != hipSuccess) { grid = -1; return; }
        if (hipFuncSetAttribute((const void*)yoco_fwd, hipFuncAttributeMaxDynamicSharedMemorySize, LDS_BYTES) != hipSuccess) { fprintf(stderr, "kernel_launch: hipFuncSetAttribute failed\n"); grid = -1; return; }
        int per_cu = 0;
        if (hipOccupancyMaxActiveBlocksPerMultiprocessor(&per_cu, (const void*)yoco_fwd, 512, LDS_BYTES) != hipSuccess || per_cu < 1) fprintf(stderr, "kernel_launch: occupancy query reports %d\n", per_cu);
        (void)hipGetLastError();
        grid = cus;
    }
    if (grid < 0) return;
    (void)hipMemsetAsync((char*)d_ws + WS_CTL, 0, CTL_ZERO_BYTES, stream);
    Args a{};
    for (int i = 0; i < N_IN; ++i) a.in[i] = (const float*)d_in[i];
    a.out = (float*)d_out; a.ws = (unsigned char*)d_ws;
#if MK_N_LAUNCHES == 1
    a.ph_lo = 0; a.ph_hi = NPH;
    hipLaunchKernelGGL(yoco_fwd, dim3(grid), dim3(512), LDS_BYTES, stream, a);
#else
    for (int p = 0; p < NPH; ++p) { if (p == 13) continue; a.ph_lo = p; a.ph_hi = p + 1; hipLaunchKernelGGL(yoco_fwd, dim3(grid), dim3(512), LDS_BYTES, stream, a); }
#endif
}
```

```cpp
#include <hip/hip_runtime.h>
#include <cstdio>
#include <cstdint>

#ifndef MK_N_LAUNCHES
#define MK_N_LAUNCHES 1
#endif
#ifndef MK_CHECK
#define MK_CHECK 0
#endif

constexpr int NB = 2, SEQ = 8192, T = NB * SEQ, DM = 2048, HD = 128;
constexpr int NMEM = 256, MEMH = 4, MEMW = 512, MIXW = 1536, MOBA_H = 12, DIFF_H = 6, DV = 256;
constexpr int NEXP = 64, NGRP = 8, EPG = 8, EFF = 512, NRT = 72, NRTP = 80;
constexpr int PROJW = 5120;
constexpr float RMS_EPS = 1e-6f;
constexpr float LOG2E = 1.4426950408889634f;
constexpr float QSCALE = 0.08838834764831845f * LOG2E;
constexpr float LAM_INIT = 0.35550906759096926f;
constexpr int MAXRB = 192;
constexpr float SC_W1 = 64.f, SC_W2 = 32.f, SC_HID = 8.f, SC_O = 16.f;

constexpr size_t MiB = 1u << 20;
constexpr size_t WS_CTL = 0, CTL_ZERO_BYTES = 1 * MiB;
constexpr size_t WS_W_INA = 1 * MiB;
constexpr size_t WS_W_INB = 21 * MiB;
constexpr size_t WS_W_OUT = 41 * MiB;
constexpr size_t WS_W_MKV = 57 * MiB;
constexpr size_t WS_W_RT  = 65 * MiB;
constexpr size_t WS_W_E1  = 67 * MiB;
constexpr size_t WS_HB8   = 323 * MiB;
constexpr size_t WS_W_E2  = 579 * MiB;
constexpr size_t WS_SMALL = 835 * MiB;
constexpr size_t WS_HB    = 851 * MiB;
constexpr size_t WS_PROJ  = 915 * MiB;
constexpr size_t WS_QH    = 1075 * MiB;
constexpr size_t WS_KH    = 1139 * MiB;
constexpr size_t WS_VH    = 1187 * MiB;
constexpr size_t WS_XS    = WS_PROJ;
constexpr size_t WS_OCAT  = 1235 * MiB;
constexpr size_t WS_HID   = 1299 * MiB;
constexpr size_t WS_YS    = 1347 * MiB;
constexpr size_t WS_HA    = 1539 * MiB;
constexpr size_t WS_H2    = 1667 * MiB;
constexpr size_t WS_LISTF = 1795 * MiB;
constexpr size_t WS_LISTA = 1821 * MiB;
constexpr size_t WS_PM    = 1822 * MiB;
constexpr size_t WS_PO    = WS_PROJ;
constexpr size_t WS_END   = 1827 * MiB;
static_assert(WS_XS + (size_t)MAXRB * 256 * 2048 * 2 <= WS_VH, "XS alias");
constexpr size_t SM_RSTD  = 0;
constexpr size_t SM_PART  = 1 * MiB;
constexpr size_t SM_TOKR  = 3 * MiB;
constexpr size_t SM_DEST  = 4 * MiB;
constexpr size_t SM_CNT   = 5 * MiB;
constexpr size_t SM_BLKE  = 5 * MiB + 128 * 1024;
constexpr size_t SM_KMEAN = 6 * MiB;
constexpr size_t SM_SEL   = 7 * MiB;
constexpr size_t SM_MEMN  = 8 * MiB;
constexpr size_t SM_KVM   = 10 * MiB;
constexpr size_t SM_KM    = 12 * MiB;
constexpr size_t SM_VM    = 13 * MiB;
constexpr size_t SM_GAINTAB = 15 * MiB;
constexpr size_t SM_ROWTOK = 14 * MiB;
constexpr int CW_BAR = 4096;
constexpr int CW_Q = 8192;
constexpr int CW_MC = 16384;

constexpr int RING_OFF = 0, RING_BYTES = 131072;
constexpr int LDSX_OFF = RING_BYTES;
constexpr int LDSCTL_OFF = RING_BYTES + 12288, MISC_OFF = LDSCTL_OFF + 320;
constexpr int LDS_BYTES = 147456;
static_assert(MISC_OFF + 128 <= LDS_BYTES, "LDS map");

#define GAS __attribute__((address_space(1)))
#define LAS __attribute__((address_space(3)))
typedef unsigned short bf16;
typedef unsigned v4u __attribute__((ext_vector_type(4)));
typedef unsigned v2u __attribute__((ext_vector_type(2)));
typedef float f32x4 __attribute__((ext_vector_type(4)));
typedef float f32x16 __attribute__((ext_vector_type(16)));
typedef short bf16x8 __attribute__((ext_vector_type(8)));
typedef short s16x4 __attribute__((ext_vector_type(4)));
typedef GAS unsigned gu32;
#define RLX_AGENT __ATOMIC_RELAXED, __HIP_MEMORY_SCOPE_AGENT
#define LDS_WAIT() asm volatile("s_waitcnt lgkmcnt(0)" ::: "memory")
#define VM_WAIT() asm volatile("s_waitcnt vmcnt(0)" ::: "memory")
__device__ __forceinline__ unsigned f2bf(float f) { unsigned u = __builtin_bit_cast(unsigned, f); return (u + 0x7fffu + ((u >> 16) & 1u)) >> 16; }
__device__ __forceinline__ unsigned pk2(float lo, float hi) { return f2bf(lo) | (f2bf(hi) << 16); }
__device__ __forceinline__ float bf2f(unsigned short b) { return __builtin_bit_cast(float, (unsigned)b << 16); }
__device__ __forceinline__ float bflo(unsigned w) { return __builtin_bit_cast(float, w << 16); }
__device__ __forceinline__ float bfhi(unsigned w) { return __builtin_bit_cast(float, w & 0xffff0000u); }
template <int M> __device__ __forceinline__ float swz_xor(float v) { return __builtin_bit_cast(float, __builtin_amdgcn_ds_swizzle(__builtin_bit_cast(int, v), (M << 10) | 0x1F)); }
__device__ __forceinline__ float add_xor32(float v) {
    auto r = __builtin_amdgcn_permlane32_swap(__float_as_uint(v), __float_as_uint(v), false, false);
    return __uint_as_float(r[0]) + __uint_as_float(r[1]); }
__device__ __forceinline__ float wave_sum(float v) {
    v += swz_xor<1>(v); v += swz_xor<2>(v); v += swz_xor<4>(v); v += swz_xor<8>(v); v += swz_xor<16>(v);
    return add_xor32(v);
}
__device__ const unsigned char T5_BUCKET[128] = {
 0, 1, 2, 3, 4, 5, 6, 7, 8, 9, 10, 11, 12, 13, 14, 15, 16, 16, 16, 17, 17, 18, 18, 18, 19, 19, 19, 20, 20, 20, 20, 21, 21, 21, 21, 22, 22, 22, 22, 22, 23, 23, 23, 23, 23, 23, 24, 24, 24, 24, 24, 24, 25, 25, 25, 25, 25, 25, 25, 26, 26, 26, 26, 26, 26, 26, 26, 27, 27, 27, 27, 27, 27, 27, 27, 27, 27, 28, 28, 28, 28, 28, 28, 28, 28, 28, 28, 29, 29, 29, 29, 29, 29, 29, 29, 29, 29, 29, 29, 30, 30, 30, 30, 30, 30, 30, 30, 30, 30, 30, 30, 30, 30, 31, 31, 31, 31, 31, 31, 31, 31, 31, 31, 31, 31, 31, 31, 31};

__device__ __forceinline__ int opaque_tid() { int t = threadIdx.x; asm volatile("" : "+v"(t)); return t; }

__device__ __forceinline__ unsigned char* opaque_ws(unsigned char* p) { asm volatile("" : "+s"(p)); return p; }
namespace pg8 {
#define PG8_LAS __attribute__((address_space(3)))
typedef unsigned short bf16_t;
typedef short bf16x8 __attribute__((ext_vector_type(8)));
typedef float f32x4 __attribute__((ext_vector_type(4)));
typedef unsigned u32x4 __attribute__((ext_vector_type(4)));
constexpr int BM = 256, BK = 64, HALF = 128, HTB = HALF * BK * 2  , STAGE_BYTES = 8 * HTB, NXCD = 8, WGM = 8;

__host__ __device__ __forceinline__ int lds_byte(int r, int c) { const int st = (r >> 4) * 2 + (c >> 5), rr = r & 15, cc = c & 31, ob = rr * 64 + cc * 2; return st * 1024 + (ob ^ (((ob >> 9) & 1) << 5)); }
__host__ __device__ __forceinline__ void stage_rc(int b, int& R, int& C) { const int st = b / 1024, sb = b % 1024, swz = sb ^ (((sb >> 9) & 1) << 5); R = (st >> 1) * 16 + swz / 64; C = (st & 1) * 32 + (swz % 64) / 2; }
__host__ __device__ __forceinline__ int perm32(int rho) { const int n = rho >> 4, i = rho & 15; return 8 * (i >> 2) + 4 * n + (i & 3); }

struct Unit { int pm, pn; };
struct Gemm { const bf16_t* A; const bf16_t* Bt; int M, N, K; const int* rowtok; };

struct StaticOrder {
    int nM, nN, nwg, G, c;
    __host__ __device__ void init(int M, int N, int G_, int c_) { nM = M / BM; nN = N / BM; nwg = nM * nN; G = G_; c = c_; }
    __host__ __device__ bool next(int i, Unit& u) const {
        const long L = (long)i * G + c; if (L >= nwg) return false;
        int wgid = (int)L; { const int q = nwg / NXCD, r = nwg % NXCD, xcd = wgid % NXCD, off = wgid / NXCD; wgid = (xcd < r ? xcd * (q + 1) : r * (q + 1) + (xcd - r) * q) + off; }
        const int nig = WGM * nN, gid = wgid / nig, fm = gid * WGM, gsz = (nM - fm) < WGM ? (nM - fm) : WGM;
        u.pm = fm + ((wgid % nig) % gsz); u.pn = (wgid % nig) / gsz; return true;
    }
    __device__ __forceinline__ void a_ready(const Unit&) const {}
    __device__ __forceinline__ void done(const Unit&) const {}
};

__device__ __forceinline__ unsigned cvt_pk_bf16(float lo, float hi) { unsigned r; asm volatile("v_cvt_pk_bf16_f32 %0, %1, %2" : "=v"(r) : "v"(lo), "v"(hi)); return r; }
typedef float f32x2 __attribute__((ext_vector_type(2)));
template <class Epi, class Sched, bool ALIGN_EPI = false, bool SP2 = false, bool GATHER = false, bool FP8 = false>
__device__ __forceinline__ void gemm_phase(PG8_LAS unsigned char* lds, const Gemm g, const Sched& S, const Epi& E) {
    const int tid = opaque_tid(), wid = __builtin_amdgcn_readfirstlane(tid >> 6), lane = tid & 63, wr = wid >> 2, wc = wid & 3, fr = lane & 15, fq = lane >> 4;
    const int K = g.K, nt = K / BK;
    unsigned voffA[2], voffB[2]; int RA[2]; unsigned CA2[2];
#pragma unroll
    for (int i = 0; i < 2; ++i) { int R, C; stage_rc(tid * 16 + i * 8192, R, C); const int Rb = Epi::PERM ? ((R & ~31) + perm32(R & 31)) : R;
        voffA[i] = (unsigned)(R * K + C) * 2u; voffB[i] = (unsigned)(Rb * K + C) * 2u; RA[i] = R; CA2[i] = (unsigned)C * 2u; }
    const size_t kstep = (size_t)(BK * 2);
    const size_t hstep = (size_t)HALF * K * 2;
    const size_t tstep = 2 * hstep;
    const unsigned ldsw = (unsigned)wid * 1024u;
    const int aoff = lds_byte(wr * 64 + fr, fq * 8), boff = lds_byte(wc * 32 + fr, fq * 8);
#define PG8_SA(b, h) (((b) * 2 + (h)) * HTB)
#define PG8_SB(b, h) ((4 + (b) * 2 + (h)) * HTB)
#define PG8_STAGE(bufoff, gbase, voff) do { _Pragma("unroll") for (int _i = 0; _i < 2; ++_i) \
        __builtin_amdgcn_global_load_lds((const unsigned*)((const char*)(gbase) + (voff)[_i]), (PG8_LAS unsigned*)(lds + (bufoff) + ldsw + _i * 8192), 16, 0, 0); } while (0)
    unsigned gc[2][2], gn[2][2];
#define PG8_GOFF(dst, pm_) do { _Pragma("unroll") for (int _h = 0; _h < 2; ++_h) _Pragma("unroll") for (int _i = 0; _i < 2; ++_i) \
        dst[_h][_i] = (unsigned)g.rowtok[(pm_) * BM + _h * HALF + RA[_i]] * (unsigned)(K * 2) + CA2[_i]; } while (0)
#define PG8_STAGE_A(bufoff, ptr, half, usenext) do { if constexpr (GATHER) { _Pragma("unroll") for (int _i = 0; _i < 2; ++_i) \
        __builtin_amdgcn_global_load_lds((const unsigned*)((const char*)(ptr) + ((usenext) ? gn[half][_i] : gc[half][_i])), (PG8_LAS unsigned*)(lds + (bufoff) + ldsw + _i * 8192), 16, 0, 0); } \
        else { PG8_STAGE(bufoff, (ptr) + (half) * hstep, voffA); } } while (0)
#define PG8_LDA(dst, b, h) do { if constexpr (FP8) { _Pragma("unroll") for (int m = 0; m < 4; ++m) dst##8[m] = PG8_CAT(*(const PG8_LAS bf16x8*)(lds + PG8_SA(b, h) + aoff + m * 2048), *(const PG8_LAS bf16x8*)(lds + PG8_SA(b, h) + aoff + m * 2048 + 1024)); } \
        else { _Pragma("unroll") for (int m = 0; m < 4; ++m) _Pragma("unroll") for (int k = 0; k < 2; ++k) dst[m][k] = *(const PG8_LAS bf16x8*)(lds + PG8_SA(b, h) + aoff + m * 2048 + k * 1024); } } while (0)
#define PG8_LDB(dst, b, h) do { if constexpr (FP8) { _Pragma("unroll") for (int n = 0; n < 2; ++n) dst##8[n] = PG8_CAT(*(const PG8_LAS bf16x8*)(lds + PG8_SB(b, h) + boff + n * 2048), *(const PG8_LAS bf16x8*)(lds + PG8_SB(b, h) + boff + n * 2048 + 1024)); } \
        else { _Pragma("unroll") for (int n = 0; n < 2; ++n) _Pragma("unroll") for (int k = 0; k < 2; ++k) dst[n][k] = *(const PG8_LAS bf16x8*)(lds + PG8_SB(b, h) + boff + n * 2048 + k * 1024); } } while (0)
typedef int pg8_v8i __attribute__((ext_vector_type(8))); typedef int pg8_v4i __attribute__((ext_vector_type(4)));
#define PG8_CAT(x0, x1) __builtin_shufflevector(__builtin_bit_cast(pg8_v4i, x0), __builtin_bit_cast(pg8_v4i, x1), 0, 1, 2, 3, 4, 5, 6, 7)
#define PG8_MMA(ai, bj, At, Bt) do { __builtin_amdgcn_s_setprio(1); if constexpr (FP8) { _Pragma("unroll") for (int m = 0; m < 4; ++m) _Pragma("unroll") for (int n = 0; n < 2; ++n) \
        asm volatile("v_mfma_scale_f32_16x16x128_f8f6f4 %0, %1, %2, %0, %3, %3 op_sel_hi:[0,0,0]" : "+v"(acc[ai][bj][m][n]) : "v"(Bt##8[n]), "v"(At##8[m]), "v"(pg8_scale1)); } \
        else { _Pragma("unroll") for (int m = 0; m < 4; ++m) _Pragma("unroll") for (int n = 0; n < 2; ++n) _Pragma("unroll") for (int k = 0; k < 2; ++k) \
        acc[ai][bj][m][n] = __builtin_amdgcn_mfma_f32_16x16x32_bf16(Bt[n][k], At[m][k], acc[ai][bj][m][n], 0, 0, 0); } __builtin_amdgcn_s_setprio(0); } while (0)
#define PG8_WAIT_V(n) asm volatile("s_waitcnt vmcnt(" #n ")" ::: "memory")
#define PG8_WAIT_L(n) asm volatile("s_waitcnt lgkmcnt(" #n ")" ::: "memory")
#define PG8_BAR __builtin_amdgcn_s_barrier()
#define PG8_SCHED __builtin_amdgcn_sched_barrier(0)
    Unit cur, nxt; int ui = 0;
    if (!S.next(0, cur)) return;
    f32x4 acc[2][2][4][2];
#pragma unroll
    for (int a = 0; a < 2; ++a)
#pragma unroll
        for (int b = 0; b < 2; ++b)
#pragma unroll
            for (int m = 0; m < 4; ++m)
#pragma unroll
                for (int n = 0; n < 2; ++n) acc[a][b][m][n] = (f32x4){0.f, 0.f, 0.f, 0.f};
    int pg8_scale1 = 0x7F7F7F7F; asm volatile("" : "+v"(pg8_scale1));
    bf16x8 At[4][2], B0[2][2], B1[2][2]; pg8_v8i At8[4], B08[2], B18[2];
    const char* cA = GATHER ? (const char*)g.A : (const char*)g.A + (size_t)cur.pm * tstep; const char* cB = (const char*)g.Bt + (size_t)cur.pn * tstep;
    if constexpr (GATHER) { PG8_GOFF(gc, cur.pm); }
    S.a_ready(cur);
    if constexpr (SP2) {
        PG8_STAGE(PG8_SB(0, 0), cB, voffB); PG8_STAGE(PG8_SB(0, 1), cB + hstep, voffB); PG8_STAGE_A(PG8_SA(0, 0), cA, 0, false); PG8_STAGE_A(PG8_SA(0, 1), cA, 1, false);
        if (wr == 1) PG8_BAR;
        PG8_WAIT_V(2); PG8_BAR;
        PG8_STAGE(PG8_SB(1, 0), cB + kstep, voffB); PG8_STAGE_A(PG8_SA(1, 0), cA + kstep, 0, false); PG8_STAGE(PG8_SB(1, 1), cB + hstep + kstep, voffB);
        PG8_WAIT_V(6); PG8_BAR;
    } else {
        PG8_STAGE(PG8_SB(0, 0), cB, voffB); PG8_STAGE_A(PG8_SA(0, 0), cA, 0, false); PG8_STAGE(PG8_SB(0, 1), cB + hstep, voffB); PG8_STAGE_A(PG8_SA(0, 1), cA, 1, false);
        if (wr == 1) PG8_BAR;
        PG8_WAIT_V(4); PG8_BAR;
        PG8_STAGE(PG8_SB(1, 0), cB + kstep, voffB); PG8_STAGE_A(PG8_SA(1, 0), cA + kstep, 0, false); PG8_STAGE(PG8_SB(1, 1), cB + hstep + kstep, voffB);
        PG8_WAIT_V(6); PG8_BAR;
    }
    for (;;) {
        const bool has_next = S.next(ui + 1, nxt);
        const char* nA = GATHER ? (const char*)g.A : (has_next ? (const char*)g.A + (size_t)nxt.pm * tstep : cA);
        if constexpr (GATHER) { if (has_next) { PG8_GOFF(gn, nxt.pm); } else { _Pragma("unroll") for (int _h = 0; _h < 2; ++_h) _Pragma("unroll") for (int _i = 0; _i < 2; ++_i) gn[_h][_i] = gc[_h][_i]; } } const char* nB = has_next ? (const char*)g.Bt + (size_t)nxt.pn * tstep : cB;
#pragma nounroll
        for (int t = 0; t < nt; t += 2) {
            const bool last = (t == nt - 2);
            const char* a1 = cA + (size_t)(t + 1) * kstep;
            const char* a2 = last ? nA : cA + (size_t)(t + 2) * kstep; const char* b2 = last ? nB : cB + (size_t)(t + 2) * kstep;
            const char* a3 = a2 + kstep; const char* b3 = b2 + kstep;
            if (last && has_next) S.a_ready(nxt);
            if constexpr (SP2) {
            PG8_LDB(B0, 0, 0); PG8_LDB(B1, 0, 1); PG8_SCHED; PG8_LDA(At, 0, 0); PG8_STAGE_A(PG8_SA(1, 1), a1, 1, false);
            PG8_WAIT_V(8); PG8_WAIT_L(0); PG8_BAR; PG8_MMA(0, 0, At, B0); PG8_MMA(0, 1, At, B1); PG8_BAR; PG8_SCHED;
            PG8_LDA(At, 0, 1); PG8_STAGE(PG8_SB(0, 0), b2, voffB); PG8_STAGE(PG8_SB(0, 1), b2 + hstep, voffB); PG8_STAGE_A(PG8_SA(0, 0), a2, 0, last);
            PG8_WAIT_V(8); PG8_WAIT_L(0); PG8_BAR; PG8_MMA(1, 0, At, B0); PG8_MMA(1, 1, At, B1); PG8_BAR; PG8_SCHED;
            PG8_LDB(B0, 1, 0); PG8_LDB(B1, 1, 1); PG8_SCHED; PG8_LDA(At, 1, 0); PG8_STAGE_A(PG8_SA(0, 1), a2, 1, last);
            PG8_WAIT_V(8); PG8_WAIT_L(0); PG8_BAR; PG8_MMA(0, 0, At, B0); PG8_MMA(0, 1, At, B1); PG8_BAR; PG8_SCHED;
            PG8_LDA(At, 1, 1); PG8_STAGE(PG8_SB(1, 0), b3, voffB); PG8_STAGE(PG8_SB(1, 1), b3 + hstep, voffB); PG8_STAGE_A(PG8_SA(1, 0), a3, 0, last);
            PG8_WAIT_V(8); PG8_WAIT_L(0); PG8_BAR; PG8_MMA(1, 0, At, B0); PG8_MMA(1, 1, At, B1); PG8_BAR; PG8_SCHED;
            } else {
            PG8_LDB(B0, 0, 0); PG8_SCHED; PG8_LDA(At, 0, 0); PG8_STAGE_A(PG8_SA(1, 1), a1, 1, false);
            PG8_WAIT_L(8); PG8_BAR; PG8_WAIT_L(0); PG8_MMA(0, 0, At, B0); PG8_BAR; PG8_SCHED;
            PG8_LDB(B1, 0, 1); PG8_STAGE(PG8_SB(0, 0), b2, voffB);
            PG8_BAR; PG8_WAIT_L(0); PG8_MMA(0, 1, At, B1); PG8_BAR;
            PG8_LDA(At, 0, 1); PG8_STAGE_A(PG8_SA(0, 0), a2, 0, last);
            PG8_BAR; PG8_WAIT_L(0); PG8_MMA(1, 0, At, B0); PG8_BAR; PG8_SCHED;
            PG8_STAGE(PG8_SB(0, 1), b2 + hstep, voffB);
            PG8_WAIT_V(6); PG8_BAR; PG8_MMA(1, 1, At, B1); PG8_BAR;
            PG8_LDB(B0, 1, 0); PG8_SCHED; PG8_LDA(At, 1, 0); PG8_STAGE_A(PG8_SA(0, 1), a2, 1, last);
            PG8_WAIT_L(8); PG8_BAR; PG8_WAIT_L(0); PG8_MMA(0, 0, At, B0); PG8_BAR; PG8_SCHED;
            PG8_LDB(B1, 1, 1); PG8_STAGE(PG8_SB(1, 0), b3, voffB);
            PG8_BAR; PG8_WAIT_L(0); PG8_MMA(0, 1, At, B1); PG8_BAR;
            PG8_LDA(At, 1, 1); PG8_STAGE_A(PG8_SA(1, 0), a3, 0, last);
            PG8_BAR; PG8_WAIT_L(0); PG8_MMA(1, 0, At, B0); PG8_BAR; PG8_SCHED;
            PG8_STAGE(PG8_SB(1, 1), b3 + hstep, voffB);
            PG8_WAIT_V(6); PG8_BAR; PG8_MMA(1, 1, At, B1); PG8_BAR;
            }
        }
        if constexpr (FP8) asm volatile("s_nop 15\n\ts_nop 15" ::: "memory");
        if constexpr (ALIGN_EPI) { if (wr == 0) PG8_BAR; }
        if constexpr (!Epi::AFTER_DRAIN) { E(acc, cur, wr, wc, fr, fq); S.done(cur); }
        if (!has_next) break;
#pragma unroll
        for (int a = 0; a < 2; ++a)
#pragma unroll
            for (int b = 0; b < 2; ++b)
#pragma unroll
                for (int m = 0; m < 4; ++m)
#pragma unroll
                    for (int n = 0; n < 2; ++n) acc[a][b][m][n] = (f32x4){0.f, 0.f, 0.f, 0.f};
        cur = nxt; cA = nA; cB = nB; ++ui;
        if constexpr (GATHER) { _Pragma("unroll") for (int _h = 0; _h < 2; ++_h) _Pragma("unroll") for (int _i = 0; _i < 2; ++_i) gc[_h][_i] = gn[_h][_i]; }
        if constexpr (ALIGN_EPI) { if (wr == 1) PG8_BAR; }
    }
    PG8_WAIT_V(0);
    if constexpr (!ALIGN_EPI) { if (wr == 0) PG8_BAR; }
    PG8_BAR;
    if constexpr (Epi::AFTER_DRAIN) { E.fused(acc, cur, wr, wc, fr, fq, lds, wid, lane); S.done(cur); }
#undef PG8_SA
#undef PG8_SB
#undef PG8_STAGE
#undef PG8_STAGE_A
#undef PG8_GOFF
#undef PG8_LDA
#undef PG8_LDB
#undef PG8_MMA
#undef PG8_CAT
#undef PG8_WAIT_V
#undef PG8_WAIT_L
#undef PG8_BAR
#undef PG8_SCHED
}
}
#define XB_TMO      128
#define XB_XCNT(j)  (256  + 64 * (j))
#define XB_XSUB(j)  (1280 + 64 * (j))
#define XB_XGEN(j)  (2304 + 64 * (j))
#define XB_TOP      3328
#define XB_TOPGEN   3392
#define XCD_BAR_WORDS 3456
#define XB_SPIN_CAP (1u << 18)

__device__ __forceinline__ unsigned xb_ld(unsigned* p)              { return __hip_atomic_load(p, __ATOMIC_RELAXED, __HIP_MEMORY_SCOPE_AGENT); }
__device__ __forceinline__ unsigned xb_add(unsigned* p, unsigned v) { return __hip_atomic_fetch_add(p, v, __ATOMIC_RELAXED, __HIP_MEMORY_SCOPE_AGENT); }
__device__ __forceinline__ unsigned xb_xcc_id() { return (unsigned)__builtin_amdgcn_s_getreg((3 << 11) | 20) & 0xFu; }
#define XB_SPIN(cond, bar) do { unsigned _sp = 0; while (cond) { __builtin_amdgcn_s_sleep(1); \
    if ((++_sp & 255u) == 0u) { if (xb_ld(&(bar)[XB_TMO])) break; if (_sp > XB_SPIN_CAP) { atomicAdd(&(bar)[XB_TMO], 1u); break; } } } } while (0)

struct XcdBarrier {
    unsigned* bar; unsigned x;
    volatile LAS unsigned* st;
};

__device__ __forceinline__ XcdBarrier xcd_barrier_post(unsigned* bar, volatile LAS unsigned* st) {
    XcdBarrier b; b.bar = bar; b.x = xb_xcc_id(); b.st = st;
    if (threadIdx.x == 0) (void)xb_add(&bar[XB_XCNT(b.x)], 1u);
    return b;
}
__device__ __forceinline__ void xcd_barrier_complete(unsigned* bar, unsigned x, unsigned& nloc, unsigned& nx) {
    const unsigned G = gridDim.x * gridDim.y * gridDim.z;
    unsigned sum, cnt, mine, sp = 0u;
    for (;;) {
        sum = 0u; cnt = 0u; mine = 0u;
#pragma unroll
        for (unsigned j = 0; j < 16; ++j) { const unsigned c = xb_ld(&bar[XB_XCNT(j)]); sum += c; cnt += (c > 0u) ? 1u : 0u; mine = (j == x) ? c : mine; }
        if (sum == G) break;
        __builtin_amdgcn_s_sleep(1);
        if ((++sp & 255u) == 0u) { if (xb_ld(&bar[XB_TMO])) break; if (sp > XB_SPIN_CAP) { atomicAdd(&bar[XB_TMO], 1u); break; } }
    }
    nloc = mine > 0u ? mine : 1u; nx = cnt > 0u ? cnt : 1u;
}

__device__ __forceinline__ void xcd_barrier(const XcdBarrier& b) {
    asm volatile("s_waitcnt vmcnt(0)" ::: "memory");
    __syncthreads();
    if (threadIdx.x == 0) {
        unsigned* bar = b.bar;
        __builtin_amdgcn_s_waitcnt(0);
        unsigned nloc = b.st[0], nx = b.st[1];
        if (nloc == 0u) { xcd_barrier_complete(bar, b.x, nloc, nx); b.st[0] = nloc; b.st[1] = nx; }
        const unsigned old = xb_add(&bar[XB_XSUB(b.x)], 1u);
        const unsigned gen = old / nloc;
        if (old + 1u == (gen + 1u) * nloc) {
            __builtin_amdgcn_fence(__ATOMIC_RELEASE, "agent");
            asm volatile("s_waitcnt vmcnt(0)" ::: "memory");
            const unsigned og = xb_add(&bar[XB_TOP], 1u);
            const unsigned tg = og / nx;
            if (og + 1u == (tg + 1u) * nx) xb_add(&bar[XB_TOPGEN], 1u);
            else XB_SPIN(xb_ld(&bar[XB_TOPGEN]) == tg, bar);
            __builtin_amdgcn_fence(__ATOMIC_ACQUIRE, "agent");
            xb_add(&bar[XB_XGEN(b.x)], 1u);
            asm volatile("s_waitcnt vmcnt(0)" ::: "memory");
        } else {
            XB_SPIN(xb_ld(&bar[XB_XGEN(b.x)]) == gen, bar);
            __builtin_amdgcn_fence(__ATOMIC_ACQUIRE, "agent");
            asm volatile("s_waitcnt vmcnt(0)" ::: "memory");
        }
    }
    __syncthreads();
}

enum InIdx { I_X = 0, I_MEM, I_RELB, I_ATTN_G, I_FFN_G, I_MEM_G, I_W_MKV, I_QN_MEM, I_KN_MEM, I_W_OUT, I_W_INA, I_QN_A, I_KN_A, I_KV_G, I_W_KVB, I_KN_B, I_W_INB, I_QN_B,
             I_LAMBDA, I_SUBLN, I_W_RG, I_B_RG, I_W_RE, I_B_RE, I_W_GATE, I_W_UP, I_W_DOWN, N_IN };
struct Args { const float* in[N_IN]; float* out; unsigned char* ws; int ph_lo, ph_hi; };
static_assert(sizeof(Args) == N_IN * 8 + 8 + 8 + 8, "Args has no padding");

using pg8::cvt_pk_bf16;
struct EpiRowScale {
    static constexpr bool PERM = true, AFTER_DRAIN = false;
    bf16* O; int ldc; const float* rs; int ntn; float cs;
    __device__ __forceinline__ void operator()(const f32x4 (&acc)[2][2][4][2], const pg8::Unit& u, int wr, int wc, int fr, int fq) const {
        const int colt = ntn ? (u.pn % ntn) : u.pn;
        const int row0 = u.pm * 256 + wr * 64 + fr, col0 = colt * 256 + wc * 32 + 8 * fq;
#pragma unroll
        for (int ai = 0; ai < 2; ++ai)
#pragma unroll
            for (int m = 0; m < 4; ++m) { const int row = row0 + ai * 128 + m * 16; const float s = (rs ? rs[row] : 1.f) * cs; bf16* rowp = O + (size_t)row * ldc + col0;
#pragma unroll
                for (int bj = 0; bj < 2; ++bj) { const f32x4 v0 = acc[ai][bj][m][0] * s, v1 = acc[ai][bj][m][1] * s;
                    v4u w; w.x = cvt_pk_bf16(v0[0], v0[1]); w.y = cvt_pk_bf16(v0[2], v0[3]); w.z = cvt_pk_bf16(v1[0], v1[1]); w.w = cvt_pk_bf16(v1[2], v1[3]);
                    *(v4u*)(rowp + bj * 128) = w; } }
    }
};
template <bool RES_F32, int PV = 0>
struct EpiOutProj {
    static constexpr bool PERM = true, AFTER_DRAIN = false;
    const float* resid; float* part; bf16* HB; unsigned char* HB8; float cs;
    __device__ __forceinline__ void operator()(const f32x4 (&acc)[2][2][4][2], const pg8::Unit& u, int wr, int wc, int fr, int fq) const {
        const int row0 = u.pm * 256 + wr * 64 + fr, col0 = u.pn * 256 + wc * 32 + 8 * fq;
#pragma unroll
        for (int ai = 0; ai < 2; ++ai)
#pragma unroll
            for (int mp = 0; mp < 2; ++mp) {
                f32x4 rf[2][2][2]; v4u rb[2][2];
#pragma unroll
                for (int mm = 0; mm < 2; ++mm) { const size_t off = (size_t)(row0 + ai * 128 + (2 * mp + mm) * 16) * DM + col0;
#pragma unroll
                    for (int bj = 0; bj < 2; ++bj) {
                        if (PV & 1) { rf[mm][bj][0] = (f32x4){0.f, 0.f, 0.f, 0.f}; rf[mm][bj][1] = rf[mm][bj][0]; rb[mm][bj] = (v4u){0u, 0u, 0u, 0u}; }
                        else if (RES_F32) { rf[mm][bj][0] = *(const f32x4*)(resid + off + bj * 128); rf[mm][bj][1] = *(const f32x4*)(resid + off + bj * 128 + 4); }
                        else rb[mm][bj] = *(const v4u*)(HB + off + bj * 128); } }
#pragma unroll
                for (int mm = 0; mm < 2; ++mm) { const int m = 2 * mp + mm; const int row = row0 + ai * 128 + m * 16; const size_t off = (size_t)row * DM + col0; float ss = 0.f;
#pragma unroll
                    for (int bj = 0; bj < 2; ++bj) { f32x4 r0, r1;
                        if (RES_F32) { r0 = rf[mm][bj][0]; r1 = rf[mm][bj][1]; }
                        else { const v4u q = rb[mm][bj]; r0 = (f32x4){bflo(q.x), bfhi(q.x), bflo(q.y), bfhi(q.y)}; r1 = (f32x4){bflo(q.z), bfhi(q.z), bflo(q.w), bfhi(q.w)}; }
                        const f32x4 v0 = r0 + acc[ai][bj][m][0] * cs, v1 = r1 + acc[ai][bj][m][1] * cs;
                        ss += ((v0[0] * v0[0] + v0[1] * v0[1]) + (v0[2] * v0[2] + v0[3] * v0[3])) + ((v1[0] * v1[0] + v1[1] * v1[1]) + (v1[2] * v1[2] + v1[3] * v1[3]));
                        v4u hb; hb.x = cvt_pk_bf16(v0[0], v0[1]); hb.y = cvt_pk_bf16(v0[2], v0[3]); hb.z = cvt_pk_bf16(v1[0], v1[1]); hb.w = cvt_pk_bf16(v1[2], v1[3]);
                        if (!(PV & 2) || hb.x == 0x12345u) *(v4u*)(HB + off + bj * 128) = hb;
                        unsigned w0 = 0u, w1 = 0u; w0 = __builtin_amdgcn_cvt_pk_fp8_f32(v0[0], v0[1], w0, false); w0 = __builtin_amdgcn_cvt_pk_fp8_f32(v0[2], v0[3], w0, true);
                        w1 = __builtin_amdgcn_cvt_pk_fp8_f32(v1[0], v1[1], w1, false); w1 = __builtin_amdgcn_cvt_pk_fp8_f32(v1[2], v1[3], w1, true);
                        if (!(PV & 4) || w0 == 0x12345u) *(v2u*)(HB8 + off + bj * 128) = (v2u){w0, w1}; }
                    ss += swz_xor<16>(ss); ss = add_xor32(ss);
                    if (fq == 0) part[(size_t)row * 32 + u.pn * 4 + wc] = ss; } }
    }
};
struct EpiSiluMul {
    static constexpr bool PERM = true, AFTER_DRAIN = false;
    bf16* O; const float* rstd; const int* rowtok;
    __device__ __forceinline__ void operator()(const f32x4 (&acc)[2][2][4][2], const pg8::Unit& u, int wr, int wc, int fr, int fq) const {
        const int row0 = u.pm * 256 + wr * 64 + fr, col0 = (u.pn & 3) * 128 + wc * 32 + 8 * fq;
        int tk[2][4]; float rsv[2][4];
#pragma unroll
        for (int ai = 0; ai < 2; ++ai)
#pragma unroll
            for (int m = 0; m < 4; ++m) tk[ai][m] = rowtok[row0 + ai * 128 + m * 16];
#pragma unroll
        for (int ai = 0; ai < 2; ++ai)
#pragma unroll
            for (int m = 0; m < 4; ++m) rsv[ai][m] = rstd[tk[ai][m]] * (1.f / SC_W1);
#pragma unroll
        for (int ai = 0; ai < 2; ++ai)
#pragma unroll
            for (int m = 0; m < 4; ++m) { const int row = row0 + ai * 128 + m * 16; float h[8]; const float rs = rsv[ai][m];
#pragma unroll
                for (int n = 0; n < 2; ++n)
#pragma unroll
                    for (int e = 0; e < 4; ++e) { const float g = acc[ai][0][m][n][e] * rs, up = acc[ai][1][m][n][e] * (rs * SC_HID);
                        h[n * 4 + e] = g * up * __builtin_amdgcn_rcpf(1.f + __builtin_amdgcn_exp2f(-g * LOG2E)); }
                unsigned w0 = 0u, w1 = 0u; w0 = __builtin_amdgcn_cvt_pk_fp8_f32(h[0], h[1], w0, false); w0 = __builtin_amdgcn_cvt_pk_fp8_f32(h[2], h[3], w0, true);
                w1 = __builtin_amdgcn_cvt_pk_fp8_f32(h[4], h[5], w1, false); w1 = __builtin_amdgcn_cvt_pk_fp8_f32(h[6], h[7], w1, true);
                *(v2u*)((unsigned char*)O + (size_t)row * EFF + col0) = (v2u){w0, w1}; }
    }
};
struct MoeOrder {
    const int* blk_e; int nunits, ntn, G, c;
    __device__ __forceinline__ bool next(int i, pg8::Unit& u) const {
        const int L = i * G + c; if (L >= nunits) return false;
        const int rb = L / ntn; u.pm = rb; u.pn = blk_e[rb] * ntn + (L - rb * ntn); return true;
    }
    __device__ __forceinline__ void a_ready(const pg8::Unit&) const {}
    __device__ __forceinline__ void done(const pg8::Unit&) const {}
};

struct TrDesc { const float* src; int N; bf16* dst; int dstK; const float* gain; float f8; };
__device__ __forceinline__ TrDesc tr_decode(const Args& a, int r) {
    unsigned char* ws = opaque_ws(a.ws); TrDesc d; d.f8 = 0.f;
    constexpr int R0 = 2560, R1 = 1024, R2 = 1536, R3 = 2048, R4 = 1024, R5 = 32768, R6 = 32768;
    if (r < R0) { const int kb = r / 160, nb = r % 160; d.src = a.in[I_W_INA] + (size_t)(128 * kb) * 5120 + 32 * nb; d.N = 5120; d.dst = (bf16*)(ws + WS_W_INA + (size_t)(32 * nb) * DM + 128 * kb); d.dstK = DM; d.gain = a.in[I_ATTN_G] + 128 * kb; d.f8 = SC_W1; return d; } r -= R0;
    if (r < R1) { const int kb = r / 64, nb = r % 64; d.src = a.in[I_W_INB] + (size_t)(128 * kb) * 2048 + 32 * nb; d.N = 2048; d.dst = (bf16*)(ws + WS_W_INB + (size_t)(32 * nb) * DM + 128 * kb); d.dstK = DM; d.gain = a.in[I_ATTN_G] + DM + 128 * kb; d.f8 = SC_W1; return d; } r -= R1;
    if (r < R2) { const int kb = r / 96, nb = r % 96; d.src = a.in[I_W_KVB] + (size_t)(128 * kb) * 3072 + 32 * nb; d.N = 3072; d.dst = (bf16*)(ws + WS_W_INB + (size_t)(2048 + 32 * nb) * DM + 128 * kb); d.dstK = DM; d.gain = a.in[I_KV_G] + 128 * kb; d.f8 = SC_W1; return d; } r -= R2;
    if (r < R3) { const int l = r / 1024, rr = r % 1024, kb = rr / 64, nb = rr % 64; d.src = a.in[I_W_OUT] + (size_t)l * DM * DM + (size_t)(128 * kb) * 2048 + 32 * nb; d.N = 2048;
        d.dst = (bf16*)(ws + WS_W_OUT + (size_t)l * DM * DM + (size_t)(32 * nb) * DM + 128 * kb); d.f8 = SC_W1;
        d.dstK = DM; d.gain = nullptr; return d; } r -= R3;
    if (r < R4) { const int l = r / 512, rr = r % 512, kb = rr / 32, nb = rr % 32; d.src = a.in[I_W_MKV] + (size_t)l * DM * 1024 + (size_t)(128 * kb) * 1024 + 32 * nb; d.N = 1024;
        d.dst = (bf16*)(ws + WS_W_MKV) + (size_t)l * 1024 * DM + (size_t)(32 * nb) * DM + 128 * kb; d.dstK = DM; d.gain = a.in[I_MEM_G] + l * DM + 128 * kb; return d; } r -= R4;
    if (r < R5 + R6) { const int up = r >= R5 ? 1 : 0; if (up) r -= R5;
        const int le = r / 256, rr = r % 256, kb = rr / 16, nb = rr % 16, n0 = 32 * nb, drow = (n0 >> 7) * 256 + (n0 & 127) + up * 128;
        d.src = (up ? a.in[I_W_UP] : a.in[I_W_GATE]) + (size_t)le * DM * EFF + (size_t)(128 * kb) * EFF + n0; d.N = EFF;
        d.dst = (bf16*)(ws + WS_W_E1 + ((size_t)le * 1024 + drow) * DM + 128 * kb); d.dstK = DM; d.gain = a.in[I_FFN_G] + (le >> 6) * DM + 128 * kb; d.f8 = SC_W1; return d; } r -= R5 + R6;
    { const int le = r / 256, rr = r % 256, kb = rr / 64, nb = rr % 64; d.src = a.in[I_W_DOWN] + (size_t)le * EFF * DM + (size_t)(128 * kb) * DM + 32 * nb; d.N = DM;
        d.dst = (bf16*)(ws + WS_W_E2 + ((size_t)le * DM + 32 * nb) * EFF + 128 * kb); d.dstK = EFF; d.gain = nullptr; d.f8 = SC_W2; return d; }
}
__device__ __forceinline__ float row_to_fp8(const float* xrow, unsigned char* orow, int lane) {
    const GAS f32x4* xr = (const GAS f32x4*)xrow + lane;
    f32x4 v[8]; float s = 0.f;
#pragma unroll
    for (int j = 0; j < 8; ++j) { v[j] = xr[64 * j]; s += (v[j].x * v[j].x + v[j].y * v[j].y) + (v[j].z * v[j].z + v[j].w * v[j].w); }
    const float rstd = 1.0f / sqrtf(wave_sum(s) * (1.f / DM) + RMS_EPS);
    GAS unsigned* o4 = (GAS unsigned*)orow + lane;
#pragma unroll
    for (int j = 0; j < 8; ++j) { unsigned w = 0u; w = __builtin_amdgcn_cvt_pk_fp8_f32(v[j].x, v[j].y, w, false); w = __builtin_amdgcn_cvt_pk_fp8_f32(v[j].z, v[j].w, w, true); o4[64 * j] = w; }
    return rstd;
}
__device__ __forceinline__ float row_to_bf16(const float* xrow, bf16* orow, bool normalise, int lane) {
    const GAS f32x4* xr = (const GAS f32x4*)xrow + lane;
    f32x4 v[8]; float s = 0.f;
#pragma unroll
    for (int j = 0; j < 8; ++j) { v[j] = xr[64 * j]; s += (v[j].x * v[j].x + v[j].y * v[j].y) + (v[j].z * v[j].z + v[j].w * v[j].w); }
    const float rstd = 1.0f / sqrtf(wave_sum(s) * (1.f / DM) + RMS_EPS);
    const float f = normalise ? rstd : 1.f;
    GAS unsigned long long* o8 = (GAS unsigned long long*)orow + lane;
#pragma unroll
    for (int j = 0; j < 8; ++j) o8[64 * j] = (unsigned long long)pk2(v[j].x * f, v[j].y * f) | ((unsigned long long)pk2(v[j].z * f, v[j].w * f) << 32);
    return rstd;
}
#define TR_IDX(i) (layer < 0 ? (i) : 8192 + ((i) / 16384) * 32768 + layer * 16384 + ((i) % 16384))
__device__ __forceinline__ void tr_loop(const Args& a, LAS float* scr, int lane, int it, int end, int stride, int layer) {
    const int first0 = it < end ? it : 0;
    {
        float v[64];
        const int lr = lane >> 5, lc = lane & 31;
        TrDesc cur = tr_decode(a, TR_IDX(it < end ? it : first0));
        if (it < end) {
#pragma unroll
            for (int i = 0; i < 64; ++i) v[i] = __builtin_nontemporal_load(cur.src + (size_t)(2 * i + lr) * cur.N + lc);
        }
        for (; it < end; it += stride) {
#pragma unroll
            for (int i = 0; i < 64; ++i) scr[(2 * i + lr) * 33 + lc] = v[i];
            LDS_WAIT(); asm volatile("" ::: "memory");
            const int nx = it + stride; const bool has_next = nx < end;
            const TrDesc nd = tr_decode(a, TR_IDX(has_next ? nx : it));
            if (has_next) {
#pragma unroll
                for (int i = 0; i < 64; ++i) v[i] = __builtin_nontemporal_load(nd.src + (size_t)(2 * i + lr) * nd.N + lc);
            }
            if (cur.f8 != 0.f) {
                const int c = lane & 7, nq = lane >> 3; const float f = cur.f8;
                f32x4 g[4];
#pragma unroll
                for (int q = 0; q < 4; ++q) g[q] = cur.gain ? *(const f32x4*)(cur.gain + 16 * c + 4 * q) * f : (f32x4){f, f, f, f};
#pragma unroll
                for (int j = 0; j < 4; ++j) { const int n = nq + 8 * j; const LAS float* sp = scr + (16 * c) * 33 + n; v4u o;
#pragma unroll
                    for (int q = 0; q < 4; ++q) { unsigned w = 0u;
                        w = __builtin_amdgcn_cvt_pk_fp8_f32(sp[(4 * q + 0) * 33] * g[q][0], sp[(4 * q + 1) * 33] * g[q][1], w, false);
                        w = __builtin_amdgcn_cvt_pk_fp8_f32(sp[(4 * q + 2) * 33] * g[q][2], sp[(4 * q + 3) * 33] * g[q][3], w, true); o[q] = w; }
                    *(GAS v4u*)((unsigned char*)cur.dst + (size_t)n * cur.dstK + 16 * c) = o; }
            } else {
                const int c = lane & 15, nq = lane >> 4;
                f32x4 g0 = (f32x4){1.f, 1.f, 1.f, 1.f}, g1 = g0;
                if (cur.gain) { g0 = *(const f32x4*)(cur.gain + 8 * c); g1 = *(const f32x4*)(cur.gain + 8 * c + 4); }
#pragma unroll
                for (int j = 0; j < 8; ++j) { const int n = nq + 4 * j; const LAS float* sp = scr + (8 * c) * 33 + n;
                    v4u o; o.x = pk2(sp[0 * 33] * g0[0], sp[1 * 33] * g0[1]); o.y = pk2(sp[2 * 33] * g0[2], sp[3 * 33] * g0[3]); o.z = pk2(sp[4 * 33] * g1[0], sp[5 * 33] * g1[1]); o.w = pk2(sp[6 * 33] * g1[2], sp[7 * 33] * g1[3]);
                    *(GAS v4u*)(cur.dst + (size_t)n * cur.dstK + 8 * c) = o; }
            }
            LDS_WAIT(); asm volatile("" ::: "memory");
            cur = nd;
        }
    }
}
#undef TR_IDX
constexpr int EXP_ITEMS = 49152, CONV_CH = 48, CONV_NCH = EXP_ITEMS / CONV_CH;
__device__ __forceinline__ void conv_chunk(const Args& a, LAS unsigned char* lds, int layer, int c) {
    const int tid = opaque_tid(), lane = tid & 63, wave = __builtin_amdgcn_readfirstlane(tid >> 6);
    tr_loop(a, (LAS float*)(lds + RING_OFF + wave * 16896), lane, c * CONV_CH + wave, (c + 1) * CONV_CH, 8, layer);
    __syncthreads();
}
struct Mix { bool conv; int idx; };
__device__ __forceinline__ Mix mix_decode(int u, int NA, int NC) {
    const long U = NA + NC; const int cb = (int)(((long)u * NC) / U), cb1 = (int)(((long)(u + 1) * NC) / U);
    Mix m; m.conv = cb1 != cb; m.idx = m.conv ? cb : u - cb; return m;
}
__device__ __forceinline__ void phase_prep(const Args& a, LAS unsigned char* lds, int G, int vb) {
    const int tid = opaque_tid(), lane = tid & 63, wave = __builtin_amdgcn_readfirstlane(tid >> 6);
    unsigned char* ws = opaque_ws(a.ws);
    LAS float* scr = (LAS float*)(lds + RING_OFF + wave * 16896);
    const int gw = vb * 8 + wave, NGW = G * 8;
    tr_loop(a, scr, lane, gw, 8192, NGW, -1);
    for (int idx = vb * 512 + tid; idx < 2 * NRTP * DM; idx += G * 512) {
        const int l = idx / (NRTP * DM), j = (idx / DM) % NRTP, k = idx % DM;
        float v = 0.f;
        if (j < 8) v = a.in[I_W_RG][((size_t)l * DM + k) * 8 + j]; else if (j < NRT) v = a.in[I_W_RE][((size_t)l * DM + k) * 64 + (j - 8)];
        v *= a.in[I_FFN_G][l * DM + k];
        const unsigned hi = f2bf(v); const float lo = v - bf2f((unsigned short)hi);
        bf16* wr = (bf16*)(ws + WS_W_RT) + (size_t)l * 2 * NRTP * DM;
        wr[(size_t)j * DM + k] = (bf16)hi; wr[(size_t)(NRTP + j) * DM + k] = (bf16)f2bf(lo);
    }
    for (int idx = vb * 512 + tid; idx < 2 * 5 * HD; idx += G * 512) { const int l = idx / (5 * HD), w = (idx / HD) % 5, i = idx % HD; float v;
        if (l == 0) v = (w < 2) ? a.in[I_QN_A][i] : (w == 2) ? a.in[I_QN_MEM][i] : a.in[I_KN_A][i];
        else v = (w == 0) ? a.in[I_QN_B][i] : (w == 1) ? a.in[I_QN_B][HD + i] : (w == 2) ? a.in[I_QN_MEM][HD + i] : (w == 3) ? a.in[I_KN_B][i] : a.in[I_KN_B][HD + i];
        ((float*)(ws + WS_SMALL + SM_GAINTAB))[idx] = v; }
    float* rstd = (float*)(ws + WS_SMALL + SM_RSTD);
    for (int m = gw; m < T; m += NGW) { const float rs = row_to_fp8(a.in[I_X] + (size_t)m * DM, ws + WS_HB8 + (size_t)m * DM, lane); if (lane == 0) rstd[m] = rs; }
    for (int m = gw; m < NB * NMEM; m += NGW) (void)row_to_bf16(a.in[I_MEM] + (size_t)m * DM, (bf16*)(ws + WS_SMALL + SM_MEMN) + (size_t)m * DM, true, lane);
}

struct PostDesc { const bf16* src; int sp; bf16* dst; int dp; const float* gain; float scale; float* kmean; };
__device__ __forceinline__ void post_unit(const PostDesc& d, LAS unsigned char* lds) {
    const int tid = opaque_tid(), lane = tid & 63, wave = __builtin_amdgcn_readfirstlane(tid >> 6), c = lane & 15, rg = lane >> 4;
    float g8[8]; float cs[8];
#pragma unroll
    for (int i = 0; i < 8; ++i) { g8[i] = d.gain ? d.gain[8 * c + i] * d.scale : 1.f; cs[i] = 0.f; }
    v4u wv[8];
#pragma unroll
    for (int it = 0; it < 8; ++it) wv[it] = *(const v4u*)(d.src + (size_t)(wave * 32 + it * 4 + rg) * d.sp + 8 * c);
#pragma unroll
    for (int it = 0; it < 8; ++it) {
        const int row = wave * 32 + it * 4 + rg;
        const v4u w = wv[it];
        float f[8] = {bflo(w.x), bfhi(w.x), bflo(w.y), bfhi(w.y), bflo(w.z), bfhi(w.z), bflo(w.w), bfhi(w.w)};
        if (d.gain) {
            float ss = 0.f;
#pragma unroll
            for (int i = 0; i < 8; ++i) ss += f[i] * f[i];
            ss += swz_xor<1>(ss); ss += swz_xor<2>(ss); ss += swz_xor<4>(ss); ss += swz_xor<8>(ss);
            const float rstd = 1.0f / sqrtf(ss * (1.f / HD) + RMS_EPS);
#pragma unroll
            for (int i = 0; i < 8; ++i) { f[i] = f[i] * rstd * g8[i]; cs[i] += f[i]; }
        }
        v4u o; o.x = pk2(f[0], f[1]); o.y = pk2(f[2], f[3]); o.z = pk2(f[4], f[5]); o.w = pk2(f[6], f[7]);
        *(v4u*)(d.dst + (size_t)row * d.dp + 8 * c) = o;
    }
    if (d.kmean) {
        LAS float* ks = (LAS float*)(lds + RING_OFF);
#pragma unroll
        for (int i = 0; i < 8; ++i) { cs[i] += swz_xor<16>(cs[i]); cs[i] = add_xor32(cs[i]); }
        if (lane < 16) {
#pragma unroll
            for (int i = 0; i < 8; ++i) ks[wave * 128 + 8 * c + i] = cs[i]; }
        __syncthreads();
        if (tid < 128) { float s = 0.f;
#pragma unroll
            for (int w = 0; w < 8; ++w) s += ks[w * 128 + tid];
            d.kmean[tid] = s * (1.f / 256.f); }
        __syncthreads();
    }
}
__device__ __forceinline__ void phase_post_mem(const Args& a, LAS unsigned char* lds, int G, int vb) {
    unsigned char* ws = opaque_ws(a.ws);
    for (int v = vb; v < 32; v += G) {
        PostDesc d; d.kmean = nullptr; d.scale = 1.f; d.gain = nullptr;
        const int l = v >> 4, b = (v >> 3) & 1, s8 = v & 7;
        const bf16* srow = (const bf16*)(ws + WS_SMALL + SM_KVM) + ((size_t)b * 256) * 2048 + l * 1024; d.sp = 2048; d.dp = HD;
        if (s8 < 4) { d.src = srow + s8 * 128; d.dst = (bf16*)(ws + WS_SMALL + SM_KM) + ((size_t)((l * 2 + b) * 4 + s8) * NMEM) * HD; d.gain = a.in[I_KN_MEM] + l * HD; }
        else { d.src = srow + 512 + (s8 - 4) * 128; d.dst = (bf16*)(ws + WS_SMALL + SM_VM) + ((size_t)((l * 2 + b) * 4 + (s8 - 4)) * NMEM) * HD; }
        post_unit(d, lds);
    }
}
struct SlotDesc { bf16* dst; int dp; const float* gain; float scale; float* kmean; };
__device__ __forceinline__ SlotDesc slot_desc(unsigned char* ws, int layer, int sl, int pm) {
    const float* gt = (const float*)(ws + WS_SMALL + SM_GAINTAB) + layer * 5 * HD;
    bf16* QH = (bf16*)(ws + WS_QH); bf16* KH = (bf16*)(ws + WS_KH); bf16* VH = (bf16*)(ws + WS_VH);
    const int t0 = pm * 256, b = pm >> 5, s0 = (pm & 31) * 256;
    SlotDesc d; d.kmean = nullptr; d.scale = 1.f; d.gain = nullptr;
    if (layer == 0) {
        if (sl < 12) { d.dst = QH + (size_t)t0 * DM + sl * 128; d.dp = DM; d.gain = gt; d.scale = QSCALE; }
        else if (sl < 24) { const int h = sl - 12; d.dst = KH + ((size_t)(b * 12 + h) * SEQ + s0) * HD; d.dp = HD; d.gain = gt + 3 * HD;
            d.kmean = (float*)(ws + WS_SMALL + SM_KMEAN) + ((size_t)(b * 12 + h) * 32 + (pm & 31)) * HD; }
        else if (sl < 36) { const int h = sl - 24; d.dst = VH + ((size_t)(b * 12 + h) * SEQ + s0) * HD; d.dp = HD; }
        else { const int h = sl - 36; d.dst = QH + (size_t)t0 * DM + (12 + h) * 128; d.dp = DM; d.gain = gt + 2 * HD; d.scale = QSCALE; }
    } else {
        if (sl < 6) { d.dst = QH + (size_t)t0 * DM + sl * 128; d.dp = DM; d.gain = gt; d.scale = QSCALE; }
        else if (sl < 12) { d.dst = QH + (size_t)t0 * DM + sl * 128; d.dp = DM; d.gain = gt + HD; d.scale = QSCALE; }
        else if (sl < 16) { d.dst = QH + (size_t)t0 * DM + sl * 128; d.dp = DM; d.gain = gt + 2 * HD; d.scale = QSCALE; }
        else if (sl < 22) { const int h = sl - 16; d.dst = KH + ((size_t)(b * 12 + h) * SEQ + s0) * HD; d.dp = HD; d.gain = gt + 3 * HD; }
        else if (sl < 28) { const int h = sl - 22; d.dst = KH + ((size_t)(b * 12 + 6 + h) * SEQ + s0) * HD; d.dp = HD; d.gain = gt + 4 * HD; }
        else { const int vh = sl - 28, h = vh >> 1, cc = vh & 1; d.dst = VH + ((size_t)(b * 6 + h) * SEQ + s0) * DV + cc * 128; d.dp = DV; }
    }
    return d;
}
template <int PV>
struct EpiHeadNormT {
    static constexpr bool PERM = true, AFTER_DRAIN = false;
    unsigned char* ws; int layer; float cs;
    __device__ __forceinline__ void operator()(const f32x4 (&acc)[2][2][4][2], const pg8::Unit& u, int wr, int wc, int fr_in, int fq_in) const {
        int fr = fr_in, fq = fq_in; asm volatile("" : "+v"(fr), "+v"(fq));
        LAS float* P = (LAS float*)(uintptr_t)LDSX_OFF;
        LAS float* KS = (LAS float*)(uintptr_t)(LDSX_OFF + 8192);
        const float* rs = (const float*)(ws + WS_SMALL + SM_RSTD);
        const SlotDesc d0 = slot_desc(ws, layer, 2 * u.pn, u.pm), d1 = slot_desc(ws, layer, 2 * u.pn + 1, u.pm);
        const int rowl = wr * 64 + fr, coll = wc * 32 + 8 * fq;
        const float* rsr = rs + u.pm * 256 + rowl;
        float rt[2][4];
#pragma unroll
        for (int ai = 0; ai < 2; ++ai)
#pragma unroll
            for (int m = 0; m < 4; ++m) rt[ai][m] = rsr[ai * 128 + m * 16] * cs;
        f32x4 gg[2][2];
#pragma unroll
        for (int bj = 0; bj < 2; ++bj) { const SlotDesc& d = bj == 0 ? d0 : d1; gg[bj][0] = (f32x4){1.f, 1.f, 1.f, 1.f}; gg[bj][1] = gg[bj][0];
            if (d.gain) { gg[bj][0] = *(const f32x4*)(d.gain + coll) * d.scale; gg[bj][1] = *(const f32x4*)(d.gain + coll + 4) * d.scale; } }
#pragma unroll
        for (int ai = 0; ai < 2; ++ai)
#pragma unroll
            for (int m = 0; m < 4; ++m) { const int row = rowl + ai * 128 + m * 16; const float rtv = rt[ai][m];
#pragma unroll
                for (int bj = 0; bj < 2; ++bj) { if ((bj == 0 ? d0.gain : d1.gain) != nullptr) {
                    const f32x4 v0 = acc[ai][bj][m][0] * rtv, v1 = acc[ai][bj][m][1] * rtv;
                    float ss = (v0[0] * v0[0] + v0[1] * v0[1]) + (v0[2] * v0[2] + v0[3] * v0[3]) + (v1[0] * v1[0] + v1[1] * v1[1]) + (v1[2] * v1[2] + v1[3] * v1[3]);
                    ss += swz_xor<16>(ss); ss = add_xor32(ss);
                    if (fq == 0 && !(PV & 2)) P[(row * 2 + bj) * 4 + wc] = ss; } } }
        if (!(PV & 2)) { asm volatile("s_waitcnt lgkmcnt(0)" ::: "memory"); __builtin_amdgcn_s_barrier(); asm volatile("" ::: "memory"); }
#pragma unroll
        for (int bj = 0; bj < 2; ++bj) { const SlotDesc& d = bj == 0 ? d0 : d1;
            const f32x4 g0 = gg[bj][0], g1 = gg[bj][1];
            f32x4 c0 = (f32x4){0.f, 0.f, 0.f, 0.f}, c1 = c0;
#pragma unroll
            for (int ai = 0; ai < 2; ++ai)
#pragma unroll
                for (int m = 0; m < 4; ++m) { const int row = rowl + ai * 128 + m * 16; float f = rt[ai][m];
                    if (d.gain) { const f32x4 p4 = *(const LAS f32x4*)(P + (row * 2 + bj) * 4); f *= 1.0f / sqrtf(((p4[0] + p4[1]) + (p4[2] + p4[3])) * (1.f / HD) + RMS_EPS); }
                    const f32x4 v0 = acc[ai][bj][m][0] * f * g0, v1 = acc[ai][bj][m][1] * f * g1;
                    if (d.kmean) { c0 += v0; c1 += v1; }
                    v4u w; w.x = cvt_pk_bf16(v0[0], v0[1]); w.y = cvt_pk_bf16(v0[2], v0[3]); w.z = cvt_pk_bf16(v1[0], v1[1]); w.w = cvt_pk_bf16(v1[2], v1[3]);
                    if (!(PV & 1) || w.x == 0x12345u) *(v4u*)(d.dst + (size_t)row * d.dp + coll) = w; }
            if (d.kmean && !(PV & 4)) {
#pragma unroll
                for (int i = 0; i < 4; ++i) { float v = c0[i]; v += swz_xor<1>(v); v += swz_xor<2>(v); v += swz_xor<4>(v); v += swz_xor<8>(v); if (fr == 0) KS[wr * 256 + bj * 128 + coll + i] = v;
                                              float w_ = c1[i]; w_ += swz_xor<1>(w_); w_ += swz_xor<2>(w_); w_ += swz_xor<4>(w_); w_ += swz_xor<8>(w_); if (fr == 0) KS[wr * 256 + bj * 128 + coll + 4 + i] = w_; } } }
        if (d0.kmean && !(PV & 4)) {
            asm volatile("s_waitcnt lgkmcnt(0)" ::: "memory"); __builtin_amdgcn_s_barrier(); asm volatile("" ::: "memory");
            const int t = (wr * 4 + wc) * 64 + fq * 16 + fr;
            if (t < 256) { const float mean = (KS[t] + KS[256 + t]) * (1.f / 256.f); float* km = (t < 128) ? d0.kmean : d1.kmean; km[t & 127] = mean; }
        }
    }
};
using EpiHeadNorm = EpiHeadNormT<0>;
__device__ __forceinline__ void phase_gate(const Args& a, LAS unsigned char* lds, int G, int vb) {
    unsigned char* ws = opaque_ws(a.ws);
    const bf16* QH = (const bf16*)(ws + WS_QH); const float* KMEAN = (const float*)(ws + WS_SMALL + SM_KMEAN); unsigned* SEL = (unsigned*)(ws + WS_SMALL + SM_SEL);
    gu32* MC = (gu32*)(ws + WS_CTL) + CW_MC; unsigned* LISTF = (unsigned*)(ws + WS_LISTF); unsigned* LISTA = (unsigned*)(ws + WS_LISTA);
    const int tid_g = opaque_tid();
    LAS float* kml = (LAS float*)(lds + RING_OFF);
    for (int idx = vb * 512 + tid_g; idx < NB * MOBA_H * SEQ; idx += G * 512) {
        const int bh = idx / SEQ, s = idx % SEQ, b = bh / MOBA_H, h = bh % MOBA_H, own = s >> 8;
        __syncthreads();
        { const f32x4* src = (const f32x4*)(KMEAN + (size_t)bh * 32 * HD); ((LAS f32x4*)kml)[tid_g] = src[tid_g]; ((LAS f32x4*)kml)[512 + tid_g] = src[512 + tid_g]; }
        __syncthreads();
        unsigned mask = 0u;
        if (own <= 3) { mask = (1u << own) - 1u; }
        else {
            float acc[31];
#pragma unroll
            for (int j = 0; j < 31; ++j) acc[j] = 0.f;
            const bf16* q = QH + ((size_t)b * SEQ + s) * DM + h * HD;
            for (int c = 0; c < 16; ++c) {
                const v4u w = *(const v4u*)(q + 8 * c);
                const float f0 = bflo(w.x), f1 = bfhi(w.x), f2 = bflo(w.y), f3 = bfhi(w.y), f4 = bflo(w.z), f5 = bfhi(w.z), f6 = bflo(w.w), f7 = bfhi(w.w);
#pragma unroll
                for (int j = 0; j < 31; ++j) if (j < own) {
                    const f32x4 k0 = *(const LAS f32x4*)(kml + j * HD + 8 * c), k1 = *(const LAS f32x4*)(kml + j * HD + 8 * c + 4);
                    acc[j] += (f0 * k0[0] + f1 * k0[1]) + (f2 * k0[2] + f3 * k0[3]) + (f4 * k1[0] + f5 * k1[1]) + (f6 * k1[2] + f7 * k1[3]); }
            }
#pragma unroll
            for (int rnd = 0; rnd < 3; ++rnd) { float best = -__builtin_inff(); int bi = 0;
#pragma unroll
                for (int j = 0; j < 31; ++j) if (j < own && !((mask >> j) & 1u) && acc[j] > best) { best = acc[j]; bi = j; }
                mask |= 1u << bi; }
        }
        SEL[idx] = mask;
        { const int lane_ = tid_g & 63; const unsigned long long lt = (1ull << lane_) - 1ull;
          for (int j = 0; j < own; ++j) {
              const bool selj = (mask >> j) & 1u; const unsigned long long bal = __ballot(selj);
              if (bal == 0ull) continue;
              const int far = (j == own - 1) ? 0 : 1; const int lead = __builtin_ctzll(bal);
              unsigned base = 0u; if (lane_ == lead) base = __hip_atomic_fetch_add(MC + (bh * 32 + j) * 2 + far, (unsigned)__builtin_popcountll(bal), RLX_AGENT);
              base = __shfl(base, lead);
              if (selj) { const unsigned pos = base + (unsigned)__builtin_popcountll(bal & lt); const int slot = __builtin_popcount(mask & ((1u << j) - 1u));
                  const unsigned ent = (unsigned)s | ((unsigned)slot << 16);
                  if (far) LISTF[((size_t)bh * 32 + j) * 8192 + pos] = ent; else LISTA[((size_t)bh * 32 + j) * 256 + pos] = ent; } } }
    }
}

namespace att {
constexpr int SHM_T = 16384;
#define KSWZ(row, colB) ((row) * 256 + ((colB) ^ (((row) & 7) << 4)))
#define SBAR() __builtin_amdgcn_sched_barrier(0)
__device__ __forceinline__ int v_rd_base(int lane) { return ((lane & 3) << 3) | (((lane >> 2) & 3) << 6) | (((lane >> 4) & 1) << 5) | (((lane >> 5) & 1) << 8); }
__device__ __forceinline__ int crow(int r, int hi) { return (r & 3) + 8 * (r >> 2) + 4 * hi; }
__device__ __forceinline__ unsigned cvtpk(float lo, float hi) { unsigned r; asm volatile("v_cvt_pk_bf16_f32 %0, %1, %2" : "=v"(r) : "v"(lo), "v"(hi)); return r; }
__device__ __forceinline__ int swap23(int k) { return (k & ~0xC) | ((k & 4) << 1) | ((k & 8) >> 1); }
__device__ __forceinline__ void glds16(const void* sbase  , unsigned voff, unsigned lds_dst) { unsigned keep;
    asm volatile("s_mov_b32 %0, m0\n\ts_mov_b32 m0, %3\n\ts_nop 0\n\tglobal_load_lds_dwordx4 %1, %2\n\ts_mov_b32 m0, %0" : "=&s"(keep) : "v"(voff), "s"(sbase), "s"(lds_dst) : "memory"); }
#define WAIT_BAR0() asm volatile("s_waitcnt vmcnt(0) lgkmcnt(0)\n\ts_barrier" ::: "memory")
constexpr float THR2 = 11.5f;

__device__ __forceinline__ void qkt(f32x16& p0, f32x16& p1, const LAS char* Kt, int r32, int hi, const bf16x8* qr) {
#pragma unroll
    for (int r = 0; r < 16; ++r) { p0[r] = 0.f; p1[r] = 0.f; }
    const LAS char* kb0 = Kt + KSWZ(r32, (0 * 16 + hi * 8) * 2);
    const LAS char* kb1 = Kt + KSWZ(r32, (1 * 16 + hi * 8) * 2);
    const LAS char* kb2 = Kt + KSWZ(r32, (2 * 16 + hi * 8) * 2);
    const LAS char* kb3 = Kt + KSWZ(r32, (3 * 16 + hi * 8) * 2);
#pragma unroll
    for (int d0 = 0; d0 < 8; ++d0) { const LAS char* a = ((d0 & 3) == 0 ? kb0 : (d0 & 3) == 1 ? kb1 : (d0 & 3) == 2 ? kb2 : kb3) + (d0 >> 2) * 128;
        const bf16x8 b0 = *(const LAS bf16x8*)a;
        const bf16x8 b1 = *(const LAS bf16x8*)(a + 32 * 256);
        p0 = __builtin_amdgcn_mfma_f32_32x32x16_bf16(b0, qr[d0], p0, 0, 0, 0);
        p1 = __builtin_amdgcn_mfma_f32_32x32x16_bf16(b1, qr[d0], p1, 0, 0, 0); }
}
__device__ __forceinline__ void pv_tile(f32x16* o, int vb, bf16x8 pa0, bf16x8 pa1, bf16x8 pa2, bf16x8 pa3) {
#define TRRD(dst, off) asm volatile("ds_read_b64_tr_b16 %0, %1 offset:%2" : "=&v"(dst) : "v"(vb), "i"(off) : "memory")
#define PV_RD(S_, d0) do { constexpr int b_ = (d0) * 512; TRRD(S_##l0, b_); TRRD(S_##h0, b_ + 2048); TRRD(S_##l1, b_ + 4096); TRRD(S_##h1, b_ + 6144); \
        TRRD(S_##l2, b_ + 8192); TRRD(S_##h2, b_ + 10240); TRRD(S_##l3, b_ + 12288); TRRD(S_##h3, b_ + 14336); } while (0)
#define PV_MM(S_, d0) do { \
        o[d0] = __builtin_amdgcn_mfma_f32_32x32x16_bf16(pa0, (bf16x8){S_##l0[0], S_##l0[1], S_##l0[2], S_##l0[3], S_##h0[0], S_##h0[1], S_##h0[2], S_##h0[3]}, o[d0], 0, 0, 0); \
        o[d0] = __builtin_amdgcn_mfma_f32_32x32x16_bf16(pa1, (bf16x8){S_##l1[0], S_##l1[1], S_##l1[2], S_##l1[3], S_##h1[0], S_##h1[1], S_##h1[2], S_##h1[3]}, o[d0], 0, 0, 0); \
        o[d0] = __builtin_amdgcn_mfma_f32_32x32x16_bf16(pa2, (bf16x8){S_##l2[0], S_##l2[1], S_##l2[2], S_##l2[3], S_##h2[0], S_##h2[1], S_##h2[2], S_##h2[3]}, o[d0], 0, 0, 0); \
        o[d0] = __builtin_amdgcn_mfma_f32_32x32x16_bf16(pa3, (bf16x8){S_##l3[0], S_##l3[1], S_##l3[2], S_##l3[3], S_##h3[0], S_##h3[1], S_##h3[2], S_##h3[3]}, o[d0], 0, 0, 0); } while (0)
#define WL(n) asm volatile("s_waitcnt lgkmcnt(" #n ")" ::: "memory")
    s16x4 Al0, Al1, Al2, Al3, Ah0, Ah1, Ah2, Ah3, Bl0, Bl1, Bl2, Bl3, Bh0, Bh1, Bh2, Bh3;
    PV_RD(A, 0); SBAR();
    PV_RD(B, 1); WL(8); SBAR(); PV_MM(A, 0); SBAR();
    PV_RD(A, 2); WL(8); SBAR(); PV_MM(B, 1); SBAR();
    PV_RD(B, 3); WL(8); SBAR(); PV_MM(A, 2); SBAR();
    WL(0); SBAR(); PV_MM(B, 3);
#undef PV_RD
#undef PV_MM
#undef TRRD
}
__device__ __forceinline__ void softmax_tile(f32x16& p0, f32x16& p1, float& m_reg, float& l_reg, float& alpha, bf16x8& pa0, bf16x8& pa1, bf16x8& pa2, bf16x8& pa3) {
    float pmax = p0[0];
#pragma unroll
    for (int r = 1; r < 16; ++r) pmax = fmaxf(pmax, p0[r]);
#pragma unroll
    for (int r = 0; r < 16; ++r) pmax = fmaxf(pmax, p1[r]);
    { auto rr = __builtin_amdgcn_permlane32_swap(__float_as_uint(pmax), __float_as_uint(pmax), false, false);
      pmax = fmaxf(__uint_as_float(rr[0]), __uint_as_float(rr[1])); }
    const float mn = (pmax - m_reg <= THR2) ? m_reg : fmaxf(m_reg, pmax);
    alpha = __builtin_amdgcn_exp2f(m_reg - mn); m_reg = mn;
#pragma unroll
    for (int r = 0; r < 16; ++r) { p0[r] = __builtin_amdgcn_exp2f(p0[r] - mn); p1[r] = __builtin_amdgcn_exp2f(p1[r] - mn); }
    float ps = 0.f;
#pragma unroll
    for (int r = 0; r < 16; ++r) ps += p0[r] + p1[r];
    { auto rr = __builtin_amdgcn_permlane32_swap(__float_as_uint(ps), __float_as_uint(ps), false, false);
      ps = __uint_as_float(rr[0]) + __uint_as_float(rr[1]); }
    l_reg = l_reg * alpha + ps;
#define PK4(P, B_, OUT) do { unsigned a0 = cvtpk(P[B_+0], P[B_+1]), a1 = cvtpk(P[B_+2], P[B_+3]); \
        unsigned b0 = cvtpk(P[B_+4], P[B_+5]), b1 = cvtpk(P[B_+6], P[B_+7]); \
        auto r0 = __builtin_amdgcn_permlane32_swap(a0, b0, false, false); auto r1 = __builtin_amdgcn_permlane32_swap(a1, b1, false, false); \
        v4u w = {r0[0], r1[0], r0[1], r1[1]}; OUT = __builtin_bit_cast(bf16x8, w); } while (0)
    PK4(p0, 0, pa0); PK4(p0, 8, pa1); PK4(p1, 0, pa2); PK4(p1, 8, pa3);
#undef PK4
}
__device__ __forceinline__ void bias_mask_tile(f32x16& p0, f32x16& p1, int dq, bool on, bool far, const LAS float* lut) {
    const float NEG = -__builtin_inff();
    if (far) {
        const float c = on ? lut[128] : NEG;
#pragma unroll
        for (int r = 0; r < 16; ++r) { p0[r] += c; p1[r] += c; }
    } else {
#pragma unroll
        for (int r = 0; r < 16; ++r) { const int c = (r & 3) + 8 * (r >> 2); const int d0 = dq - c, d1 = dq - c - 32;
            const float b0 = lut[min(max(d0, 0), 128)], b1 = lut[min(max(d1, 0), 128)];
            p0[r] = (on && d0 >= 0) ? p0[r] + b0 : NEG; p1[r] = (on && d1 >= 0) ? p1[r] + b1 : NEG; }
    }
}

__device__ __forceinline__ void qkt_half(f32x16& p, const LAS char* Kt  , int r32, int hi, const bf16x8* qr) {
#pragma unroll
    for (int r = 0; r < 16; ++r) p[r] = 0.f;
    const LAS char* kb0 = Kt + KSWZ(r32, (0 * 16 + hi * 8) * 2);
    const LAS char* kb1 = Kt + KSWZ(r32, (1 * 16 + hi * 8) * 2);
    const LAS char* kb2 = Kt + KSWZ(r32, (2 * 16 + hi * 8) * 2);
    const LAS char* kb3 = Kt + KSWZ(r32, (3 * 16 + hi * 8) * 2);
#pragma unroll
    for (int d0 = 0; d0 < 8; ++d0) { const LAS char* a = ((d0 & 3) == 0 ? kb0 : (d0 & 3) == 1 ? kb1 : (d0 & 3) == 2 ? kb2 : kb3) + (d0 >> 2) * 128;
        const bf16x8 b0 = *(const LAS bf16x8*)a;
        p = __builtin_amdgcn_mfma_f32_32x32x16_bf16(b0, qr[d0], p, 0, 0, 0); }
}
template <int HALF>
__device__ __forceinline__ void pv_half8(f32x16* o, int vb, bf16x8 pa0, bf16x8 pa1) {
#define TRRD(dst, off) asm volatile("ds_read_b64_tr_b16 %0, %1 offset:%2" : "=&v"(dst) : "v"(vb), "i"(off) : "memory")
#define PV_RD(S_, d0) do { constexpr int b_ = ((d0) & 3) * 512 + ((d0) >> 2) * SHM_T + HALF * 8192; TRRD(S_##l0, b_); TRRD(S_##h0, b_ + 2048); TRRD(S_##l1, b_ + 4096); TRRD(S_##h1, b_ + 6144); } while (0)
#define PV_MM(S_, d0) do { \
        o[d0] = __builtin_amdgcn_mfma_f32_32x32x16_bf16(pa0, (bf16x8){S_##l0[0], S_##l0[1], S_##l0[2], S_##l0[3], S_##h0[0], S_##h0[1], S_##h0[2], S_##h0[3]}, o[d0], 0, 0, 0); \
        o[d0] = __builtin_amdgcn_mfma_f32_32x32x16_bf16(pa1, (bf16x8){S_##l1[0], S_##l1[1], S_##l1[2], S_##l1[3], S_##h1[0], S_##h1[1], S_##h1[2], S_##h1[3]}, o[d0], 0, 0, 0); } while (0)
#define WL(n) asm volatile("s_waitcnt lgkmcnt(" #n ")" ::: "memory")
    s16x4 Al0, Al1, Ah0, Ah1, Bl0, Bl1, Bh0, Bh1;
    PV_RD(A, 0); SBAR();
    PV_RD(B, 1); WL(4); SBAR(); PV_MM(A, 0); SBAR();
    PV_RD(A, 2); WL(4); SBAR(); PV_MM(B, 1); SBAR();
    PV_RD(B, 3); WL(4); SBAR(); PV_MM(A, 2); SBAR();
    PV_RD(A, 4); WL(4); SBAR(); PV_MM(B, 3); SBAR();
    PV_RD(B, 5); WL(4); SBAR(); PV_MM(A, 4); SBAR();
    PV_RD(A, 6); WL(4); SBAR(); PV_MM(B, 5); SBAR();
    PV_RD(B, 7); WL(4); SBAR(); PV_MM(A, 6); SBAR();
    WL(0); SBAR(); PV_MM(B, 7);
#undef PV_RD
#undef PV_MM
#undef WL
#undef TRRD
}
__device__ __forceinline__ void softmax_half(f32x16& p0, float& m_reg, float& l_reg, float& alpha, bf16x8& pa0, bf16x8& pa1) {
    float pmax = p0[0];
#pragma unroll
    for (int r = 1; r < 16; ++r) pmax = fmaxf(pmax, p0[r]);
    { auto rr = __builtin_amdgcn_permlane32_swap(__float_as_uint(pmax), __float_as_uint(pmax), false, false);
      pmax = fmaxf(__uint_as_float(rr[0]), __uint_as_float(rr[1])); }
    const float mn = (pmax - m_reg <= THR2) ? m_reg : fmaxf(m_reg, pmax);
    alpha = __builtin_amdgcn_exp2f(m_reg - mn); m_reg = mn;
#pragma unroll
    for (int r = 0; r < 16; ++r) p0[r] = __builtin_amdgcn_exp2f(p0[r] - mn);
    float ps = 0.f;
#pragma unroll
    for (int r = 0; r < 16; ++r) ps += p0[r];
    { auto rr = __builtin_amdgcn_permlane32_swap(__float_as_uint(ps), __float_as_uint(ps), false, false);
      ps = __uint_as_float(rr[0]) + __uint_as_float(rr[1]); }
    l_reg = l_reg * alpha + ps;
#define PK4(P, B_, OUT) do { unsigned a0 = cvtpk(P[B_+0], P[B_+1]), a1 = cvtpk(P[B_+2], P[B_+3]); \
        unsigned b0 = cvtpk(P[B_+4], P[B_+5]), b1 = cvtpk(P[B_+6], P[B_+7]); \
        auto r0 = __builtin_amdgcn_permlane32_swap(a0, b0, false, false); auto r1 = __builtin_amdgcn_permlane32_swap(a1, b1, false, false); \
        v4u w = {r0[0], r1[0], r0[1], r1[1]}; OUT = __builtin_bit_cast(bf16x8, w); } while (0)
    PK4(p0, 0, pa0); PK4(p0, 8, pa1);
#undef PK4
}
__device__ __forceinline__ void bias_mask_half(f32x16& p0, int dq, bool far, const LAS float* lut) {
    const float NEG = -__builtin_inff();
    if (far) { const float c = lut[128];
#pragma unroll
        for (int r = 0; r < 16; ++r) p0[r] += c;
    } else {
#pragma unroll
        for (int r = 0; r < 16; ++r) { const int c = (r & 3) + 8 * (r >> 2); const int d0 = dq - c;
            const float b0 = lut[min(max(d0, 0), 128)]; p0[r] = (d0 >= 0) ? p0[r] + b0 : NEG; }
    }
}
#define RESC(o_, nd_, al_l_, alpha_) do { if (__any((alpha_) < 1.f)) { if (hi == 0) (al_l_)[r32] = (alpha_); asm volatile("s_waitcnt lgkmcnt(0)" ::: "memory"); \
        _Pragma("unroll") for (int r = 0; r < 16; ++r) { const float f_ = (al_l_)[crow(r, hi)]; _Pragma("unroll") for (int d_ = 0; d_ < (nd_); ++d_) (o_)[d_][r] *= f_; } } } while (0)

template <int MODE, bool F8OUT = false>
__device__ __forceinline__ void attn128_unit(LAS unsigned char* lds, const bf16* Qrow0, const bf16* Kh, const bf16* Vh, bf16* Orow0, int NT, int qb, const unsigned* selrow, const float* relb, int h) {
    const int tid = opaque_tid(), wid = __builtin_amdgcn_readfirstlane(tid >> 6), lane = tid & 63, r32 = lane & 31, hi = lane >> 5;
    LAS float* wsf = (LAS float*)(lds + LDSX_OFF) + wid * 64; LAS float* li_l = wsf; LAS float* al_l = wsf + 32;
    LAS float* lut = (LAS float*)(lds + LDSX_OFF + 2048);
    if (MODE == 0 && tid <= 128) lut[tid] = relb[(tid < 128 ? (int)T5_BUCKET[tid] : 31) * 12 + h] * LOG2E;
    bf16x8 qr[8];
#pragma unroll
    for (int d0 = 0; d0 < 8; ++d0) qr[d0] = *(const bf16x8*)(Qrow0 + (size_t)(wid * 32 + r32) * DM + d0 * 16 + hi * 8);
    unsigned sel = 0u; if (MODE == 0) sel = selrow[wid * 32 + r32];
    const int krow = 4 * wid + (lane >> 4); const unsigned ksrc = (unsigned) krow * 256 + ((16 * (lane & 15)) ^ ((krow & 7) << 4));
    const int vkk = 8 * (wid >> 1) + ((lane & 31) >> 2); const unsigned vsrc = (unsigned) swap23(vkk) * 256 + (32 * (2 * (wid & 1) + (lane >> 5)) + 8 * (lane & 3)) * 2;
    const unsigned lds0 = (unsigned)(uintptr_t)(lds + RING_OFF);
    const char* Kg = (const char*)Kh; const char* Vg = (const char*)Vh;
#define ISSUE(t, s) do { const unsigned base_ = (unsigned)__builtin_amdgcn_readfirstlane(lds0 + (s) * 32768 + wid * 1024); const size_t tb_ = (size_t)(t) * SHM_T; \
        glds16(Kg + tb_, ksrc, base_); glds16(Kg + tb_ + 8192, ksrc, base_ + 8192); glds16(Vg + tb_, vsrc, base_ + SHM_T); glds16(Vg + tb_ + 8192, vsrc, base_ + SHM_T + 8192); } while (0)
    const int vb0 = (int)lds0 + SHM_T + v_rd_base(lane);
    float m_reg = -1e30f, l_reg = 0.f; f32x16 o[4];
#pragma unroll
    for (int d = 0; d < 4; ++d)
#pragma unroll
        for (int r = 0; r < 16; ++r) o[d][r] = 0.f;
    const int q0w = qb * 256 + wid * 32, qpos = q0w + r32;
    ISSUE(0, 0);
    for (int t = 0; t < NT; ++t) {
        WAIT_BAR0();
        if (t + 1 < NT) ISSUE(t + 1, (t + 1) & 1);
        const int s = t & 1;
        f32x16 p0, p1;
        qkt(p0, p1, (const LAS char*)(lds + RING_OFF + s * 32768), r32, hi, qr);
        if (MODE == 0) { const int jb = t >> 2, tk0 = t * 64; const bool on = (jb >= qb) || ((sel >> jb) & 1u); const bool far = (q0w - (tk0 + 63)) >= 128;
            bias_mask_tile(p0, p1, qpos - tk0 - 4 * hi, on, far, lut); }
        float alpha; bf16x8 pa0, pa1, pa2, pa3;
        softmax_tile(p0, p1, m_reg, l_reg, alpha, pa0, pa1, pa2, pa3);
        RESC(o, 4, al_l, alpha);
        pv_tile(o, vb0 + s * 32768, pa0, pa1, pa2, pa3);
    }
#undef ISSUE
    if (hi == 0) li_l[r32] = l_reg; asm volatile("s_waitcnt lgkmcnt(0)" ::: "memory");
    int r32o = r32, hio = hi; asm volatile("" : "+v"(r32o), "+v"(hio));
    bf16* Ow = Orow0 + (size_t)(wid * 32) * DM + r32o;
#pragma unroll
    for (int r = 0; r < 16; ++r) { const int orow = crow(r, hio); const float rli = __builtin_amdgcn_rcpf(li_l[orow]);
#pragma unroll
        for (int d0 = 0; d0 < 4; ++d0) { const float v = o[d0][r] * rli; const float vn = swz_xor<1>(v);
            if (F8OUT) { if ((r32 & 1) == 0) *(unsigned short*)((unsigned char*)Orow0 + (size_t)(wid * 32 + orow) * DM + d0 * 32 + r32o) = (unsigned short)__builtin_amdgcn_cvt_pk_fp8_f32(v * SC_O, vn * SC_O, 0u, false); }
            else if ((r32 & 1) == 0) *(unsigned*)(Ow + (size_t)orow * DM + d0 * 32) = cvtpk(v, vn); } }
    WAIT_BAR0();
}

#define PK4X(P, B_, OUT) do { unsigned a0 = cvtpk(P[B_+0], P[B_+1]), a1 = cvtpk(P[B_+2], P[B_+3]); unsigned b0 = cvtpk(P[B_+4], P[B_+5]), b1 = cvtpk(P[B_+6], P[B_+7]); \
        auto r0 = __builtin_amdgcn_permlane32_swap(a0, b0, false, false); auto r1 = __builtin_amdgcn_permlane32_swap(a1, b1, false, false); v4u w = {r0[0], r1[0], r0[1], r1[1]}; OUT = __builtin_bit_cast(bf16x8, w); } while (0)
template <int VAR>
__device__ __forceinline__ void diff_unit(LAS unsigned char* lds, const bf16* Qrow0  , const bf16* K1h, const bf16* K2h, const bf16* Vh, bf16* Orow0  ,
                                          int qblk, const float* relb, int h, float lam, const float* subln) {
    const int tid = opaque_tid(), wid = __builtin_amdgcn_readfirstlane(tid >> 6), lane = tid & 63, r32 = lane & 31, hi = lane >> 5, mp = wid >> 2, w4 = wid & 3;
    LAS float* wsf = (LAS float*)(lds + LDSX_OFF) + wid * 64; LAS float* li_l = wsf; LAS float* al_l = wsf + 32;
    LAS float* lut2 = (LAS float*)(lds + LDSX_OFF + 2048);
    if (tid < 2 * 132) { const int m_ = tid / 132, i_ = tid % 132; if (i_ <= 128) lut2[tid] = relb[(i_ < 128 ? (int)T5_BUCKET[i_] : 31) * 12 + 2 * h + m_] * LOG2E; }
    const LAS float* lut = lut2 + mp * 132;
    bf16x8 qr[8];
#pragma unroll
    for (int d0 = 0; d0 < 8; ++d0) qr[d0] = *(const bf16x8*)(Qrow0 + (size_t)(w4 * 32 + r32) * DM + (h + 6 * mp) * HD + d0 * 16 + hi * 8);
    const int krow = 4 * wid + (lane >> 4); const unsigned ksrc = (unsigned) krow * 256 + ((16 * (lane & 15)) ^ ((krow & 7) << 4));
    const int vkk = 8 * (wid >> 1) + ((lane & 31) >> 2); const unsigned vsrc = (unsigned) swap23(vkk) * 512 + (32 * (2 * (wid & 1) + (lane >> 5)) + 8 * (lane & 3)) * 2;
    const unsigned lds0 = (unsigned)(uintptr_t)(lds + RING_OFF);
    const char* K1g = (const char*)K1h; const char* K2g = (const char*)K2h; const char* Vg = (const char*)Vh;
#define ISSUE(t, s) do { const unsigned base_ = (unsigned)__builtin_amdgcn_readfirstlane(lds0 + (s) * 65536 + wid * 1024); const size_t tb_ = (size_t)(t) * SHM_T; \
        glds16(K1g + tb_, ksrc, base_); glds16(K1g + tb_ + 8192, ksrc, base_ + 8192); glds16(K2g + tb_, ksrc, base_ + SHM_T); glds16(K2g + tb_ + 8192, ksrc, base_ + SHM_T + 8192); \
        glds16(Vg + 2 * tb_, vsrc, base_ + 2 * SHM_T); glds16(Vg + 2 * tb_ + 16384, vsrc, base_ + 2 * SHM_T + 8192); \
        glds16(Vg + 2 * tb_ + 256, vsrc, base_ + 3 * SHM_T); glds16(Vg + 2 * tb_ + 256 + 16384, vsrc, base_ + 3 * SHM_T + 8192); } while (0)
#define ISSUE_K(t, s) do { const unsigned base_ = (unsigned)__builtin_amdgcn_readfirstlane(lds0 + (s) * 65536 + wid * 1024); const size_t tb_ = (size_t)(t) * SHM_T; \
        glds16(K1g + tb_, ksrc, base_); glds16(K1g + tb_ + 8192, ksrc, base_ + 8192); glds16(K2g + tb_, ksrc, base_ + SHM_T); glds16(K2g + tb_ + 8192, ksrc, base_ + SHM_T + 8192); } while (0)
#define ISSUE_V(t, s) do { const unsigned base_ = (unsigned)__builtin_amdgcn_readfirstlane(lds0 + (s) * 65536 + wid * 1024); const size_t tb_ = (size_t)(t) * SHM_T; \
        glds16(Vg + 2 * tb_, vsrc, base_ + 2 * SHM_T); glds16(Vg + 2 * tb_ + 16384, vsrc, base_ + 2 * SHM_T + 8192); \
        glds16(Vg + 2 * tb_ + 256, vsrc, base_ + 3 * SHM_T); glds16(Vg + 2 * tb_ + 256 + 16384, vsrc, base_ + 3 * SHM_T + 8192); } while (0)
    const int vb0 = (int)lds0 + 2 * SHM_T + v_rd_base(lane);
    float m_reg = -1e30f, l_reg = 0.f; f32x16 o[8];
#pragma unroll
    for (int d = 0; d < 8; ++d)
#pragma unroll
        for (int r = 0; r < 16; ++r) o[d][r] = 0.f;
    const int q0w = qblk * 128 + w4 * 32, qpos = q0w + r32, NT = 2 * (qblk + 1);
    if (!(VAR & 1)) ISSUE(0, 0);
    for (int t = 0; t < NT; ++t) {
        WAIT_BAR0();
        if (!(VAR & 1)) if (t + 1 < NT) ISSUE(t + 1, (t + 1) & 1);
        const int s = t & 1, tk0 = t * 64;
        if (VAR & 2) continue;
        const bool far = (q0w - (tk0 + 63)) >= 128;
        { f32x16 p; float alpha; bf16x8 pa0, pa1;
          qkt_half(p, (const LAS char*)(lds + RING_OFF + s * 65536 + mp * SHM_T), r32, hi, qr);
          bias_mask_half(p, qpos - tk0 - 4 * hi, far, lut);
          if (VAR & 4) { alpha = 1.f; l_reg += p[0]; PK4X(p, 0, pa0); PK4X(p, 8, pa1); } else { softmax_half(p, m_reg, l_reg, alpha, pa0, pa1);
          RESC(o, 8, al_l, alpha); }
          pv_half8<0>(o, vb0 + s * 65536, pa0, pa1); }
        SBAR();
        { f32x16 p; float alpha; bf16x8 pa0, pa1;
          qkt_half(p, (const LAS char*)(lds + RING_OFF + s * 65536 + mp * SHM_T + 32 * 256), r32, hi, qr);
          bias_mask_half(p, qpos - tk0 - 32 - 4 * hi, far, lut);
          if (VAR & 4) { alpha = 1.f; l_reg += p[0]; PK4X(p, 0, pa0); PK4X(p, 8, pa1); } else { softmax_half(p, m_reg, l_reg, alpha, pa0, pa1);
          RESC(o, 8, al_l, alpha); }
          pv_half8<1>(o, vb0 + s * 65536, pa0, pa1); }
        SBAR();
    }
#undef ISSUE
#undef ISSUE_K
#undef ISSUE_V
    if (hi == 0) li_l[r32] = l_reg;
    WAIT_BAR0();
    int laneo = lane; asm volatile("" : "+v"(laneo));
    LAS float* X = (LAS float*)(lds + RING_OFF) + (w4 * 8 * 16 * 64 + laneo);
    if (mp == 1) {
#pragma unroll
        for (int r = 0; r < 16; ++r) { const float f = lam * __builtin_amdgcn_rcpf(li_l[crow(r, hi)]);
#pragma unroll
            for (int d0 = 0; d0 < 8; ++d0) X[(d0 * 16 + r) * 64] = o[d0][r] * f; }
    }
    WAIT_BAR0();
    if (mp == 0) {
        int r32o = r32, hio = hi; asm volatile("" : "+v"(r32o), "+v"(hio));
        unsigned char* Ow = (unsigned char*)Orow0 + (size_t)(w4 * 32) * DM + r32o; const float* sg = subln + r32o;
#pragma unroll
        for (int r = 0; r < 16; ++r) { const float rli = __builtin_amdgcn_rcpf(li_l[crow(r, hi)]); float ss = 0.f;
#pragma unroll
            for (int d0 = 0; d0 < 8; ++d0) { const float v = o[d0][r] * rli - X[(d0 * 16 + r) * 64]; o[d0][r] = v; ss += v * v; }
            ss += swz_xor<1>(ss); ss += swz_xor<2>(ss); ss += swz_xor<4>(ss); ss += swz_xor<8>(ss); ss += swz_xor<16>(ss);
            const float rs = (1.0f / sqrtf(ss * (1.f / DV) + RMS_EPS)) * (1.f - LAM_INIT); const int orow = crow(r, hio);
#pragma unroll
            for (int d0 = 0; d0 < 8; ++d0) { const float v = o[d0][r] * rs * sg[d0 * 32]; const float vn = swz_xor<1>(v);
                if ((r32 & 1) == 0) *(unsigned short*)(Ow + (size_t)orow * DM + d0 * 32) = (unsigned short)__builtin_amdgcn_cvt_pk_fp8_f32(v * SC_O, vn * SC_O, 0u, false); } }
    }
    WAIT_BAR0();
}

__device__ __forceinline__ void moba_sparse_unit(LAS unsigned char* lds, const bf16* QHb, const bf16* Kblk, const bf16* Vblk, const unsigned* listF, int cntF, const unsigned* listA, int cntA, int j,
                                                 bf16* PO, float* PM, const float* relb, int h) {
    const int tid = opaque_tid(), wid = __builtin_amdgcn_readfirstlane(tid >> 6), lane = tid & 63, r32 = lane & 31, hi = lane >> 5;
    LAS float* wsf = (LAS float*)(lds + LDSX_OFF) + wid * 64; LAS float* li_l = wsf; LAS float* al_l = wsf + 32;
    LAS float* lut = (LAS float*)(lds + LDSX_OFF + 2048);
    if (tid <= 128) lut[tid] = relb[(tid < 128 ? (int)T5_BUCKET[tid] : 31) * 12 + h] * LOG2E;
    const int krow = 4 * wid + (lane >> 4); const unsigned ksrc = (unsigned) krow * 256 + ((16 * (lane & 15)) ^ ((krow & 7) << 4));
    const int vkk = 8 * (wid >> 1) + ((lane & 31) >> 2); const unsigned vsrc = (unsigned) swap23(vkk) * 256 + (32 * (2 * (wid & 1) + (lane >> 5)) + 8 * (lane & 3)) * 2;
    const unsigned lds0 = (unsigned)(uintptr_t)(lds + RING_OFF);
    const char* Kg = (const char*)Kblk; const char* Vg = (const char*)Vblk;
    { const unsigned base_ = (unsigned)__builtin_amdgcn_readfirstlane(lds0 + wid * 1024);
#pragma unroll
      for (int t = 0; t < 4; ++t) { glds16(Kg + t * SHM_T, ksrc, base_ + t * SHM_T); glds16(Kg + t * SHM_T + 8192, ksrc, base_ + t * SHM_T + 8192);
                                    glds16(Vg + t * SHM_T, vsrc, base_ + 65536 + t * SHM_T); glds16(Vg + t * SHM_T + 8192, vsrc, base_ + 65536 + t * SHM_T + 8192); } }
    const int vb0 = (int)lds0 + 65536 + v_rd_base(lane);
    const int gF = (cntF + 31) >> 5, ng = gF + ((cntA + 31) >> 5);
    const float c31 = relb[31 * 12 + h] * LOG2E;
#define GRP_ENT(g_, ent_, val_) do { const bool fr_ = (g_) < gF; const int b0_ = fr_ ? (g_) * 32 : ((g_) - gF) * 32; const int n_ = fr_ ? cntF : cntA; const unsigned* l_ = fr_ ? listF : listA; \
        val_ = (b0_ + r32) < n_; ent_ = l_[val_ ? b0_ + r32 : b0_]; } while (0)
#define LOADQ(dst_, ent_) do { const bf16* qp_ = QHb + (size_t)((ent_) & 0xffffu) * DM + hi * 8; _Pragma("unroll") for (int d0 = 0; d0 < 8; ++d0) dst_[d0] = *(const bf16x8*)(qp_ + d0 * 16); } while (0)
    int g = wid; unsigned ent = 0u, entn = 0u; bool valid = false, validn = false; bf16x8 qr[8], qn[8];
    if (g < ng) { GRP_ENT(g, ent, valid); LOADQ(qr, ent); }
    if (g + 8 < ng) GRP_ENT(g + 8, entn, validn);
    WAIT_BAR0();
    for (; g < ng; g += 8) {
        const bool adj = g >= gF;
        unsigned entnn = 0u; bool validnn = false;
        if (g + 8 < ng) LOADQ(qn, entn);
        if (g + 16 < ng) GRP_ENT(g + 16, entnn, validnn);
        const int srow = (int)(ent & 0xffffu), slot = (int)(ent >> 16);
        float m_reg = -1e30f, l_reg = 0.f; f32x16 o[4];
#pragma unroll
        for (int d = 0; d < 4; ++d)
#pragma unroll
            for (int r = 0; r < 16; ++r) o[d][r] = 0.f;
#pragma unroll 1
        for (int t = 0; t < 4; ++t) {
            f32x16 p0, p1;
            qkt(p0, p1, (const LAS char*)(lds + RING_OFF + t * SHM_T), r32, hi, qr);
            if (adj) bias_mask_tile(p0, p1, srow - (j * 256 + t * 64) - 4 * hi, true, false, lut);
            float alpha; bf16x8 pa0, pa1, pa2, pa3;
            softmax_tile(p0, p1, m_reg, l_reg, alpha, pa0, pa1, pa2, pa3);
            RESC(o, 4, al_l, alpha);
            pv_tile(o, vb0 + t * SHM_T, pa0, pa1, pa2, pa3);
        }
        LAS int* rd = (LAS int*)al_l;
        const int rec = srow * 3 + slot;
        if (hi == 0) { li_l[r32] = l_reg; rd[r32] = valid ? rec : -1;
            if (valid) { PM[(size_t)rec * 2] = m_reg + (adj ? 0.f : c31); PM[(size_t)rec * 2 + 1] = l_reg; } }
        asm volatile("s_waitcnt lgkmcnt(0)" ::: "memory");
        int r32o = r32, hio = hi; asm volatile("" : "+v"(r32o), "+v"(hio));
#pragma unroll
        for (int r = 0; r < 16; ++r) { const int orow = crow(r, hio); const float rli = __builtin_amdgcn_rcpf(li_l[orow]); const int dst = rd[orow];
#pragma unroll
            for (int d0 = 0; d0 < 4; ++d0) { const float v = o[d0][r] * rli; const float vn = swz_xor<1>(v);
                if ((r32 & 1) == 0 && dst >= 0) *(unsigned*)(PO + (size_t)dst * HD + d0 * 32 + r32o) = cvtpk(v, vn); } }
        asm volatile("s_waitcnt lgkmcnt(0)" ::: "memory");
#pragma unroll
        for (int d0 = 0; d0 < 8; ++d0) qr[d0] = qn[d0];
        ent = entn; valid = validn; entn = entnn; validn = validnn;
    }
#undef GRP_ENT
#undef LOADQ
    WAIT_BAR0();
}

__device__ __forceinline__ void moba_final_unit(LAS unsigned char* lds, const bf16* Qrow0, const bf16* Kh, const bf16* Vh, bf16* Orow0, int qb, const unsigned* selrow, const float* relb, int h, const bf16* PO, const float* PM) {
    const int tid = opaque_tid(), wid = __builtin_amdgcn_readfirstlane(tid >> 6), lane = tid & 63, r32 = lane & 31, hi = lane >> 5;
    LAS float* wsf = (LAS float*)(lds + LDSX_OFF) + wid * 64; LAS float* al_l = wsf + 32;
    LAS float* lut = (LAS float*)(lds + LDSX_OFF + 2048);
    LAS float* ftab = (LAS float*)(lds + LDSX_OFF + 4352) + wid * 128;
    if (tid <= 128) lut[tid] = relb[(tid < 128 ? (int)T5_BUCKET[tid] : 31) * 12 + h] * LOG2E;
    bf16x8 qr[8];
#pragma unroll
    for (int d0 = 0; d0 < 8; ++d0) qr[d0] = *(const bf16x8*)(Qrow0 + (size_t)(wid * 32 + r32) * DM + d0 * 16 + hi * 8);
    const unsigned sel = selrow[wid * 32 + r32];
    const int krow = 4 * wid + (lane >> 4); const unsigned ksrc = (unsigned) krow * 256 + ((16 * (lane & 15)) ^ ((krow & 7) << 4));
    const int vkk = 8 * (wid >> 1) + ((lane & 31) >> 2); const unsigned vsrc = (unsigned) swap23(vkk) * 256 + (32 * (2 * (wid & 1) + (lane >> 5)) + 8 * (lane & 3)) * 2;
    const unsigned lds0 = (unsigned)(uintptr_t)(lds + RING_OFF);
    const char* Kg = (const char*)(Kh + (size_t)qb * 256 * HD); const char* Vg = (const char*)(Vh + (size_t)qb * 256 * HD);
    { const unsigned base_ = (unsigned)__builtin_amdgcn_readfirstlane(lds0 + wid * 1024);
#pragma unroll
      for (int t = 0; t < 4; ++t) { glds16(Kg + t * SHM_T, ksrc, base_ + t * SHM_T); glds16(Kg + t * SHM_T + 8192, ksrc, base_ + t * SHM_T + 8192);
                                    glds16(Vg + t * SHM_T, vsrc, base_ + 65536 + t * SHM_T); glds16(Vg + t * SHM_T + 8192, vsrc, base_ + 65536 + t * SHM_T + 8192); } }
    const int vb0 = (int)lds0 + 65536 + v_rd_base(lane);
    float m_reg = -1e30f, l_reg = 0.f; f32x16 o[4];
#pragma unroll
    for (int d = 0; d < 4; ++d)
#pragma unroll
        for (int r = 0; r < 16; ++r) o[d][r] = 0.f;
    const int qrel = wid * 32 + r32;
    WAIT_BAR0();
#pragma unroll 1
    for (int t = 0; t <= (wid >> 1); ++t) {
        f32x16 p0, p1;
        qkt(p0, p1, (const LAS char*)(lds + RING_OFF + t * SHM_T), r32, hi, qr);
        bias_mask_tile(p0, p1, qrel - t * 64 - 4 * hi, true, false, lut);
        float alpha; bf16x8 pa0, pa1, pa2, pa3;
        softmax_tile(p0, p1, m_reg, l_reg, alpha, pa0, pa1, pa2, pa3);
        RESC(o, 4, al_l, alpha);
        pv_tile(o, vb0 + t * SHM_T, pa0, pa1, pa2, pa3);
    }
    const int nsel = __builtin_popcount(sel); const size_t rec0 = (size_t)(qb * 256 + qrel) * 3;
    float mi[3], li[3]; float M = m_reg;
#pragma unroll
    for (int i = 0; i < 3; ++i) { mi[i] = -1e30f; li[i] = 0.f; if (i < nsel) { mi[i] = PM[(rec0 + i) * 2]; li[i] = PM[(rec0 + i) * 2 + 1]; } M = fmaxf(M, mi[i]); }
    const float wo = __builtin_amdgcn_exp2f(m_reg - M); float L = l_reg * wo; float wi[3];
#pragma unroll
    for (int i = 0; i < 3; ++i) { wi[i] = (i < nsel) ? li[i] * __builtin_amdgcn_exp2f(mi[i] - M) : 0.f; L += wi[i]; }
    const float rL = 1.f / L;
    if (hi == 0) { ftab[r32] = wo * rL; ftab[32 + r32] = wi[0] * rL; ftab[64 + r32] = wi[1] * rL; ftab[96 + r32] = wi[2] * rL; }
    WAIT_BAR0();
    int r32o = r32, hio = hi, laneo = lane; asm volatile("" : "+v"(r32o), "+v"(hio), "+v"(laneo));
    LAS float* X = (LAS float*)(lds + RING_OFF) + wid * 4096;
#pragma unroll
    for (int r = 0; r < 16; ++r) { const int orow = crow(r, hio); const float fo = ftab[orow];
#pragma unroll
        for (int d0 = 0; d0 < 4; ++d0) X[orow * 128 + d0 * 32 + r32o] = o[d0][r] * fo; }
    asm volatile("s_waitcnt lgkmcnt(0)" ::: "memory");
    { const int rg = laneo >> 4, c = laneo & 15;
      unsigned char* Ow = (unsigned char*)Orow0 + (size_t)(wid * 32) * DM + 8 * c;
      const bf16* Pw = PO + ((size_t)(qb * 256 + wid * 32) * 3) * HD + 8 * c;
#pragma unroll 2
      for (int it = 0; it < 8; ++it) { const int row = it * 4 + rg;
          const f32x4 x0 = *(const LAS f32x4*)(X + row * 128 + 8 * c), x1 = *(const LAS f32x4*)(X + row * 128 + 8 * c + 4);
          float v[8] = {x0[0], x0[1], x0[2], x0[3], x1[0], x1[1], x1[2], x1[3]};
#pragma unroll
          for (int i = 0; i < 3; ++i) { const float f = ftab[32 * (i + 1) + row];
              if (f != 0.f) { const v4u w = *(const v4u*)(Pw + ((size_t)row * 3 + i) * HD);
                  v[0] += f * bflo(w.x); v[1] += f * bfhi(w.x); v[2] += f * bflo(w.y); v[3] += f * bfhi(w.y); v[4] += f * bflo(w.z); v[5] += f * bfhi(w.z); v[6] += f * bflo(w.w); v[7] += f * bfhi(w.w); } }
          unsigned w0 = 0u, w1 = 0u;
          w0 = __builtin_amdgcn_cvt_pk_fp8_f32(v[0] * SC_O, v[1] * SC_O, w0, false); w0 = __builtin_amdgcn_cvt_pk_fp8_f32(v[2] * SC_O, v[3] * SC_O, w0, true);
          w1 = __builtin_amdgcn_cvt_pk_fp8_f32(v[4] * SC_O, v[5] * SC_O, w1, false); w1 = __builtin_amdgcn_cvt_pk_fp8_f32(v[6] * SC_O, v[7] * SC_O, w1, true);
          *(v2u*)(Ow + (size_t)row * DM) = (v2u){w0, w1}; } }
    WAIT_BAR0();
}
#undef RESC
}

__device__ __forceinline__ int queue_next(gu32* ctr, LAS unsigned char* lds) {
    volatile LAS int* slot = (volatile LAS int*)(lds + LDSX_OFF + 4096);
    if (threadIdx.x == 0) slot[0] = (int)__hip_atomic_fetch_add(ctr, 1u, RLX_AGENT);
    __syncthreads();
    return __builtin_amdgcn_readfirstlane(slot[0]);
}

__device__ __forceinline__ void phase_moba_sparse(const Args& a, LAS unsigned char* lds, gu32* qctr) {
    unsigned char* ws = opaque_ws(a.ws);
    const bf16* QH = (const bf16*)(ws + WS_QH); const bf16* KH = (const bf16*)(ws + WS_KH); const bf16* VH = (const bf16*)(ws + WS_VH);
    const unsigned* MC = (const unsigned*)(ws + WS_CTL) + CW_MC;
    for (;;) {
        const int uq = queue_next(qctr, lds);
        if (uq >= 744 + CONV_NCH / 2) break;
        const Mix mx = mix_decode(uq, 744, CONV_NCH / 2);
        if (mx.conv) { conv_chunk(a, lds, 0, mx.idx); continue; }
        const int u = mx.idx;
        const int j = u / 24, bh = u % 24, b = bh / 12, h = bh % 12;
        const int cntA = (int)MC[(bh * 32 + j) * 2], cntF = (int)MC[(bh * 32 + j) * 2 + 1];
        const bf16* QHb = QH + (size_t)b * SEQ * DM + h * HD; const bf16* Kblk = KH + ((size_t)bh * SEQ + j * 256) * HD; const bf16* Vblk = VH + ((size_t)bh * SEQ + j * 256) * HD;
        bf16* PO = (bf16*)(ws + WS_PO) + (size_t)bh * SEQ * 3 * HD; float* PM = (float*)(ws + WS_PM) + (size_t)bh * SEQ * 3 * 2;
        att::moba_sparse_unit(lds, QHb, Kblk, Vblk, (const unsigned*)(ws + WS_LISTF) + ((size_t)bh * 32 + j) * 8192, cntF, (const unsigned*)(ws + WS_LISTA) + ((size_t)bh * 32 + j) * 256, cntA, j, PO, PM, a.in[I_RELB], h);
    }
}
__device__ __forceinline__ void phase_attn_a(const Args& a, LAS unsigned char* lds, gu32* qctr) {
    unsigned char* ws = opaque_ws(a.ws);
    const bf16* QH = (const bf16*)(ws + WS_QH); const bf16* KH = (const bf16*)(ws + WS_KH); const bf16* VH = (const bf16*)(ws + WS_VH); bf16* OC = (bf16*)(ws + WS_OCAT);
    const unsigned* SEL = (const unsigned*)(ws + WS_SMALL + SM_SEL);
    for (;;) {
        const int uq = queue_next(qctr, lds);
        if (uq >= 768 + 256 + CONV_NCH / 2) break;
        const Mix mx = mix_decode(uq, 768 + 256, CONV_NCH / 2);
        if (mx.conv) { conv_chunk(a, lds, 0, CONV_NCH / 2 + mx.idx); continue; }
        const int u = mx.idx;
        if (u < 768) { const int qb = 31 - u / 24, bh = u % 24, b = bh / 12, h = bh % 12; const size_t row0 = (size_t)b * SEQ + qb * 256;
            att::moba_final_unit(lds, QH + row0 * DM + h * HD, KH + (size_t)bh * SEQ * HD, VH + (size_t)bh * SEQ * HD, (bf16*)((unsigned char*)OC + row0 * DM + h * HD), qb,
                                 SEL + (size_t)bh * SEQ + qb * 256, a.in[I_RELB], h, (const bf16*)(ws + WS_PO) + (size_t)bh * SEQ * 3 * HD, (const float*)(ws + WS_PM) + (size_t)bh * SEQ * 3 * 2);
        } else { const int v = u - 768, b = v >> 7, hm = (v >> 5) & 3, qb = v & 31; const size_t row0 = (size_t)b * SEQ + qb * 256;
            const size_t mo = (size_t)((0 * 2 + b) * 4 + hm) * NMEM * HD;
            att::attn128_unit<1, true>(lds, QH + row0 * DM + (12 + hm) * HD, (const bf16*)(ws + WS_SMALL + SM_KM) + mo, (const bf16*)(ws + WS_SMALL + SM_VM) + mo, (bf16*)((unsigned char*)OC + row0 * DM + MIXW + hm * HD), 4, 0, nullptr, nullptr, 0);
        }
    }
}
template <int VAR>
__device__ __forceinline__ void phase_attn_b(const Args& a, LAS unsigned char* lds, gu32* qctr, bf16* OC) {
    unsigned char* ws = opaque_ws(a.ws);
    const bf16* QH = (const bf16*)(ws + WS_QH); const bf16* KH = (const bf16*)(ws + WS_KH); const bf16* VH = (const bf16*)(ws + WS_VH);
    float lam;
    { const float* lb = a.in[I_LAMBDA]; const int lane = opaque_tid() & 63;
      float s1 = lb[lane] * lb[128 + lane] + lb[64 + lane] * lb[128 + 64 + lane], s2 = lb[256 + lane] * lb[384 + lane] + lb[256 + 64 + lane] * lb[384 + 64 + lane];
      s1 = wave_sum(s1); s2 = wave_sum(s2); lam = expf(s1) - expf(s2) + LAM_INIT; }
    for (;;) {
        const int uq = queue_next(qctr, lds);
        if (uq >= 768 + 256 + CONV_NCH) break;
        const Mix mx = mix_decode(uq, 768 + 256, CONV_NCH);
        if (mx.conv) { conv_chunk(a, lds, 1, mx.idx); continue; }
        const int u = mx.idx;
        if (u < 768) { const int qblk = 63 - u / 12, bh = u % 12, b = bh / 6, h = bh % 6; const size_t row0 = (size_t)b * SEQ + qblk * 128;
            att::diff_unit<VAR>(lds, QH + row0 * DM, KH + (size_t)(b * 12 + h) * SEQ * HD, KH + (size_t)(b * 12 + 6 + h) * SEQ * HD, VH + (size_t)(b * 6 + h) * SEQ * DV, (bf16*)((unsigned char*)OC + row0 * DM + h * DV),
                           qblk, a.in[I_RELB], h, lam, a.in[I_SUBLN]);
        } else { const int v = u - 768, b = v >> 7, hm = (v >> 5) & 3, qb = v & 31; const size_t row0 = (size_t)b * SEQ + qb * 256;
            const size_t mo = (size_t)((1 * 2 + b) * 4 + hm) * NMEM * HD;
            att::attn128_unit<1, true>(lds, QH + row0 * DM + (12 + hm) * HD, (const bf16*)(ws + WS_SMALL + SM_KM) + mo, (const bf16*)(ws + WS_SMALL + SM_VM) + mo, (bf16*)((unsigned char*)OC + row0 * DM + MIXW + hm * HD), 4, 0, nullptr, nullptr, 0);
        }
    }
}

template <int RV>
__device__ __forceinline__ void phase_router(const Args& a, LAS unsigned char* lds, int G, int vb, int layer) {
    unsigned char* ws = opaque_ws(a.ws);
    const int tid = opaque_tid(), lane = tid & 63, wave = __builtin_amdgcn_readfirstlane(tid >> 6), i16 = lane & 15, g4 = lane >> 4, tg = wave & 1, kq = wave >> 1;
    const bf16* H = (const bf16*)(ws + WS_HB);
    const bf16* WRh = (const bf16*)(ws + WS_W_RT) + (size_t)layer * 2 * NRTP * DM;
    LAS float* L = (LAS float*)(lds + RING_OFF);
    LAS int* cnt = (LAS int*)(lds + RING_OFF + 4 * 64 * NRTP * 4);
    for (int blk = vb; blk < T / 64; blk += G) {
        if (tid < 64) cnt[tid] = 0;
        f32x4 acc[2][5];
#pragma unroll
        for (int t2 = 0; t2 < 2; ++t2)
#pragma unroll
            for (int j = 0; j < 5; ++j) acc[t2][j] = (f32x4){0.f, 0.f, 0.f, 0.f};
        const bf16* hrow = H + (size_t)(blk * 64 + tg * 32 + i16) * DM + kq * 512 + 8 * g4;
        const bf16* wh = WRh + (size_t)i16 * DM + kq * 512 + 8 * g4;
#pragma unroll 4
        for (int ks = 0; ks < ((RV & 1) ? 0 : 16); ++ks) {
            bf16x8 fa[2];
#pragma unroll
            for (int t2 = 0; t2 < 2; ++t2) fa[t2] = *(const bf16x8*)(hrow + (size_t)t2 * 16 * DM + ks * 32);
#pragma unroll
            for (int jt = 0; jt < 5; ++jt) {
                const bf16x8 bh = *(const bf16x8*)(wh + (size_t)jt * 16 * DM + ks * 32);
#pragma unroll
                for (int t2 = 0; t2 < 2; ++t2) acc[t2][jt] = __builtin_amdgcn_mfma_f32_16x16x32_bf16(fa[t2], bh, acc[t2][jt], 0, 0, 0);
            }
        }
#pragma unroll
        for (int t2 = 0; t2 < 2; ++t2)
#pragma unroll
            for (int jt = 0; jt < 5; ++jt)
#pragma unroll
                for (int r = 0; r < 4; ++r) L[(kq * 64 + tg * 32 + t2 * 16 + 4 * g4 + r) * NRTP + jt * 16 + i16] = acc[t2][jt][r];
        __syncthreads();
        if (tid < 64 && !(RV & 2)) {
            const int tok = blk * 64 + tid;
            const float* part = (const float*)(ws + WS_SMALL + SM_PART) + (size_t)tok * 32;
            float ss = 0.f;
#pragma unroll
            for (int i = 0; i < 32; ++i) ss += part[i];
            const float rstd = 1.0f / sqrtf(ss * (1.f / DM) + RMS_EPS);
            const LAS float* l0 = L + tid * NRTP;
            const float* brg = a.in[I_B_RG] + layer * 8; const float* bre = a.in[I_B_RE] + layer * 64;
            float gmax = -__builtin_inff(); int gi = 0; float gl[8];
#pragma unroll
            for (int j = 0; j < 8; ++j) { gl[j] = ((l0[j] + l0[64 * NRTP + j]) + (l0[128 * NRTP + j] + l0[192 * NRTP + j])) * rstd + brg[j]; if (gl[j] > gmax) { gmax = gl[j]; gi = j; } }
            float gs = 0.f;
#pragma unroll
            for (int j = 0; j < 8; ++j) gs += expf(gl[j] - gmax);
            const float pg = 1.f / gs;
            float v0 = -__builtin_inff(), v1 = -__builtin_inff(); int i0 = 0, i1 = 0;
#pragma unroll
            for (int j = 0; j < 8; ++j) { const int ix = 8 + gi * 8 + j; const float e = ((l0[ix] + l0[64 * NRTP + ix]) + (l0[128 * NRTP + ix] + l0[192 * NRTP + ix])) * rstd + bre[gi * 8 + j];
                if (e > v0) { v1 = v0; i1 = i0; v0 = e; i0 = j; } else if (e > v1) { v1 = e; i1 = j; } }
            const float dd = expf(v1 - v0), w0 = pg / (1.f + dd), w1 = pg * dd / (1.f + dd);
            const int e0 = gi * 8 + i0, e1 = gi * 8 + i1;
            v4u tr; tr.x = (unsigned)e0; tr.y = (unsigned)e1; tr.z = __float_as_uint(w0); tr.w = __float_as_uint(w1);
            *(v4u*)(ws + WS_SMALL + SM_TOKR + (size_t)tok * 16) = tr;
            ((float*)(ws + WS_SMALL + SM_RSTD))[tok] = rstd;
            __hip_atomic_fetch_add(cnt + e0, 1, __ATOMIC_RELAXED, __HIP_MEMORY_SCOPE_WORKGROUP);
            __hip_atomic_fetch_add(cnt + e1, 1, __ATOMIC_RELAXED, __HIP_MEMORY_SCOPE_WORKGROUP);
        }
        __syncthreads();
        if (tid < 64 && !(RV & 2)) ((int*)(ws + WS_SMALL + SM_CNT))[blk * 64 + tid] = cnt[tid];
        __syncthreads();
    }
}

__device__ __forceinline__ void phase_gather(const Args& a, LAS unsigned char* lds, int G, int vb) {
    unsigned char* ws = opaque_ws(a.ws);
    const int tid = opaque_tid(), lane = tid & 63, wave = __builtin_amdgcn_readfirstlane(tid >> 6);
    const int* CNT = (const int*)(ws + WS_SMALL + SM_CNT); int* BLKE = (int*)(ws + WS_SMALL + SM_BLKE); int* DEST = (int*)(ws + WS_SMALL + SM_DEST);
    const unsigned* TOKR = (const unsigned*)(ws + WS_SMALL + SM_TOKR);
    int* ROWTOK = (int*)(ws + WS_SMALL + SM_ROWTOK);
    LAS int* tot = (LAS int*)(lds + RING_OFF); LAS int* pre = tot + 64; LAS int* pst = tot + 128; LAS int* destl = tot + 192;
    LAS int* part8 = tot + 320;
    LAS int* tokl = tot + 320 + 1024;
    for (int blk = vb; blk < T / 64; blk += G) {
        { const int e = tid & 63, p8 = tid >> 6; int t_ = 0, p_ = 0;
#pragma unroll 8
          for (int b2 = p8 * 32; b2 < p8 * 32 + 32; ++b2) { const int c = CNT[b2 * 64 + e]; t_ += c; p_ += (b2 < blk) ? c : 0; }
          part8[(p8 * 64 + e) * 2] = t_; part8[(p8 * 64 + e) * 2 + 1] = p_;
          if (tid < 128) tokl[tid] = (int)TOKR[(size_t)(blk * 64 + (tid >> 1)) * 4 + (tid & 1)]; }
        __syncthreads();
        if (tid < 64) { int t_ = 0, p_ = 0;
#pragma unroll
            for (int p8 = 0; p8 < 8; ++p8) { t_ += part8[(p8 * 64 + tid) * 2]; p_ += part8[(p8 * 64 + tid) * 2 + 1]; }
            tot[tid] = t_; pre[tid] = p_;
            const int padded = ((t_ + 255) >> 8) << 8; int incl = padded;
#pragma unroll
            for (int o = 1; o < 64; o <<= 1) { const int up = __shfl_up(incl, o); if (tid >= o) incl += up; }
            pst[tid] = incl - padded;
            if (blk == 0 && tid == 63) BLKE[MAXRB] = incl >> 8; }
        __syncthreads();
        if (tid < 64) {
            if (blk == 0) { const int rb0 = pst[tid] >> 8, rb1 = (pst[tid] + (((tot[tid] + 255) >> 8) << 8)) >> 8; for (int rb = rb0; rb < rb1; ++rb) BLKE[rb] = tid; }
            int r = pst[tid] + pre[tid];
            for (int as = 0; as < 128; ++as) { if (tokl[as] == tid) destl[as] = r++; }
        }
        __syncthreads();
        if (tid < 128) { const int tok = blk * 64 + (tid >> 1), dest = destl[tid]; DEST[tok * 2 + (tid & 1)] = dest; ROWTOK[dest] = tok; }
        if (blk < 64) {
            const int r0 = pst[blk] + tot[blk], r1 = pst[blk] + (((tot[blk] + 255) >> 8) << 8);
            for (int r = r0 + tid; r < r1; r += 512) ROWTOK[r] = 0;
        }
        __syncthreads();
    }
}

__device__ __forceinline__ void phase_combine(const Args& a, int G, int vb, float* Fout  ) {
    unsigned char* ws = opaque_ws(a.ws);
    const int tid = opaque_tid(), lane = tid & 63, wave = __builtin_amdgcn_readfirstlane(tid >> 6);
    const int gw = vb * 8 + wave, NGW = G * 8;
    const bf16* YS = (const bf16*)(ws + WS_YS); const int* DEST = (const int*)(ws + WS_SMALL + SM_DEST); float* RSTD = (float*)(ws + WS_SMALL + SM_RSTD); bf16* HB = (bf16*)(ws + WS_HB);
    for (int tok = gw; tok < T; tok += NGW) {
        const v4u tr = *(const v4u*)(ws + WS_SMALL + SM_TOKR + (size_t)tok * 16); const float w0 = __uint_as_float(tr.z), w1 = __uint_as_float(tr.w);
        const int d0 = DEST[tok * 2], d1 = DEST[tok * 2 + 1];
        GAS v2u* hr = (GAS v2u*)(HB + (size_t)tok * DM) + lane;
        const GAS v2u* y0 = (const GAS v2u*)(YS + (size_t)d0 * DM) + lane; const GAS v2u* y1 = (const GAS v2u*)(YS + (size_t)d1 * DM) + lane;
        v2u hv[8], a0[8], a1[8];
#pragma unroll
        for (int j = 0; j < 8; ++j) { hv[j] = hr[64 * j]; a0[j] = y0[64 * j]; a1[j] = y1[64 * j]; }
        float ss = 0.f;
#pragma unroll
        for (int j = 0; j < 8; ++j) { f32x4 v;
            v.x = bflo(hv[j].x) + (w0 * bflo(a0[j].x) + w1 * bflo(a1[j].x)); v.y = bfhi(hv[j].x) + (w0 * bfhi(a0[j].x) + w1 * bfhi(a1[j].x));
            v.z = bflo(hv[j].y) + (w0 * bflo(a0[j].y) + w1 * bflo(a1[j].y)); v.w = bfhi(hv[j].y) + (w0 * bfhi(a0[j].y) + w1 * bfhi(a1[j].y));
            ss += (v.x * v.x + v.y * v.y) + (v.z * v.z + v.w * v.w);
            if (Fout) ((GAS f32x4*)(Fout + (size_t)tok * DM) + lane)[64 * j] = v;
            else { v2u o; o.x = pk2(v.x, v.y); o.y = pk2(v.z, v.w); hr[64 * j] = o;
                   unsigned w8 = 0u; w8 = __builtin_amdgcn_cvt_pk_fp8_f32(v.x, v.y, w8, false); w8 = __builtin_amdgcn_cvt_pk_fp8_f32(v.z, v.w, w8, true); ((GAS unsigned*)(ws + WS_HB8 + (size_t)tok * DM) + lane)[64 * j] = w8; } }
        if (!Fout) { const float rstd = 1.0f / sqrtf(wave_sum(ss) * (1.f / DM) + RMS_EPS); if (lane == 0) RSTD[tok] = rstd; }
    }
}

struct EpiNull { static constexpr bool PERM = false, AFTER_DRAIN = false;
    __device__ __forceinline__ void operator()(const f32x4 (&acc)[2][2][4][2], const pg8::Unit& u, int wr, int wc, int fr, int fq) const {} };
#ifndef MK_DUP
#define MK_DUP -1
#endif
#define DUP(k) (MK_DUP == (k))
#ifndef MK_VAR
#define MK_VAR 0
#endif
#ifndef FP8IN_SP2
#define FP8IN_SP2 true
#endif
constexpr int NPH = 21;
__global__ void __launch_bounds__(512, 2) yoco_fwd(Args args) {
    extern __shared__ __attribute__((aligned(16))) unsigned char lds_raw[];
    LAS unsigned char* lds = (LAS unsigned char*)lds_raw;
    const int tid = opaque_tid();
    const int G = gridDim.x; const int bx0 = blockIdx.x; const int vb = (G % 8 == 0) ? (bx0 % 8) * (G / 8) + bx0 / 8 : bx0;
    unsigned char* ws = args.ws;
    gu32* ctl = (gu32*)(ws + WS_CTL);
    for (int u = tid; u < (LDS_BYTES - LDSCTL_OFF) / 4; u += 512) ((LAS unsigned*)(lds + LDSCTL_OFF))[u] = 0u;
    __syncthreads();
    volatile LAS unsigned* MISC = (volatile LAS unsigned*)(lds + MISC_OFF);
#if MK_N_LAUNCHES == 1
    constexpr int lo = 0, hi = NPH; constexpr bool one = true;
#else
    const int lo = args.ph_lo, hi = args.ph_hi;
    const bool one = (hi - lo) > 1;
#endif
    XcdBarrier bar; bar.bar = (unsigned*)(ctl + CW_BAR); bar.x = 0; bar.st = nullptr;
    if (one) bar = xcd_barrier_post((unsigned*)(ctl + CW_BAR), MISC + 8);
#define GBAR() do { XcdBarrier b2_ = bar; b2_.bar = (unsigned*)opaque_ws((unsigned char*)bar.bar); { unsigned x_ = bar.x; asm volatile("" : "+s"(x_)); b2_.x = x_; } xcd_barrier(b2_); } while (0)
#define IN(k) (lo <= (k) && (k) < hi)
#define SEAM(k) do { if (IN(k) && IN((k) + 1)) GBAR(); } while (0)

#define RUN(k, ...) do { if (IN(k)) { __VA_ARGS__ if (DUP(k)) { __syncthreads(); __VA_ARGS__ } } } while (0)
    RUN(0, phase_prep(args, lds, G, vb););
    SEAM(0);
    for (int l = 0; l < 2; ++l) {
        const int pb = 1 + 10 * l;
        int bx = bx0; asm volatile("" : "+s"(bx));
        RUN(pb + 0,
            { pg8::Gemm g{(const bf16*)(ws + WS_HB8), (const bf16*)(ws + (l == 0 ? WS_W_INA : WS_W_INB)), T, PROJW, DM / 2}; pg8::StaticOrder S; S.init(T, PROJW, G, bx);
              EpiHeadNorm E{ws, l, 1.f / SC_W1};
              pg8::gemm_phase<EpiHeadNorm, pg8::StaticOrder, true, FP8IN_SP2, false, true>(lds + RING_OFF, g, S, E); }
            );
        if (one) GBAR();
        if (l == 0) { if (IN(pb + 2)) {
                if (bx < 16) { pg8::Gemm g{(const bf16*)(ws + WS_SMALL + SM_MEMN), (const bf16*)(ws + WS_W_MKV), NB * NMEM, 2048, DM}; pg8::StaticOrder S; S.init(NB * NMEM, 2048, G, bx);
                    EpiRowScale E{(bf16*)(ws + WS_SMALL + SM_KVM), 2048, nullptr, 0, 1.f};
                    pg8::gemm_phase<EpiRowScale, pg8::StaticOrder, true, true>(lds + RING_OFF, g, S, E); }
                else phase_gate(args, lds, G - 16, bx - 16); }
            if (one) GBAR(); }
        if (IN(pb + 3)) { if (l == 0) { phase_post_mem(args, lds, G, vb); phase_moba_sparse(args, lds, ctl + CW_Q + 256); if (DUP(40)) { __syncthreads(); phase_moba_sparse(args, lds, ctl + CW_Q + 320); } if (one) GBAR(); phase_attn_a(args, lds, ctl + CW_Q); if (DUP(41)) { __syncthreads(); phase_attn_a(args, lds, ctl + CW_Q + 128); } }
            else { phase_attn_b<0>(args, lds, ctl + CW_Q + 64, (bf16*)(ws + WS_OCAT)); if (DUP(14)) { __syncthreads(); phase_attn_b<MK_VAR>(args, lds, ctl + CW_Q + 192, (bf16*)(ws + WS_YS)); } } }
        SEAM(pb + 3);
        RUN(pb + 4,
            {
#ifdef MK_STAG
              if (bx0 & 1) { for (int i_ = 0; i_ < MK_STAG; ++i_) __builtin_amdgcn_s_sleep(127); }
#endif
              pg8::Gemm g8{(const bf16*)(ws + WS_OCAT), (const bf16*)(ws + WS_W_OUT + (size_t)l * DM * DM), T, DM, DM / 2}; pg8::StaticOrder S; S.init(T, DM, G, bx);
              if (l == 0) { EpiOutProj<true> E{args.in[I_X], (float*)(ws + WS_SMALL + SM_PART), (bf16*)(ws + WS_HB), ws + WS_HB8, 1.f / (SC_O * SC_W1)}; pg8::gemm_phase<EpiOutProj<true>, pg8::StaticOrder, true, true, false, true>(lds + RING_OFF, g8, S, E); }
              else { EpiOutProj<false> E{nullptr, (float*)(ws + WS_SMALL + SM_PART), (bf16*)(ws + WS_HB), ws + WS_HB8, 1.f / (SC_O * SC_W1)}; pg8::gemm_phase<EpiOutProj<false>, pg8::StaticOrder, true, true, false, true>(lds + RING_OFF, g8, S, E); } });
#if MK_DUP == 53
        if (l == 0) { __syncthreads();
            pg8::Gemm g9{(const bf16*)(ws + WS_OCAT), (const bf16*)(ws + WS_W_OUT), T, DM, DM / 2}; pg8::StaticOrder S9; S9.init(T, DM, G, bx);
            EpiOutProj<true, MK_VAR> E9{args.in[I_X], (float*)(ws + WS_YS + (size_t)(96 << 20)), (bf16*)(ws + WS_YS), ws + WS_YS + (size_t)(64 << 20), 1.f / (SC_O * SC_W1)};
            pg8::gemm_phase<EpiOutProj<true, MK_VAR>, pg8::StaticOrder, true, true, false, true>(lds + RING_OFF, g9, S9, E9); }
#endif
#if MK_DUP == 52
        if (l == 0) { __syncthreads();
            pg8::Gemm g9{(const bf16*)(ws + WS_OCAT), (const bf16*)(ws + WS_W_INA), T, PROJW, DM / 2}; pg8::StaticOrder S9; S9.init(T, PROJW, G, bx);
            EpiHeadNormT<MK_VAR> E9{ws, 0, 1.f / SC_W1}; pg8::gemm_phase<EpiHeadNormT<MK_VAR>, pg8::StaticOrder, true, true, false, true>(lds + RING_OFF, g9, S9, E9); }
#endif
#if MK_DUP == 50 || MK_DUP == 51
        if (l == 0) { __syncthreads(); constexpr int NN9 = (MK_DUP == 50) ? DM : PROJW;
            pg8::Gemm g9{(const bf16*)(ws + WS_OCAT), (const bf16*)(ws + (MK_DUP == 50 ? WS_W_OUT : WS_W_INA)), T, NN9, DM / 2}; pg8::StaticOrder S9; S9.init(T, NN9, G, bx);
            EpiNull E9; pg8::gemm_phase<EpiNull, pg8::StaticOrder, false, true, false, true>(lds + RING_OFF, g9, S9, E9); }
#endif
        SEAM(pb + 4);
        if (IN(pb + 5)) { phase_router<0>(args, lds, G, vb, l); if (DUP(pb + 5)) { __syncthreads(); phase_router<MK_VAR>(args, lds, G, vb, l); } }
        SEAM(pb + 5);
        RUN(pb + 6, phase_gather(args, lds, G, vb););
        SEAM(pb + 6);
        RUN(pb + 7,
            { const int* blke = (const int*)(ws + WS_SMALL + SM_BLKE);
              const int* rowtok = (const int*)(ws + WS_SMALL + SM_ROWTOK);
              pg8::Gemm g{(const bf16*)(ws + WS_HB8), (const bf16*)(ws + WS_W_E1 + (size_t)l * NEXP * 1024 * DM), MAXRB * 256, 1024, DM / 2, rowtok};
              MoeOrder S{blke, blke[MAXRB] * 4, 4, G, bx}; EpiSiluMul E{(bf16*)(ws + WS_HID), (const float*)(ws + WS_SMALL + SM_RSTD), rowtok};
              pg8::gemm_phase<EpiSiluMul, MoeOrder, true, true, true, true>(lds + RING_OFF, g, S, E); });
        SEAM(pb + 7);
        RUN(pb + 8,
            { const int* blke = (const int*)(ws + WS_SMALL + SM_BLKE);
              pg8::Gemm g{(const bf16*)(ws + WS_HID), (const bf16*)(ws + WS_W_E2 + (size_t)l * NEXP * DM * EFF), MAXRB * 256, DM, EFF / 2};
              MoeOrder S{blke, blke[MAXRB] * 8, 8, G, bx}; EpiRowScale E{(bf16*)(ws + WS_YS), DM, nullptr, 8, 1.f / (SC_HID * SC_W2)};
              pg8::gemm_phase<EpiRowScale, MoeOrder, true, true, false, true>(lds + RING_OFF, g, S, E); });
        SEAM(pb + 8);
        if (IN(pb + 9)) phase_combine(args, G, vb, l == 0 ? nullptr : args.out);
        if (l == 0) SEAM(pb + 9);
    }
#undef RUN
#undef IN
#undef SEAM
}

extern "C" void kernel_launch(void* const* d_in, const int* in_sizes, int n_in, void* d_out, int out_size, void* d_ws, size_t ws_size, hipStream_t stream) {
    static int grid = 0;
    if (grid == 0) {
        if (n_in != N_IN || out_size != T * DM || ws_size < WS_END) { fprintf(stderr, "kernel_launch: unexpected shapes (n_in %d out %d ws %zu)\n", n_in, out_size, ws_size); grid = -1; return; }
        int dev = 0, cus = 0;
        if (hipGetDevice(&dev) != hipSuccess || hipDeviceGetAttribute(&cus, hipDeviceAttributeMultiprocessorCount, dev) != hipSuccess) { grid = -1; return; }
        if (hipFuncSetAttribute((const void*)yoco_fwd, hipFuncAttributeMaxDynamicSharedMemorySize, LDS_BYTES) != hipSuccess) { fprintf(stderr, "kernel_launch: hipFuncSetAttribute failed\n"); grid = -1; return; }
        int per_cu = 0;
        if (hipOccupancyMaxActiveBlocksPerMultiprocessor(&per_cu, (const void*)yoco_fwd, 512, LDS_BYTES) != hipSuccess || per_cu < 1) fprintf(stderr, "kernel_launch: occupancy query reports %d\n", per_cu);
        (void)hipGetLastError();
        grid = cus;
    }
    if (grid < 0) return;
    (void)hipMemsetAsync((char*)d_ws + WS_CTL, 0, CTL_ZERO_BYTES, stream);
    Args a{};
    for (int i = 0; i < N_IN; ++i) a.in[i] = (const float*)d_in[i];
    a.out = (float*)d_out; a.ws = (unsigned char*)d_ws;
#if MK_N_LAUNCHES == 1
    a.ph_lo = 0; a.ph_hi = NPH;
    hipLaunchKernelGGL(yoco_fwd, dim3(grid), dim3(512), LDS_BYTES, stream, a);
#else
    for (int p = 0; p < NPH; ++p) { if (p == 13) continue; a.ph_lo = p; a.ph_hi = p + 1; hipLaunchKernelGGL(yoco_fwd, dim3(grid), dim3(512), LDS_BYTES, stream, a); }
#endif
}
```

```cpp
#include <hip/hip_runtime.h>
#include <cstdio>
#include <cstdint>

#ifndef MK_N_LAUNCHES
#define MK_N_LAUNCHES 1
#endif
#ifndef MK_CHECK
#define MK_CHECK 0
#endif

constexpr int NB = 2, SEQ = 8192, T = NB * SEQ, DM = 2048, HD = 128;
constexpr int NMEM = 256, MEMH = 4, MEMW = 512, MIXW = 1536, MOBA_H = 12, DIFF_H = 6, DV = 256;
constexpr int NEXP = 64, NGRP = 8, EPG = 8, EFF = 512, NRT = 72, NRTP = 80;
constexpr int PROJW = 5120;
constexpr float RMS_EPS = 1e-6f;
constexpr float LOG2E = 1.4426950408889634f;
constexpr float QSCALE = 0.08838834764831845f * LOG2E;
constexpr float LAM_INIT = 0.35550906759096926f;
constexpr int MAXRB = 192;
constexpr float SC_W1 = 64.f, SC_W2 = 32.f, SC_HID = 8.f, SC_O = 16.f;

constexpr size_t MiB = 1u << 20;
constexpr size_t WS_CTL = 0, CTL_ZERO_BYTES = 1 * MiB;
constexpr size_t WS_W_INA = 1 * MiB;
constexpr size_t WS_W_INB = 21 * MiB;
constexpr size_t WS_W_OUT = 41 * MiB;
constexpr size_t WS_W_MKV = 57 * MiB;
constexpr size_t WS_W_RT  = 65 * MiB;
constexpr size_t WS_W_E1  = 67 * MiB;
constexpr size_t WS_HB8   = 323 * MiB;
constexpr size_t WS_W_E2  = 579 * MiB;
constexpr size_t WS_SMALL = 835 * MiB;
constexpr size_t WS_HB    = 851 * MiB;
constexpr size_t WS_PROJ  = 915 * MiB;
constexpr size_t WS_QH    = 1075 * MiB;
constexpr size_t WS_KH    = 1139 * MiB;
constexpr size_t WS_VH    = 1187 * MiB;
constexpr size_t WS_XS    = WS_PROJ;
constexpr size_t WS_OCAT  = 1235 * MiB;
constexpr size_t WS_HID   = 1299 * MiB;
constexpr size_t WS_YS    = 1347 * MiB;
constexpr size_t WS_HA    = 1539 * MiB;
constexpr size_t WS_H2    = 1667 * MiB;
constexpr size_t WS_LISTF = 1795 * MiB;
constexpr size_t WS_LISTA = 1821 * MiB;
constexpr size_t WS_PM    = 1822 * MiB;
constexpr size_t WS_PO    = WS_PROJ;
constexpr size_t WS_END   = 1827 * MiB;
static_assert(WS_XS + (size_t)MAXRB * 256 * 2048 * 2 <= WS_VH, "XS alias");
constexpr size_t SM_RSTD  = 0;
constexpr size_t SM_PART  = 1 * MiB;
constexpr size_t SM_TOKR  = 3 * MiB;
constexpr size_t SM_DEST  = 4 * MiB;
constexpr size_t SM_CNT   = 5 * MiB;
constexpr size_t SM_BLKE  = 5 * MiB + 128 * 1024;
constexpr size_t SM_KMEAN = 6 * MiB;
constexpr size_t SM_SEL   = 7 * MiB;
constexpr size_t SM_MEMN  = 8 * MiB;
constexpr size_t SM_KVM   = 10 * MiB;
constexpr size_t SM_KM    = 12 * MiB;
constexpr size_t SM_VM    = 13 * MiB;
constexpr size_t SM_GAINTAB = 15 * MiB;
constexpr size_t SM_ROWTOK = 14 * MiB;
constexpr int CW_BAR = 4096;
constexpr int CW_Q = 8192;
constexpr int CW_MC = 16384;

constexpr int RING_OFF = 0, RING_BYTES = 131072;
constexpr int LDSX_OFF = RING_BYTES;
constexpr int LDSCTL_OFF = RING_BYTES + 12288, MISC_OFF = LDSCTL_OFF + 320;
constexpr int LDS_BYTES = 147456;
static_assert(MISC_OFF + 128 <= LDS_BYTES, "LDS map");

#define GAS __attribute__((address_space(1)))
#define LAS __attribute__((address_space(3)))
typedef unsigned short bf16;
typedef unsigned v4u __attribute__((ext_vector_type(4)));
typedef unsigned v2u __attribute__((ext_vector_type(2)));
typedef float f32x4 __attribute__((ext_vector_type(4)));
typedef float f32x16 __attribute__((ext_vector_type(16)));
typedef short bf16x8 __attribute__((ext_vector_type(8)));
typedef short s16x4 __attribute__((ext_vector_type(4)));
typedef GAS unsigned gu32;
#define RLX_AGENT __ATOMIC_RELAXED, __HIP_MEMORY_SCOPE_AGENT
#define LDS_WAIT() asm volatile("s_waitcnt lgkmcnt(0)" ::: "memory")
#define VM_WAIT() asm volatile("s_waitcnt vmcnt(0)" ::: "memory")
__device__ __forceinline__ unsigned f2bf(float f) { unsigned u = __builtin_bit_cast(unsigned, f); return (u + 0x7fffu + ((u >> 16) & 1u)) >> 16; }
__device__ __forceinline__ unsigned pk2(float lo, float hi) { return f2bf(lo) | (f2bf(hi) << 16); }
__device__ __forceinline__ float bf2f(unsigned short b) { return __builtin_bit_cast(float, (unsigned)b << 16); }
__device__ __forceinline__ float bflo(unsigned w) { return __builtin_bit_cast(float, w << 16); }
__device__ __forceinline__ float bfhi(unsigned w) { return __builtin_bit_cast(float, w & 0xffff0000u); }
template <int M> __device__ __forceinline__ float swz_xor(float v) { return __builtin_bit_cast(float, __builtin_amdgcn_ds_swizzle(__builtin_bit_cast(int, v), (M << 10) | 0x1F)); }
__device__ __forceinline__ float add_xor32(float v) {
    auto r = __builtin_amdgcn_permlane32_swap(__float_as_uint(v), __float_as_uint(v), false, false);
    return __uint_as_float(r[0]) + __uint_as_float(r[1]); }
__device__ __forceinline__ float wave_sum(float v) {
    v += swz_xor<1>(v); v += swz_xor<2>(v); v += swz_xor<4>(v); v += swz_xor<8>(v); v += swz_xor<16>(v);
    return add_xor32(v);
}
__device__ const unsigned char T5_BUCKET[128] = {
 0, 1, 2, 3, 4, 5, 6, 7, 8, 9, 10, 11, 12, 13, 14, 15, 16, 16, 16, 17, 17, 18, 18, 18, 19, 19, 19, 20, 20, 20, 20, 21, 21, 21, 21, 22, 22, 22, 22, 22, 23, 23, 23, 23, 23, 23, 24, 24, 24, 24, 24, 24, 25, 25, 25, 25, 25, 25, 25, 26, 26, 26, 26, 26, 26, 26, 26, 27, 27, 27, 27, 27, 27, 27, 27, 27, 27, 28, 28, 28, 28, 28, 28, 28, 28, 28, 28, 29, 29, 29, 29, 29, 29, 29, 29, 29, 29, 29, 29, 30, 30, 30, 30, 30, 30, 30, 30, 30, 30, 30, 30, 30, 30, 31, 31, 31, 31, 31, 31, 31, 31, 31, 31, 31, 31, 31, 31, 31};

__device__ __forceinline__ int opaque_tid() { int t = threadIdx.x; asm volatile("" : "+v"(t)); return t; }

__device__ __forceinline__ unsigned char* opaque_ws(unsigned char* p) { asm volatile("" : "+s"(p)); return p; }
namespace pg8 {
#define PG8_LAS __attribute__((address_space(3)))
typedef unsigned short bf16_t;
typedef short bf16x8 __attribute__((ext_vector_type(8)));
typedef float f32x4 __attribute__((ext_vector_type(4)));
typedef unsigned u32x4 __attribute__((ext_vector_type(4)));
constexpr int BM = 256, BK = 64, HALF = 128, HTB = HALF * BK * 2  , STAGE_BYTES = 8 * HTB, NXCD = 8, WGM = 8;

__host__ __device__ __forceinline__ int lds_byte(int r, int c) { const int st = (r >> 4) * 2 + (c >> 5), rr = r & 15, cc = c & 31, ob = rr * 64 + cc * 2; return st * 1024 + (ob ^ (((ob >> 9) & 1) << 5)); }
__host__ __device__ __forceinline__ void stage_rc(int b, int& R, int& C) { const int st = b / 1024, sb = b % 1024, swz = sb ^ (((sb >> 9) & 1) << 5); R = (st >> 1) * 16 + swz / 64; C = (st & 1) * 32 + (swz % 64) / 2; }
__host__ __device__ __forceinline__ int perm32(int rho) { const int n = rho >> 4, i = rho & 15; return 8 * (i >> 2) + 4 * n + (i & 3); }

struct Unit { int pm, pn; };
struct Gemm { const bf16_t* A; const bf16_t* Bt; int M, N, K; const int* rowtok; };

struct StaticOrder {
    int nM, nN, nwg, G, c;
    __host__ __device__ void init(int M, int N, int G_, int c_) { nM = M / BM; nN = N / BM; nwg = nM * nN; G = G_; c = c_; }
    __host__ __device__ bool next(int i, Unit& u) const {
        const long L = (long)i * G + c; if (L >= nwg) return false;
        int wgid = (int)L; { const int q = nwg / NXCD, r = nwg % NXCD, xcd = wgid % NXCD, off = wgid / NXCD; wgid = (xcd < r ? xcd * (q + 1) : r * (q + 1) + (xcd - r) * q) + off; }
        const int nig = WGM * nN, gid = wgid / nig, fm = gid * WGM, gsz = (nM - fm) < WGM ? (nM - fm) : WGM;
        u.pm = fm + ((wgid % nig) % gsz); u.pn = (wgid % nig) / gsz; return true;
    }
    __device__ __forceinline__ void a_ready(const Unit&) const {}
    __device__ __forceinline__ void done(const Unit&) const {}
};

__device__ __forceinline__ unsigned cvt_pk_bf16(float lo, float hi) { unsigned r; asm volatile("v_cvt_pk_bf16_f32 %0, %1, %2" : "=v"(r) : "v"(lo), "v"(hi)); return r; }
typedef float f32x2 __attribute__((ext_vector_type(2)));
struct RangeOrder {
    StaticOrder S; int i0, i1;
    __device__ __forceinline__ bool next(int i, Unit& u) const { return (i0 + i < i1) && S.next(i0 + i, u); }
    __device__ __forceinline__ void a_ready(const Unit&) const {}
    __device__ __forceinline__ void done(const Unit&) const {}
};
template <class E> struct ProbeOf { static constexpr int v = 0; };
template <class Epi, class Sched, bool ALIGN_EPI = false, bool SP2 = false, bool GATHER = false, bool FP8 = false>
__device__ __forceinline__ void gemm_phase(PG8_LAS unsigned char* lds, const Gemm g, const Sched& S, const Epi& E) {
    const int tid = opaque_tid(), wid = __builtin_amdgcn_readfirstlane(tid >> 6), lane = tid & 63, wr = wid >> 2, wc = wid & 3, fr = lane & 15, fq = lane >> 4;
    const int K = g.K, nt = K / BK;
    unsigned voffA[2], voffB[2]; int RA[2]; unsigned CA2[2];
#pragma unroll
    for (int i = 0; i < 2; ++i) { int R, C; stage_rc(tid * 16 + i * 8192, R, C); const int Rb = Epi::PERM ? ((R & ~31) + perm32(R & 31)) : R;
        voffA[i] = (unsigned)(R * K + C) * 2u; voffB[i] = (unsigned)(Rb * K + C) * 2u; RA[i] = R; CA2[i] = (unsigned)C * 2u; }
    const size_t kstep = (size_t)(BK * 2);
    const size_t hstep = (size_t)HALF * K * 2;
    const size_t tstep = 2 * hstep;
    const unsigned ldsw = (unsigned)wid * 1024u;
    const int aoff = lds_byte(wr * 64 + fr, fq * 8), boff = lds_byte(wc * 32 + fr, fq * 8);
#define PG8_SA(b, h) (((b) * 2 + (h)) * HTB)
#define PG8_SB(b, h) ((4 + (b) * 2 + (h)) * HTB)
#define PG8_STAGE(bufoff, gbase, voff) do { if constexpr (!(ProbeOf<Epi>::v & 4)) _Pragma("unroll") for (int _i = 0; _i < 2; ++_i) \
        __builtin_amdgcn_global_load_lds((const unsigned*)((const char*)(gbase) + (voff)[_i]), (PG8_LAS unsigned*)(lds + (bufoff) + ldsw + _i * 8192), 16, 0, 0); } while (0)
    unsigned gc[2][2], gn[2][2];
#define PG8_GOFF(dst, pm_) do { _Pragma("unroll") for (int _h = 0; _h < 2; ++_h) _Pragma("unroll") for (int _i = 0; _i < 2; ++_i) \
        dst[_h][_i] = (unsigned)g.rowtok[(pm_) * BM + _h * HALF + RA[_i]] * (unsigned)(K * 2) + CA2[_i]; } while (0)
#define PG8_STAGE_A(bufoff, ptr, half, usenext) do { if constexpr (GATHER) { _Pragma("unroll") for (int _i = 0; _i < 2; ++_i) \
        __builtin_amdgcn_global_load_lds((const unsigned*)((const char*)(ptr) + ((usenext) ? gn[half][_i] : gc[half][_i])), (PG8_LAS unsigned*)(lds + (bufoff) + ldsw + _i * 8192), 16, 0, 0); } \
        else { PG8_STAGE(bufoff, (ptr) + (half) * hstep, voffA); } } while (0)
#define PG8_LDA(dst, b, h) do { if constexpr (ProbeOf<Epi>::v & 2) {} else if constexpr (FP8) { _Pragma("unroll") for (int m = 0; m < 4; ++m) dst##8[m] = PG8_CAT(*(const PG8_LAS bf16x8*)(lds + PG8_SA(b, h) + aoff + m * 2048), *(const PG8_LAS bf16x8*)(lds + PG8_SA(b, h) + aoff + m * 2048 + 1024)); } \
        else { _Pragma("unroll") for (int m = 0; m < 4; ++m) _Pragma("unroll") for (int k = 0; k < 2; ++k) dst[m][k] = *(const PG8_LAS bf16x8*)(lds + PG8_SA(b, h) + aoff + m * 2048 + k * 1024); } } while (0)
#define PG8_LDB(dst, b, h) do { if constexpr (ProbeOf<Epi>::v & 2) {} else if constexpr (FP8) { _Pragma("unroll") for (int n = 0; n < 2; ++n) dst##8[n] = PG8_CAT(*(const PG8_LAS bf16x8*)(lds + PG8_SB(b, h) + boff + n * 2048), *(const PG8_LAS bf16x8*)(lds + PG8_SB(b, h) + boff + n * 2048 + 1024)); } \
        else { _Pragma("unroll") for (int n = 0; n < 2; ++n) _Pragma("unroll") for (int k = 0; k < 2; ++k) dst[n][k] = *(const PG8_LAS bf16x8*)(lds + PG8_SB(b, h) + boff + n * 2048 + k * 1024); } } while (0)
typedef int pg8_v8i __attribute__((ext_vector_type(8))); typedef int pg8_v4i __attribute__((ext_vector_type(4)));
#define PG8_CAT(x0, x1) __builtin_shufflevector(__builtin_bit_cast(pg8_v4i, x0), __builtin_bit_cast(pg8_v4i, x1), 0, 1, 2, 3, 4, 5, 6, 7)
#define PG8_MMA(ai, bj, At, Bt) do { __builtin_amdgcn_s_setprio(1); if constexpr (ProbeOf<Epi>::v & 1) {} else if constexpr (FP8) { _Pragma("unroll") for (int m = 0; m < 4; ++m) _Pragma("unroll") for (int n = 0; n < 2; ++n) \
        asm volatile("v_mfma_scale_f32_16x16x128_f8f6f4 %0, %1, %2, %0, %3, %3 op_sel_hi:[0,0,0]" : "+v"(acc[ai][bj][m][n]) : "v"(Bt##8[n]), "v"(At##8[m]), "v"(pg8_scale1)); } \
        else { _Pragma("unroll") for (int m = 0; m < 4; ++m) _Pragma("unroll") for (int n = 0; n < 2; ++n) _Pragma("unroll") for (int k = 0; k < 2; ++k) \
        acc[ai][bj][m][n] = __builtin_amdgcn_mfma_f32_16x16x32_bf16(Bt[n][k], At[m][k], acc[ai][bj][m][n], 0, 0, 0); } __builtin_amdgcn_s_setprio(0); } while (0)
#define PG8_WAIT_V(n) asm volatile("s_waitcnt vmcnt(" #n ")" ::: "memory")
#define PG8_WAIT_L(n) asm volatile("s_waitcnt lgkmcnt(" #n ")" ::: "memory")
#define PG8_BAR __builtin_amdgcn_s_barrier()
#define PG8_SCHED __builtin_amdgcn_sched_barrier(0)
    Unit cur, nxt; int ui = 0;
    if (!S.next(0, cur)) return;
    f32x4 acc[2][2][4][2];
#pragma unroll
    for (int a = 0; a < 2; ++a)
#pragma unroll
        for (int b = 0; b < 2; ++b)
#pragma unroll
            for (int m = 0; m < 4; ++m)
#pragma unroll
                for (int n = 0; n < 2; ++n) acc[a][b][m][n] = (f32x4){0.f, 0.f, 0.f, 0.f};
    int pg8_scale1 = 0x7F7F7F7F; asm volatile("" : "+v"(pg8_scale1));
    bf16x8 At[4][2], B0[2][2], B1[2][2]; pg8_v8i At8[4], B08[2], B18[2];
    if constexpr (ProbeOf<Epi>::v & 2) { _Pragma("unroll") for (int m = 0; m < 4; ++m) { At8[m] = (pg8_v8i){1, 2, 3, 4, 5, 6, 7, 8}; asm volatile("" : "+v"(At8[m])); } _Pragma("unroll") for (int n = 0; n < 2; ++n) { B08[n] = (pg8_v8i){1, 2, 3, 4, 5, 6, 7, 8}; B18[n] = B08[n]; asm volatile("" : "+v"(B08[n]), "+v"(B18[n])); } }
    const char* cA = GATHER ? (const char*)g.A : (const char*)g.A + (size_t)cur.pm * tstep; const char* cB = (const char*)g.Bt + (size_t)cur.pn * tstep;
    if constexpr (GATHER) { PG8_GOFF(gc, cur.pm); }
    S.a_ready(cur);
    if constexpr (SP2) {
        PG8_STAGE(PG8_SB(0, 0), cB, voffB); PG8_STAGE(PG8_SB(0, 1), cB + hstep, voffB); PG8_STAGE_A(PG8_SA(0, 0), cA, 0, false); PG8_STAGE_A(PG8_SA(0, 1), cA, 1, false);
        if (wr == 1) PG8_BAR;
        PG8_WAIT_V(2); PG8_BAR;
        PG8_STAGE(PG8_SB(1, 0), cB + kstep, voffB); PG8_STAGE_A(PG8_SA(1, 0), cA + kstep, 0, false); PG8_STAGE(PG8_SB(1, 1), cB + hstep + kstep, voffB);
        PG8_WAIT_V(6); PG8_BAR;
    } else {
        PG8_STAGE(PG8_SB(0, 0), cB, voffB); PG8_STAGE_A(PG8_SA(0, 0), cA, 0, false); PG8_STAGE(PG8_SB(0, 1), cB + hstep, voffB); PG8_STAGE_A(PG8_SA(0, 1), cA, 1, false);
        if (wr == 1) PG8_BAR;
        PG8_WAIT_V(4); PG8_BAR;
        PG8_STAGE(PG8_SB(1, 0), cB + kstep, voffB); PG8_STAGE_A(PG8_SA(1, 0), cA + kstep, 0, false); PG8_STAGE(PG8_SB(1, 1), cB + hstep + kstep, voffB);
        PG8_WAIT_V(6); PG8_BAR;
    }
    for (;;) {
        const bool has_next = S.next(ui + 1, nxt);
        const char* nA = GATHER ? (const char*)g.A : (has_next ? (const char*)g.A + (size_t)nxt.pm * tstep : cA);
        if constexpr (GATHER) { if (has_next) { PG8_GOFF(gn, nxt.pm); } else { _Pragma("unroll") for (int _h = 0; _h < 2; ++_h) _Pragma("unroll") for (int _i = 0; _i < 2; ++_i) gn[_h][_i] = gc[_h][_i]; } } const char* nB = has_next ? (const char*)g.Bt + (size_t)nxt.pn * tstep : cB;
#pragma nounroll
        for (int t = 0; t < nt; t += 2) {
            const bool last = (t == nt - 2);
            const char* a1 = cA + (size_t)(t + 1) * kstep;
            const char* a2 = last ? nA : cA + (size_t)(t + 2) * kstep; const char* b2 = last ? nB : cB + (size_t)(t + 2) * kstep;
            const char* a3 = a2 + kstep; const char* b3 = b2 + kstep;
            if (last && has_next) S.a_ready(nxt);
            if constexpr (SP2) {
            PG8_LDB(B0, 0, 0); PG8_LDB(B1, 0, 1); PG8_SCHED; PG8_LDA(At, 0, 0); PG8_STAGE_A(PG8_SA(1, 1), a1, 1, false);
            PG8_WAIT_V(8); PG8_WAIT_L(0); PG8_BAR; PG8_MMA(0, 0, At, B0); PG8_MMA(0, 1, At, B1); PG8_BAR; PG8_SCHED;
            PG8_LDA(At, 0, 1); PG8_STAGE(PG8_SB(0, 0), b2, voffB); PG8_STAGE(PG8_SB(0, 1), b2 + hstep, voffB); PG8_STAGE_A(PG8_SA(0, 0), a2, 0, last);
            PG8_WAIT_V(8); PG8_WAIT_L(0); PG8_BAR; PG8_MMA(1, 0, At, B0); PG8_MMA(1, 1, At, B1); PG8_BAR; PG8_SCHED;
            PG8_LDB(B0, 1, 0); PG8_LDB(B1, 1, 1); PG8_SCHED; PG8_LDA(At, 1, 0); PG8_STAGE_A(PG8_SA(0, 1), a2, 1, last);
            PG8_WAIT_V(8); PG8_WAIT_L(0); PG8_BAR; PG8_MMA(0, 0, At, B0); PG8_MMA(0, 1, At, B1); PG8_BAR; PG8_SCHED;
            PG8_LDA(At, 1, 1); PG8_STAGE(PG8_SB(1, 0), b3, voffB); PG8_STAGE(PG8_SB(1, 1), b3 + hstep, voffB); PG8_STAGE_A(PG8_SA(1, 0), a3, 0, last);
            PG8_WAIT_V(8); PG8_WAIT_L(0); PG8_BAR; PG8_MMA(1, 0, At, B0); PG8_MMA(1, 1, At, B1); PG8_BAR; PG8_SCHED;
            } else {
            PG8_LDB(B0, 0, 0); PG8_SCHED; PG8_LDA(At, 0, 0); PG8_STAGE_A(PG8_SA(1, 1), a1, 1, false);
            PG8_WAIT_L(8); PG8_BAR; PG8_WAIT_L(0); PG8_MMA(0, 0, At, B0); PG8_BAR; PG8_SCHED;
            PG8_LDB(B1, 0, 1); PG8_STAGE(PG8_SB(0, 0), b2, voffB);
            PG8_BAR; PG8_WAIT_L(0); PG8_MMA(0, 1, At, B1); PG8_BAR;
            PG8_LDA(At, 0, 1); PG8_STAGE_A(PG8_SA(0, 0), a2, 0, last);
            PG8_BAR; PG8_WAIT_L(0); PG8_MMA(1, 0, At, B0); PG8_BAR; PG8_SCHED;
            PG8_STAGE(PG8_SB(0, 1), b2 + hstep, voffB);
            PG8_WAIT_V(6); PG8_BAR; PG8_MMA(1, 1, At, B1); PG8_BAR;
            PG8_LDB(B0, 1, 0); PG8_SCHED; PG8_LDA(At, 1, 0); PG8_STAGE_A(PG8_SA(0, 1), a2, 1, last);
            PG8_WAIT_L(8); PG8_BAR; PG8_WAIT_L(0); PG8_MMA(0, 0, At, B0); PG8_BAR; PG8_SCHED;
            PG8_LDB(B1, 1, 1); PG8_STAGE(PG8_SB(1, 0), b3, voffB);
            PG8_BAR; PG8_WAIT_L(0); PG8_MMA(0, 1, At, B1); PG8_BAR;
            PG8_LDA(At, 1, 1); PG8_STAGE_A(PG8_SA(1, 0), a3, 0, last);
            PG8_BAR; PG8_WAIT_L(0); PG8_MMA(1, 0, At, B0); PG8_BAR; PG8_SCHED;
            PG8_STAGE(PG8_SB(1, 1), b3 + hstep, voffB);
            PG8_WAIT_V(6); PG8_BAR; PG8_MMA(1, 1, At, B1); PG8_BAR;
            }
        }
        if constexpr (FP8) asm volatile("s_nop 15\n\ts_nop 15" ::: "memory");
        if constexpr (ALIGN_EPI) { if (wr == 0) PG8_BAR; }
        if constexpr (!Epi::AFTER_DRAIN) { E(acc, cur, wr, wc, fr, fq); S.done(cur); }
        if (!has_next) break;
#pragma unroll
        for (int a = 0; a < 2; ++a)
#pragma unroll
            for (int b = 0; b < 2; ++b)
#pragma unroll
                for (int m = 0; m < 4; ++m)
#pragma unroll
                    for (int n = 0; n < 2; ++n) acc[a][b][m][n] = (f32x4){0.f, 0.f, 0.f, 0.f};
        cur = nxt; cA = nA; cB = nB; ++ui;
        if constexpr (GATHER) { _Pragma("unroll") for (int _h = 0; _h < 2; ++_h) _Pragma("unroll") for (int _i = 0; _i < 2; ++_i) gc[_h][_i] = gn[_h][_i]; }
        if constexpr (ALIGN_EPI) { if (wr == 1) PG8_BAR; }
    }
    PG8_WAIT_V(0);
    if constexpr (!ALIGN_EPI) { if (wr == 0) PG8_BAR; }
    PG8_BAR;
    if constexpr (Epi::AFTER_DRAIN) { E.fused(acc, cur, wr, wc, fr, fq, lds, wid, lane); S.done(cur); }
#undef PG8_SA
#undef PG8_SB
#undef PG8_STAGE
#undef PG8_STAGE_A
#undef PG8_GOFF
#undef PG8_LDA
#undef PG8_LDB
#undef PG8_MMA
#undef PG8_CAT
#undef PG8_WAIT_V
#undef PG8_WAIT_L
#undef PG8_BAR
#undef PG8_SCHED
}
}
#define XB_TMO      128
#define XB_XCNT(j)  (256  + 64 * (j))
#define XB_XSUB(j)  (1280 + 64 * (j))
#define XB_XGEN(j)  (2304 + 64 * (j))
#define XB_TOP      3328
#define XB_TOPGEN   3392
#define XCD_BAR_WORDS 3456
#define XB_SPIN_CAP (1u << 18)

__device__ __forceinline__ unsigned xb_ld(unsigned* p)              { return __hip_atomic_load(p, __ATOMIC_RELAXED, __HIP_MEMORY_SCOPE_AGENT); }
__device__ __forceinline__ unsigned xb_add(unsigned* p, unsigned v) { return __hip_atomic_fetch_add(p, v, __ATOMIC_RELAXED, __HIP_MEMORY_SCOPE_AGENT); }
__device__ __forceinline__ unsigned xb_xcc_id() { return (unsigned)__builtin_amdgcn_s_getreg((3 << 11) | 20) & 0xFu; }
#define XB_SPIN(cond, bar) do { unsigned _sp = 0; while (cond) { __builtin_amdgcn_s_sleep(1); \
    if ((++_sp & 255u) == 0u) { if (xb_ld(&(bar)[XB_TMO])) break; if (_sp > XB_SPIN_CAP) { atomicAdd(&(bar)[XB_TMO], 1u); break; } } } } while (0)

struct XcdBarrier {
    unsigned* bar; unsigned x;
    volatile LAS unsigned* st;
};

__device__ __forceinline__ XcdBarrier xcd_barrier_post(unsigned* bar, volatile LAS unsigned* st) {
    XcdBarrier b; b.bar = bar; b.x = xb_xcc_id(); b.st = st;
    if (threadIdx.x == 0) (void)xb_add(&bar[XB_XCNT(b.x)], 1u);
    return b;
}
__device__ __forceinline__ void xcd_barrier_complete(unsigned* bar, unsigned x, unsigned& nloc, unsigned& nx) {
    const unsigned G = gridDim.x * gridDim.y * gridDim.z;
    unsigned sum, cnt, mine, sp = 0u;
    for (;;) {
        sum = 0u; cnt = 0u; mine = 0u;
#pragma unroll
        for (unsigned j = 0; j < 16; ++j) { const unsigned c = xb_ld(&bar[XB_XCNT(j)]); sum += c; cnt += (c > 0u) ? 1u : 0u; mine = (j == x) ? c : mine; }
        if (sum == G) break;
        __builtin_amdgcn_s_sleep(1);
        if ((++sp & 255u) == 0u) { if (xb_ld(&bar[XB_TMO])) break; if (sp > XB_SPIN_CAP) { atomicAdd(&bar[XB_TMO], 1u); break; } }
    }
    nloc = mine > 0u ? mine : 1u; nx = cnt > 0u ? cnt : 1u;
}

__device__ __forceinline__ void xcd_barrier(const XcdBarrier& b) {
    asm volatile("s_waitcnt vmcnt(0)" ::: "memory");
    __syncthreads();
    if (threadIdx.x == 0) {
        unsigned* bar = b.bar;
        __builtin_amdgcn_s_waitcnt(0);
        unsigned nloc = b.st[0], nx = b.st[1];
        if (nloc == 0u) { xcd_barrier_complete(bar, b.x, nloc, nx); b.st[0] = nloc; b.st[1] = nx; }
        const unsigned old = xb_add(&bar[XB_XSUB(b.x)], 1u);
        const unsigned gen = old / nloc;
        if (old + 1u == (gen + 1u) * nloc) {
            __builtin_amdgcn_fence(__ATOMIC_RELEASE, "agent");
            asm volatile("s_waitcnt vmcnt(0)" ::: "memory");
            const unsigned og = xb_add(&bar[XB_TOP], 1u);
            const unsigned tg = og / nx;
            if (og + 1u == (tg + 1u) * nx) xb_add(&bar[XB_TOPGEN], 1u);
            else XB_SPIN(xb_ld(&bar[XB_TOPGEN]) == tg, bar);
            __builtin_amdgcn_fence(__ATOMIC_ACQUIRE, "agent");
            xb_add(&bar[XB_XGEN(b.x)], 1u);
            asm volatile("s_waitcnt vmcnt(0)" ::: "memory");
        } else {
            XB_SPIN(xb_ld(&bar[XB_XGEN(b.x)]) == gen, bar);
            __builtin_amdgcn_fence(__ATOMIC_ACQUIRE, "agent");
            asm volatile("s_waitcnt vmcnt(0)" ::: "memory");
        }
    }
    __syncthreads();
}

enum InIdx { I_X = 0, I_MEM, I_RELB, I_ATTN_G, I_FFN_G, I_MEM_G, I_W_MKV, I_QN_MEM, I_KN_MEM, I_W_OUT, I_W_INA, I_QN_A, I_KN_A, I_KV_G, I_W_KVB, I_KN_B, I_W_INB, I_QN_B,
             I_LAMBDA, I_SUBLN, I_W_RG, I_B_RG, I_W_RE, I_B_RE, I_W_GATE, I_W_UP, I_W_DOWN, N_IN };
struct Args { const float* in[N_IN]; float* out; unsigned char* ws; int ph_lo, ph_hi; };
static_assert(sizeof(Args) == N_IN * 8 + 8 + 8 + 8, "Args has no padding");

using pg8::cvt_pk_bf16;
struct EpiRowScale {
    static constexpr bool PERM = true, AFTER_DRAIN = false;
    bf16* O; int ldc; const float* rs; int ntn; float cs;
    __device__ __forceinline__ void operator()(const f32x4 (&acc)[2][2][4][2], const pg8::Unit& u, int wr, int wc, int fr, int fq) const {
        const int colt = ntn ? (u.pn % ntn) : u.pn;
        const int row0 = u.pm * 256 + wr * 64 + fr, col0 = colt * 256 + wc * 32 + 8 * fq;
#pragma unroll
        for (int ai = 0; ai < 2; ++ai)
#pragma unroll
            for (int m = 0; m < 4; ++m) { const int row = row0 + ai * 128 + m * 16; const float s = (rs ? rs[row] : 1.f) * cs; bf16* rowp = O + (size_t)row * ldc + col0;
#pragma unroll
                for (int bj = 0; bj < 2; ++bj) { const f32x4 v0 = acc[ai][bj][m][0] * s, v1 = acc[ai][bj][m][1] * s;
                    v4u w; w.x = cvt_pk_bf16(v0[0], v0[1]); w.y = cvt_pk_bf16(v0[2], v0[3]); w.z = cvt_pk_bf16(v1[0], v1[1]); w.w = cvt_pk_bf16(v1[2], v1[3]);
                    *(v4u*)(rowp + bj * 128) = w; } }
    }
};
template <bool RES_F32, int PV = 0>
struct EpiOutProj {
    static constexpr bool PERM = true, AFTER_DRAIN = false;
    const float* resid; float* part; bf16* HB; unsigned char* HB8; float cs;
    __device__ __forceinline__ void operator()(const f32x4 (&acc)[2][2][4][2], const pg8::Unit& u, int wr, int wc, int fr, int fq) const {
        const int row0 = u.pm * 256 + wr * 64 + fr, col0 = u.pn * 256 + wc * 32 + 8 * fq;
#pragma unroll
        for (int ai = 0; ai < 2; ++ai)
#pragma unroll
            for (int mp = 0; mp < 2; ++mp) {
                f32x4 rf[2][2][2]; v4u rb[2][2];
#pragma unroll
                for (int mm = 0; mm < 2; ++mm) { const size_t off = (size_t)(row0 + ai * 128 + (2 * mp + mm) * 16) * DM + col0;
#pragma unroll
                    for (int bj = 0; bj < 2; ++bj) {
                        if (PV & 1) { rf[mm][bj][0] = (f32x4){0.f, 0.f, 0.f, 0.f}; rf[mm][bj][1] = rf[mm][bj][0]; rb[mm][bj] = (v4u){0u, 0u, 0u, 0u}; }
                        else if (RES_F32) { rf[mm][bj][0] = *(const f32x4*)(resid + off + bj * 128); rf[mm][bj][1] = *(const f32x4*)(resid + off + bj * 128 + 4); }
                        else rb[mm][bj] = *(const v4u*)(HB + off + bj * 128); } }
#pragma unroll
                for (int mm = 0; mm < 2; ++mm) { const int m = 2 * mp + mm; const int row = row0 + ai * 128 + m * 16; const size_t off = (size_t)row * DM + col0; float ss = 0.f;
#pragma unroll
                    for (int bj = 0; bj < 2; ++bj) { f32x4 r0, r1;
                        if (RES_F32) { r0 = rf[mm][bj][0]; r1 = rf[mm][bj][1]; }
                        else { const v4u q = rb[mm][bj]; r0 = (f32x4){bflo(q.x), bfhi(q.x), bflo(q.y), bfhi(q.y)}; r1 = (f32x4){bflo(q.z), bfhi(q.z), bflo(q.w), bfhi(q.w)}; }
                        const f32x4 v0 = r0 + acc[ai][bj][m][0] * cs, v1 = r1 + acc[ai][bj][m][1] * cs;
                        ss += ((v0[0] * v0[0] + v0[1] * v0[1]) + (v0[2] * v0[2] + v0[3] * v0[3])) + ((v1[0] * v1[0] + v1[1] * v1[1]) + (v1[2] * v1[2] + v1[3] * v1[3]));
                        v4u hb; hb.x = cvt_pk_bf16(v0[0], v0[1]); hb.y = cvt_pk_bf16(v0[2], v0[3]); hb.z = cvt_pk_bf16(v1[0], v1[1]); hb.w = cvt_pk_bf16(v1[2], v1[3]);
                        if (!(PV & 2) || hb.x == 0x12345u) *(v4u*)(HB + off + bj * 128) = hb;
                        unsigned w0 = 0u, w1 = 0u; w0 = __builtin_amdgcn_cvt_pk_fp8_f32(v0[0], v0[1], w0, false); w0 = __builtin_amdgcn_cvt_pk_fp8_f32(v0[2], v0[3], w0, true);
                        w1 = __builtin_amdgcn_cvt_pk_fp8_f32(v1[0], v1[1], w1, false); w1 = __builtin_amdgcn_cvt_pk_fp8_f32(v1[2], v1[3], w1, true);
                        if (!(PV & 4) || w0 == 0x12345u) *(v2u*)(HB8 + off + bj * 128) = (v2u){w0, w1}; }
                    ss += swz_xor<16>(ss); ss = add_xor32(ss);
                    if (fq == 0) part[(size_t)row * 32 + u.pn * 4 + wc] = ss; } }
    }
};
struct EpiSiluMul {
    static constexpr bool PERM = true, AFTER_DRAIN = false;
    bf16* O; const float* rstd; const int* rowtok;
    __device__ __forceinline__ void operator()(const f32x4 (&acc)[2][2][4][2], const pg8::Unit& u, int wr, int wc, int fr, int fq) const {
        const int row0 = u.pm * 256 + wr * 64 + fr, col0 = (u.pn & 3) * 128 + wc * 32 + 8 * fq;
        int tk[2][4]; float rsv[2][4];
#pragma unroll
        for (int ai = 0; ai < 2; ++ai)
#pragma unroll
            for (int m = 0; m < 4; ++m) tk[ai][m] = rowtok[row0 + ai * 128 + m * 16];
#pragma unroll
        for (int ai = 0; ai < 2; ++ai)
#pragma unroll
            for (int m = 0; m < 4; ++m) rsv[ai][m] = rstd[tk[ai][m]] * (1.f / SC_W1);
#pragma unroll
        for (int ai = 0; ai < 2; ++ai)
#pragma unroll
            for (int m = 0; m < 4; ++m) { const int row = row0 + ai * 128 + m * 16; float h[8]; const float rs = rsv[ai][m];
#pragma unroll
                for (int n = 0; n < 2; ++n)
#pragma unroll
                    for (int e = 0; e < 4; ++e) { const float g = acc[ai][0][m][n][e] * rs, up = acc[ai][1][m][n][e] * (rs * SC_HID);
                        h[n * 4 + e] = g * up * __builtin_amdgcn_rcpf(1.f + __builtin_amdgcn_exp2f(-g * LOG2E)); }
                unsigned w0 = 0u, w1 = 0u; w0 = __builtin_amdgcn_cvt_pk_fp8_f32(h[0], h[1], w0, false); w0 = __builtin_amdgcn_cvt_pk_fp8_f32(h[2], h[3], w0, true);
                w1 = __builtin_amdgcn_cvt_pk_fp8_f32(h[4], h[5], w1, false); w1 = __builtin_amdgcn_cvt_pk_fp8_f32(h[6], h[7], w1, true);
                *(v2u*)((unsigned char*)O + (size_t)row * EFF + col0) = (v2u){w0, w1}; }
    }
};
struct MoeOrder {
    const int* blk_e; int nunits, ntn, G, c;
    __device__ __forceinline__ bool next(int i, pg8::Unit& u) const {
        const int L = i * G + c; if (L >= nunits) return false;
        const int rb = L / ntn; u.pm = rb; u.pn = blk_e[rb] * ntn + (L - rb * ntn); return true;
    }
    __device__ __forceinline__ void a_ready(const pg8::Unit&) const {}
    __device__ __forceinline__ void done(const pg8::Unit&) const {}
};

struct TrDesc { const float* src; int N; bf16* dst; int dstK; const float* gain; float f8; };
__device__ __forceinline__ TrDesc tr_decode(const Args& a, int r) {
    unsigned char* ws = opaque_ws(a.ws); TrDesc d; d.f8 = 0.f;
    constexpr int R0 = 2560, R1 = 1024, R2 = 1536, R3 = 2048, R4 = 1024, R5 = 32768, R6 = 32768;
    if (r < R0) { const int kb = r / 160, nb = r % 160; d.src = a.in[I_W_INA] + (size_t)(128 * kb) * 5120 + 32 * nb; d.N = 5120; d.dst = (bf16*)(ws + WS_W_INA + (size_t)(32 * nb) * DM + 128 * kb); d.dstK = DM; d.gain = a.in[I_ATTN_G] + 128 * kb; d.f8 = SC_W1; return d; } r -= R0;
    if (r < R1) { const int kb = r / 64, nb = r % 64; d.src = a.in[I_W_INB] + (size_t)(128 * kb) * 2048 + 32 * nb; d.N = 2048; d.dst = (bf16*)(ws + WS_W_INB + (size_t)(32 * nb) * DM + 128 * kb); d.dstK = DM; d.gain = a.in[I_ATTN_G] + DM + 128 * kb; d.f8 = SC_W1; return d; } r -= R1;
    if (r < R2) { const int kb = r / 96, nb = r % 96; d.src = a.in[I_W_KVB] + (size_t)(128 * kb) * 3072 + 32 * nb; d.N = 3072; d.dst = (bf16*)(ws + WS_W_INB + (size_t)(2048 + 32 * nb) * DM + 128 * kb); d.dstK = DM; d.gain = a.in[I_KV_G] + 128 * kb; d.f8 = SC_W1; return d; } r -= R2;
    if (r < R3) { const int l = r / 1024, rr = r % 1024, kb = rr / 64, nb = rr % 64; d.src = a.in[I_W_OUT] + (size_t)l * DM * DM + (size_t)(128 * kb) * 2048 + 32 * nb; d.N = 2048;
        d.dst = (bf16*)(ws + WS_W_OUT + (size_t)l * DM * DM + (size_t)(32 * nb) * DM + 128 * kb); d.f8 = SC_W1;
        d.dstK = DM; d.gain = nullptr; return d; } r -= R3;
    if (r < R4) { const int l = r / 512, rr = r % 512, kb = rr / 32, nb = rr % 32; d.src = a.in[I_W_MKV] + (size_t)l * DM * 1024 + (size_t)(128 * kb) * 1024 + 32 * nb; d.N = 1024;
        d.dst = (bf16*)(ws + WS_W_MKV) + (size_t)l * 1024 * DM + (size_t)(32 * nb) * DM + 128 * kb; d.dstK = DM; d.gain = a.in[I_MEM_G] + l * DM + 128 * kb; return d; } r -= R4;
    if (r < R5 + R6) { const int up = r >= R5 ? 1 : 0; if (up) r -= R5;
        const int le = r / 256, rr = r % 256, kb = rr / 16, nb = rr % 16, n0 = 32 * nb, drow = (n0 >> 7) * 256 + (n0 & 127) + up * 128;
        d.src = (up ? a.in[I_W_UP] : a.in[I_W_GATE]) + (size_t)le * DM * EFF + (size_t)(128 * kb) * EFF + n0; d.N = EFF;
        d.dst = (bf16*)(ws + WS_W_E1 + ((size_t)le * 1024 + drow) * DM + 128 * kb); d.dstK = DM; d.gain = a.in[I_FFN_G] + (le >> 6) * DM + 128 * kb; d.f8 = SC_W1; return d; } r -= R5 + R6;
    { const int le = r / 256, rr = r % 256, kb = rr / 64, nb = rr % 64; d.src = a.in[I_W_DOWN] + (size_t)le * EFF * DM + (size_t)(128 * kb) * DM + 32 * nb; d.N = DM;
        d.dst = (bf16*)(ws + WS_W_E2 + ((size_t)le * DM + 32 * nb) * EFF + 128 * kb); d.dstK = EFF; d.gain = nullptr; d.f8 = SC_W2; return d; }
}
__device__ __forceinline__ float row_to_fp8(const float* xrow, unsigned char* orow, int lane) {
    const GAS f32x4* xr = (const GAS f32x4*)xrow + lane;
    f32x4 v[8]; float s = 0.f;
#pragma unroll
    for (int j = 0; j < 8; ++j) { v[j] = xr[64 * j]; s += (v[j].x * v[j].x + v[j].y * v[j].y) + (v[j].z * v[j].z + v[j].w * v[j].w); }
    const float rstd = 1.0f / sqrtf(wave_sum(s) * (1.f / DM) + RMS_EPS);
    GAS unsigned* o4 = (GAS unsigned*)orow + lane;
#pragma unroll
    for (int j = 0; j < 8; ++j) { unsigned w = 0u; w = __builtin_amdgcn_cvt_pk_fp8_f32(v[j].x, v[j].y, w, false); w = __builtin_amdgcn_cvt_pk_fp8_f32(v[j].z, v[j].w, w, true); o4[64 * j] = w; }
    return rstd;
}
__device__ __forceinline__ float row_to_bf16(const float* xrow, bf16* orow, bool normalise, int lane) {
    const GAS f32x4* xr = (const GAS f32x4*)xrow + lane;
    f32x4 v[8]; float s = 0.f;
#pragma unroll
    for (int j = 0; j < 8; ++j) { v[j] = xr[64 * j]; s += (v[j].x * v[j].x + v[j].y * v[j].y) + (v[j].z * v[j].z + v[j].w * v[j].w); }
    const float rstd = 1.0f / sqrtf(wave_sum(s) * (1.f / DM) + RMS_EPS);
    const float f = normalise ? rstd : 1.f;
    GAS unsigned long long* o8 = (GAS unsigned long long*)orow + lane;
#pragma unroll
    for (int j = 0; j < 8; ++j) o8[64 * j] = (unsigned long long)pk2(v[j].x * f, v[j].y * f) | ((unsigned long long)pk2(v[j].z * f, v[j].w * f) << 32);
    return rstd;
}
#define TR_IDX(i) (layer < 0 ? (i) : 8192 + ((i) / 16384) * 32768 + layer * 16384 + ((i) % 16384))
__device__ __forceinline__ void tr_loop(const Args& a, LAS float* scr, int lane, int it, int end, int stride, int layer) {
    const int first0 = it < end ? it : 0;
    {
        float v[64];
        const int lr = lane >> 5, lc = lane & 31;
        TrDesc cur = tr_decode(a, TR_IDX(it < end ? it : first0));
        if (it < end) {
#pragma unroll
            for (int i = 0; i < 64; ++i) v[i] = __builtin_nontemporal_load(cur.src + (size_t)(2 * i + lr) * cur.N + lc);
        }
        for (; it < end; it += stride) {
#pragma unroll
            for (int i = 0; i < 64; ++i) scr[(2 * i + lr) * 33 + lc] = v[i];
            LDS_WAIT(); asm volatile("" ::: "memory");
            const int nx = it + stride; const bool has_next = nx < end;
            const TrDesc nd = tr_decode(a, TR_IDX(has_next ? nx : it));
            if (has_next) {
#pragma unroll
                for (int i = 0; i < 64; ++i) v[i] = __builtin_nontemporal_load(nd.src + (size_t)(2 * i + lr) * nd.N + lc);
            }
            if (cur.f8 != 0.f) {
                const int c = lane & 7, nq = lane >> 3; const float f = cur.f8;
                f32x4 g[4];
#pragma unroll
                for (int q = 0; q < 4; ++q) g[q] = cur.gain ? *(const f32x4*)(cur.gain + 16 * c + 4 * q) * f : (f32x4){f, f, f, f};
#pragma unroll
                for (int j = 0; j < 4; ++j) { const int n = nq + 8 * j; const LAS float* sp = scr + (16 * c) * 33 + n; v4u o;
#pragma unroll
                    for (int q = 0; q < 4; ++q) { unsigned w = 0u;
                        w = __builtin_amdgcn_cvt_pk_fp8_f32(sp[(4 * q + 0) * 33] * g[q][0], sp[(4 * q + 1) * 33] * g[q][1], w, false);
                        w = __builtin_amdgcn_cvt_pk_fp8_f32(sp[(4 * q + 2) * 33] * g[q][2], sp[(4 * q + 3) * 33] * g[q][3], w, true); o[q] = w; }
                    *(GAS v4u*)((unsigned char*)cur.dst + (size_t)n * cur.dstK + 16 * c) = o; }
            } else {
                const int c = lane & 15, nq = lane >> 4;
                f32x4 g0 = (f32x4){1.f, 1.f, 1.f, 1.f}, g1 = g0;
                if (cur.gain) { g0 = *(const f32x4*)(cur.gain + 8 * c); g1 = *(const f32x4*)(cur.gain + 8 * c + 4); }
#pragma unroll
                for (int j = 0; j < 8; ++j) { const int n = nq + 4 * j; const LAS float* sp = scr + (8 * c) * 33 + n;
                    v4u o; o.x = pk2(sp[0 * 33] * g0[0], sp[1 * 33] * g0[1]); o.y = pk2(sp[2 * 33] * g0[2], sp[3 * 33] * g0[3]); o.z = pk2(sp[4 * 33] * g1[0], sp[5 * 33] * g1[1]); o.w = pk2(sp[6 * 33] * g1[2], sp[7 * 33] * g1[3]);
                    *(GAS v4u*)(cur.dst + (size_t)n * cur.dstK + 8 * c) = o; }
            }
            LDS_WAIT(); asm volatile("" ::: "memory");
            cur = nd;
        }
    }
}
#undef TR_IDX
constexpr int EXP_ITEMS = 49152, CONV_CH = 48, CONV_NCH = EXP_ITEMS / CONV_CH, CONV_IN = 512, CONV_SP = 256;
__device__ __forceinline__ void conv_chunk(const Args& a, LAS unsigned char* lds, int layer, int c) {
    const int tid = opaque_tid(), lane = tid & 63, wave = __builtin_amdgcn_readfirstlane(tid >> 6);
    tr_loop(a, (LAS float*)(lds + RING_OFF + wave * 16896), lane, c * CONV_CH + wave, (c + 1) * CONV_CH, 8, layer);
    __syncthreads();
}
struct Mix { bool conv; int idx; };
__device__ __forceinline__ Mix mix_decode(int u, int NA, int NC) {
    const long U = NA + NC; const int cb = (int)(((long)u * NC) / U), cb1 = (int)(((long)(u + 1) * NC) / U);
    Mix m; m.conv = cb1 != cb; m.idx = m.conv ? cb : u - cb; return m;
}
__device__ __forceinline__ void phase_prep(const Args& a, LAS unsigned char* lds, int G, int vb) {
    const int tid = opaque_tid(), lane = tid & 63, wave = __builtin_amdgcn_readfirstlane(tid >> 6);
    unsigned char* ws = opaque_ws(a.ws);
    LAS float* scr = (LAS float*)(lds + RING_OFF + wave * 16896);
    const int gw = vb * 8 + wave, NGW = G * 8;
    tr_loop(a, scr, lane, gw, 8192, NGW, -1);
    for (int idx = vb * 512 + tid; idx < 2 * NRTP * DM; idx += G * 512) {
        const int l = idx / (NRTP * DM), j = (idx / DM) % NRTP, k = idx % DM;
        float v = 0.f;
        if (j < 8) v = a.in[I_W_RG][((size_t)l * DM + k) * 8 + j]; else if (j < NRT) v = a.in[I_W_RE][((size_t)l * DM + k) * 64 + (j - 8)];
        v *= a.in[I_FFN_G][l * DM + k];
        const unsigned hi = f2bf(v); const float lo = v - bf2f((unsigned short)hi);
        bf16* wr = (bf16*)(ws + WS_W_RT) + (size_t)l * 2 * NRTP * DM;
        wr[(size_t)j * DM + k] = (bf16)hi; wr[(size_t)(NRTP + j) * DM + k] = (bf16)f2bf(lo);
    }
    for (int idx = vb * 512 + tid; idx < 2 * 5 * HD; idx += G * 512) { const int l = idx / (5 * HD), w = (idx / HD) % 5, i = idx % HD; float v;
        if (l == 0) v = (w < 2) ? a.in[I_QN_A][i] : (w == 2) ? a.in[I_QN_MEM][i] : a.in[I_KN_A][i];
        else v = (w == 0) ? a.in[I_QN_B][i] : (w == 1) ? a.in[I_QN_B][HD + i] : (w == 2) ? a.in[I_QN_MEM][HD + i] : (w == 3) ? a.in[I_KN_B][i] : a.in[I_KN_B][HD + i];
        ((float*)(ws + WS_SMALL + SM_GAINTAB))[idx] = v; }
    float* rstd = (float*)(ws + WS_SMALL + SM_RSTD);
    for (int m = gw; m < T; m += NGW) { const float rs = row_to_fp8(a.in[I_X] + (size_t)m * DM, ws + WS_HB8 + (size_t)m * DM, lane); if (lane == 0) rstd[m] = rs; }
    for (int m = gw; m < NB * NMEM; m += NGW) (void)row_to_bf16(a.in[I_MEM] + (size_t)m * DM, (bf16*)(ws + WS_SMALL + SM_MEMN) + (size_t)m * DM, true, lane);
}

struct PostDesc { const bf16* src; int sp; bf16* dst; int dp; const float* gain; float scale; float* kmean; };
__device__ __forceinline__ void post_unit(const PostDesc& d, LAS unsigned char* lds) {
    const int tid = opaque_tid(), lane = tid & 63, wave = __builtin_amdgcn_readfirstlane(tid >> 6), c = lane & 15, rg = lane >> 4;
    float g8[8]; float cs[8];
#pragma unroll
    for (int i = 0; i < 8; ++i) { g8[i] = d.gain ? d.gain[8 * c + i] * d.scale : 1.f; cs[i] = 0.f; }
    v4u wv[8];
#pragma unroll
    for (int it = 0; it < 8; ++it) wv[it] = *(const v4u*)(d.src + (size_t)(wave * 32 + it * 4 + rg) * d.sp + 8 * c);
#pragma unroll
    for (int it = 0; it < 8; ++it) {
        const int row = wave * 32 + it * 4 + rg;
        const v4u w = wv[it];
        float f[8] = {bflo(w.x), bfhi(w.x), bflo(w.y), bfhi(w.y), bflo(w.z), bfhi(w.z), bflo(w.w), bfhi(w.w)};
        if (d.gain) {
            float ss = 0.f;
#pragma unroll
            for (int i = 0; i < 8; ++i) ss += f[i] * f[i];
            ss += swz_xor<1>(ss); ss += swz_xor<2>(ss); ss += swz_xor<4>(ss); ss += swz_xor<8>(ss);
            const float rstd = 1.0f / sqrtf(ss * (1.f / HD) + RMS_EPS);
#pragma unroll
            for (int i = 0; i < 8; ++i) { f[i] = f[i] * rstd * g8[i]; cs[i] += f[i]; }
        }
        v4u o; o.x = pk2(f[0], f[1]); o.y = pk2(f[2], f[3]); o.z = pk2(f[4], f[5]); o.w = pk2(f[6], f[7]);
        *(v4u*)(d.dst + (size_t)row * d.dp + 8 * c) = o;
    }
    if (d.kmean) {
        LAS float* ks = (LAS float*)(lds + RING_OFF);
#pragma unroll
        for (int i = 0; i < 8; ++i) { cs[i] += swz_xor<16>(cs[i]); cs[i] = add_xor32(cs[i]); }
        if (lane < 16) {
#pragma unroll
            for (int i = 0; i < 8; ++i) ks[wave * 128 + 8 * c + i] = cs[i]; }
        __syncthreads();
        if (tid < 128) { float s = 0.f;
#pragma unroll
            for (int w = 0; w < 8; ++w) s += ks[w * 128 + tid];
            d.kmean[tid] = s * (1.f / 256.f); }
        __syncthreads();
    }
}
__device__ __forceinline__ void phase_post_mem(const Args& a, LAS unsigned char* lds, int G, int vb) {
    unsigned char* ws = opaque_ws(a.ws);
    for (int v = vb; v < 32; v += G) {
        PostDesc d; d.kmean = nullptr; d.scale = 1.f; d.gain = nullptr;
        const int l = v >> 4, b = (v >> 3) & 1, s8 = v & 7;
        const bf16* srow = (const bf16*)(ws + WS_SMALL + SM_KVM) + ((size_t)b * 256) * 2048 + l * 1024; d.sp = 2048; d.dp = HD;
        if (s8 < 4) { d.src = srow + s8 * 128; d.dst = (bf16*)(ws + WS_SMALL + SM_KM) + ((size_t)((l * 2 + b) * 4 + s8) * NMEM) * HD; d.gain = a.in[I_KN_MEM] + l * HD; }
        else { d.src = srow + 512 + (s8 - 4) * 128; d.dst = (bf16*)(ws + WS_SMALL + SM_VM) + ((size_t)((l * 2 + b) * 4 + (s8 - 4)) * NMEM) * HD; }
        post_unit(d, lds);
    }
}
struct SlotDesc { bf16* dst; int dp; const float* gain; float scale; float* kmean; };
__device__ __forceinline__ SlotDesc slot_desc(unsigned char* ws, int layer, int sl, int pm) {
    const float* gt = (const float*)(ws + WS_SMALL + SM_GAINTAB) + layer * 5 * HD;
    bf16* QH = (bf16*)(ws + WS_QH); bf16* KH = (bf16*)(ws + WS_KH); bf16* VH = (bf16*)(ws + WS_VH);
    const int t0 = pm * 256, b = pm >> 5, s0 = (pm & 31) * 256;
    SlotDesc d; d.kmean = nullptr; d.scale = 1.f; d.gain = nullptr;
    if (layer == 0) {
        if (sl < 12) { d.dst = QH + (size_t)t0 * DM + sl * 128; d.dp = DM; d.gain = gt; d.scale = QSCALE; }
        else if (sl < 24) { const int h = sl - 12; d.dst = KH + ((size_t)(b * 12 + h) * SEQ + s0) * HD; d.dp = HD; d.gain = gt + 3 * HD;
            d.kmean = (float*)(ws + WS_SMALL + SM_KMEAN) + ((size_t)(b * 12 + h) * 32 + (pm & 31)) * HD; }
        else if (sl < 36) { const int h = sl - 24; d.dst = VH + ((size_t)(b * 12 + h) * SEQ + s0) * HD; d.dp = HD; }
        else { const int h = sl - 36; d.dst = QH + (size_t)t0 * DM + (12 + h) * 128; d.dp = DM; d.gain = gt + 2 * HD; d.scale = QSCALE; }
    } else {
        if (sl < 6) { d.dst = QH + (size_t)t0 * DM + sl * 128; d.dp = DM; d.gain = gt; d.scale = QSCALE; }
        else if (sl < 12) { d.dst = QH + (size_t)t0 * DM + sl * 128; d.dp = DM; d.gain = gt + HD; d.scale = QSCALE; }
        else if (sl < 16) { d.dst = QH + (size_t)t0 * DM + sl * 128; d.dp = DM; d.gain = gt + 2 * HD; d.scale = QSCALE; }
        else if (sl < 22) { const int h = sl - 16; d.dst = KH + ((size_t)(b * 12 + h) * SEQ + s0) * HD; d.dp = HD; d.gain = gt + 3 * HD; }
        else if (sl < 28) { const int h = sl - 22; d.dst = KH + ((size_t)(b * 12 + 6 + h) * SEQ + s0) * HD; d.dp = HD; d.gain = gt + 4 * HD; }
        else { const int vh = sl - 28, h = vh >> 1, cc = vh & 1; d.dst = VH + ((size_t)(b * 6 + h) * SEQ + s0) * DV + cc * 128; d.dp = DV; }
    }
    return d;
}
template <int PV>
struct EpiHeadNormT {
    static constexpr bool PERM = true, AFTER_DRAIN = false;
    unsigned char* ws; int layer; float cs;
    __device__ __forceinline__ void operator()(const f32x4 (&acc)[2][2][4][2], const pg8::Unit& u, int wr, int wc, int fr_in, int fq_in) const {
        int fr = fr_in, fq = fq_in; asm volatile("" : "+v"(fr), "+v"(fq));
        LAS float* P = (LAS float*)(uintptr_t)LDSX_OFF;
        LAS float* KS = (LAS float*)(uintptr_t)(LDSX_OFF + 8192);
        const float* rs = (const float*)(ws + WS_SMALL + SM_RSTD);
        const SlotDesc d0 = slot_desc(ws, layer, 2 * u.pn, u.pm), d1 = slot_desc(ws, layer, 2 * u.pn + 1, u.pm);
        const int rowl = wr * 64 + fr, coll = wc * 32 + 8 * fq;
        const float* rsr = rs + u.pm * 256 + rowl;
        float rt[2][4];
#pragma unroll
        for (int ai = 0; ai < 2; ++ai)
#pragma unroll
            for (int m = 0; m < 4; ++m) rt[ai][m] = rsr[ai * 128 + m * 16] * cs;
        f32x4 gg[2][2];
#pragma unroll
        for (int bj = 0; bj < 2; ++bj) { const SlotDesc& d = bj == 0 ? d0 : d1; gg[bj][0] = (f32x4){1.f, 1.f, 1.f, 1.f}; gg[bj][1] = gg[bj][0];
            if (d.gain) { gg[bj][0] = *(const f32x4*)(d.gain + coll) * d.scale; gg[bj][1] = *(const f32x4*)(d.gain + coll + 4) * d.scale; } }
#pragma unroll
        for (int ai = 0; ai < 2; ++ai)
#pragma unroll
            for (int m = 0; m < 4; ++m) { const int row = rowl + ai * 128 + m * 16; const float rtv = rt[ai][m];
#pragma unroll
                for (int bj = 0; bj < 2; ++bj) { if ((bj == 0 ? d0.gain : d1.gain) != nullptr) {
                    const f32x4 v0 = acc[ai][bj][m][0] * rtv, v1 = acc[ai][bj][m][1] * rtv;
                    float ss = (v0[0] * v0[0] + v0[1] * v0[1]) + (v0[2] * v0[2] + v0[3] * v0[3]) + (v1[0] * v1[0] + v1[1] * v1[1]) + (v1[2] * v1[2] + v1[3] * v1[3]);
                    ss += swz_xor<16>(ss); ss = add_xor32(ss);
                    if (fq == 0 && !(PV & 2)) P[(row * 2 + bj) * 4 + wc] = ss; } } }
        if (!(PV & 2)) { asm volatile("s_waitcnt lgkmcnt(0)" ::: "memory"); __builtin_amdgcn_s_barrier(); asm volatile("" ::: "memory"); }
#pragma unroll
        for (int bj = 0; bj < 2; ++bj) { const SlotDesc& d = bj == 0 ? d0 : d1;
            const f32x4 g0 = gg[bj][0], g1 = gg[bj][1];
            f32x4 c0 = (f32x4){0.f, 0.f, 0.f, 0.f}, c1 = c0;
#pragma unroll
            for (int ai = 0; ai < 2; ++ai)
#pragma unroll
                for (int m = 0; m < 4; ++m) { const int row = rowl + ai * 128 + m * 16; float f = rt[ai][m];
                    if (d.gain) { const f32x4 p4 = *(const LAS f32x4*)(P + (row * 2 + bj) * 4); f *= 1.0f / sqrtf(((p4[0] + p4[1]) + (p4[2] + p4[3])) * (1.f / HD) + RMS_EPS); }
                    const f32x4 v0 = acc[ai][bj][m][0] * f * g0, v1 = acc[ai][bj][m][1] * f * g1;
                    if (d.kmean) { c0 += v0; c1 += v1; }
                    v4u w; w.x = cvt_pk_bf16(v0[0], v0[1]); w.y = cvt_pk_bf16(v0[2], v0[3]); w.z = cvt_pk_bf16(v1[0], v1[1]); w.w = cvt_pk_bf16(v1[2], v1[3]);
                    if (!(PV & 1) || w.x == 0x12345u) *(v4u*)(d.dst + (size_t)row * d.dp + coll) = w; }
            if (d.kmean && !(PV & 4)) {
#pragma unroll
                for (int i = 0; i < 4; ++i) { float v = c0[i]; v += swz_xor<1>(v); v += swz_xor<2>(v); v += swz_xor<4>(v); v += swz_xor<8>(v); if (fr == 0) KS[wr * 256 + bj * 128 + coll + i] = v;
                                              float w_ = c1[i]; w_ += swz_xor<1>(w_); w_ += swz_xor<2>(w_); w_ += swz_xor<4>(w_); w_ += swz_xor<8>(w_); if (fr == 0) KS[wr * 256 + bj * 128 + coll + 4 + i] = w_; } } }
        if (d0.kmean && !(PV & 4)) {
            asm volatile("s_waitcnt lgkmcnt(0)" ::: "memory"); __builtin_amdgcn_s_barrier(); asm volatile("" ::: "memory");
            const int t = (wr * 4 + wc) * 64 + fq * 16 + fr;
            if (t < 256) { const float mean = (KS[t] + KS[256 + t]) * (1.f / 256.f); float* km = (t < 128) ? d0.kmean : d1.kmean; km[t & 127] = mean; }
        }
    }
};
using EpiHeadNorm = EpiHeadNormT<0>;
__device__ __forceinline__ void phase_gate(const Args& a, LAS unsigned char* lds, int G, int vb) {
    unsigned char* ws = opaque_ws(a.ws);
    const bf16* QH = (const bf16*)(ws + WS_QH); const float* KMEAN = (const float*)(ws + WS_SMALL + SM_KMEAN); unsigned* SEL = (unsigned*)(ws + WS_SMALL + SM_SEL);
    gu32* MC = (gu32*)(ws + WS_CTL) + CW_MC; unsigned* LISTF = (unsigned*)(ws + WS_LISTF); unsigned* LISTA = (unsigned*)(ws + WS_LISTA);
    const int tid_g = opaque_tid();
    LAS float* kml = (LAS float*)(lds + RING_OFF);
    for (int idx = vb * 512 + tid_g; idx < NB * MOBA_H * SEQ; idx += G * 512) {
        const int bh = idx / SEQ, s = idx % SEQ, b = bh / MOBA_H, h = bh % MOBA_H, own = s >> 8;
        __syncthreads();
        { const f32x4* src = (const f32x4*)(KMEAN + (size_t)bh * 32 * HD); ((LAS f32x4*)kml)[tid_g] = src[tid_g]; ((LAS f32x4*)kml)[512 + tid_g] = src[512 + tid_g]; }
        __syncthreads();
        unsigned mask = 0u;
        if (own <= 3) { mask = (1u << own) - 1u; }
        else {
            float acc[31];
#pragma unroll
            for (int j = 0; j < 31; ++j) acc[j] = 0.f;
            const bf16* q = QH + ((size_t)b * SEQ + s) * DM + h * HD;
            for (int c = 0; c < 16; ++c) {
                const v4u w = *(const v4u*)(q + 8 * c);
                const float f0 = bflo(w.x), f1 = bfhi(w.x), f2 = bflo(w.y), f3 = bfhi(w.y), f4 = bflo(w.z), f5 = bfhi(w.z), f6 = bflo(w.w), f7 = bfhi(w.w);
#pragma unroll
                for (int j = 0; j < 31; ++j) if (j < own) {
                    const f32x4 k0 = *(const LAS f32x4*)(kml + j * HD + 8 * c), k1 = *(const LAS f32x4*)(kml + j * HD + 8 * c + 4);
                    acc[j] += (f0 * k0[0] + f1 * k0[1]) + (f2 * k0[2] + f3 * k0[3]) + (f4 * k1[0] + f5 * k1[1]) + (f6 * k1[2] + f7 * k1[3]); }
            }
#pragma unroll
            for (int rnd = 0; rnd < 3; ++rnd) { float best = -__builtin_inff(); int bi = 0;
#pragma unroll
                for (int j = 0; j < 31; ++j) if (j < own && !((mask >> j) & 1u) && acc[j] > best) { best = acc[j]; bi = j; }
                mask |= 1u << bi; }
        }
        SEL[idx] = mask;
        { const int lane_ = tid_g & 63; const unsigned long long lt = (1ull << lane_) - 1ull;
          for (int j = 0; j < own; ++j) {
              const bool selj = (mask >> j) & 1u; const unsigned long long bal = __ballot(selj);
              if (bal == 0ull) continue;
              const int far = (j == own - 1) ? 0 : 1; const int lead = __builtin_ctzll(bal);
              unsigned base = 0u; if (lane_ == lead) base = __hip_atomic_fetch_add(MC + (bh * 32 + j) * 2 + far, (unsigned)__builtin_popcountll(bal), RLX_AGENT);
              base = __shfl(base, lead);
              if (selj) { const unsigned pos = base + (unsigned)__builtin_popcountll(bal & lt); const int slot = __builtin_popcount(mask & ((1u << j) - 1u));
                  const unsigned ent = (unsigned)s | ((unsigned)slot << 16);
                  if (far) LISTF[((size_t)bh * 32 + j) * 8192 + pos] = ent; else LISTA[((size_t)bh * 32 + j) * 256 + pos] = ent; } } }
    }
}

namespace att {
constexpr int SHM_T = 16384;
#define KSWZ(row, colB) ((row) * 256 + ((colB) ^ (((row) & 7) << 4)))
#define SBAR() __builtin_amdgcn_sched_barrier(0)
__device__ __forceinline__ int v_rd_base(int lane) { return ((lane & 3) << 3) | (((lane >> 2) & 3) << 6) | (((lane >> 4) & 1) << 5) | (((lane >> 5) & 1) << 8); }
__device__ __forceinline__ int crow(int r, int hi) { return (r & 3) + 8 * (r >> 2) + 4 * hi; }
__device__ __forceinline__ unsigned cvtpk(float lo, float hi) { unsigned r; asm volatile("v_cvt_pk_bf16_f32 %0, %1, %2" : "=v"(r) : "v"(lo), "v"(hi)); return r; }
__device__ __forceinline__ int swap23(int k) { return (k & ~0xC) | ((k & 4) << 1) | ((k & 8) >> 1); }
__device__ __forceinline__ void glds16(const void* sbase  , unsigned voff, unsigned lds_dst) { unsigned keep;
    asm volatile("s_mov_b32 %0, m0\n\ts_mov_b32 m0, %3\n\ts_nop 0\n\tglobal_load_lds_dwordx4 %1, %2\n\ts_mov_b32 m0, %0" : "=&s"(keep) : "v"(voff), "s"(sbase), "s"(lds_dst) : "memory"); }
#define WAIT_BAR0() asm volatile("s_waitcnt vmcnt(0) lgkmcnt(0)\n\ts_barrier" ::: "memory")
constexpr float THR2 = 11.5f;

__device__ __forceinline__ void qkt(f32x16& p0, f32x16& p1, const LAS char* Kt, int r32, int hi, const bf16x8* qr) {
#pragma unroll
    for (int r = 0; r < 16; ++r) { p0[r] = 0.f; p1[r] = 0.f; }
    const LAS char* kb0 = Kt + KSWZ(r32, (0 * 16 + hi * 8) * 2);
    const LAS char* kb1 = Kt + KSWZ(r32, (1 * 16 + hi * 8) * 2);
    const LAS char* kb2 = Kt + KSWZ(r32, (2 * 16 + hi * 8) * 2);
    const LAS char* kb3 = Kt + KSWZ(r32, (3 * 16 + hi * 8) * 2);
#pragma unroll
    for (int d0 = 0; d0 < 8; ++d0) { const LAS char* a = ((d0 & 3) == 0 ? kb0 : (d0 & 3) == 1 ? kb1 : (d0 & 3) == 2 ? kb2 : kb3) + (d0 >> 2) * 128;
        const bf16x8 b0 = *(const LAS bf16x8*)a;
        const bf16x8 b1 = *(const LAS bf16x8*)(a + 32 * 256);
        p0 = __builtin_amdgcn_mfma_f32_32x32x16_bf16(b0, qr[d0], p0, 0, 0, 0);
        p1 = __builtin_amdgcn_mfma_f32_32x32x16_bf16(b1, qr[d0], p1, 0, 0, 0); }
}
__device__ __forceinline__ void pv_tile(f32x16* o, int vb, bf16x8 pa0, bf16x8 pa1, bf16x8 pa2, bf16x8 pa3) {
#define TRRD(dst, off) asm volatile("ds_read_b64_tr_b16 %0, %1 offset:%2" : "=&v"(dst) : "v"(vb), "i"(off) : "memory")
#define PV_RD(S_, d0) do { constexpr int b_ = (d0) * 512; TRRD(S_##l0, b_); TRRD(S_##h0, b_ + 2048); TRRD(S_##l1, b_ + 4096); TRRD(S_##h1, b_ + 6144); \
        TRRD(S_##l2, b_ + 8192); TRRD(S_##h2, b_ + 10240); TRRD(S_##l3, b_ + 12288); TRRD(S_##h3, b_ + 14336); } while (0)
#define PV_MM(S_, d0) do { \
        o[d0] = __builtin_amdgcn_mfma_f32_32x32x16_bf16(pa0, (bf16x8){S_##l0[0], S_##l0[1], S_##l0[2], S_##l0[3], S_##h0[0], S_##h0[1], S_##h0[2], S_##h0[3]}, o[d0], 0, 0, 0); \
        o[d0] = __builtin_amdgcn_mfma_f32_32x32x16_bf16(pa1, (bf16x8){S_##l1[0], S_##l1[1], S_##l1[2], S_##l1[3], S_##h1[0], S_##h1[1], S_##h1[2], S_##h1[3]}, o[d0], 0, 0, 0); \
        o[d0] = __builtin_amdgcn_mfma_f32_32x32x16_bf16(pa2, (bf16x8){S_##l2[0], S_##l2[1], S_##l2[2], S_##l2[3], S_##h2[0], S_##h2[1], S_##h2[2], S_##h2[3]}, o[d0], 0, 0, 0); \
        o[d0] = __builtin_amdgcn_mfma_f32_32x32x16_bf16(pa3, (bf16x8){S_##l3[0], S_##l3[1], S_##l3[2], S_##l3[3], S_##h3[0], S_##h3[1], S_##h3[2], S_##h3[3]}, o[d0], 0, 0, 0); } while (0)
#define WL(n) asm volatile("s_waitcnt lgkmcnt(" #n ")" ::: "memory")
    s16x4 Al0, Al1, Al2, Al3, Ah0, Ah1, Ah2, Ah3, Bl0, Bl1, Bl2, Bl3, Bh0, Bh1, Bh2, Bh3;
    PV_RD(A, 0); SBAR();
    PV_RD(B, 1); WL(8); SBAR(); PV_MM(A, 0); SBAR();
    PV_RD(A, 2); WL(8); SBAR(); PV_MM(B, 1); SBAR();
    PV_RD(B, 3); WL(8); SBAR(); PV_MM(A, 2); SBAR();
    WL(0); SBAR(); PV_MM(B, 3);
#undef PV_RD
#undef PV_MM
#undef TRRD
}
__device__ __forceinline__ void softmax_tile(f32x16& p0, f32x16& p1, float& m_reg, float& l_reg, float& alpha, bf16x8& pa0, bf16x8& pa1, bf16x8& pa2, bf16x8& pa3) {
    float pmax = p0[0];
#pragma unroll
    for (int r = 1; r < 16; ++r) pmax = fmaxf(pmax, p0[r]);
#pragma unroll
    for (int r = 0; r < 16; ++r) pmax = fmaxf(pmax, p1[r]);
    { auto rr = __builtin_amdgcn_permlane32_swap(__float_as_uint(pmax), __float_as_uint(pmax), false, false);
      pmax = fmaxf(__uint_as_float(rr[0]), __uint_as_float(rr[1])); }
    const float mn = (pmax - m_reg <= THR2) ? m_reg : fmaxf(m_reg, pmax);
    alpha = __builtin_amdgcn_exp2f(m_reg - mn); m_reg = mn;
#pragma unroll
    for (int r = 0; r < 16; ++r) { p0[r] = __builtin_amdgcn_exp2f(p0[r] - mn); p1[r] = __builtin_amdgcn_exp2f(p1[r] - mn); }
    float ps = 0.f;
#pragma unroll
    for (int r = 0; r < 16; ++r) ps += p0[r] + p1[r];
    { auto rr = __builtin_amdgcn_permlane32_swap(__float_as_uint(ps), __float_as_uint(ps), false, false);
      ps = __uint_as_float(rr[0]) + __uint_as_float(rr[1]); }
    l_reg = l_reg * alpha + ps;
#define PK4(P, B_, OUT) do { unsigned a0 = cvtpk(P[B_+0], P[B_+1]), a1 = cvtpk(P[B_+2], P[B_+3]); \
        unsigned b0 = cvtpk(P[B_+4], P[B_+5]), b1 = cvtpk(P[B_+6], P[B_+7]); \
        auto r0 = __builtin_amdgcn_permlane32_swap(a0, b0, false, false); auto r1 = __builtin_amdgcn_permlane32_swap(a1, b1, false, false); \
        v4u w = {r0[0], r1[0], r0[1], r1[1]}; OUT = __builtin_bit_cast(bf16x8, w); } while (0)
    PK4(p0, 0, pa0); PK4(p0, 8, pa1); PK4(p1, 0, pa2); PK4(p1, 8, pa3);
#undef PK4
}
__device__ __forceinline__ void bias_mask_tile(f32x16& p0, f32x16& p1, int dq, bool on, bool far, const LAS float* lut) {
    const float NEG = -__builtin_inff();
    if (far) {
        const float c = on ? lut[128] : NEG;
#pragma unroll
        for (int r = 0; r < 16; ++r) { p0[r] += c; p1[r] += c; }
    } else {
#pragma unroll
        for (int r = 0; r < 16; ++r) { const int c = (r & 3) + 8 * (r >> 2); const int d0 = dq - c, d1 = dq - c - 32;
            const float b0 = lut[min(max(d0, 0), 128)], b1 = lut[min(max(d1, 0), 128)];
            p0[r] = (on && d0 >= 0) ? p0[r] + b0 : NEG; p1[r] = (on && d1 >= 0) ? p1[r] + b1 : NEG; }
    }
}

__device__ __forceinline__ void qkt_half(f32x16& p, const LAS char* Kt  , int r32, int hi, const bf16x8* qr) {
#pragma unroll
    for (int r = 0; r < 16; ++r) p[r] = 0.f;
    const LAS char* kb0 = Kt + KSWZ(r32, (0 * 16 + hi * 8) * 2);
    const LAS char* kb1 = Kt + KSWZ(r32, (1 * 16 + hi * 8) * 2);
    const LAS char* kb2 = Kt + KSWZ(r32, (2 * 16 + hi * 8) * 2);
    const LAS char* kb3 = Kt + KSWZ(r32, (3 * 16 + hi * 8) * 2);
#pragma unroll
    for (int d0 = 0; d0 < 8; ++d0) { const LAS char* a = ((d0 & 3) == 0 ? kb0 : (d0 & 3) == 1 ? kb1 : (d0 & 3) == 2 ? kb2 : kb3) + (d0 >> 2) * 128;
        const bf16x8 b0 = *(const LAS bf16x8*)a;
        p = __builtin_amdgcn_mfma_f32_32x32x16_bf16(b0, qr[d0], p, 0, 0, 0); }
}
template <int HALF>
__device__ __forceinline__ void pv_half8(f32x16* o, int vb, bf16x8 pa0, bf16x8 pa1) {
#define TRRD(dst, off) asm volatile("ds_read_b64_tr_b16 %0, %1 offset:%2" : "=&v"(dst) : "v"(vb), "i"(off) : "memory")
#define PV_RD(S_, d0) do { constexpr int b_ = ((d0) & 3) * 512 + ((d0) >> 2) * SHM_T + HALF * 8192; TRRD(S_##l0, b_); TRRD(S_##h0, b_ + 2048); TRRD(S_##l1, b_ + 4096); TRRD(S_##h1, b_ + 6144); } while (0)
#define PV_MM(S_, d0) do { \
        o[d0] = __builtin_amdgcn_mfma_f32_32x32x16_bf16(pa0, (bf16x8){S_##l0[0], S_##l0[1], S_##l0[2], S_##l0[3], S_##h0[0], S_##h0[1], S_##h0[2], S_##h0[3]}, o[d0], 0, 0, 0); \
        o[d0] = __builtin_amdgcn_mfma_f32_32x32x16_bf16(pa1, (bf16x8){S_##l1[0], S_##l1[1], S_##l1[2], S_##l1[3], S_##h1[0], S_##h1[1], S_##h1[2], S_##h1[3]}, o[d0], 0, 0, 0); } while (0)
#define WL(n) asm volatile("s_waitcnt lgkmcnt(" #n ")" ::: "memory")
    s16x4 Al0, Al1, Ah0, Ah1, Bl0, Bl1, Bh0, Bh1;
    PV_RD(A, 0); SBAR();
    PV_RD(B, 1); WL(4); SBAR(); PV_MM(A, 0); SBAR();
    PV_RD(A, 2); WL(4); SBAR(); PV_MM(B, 1); SBAR();
    PV_RD(B, 3); WL(4); SBAR(); PV_MM(A, 2); SBAR();
    PV_RD(A, 4); WL(4); SBAR(); PV_MM(B, 3); SBAR();
    PV_RD(B, 5); WL(4); SBAR(); PV_MM(A, 4); SBAR();
    PV_RD(A, 6); WL(4); SBAR(); PV_MM(B, 5); SBAR();
    PV_RD(B, 7); WL(4); SBAR(); PV_MM(A, 6); SBAR();
    WL(0); SBAR(); PV_MM(B, 7);
#undef PV_RD
#undef PV_MM
#undef WL
#undef TRRD
}
__device__ __forceinline__ void softmax_half(f32x16& p0, float& m_reg, float& l_reg, float& alpha, bf16x8& pa0, bf16x8& pa1) {
    float pmax = p0[0];
#pragma unroll
    for (int r = 1; r < 16; ++r) pmax = fmaxf(pmax, p0[r]);
    { auto rr = __builtin_amdgcn_permlane32_swap(__float_as_uint(pmax), __float_as_uint(pmax), false, false);
      pmax = fmaxf(__uint_as_float(rr[0]), __uint_as_float(rr[1])); }
    const float mn = (pmax - m_reg <= THR2) ? m_reg : fmaxf(m_reg, pmax);
    alpha = __builtin_amdgcn_exp2f(m_reg - mn); m_reg = mn;
#pragma unroll
    for (int r = 0; r < 16; ++r) p0[r] = __builtin_amdgcn_exp2f(p0[r] - mn);
    float ps = 0.f;
#pragma unroll
    for (int r = 0; r < 16; ++r) ps += p0[r];
    { auto rr = __builtin_amdgcn_permlane32_swap(__float_as_uint(ps), __float_as_uint(ps), false, false);
      ps = __uint_as_float(rr[0]) + __uint_as_float(rr[1]); }
    l_reg = l_reg * alpha + ps;
#define PK4(P, B_, OUT) do { unsigned a0 = cvtpk(P[B_+0], P[B_+1]), a1 = cvtpk(P[B_+2], P[B_+3]); \
        unsigned b0 = cvtpk(P[B_+4], P[B_+5]), b1 = cvtpk(P[B_+6], P[B_+7]); \
        auto r0 = __builtin_amdgcn_permlane32_swap(a0, b0, false, false); auto r1 = __builtin_amdgcn_permlane32_swap(a1, b1, false, false); \
        v4u w = {r0[0], r1[0], r0[1], r1[1]}; OUT = __builtin_bit_cast(bf16x8, w); } while (0)
    PK4(p0, 0, pa0); PK4(p0, 8, pa1);
#undef PK4
}
__device__ __forceinline__ void bias_mask_half(f32x16& p0, int dq, bool far, const LAS float* lut) {
    const float NEG = -__builtin_inff();
    if (far) { const float c = lut[128];
#pragma unroll
        for (int r = 0; r < 16; ++r) p0[r] += c;
    } else {
#pragma unroll
        for (int r = 0; r < 16; ++r) { const int c = (r & 3) + 8 * (r >> 2); const int d0 = dq - c;
            const float b0 = lut[min(max(d0, 0), 128)]; p0[r] = (d0 >= 0) ? p0[r] + b0 : NEG; }
    }
}
#define RESC(o_, nd_, al_l_, alpha_) do { if (__any((alpha_) < 1.f)) { if (hi == 0) (al_l_)[r32] = (alpha_); asm volatile("s_waitcnt lgkmcnt(0)" ::: "memory"); \
        _Pragma("unroll") for (int r = 0; r < 16; ++r) { const float f_ = (al_l_)[crow(r, hi)]; _Pragma("unroll") for (int d_ = 0; d_ < (nd_); ++d_) (o_)[d_][r] *= f_; } } } while (0)

template <int MODE, bool F8OUT = false>
__device__ __forceinline__ void attn128_unit(LAS unsigned char* lds, const bf16* Qrow0, const bf16* Kh, const bf16* Vh, bf16* Orow0, int NT, int qb, const unsigned* selrow, const float* relb, int h) {
    const int tid = opaque_tid(), wid = __builtin_amdgcn_readfirstlane(tid >> 6), lane = tid & 63, r32 = lane & 31, hi = lane >> 5;
    LAS float* wsf = (LAS float*)(lds + LDSX_OFF) + wid * 64; LAS float* li_l = wsf; LAS float* al_l = wsf + 32;
    LAS float* lut = (LAS float*)(lds + LDSX_OFF + 2048);
    if (MODE == 0 && tid <= 128) lut[tid] = relb[(tid < 128 ? (int)T5_BUCKET[tid] : 31) * 12 + h] * LOG2E;
    bf16x8 qr[8];
#pragma unroll
    for (int d0 = 0; d0 < 8; ++d0) qr[d0] = *(const bf16x8*)(Qrow0 + (size_t)(wid * 32 + r32) * DM + d0 * 16 + hi * 8);
    unsigned sel = 0u; if (MODE == 0) sel = selrow[wid * 32 + r32];
    const int krow = 4 * wid + (lane >> 4); const unsigned ksrc = (unsigned) krow * 256 + ((16 * (lane & 15)) ^ ((krow & 7) << 4));
    const int vkk = 8 * (wid >> 1) + ((lane & 31) >> 2); const unsigned vsrc = (unsigned) swap23(vkk) * 256 + (32 * (2 * (wid & 1) + (lane >> 5)) + 8 * (lane & 3)) * 2;
    const unsigned lds0 = (unsigned)(uintptr_t)(lds + RING_OFF);
    const char* Kg = (const char*)Kh; const char* Vg = (const char*)Vh;
#define ISSUE(t, s) do { const unsigned base_ = (unsigned)__builtin_amdgcn_readfirstlane(lds0 + (s) * 32768 + wid * 1024); const size_t tb_ = (size_t)(t) * SHM_T; \
        glds16(Kg + tb_, ksrc, base_); glds16(Kg + tb_ + 8192, ksrc, base_ + 8192); glds16(Vg + tb_, vsrc, base_ + SHM_T); glds16(Vg + tb_ + 8192, vsrc, base_ + SHM_T + 8192); } while (0)
    const int vb0 = (int)lds0 + SHM_T + v_rd_base(lane);
    float m_reg = -1e30f, l_reg = 0.f; f32x16 o[4];
#pragma unroll
    for (int d = 0; d < 4; ++d)
#pragma unroll
        for (int r = 0; r < 16; ++r) o[d][r] = 0.f;
    const int q0w = qb * 256 + wid * 32, qpos = q0w + r32;
    ISSUE(0, 0);
    for (int t = 0; t < NT; ++t) {
        WAIT_BAR0();
        if (t + 1 < NT) ISSUE(t + 1, (t + 1) & 1);
        const int s = t & 1;
        f32x16 p0, p1;
        qkt(p0, p1, (const LAS char*)(lds + RING_OFF + s * 32768), r32, hi, qr);
        if (MODE == 0) { const int jb = t >> 2, tk0 = t * 64; const bool on = (jb >= qb) || ((sel >> jb) & 1u); const bool far = (q0w - (tk0 + 63)) >= 128;
            bias_mask_tile(p0, p1, qpos - tk0 - 4 * hi, on, far, lut); }
        float alpha; bf16x8 pa0, pa1, pa2, pa3;
        softmax_tile(p0, p1, m_reg, l_reg, alpha, pa0, pa1, pa2, pa3);
        RESC(o, 4, al_l, alpha);
        pv_tile(o, vb0 + s * 32768, pa0, pa1, pa2, pa3);
    }
#undef ISSUE
    if (hi == 0) li_l[r32] = l_reg; asm volatile("s_waitcnt lgkmcnt(0)" ::: "memory");
    int r32o = r32, hio = hi; asm volatile("" : "+v"(r32o), "+v"(hio));
    bf16* Ow = Orow0 + (size_t)(wid * 32) * DM + r32o;
#pragma unroll
    for (int r = 0; r < 16; ++r) { const int orow = crow(r, hio); const float rli = __builtin_amdgcn_rcpf(li_l[orow]);
#pragma unroll
        for (int d0 = 0; d0 < 4; ++d0) { const float v = o[d0][r] * rli; const float vn = swz_xor<1>(v);
            if (F8OUT) { if ((r32 & 1) == 0) *(unsigned short*)((unsigned char*)Orow0 + (size_t)(wid * 32 + orow) * DM + d0 * 32 + r32o) = (unsigned short)__builtin_amdgcn_cvt_pk_fp8_f32(v * SC_O, vn * SC_O, 0u, false); }
            else if ((r32 & 1) == 0) *(unsigned*)(Ow + (size_t)orow * DM + d0 * 32) = cvtpk(v, vn); } }
    WAIT_BAR0();
}

#define PK4X(P, B_, OUT) do { unsigned a0 = cvtpk(P[B_+0], P[B_+1]), a1 = cvtpk(P[B_+2], P[B_+3]); unsigned b0 = cvtpk(P[B_+4], P[B_+5]), b1 = cvtpk(P[B_+6], P[B_+7]); \
        auto r0 = __builtin_amdgcn_permlane32_swap(a0, b0, false, false); auto r1 = __builtin_amdgcn_permlane32_swap(a1, b1, false, false); v4u w = {r0[0], r1[0], r0[1], r1[1]}; OUT = __builtin_bit_cast(bf16x8, w); } while (0)
template <int VAR>
__device__ __forceinline__ void diff_unit(LAS unsigned char* lds, const bf16* Qrow0  , const bf16* K1h, const bf16* K2h, const bf16* Vh, bf16* Orow0  ,
                                          int qblk, const float* relb, int h, float lam, const float* subln) {
    const int tid = opaque_tid(), wid = __builtin_amdgcn_readfirstlane(tid >> 6), lane = tid & 63, r32 = lane & 31, hi = lane >> 5, mp = wid >> 2, w4 = wid & 3;
    LAS float* wsf = (LAS float*)(lds + LDSX_OFF) + wid * 64; LAS float* li_l = wsf; LAS float* al_l = wsf + 32;
    LAS float* lut2 = (LAS float*)(lds + LDSX_OFF + 2048);
    if (tid < 2 * 132) { const int m_ = tid / 132, i_ = tid % 132; if (i_ <= 128) lut2[tid] = relb[(i_ < 128 ? (int)T5_BUCKET[i_] : 31) * 12 + 2 * h + m_] * LOG2E; }
    const LAS float* lut = lut2 + mp * 132;
    bf16x8 qr[8];
#pragma unroll
    for (int d0 = 0; d0 < 8; ++d0) qr[d0] = *(const bf16x8*)(Qrow0 + (size_t)(w4 * 32 + r32) * DM + (h + 6 * mp) * HD + d0 * 16 + hi * 8);
    const int krow = 4 * wid + (lane >> 4); const unsigned ksrc = (unsigned) krow * 256 + ((16 * (lane & 15)) ^ ((krow & 7) << 4));
    const int vkk = 8 * (wid >> 1) + ((lane & 31) >> 2); const unsigned vsrc = (unsigned) swap23(vkk) * 512 + (32 * (2 * (wid & 1) + (lane >> 5)) + 8 * (lane & 3)) * 2;
    const unsigned lds0 = (unsigned)(uintptr_t)(lds + RING_OFF);
    const char* K1g = (const char*)K1h; const char* K2g = (const char*)K2h; const char* Vg = (const char*)Vh;
#define ISSUE(t, s) do { const unsigned base_ = (unsigned)__builtin_amdgcn_readfirstlane(lds0 + (s) * 65536 + wid * 1024); const size_t tb_ = (size_t)(t) * SHM_T; \
        glds16(K1g + tb_, ksrc, base_); glds16(K1g + tb_ + 8192, ksrc, base_ + 8192); glds16(K2g + tb_, ksrc, base_ + SHM_T); glds16(K2g + tb_ + 8192, ksrc, base_ + SHM_T + 8192); \
        glds16(Vg + 2 * tb_, vsrc, base_ + 2 * SHM_T); glds16(Vg + 2 * tb_ + 16384, vsrc, base_ + 2 * SHM_T + 8192); \
        glds16(Vg + 2 * tb_ + 256, vsrc, base_ + 3 * SHM_T); glds16(Vg + 2 * tb_ + 256 + 16384, vsrc, base_ + 3 * SHM_T + 8192); } while (0)
#define ISSUE_K(t, s) do { const unsigned base_ = (unsigned)__builtin_amdgcn_readfirstlane(lds0 + (s) * 65536 + wid * 1024); const size_t tb_ = (size_t)(t) * SHM_T; \
        glds16(K1g + tb_, ksrc, base_); glds16(K1g + tb_ + 8192, ksrc, base_ + 8192); glds16(K2g + tb_, ksrc, base_ + SHM_T); glds16(K2g + tb_ + 8192, ksrc, base_ + SHM_T + 8192); } while (0)
#define ISSUE_V(t, s) do { const unsigned base_ = (unsigned)__builtin_amdgcn_readfirstlane(lds0 + (s) * 65536 + wid * 1024); const size_t tb_ = (size_t)(t) * SHM_T; \
        glds16(Vg + 2 * tb_, vsrc, base_ + 2 * SHM_T); glds16(Vg + 2 * tb_ + 16384, vsrc, base_ + 2 * SHM_T + 8192); \
        glds16(Vg + 2 * tb_ + 256, vsrc, base_ + 3 * SHM_T); glds16(Vg + 2 * tb_ + 256 + 16384, vsrc, base_ + 3 * SHM_T + 8192); } while (0)
    const int vb0 = (int)lds0 + 2 * SHM_T + v_rd_base(lane);
    float m_reg = -1e30f, l_reg = 0.f; f32x16 o[8];
#pragma unroll
    for (int d = 0; d < 8; ++d)
#pragma unroll
        for (int r = 0; r < 16; ++r) o[d][r] = 0.f;
    const int q0w = qblk * 128 + w4 * 32, qpos = q0w + r32, NT = 2 * (qblk + 1);
    if (!(VAR & 1)) ISSUE(0, 0);
    for (int t = 0; t < NT; ++t) {
        WAIT_BAR0();
        if (!(VAR & 1)) if (t + 1 < NT) ISSUE(t + 1, (t + 1) & 1);
        const int s = t & 1, tk0 = t * 64;
        if (VAR & 2) continue;
        const bool far = (q0w - (tk0 + 63)) >= 128;
        { f32x16 p; float alpha; bf16x8 pa0, pa1;
          qkt_half(p, (const LAS char*)(lds + RING_OFF + s * 65536 + mp * SHM_T), r32, hi, qr);
          bias_mask_half(p, qpos - tk0 - 4 * hi, far, lut);
          if (VAR & 4) { alpha = 1.f; l_reg += p[0]; PK4X(p, 0, pa0); PK4X(p, 8, pa1); } else { softmax_half(p, m_reg, l_reg, alpha, pa0, pa1);
          RESC(o, 8, al_l, alpha); }
          pv_half8<0>(o, vb0 + s * 65536, pa0, pa1); }
        SBAR();
        { f32x16 p; float alpha; bf16x8 pa0, pa1;
          qkt_half(p, (const LAS char*)(lds + RING_OFF + s * 65536 + mp * SHM_T + 32 * 256), r32, hi, qr);
          bias_mask_half(p, qpos - tk0 - 32 - 4 * hi, far, lut);
          if (VAR & 4) { alpha = 1.f; l_reg += p[0]; PK4X(p, 0, pa0); PK4X(p, 8, pa1); } else { softmax_half(p, m_reg, l_reg, alpha, pa0, pa1);
          RESC(o, 8, al_l, alpha); }
          pv_half8<1>(o, vb0 + s * 65536, pa0, pa1); }
        SBAR();
    }
#undef ISSUE
#undef ISSUE_K
#undef ISSUE_V
    if (hi == 0) li_l[r32] = l_reg;
    WAIT_BAR0();
    int laneo = lane; asm volatile("" : "+v"(laneo));
    LAS float* X = (LAS float*)(lds + RING_OFF) + (w4 * 8 * 16 * 64 + laneo);
    if (mp == 1) {
#pragma unroll
        for (int r = 0; r < 16; ++r) { const float f = lam * __builtin_amdgcn_rcpf(li_l[crow(r, hi)]);
#pragma unroll
            for (int d0 = 0; d0 < 8; ++d0) X[(d0 * 16 + r) * 64] = o[d0][r] * f; }
    }
    WAIT_BAR0();
    if (mp == 0) {
        int r32o = r32, hio = hi; asm volatile("" : "+v"(r32o), "+v"(hio));
        unsigned char* Ow = (unsigned char*)Orow0 + (size_t)(w4 * 32) * DM + r32o; const float* sg = subln + r32o;
#pragma unroll
        for (int r = 0; r < 16; ++r) { const float rli = __builtin_amdgcn_rcpf(li_l[crow(r, hi)]); float ss = 0.f;
#pragma unroll
            for (int d0 = 0; d0 < 8; ++d0) { const float v = o[d0][r] * rli - X[(d0 * 16 + r) * 64]; o[d0][r] = v; ss += v * v; }
            ss += swz_xor<1>(ss); ss += swz_xor<2>(ss); ss += swz_xor<4>(ss); ss += swz_xor<8>(ss); ss += swz_xor<16>(ss);
            const float rs = (1.0f / sqrtf(ss * (1.f / DV) + RMS_EPS)) * (1.f - LAM_INIT); const int orow = crow(r, hio);
#pragma unroll
            for (int d0 = 0; d0 < 8; ++d0) { const float v = o[d0][r] * rs * sg[d0 * 32]; const float vn = swz_xor<1>(v);
                if ((r32 & 1) == 0) *(unsigned short*)(Ow + (size_t)orow * DM + d0 * 32) = (unsigned short)__builtin_amdgcn_cvt_pk_fp8_f32(v * SC_O, vn * SC_O, 0u, false); } }
    }
    WAIT_BAR0();
}

__device__ __forceinline__ void moba_sparse_unit(LAS unsigned char* lds, const bf16* QHb, const bf16* Kblk, const bf16* Vblk, const unsigned* listF, int cntF, const unsigned* listA, int cntA, int j,
                                                 bf16* PO, float* PM, const float* relb, int h) {
    const int tid = opaque_tid(), wid = __builtin_amdgcn_readfirstlane(tid >> 6), lane = tid & 63, r32 = lane & 31, hi = lane >> 5;
    LAS float* wsf = (LAS float*)(lds + LDSX_OFF) + wid * 64; LAS float* li_l = wsf; LAS float* al_l = wsf + 32;
    LAS float* lut = (LAS float*)(lds + LDSX_OFF + 2048);
    if (tid <= 128) lut[tid] = relb[(tid < 128 ? (int)T5_BUCKET[tid] : 31) * 12 + h] * LOG2E;
    const int krow = 4 * wid + (lane >> 4); const unsigned ksrc = (unsigned) krow * 256 + ((16 * (lane & 15)) ^ ((krow & 7) << 4));
    const int vkk = 8 * (wid >> 1) + ((lane & 31) >> 2); const unsigned vsrc = (unsigned) swap23(vkk) * 256 + (32 * (2 * (wid & 1) + (lane >> 5)) + 8 * (lane & 3)) * 2;
    const unsigned lds0 = (unsigned)(uintptr_t)(lds + RING_OFF);
    const char* Kg = (const char*)Kblk; const char* Vg = (const char*)Vblk;
    { const unsigned base_ = (unsigned)__builtin_amdgcn_readfirstlane(lds0 + wid * 1024);
#pragma unroll
      for (int t = 0; t < 4; ++t) { glds16(Kg + t * SHM_T, ksrc, base_ + t * SHM_T); glds16(Kg + t * SHM_T + 8192, ksrc, base_ + t * SHM_T + 8192);
                                    glds16(Vg + t * SHM_T, vsrc, base_ + 65536 + t * SHM_T); glds16(Vg + t * SHM_T + 8192, vsrc, base_ + 65536 + t * SHM_T + 8192); } }
    const int vb0 = (int)lds0 + 65536 + v_rd_base(lane);
    const int gF = (cntF + 31) >> 5, ng = gF + ((cntA + 31) >> 5);
    const float c31 = relb[31 * 12 + h] * LOG2E;
#define GRP_ENT(g_, ent_, val_) do { const bool fr_ = (g_) < gF; const int b0_ = fr_ ? (g_) * 32 : ((g_) - gF) * 32; const int n_ = fr_ ? cntF : cntA; const unsigned* l_ = fr_ ? listF : listA; \
        val_ = (b0_ + r32) < n_; ent_ = l_[val_ ? b0_ + r32 : b0_]; } while (0)
#define LOADQ(dst_, ent_) do { const bf16* qp_ = QHb + (size_t)((ent_) & 0xffffu) * DM + hi * 8; _Pragma("unroll") for (int d0 = 0; d0 < 8; ++d0) dst_[d0] = *(const bf16x8*)(qp_ + d0 * 16); } while (0)
    int g = wid; unsigned ent = 0u, entn = 0u; bool valid = false, validn = false; bf16x8 qr[8], qn[8];
    if (g < ng) { GRP_ENT(g, ent, valid); LOADQ(qr, ent); }
    if (g + 8 < ng) GRP_ENT(g + 8, entn, validn);
    WAIT_BAR0();
    for (; g < ng; g += 8) {
        const bool adj = g >= gF;
        unsigned entnn = 0u; bool validnn = false;
        if (g + 8 < ng) LOADQ(qn, entn);
        if (g + 16 < ng) GRP_ENT(g + 16, entnn, validnn);
        const int srow = (int)(ent & 0xffffu), slot = (int)(ent >> 16);
        float m_reg = -1e30f, l_reg = 0.f; f32x16 o[4];
#pragma unroll
        for (int d = 0; d < 4; ++d)
#pragma unroll
            for (int r = 0; r < 16; ++r) o[d][r] = 0.f;
#pragma unroll 1
        for (int t = 0; t < 4; ++t) {
            f32x16 p0, p1;
            qkt(p0, p1, (const LAS char*)(lds + RING_OFF + t * SHM_T), r32, hi, qr);
            if (adj) bias_mask_tile(p0, p1, srow - (j * 256 + t * 64) - 4 * hi, true, false, lut);
            float alpha; bf16x8 pa0, pa1, pa2, pa3;
            softmax_tile(p0, p1, m_reg, l_reg, alpha, pa0, pa1, pa2, pa3);
            RESC(o, 4, al_l, alpha);
            pv_tile(o, vb0 + t * SHM_T, pa0, pa1, pa2, pa3);
        }
        LAS int* rd = (LAS int*)al_l;
        const int rec = srow * 3 + slot;
        if (hi == 0) { li_l[r32] = l_reg; rd[r32] = valid ? rec : -1;
            if (valid) { PM[(size_t)rec * 2] = m_reg + (adj ? 0.f : c31); PM[(size_t)rec * 2 + 1] = l_reg; } }
        asm volatile("s_waitcnt lgkmcnt(0)" ::: "memory");
        int r32o = r32, hio = hi; asm volatile("" : "+v"(r32o), "+v"(hio));
#pragma unroll
        for (int r = 0; r < 16; ++r) { const int orow = crow(r, hio); const float rli = __builtin_amdgcn_rcpf(li_l[orow]); const int dst = rd[orow];
#pragma unroll
            for (int d0 = 0; d0 < 4; ++d0) { const float v = o[d0][r] * rli; const float vn = swz_xor<1>(v);
                if ((r32 & 1) == 0 && dst >= 0) *(unsigned*)(PO + (size_t)dst * HD + d0 * 32 + r32o) = cvtpk(v, vn); } }
        asm volatile("s_waitcnt lgkmcnt(0)" ::: "memory");
#pragma unroll
        for (int d0 = 0; d0 < 8; ++d0) qr[d0] = qn[d0];
        ent = entn; valid = validn; entn = entnn; validn = validnn;
    }
#undef GRP_ENT
#undef LOADQ
    WAIT_BAR0();
}

__device__ __forceinline__ void moba_final_unit(LAS unsigned char* lds, const bf16* Qrow0, const bf16* Kh, const bf16* Vh, bf16* Orow0, int qb, const unsigned* selrow, const float* relb, int h, const bf16* PO, const float* PM) {
    const int tid = opaque_tid(), wid = __builtin_amdgcn_readfirstlane(tid >> 6), lane = tid & 63, r32 = lane & 31, hi = lane >> 5;
    LAS float* wsf = (LAS float*)(lds + LDSX_OFF) + wid * 64; LAS float* al_l = wsf + 32;
    LAS float* lut = (LAS float*)(lds + LDSX_OFF + 2048);
    LAS float* ftab = (LAS float*)(lds + LDSX_OFF + 4352) + wid * 128;
    if (tid <= 128) lut[tid] = relb[(tid < 128 ? (int)T5_BUCKET[tid] : 31) * 12 + h] * LOG2E;
    bf16x8 qr[8];
#pragma unroll
    for (int d0 = 0; d0 < 8; ++d0) qr[d0] = *(const bf16x8*)(Qrow0 + (size_t)(wid * 32 + r32) * DM + d0 * 16 + hi * 8);
    const unsigned sel = selrow[wid * 32 + r32];
    const int krow = 4 * wid + (lane >> 4); const unsigned ksrc = (unsigned) krow * 256 + ((16 * (lane & 15)) ^ ((krow & 7) << 4));
    const int vkk = 8 * (wid >> 1) + ((lane & 31) >> 2); const unsigned vsrc = (unsigned) swap23(vkk) * 256 + (32 * (2 * (wid & 1) + (lane >> 5)) + 8 * (lane & 3)) * 2;
    const unsigned lds0 = (unsigned)(uintptr_t)(lds + RING_OFF);
    const char* Kg = (const char*)(Kh + (size_t)qb * 256 * HD); const char* Vg = (const char*)(Vh + (size_t)qb * 256 * HD);
    { const unsigned base_ = (unsigned)__builtin_amdgcn_readfirstlane(lds0 + wid * 1024);
#pragma unroll
      for (int t = 0; t < 4; ++t) { glds16(Kg + t * SHM_T, ksrc, base_ + t * SHM_T); glds16(Kg + t * SHM_T + 8192, ksrc, base_ + t * SHM_T + 8192);
                                    glds16(Vg + t * SHM_T, vsrc, base_ + 65536 + t * SHM_T); glds16(Vg + t * SHM_T + 8192, vsrc, base_ + 65536 + t * SHM_T + 8192); } }
    const int vb0 = (int)lds0 + 65536 + v_rd_base(lane);
    float m_reg = -1e30f, l_reg = 0.f; f32x16 o[4];
#pragma unroll
    for (int d = 0; d < 4; ++d)
#pragma unroll
        for (int r = 0; r < 16; ++r) o[d][r] = 0.f;
    const int qrel = wid * 32 + r32;
    WAIT_BAR0();
#pragma unroll 1
    for (int t = 0; t <= (wid >> 1); ++t) {
        f32x16 p0, p1;
        qkt(p0, p1, (const LAS char*)(lds + RING_OFF + t * SHM_T), r32, hi, qr);
        bias_mask_tile(p0, p1, qrel - t * 64 - 4 * hi, true, false, lut);
        float alpha; bf16x8 pa0, pa1, pa2, pa3;
        softmax_tile(p0, p1, m_reg, l_reg, alpha, pa0, pa1, pa2, pa3);
        RESC(o, 4, al_l, alpha);
        pv_tile(o, vb0 + t * SHM_T, pa0, pa1, pa2, pa3);
    }
    const int nsel = __builtin_popcount(sel); const size_t rec0 = (size_t)(qb * 256 + qrel) * 3;
    float mi[3], li[3]; float M = m_reg;
#pragma unroll
    for (int i = 0; i < 3; ++i) { mi[i] = -1e30f; li[i] = 0.f; if (i < nsel) { mi[i] = PM[(rec0 + i) * 2]; li[i] = PM[(rec0 + i) * 2 + 1]; } M = fmaxf(M, mi[i]); }
    const float wo = __builtin_amdgcn_exp2f(m_reg - M); float L = l_reg * wo; float wi[3];
#pragma unroll
    for (int i = 0; i < 3; ++i) { wi[i] = (i < nsel) ? li[i] * __builtin_amdgcn_exp2f(mi[i] - M) : 0.f; L += wi[i]; }
    const float rL = 1.f / L;
    if (hi == 0) { ftab[r32] = wo * rL; ftab[32 + r32] = wi[0] * rL; ftab[64 + r32] = wi[1] * rL; ftab[96 + r32] = wi[2] * rL; }
    WAIT_BAR0();
    int r32o = r32, hio = hi, laneo = lane; asm volatile("" : "+v"(r32o), "+v"(hio), "+v"(laneo));
    LAS float* X = (LAS float*)(lds + RING_OFF) + wid * 4096;
#pragma unroll
    for (int r = 0; r < 16; ++r) { const int orow = crow(r, hio); const float fo = ftab[orow];
#pragma unroll
        for (int d0 = 0; d0 < 4; ++d0) X[orow * 128 + d0 * 32 + r32o] = o[d0][r] * fo; }
    asm volatile("s_waitcnt lgkmcnt(0)" ::: "memory");
    { const int rg = laneo >> 4, c = laneo & 15;
      unsigned char* Ow = (unsigned char*)Orow0 + (size_t)(wid * 32) * DM + 8 * c;
      const bf16* Pw = PO + ((size_t)(qb * 256 + wid * 32) * 3) * HD + 8 * c;
#pragma unroll 2
      for (int it = 0; it < 8; ++it) { const int row = it * 4 + rg;
          const f32x4 x0 = *(const LAS f32x4*)(X + row * 128 + 8 * c), x1 = *(const LAS f32x4*)(X + row * 128 + 8 * c + 4);
          float v[8] = {x0[0], x0[1], x0[2], x0[3], x1[0], x1[1], x1[2], x1[3]};
#pragma unroll
          for (int i = 0; i < 3; ++i) { const float f = ftab[32 * (i + 1) + row];
              if (f != 0.f) { const v4u w = *(const v4u*)(Pw + ((size_t)row * 3 + i) * HD);
                  v[0] += f * bflo(w.x); v[1] += f * bfhi(w.x); v[2] += f * bflo(w.y); v[3] += f * bfhi(w.y); v[4] += f * bflo(w.z); v[5] += f * bfhi(w.z); v[6] += f * bflo(w.w); v[7] += f * bfhi(w.w); } }
          unsigned w0 = 0u, w1 = 0u;
          w0 = __builtin_amdgcn_cvt_pk_fp8_f32(v[0] * SC_O, v[1] * SC_O, w0, false); w0 = __builtin_amdgcn_cvt_pk_fp8_f32(v[2] * SC_O, v[3] * SC_O, w0, true);
          w1 = __builtin_amdgcn_cvt_pk_fp8_f32(v[4] * SC_O, v[5] * SC_O, w1, false); w1 = __builtin_amdgcn_cvt_pk_fp8_f32(v[6] * SC_O, v[7] * SC_O, w1, true);
          *(v2u*)(Ow + (size_t)row * DM) = (v2u){w0, w1}; } }
    WAIT_BAR0();
}
#undef RESC
}

__device__ __forceinline__ int queue_next(gu32* ctr, LAS unsigned char* lds) {
    volatile LAS int* slot = (volatile LAS int*)(lds + LDSX_OFF + 4096);
    if (threadIdx.x == 0) slot[0] = (int)__hip_atomic_fetch_add(ctr, 1u, RLX_AGENT);
    __syncthreads();
    return __builtin_amdgcn_readfirstlane(slot[0]);
}

template <int PV>
__device__ __forceinline__ void phase_moba_sparse(const Args& a, LAS unsigned char* lds, gu32* qctr) {
    unsigned char* ws = opaque_ws(a.ws);
    const bf16* QH = (const bf16*)(ws + WS_QH); const bf16* KH = (const bf16*)(ws + WS_KH); const bf16* VH = (const bf16*)(ws + WS_VH);
    const unsigned* MC = (const unsigned*)(ws + WS_CTL) + CW_MC;
    for (;;) {
        const int uq = queue_next(qctr, lds);
        if (uq >= 744 + CONV_SP) break;
        const Mix mx = mix_decode(uq, 744, CONV_SP);
        if (mx.conv) { if (!(PV & 1)) conv_chunk(a, lds, 0, CONV_IN + mx.idx); else __syncthreads(); continue; }
        const int u = mx.idx;
        if (PV & 2) { __syncthreads(); continue; }
        const int j = u / 24, bh = u % 24, b = bh / 12, h = bh % 12;
        const int cntA = (int)MC[(bh * 32 + j) * 2], cntF = (int)MC[(bh * 32 + j) * 2 + 1];
        const bf16* QHb = QH + (size_t)b * SEQ * DM + h * HD; const bf16* Kblk = KH + ((size_t)bh * SEQ + j * 256) * HD; const bf16* Vblk = VH + ((size_t)bh * SEQ + j * 256) * HD;
        bf16* PO = (bf16*)(ws + WS_PO) + (size_t)bh * SEQ * 3 * HD; float* PM = (float*)(ws + WS_PM) + (size_t)bh * SEQ * 3 * 2;
        att::moba_sparse_unit(lds, QHb, Kblk, Vblk, (const unsigned*)(ws + WS_LISTF) + ((size_t)bh * 32 + j) * 8192, cntF, (const unsigned*)(ws + WS_LISTA) + ((size_t)bh * 32 + j) * 256, cntA, j, PO, PM, a.in[I_RELB], h);
    }
}
__device__ __forceinline__ void phase_attn_a(const Args& a, LAS unsigned char* lds, gu32* qctr) {
    unsigned char* ws = opaque_ws(a.ws);
    const bf16* QH = (const bf16*)(ws + WS_QH); const bf16* KH = (const bf16*)(ws + WS_KH); const bf16* VH = (const bf16*)(ws + WS_VH); bf16* OC = (bf16*)(ws + WS_OCAT);
    const unsigned* SEL = (const unsigned*)(ws + WS_SMALL + SM_SEL);
    for (;;) {
        const int uq = queue_next(qctr, lds);
        if (uq >= 768 + 256 + (CONV_NCH - CONV_IN - CONV_SP)) break;
        const Mix mx = mix_decode(uq, 768 + 256, CONV_NCH - CONV_IN - CONV_SP);
        if (mx.conv) { conv_chunk(a, lds, 0, CONV_IN + CONV_SP + mx.idx); continue; }
        const int u = mx.idx;
        if (u < 768) { const int qb = 31 - u / 24, bh = u % 24, b = bh / 12, h = bh % 12; const size_t row0 = (size_t)b * SEQ + qb * 256;
            att::moba_final_unit(lds, QH + row0 * DM + h * HD, KH + (size_t)bh * SEQ * HD, VH + (size_t)bh * SEQ * HD, (bf16*)((unsigned char*)OC + row0 * DM + h * HD), qb,
                                 SEL + (size_t)bh * SEQ + qb * 256, a.in[I_RELB], h, (const bf16*)(ws + WS_PO) + (size_t)bh * SEQ * 3 * HD, (const float*)(ws + WS_PM) + (size_t)bh * SEQ * 3 * 2);
        } else { const int v = u - 768, b = v >> 7, hm = (v >> 5) & 3, qb = v & 31; const size_t row0 = (size_t)b * SEQ + qb * 256;
            const size_t mo = (size_t)((0 * 2 + b) * 4 + hm) * NMEM * HD;
            att::attn128_unit<1, true>(lds, QH + row0 * DM + (12 + hm) * HD, (const bf16*)(ws + WS_SMALL + SM_KM) + mo, (const bf16*)(ws + WS_SMALL + SM_VM) + mo, (bf16*)((unsigned char*)OC + row0 * DM + MIXW + hm * HD), 4, 0, nullptr, nullptr, 0);
        }
    }
}
template <int VAR>
__device__ __forceinline__ void phase_attn_b(const Args& a, LAS unsigned char* lds, gu32* qctr, bf16* OC) {
    unsigned char* ws = opaque_ws(a.ws);
    const bf16* QH = (const bf16*)(ws + WS_QH); const bf16* KH = (const bf16*)(ws + WS_KH); const bf16* VH = (const bf16*)(ws + WS_VH);
    float lam;
    { const float* lb = a.in[I_LAMBDA]; const int lane = opaque_tid() & 63;
      float s1 = lb[lane] * lb[128 + lane] + lb[64 + lane] * lb[128 + 64 + lane], s2 = lb[256 + lane] * lb[384 + lane] + lb[256 + 64 + lane] * lb[384 + 64 + lane];
      s1 = wave_sum(s1); s2 = wave_sum(s2); lam = expf(s1) - expf(s2) + LAM_INIT; }
    for (;;) {
        const int uq = queue_next(qctr, lds);
        if (uq >= 768 + 256 + CONV_NCH) break;
        const Mix mx = mix_decode(uq, 768 + 256, CONV_NCH);
        if (mx.conv) { if (!(VAR & 8)) conv_chunk(a, lds, 1, mx.idx); else __syncthreads(); continue; }
        const int u = mx.idx;
        if (u < 768) { const int qblk = 63 - u / 12, bh = u % 12, b = bh / 6, h = bh % 6; const size_t row0 = (size_t)b * SEQ + qblk * 128;
            att::diff_unit<VAR>(lds, QH + row0 * DM, KH + (size_t)(b * 12 + h) * SEQ * HD, KH + (size_t)(b * 12 + 6 + h) * SEQ * HD, VH + (size_t)(b * 6 + h) * SEQ * DV, (bf16*)((unsigned char*)OC + row0 * DM + h * DV),
                           qblk, a.in[I_RELB], h, lam, a.in[I_SUBLN]);
        } else { const int v = u - 768, b = v >> 7, hm = (v >> 5) & 3, qb = v & 31; const size_t row0 = (size_t)b * SEQ + qb * 256;
            const size_t mo = (size_t)((1 * 2 + b) * 4 + hm) * NMEM * HD;
            att::attn128_unit<1, true>(lds, QH + row0 * DM + (12 + hm) * HD, (const bf16*)(ws + WS_SMALL + SM_KM) + mo, (const bf16*)(ws + WS_SMALL + SM_VM) + mo, (bf16*)((unsigned char*)OC + row0 * DM + MIXW + hm * HD), 4, 0, nullptr, nullptr, 0);
        }
    }
}

template <int RV>
__device__ __forceinline__ void phase_router(const Args& a, LAS unsigned char* lds, int G, int vb, int layer) {
    unsigned char* ws = opaque_ws(a.ws);
    const int tid = opaque_tid(), lane = tid & 63, wave = __builtin_amdgcn_readfirstlane(tid >> 6), i16 = lane & 15, g4 = lane >> 4, tg = wave & 1, kq = wave >> 1;
    const bf16* H = (const bf16*)(ws + WS_HB);
    const bf16* WRh = (const bf16*)(ws + WS_W_RT) + (size_t)layer * 2 * NRTP * DM;
    LAS float* L = (LAS float*)(lds + RING_OFF);
    LAS int* cnt = (LAS int*)(lds + RING_OFF + 4 * 64 * NRTP * 4);
    for (int blk = vb; blk < T / 64; blk += G) {
        if (tid < 64) cnt[tid] = 0;
        f32x4 acc[2][5];
#pragma unroll
        for (int t2 = 0; t2 < 2; ++t2)
#pragma unroll
            for (int j = 0; j < 5; ++j) acc[t2][j] = (f32x4){0.f, 0.f, 0.f, 0.f};
        const bf16* hrow = H + (size_t)(blk * 64 + tg * 32 + i16) * DM + kq * 512 + 8 * g4;
        const bf16* wh = WRh + (size_t)i16 * DM + kq * 512 + 8 * g4;
#pragma unroll 4
        for (int ks = 0; ks < ((RV & 1) ? 0 : 16); ++ks) {
            bf16x8 fa[2];
#pragma unroll
            for (int t2 = 0; t2 < 2; ++t2) fa[t2] = *(const bf16x8*)(hrow + (size_t)t2 * 16 * DM + ks * 32);
#pragma unroll
            for (int jt = 0; jt < 5; ++jt) {
                const bf16x8 bh = *(const bf16x8*)(wh + (size_t)jt * 16 * DM + ks * 32);
#pragma unroll
                for (int t2 = 0; t2 < 2; ++t2) acc[t2][jt] = __builtin_amdgcn_mfma_f32_16x16x32_bf16(fa[t2], bh, acc[t2][jt], 0, 0, 0);
            }
        }
#pragma unroll
        for (int t2 = 0; t2 < 2; ++t2)
#pragma unroll
            for (int jt = 0; jt < 5; ++jt)
#pragma unroll
                for (int r = 0; r < 4; ++r) L[(kq * 64 + tg * 32 + t2 * 16 + 4 * g4 + r) * NRTP + jt * 16 + i16] = acc[t2][jt][r];
        __syncthreads();
        if (tid < 64 && !(RV & 2)) {
            const int tok = blk * 64 + tid;
            const float* part = (const float*)(ws + WS_SMALL + SM_PART) + (size_t)tok * 32;
            float ss = 0.f;
#pragma unroll
            for (int i = 0; i < 32; ++i) ss += part[i];
            const float rstd = 1.0f / sqrtf(ss * (1.f / DM) + RMS_EPS);
            const LAS float* l0 = L + tid * NRTP;
            const float* brg = a.in[I_B_RG] + layer * 8; const float* bre = a.in[I_B_RE] + layer * 64;
            float gmax = -__builtin_inff(); int gi = 0; float gl[8];
#pragma unroll
            for (int j = 0; j < 8; ++j) { gl[j] = ((l0[j] + l0[64 * NRTP + j]) + (l0[128 * NRTP + j] + l0[192 * NRTP + j])) * rstd + brg[j]; if (gl[j] > gmax) { gmax = gl[j]; gi = j; } }
            float gs = 0.f;
#pragma unroll
            for (int j = 0; j < 8; ++j) gs += expf(gl[j] - gmax);
            const float pg = 1.f / gs;
            float v0 = -__builtin_inff(), v1 = -__builtin_inff(); int i0 = 0, i1 = 0;
#pragma unroll
            for (int j = 0; j < 8; ++j) { const int ix = 8 + gi * 8 + j; const float e = ((l0[ix] + l0[64 * NRTP + ix]) + (l0[128 * NRTP + ix] + l0[192 * NRTP + ix])) * rstd + bre[gi * 8 + j];
                if (e > v0) { v1 = v0; i1 = i0; v0 = e; i0 = j; } else if (e > v1) { v1 = e; i1 = j; } }
            const float dd = expf(v1 - v0), w0 = pg / (1.f + dd), w1 = pg * dd / (1.f + dd);
            const int e0 = gi * 8 + i0, e1 = gi * 8 + i1;
            v4u tr; tr.x = (unsigned)e0; tr.y = (unsigned)e1; tr.z = __float_as_uint(w0); tr.w = __float_as_uint(w1);
            *(v4u*)(ws + WS_SMALL + SM_TOKR + (size_t)tok * 16) = tr;
            ((float*)(ws + WS_SMALL + SM_RSTD))[tok] = rstd;
            __hip_atomic_fetch_add(cnt + e0, 1, __ATOMIC_RELAXED, __HIP_MEMORY_SCOPE_WORKGROUP);
            __hip_atomic_fetch_add(cnt + e1, 1, __ATOMIC_RELAXED, __HIP_MEMORY_SCOPE_WORKGROUP);
        }
        __syncthreads();
        if (tid < 64 && !(RV & 2)) ((int*)(ws + WS_SMALL + SM_CNT))[blk * 64 + tid] = cnt[tid];
        __syncthreads();
    }
}

__device__ __forceinline__ void phase_gather(const Args& a, LAS unsigned char* lds, int G, int vb) {
    unsigned char* ws = opaque_ws(a.ws);
    const int tid = opaque_tid(), lane = tid & 63, wave = __builtin_amdgcn_readfirstlane(tid >> 6);
    const int* CNT = (const int*)(ws + WS_SMALL + SM_CNT); int* BLKE = (int*)(ws + WS_SMALL + SM_BLKE); int* DEST = (int*)(ws + WS_SMALL + SM_DEST);
    const unsigned* TOKR = (const unsigned*)(ws + WS_SMALL + SM_TOKR);
    int* ROWTOK = (int*)(ws + WS_SMALL + SM_ROWTOK);
    LAS int* tot = (LAS int*)(lds + RING_OFF); LAS int* pre = tot + 64; LAS int* pst = tot + 128; LAS int* destl = tot + 192;
    LAS int* part8 = tot + 320;
    LAS int* tokl = tot + 320 + 1024;
    for (int blk = vb; blk < T / 64; blk += G) {
        { const int e = tid & 63, p8 = tid >> 6; int t_ = 0, p_ = 0;
#pragma unroll 8
          for (int b2 = p8 * 32; b2 < p8 * 32 + 32; ++b2) { const int c = CNT[b2 * 64 + e]; t_ += c; p_ += (b2 < blk) ? c : 0; }
          part8[(p8 * 64 + e) * 2] = t_; part8[(p8 * 64 + e) * 2 + 1] = p_;
          if (tid < 128) tokl[tid] = (int)TOKR[(size_t)(blk * 64 + (tid >> 1)) * 4 + (tid & 1)]; }
        __syncthreads();
        if (tid < 64) { int t_ = 0, p_ = 0;
#pragma unroll
            for (int p8 = 0; p8 < 8; ++p8) { t_ += part8[(p8 * 64 + tid) * 2]; p_ += part8[(p8 * 64 + tid) * 2 + 1]; }
            tot[tid] = t_; pre[tid] = p_;
            const int padded = ((t_ + 255) >> 8) << 8; int incl = padded;
#pragma unroll
            for (int o = 1; o < 64; o <<= 1) { const int up = __shfl_up(incl, o); if (tid >= o) incl += up; }
            pst[tid] = incl - padded;
            if (blk == 0 && tid == 63) BLKE[MAXRB] = incl >> 8; }
        __syncthreads();
        if (tid < 64) {
            if (blk == 0) { const int rb0 = pst[tid] >> 8, rb1 = (pst[tid] + (((tot[tid] + 255) >> 8) << 8)) >> 8; for (int rb = rb0; rb < rb1; ++rb) BLKE[rb] = tid; }
            int r = pst[tid] + pre[tid];
            for (int as = 0; as < 128; ++as) { if (tokl[as] == tid) destl[as] = r++; }
        }
        __syncthreads();
        if (tid < 128) { const int tok = blk * 64 + (tid >> 1), dest = destl[tid]; DEST[tok * 2 + (tid & 1)] = dest; ROWTOK[dest] = tok; }
        if (blk < 64) {
            const int r0 = pst[blk] + tot[blk], r1 = pst[blk] + (((tot[blk] + 255) >> 8) << 8);
            for (int r = r0 + tid; r < r1; r += 512) ROWTOK[r] = 0;
        }
        __syncthreads();
    }
}

__device__ __forceinline__ void phase_combine(const Args& a, int G, int vb, float* Fout  ) {
    unsigned char* ws = opaque_ws(a.ws);
    const int tid = opaque_tid(), lane = tid & 63, wave = __builtin_amdgcn_readfirstlane(tid >> 6);
    const int gw = vb * 8 + wave, NGW = G * 8;
    const bf16* YS = (const bf16*)(ws + WS_YS); const int* DEST = (const int*)(ws + WS_SMALL + SM_DEST); float* RSTD = (float*)(ws + WS_SMALL + SM_RSTD); bf16* HB = (bf16*)(ws + WS_HB);
    for (int tok = gw; tok < T; tok += NGW) {
        const v4u tr = *(const v4u*)(ws + WS_SMALL + SM_TOKR + (size_t)tok * 16); const float w0 = __uint_as_float(tr.z), w1 = __uint_as_float(tr.w);
        const int d0 = DEST[tok * 2], d1 = DEST[tok * 2 + 1];
        GAS v2u* hr = (GAS v2u*)(HB + (size_t)tok * DM) + lane;
        const GAS v2u* y0 = (const GAS v2u*)(YS + (size_t)d0 * DM) + lane; const GAS v2u* y1 = (const GAS v2u*)(YS + (size_t)d1 * DM) + lane;
        v2u hv[8], a0[8], a1[8];
#pragma unroll
        for (int j = 0; j < 8; ++j) { hv[j] = hr[64 * j]; a0[j] = y0[64 * j]; a1[j] = y1[64 * j]; }
        float ss = 0.f;
#pragma unroll
        for (int j = 0; j < 8; ++j) { f32x4 v;
            v.x = bflo(hv[j].x) + (w0 * bflo(a0[j].x) + w1 * bflo(a1[j].x)); v.y = bfhi(hv[j].x) + (w0 * bfhi(a0[j].x) + w1 * bfhi(a1[j].x));
            v.z = bflo(hv[j].y) + (w0 * bflo(a0[j].y) + w1 * bflo(a1[j].y)); v.w = bfhi(hv[j].y) + (w0 * bfhi(a0[j].y) + w1 * bfhi(a1[j].y));
            ss += (v.x * v.x + v.y * v.y) + (v.z * v.z + v.w * v.w);
            if (Fout) ((GAS f32x4*)(Fout + (size_t)tok * DM) + lane)[64 * j] = v;
            else { v2u o; o.x = pk2(v.x, v.y); o.y = pk2(v.z, v.w); hr[64 * j] = o;
                   unsigned w8 = 0u; w8 = __builtin_amdgcn_cvt_pk_fp8_f32(v.x, v.y, w8, false); w8 = __builtin_amdgcn_cvt_pk_fp8_f32(v.z, v.w, w8, true); ((GAS unsigned*)(ws + WS_HB8 + (size_t)tok * DM) + lane)[64 * j] = w8; } }
        if (!Fout) { const float rstd = 1.0f / sqrtf(wave_sum(ss) * (1.f / DM) + RMS_EPS); if (lane == 0) RSTD[tok] = rstd; }
    }
}

struct ZeroOrder { int n, G, c;
    __device__ __forceinline__ bool next(int i, pg8::Unit& u) const { if (i * G + c >= n) return false; u.pm = 0; u.pn = 0; return true; }
    __device__ __forceinline__ void a_ready(const pg8::Unit&) const {}
    __device__ __forceinline__ void done(const pg8::Unit&) const {} };
struct EpiNull { static constexpr bool PERM = false, AFTER_DRAIN = false;
    __device__ __forceinline__ void operator()(const f32x4 (&acc)[2][2][4][2], const pg8::Unit& u, int wr, int wc, int fr, int fq) const {} };
#ifndef MK_VAR
#define MK_VAR 0
#endif
namespace pg8 { template <> struct ProbeOf<EpiNull> { static constexpr int v = MK_VAR; }; }
#ifndef MK_DUP
#define MK_DUP -1
#endif
#define DUP(k) (MK_DUP == (k))
#ifndef MK_VAR
#define MK_VAR 0
#endif
#ifndef FP8IN_SP2
#define FP8IN_SP2 true
#endif
constexpr int NPH = 21;
__global__ void __launch_bounds__(512, 2) yoco_fwd(Args args) {
    extern __shared__ __attribute__((aligned(16))) unsigned char lds_raw[];
    LAS unsigned char* lds = (LAS unsigned char*)lds_raw;
    const int tid = opaque_tid();
    const int G = gridDim.x; const int bx0 = blockIdx.x; const int vb = (G % 8 == 0) ? (bx0 % 8) * (G / 8) + bx0 / 8 : bx0;
    unsigned char* ws = args.ws;
    gu32* ctl = (gu32*)(ws + WS_CTL);
    for (int u = tid; u < (LDS_BYTES - LDSCTL_OFF) / 4; u += 512) ((LAS unsigned*)(lds + LDSCTL_OFF))[u] = 0u;
    __syncthreads();
    volatile LAS unsigned* MISC = (volatile LAS unsigned*)(lds + MISC_OFF);
#if MK_N_LAUNCHES == 1
    constexpr int lo = 0, hi = NPH; constexpr bool one = true;
#else
    const int lo = args.ph_lo, hi = args.ph_hi;
    const bool one = (hi - lo) > 1;
#endif
    XcdBarrier bar; bar.bar = (unsigned*)(ctl + CW_BAR); bar.x = 0; bar.st = nullptr;
    if (one) bar = xcd_barrier_post((unsigned*)(ctl + CW_BAR), MISC + 8);
#define GBAR() do { XcdBarrier b2_ = bar; b2_.bar = (unsigned*)opaque_ws((unsigned char*)bar.bar); { unsigned x_ = bar.x; asm volatile("" : "+s"(x_)); b2_.x = x_; } xcd_barrier(b2_); } while (0)
#define IN(k) (lo <= (k) && (k) < hi)
#define SEAM(k) do { if (IN(k) && IN((k) + 1)) GBAR(); } while (0)

#define RUN(k, ...) do { if (IN(k)) { __VA_ARGS__ if (DUP(k)) { __syncthreads(); __VA_ARGS__ } } } while (0)
    RUN(0, phase_prep(args, lds, G, vb););
    SEAM(0);
    for (int l = 0; l < 2; ++l) {
        const int pb = 1 + 10 * l;
        int bx = bx0; asm volatile("" : "+s"(bx));
        RUN(pb + 0,
            { pg8::Gemm g{(const bf16*)(ws + WS_HB8), (const bf16*)(ws + (l == 0 ? WS_W_INA : WS_W_INB)), T, PROJW, DM / 2}; pg8::StaticOrder S; S.init(T, PROJW, G, bx);
              EpiHeadNorm E{ws, l, 1.f / SC_W1};
              const int nun = (T / 256) * (PROJW / 256), upc = (nun + G - 1) / G, ksp = (l == 0) ? bx % (upc + 1) : upc;
              { pg8::RangeOrder R{S, 0, ksp}; pg8::gemm_phase<EpiHeadNorm, pg8::RangeOrder, true, FP8IN_SP2, false, true>(lds + RING_OFF, g, R, E); }
              if (l == 0) { __syncthreads(); for (int ch = bx; ch < CONV_IN; ch += G) conv_chunk(args, lds, 0, ch);
                pg8::RangeOrder R{S, ksp, upc}; pg8::gemm_phase<EpiHeadNorm, pg8::RangeOrder, true, FP8IN_SP2, false, true>(lds + RING_OFF, g, R, E); } }
            );
        if (one) GBAR();
        if (l == 0) { if (IN(pb + 2)) {
                if (bx < 16) { pg8::Gemm g{(const bf16*)(ws + WS_SMALL + SM_MEMN), (const bf16*)(ws + WS_W_MKV), NB * NMEM, 2048, DM}; pg8::StaticOrder S; S.init(NB * NMEM, 2048, G, bx);
                    EpiRowScale E{(bf16*)(ws + WS_SMALL + SM_KVM), 2048, nullptr, 0, 1.f};
                    pg8::gemm_phase<EpiRowScale, pg8::StaticOrder, true, true>(lds + RING_OFF, g, S, E); }
                else phase_gate(args, lds, G - 16, bx - 16); }
            if (one) GBAR(); }
        if (IN(pb + 3)) { if (l == 0) { phase_post_mem(args, lds, G, vb); phase_moba_sparse<0>(args, lds, ctl + CW_Q + 256); if (DUP(40)) { __syncthreads(); phase_moba_sparse<MK_VAR>(args, lds, ctl + CW_Q + 320); } if (one) GBAR(); phase_attn_a(args, lds, ctl + CW_Q); if (DUP(41)) { __syncthreads(); phase_attn_a(args, lds, ctl + CW_Q + 128); } }
            else { phase_attn_b<0>(args, lds, ctl + CW_Q + 64, (bf16*)(ws + WS_OCAT)); if (DUP(14)) { __syncthreads(); phase_attn_b<MK_VAR>(args, lds, ctl + CW_Q + 192, (bf16*)(ws + WS_YS)); } } }
        SEAM(pb + 3);
        RUN(pb + 4,
            {
#ifdef MK_STAG
              if (bx0 & 1) { for (int i_ = 0; i_ < MK_STAG; ++i_) __builtin_amdgcn_s_sleep(127); }
#endif
              pg8::Gemm g8{(const bf16*)(ws + WS_OCAT), (const bf16*)(ws + WS_W_OUT + (size_t)l * DM * DM), T, DM, DM / 2}; pg8::StaticOrder S; S.init(T, DM, G, bx);
              if (l == 0) { EpiOutProj<true> E{args.in[I_X], (float*)(ws + WS_SMALL + SM_PART), (bf16*)(ws + WS_HB), ws + WS_HB8, 1.f / (SC_O * SC_W1)}; pg8::gemm_phase<EpiOutProj<true>, pg8::StaticOrder, true, true, false, true>(lds + RING_OFF, g8, S, E); }
              else { EpiOutProj<false> E{nullptr, (float*)(ws + WS_SMALL + SM_PART), (bf16*)(ws + WS_HB), ws + WS_HB8, 1.f / (SC_O * SC_W1)}; pg8::gemm_phase<EpiOutProj<false>, pg8::StaticOrder, true, true, false, true>(lds + RING_OFF, g8, S, E); } });
#if MK_DUP == 54
        if (l == 0) { __syncthreads();
            pg8::Gemm g9{(const bf16*)(ws + WS_OCAT), (const bf16*)(ws + WS_W_INA), T, PROJW, DM / 2}; ZeroOrder S9{1280, G, bx};
            EpiNull E9; pg8::gemm_phase<EpiNull, ZeroOrder, false, true, false, true>(lds + RING_OFF, g9, S9, E9); }
#endif
#if MK_DUP == 53
        if (l == 0) { __syncthreads();
            pg8::Gemm g9{(const bf16*)(ws + WS_OCAT), (const bf16*)(ws + WS_W_OUT), T, DM, DM / 2}; pg8::StaticOrder S9; S9.init(T, DM, G, bx);
            EpiOutProj<true, MK_VAR> E9{args.in[I_X], (float*)(ws + WS_YS + (size_t)(96 << 20)), (bf16*)(ws + WS_YS), ws + WS_YS + (size_t)(64 << 20), 1.f / (SC_O * SC_W1)};
            pg8::gemm_phase<EpiOutProj<true, MK_VAR>, pg8::StaticOrder, true, true, false, true>(lds + RING_OFF, g9, S9, E9); }
#endif
#if MK_DUP == 52
        if (l == 0) { __syncthreads();
            pg8::Gemm g9{(const bf16*)(ws + WS_OCAT), (const bf16*)(ws + WS_W_INA), T, PROJW, DM / 2}; pg8::StaticOrder S9; S9.init(T, PROJW, G, bx);
            EpiHeadNormT<MK_VAR> E9{ws, 0, 1.f / SC_W1}; pg8::gemm_phase<EpiHeadNormT<MK_VAR>, pg8::StaticOrder, true, true, false, true>(lds + RING_OFF, g9, S9, E9); }
#endif
#if MK_DUP == 50 || MK_DUP == 51
        if (l == 0) { __syncthreads(); constexpr int NN9 = (MK_DUP == 50) ? DM : PROJW;
            pg8::Gemm g9{(const bf16*)(ws + WS_OCAT), (const bf16*)(ws + (MK_DUP == 50 ? WS_W_OUT : WS_W_INA)), T, NN9, DM / 2}; pg8::StaticOrder S9; S9.init(T, NN9, G, bx);
            EpiNull E9; pg8::gemm_phase<EpiNull, pg8::StaticOrder, false, true, false, true>(lds + RING_OFF, g9, S9, E9); }
#endif
        SEAM(pb + 4);
        if (IN(pb + 5)) { phase_router<0>(args, lds, G, vb, l); if (DUP(pb + 5)) { __syncthreads(); phase_router<MK_VAR>(args, lds, G, vb, l); } }
        SEAM(pb + 5);
        RUN(pb + 6, phase_gather(args, lds, G, vb););
        SEAM(pb + 6);
        RUN(pb + 7,
            { const int* blke = (const int*)(ws + WS_SMALL + SM_BLKE);
              const int* rowtok = (const int*)(ws + WS_SMALL + SM_ROWTOK);
              pg8::Gemm g{(const bf16*)(ws + WS_HB8), (const bf16*)(ws + WS_W_E1 + (size_t)l * NEXP * 1024 * DM), MAXRB * 256, 1024, DM / 2, rowtok};
              MoeOrder S{blke, blke[MAXRB] * 4, 4, G, bx}; EpiSiluMul E{(bf16*)(ws + WS_HID), (const float*)(ws + WS_SMALL + SM_RSTD), rowtok};
              pg8::gemm_phase<EpiSiluMul, MoeOrder, true, true, true, true>(lds + RING_OFF, g, S, E); });
        SEAM(pb + 7);
        RUN(pb + 8,
            { const int* blke = (const int*)(ws + WS_SMALL + SM_BLKE);
              pg8::Gemm g{(const bf16*)(ws + WS_HID), (const bf16*)(ws + WS_W_E2 + (size_t)l * NEXP * DM * EFF), MAXRB * 256, DM, EFF / 2};
              MoeOrder S{blke, blke[MAXRB] * 8, 8, G, bx}; EpiRowScale E{(bf16*)(ws + WS_YS), DM, nullptr, 8, 1.f / (SC_HID * SC_W2)};
              pg8::gemm_phase<EpiRowScale, MoeOrder, true, true, false, true>(lds + RING_OFF, g, S, E); });
        SEAM(pb + 8);
        if (IN(pb + 9)) phase_combine(args, G, vb, l == 0 ? nullptr : args.out);
        if (l == 0) SEAM(pb + 9);
    }
#undef RUN
#undef IN
#undef SEAM
}

extern "C" void kernel_launch(void* const* d_in, const int* in_sizes, int n_in, void* d_out, int out_size, void* d_ws, size_t ws_size, hipStream_t stream) {
    static int grid = 0;
    if (grid == 0) {
        if (n_in != N_IN || out_size != T * DM || ws_size < WS_END) { fprintf(stderr, "kernel_launch: unexpected shapes (n_in %d out %d ws %zu)\n", n_in, out_size, ws_size); grid = -1; return; }
        int dev = 0, cus = 0;
        if (hipGetDevice(&dev) != hipSuccess || hipDeviceGetAttribute(&cus, hipDeviceAttributeMultiprocessorCount, dev) != hipSuccess) { grid = -1; return; }
        if (hipFuncSetAttribute((const void*)yoco_fwd, hipFuncAttributeMaxDynamicSharedMemorySize, LDS_BYTES) != hipSuccess) { fprintf(stderr, "kernel_launch: hipFuncSetAttribute failed\n"); grid = -1; return; }
        int per_cu = 0;
        if (hipOccupancyMaxActiveBlocksPerMultiprocessor(&per_cu, (const void*)yoco_fwd, 512, LDS_BYTES) != hipSuccess || per_cu < 1) fprintf(stderr, "kernel_launch: occupancy query reports %d\n", per_cu);
        (void)hipGetLastError();
        grid = cus;
    }
    if (grid < 0) return;
    (void)hipMemsetAsync((char*)d_ws + WS_CTL, 0, CTL_ZERO_BYTES, stream);
    Args a{};
    for (int i = 0; i < N_IN; ++i) a.in[i] = (const float*)d_in[i];
    a.out = (float*)d_out; a.ws = (unsigned char*)d_ws;
#if MK_N_LAUNCHES == 1
    a.ph_lo = 0; a.ph_hi = NPH;
    hipLaunchKernelGGL(yoco_fwd, dim3(grid), dim3(512), LDS_BYTES, stream, a);
#else
    for (int p = 0; p < NPH; ++p) { if (p == 13) continue; a.ph_lo = p; a.ph_hi = p + 1; hipLaunchKernelGGL(yoco_fwd, dim3(grid), dim3(512), LDS_BYTES, stream, a); }
#endif
}
```

```cpp
#include <hip/hip_runtime.h>
#include <cstdio>
#include <cstdint>

#ifndef MK_N_LAUNCHES
#define MK_N_LAUNCHES 1
#endif
#ifndef MK_CHECK
#define MK_CHECK 0
#endif

constexpr int NB = 2, SEQ = 8192, T = NB * SEQ, DM = 2048, HD = 128;
constexpr int NMEM = 256, MEMH = 4, MEMW = 512, MIXW = 1536, MOBA_H = 12, DIFF_H = 6, DV = 256;
constexpr int NEXP = 64, NGRP = 8, EPG = 8, EFF = 512, NRT = 72, NRTP = 80;
constexpr int PROJW = 5120;
constexpr float RMS_EPS = 1e-6f;
constexpr float LOG2E = 1.4426950408889634f;
constexpr float QSCALE = 0.08838834764831845f * LOG2E;
constexpr float LAM_INIT = 0.35550906759096926f;
constexpr int MAXRB = 192;
constexpr float SC_W1 = 64.f, SC_W2 = 32.f, SC_HID = 8.f, SC_O = 16.f;

constexpr size_t MiB = 1u << 20;
constexpr size_t WS_CTL = 0, CTL_ZERO_BYTES = 1 * MiB;
constexpr size_t WS_W_INA = 1 * MiB;
constexpr size_t WS_W_INB = 21 * MiB;
constexpr size_t WS_W_OUT = 41 * MiB;
constexpr size_t WS_W_MKV = 57 * MiB;
constexpr size_t WS_W_RT  = 65 * MiB;
constexpr size_t WS_W_E1  = 67 * MiB;
constexpr size_t WS_HB8   = 323 * MiB;
constexpr size_t WS_W_E2  = 579 * MiB;
constexpr size_t WS_SMALL = 835 * MiB;
constexpr size_t WS_HB    = 851 * MiB;
constexpr size_t WS_PROJ  = 915 * MiB;
constexpr size_t WS_QH    = 1075 * MiB;
constexpr size_t WS_KH    = 1139 * MiB;
constexpr size_t WS_VH    = 1187 * MiB;
constexpr size_t WS_XS    = WS_PROJ;
constexpr size_t WS_OCAT  = 1235 * MiB;
constexpr size_t WS_HID   = 1299 * MiB;
constexpr size_t WS_YS    = 1347 * MiB;
constexpr size_t WS_HA    = 1539 * MiB;
constexpr size_t WS_H2    = 1667 * MiB;
constexpr size_t WS_LISTF = 1795 * MiB;
constexpr size_t WS_LISTA = 1821 * MiB;
constexpr size_t WS_PM    = 1822 * MiB;
constexpr size_t WS_PO    = WS_PROJ;
constexpr size_t WS_END   = 1827 * MiB;
static_assert(WS_XS + (size_t)MAXRB * 256 * 2048 * 2 <= WS_VH, "XS alias");
constexpr size_t SM_RSTD  = 0;
constexpr size_t SM_PART  = 1 * MiB;
constexpr size_t SM_TOKR  = 3 * MiB;
constexpr size_t SM_DEST  = 4 * MiB;
constexpr size_t SM_CNT   = 5 * MiB;
constexpr size_t SM_BLKE  = 5 * MiB + 128 * 1024;
constexpr size_t SM_KMEAN = 6 * MiB;
constexpr size_t SM_SEL   = 7 * MiB;
constexpr size_t SM_MEMN  = 8 * MiB;
constexpr size_t SM_KVM   = 10 * MiB;
constexpr size_t SM_KM    = 12 * MiB;
constexpr size_t SM_VM    = 13 * MiB;
constexpr size_t SM_GAINTAB = 15 * MiB;
constexpr size_t SM_ROWTOK = 14 * MiB;
constexpr int CW_BAR = 4096;
constexpr int CW_Q = 8192;
constexpr int CW_MC = 16384;

constexpr int RING_OFF = 0, RING_BYTES = 131072;
constexpr int LDSX_OFF = RING_BYTES;
constexpr int LDSCTL_OFF = RING_BYTES + 12288, MISC_OFF = LDSCTL_OFF + 320;
constexpr int LDS_BYTES = 147456;
static_assert(MISC_OFF + 128 <= LDS_BYTES, "LDS map");

#define GAS __attribute__((address_space(1)))
#define LAS __attribute__((address_space(3)))
typedef unsigned short bf16;
typedef unsigned v4u __attribute__((ext_vector_type(4)));
typedef unsigned v2u __attribute__((ext_vector_type(2)));
typedef float f32x4 __attribute__((ext_vector_type(4)));
typedef float f32x16 __attribute__((ext_vector_type(16)));
typedef short bf16x8 __attribute__((ext_vector_type(8)));
typedef short s16x4 __attribute__((ext_vector_type(4)));
typedef GAS unsigned gu32;
#define RLX_AGENT __ATOMIC_RELAXED, __HIP_MEMORY_SCOPE_AGENT
#define LDS_WAIT() asm volatile("s_waitcnt lgkmcnt(0)" ::: "memory")
#define VM_WAIT() asm volatile("s_waitcnt vmcnt(0)" ::: "memory")
__device__ __forceinline__ unsigned f2bf(float f) { unsigned u = __builtin_bit_cast(unsigned, f); return (u + 0x7fffu + ((u >> 16) & 1u)) >> 16; }
__device__ __forceinline__ unsigned pk2(float lo, float hi) { return f2bf(lo) | (f2bf(hi) << 16); }
__device__ __forceinline__ float bf2f(unsigned short b) { return __builtin_bit_cast(float, (unsigned)b << 16); }
__device__ __forceinline__ float bflo(unsigned w) { return __builtin_bit_cast(float, w << 16); }
__device__ __forceinline__ float bfhi(unsigned w) { return __builtin_bit_cast(float, w & 0xffff0000u); }
template <int M> __device__ __forceinline__ float swz_xor(float v) { return __builtin_bit_cast(float, __builtin_amdgcn_ds_swizzle(__builtin_bit_cast(int, v), (M << 10) | 0x1F)); }
__device__ __forceinline__ float add_xor32(float v) {
    auto r = __builtin_amdgcn_permlane32_swap(__float_as_uint(v), __float_as_uint(v), false, false);
    return __uint_as_float(r[0]) + __uint_as_float(r[1]); }
__device__ __forceinline__ float wave_sum(float v) {
    v += swz_xor<1>(v); v += swz_xor<2>(v); v += swz_xor<4>(v); v += swz_xor<8>(v); v += swz_xor<16>(v);
    return add_xor32(v);
}
__device__ const unsigned char T5_BUCKET[128] = {
 0, 1, 2, 3, 4, 5, 6, 7, 8, 9, 10, 11, 12, 13, 14, 15, 16, 16, 16, 17, 17, 18, 18, 18, 19, 19, 19, 20, 20, 20, 20, 21, 21, 21, 21, 22, 22, 22, 22, 22, 23, 23, 23, 23, 23, 23, 24, 24, 24, 24, 24, 24, 25, 25, 25, 25, 25, 25, 25, 26, 26, 26, 26, 26, 26, 26, 26, 27, 27, 27, 27, 27, 27, 27, 27, 27, 27, 28, 28, 28, 28, 28, 28, 28, 28, 28, 28, 29, 29, 29, 29, 29, 29, 29, 29, 29, 29, 29, 29, 30, 30, 30, 30, 30, 30, 30, 30, 30, 30, 30, 30, 30, 30, 31, 31, 31, 31, 31, 31, 31, 31, 31, 31, 31, 31, 31, 31, 31};

__device__ __forceinline__ int opaque_tid() { int t = threadIdx.x; asm volatile("" : "+v"(t)); return t; }

__device__ __forceinline__ unsigned char* opaque_ws(unsigned char* p) { asm volatile("" : "+s"(p)); return p; }
namespace pg8 {
#define PG8_LAS __attribute__((address_space(3)))
typedef unsigned short bf16_t;
typedef short bf16x8 __attribute__((ext_vector_type(8)));
typedef float f32x4 __attribute__((ext_vector_type(4)));
typedef unsigned u32x4 __attribute__((ext_vector_type(4)));
constexpr int BM = 256, BK = 64, HALF = 128, HTB = HALF * BK * 2  , STAGE_BYTES = 8 * HTB, NXCD = 8, WGM = 8;

__host__ __device__ __forceinline__ int lds_byte(int r, int c) { const int st = (r >> 4) * 2 + (c >> 5), rr = r & 15, cc = c & 31, ob = rr * 64 + cc * 2; return st * 1024 + (ob ^ (((ob >> 9) & 1) << 5)); }
__host__ __device__ __forceinline__ void stage_rc(int b, int& R, int& C) { const int st = b / 1024, sb = b % 1024, swz = sb ^ (((sb >> 9) & 1) << 5); R = (st >> 1) * 16 + swz / 64; C = (st & 1) * 32 + (swz % 64) / 2; }
__host__ __device__ __forceinline__ int perm32(int rho) { const int n = rho >> 4, i = rho & 15; return 8 * (i >> 2) + 4 * n + (i & 3); }

struct Unit { int pm, pn; };
struct Gemm { const bf16_t* A; const bf16_t* Bt; int M, N, K; const int* rowtok; };

struct StaticOrder {
    int nM, nN, nwg, G, c;
    __host__ __device__ void init(int M, int N, int G_, int c_) { nM = M / BM; nN = N / BM; nwg = nM * nN; G = G_; c = c_; }
    __host__ __device__ bool next(int i, Unit& u) const {
        const long L = (long)i * G + c; if (L >= nwg) return false;
        int wgid = (int)L; { const int q = nwg / NXCD, r = nwg % NXCD, xcd = wgid % NXCD, off = wgid / NXCD; wgid = (xcd < r ? xcd * (q + 1) : r * (q + 1) + (xcd - r) * q) + off; }
        const int nig = WGM * nN, gid = wgid / nig, fm = gid * WGM, gsz = (nM - fm) < WGM ? (nM - fm) : WGM;
        u.pm = fm + ((wgid % nig) % gsz); u.pn = (wgid % nig) / gsz; return true;
    }
    __device__ __forceinline__ void a_ready(const Unit&) const {}
    __device__ __forceinline__ void done(const Unit&) const {}
};

__device__ __forceinline__ unsigned cvt_pk_bf16(float lo, float hi) { unsigned r; asm volatile("v_cvt_pk_bf16_f32 %0, %1, %2" : "=v"(r) : "v"(lo), "v"(hi)); return r; }
typedef float f32x2 __attribute__((ext_vector_type(2)));
struct RangeOrder {
    StaticOrder S; int i0, i1;
    __device__ __forceinline__ bool next(int i, Unit& u) const { return (i0 + i < i1) && S.next(i0 + i, u); }
    __device__ __forceinline__ void a_ready(const Unit&) const {}
    __device__ __forceinline__ void done(const Unit&) const {}
};
template <class E> struct ProbeOf { static constexpr int v = 0; };
template <class Epi, class Sched, bool ALIGN_EPI = false, bool SP2 = false, bool GATHER = false, bool FP8 = false>
__device__ __forceinline__ void gemm_phase(PG8_LAS unsigned char* lds, const Gemm g, const Sched& S, const Epi& E) {
    const int tid = opaque_tid(), wid = __builtin_amdgcn_readfirstlane(tid >> 6), lane = tid & 63, wr = wid >> 2, wc = wid & 3, fr = lane & 15, fq = lane >> 4;
    const int K = g.K, nt = K / BK;
    unsigned voffA[2], voffB[2]; int RA[2]; unsigned CA2[2];
#pragma unroll
    for (int i = 0; i < 2; ++i) { int R, C; stage_rc(tid * 16 + i * 8192, R, C); const int Rb = Epi::PERM ? ((R & ~31) + perm32(R & 31)) : R;
        voffA[i] = (unsigned)(R * K + C) * 2u; voffB[i] = (unsigned)(Rb * K + C) * 2u; RA[i] = R; CA2[i] = (unsigned)C * 2u; }
    const size_t kstep = (size_t)(BK * 2);
    const size_t hstep = (size_t)HALF * K * 2;
    const size_t tstep = 2 * hstep;
    const unsigned ldsw = (unsigned)wid * 1024u;
    const int aoff = lds_byte(wr * 64 + fr, fq * 8), boff = lds_byte(wc * 32 + fr, fq * 8);
#define PG8_SA(b, h) (((b) * 2 + (h)) * HTB)
#define PG8_SB(b, h) ((4 + (b) * 2 + (h)) * HTB)
#define PG8_STAGE(bufoff, gbase, voff) do { if constexpr (!(ProbeOf<Epi>::v & 4)) _Pragma("unroll") for (int _i = 0; _i < 2; ++_i) \
        __builtin_amdgcn_global_load_lds((const unsigned*)((const char*)(gbase) + (voff)[_i]), (PG8_LAS unsigned*)(lds + (bufoff) + ldsw + _i * 8192), 16, 0, 0); } while (0)
    unsigned gc[2][2], gn[2][2];
#define PG8_GOFF(dst, pm_) do { _Pragma("unroll") for (int _h = 0; _h < 2; ++_h) _Pragma("unroll") for (int _i = 0; _i < 2; ++_i) \
        dst[_h][_i] = (unsigned)g.rowtok[(pm_) * BM + _h * HALF + RA[_i]] * (unsigned)(K * 2) + CA2[_i]; } while (0)
#define PG8_STAGE_A(bufoff, ptr, half, usenext) do { if constexpr (GATHER) { _Pragma("unroll") for (int _i = 0; _i < 2; ++_i) \
        __builtin_amdgcn_global_load_lds((const unsigned*)((const char*)(ptr) + ((usenext) ? gn[half][_i] : gc[half][_i])), (PG8_LAS unsigned*)(lds + (bufoff) + ldsw + _i * 8192), 16, 0, 0); } \
        else { PG8_STAGE(bufoff, (ptr) + (half) * hstep, voffA); } } while (0)
#define PG8_LDA(dst, b, h) do { if constexpr (ProbeOf<Epi>::v & 2) {} else if constexpr (FP8) { _Pragma("unroll") for (int m = 0; m < 4; ++m) dst##8[m] = PG8_CAT(*(const PG8_LAS bf16x8*)(lds + PG8_SA(b, h) + aoff + m * 2048), *(const PG8_LAS bf16x8*)(lds + PG8_SA(b, h) + aoff + m * 2048 + 1024)); } \
        else { _Pragma("unroll") for (int m = 0; m < 4; ++m) _Pragma("unroll") for (int k = 0; k < 2; ++k) dst[m][k] = *(const PG8_LAS bf16x8*)(lds + PG8_SA(b, h) + aoff + m * 2048 + k * 1024); } } while (0)
#define PG8_LDB(dst, b, h) do { if constexpr (ProbeOf<Epi>::v & 2) {} else if constexpr (FP8) { _Pragma("unroll") for (int n = 0; n < 2; ++n) dst##8[n] = PG8_CAT(*(const PG8_LAS bf16x8*)(lds + PG8_SB(b, h) + boff + n * 2048), *(const PG8_LAS bf16x8*)(lds + PG8_SB(b, h) + boff + n * 2048 + 1024)); } \
        else { _Pragma("unroll") for (int n = 0; n < 2; ++n) _Pragma("unroll") for (int k = 0; k < 2; ++k) dst[n][k] = *(const PG8_LAS bf16x8*)(lds + PG8_SB(b, h) + boff + n * 2048 + k * 1024); } } while (0)
typedef int pg8_v8i __attribute__((ext_vector_type(8))); typedef int pg8_v4i __attribute__((ext_vector_type(4)));
#define PG8_CAT(x0, x1) __builtin_shufflevector(__builtin_bit_cast(pg8_v4i, x0), __builtin_bit_cast(pg8_v4i, x1), 0, 1, 2, 3, 4, 5, 6, 7)
#define PG8_MMA(ai, bj, At, Bt) do { __builtin_amdgcn_s_setprio(1); if constexpr (ProbeOf<Epi>::v & 1) {} else if constexpr (FP8) { _Pragma("unroll") for (int m = 0; m < 4; ++m) _Pragma("unroll") for (int n = 0; n < 2; ++n) \
        asm volatile("v_mfma_scale_f32_16x16x128_f8f6f4 %0, %1, %2, %0, %3, %3 op_sel_hi:[0,0,0]" : "+v"(acc[ai][bj][m][n]) : "v"(Bt##8[n]), "v"(At##8[m]), "v"(pg8_scale1)); } \
        else { _Pragma("unroll") for (int m = 0; m < 4; ++m) _Pragma("unroll") for (int n = 0; n < 2; ++n) _Pragma("unroll") for (int k = 0; k < 2; ++k) \
        acc[ai][bj][m][n] = __builtin_amdgcn_mfma_f32_16x16x32_bf16(Bt[n][k], At[m][k], acc[ai][bj][m][n], 0, 0, 0); } __builtin_amdgcn_s_setprio(0); } while (0)
#define PG8_WAIT_V(n) asm volatile("s_waitcnt vmcnt(" #n ")" ::: "memory")
#define PG8_WAIT_L(n) asm volatile("s_waitcnt lgkmcnt(" #n ")" ::: "memory")
#define PG8_BAR __builtin_amdgcn_s_barrier()
#define PG8_SCHED __builtin_amdgcn_sched_barrier(0)
    Unit cur, nxt; int ui = 0;
    if (!S.next(0, cur)) return;
    f32x4 acc[2][2][4][2];
#pragma unroll
    for (int a = 0; a < 2; ++a)
#pragma unroll
        for (int b = 0; b < 2; ++b)
#pragma unroll
            for (int m = 0; m < 4; ++m)
#pragma unroll
                for (int n = 0; n < 2; ++n) acc[a][b][m][n] = (f32x4){0.f, 0.f, 0.f, 0.f};
    int pg8_scale1 = 0x7F7F7F7F; asm volatile("" : "+v"(pg8_scale1));
    bf16x8 At[4][2], B0[2][2], B1[2][2]; pg8_v8i At8[4], B08[2], B18[2];
    if constexpr (ProbeOf<Epi>::v & 2) { _Pragma("unroll") for (int m = 0; m < 4; ++m) { At8[m] = (pg8_v8i){1, 2, 3, 4, 5, 6, 7, 8}; asm volatile("" : "+v"(At8[m])); } _Pragma("unroll") for (int n = 0; n < 2; ++n) { B08[n] = (pg8_v8i){1, 2, 3, 4, 5, 6, 7, 8}; B18[n] = B08[n]; asm volatile("" : "+v"(B08[n]), "+v"(B18[n])); } }
    const char* cA = GATHER ? (const char*)g.A : (const char*)g.A + (size_t)cur.pm * tstep; const char* cB = (const char*)g.Bt + (size_t)cur.pn * tstep;
    if constexpr (GATHER) { PG8_GOFF(gc, cur.pm); }
    S.a_ready(cur);
    if constexpr (SP2) {
        PG8_STAGE(PG8_SB(0, 0), cB, voffB); PG8_STAGE(PG8_SB(0, 1), cB + hstep, voffB); PG8_STAGE_A(PG8_SA(0, 0), cA, 0, false); PG8_STAGE_A(PG8_SA(0, 1), cA, 1, false);
        if (wr == 1) PG8_BAR;
        PG8_WAIT_V(2); PG8_BAR;
        PG8_STAGE(PG8_SB(1, 0), cB + kstep, voffB); PG8_STAGE_A(PG8_SA(1, 0), cA + kstep, 0, false); PG8_STAGE(PG8_SB(1, 1), cB + hstep + kstep, voffB);
        PG8_WAIT_V(6); PG8_BAR;
    } else {
        PG8_STAGE(PG8_SB(0, 0), cB, voffB); PG8_STAGE_A(PG8_SA(0, 0), cA, 0, false); PG8_STAGE(PG8_SB(0, 1), cB + hstep, voffB); PG8_STAGE_A(PG8_SA(0, 1), cA, 1, false);
        if (wr == 1) PG8_BAR;
        PG8_WAIT_V(4); PG8_BAR;
        PG8_STAGE(PG8_SB(1, 0), cB + kstep, voffB); PG8_STAGE_A(PG8_SA(1, 0), cA + kstep, 0, false); PG8_STAGE(PG8_SB(1, 1), cB + hstep + kstep, voffB);
        PG8_WAIT_V(6); PG8_BAR;
    }
    for (;;) {
        const bool has_next = S.next(ui + 1, nxt);
        const char* nA = GATHER ? (const char*)g.A : (has_next ? (const char*)g.A + (size_t)nxt.pm * tstep : cA);
        if constexpr (GATHER) { if (has_next) { PG8_GOFF(gn, nxt.pm); } else { _Pragma("unroll") for (int _h = 0; _h < 2; ++_h) _Pragma("unroll") for (int _i = 0; _i < 2; ++_i) gn[_h][_i] = gc[_h][_i]; } } const char* nB = has_next ? (const char*)g.Bt + (size_t)nxt.pn * tstep : cB;
#pragma nounroll
        for (int t = 0; t < nt; t += 2) {
            const bool last = (t == nt - 2);
            const char* a1 = cA + (size_t)(t + 1) * kstep;
            const char* a2 = last ? nA : cA + (size_t)(t + 2) * kstep; const char* b2 = last ? nB : cB + (size_t)(t + 2) * kstep;
            const char* a3 = a2 + kstep; const char* b3 = b2 + kstep;
            if (last && has_next) S.a_ready(nxt);
            if constexpr (SP2) {
            PG8_LDB(B0, 0, 0); PG8_LDB(B1, 0, 1); PG8_SCHED; PG8_LDA(At, 0, 0); PG8_STAGE_A(PG8_SA(1, 1), a1, 1, false);
            PG8_WAIT_V(8); PG8_WAIT_L(0); PG8_BAR; PG8_MMA(0, 0, At, B0); PG8_MMA(0, 1, At, B1); PG8_BAR; PG8_SCHED;
            PG8_LDA(At, 0, 1); PG8_STAGE(PG8_SB(0, 0), b2, voffB); PG8_STAGE(PG8_SB(0, 1), b2 + hstep, voffB); PG8_STAGE_A(PG8_SA(0, 0), a2, 0, last);
            PG8_WAIT_V(8); PG8_WAIT_L(0); PG8_BAR; PG8_MMA(1, 0, At, B0); PG8_MMA(1, 1, At, B1); PG8_BAR; PG8_SCHED;
            PG8_LDB(B0, 1, 0); PG8_LDB(B1, 1, 1); PG8_SCHED; PG8_LDA(At, 1, 0); PG8_STAGE_A(PG8_SA(0, 1), a2, 1, last);
            PG8_WAIT_V(8); PG8_WAIT_L(0); PG8_BAR; PG8_MMA(0, 0, At, B0); PG8_MMA(0, 1, At, B1); PG8_BAR; PG8_SCHED;
            PG8_LDA(At, 1, 1); PG8_STAGE(PG8_SB(1, 0), b3, voffB); PG8_STAGE(PG8_SB(1, 1), b3 + hstep, voffB); PG8_STAGE_A(PG8_SA(1, 0), a3, 0, last);
            PG8_WAIT_V(8); PG8_WAIT_L(0); PG8_BAR; PG8_MMA(1, 0, At, B0); PG8_MMA(1, 1, At, B1); PG8_BAR; PG8_SCHED;
            } else {
            PG8_LDB(B0, 0, 0); PG8_SCHED; PG8_LDA(At, 0, 0); PG8_STAGE_A(PG8_SA(1, 1), a1, 1, false);
            PG8_WAIT_L(8); PG8_BAR; PG8_WAIT_L(0); PG8_MMA(0, 0, At, B0); PG8_BAR; PG8_SCHED;
            PG8_LDB(B1, 0, 1); PG8_STAGE(PG8_SB(0, 0), b2, voffB);
            PG8_BAR; PG8_WAIT_L(0); PG8_MMA(0, 1, At, B1); PG8_BAR;
            PG8_LDA(At, 0, 1); PG8_STAGE_A(PG8_SA(0, 0), a2, 0, last);
            PG8_BAR; PG8_WAIT_L(0); PG8_MMA(1, 0, At, B0); PG8_BAR; PG8_SCHED;
            PG8_STAGE(PG8_SB(0, 1), b2 + hstep, voffB);
            PG8_WAIT_V(6); PG8_BAR; PG8_MMA(1, 1, At, B1); PG8_BAR;
            PG8_LDB(B0, 1, 0); PG8_SCHED; PG8_LDA(At, 1, 0); PG8_STAGE_A(PG8_SA(0, 1), a2, 1, last);
            PG8_WAIT_L(8); PG8_BAR; PG8_WAIT_L(0); PG8_MMA(0, 0, At, B0); PG8_BAR; PG8_SCHED;
            PG8_LDB(B1, 1, 1); PG8_STAGE(PG8_SB(1, 0), b3, voffB);
            PG8_BAR; PG8_WAIT_L(0); PG8_MMA(0, 1, At, B1); PG8_BAR;
            PG8_LDA(At, 1, 1); PG8_STAGE_A(PG8_SA(1, 0), a3, 0, last);
            PG8_BAR; PG8_WAIT_L(0); PG8_MMA(1, 0, At, B0); PG8_BAR; PG8_SCHED;
            PG8_STAGE(PG8_SB(1, 1), b3 + hstep, voffB);
            PG8_WAIT_V(6); PG8_BAR; PG8_MMA(1, 1, At, B1); PG8_BAR;
            }
        }
        if constexpr (FP8) asm volatile("s_nop 15\n\ts_nop 15" ::: "memory");
        if constexpr (ALIGN_EPI) { if (wr == 0) PG8_BAR; }
        if constexpr (!Epi::AFTER_DRAIN) { E(acc, cur, wr, wc, fr, fq); S.done(cur); }
        if (!has_next) break;
#pragma unroll
        for (int a = 0; a < 2; ++a)
#pragma unroll
            for (int b = 0; b < 2; ++b)
#pragma unroll
                for (int m = 0; m < 4; ++m)
#pragma unroll
                    for (int n = 0; n < 2; ++n) acc[a][b][m][n] = (f32x4){0.f, 0.f, 0.f, 0.f};
        cur = nxt; cA = nA; cB = nB; ++ui;
        if constexpr (GATHER) { _Pragma("unroll") for (int _h = 0; _h < 2; ++_h) _Pragma("unroll") for (int _i = 0; _i < 2; ++_i) gc[_h][_i] = gn[_h][_i]; }
        if constexpr (ALIGN_EPI) { if (wr == 1) PG8_BAR; }
    }
    PG8_WAIT_V(0);
    if constexpr (!ALIGN_EPI) { if (wr == 0) PG8_BAR; }
    PG8_BAR;
    if constexpr (Epi::AFTER_DRAIN) { E.fused(acc, cur, wr, wc, fr, fq, lds, wid, lane); S.done(cur); }
#undef PG8_SA
#undef PG8_SB
#undef PG8_STAGE
#undef PG8_STAGE_A
#undef PG8_GOFF
#undef PG8_LDA
#undef PG8_LDB
#undef PG8_MMA
#undef PG8_CAT
#undef PG8_WAIT_V
#undef PG8_WAIT_L
#undef PG8_BAR
#undef PG8_SCHED
}
}
#define XB_TMO      128
#define XB_XCNT(j)  (256  + 64 * (j))
#define XB_XSUB(j)  (1280 + 64 * (j))
#define XB_XGEN(j)  (2304 + 64 * (j))
#define XB_TOP      3328
#define XB_TOPGEN   3392
#define XCD_BAR_WORDS 3456
#define XB_SPIN_CAP (1u << 18)

__device__ __forceinline__ unsigned xb_ld(unsigned* p)              { return __hip_atomic_load(p, __ATOMIC_RELAXED, __HIP_MEMORY_SCOPE_AGENT); }
__device__ __forceinline__ unsigned xb_add(unsigned* p, unsigned v) { return __hip_atomic_fetch_add(p, v, __ATOMIC_RELAXED, __HIP_MEMORY_SCOPE_AGENT); }
__device__ __forceinline__ unsigned xb_xcc_id() { return (unsigned)__builtin_amdgcn_s_getreg((3 << 11) | 20) & 0xFu; }
#define XB_SPIN(cond, bar) do { unsigned _sp = 0; while (cond) { __builtin_amdgcn_s_sleep(1); \
    if ((++_sp & 255u) == 0u) { if (xb_ld(&(bar)[XB_TMO])) break; if (_sp > XB_SPIN_CAP) { atomicAdd(&(bar)[XB_TMO], 1u); break; } } } } while (0)

struct XcdBarrier {
    unsigned* bar; unsigned x;
    volatile LAS unsigned* st;
};

__device__ __forceinline__ XcdBarrier xcd_barrier_post(unsigned* bar, volatile LAS unsigned* st) {
    XcdBarrier b; b.bar = bar; b.x = xb_xcc_id(); b.st = st;
    if (threadIdx.x == 0) (void)xb_add(&bar[XB_XCNT(b.x)], 1u);
    return b;
}
__device__ __forceinline__ void xcd_barrier_complete(unsigned* bar, unsigned x, unsigned& nloc, unsigned& nx) {
    const unsigned G = gridDim.x * gridDim.y * gridDim.z;
    unsigned sum, cnt, mine, sp = 0u;
    for (;;) {
        sum = 0u; cnt = 0u; mine = 0u;
#pragma unroll
        for (unsigned j = 0; j < 16; ++j) { const unsigned c = xb_ld(&bar[XB_XCNT(j)]); sum += c; cnt += (c > 0u) ? 1u : 0u; mine = (j == x) ? c : mine; }
        if (sum == G) break;
        __builtin_amdgcn_s_sleep(1);
        if ((++sp & 255u) == 0u) { if (xb_ld(&bar[XB_TMO])) break; if (sp > XB_SPIN_CAP) { atomicAdd(&bar[XB_TMO], 1u); break; } }
    }
    nloc = mine > 0u ? mine : 1u; nx = cnt > 0u ? cnt : 1u;
}

__device__ __forceinline__ void xcd_barrier(const XcdBarrier& b) {
    asm volatile("s_waitcnt vmcnt(0)" ::: "memory");
    __syncthreads();
    if (threadIdx.x == 0) {
        unsigned* bar = b.bar;
        __builtin_amdgcn_s_waitcnt(0);
        unsigned nloc = b.st[0], nx = b.st[1];
        if (nloc == 0u) { xcd_barrier_complete(bar, b.x, nloc, nx); b.st[0] = nloc; b.st[1] = nx; }
        const unsigned old = xb_add(&bar[XB_XSUB(b.x)], 1u);
        const unsigned gen = old / nloc;
        if (old + 1u == (gen + 1u) * nloc) {
            __builtin_amdgcn_fence(__ATOMIC_RELEASE, "agent");
            asm volatile("s_waitcnt vmcnt(0)" ::: "memory");
            const unsigned og = xb_add(&bar[XB_TOP], 1u);
            const unsigned tg = og / nx;
            if (og + 1u == (tg + 1u) * nx) xb_add(&bar[XB_TOPGEN], 1u);
            else XB_SPIN(xb_ld(&bar[XB_TOPGEN]) == tg, bar);
            __builtin_amdgcn_fence(__ATOMIC_ACQUIRE, "agent");
            xb_add(&bar[XB_XGEN(b.x)], 1u);
            asm volatile("s_waitcnt vmcnt(0)" ::: "memory");
        } else {
            XB_SPIN(xb_ld(&bar[XB_XGEN(b.x)]) == gen, bar);
            __builtin_amdgcn_fence(__ATOMIC_ACQUIRE, "agent");
            asm volatile("s_waitcnt vmcnt(0)" ::: "memory");
        }
    }
    __syncthreads();
}

enum InIdx { I_X = 0, I_MEM, I_RELB, I_ATTN_G, I_FFN_G, I_MEM_G, I_W_MKV, I_QN_MEM, I_KN_MEM, I_W_OUT, I_W_INA, I_QN_A, I_KN_A, I_KV_G, I_W_KVB, I_KN_B, I_W_INB, I_QN_B,
             I_LAMBDA, I_SUBLN, I_W_RG, I_B_RG, I_W_RE, I_B_RE, I_W_GATE, I_W_UP, I_W_DOWN, N_IN };
struct Args { const float* in[N_IN]; float* out; unsigned char* ws; int ph_lo, ph_hi; };
static_assert(sizeof(Args) == N_IN * 8 + 8 + 8 + 8, "Args has no padding");

using pg8::cvt_pk_bf16;
struct EpiRowScale {
    static constexpr bool PERM = true, AFTER_DRAIN = false;
    bf16* O; int ldc; const float* rs; int ntn; float cs;
    __device__ __forceinline__ void operator()(const f32x4 (&acc)[2][2][4][2], const pg8::Unit& u, int wr, int wc, int fr, int fq) const {
        const int colt = ntn ? (u.pn % ntn) : u.pn;
        const int row0 = u.pm * 256 + wr * 64 + fr, col0 = colt * 256 + wc * 32 + 8 * fq;
#pragma unroll
        for (int ai = 0; ai < 2; ++ai)
#pragma unroll
            for (int m = 0; m < 4; ++m) { const int row = row0 + ai * 128 + m * 16; const float s = (rs ? rs[row] : 1.f) * cs; bf16* rowp = O + (size_t)row * ldc + col0;
#pragma unroll
                for (int bj = 0; bj < 2; ++bj) { const f32x4 v0 = acc[ai][bj][m][0] * s, v1 = acc[ai][bj][m][1] * s;
                    v4u w; w.x = cvt_pk_bf16(v0[0], v0[1]); w.y = cvt_pk_bf16(v0[2], v0[3]); w.z = cvt_pk_bf16(v1[0], v1[1]); w.w = cvt_pk_bf16(v1[2], v1[3]);
                    *(v4u*)(rowp + bj * 128) = w; } }
    }
};
template <bool RES_F32, int PV = 0>
struct EpiOutProj {
    static constexpr bool PERM = true, AFTER_DRAIN = false;
    const float* resid; float* part; bf16* HB; unsigned char* HB8; float cs;
    __device__ __forceinline__ void operator()(const f32x4 (&acc)[2][2][4][2], const pg8::Unit& u, int wr, int wc, int fr, int fq) const {
        const int row0 = u.pm * 256 + wr * 64 + fr, col0 = u.pn * 256 + wc * 32 + 8 * fq;
#pragma unroll
        for (int ai = 0; ai < 2; ++ai)
#pragma unroll
            for (int mp = 0; mp < 2; ++mp) {
                f32x4 rf[2][2][2]; v4u rb[2][2];
#pragma unroll
                for (int mm = 0; mm < 2; ++mm) { const size_t off = (size_t)(row0 + ai * 128 + (2 * mp + mm) * 16) * DM + col0;
#pragma unroll
                    for (int bj = 0; bj < 2; ++bj) {
                        if (PV & 1) { rf[mm][bj][0] = (f32x4){0.f, 0.f, 0.f, 0.f}; rf[mm][bj][1] = rf[mm][bj][0]; rb[mm][bj] = (v4u){0u, 0u, 0u, 0u}; }
                        else if (RES_F32) { rf[mm][bj][0] = *(const f32x4*)(resid + off + bj * 128); rf[mm][bj][1] = *(const f32x4*)(resid + off + bj * 128 + 4); }
                        else rb[mm][bj] = *(const v4u*)(HB + off + bj * 128); } }
#pragma unroll
                for (int mm = 0; mm < 2; ++mm) { const int m = 2 * mp + mm; const int row = row0 + ai * 128 + m * 16; const size_t off = (size_t)row * DM + col0; float ss = 0.f;
#pragma unroll
                    for (int bj = 0; bj < 2; ++bj) { f32x4 r0, r1;
                        if (RES_F32) { r0 = rf[mm][bj][0]; r1 = rf[mm][bj][1]; }
                        else { const v4u q = rb[mm][bj]; r0 = (f32x4){bflo(q.x), bfhi(q.x), bflo(q.y), bfhi(q.y)}; r1 = (f32x4){bflo(q.z), bfhi(q.z), bflo(q.w), bfhi(q.w)}; }
                        const f32x4 v0 = r0 + acc[ai][bj][m][0] * cs, v1 = r1 + acc[ai][bj][m][1] * cs;
                        ss += ((v0[0] * v0[0] + v0[1] * v0[1]) + (v0[2] * v0[2] + v0[3] * v0[3])) + ((v1[0] * v1[0] + v1[1] * v1[1]) + (v1[2] * v1[2] + v1[3] * v1[3]));
                        v4u hb; hb.x = cvt_pk_bf16(v0[0], v0[1]); hb.y = cvt_pk_bf16(v0[2], v0[3]); hb.z = cvt_pk_bf16(v1[0], v1[1]); hb.w = cvt_pk_bf16(v1[2], v1[3]);
                        if (!(PV & 2) || hb.x == 0x12345u) *(v4u*)(HB + off + bj * 128) = hb;
                        unsigned w0 = 0u, w1 = 0u; w0 = __builtin_amdgcn_cvt_pk_fp8_f32(v0[0], v0[1], w0, false); w0 = __builtin_amdgcn_cvt_pk_fp8_f32(v0[2], v0[3], w0, true);
                        w1 = __builtin_amdgcn_cvt_pk_fp8_f32(v1[0], v1[1], w1, false); w1 = __builtin_amdgcn_cvt_pk_fp8_f32(v1[2], v1[3], w1, true);
                        if (!(PV & 4) || w0 == 0x12345u) *(v2u*)(HB8 + off + bj * 128) = (v2u){w0, w1}; }
                    ss += swz_xor<16>(ss); ss = add_xor32(ss);
                    if (fq == 0) part[(size_t)row * 32 + u.pn * 4 + wc] = ss; } }
    }
};
struct EpiSiluMul {
    static constexpr bool PERM = true, AFTER_DRAIN = false;
    bf16* O; const float* rstd; const int* rowtok;
    __device__ __forceinline__ void operator()(const f32x4 (&acc)[2][2][4][2], const pg8::Unit& u, int wr, int wc, int fr, int fq) const {
        const int row0 = u.pm * 256 + wr * 64 + fr, col0 = (u.pn & 3) * 128 + wc * 32 + 8 * fq;
        int tk[2][4]; float rsv[2][4];
#pragma unroll
        for (int ai = 0; ai < 2; ++ai)
#pragma unroll
            for (int m = 0; m < 4; ++m) tk[ai][m] = rowtok[row0 + ai * 128 + m * 16];
#pragma unroll
        for (int ai = 0; ai < 2; ++ai)
#pragma unroll
            for (int m = 0; m < 4; ++m) rsv[ai][m] = rstd[tk[ai][m]] * (1.f / SC_W1);
#pragma unroll
        for (int ai = 0; ai < 2; ++ai)
#pragma unroll
            for (int m = 0; m < 4; ++m) { const int row = row0 + ai * 128 + m * 16; float h[8]; const float rs = rsv[ai][m];
#pragma unroll
                for (int n = 0; n < 2; ++n)
#pragma unroll
                    for (int e = 0; e < 4; ++e) { const float g = acc[ai][0][m][n][e] * rs, up = acc[ai][1][m][n][e] * (rs * SC_HID);
                        h[n * 4 + e] = g * up * __builtin_amdgcn_rcpf(1.f + __builtin_amdgcn_exp2f(-g * LOG2E)); }
                unsigned w0 = 0u, w1 = 0u; w0 = __builtin_amdgcn_cvt_pk_fp8_f32(h[0], h[1], w0, false); w0 = __builtin_amdgcn_cvt_pk_fp8_f32(h[2], h[3], w0, true);
                w1 = __builtin_amdgcn_cvt_pk_fp8_f32(h[4], h[5], w1, false); w1 = __builtin_amdgcn_cvt_pk_fp8_f32(h[6], h[7], w1, true);
                *(v2u*)((unsigned char*)O + (size_t)row * EFF + col0) = (v2u){w0, w1}; }
    }
};
struct MoeOrder {
    const int* blk_e; int nunits, ntn, G, c;
    __device__ __forceinline__ bool next(int i, pg8::Unit& u) const {
        const int L = i * G + c; if (L >= nunits) return false;
        const int rb = L / ntn; u.pm = rb; u.pn = blk_e[rb] * ntn + (L - rb * ntn); return true;
    }
    __device__ __forceinline__ void a_ready(const pg8::Unit&) const {}
    __device__ __forceinline__ void done(const pg8::Unit&) const {}
};

struct TrDesc { const float* src; int N; bf16* dst; int dstK; const float* gain; float f8; };
__device__ __forceinline__ TrDesc tr_decode(const Args& a, int r) {
    unsigned char* ws = opaque_ws(a.ws); TrDesc d; d.f8 = 0.f;
    constexpr int R0 = 2560, R1 = 1024, R2 = 1536, R3 = 2048, R4 = 1024, R5 = 32768, R6 = 32768;
    if (r < R0) { const int kb = r / 160, nb = r % 160; d.src = a.in[I_W_INA] + (size_t)(128 * kb) * 5120 + 32 * nb; d.N = 5120; d.dst = (bf16*)(ws + WS_W_INA + (size_t)(32 * nb) * DM + 128 * kb); d.dstK = DM; d.gain = a.in[I_ATTN_G] + 128 * kb; d.f8 = SC_W1; return d; } r -= R0;
    if (r < R1) { const int kb = r / 64, nb = r % 64; d.src = a.in[I_W_INB] + (size_t)(128 * kb) * 2048 + 32 * nb; d.N = 2048; d.dst = (bf16*)(ws + WS_W_INB + (size_t)(32 * nb) * DM + 128 * kb); d.dstK = DM; d.gain = a.in[I_ATTN_G] + DM + 128 * kb; d.f8 = SC_W1; return d; } r -= R1;
    if (r < R2) { const int kb = r / 96, nb = r % 96; d.src = a.in[I_W_KVB] + (size_t)(128 * kb) * 3072 + 32 * nb; d.N = 3072; d.dst = (bf16*)(ws + WS_W_INB + (size_t)(2048 + 32 * nb) * DM + 128 * kb); d.dstK = DM; d.gain = a.in[I_KV_G] + 128 * kb; d.f8 = SC_W1; return d; } r -= R2;
    if (r < R3) { const int l = r / 1024, rr = r % 1024, kb = rr / 64, nb = rr % 64; d.src = a.in[I_W_OUT] + (size_t)l * DM * DM + (size_t)(128 * kb) * 2048 + 32 * nb; d.N = 2048;
        d.dst = (bf16*)(ws + WS_W_OUT + (size_t)l * DM * DM + (size_t)(32 * nb) * DM + 128 * kb); d.f8 = SC_W1;
        d.dstK = DM; d.gain = nullptr; return d; } r -= R3;
    if (r < R4) { const int l = r / 512, rr = r % 512, kb = rr / 32, nb = rr % 32; d.src = a.in[I_W_MKV] + (size_t)l * DM * 1024 + (size_t)(128 * kb) * 1024 + 32 * nb; d.N = 1024;
        d.dst = (bf16*)(ws + WS_W_MKV) + (size_t)l * 1024 * DM + (size_t)(32 * nb) * DM + 128 * kb; d.dstK = DM; d.gain = a.in[I_MEM_G] + l * DM + 128 * kb; return d; } r -= R4;
    if (r < R5 + R6) { const int up = r >= R5 ? 1 : 0; if (up) r -= R5;
        const int le = r / 256, rr = r % 256, kb = rr / 16, nb = rr % 16, n0 = 32 * nb, drow = (n0 >> 7) * 256 + (n0 & 127) + up * 128;
        d.src = (up ? a.in[I_W_UP] : a.in[I_W_GATE]) + (size_t)le * DM * EFF + (size_t)(128 * kb) * EFF + n0; d.N = EFF;
        d.dst = (bf16*)(ws + WS_W_E1 + ((size_t)le * 1024 + drow) * DM + 128 * kb); d.dstK = DM; d.gain = a.in[I_FFN_G] + (le >> 6) * DM + 128 * kb; d.f8 = SC_W1; return d; } r -= R5 + R6;
    { const int le = r / 256, rr = r % 256, kb = rr / 64, nb = rr % 64; d.src = a.in[I_W_DOWN] + (size_t)le * EFF * DM + (size_t)(128 * kb) * DM + 32 * nb; d.N = DM;
        d.dst = (bf16*)(ws + WS_W_E2 + ((size_t)le * DM + 32 * nb) * EFF + 128 * kb); d.dstK = EFF; d.gain = nullptr; d.f8 = SC_W2; return d; }
}
__device__ __forceinline__ float row_to_fp8(const float* xrow, unsigned char* orow, int lane) {
    const GAS f32x4* xr = (const GAS f32x4*)xrow + lane;
    f32x4 v[8]; float s = 0.f;
#pragma unroll
    for (int j = 0; j < 8; ++j) { v[j] = xr[64 * j]; s += (v[j].x * v[j].x + v[j].y * v[j].y) + (v[j].z * v[j].z + v[j].w * v[j].w); }
    const float rstd = 1.0f / sqrtf(wave_sum(s) * (1.f / DM) + RMS_EPS);
    GAS unsigned* o4 = (GAS unsigned*)orow + lane;
#pragma unroll
    for (int j = 0; j < 8; ++j) { unsigned w = 0u; w = __builtin_amdgcn_cvt_pk_fp8_f32(v[j].x, v[j].y, w, false); w = __builtin_amdgcn_cvt_pk_fp8_f32(v[j].z, v[j].w, w, true); o4[64 * j] = w; }
    return rstd;
}
__device__ __forceinline__ float row_to_bf16(const float* xrow, bf16* orow, bool normalise, int lane) {
    const GAS f32x4* xr = (const GAS f32x4*)xrow + lane;
    f32x4 v[8]; float s = 0.f;
#pragma unroll
    for (int j = 0; j < 8; ++j) { v[j] = xr[64 * j]; s += (v[j].x * v[j].x + v[j].y * v[j].y) + (v[j].z * v[j].z + v[j].w * v[j].w); }
    const float rstd = 1.0f / sqrtf(wave_sum(s) * (1.f / DM) + RMS_EPS);
    const float f = normalise ? rstd : 1.f;
    GAS unsigned long long* o8 = (GAS unsigned long long*)orow + lane;
#pragma unroll
    for (int j = 0; j < 8; ++j) o8[64 * j] = (unsigned long long)pk2(v[j].x * f, v[j].y * f) | ((unsigned long long)pk2(v[j].z * f, v[j].w * f) << 32);
    return rstd;
}
#define TR_IDX(i) (layer < 0 ? (i) : 8192 + ((i) / 16384) * 32768 + layer * 16384 + ((i) % 16384))
__device__ __forceinline__ void tr_loop(const Args& a, LAS float* scr, int lane, int it, int end, int stride, int layer) {
    const int first0 = it < end ? it : 0;
    {
        float v[64];
        const int lr = lane >> 5, lc = lane & 31;
        TrDesc cur = tr_decode(a, TR_IDX(it < end ? it : first0));
        if (it < end) {
#pragma unroll
            for (int i = 0; i < 64; ++i) v[i] = __builtin_nontemporal_load(cur.src + (size_t)(2 * i + lr) * cur.N + lc);
        }
        for (; it < end; it += stride) {
#pragma unroll
            for (int i = 0; i < 64; ++i) scr[(2 * i + lr) * 33 + lc] = v[i];
            LDS_WAIT(); asm volatile("" ::: "memory");
            const int nx = it + stride; const bool has_next = nx < end;
            const TrDesc nd = tr_decode(a, TR_IDX(has_next ? nx : it));
            if (has_next) {
#pragma unroll
                for (int i = 0; i < 64; ++i) v[i] = __builtin_nontemporal_load(nd.src + (size_t)(2 * i + lr) * nd.N + lc);
            }
            if (cur.f8 != 0.f) {
                const int c = lane & 7, nq = lane >> 3; const float f = cur.f8;
                f32x4 g[4];
#pragma unroll
                for (int q = 0; q < 4; ++q) g[q] = cur.gain ? *(const f32x4*)(cur.gain + 16 * c + 4 * q) * f : (f32x4){f, f, f, f};
#pragma unroll
                for (int j = 0; j < 4; ++j) { const int n = nq + 8 * j; const LAS float* sp = scr + (16 * c) * 33 + n; v4u o;
#pragma unroll
                    for (int q = 0; q < 4; ++q) { unsigned w = 0u;
                        w = __builtin_amdgcn_cvt_pk_fp8_f32(sp[(4 * q + 0) * 33] * g[q][0], sp[(4 * q + 1) * 33] * g[q][1], w, false);
                        w = __builtin_amdgcn_cvt_pk_fp8_f32(sp[(4 * q + 2) * 33] * g[q][2], sp[(4 * q + 3) * 33] * g[q][3], w, true); o[q] = w; }
                    *(GAS v4u*)((unsigned char*)cur.dst + (size_t)n * cur.dstK + 16 * c) = o; }
            } else {
                const int c = lane & 15, nq = lane >> 4;
                f32x4 g0 = (f32x4){1.f, 1.f, 1.f, 1.f}, g1 = g0;
                if (cur.gain) { g0 = *(const f32x4*)(cur.gain + 8 * c); g1 = *(const f32x4*)(cur.gain + 8 * c + 4); }
#pragma unroll
                for (int j = 0; j < 8; ++j) { const int n = nq + 4 * j; const LAS float* sp = scr + (8 * c) * 33 + n;
                    v4u o; o.x = pk2(sp[0 * 33] * g0[0], sp[1 * 33] * g0[1]); o.y = pk2(sp[2 * 33] * g0[2], sp[3 * 33] * g0[3]); o.z = pk2(sp[4 * 33] * g1[0], sp[5 * 33] * g1[1]); o.w = pk2(sp[6 * 33] * g1[2], sp[7 * 33] * g1[3]);
                    *(GAS v4u*)(cur.dst + (size_t)n * cur.dstK + 8 * c) = o; }
            }
            LDS_WAIT(); asm volatile("" ::: "memory");
            cur = nd;
        }
    }
}
#undef TR_IDX
constexpr int EXP_ITEMS = 49152, CONV_CH = 48, CONV_NCH = EXP_ITEMS / CONV_CH, CONV_IN = 512, CONV_SP = 256;
__device__ __forceinline__ void conv_chunk(const Args& a, LAS unsigned char* lds, int layer, int c) {
    const int tid = opaque_tid(), lane = tid & 63, wave = __builtin_amdgcn_readfirstlane(tid >> 6);
    tr_loop(a, (LAS float*)(lds + RING_OFF + wave * 16896), lane, c * CONV_CH + wave, (c + 1) * CONV_CH, 8, layer);
    __syncthreads();
}
struct Mix { bool conv; int idx; };
__device__ __forceinline__ Mix mix_decode(int u, int NA, int NC) {
    const long U = NA + NC; const int cb = (int)(((long)u * NC) / U), cb1 = (int)(((long)(u + 1) * NC) / U);
    Mix m; m.conv = cb1 != cb; m.idx = m.conv ? cb : u - cb; return m;
}
__device__ __forceinline__ void phase_prep(const Args& a, LAS unsigned char* lds, int G, int vb) {
    const int tid = opaque_tid(), lane = tid & 63, wave = __builtin_amdgcn_readfirstlane(tid >> 6);
    unsigned char* ws = opaque_ws(a.ws);
    LAS float* scr = (LAS float*)(lds + RING_OFF + wave * 16896);
    const int gw = vb * 8 + wave, NGW = G * 8;
    tr_loop(a, scr, lane, gw, 8192, NGW, -1);
    for (int idx = vb * 512 + tid; idx < 2 * NRTP * DM; idx += G * 512) {
        const int l = idx / (NRTP * DM), j = (idx / DM) % NRTP, k = idx % DM;
        float v = 0.f;
        if (j < 8) v = a.in[I_W_RG][((size_t)l * DM + k) * 8 + j]; else if (j < NRT) v = a.in[I_W_RE][((size_t)l * DM + k) * 64 + (j - 8)];
        v *= a.in[I_FFN_G][l * DM + k];
        const unsigned hi = f2bf(v); const float lo = v - bf2f((unsigned short)hi);
        bf16* wr = (bf16*)(ws + WS_W_RT) + (size_t)l * 2 * NRTP * DM;
        wr[(size_t)j * DM + k] = (bf16)hi; wr[(size_t)(NRTP + j) * DM + k] = (bf16)f2bf(lo);
    }
    for (int idx = vb * 512 + tid; idx < 2 * 5 * HD; idx += G * 512) { const int l = idx / (5 * HD), w = (idx / HD) % 5, i = idx % HD; float v;
        if (l == 0) v = (w < 2) ? a.in[I_QN_A][i] : (w == 2) ? a.in[I_QN_MEM][i] : a.in[I_KN_A][i];
        else v = (w == 0) ? a.in[I_QN_B][i] : (w == 1) ? a.in[I_QN_B][HD + i] : (w == 2) ? a.in[I_QN_MEM][HD + i] : (w == 3) ? a.in[I_KN_B][i] : a.in[I_KN_B][HD + i];
        ((float*)(ws + WS_SMALL + SM_GAINTAB))[idx] = v; }
    float* rstd = (float*)(ws + WS_SMALL + SM_RSTD);
    for (int m = gw; m < T; m += NGW) { const float rs = row_to_fp8(a.in[I_X] + (size_t)m * DM, ws + WS_HB8 + (size_t)m * DM, lane); if (lane == 0) rstd[m] = rs; }
    for (int m = gw; m < NB * NMEM; m += NGW) (void)row_to_bf16(a.in[I_MEM] + (size_t)m * DM, (bf16*)(ws + WS_SMALL + SM_MEMN) + (size_t)m * DM, true, lane);
}

struct PostDesc { const bf16* src; int sp; bf16* dst; int dp; const float* gain; float scale; float* kmean; };
__device__ __forceinline__ void post_unit(const PostDesc& d, LAS unsigned char* lds) {
    const int tid = opaque_tid(), lane = tid & 63, wave = __builtin_amdgcn_readfirstlane(tid >> 6), c = lane & 15, rg = lane >> 4;
    float g8[8]; float cs[8];
#pragma unroll
    for (int i = 0; i < 8; ++i) { g8[i] = d.gain ? d.gain[8 * c + i] * d.scale : 1.f; cs[i] = 0.f; }
    v4u wv[8];
#pragma unroll
    for (int it = 0; it < 8; ++it) wv[it] = *(const v4u*)(d.src + (size_t)(wave * 32 + it * 4 + rg) * d.sp + 8 * c);
#pragma unroll
    for (int it = 0; it < 8; ++it) {
        const int row = wave * 32 + it * 4 + rg;
        const v4u w = wv[it];
        float f[8] = {bflo(w.x), bfhi(w.x), bflo(w.y), bfhi(w.y), bflo(w.z), bfhi(w.z), bflo(w.w), bfhi(w.w)};
        if (d.gain) {
            float ss = 0.f;
#pragma unroll
            for (int i = 0; i < 8; ++i) ss += f[i] * f[i];
            ss += swz_xor<1>(ss); ss += swz_xor<2>(ss); ss += swz_xor<4>(ss); ss += swz_xor<8>(ss);
            const float rstd = 1.0f / sqrtf(ss * (1.f / HD) + RMS_EPS);
#pragma unroll
            for (int i = 0; i < 8; ++i) { f[i] = f[i] * rstd * g8[i]; cs[i] += f[i]; }
        }
        v4u o; o.x = pk2(f[0], f[1]); o.y = pk2(f[2], f[3]); o.z = pk2(f[4], f[5]); o.w = pk2(f[6], f[7]);
        *(v4u*)(d.dst + (size_t)row * d.dp + 8 * c) = o;
    }
    if (d.kmean) {
        LAS float* ks = (LAS float*)(lds + RING_OFF);
#pragma unroll
        for (int i = 0; i < 8; ++i) { cs[i] += swz_xor<16>(cs[i]); cs[i] = add_xor32(cs[i]); }
        if (lane < 16) {
#pragma unroll
            for (int i = 0; i < 8; ++i) ks[wave * 128 + 8 * c + i] = cs[i]; }
        __syncthreads();
        if (tid < 128) { float s = 0.f;
#pragma unroll
            for (int w = 0; w < 8; ++w) s += ks[w * 128 + tid];
            d.kmean[tid] = s * (1.f / 256.f); }
        __syncthreads();
    }
}
__device__ __forceinline__ void phase_post_mem(const Args& a, LAS unsigned char* lds, int G, int vb) {
    unsigned char* ws = opaque_ws(a.ws);
    for (int v = vb; v < 32; v += G) {
        PostDesc d; d.kmean = nullptr; d.scale = 1.f; d.gain = nullptr;
        const int l = v >> 4, b = (v >> 3) & 1, s8 = v & 7;
        const bf16* srow = (const bf16*)(ws + WS_SMALL + SM_KVM) + ((size_t)b * 256) * 2048 + l * 1024; d.sp = 2048; d.dp = HD;
        if (s8 < 4) { d.src = srow + s8 * 128; d.dst = (bf16*)(ws + WS_SMALL + SM_KM) + ((size_t)((l * 2 + b) * 4 + s8) * NMEM) * HD; d.gain = a.in[I_KN_MEM] + l * HD; }
        else { d.src = srow + 512 + (s8 - 4) * 128; d.dst = (bf16*)(ws + WS_SMALL + SM_VM) + ((size_t)((l * 2 + b) * 4 + (s8 - 4)) * NMEM) * HD; }
        post_unit(d, lds);
    }
}
struct SlotDesc { bf16* dst; int dp; const float* gain; float scale; float* kmean; };
__device__ __forceinline__ SlotDesc slot_desc(unsigned char* ws, int layer, int sl, int pm) {
    const float* gt = (const float*)(ws + WS_SMALL + SM_GAINTAB) + layer * 5 * HD;
    bf16* QH = (bf16*)(ws + WS_QH); bf16* KH = (bf16*)(ws + WS_KH); bf16* VH = (bf16*)(ws + WS_VH);
    const int t0 = pm * 256, b = pm >> 5, s0 = (pm & 31) * 256;
    SlotDesc d; d.kmean = nullptr; d.scale = 1.f; d.gain = nullptr;
    if (layer == 0) {
        if (sl < 12) { d.dst = QH + (size_t)t0 * DM + sl * 128; d.dp = DM; d.gain = gt; d.scale = QSCALE; }
        else if (sl < 24) { const int h = sl - 12; d.dst = KH + ((size_t)(b * 12 + h) * SEQ + s0) * HD; d.dp = HD; d.gain = gt + 3 * HD;
            d.kmean = (float*)(ws + WS_SMALL + SM_KMEAN) + ((size_t)(b * 12 + h) * 32 + (pm & 31)) * HD; }
        else if (sl < 36) { const int h = sl - 24; d.dst = VH + ((size_t)(b * 12 + h) * SEQ + s0) * HD; d.dp = HD; }
        else { const int h = sl - 36; d.dst = QH + (size_t)t0 * DM + (12 + h) * 128; d.dp = DM; d.gain = gt + 2 * HD; d.scale = QSCALE; }
    } else {
        if (sl < 6) { d.dst = QH + (size_t)t0 * DM + sl * 128; d.dp = DM; d.gain = gt; d.scale = QSCALE; }
        else if (sl < 12) { d.dst = QH + (size_t)t0 * DM + sl * 128; d.dp = DM; d.gain = gt + HD; d.scale = QSCALE; }
        else if (sl < 16) { d.dst = QH + (size_t)t0 * DM + sl * 128; d.dp = DM; d.gain = gt + 2 * HD; d.scale = QSCALE; }
        else if (sl < 22) { const int h = sl - 16; d.dst = KH + ((size_t)(b * 12 + h) * SEQ + s0) * HD; d.dp = HD; d.gain = gt + 3 * HD; }
        else if (sl < 28) { const int h = sl - 22; d.dst = KH + ((size_t)(b * 12 + 6 + h) * SEQ + s0) * HD; d.dp = HD; d.gain = gt + 4 * HD; }
        else { const int vh = sl - 28, h = vh >> 1, cc = vh & 1; d.dst = VH + ((size_t)(b * 6 + h) * SEQ + s0) * DV + cc * 128; d.dp = DV; }
    }
    return d;
}
template <int PV>
struct EpiHeadNormT {
    static constexpr bool PERM = true, AFTER_DRAIN = false;
    unsigned char* ws; int layer; float cs;
    __device__ __forceinline__ void operator()(const f32x4 (&acc)[2][2][4][2], const pg8::Unit& u, int wr, int wc, int fr_in, int fq_in) const {
        int fr = fr_in, fq = fq_in; asm volatile("" : "+v"(fr), "+v"(fq));
        LAS float* P = (LAS float*)(uintptr_t)LDSX_OFF;
        LAS float* KS = (LAS float*)(uintptr_t)(LDSX_OFF + 8192);
        const float* rs = (const float*)(ws + WS_SMALL + SM_RSTD);
        const SlotDesc d0 = slot_desc(ws, layer, 2 * u.pn, u.pm), d1 = slot_desc(ws, layer, 2 * u.pn + 1, u.pm);
        const int rowl = wr * 64 + fr, coll = wc * 32 + 8 * fq;
        const float* rsr = rs + u.pm * 256 + rowl;
        float rt[2][4];
#pragma unroll
        for (int ai = 0; ai < 2; ++ai)
#pragma unroll
            for (int m = 0; m < 4; ++m) rt[ai][m] = rsr[ai * 128 + m * 16] * cs;
        f32x4 gg[2][2];
#pragma unroll
        for (int bj = 0; bj < 2; ++bj) { const SlotDesc& d = bj == 0 ? d0 : d1; gg[bj][0] = (f32x4){1.f, 1.f, 1.f, 1.f}; gg[bj][1] = gg[bj][0];
            if (d.gain) { gg[bj][0] = *(const f32x4*)(d.gain + coll) * d.scale; gg[bj][1] = *(const f32x4*)(d.gain + coll + 4) * d.scale; } }
#pragma unroll
        for (int ai = 0; ai < 2; ++ai)
#pragma unroll
            for (int m = 0; m < 4; ++m) { const int row = rowl + ai * 128 + m * 16; const float rtv = rt[ai][m];
#pragma unroll
                for (int bj = 0; bj < 2; ++bj) { if ((bj == 0 ? d0.gain : d1.gain) != nullptr) {
                    const f32x4 v0 = acc[ai][bj][m][0] * rtv, v1 = acc[ai][bj][m][1] * rtv;
                    float ss = (v0[0] * v0[0] + v0[1] * v0[1]) + (v0[2] * v0[2] + v0[3] * v0[3]) + (v1[0] * v1[0] + v1[1] * v1[1]) + (v1[2] * v1[2] + v1[3] * v1[3]);
                    ss += swz_xor<16>(ss); ss = add_xor32(ss);
                    if (fq == 0 && !(PV & 2)) P[(row * 2 + bj) * 4 + wc] = ss; } } }
        if (!(PV & 2)) { asm volatile("s_waitcnt lgkmcnt(0)" ::: "memory"); __builtin_amdgcn_s_barrier(); asm volatile("" ::: "memory"); }
#pragma unroll
        for (int bj = 0; bj < 2; ++bj) { const SlotDesc& d = bj == 0 ? d0 : d1;
            const f32x4 g0 = gg[bj][0], g1 = gg[bj][1];
            f32x4 c0 = (f32x4){0.f, 0.f, 0.f, 0.f}, c1 = c0;
#pragma unroll
            for (int ai = 0; ai < 2; ++ai)
#pragma unroll
                for (int m = 0; m < 4; ++m) { const int row = rowl + ai * 128 + m * 16; float f = rt[ai][m];
                    if (d.gain) { const f32x4 p4 = *(const LAS f32x4*)(P + (row * 2 + bj) * 4); f *= 1.0f / sqrtf(((p4[0] + p4[1]) + (p4[2] + p4[3])) * (1.f / HD) + RMS_EPS); }
                    const f32x4 v0 = acc[ai][bj][m][0] * f * g0, v1 = acc[ai][bj][m][1] * f * g1;
                    if (d.kmean) { c0 += v0; c1 += v1; }
                    v4u w; w.x = cvt_pk_bf16(v0[0], v0[1]); w.y = cvt_pk_bf16(v0[2], v0[3]); w.z = cvt_pk_bf16(v1[0], v1[1]); w.w = cvt_pk_bf16(v1[2], v1[3]);
                    if (!(PV & 1) || w.x == 0x12345u) *(v4u*)(d.dst + (size_t)row * d.dp + coll) = w; }
            if (d.kmean && !(PV & 4)) {
#pragma unroll
                for (int i = 0; i < 4; ++i) { float v = c0[i]; v += swz_xor<1>(v); v += swz_xor<2>(v); v += swz_xor<4>(v); v += swz_xor<8>(v); if (fr == 0) KS[wr * 256 + bj * 128 + coll + i] = v;
                                              float w_ = c1[i]; w_ += swz_xor<1>(w_); w_ += swz_xor<2>(w_); w_ += swz_xor<4>(w_); w_ += swz_xor<8>(w_); if (fr == 0) KS[wr * 256 + bj * 128 + coll + 4 + i] = w_; } } }
        if (d0.kmean && !(PV & 4)) {
            asm volatile("s_waitcnt lgkmcnt(0)" ::: "memory"); __builtin_amdgcn_s_barrier(); asm volatile("" ::: "memory");
            const int t = (wr * 4 + wc) * 64 + fq * 16 + fr;
            if (t < 256) { const float mean = (KS[t] + KS[256 + t]) * (1.f / 256.f); float* km = (t < 128) ? d0.kmean : d1.kmean; km[t & 127] = mean; }
        }
    }
};
using EpiHeadNorm = EpiHeadNormT<0>;
__device__ __forceinline__ void phase_gate(const Args& a, LAS unsigned char* lds, int G, int vb) {
    unsigned char* ws = opaque_ws(a.ws);
    const bf16* QH = (const bf16*)(ws + WS_QH); const float* KMEAN = (const float*)(ws + WS_SMALL + SM_KMEAN); unsigned* SEL = (unsigned*)(ws + WS_SMALL + SM_SEL);
    gu32* MC = (gu32*)(ws + WS_CTL) + CW_MC; unsigned* LISTF = (unsigned*)(ws + WS_LISTF); unsigned* LISTA = (unsigned*)(ws + WS_LISTA);
    const int tid_g = opaque_tid();
    LAS float* kml = (LAS float*)(lds + RING_OFF);
    for (int idx = vb * 512 + tid_g; idx < NB * MOBA_H * SEQ; idx += G * 512) {
        const int bh = idx / SEQ, s = idx % SEQ, b = bh / MOBA_H, h = bh % MOBA_H, own = s >> 8;
        __syncthreads();
        { const f32x4* src = (const f32x4*)(KMEAN + (size_t)bh * 32 * HD); ((LAS f32x4*)kml)[tid_g] = src[tid_g]; ((LAS f32x4*)kml)[512 + tid_g] = src[512 + tid_g]; }
        __syncthreads();
        unsigned mask = 0u;
        if (own <= 3) { mask = (1u << own) - 1u; }
        else {
            float acc[31];
#pragma unroll
            for (int j = 0; j < 31; ++j) acc[j] = 0.f;
            const bf16* q = QH + ((size_t)b * SEQ + s) * DM + h * HD;
            for (int c = 0; c < 16; ++c) {
                const v4u w = *(const v4u*)(q + 8 * c);
                const float f0 = bflo(w.x), f1 = bfhi(w.x), f2 = bflo(w.y), f3 = bfhi(w.y), f4 = bflo(w.z), f5 = bfhi(w.z), f6 = bflo(w.w), f7 = bfhi(w.w);
#pragma unroll
                for (int j = 0; j < 31; ++j) if (j < own) {
                    const f32x4 k0 = *(const LAS f32x4*)(kml + j * HD + 8 * c), k1 = *(const LAS f32x4*)(kml + j * HD + 8 * c + 4);
                    acc[j] += (f0 * k0[0] + f1 * k0[1]) + (f2 * k0[2] + f3 * k0[3]) + (f4 * k1[0] + f5 * k1[1]) + (f6 * k1[2] + f7 * k1[3]); }
            }
#pragma unroll
            for (int rnd = 0; rnd < 3; ++rnd) { float best = -__builtin_inff(); int bi = 0;
#pragma unroll
                for (int j = 0; j < 31; ++j) if (j < own && !((mask >> j) & 1u) && acc[j] > best) { best = acc[j]; bi = j; }
                mask |= 1u << bi; }
        }
        SEL[idx] = mask;
        { const int lane_ = tid_g & 63; const unsigned long long lt = (1ull << lane_) - 1ull;
          for (int j = 0; j < own; ++j) {
              const bool selj = (mask >> j) & 1u; const unsigned long long bal = __ballot(selj);
              if (bal == 0ull) continue;
              const int far = (j == own - 1) ? 0 : 1; const int lead = __builtin_ctzll(bal);
              unsigned base = 0u; if (lane_ == lead) base = __hip_atomic_fetch_add(MC + (bh * 32 + j) * 2 + far, (unsigned)__builtin_popcountll(bal), RLX_AGENT);
              base = __shfl(base, lead);
              if (selj) { const unsigned pos = base + (unsigned)__builtin_popcountll(bal & lt); const int slot = __builtin_popcount(mask & ((1u << j) - 1u));
                  const unsigned ent = (unsigned)s | ((unsigned)slot << 16);
                  if (far) LISTF[((size_t)bh * 32 + j) * 8192 + pos] = ent; else LISTA[((size_t)bh * 32 + j) * 256 + pos] = ent; } } }
    }
}

namespace att {
constexpr int SHM_T = 16384;
#define KSWZ(row, colB) ((row) * 256 + ((colB) ^ (((row) & 7) << 4)))
#define SBAR() __builtin_amdgcn_sched_barrier(0)
__device__ __forceinline__ int v_rd_base(int lane) { return ((lane & 3) << 3) | (((lane >> 2) & 3) << 6) | (((lane >> 4) & 1) << 5) | (((lane >> 5) & 1) << 8); }
__device__ __forceinline__ int crow(int r, int hi) { return (r & 3) + 8 * (r >> 2) + 4 * hi; }
__device__ __forceinline__ unsigned cvtpk(float lo, float hi) { unsigned r; asm volatile("v_cvt_pk_bf16_f32 %0, %1, %2" : "=v"(r) : "v"(lo), "v"(hi)); return r; }
__device__ __forceinline__ int swap23(int k) { return (k & ~0xC) | ((k & 4) << 1) | ((k & 8) >> 1); }
__device__ __forceinline__ void glds16(const void* sbase  , unsigned voff, unsigned lds_dst) { unsigned keep;
    asm volatile("s_mov_b32 %0, m0\n\ts_mov_b32 m0, %3\n\ts_nop 0\n\tglobal_load_lds_dwordx4 %1, %2\n\ts_mov_b32 m0, %0" : "=&s"(keep) : "v"(voff), "s"(sbase), "s"(lds_dst) : "memory"); }
#define WAIT_BAR0() asm volatile("s_waitcnt vmcnt(0) lgkmcnt(0)\n\ts_barrier" ::: "memory")
constexpr float THR2 = 11.5f;

__device__ __forceinline__ void qkt(f32x16& p0, f32x16& p1, const LAS char* Kt, int r32, int hi, const bf16x8* qr) {
#pragma unroll
    for (int r = 0; r < 16; ++r) { p0[r] = 0.f; p1[r] = 0.f; }
    const LAS char* kb0 = Kt + KSWZ(r32, (0 * 16 + hi * 8) * 2);
    const LAS char* kb1 = Kt + KSWZ(r32, (1 * 16 + hi * 8) * 2);
    const LAS char* kb2 = Kt + KSWZ(r32, (2 * 16 + hi * 8) * 2);
    const LAS char* kb3 = Kt + KSWZ(r32, (3 * 16 + hi * 8) * 2);
#pragma unroll
    for (int d0 = 0; d0 < 8; ++d0) { const LAS char* a = ((d0 & 3) == 0 ? kb0 : (d0 & 3) == 1 ? kb1 : (d0 & 3) == 2 ? kb2 : kb3) + (d0 >> 2) * 128;
        const bf16x8 b0 = *(const LAS bf16x8*)a;
        const bf16x8 b1 = *(const LAS bf16x8*)(a + 32 * 256);
        p0 = __builtin_amdgcn_mfma_f32_32x32x16_bf16(b0, qr[d0], p0, 0, 0, 0);
        p1 = __builtin_amdgcn_mfma_f32_32x32x16_bf16(b1, qr[d0], p1, 0, 0, 0); }
}
__device__ __forceinline__ void pv_tile(f32x16* o, int vb, bf16x8 pa0, bf16x8 pa1, bf16x8 pa2, bf16x8 pa3) {
#define TRRD(dst, off) asm volatile("ds_read_b64_tr_b16 %0, %1 offset:%2" : "=&v"(dst) : "v"(vb), "i"(off) : "memory")
#define PV_RD(S_, d0) do { constexpr int b_ = (d0) * 512; TRRD(S_##l0, b_); TRRD(S_##h0, b_ + 2048); TRRD(S_##l1, b_ + 4096); TRRD(S_##h1, b_ + 6144); \
        TRRD(S_##l2, b_ + 8192); TRRD(S_##h2, b_ + 10240); TRRD(S_##l3, b_ + 12288); TRRD(S_##h3, b_ + 14336); } while (0)
#define PV_MM(S_, d0) do { \
        o[d0] = __builtin_amdgcn_mfma_f32_32x32x16_bf16(pa0, (bf16x8){S_##l0[0], S_##l0[1], S_##l0[2], S_##l0[3], S_##h0[0], S_##h0[1], S_##h0[2], S_##h0[3]}, o[d0], 0, 0, 0); \
        o[d0] = __builtin_amdgcn_mfma_f32_32x32x16_bf16(pa1, (bf16x8){S_##l1[0], S_##l1[1], S_##l1[2], S_##l1[3], S_##h1[0], S_##h1[1], S_##h1[2], S_##h1[3]}, o[d0], 0, 0, 0); \
        o[d0] = __builtin_amdgcn_mfma_f32_32x32x16_bf16(pa2, (bf16x8){S_##l2[0], S_##l2[1], S_##l2[2], S_##l2[3], S_##h2[0], S_##h2[1], S_##h2[2], S_##h2[3]}, o[d0], 0, 0, 0); \
        o[d0] = __builtin_amdgcn_mfma_f32_32x32x16_bf16(pa3, (bf16x8){S_##l3[0], S_##l3[1], S_##l3[2], S_##l3[3], S_##h3[0], S_##h3[1], S_##h3[2], S_##h3[3]}, o[d0], 0, 0, 0); } while (0)
#define WL(n) asm volatile("s_waitcnt lgkmcnt(" #n ")" ::: "memory")
    s16x4 Al0, Al1, Al2, Al3, Ah0, Ah1, Ah2, Ah3, Bl0, Bl1, Bl2, Bl3, Bh0, Bh1, Bh2, Bh3;
    PV_RD(A, 0); SBAR();
    PV_RD(B, 1); WL(8); SBAR(); PV_MM(A, 0); SBAR();
    PV_RD(A, 2); WL(8); SBAR(); PV_MM(B, 1); SBAR();
    PV_RD(B, 3); WL(8); SBAR(); PV_MM(A, 2); SBAR();
    WL(0); SBAR(); PV_MM(B, 3);
#undef PV_RD
#undef PV_MM
#undef TRRD
}
__device__ __forceinline__ void softmax_tile(f32x16& p0, f32x16& p1, float& m_reg, float& l_reg, float& alpha, bf16x8& pa0, bf16x8& pa1, bf16x8& pa2, bf16x8& pa3) {
    float pmax = p0[0];
#pragma unroll
    for (int r = 1; r < 16; ++r) pmax = fmaxf(pmax, p0[r]);
#pragma unroll
    for (int r = 0; r < 16; ++r) pmax = fmaxf(pmax, p1[r]);
    { auto rr = __builtin_amdgcn_permlane32_swap(__float_as_uint(pmax), __float_as_uint(pmax), false, false);
      pmax = fmaxf(__uint_as_float(rr[0]), __uint_as_float(rr[1])); }
    const float mn = (pmax - m_reg <= THR2) ? m_reg : fmaxf(m_reg, pmax);
    alpha = __builtin_amdgcn_exp2f(m_reg - mn); m_reg = mn;
#pragma unroll
    for (int r = 0; r < 16; ++r) { p0[r] = __builtin_amdgcn_exp2f(p0[r] - mn); p1[r] = __builtin_amdgcn_exp2f(p1[r] - mn); }
    float ps = 0.f;
#pragma unroll
    for (int r = 0; r < 16; ++r) ps += p0[r] + p1[r];
    { auto rr = __builtin_amdgcn_permlane32_swap(__float_as_uint(ps), __float_as_uint(ps), false, false);
      ps = __uint_as_float(rr[0]) + __uint_as_float(rr[1]); }
    l_reg = l_reg * alpha + ps;
#define PK4(P, B_, OUT) do { unsigned a0 = cvtpk(P[B_+0], P[B_+1]), a1 = cvtpk(P[B_+2], P[B_+3]); \
        unsigned b0 = cvtpk(P[B_+4], P[B_+5]), b1 = cvtpk(P[B_+6], P[B_+7]); \
        auto r0 = __builtin_amdgcn_permlane32_swap(a0, b0, false, false); auto r1 = __builtin_amdgcn_permlane32_swap(a1, b1, false, false); \
        v4u w = {r0[0], r1[0], r0[1], r1[1]}; OUT = __builtin_bit_cast(bf16x8, w); } while (0)
    PK4(p0, 0, pa0); PK4(p0, 8, pa1); PK4(p1, 0, pa2); PK4(p1, 8, pa3);
#undef PK4
}
__device__ __forceinline__ void bias_mask_tile(f32x16& p0, f32x16& p1, int dq, bool on, bool far, const LAS float* lut) {
    const float NEG = -__builtin_inff();
    if (far) {
        const float c = on ? lut[128] : NEG;
#pragma unroll
        for (int r = 0; r < 16; ++r) { p0[r] += c; p1[r] += c; }
    } else {
#pragma unroll
        for (int r = 0; r < 16; ++r) { const int c = (r & 3) + 8 * (r >> 2); const int d0 = dq - c, d1 = dq - c - 32;
            const float b0 = lut[min(max(d0, 0), 128)], b1 = lut[min(max(d1, 0), 128)];
            p0[r] = (on && d0 >= 0) ? p0[r] + b0 : NEG; p1[r] = (on && d1 >= 0) ? p1[r] + b1 : NEG; }
    }
}

__device__ __forceinline__ void qkt_half(f32x16& p, const LAS char* Kt  , int r32, int hi, const bf16x8* qr) {
#pragma unroll
    for (int r = 0; r < 16; ++r) p[r] = 0.f;
    const LAS char* kb0 = Kt + KSWZ(r32, (0 * 16 + hi * 8) * 2);
    const LAS char* kb1 = Kt + KSWZ(r32, (1 * 16 + hi * 8) * 2);
    const LAS char* kb2 = Kt + KSWZ(r32, (2 * 16 + hi * 8) * 2);
    const LAS char* kb3 = Kt + KSWZ(r32, (3 * 16 + hi * 8) * 2);
#pragma unroll
    for (int d0 = 0; d0 < 8; ++d0) { const LAS char* a = ((d0 & 3) == 0 ? kb0 : (d0 & 3) == 1 ? kb1 : (d0 & 3) == 2 ? kb2 : kb3) + (d0 >> 2) * 128;
        const bf16x8 b0 = *(const LAS bf16x8*)a;
        p = __builtin_amdgcn_mfma_f32_32x32x16_bf16(b0, qr[d0], p, 0, 0, 0); }
}
template <int HALF>
__device__ __forceinline__ void pv_half8(f32x16* o, int vb, bf16x8 pa0, bf16x8 pa1) {
#define TRRD(dst, off) asm volatile("ds_read_b64_tr_b16 %0, %1 offset:%2" : "=&v"(dst) : "v"(vb), "i"(off) : "memory")
#define PV_RD(S_, d0) do { constexpr int b_ = ((d0) & 3) * 512 + ((d0) >> 2) * SHM_T + HALF * 8192; TRRD(S_##l0, b_); TRRD(S_##h0, b_ + 2048); TRRD(S_##l1, b_ + 4096); TRRD(S_##h1, b_ + 6144); } while (0)
#define PV_MM(S_, d0) do { \
        o[d0] = __builtin_amdgcn_mfma_f32_32x32x16_bf16(pa0, (bf16x8){S_##l0[0], S_##l0[1], S_##l0[2], S_##l0[3], S_##h0[0], S_##h0[1], S_##h0[2], S_##h0[3]}, o[d0], 0, 0, 0); \
        o[d0] = __builtin_amdgcn_mfma_f32_32x32x16_bf16(pa1, (bf16x8){S_##l1[0], S_##l1[1], S_##l1[2], S_##l1[3], S_##h1[0], S_##h1[1], S_##h1[2], S_##h1[3]}, o[d0], 0, 0, 0); } while (0)
#define WL(n) asm volatile("s_waitcnt lgkmcnt(" #n ")" ::: "memory")
    s16x4 Al0, Al1, Ah0, Ah1, Bl0, Bl1, Bh0, Bh1;
    PV_RD(A, 0); SBAR();
    PV_RD(B, 1); WL(4); SBAR(); PV_MM(A, 0); SBAR();
    PV_RD(A, 2); WL(4); SBAR(); PV_MM(B, 1); SBAR();
    PV_RD(B, 3); WL(4); SBAR(); PV_MM(A, 2); SBAR();
    PV_RD(A, 4); WL(4); SBAR(); PV_MM(B, 3); SBAR();
    PV_RD(B, 5); WL(4); SBAR(); PV_MM(A, 4); SBAR();
    PV_RD(A, 6); WL(4); SBAR(); PV_MM(B, 5); SBAR();
    PV_RD(B, 7); WL(4); SBAR(); PV_MM(A, 6); SBAR();
    WL(0); SBAR(); PV_MM(B, 7);
#undef PV_RD
#undef PV_MM
#undef WL
#undef TRRD
}
__device__ __forceinline__ void softmax_half(f32x16& p0, float& m_reg, float& l_reg, float& alpha, bf16x8& pa0, bf16x8& pa1) {
    float pmax = p0[0];
#pragma unroll
    for (int r = 1; r < 16; ++r) pmax = fmaxf(pmax, p0[r]);
    { auto rr = __builtin_amdgcn_permlane32_swap(__float_as_uint(pmax), __float_as_uint(pmax), false, false);
      pmax = fmaxf(__uint_as_float(rr[0]), __uint_as_float(rr[1])); }
    const float mn = (pmax - m_reg <= THR2) ? m_reg : fmaxf(m_reg, pmax);
    alpha = __builtin_amdgcn_exp2f(m_reg - mn); m_reg = mn;
#pragma unroll
    for (int r = 0; r < 16; ++r) p0[r] = __builtin_amdgcn_exp2f(p0[r] - mn);
    float ps = 0.f;
#pragma unroll
    for (int r = 0; r < 16; ++r) ps += p0[r];
    { auto rr = __builtin_amdgcn_permlane32_swap(__float_as_uint(ps), __float_as_uint(ps), false, false);
      ps = __uint_as_float(rr[0]) + __uint_as_float(rr[1]); }
    l_reg = l_reg * alpha + ps;
#define PK4(P, B_, OUT) do { unsigned a0 = cvtpk(P[B_+0], P[B_+1]), a1 = cvtpk(P[B_+2], P[B_+3]); \
        unsigned b0 = cvtpk(P[B_+4], P[B_+5]), b1 = cvtpk(P[B_+6], P[B_+7]); \
        auto r0 = __builtin_amdgcn_permlane32_swap(a0, b0, false, false); auto r1 = __builtin_amdgcn_permlane32_swap(a1, b1, false, false); \
        v4u w = {r0[0], r1[0], r0[1], r1[1]}; OUT = __builtin_bit_cast(bf16x8, w); } while (0)
    PK4(p0, 0, pa0); PK4(p0, 8, pa1);
#undef PK4
}
__device__ __forceinline__ void bias_mask_half(f32x16& p0, int dq, bool far, const LAS float* lut) {
    const float NEG = -__builtin_inff();
    if (far) { const float c = lut[128];
#pragma unroll
        for (int r = 0; r < 16; ++r) p0[r] += c;
    } else {
#pragma unroll
        for (int r = 0; r < 16; ++r) { const int c = (r & 3) + 8 * (r >> 2); const int d0 = dq - c;
            const float b0 = lut[min(max(d0, 0), 128)]; p0[r] = (d0 >= 0) ? p0[r] + b0 : NEG; }
    }
}
#define RESC(o_, nd_, al_l_, alpha_) do { if (__any((alpha_) < 1.f)) { if (hi == 0) (al_l_)[r32] = (alpha_); asm volatile("s_waitcnt lgkmcnt(0)" ::: "memory"); \
        _Pragma("unroll") for (int r = 0; r < 16; ++r) { const float f_ = (al_l_)[crow(r, hi)]; _Pragma("unroll") for (int d_ = 0; d_ < (nd_); ++d_) (o_)[d_][r] *= f_; } } } while (0)

template <int MODE, bool F8OUT = false>
__device__ __forceinline__ void attn128_unit(LAS unsigned char* lds, const bf16* Qrow0, const bf16* Kh, const bf16* Vh, bf16* Orow0, int NT, int qb, const unsigned* selrow, const float* relb, int h) {
    const int tid = opaque_tid(), wid = __builtin_amdgcn_readfirstlane(tid >> 6), lane = tid & 63, r32 = lane & 31, hi = lane >> 5;
    LAS float* wsf = (LAS float*)(lds + LDSX_OFF) + wid * 64; LAS float* li_l = wsf; LAS float* al_l = wsf + 32;
    LAS float* lut = (LAS float*)(lds + LDSX_OFF + 2048);
    if (MODE == 0 && tid <= 128) lut[tid] = relb[(tid < 128 ? (int)T5_BUCKET[tid] : 31) * 12 + h] * LOG2E;
    bf16x8 qr[8];
#pragma unroll
    for (int d0 = 0; d0 < 8; ++d0) qr[d0] = *(const bf16x8*)(Qrow0 + (size_t)(wid * 32 + r32) * DM + d0 * 16 + hi * 8);
    unsigned sel = 0u; if (MODE == 0) sel = selrow[wid * 32 + r32];
    const int krow = 4 * wid + (lane >> 4); const unsigned ksrc = (unsigned) krow * 256 + ((16 * (lane & 15)) ^ ((krow & 7) << 4));
    const int vkk = 8 * (wid >> 1) + ((lane & 31) >> 2); const unsigned vsrc = (unsigned) swap23(vkk) * 256 + (32 * (2 * (wid & 1) + (lane >> 5)) + 8 * (lane & 3)) * 2;
    const unsigned lds0 = (unsigned)(uintptr_t)(lds + RING_OFF);
    const char* Kg = (const char*)Kh; const char* Vg = (const char*)Vh;
#define ISSUE(t, s) do { const unsigned base_ = (unsigned)__builtin_amdgcn_readfirstlane(lds0 + (s) * 32768 + wid * 1024); const size_t tb_ = (size_t)(t) * SHM_T; \
        glds16(Kg + tb_, ksrc, base_); glds16(Kg + tb_ + 8192, ksrc, base_ + 8192); glds16(Vg + tb_, vsrc, base_ + SHM_T); glds16(Vg + tb_ + 8192, vsrc, base_ + SHM_T + 8192); } while (0)
    const int vb0 = (int)lds0 + SHM_T + v_rd_base(lane);
    float m_reg = -1e30f, l_reg = 0.f; f32x16 o[4];
#pragma unroll
    for (int d = 0; d < 4; ++d)
#pragma unroll
        for (int r = 0; r < 16; ++r) o[d][r] = 0.f;
    const int q0w = qb * 256 + wid * 32, qpos = q0w + r32;
    ISSUE(0, 0);
    for (int t = 0; t < NT; ++t) {
        WAIT_BAR0();
        if (t + 1 < NT) ISSUE(t + 1, (t + 1) & 1);
        const int s = t & 1;
        f32x16 p0, p1;
        qkt(p0, p1, (const LAS char*)(lds + RING_OFF + s * 32768), r32, hi, qr);
        if (MODE == 0) { const int jb = t >> 2, tk0 = t * 64; const bool on = (jb >= qb) || ((sel >> jb) & 1u); const bool far = (q0w - (tk0 + 63)) >= 128;
            bias_mask_tile(p0, p1, qpos - tk0 - 4 * hi, on, far, lut); }
        float alpha; bf16x8 pa0, pa1, pa2, pa3;
        softmax_tile(p0, p1, m_reg, l_reg, alpha, pa0, pa1, pa2, pa3);
        RESC(o, 4, al_l, alpha);
        pv_tile(o, vb0 + s * 32768, pa0, pa1, pa2, pa3);
    }
#undef ISSUE
    if (hi == 0) li_l[r32] = l_reg; asm volatile("s_waitcnt lgkmcnt(0)" ::: "memory");
    int r32o = r32, hio = hi; asm volatile("" : "+v"(r32o), "+v"(hio));
    bf16* Ow = Orow0 + (size_t)(wid * 32) * DM + r32o;
#pragma unroll
    for (int r = 0; r < 16; ++r) { const int orow = crow(r, hio); const float rli = __builtin_amdgcn_rcpf(li_l[orow]);
#pragma unroll
        for (int d0 = 0; d0 < 4; ++d0) { const float v = o[d0][r] * rli; const float vn = swz_xor<1>(v);
            if (F8OUT) { if ((r32 & 1) == 0) *(unsigned short*)((unsigned char*)Orow0 + (size_t)(wid * 32 + orow) * DM + d0 * 32 + r32o) = (unsigned short)__builtin_amdgcn_cvt_pk_fp8_f32(v * SC_O, vn * SC_O, 0u, false); }
            else if ((r32 & 1) == 0) *(unsigned*)(Ow + (size_t)orow * DM + d0 * 32) = cvtpk(v, vn); } }
    WAIT_BAR0();
}

#define PK4X(P, B_, OUT) do { unsigned a0 = cvtpk(P[B_+0], P[B_+1]), a1 = cvtpk(P[B_+2], P[B_+3]); unsigned b0 = cvtpk(P[B_+4], P[B_+5]), b1 = cvtpk(P[B_+6], P[B_+7]); \
        auto r0 = __builtin_amdgcn_permlane32_swap(a0, b0, false, false); auto r1 = __builtin_amdgcn_permlane32_swap(a1, b1, false, false); v4u w = {r0[0], r1[0], r0[1], r1[1]}; OUT = __builtin_bit_cast(bf16x8, w); } while (0)
template <int VAR>
__device__ __forceinline__ void diff_unit(LAS unsigned char* lds, const bf16* Qrow0  , const bf16* K1h, const bf16* K2h, const bf16* Vh, bf16* Orow0  ,
                                          int qblk, const float* relb, int h, float lam, const float* subln) {
    const int tid = opaque_tid(), wid = __builtin_amdgcn_readfirstlane(tid >> 6), lane = tid & 63, r32 = lane & 31, hi = lane >> 5, mp = wid >> 2, w4 = wid & 3;
    LAS float* wsf = (LAS float*)(lds + LDSX_OFF) + wid * 64; LAS float* li_l = wsf; LAS float* al_l = wsf + 32;
    LAS float* lut2 = (LAS float*)(lds + LDSX_OFF + 2048);
    if (tid < 2 * 132) { const int m_ = tid / 132, i_ = tid % 132; if (i_ <= 128) lut2[tid] = relb[(i_ < 128 ? (int)T5_BUCKET[i_] : 31) * 12 + 2 * h + m_] * LOG2E; }
    const LAS float* lut = lut2 + mp * 132;
    bf16x8 qr[8];
#pragma unroll
    for (int d0 = 0; d0 < 8; ++d0) qr[d0] = *(const bf16x8*)(Qrow0 + (size_t)(w4 * 32 + r32) * DM + (h + 6 * mp) * HD + d0 * 16 + hi * 8);
    const int krow = 4 * wid + (lane >> 4); const unsigned ksrc = (unsigned) krow * 256 + ((16 * (lane & 15)) ^ ((krow & 7) << 4));
    const int vkk = 8 * (wid >> 1) + ((lane & 31) >> 2); const unsigned vsrc = (unsigned) swap23(vkk) * 512 + (32 * (2 * (wid & 1) + (lane >> 5)) + 8 * (lane & 3)) * 2;
    const unsigned lds0 = (unsigned)(uintptr_t)(lds + RING_OFF);
    const char* K1g = (const char*)K1h; const char* K2g = (const char*)K2h; const char* Vg = (const char*)Vh;
#define ISSUE(t, s) do { const unsigned base_ = (unsigned)__builtin_amdgcn_readfirstlane(lds0 + (s) * 65536 + wid * 1024); const size_t tb_ = (size_t)(t) * SHM_T; \
        glds16(K1g + tb_, ksrc, base_); glds16(K1g + tb_ + 8192, ksrc, base_ + 8192); glds16(K2g + tb_, ksrc, base_ + SHM_T); glds16(K2g + tb_ + 8192, ksrc, base_ + SHM_T + 8192); \
        glds16(Vg + 2 * tb_, vsrc, base_ + 2 * SHM_T); glds16(Vg + 2 * tb_ + 16384, vsrc, base_ + 2 * SHM_T + 8192); \
        glds16(Vg + 2 * tb_ + 256, vsrc, base_ + 3 * SHM_T); glds16(Vg + 2 * tb_ + 256 + 16384, vsrc, base_ + 3 * SHM_T + 8192); } while (0)
#define ISSUE_K(t, s) do { const unsigned base_ = (unsigned)__builtin_amdgcn_readfirstlane(lds0 + (s) * 65536 + wid * 1024); const size_t tb_ = (size_t)(t) * SHM_T; \
        glds16(K1g + tb_, ksrc, base_); glds16(K1g + tb_ + 8192, ksrc, base_ + 8192); glds16(K2g + tb_, ksrc, base_ + SHM_T); glds16(K2g + tb_ + 8192, ksrc, base_ + SHM_T + 8192); } while (0)
#define ISSUE_V(t, s) do { const unsigned base_ = (unsigned)__builtin_amdgcn_readfirstlane(lds0 + (s) * 65536 + wid * 1024); const size_t tb_ = (size_t)(t) * SHM_T; \
        glds16(Vg + 2 * tb_, vsrc, base_ + 2 * SHM_T); glds16(Vg + 2 * tb_ + 16384, vsrc, base_ + 2 * SHM_T + 8192); \
        glds16(Vg + 2 * tb_ + 256, vsrc, base_ + 3 * SHM_T); glds16(Vg + 2 * tb_ + 256 + 16384, vsrc, base_ + 3 * SHM_T + 8192); } while (0)
    const int vb0 = (int)lds0 + 2 * SHM_T + v_rd_base(lane);
    float m_reg = -1e30f, l_reg = 0.f; f32x16 o[8];
#pragma unroll
    for (int d = 0; d < 8; ++d)
#pragma unroll
        for (int r = 0; r < 16; ++r) o[d][r] = 0.f;
    const int q0w = qblk * 128 + w4 * 32, qpos = q0w + r32, NT = 2 * (qblk + 1);
    if (!(VAR & 1)) ISSUE(0, 0);
    for (int t = 0; t < NT; ++t) {
        WAIT_BAR0();
        if (!(VAR & 1)) if (t + 1 < NT) ISSUE(t + 1, (t + 1) & 1);
        const int s = t & 1, tk0 = t * 64;
        if (VAR & 2) continue;
        const bool far = (q0w - (tk0 + 63)) >= 128;
        { f32x16 p; float alpha; bf16x8 pa0, pa1;
          qkt_half(p, (const LAS char*)(lds + RING_OFF + s * 65536 + mp * SHM_T), r32, hi, qr);
          bias_mask_half(p, qpos - tk0 - 4 * hi, far, lut);
          if (VAR & 4) { alpha = 1.f; l_reg += p[0]; PK4X(p, 0, pa0); PK4X(p, 8, pa1); } else { softmax_half(p, m_reg, l_reg, alpha, pa0, pa1);
          RESC(o, 8, al_l, alpha); }
          pv_half8<0>(o, vb0 + s * 65536, pa0, pa1); }
        SBAR();
        { f32x16 p; float alpha; bf16x8 pa0, pa1;
          qkt_half(p, (const LAS char*)(lds + RING_OFF + s * 65536 + mp * SHM_T + 32 * 256), r32, hi, qr);
          bias_mask_half(p, qpos - tk0 - 32 - 4 * hi, far, lut);
          if (VAR & 4) { alpha = 1.f; l_reg += p[0]; PK4X(p, 0, pa0); PK4X(p, 8, pa1); } else { softmax_half(p, m_reg, l_reg, alpha, pa0, pa1);
          RESC(o, 8, al_l, alpha); }
          pv_half8<1>(o, vb0 + s * 65536, pa0, pa1); }
        SBAR();
    }
#undef ISSUE
#undef ISSUE_K
#undef ISSUE_V
    if (hi == 0) li_l[r32] = l_reg;
    WAIT_BAR0();
    int laneo = lane; asm volatile("" : "+v"(laneo));
    LAS float* X = (LAS float*)(lds + RING_OFF) + (w4 * 8 * 16 * 64 + laneo);
    if (mp == 1) {
#pragma unroll
        for (int r = 0; r < 16; ++r) { const float f = lam * __builtin_amdgcn_rcpf(li_l[crow(r, hi)]);
#pragma unroll
            for (int d0 = 0; d0 < 8; ++d0) X[(d0 * 16 + r) * 64] = o[d0][r] * f; }
    }
    WAIT_BAR0();
    if (mp == 0) {
        int r32o = r32, hio = hi; asm volatile("" : "+v"(r32o), "+v"(hio));
        unsigned char* Ow = (unsigned char*)Orow0 + (size_t)(w4 * 32) * DM + r32o; const float* sg = subln + r32o;
#pragma unroll
        for (int r = 0; r < 16; ++r) { const float rli = __builtin_amdgcn_rcpf(li_l[crow(r, hi)]); float ss = 0.f;
#pragma unroll
            for (int d0 = 0; d0 < 8; ++d0) { const float v = o[d0][r] * rli - X[(d0 * 16 + r) * 64]; o[d0][r] = v; ss += v * v; }
            ss += swz_xor<1>(ss); ss += swz_xor<2>(ss); ss += swz_xor<4>(ss); ss += swz_xor<8>(ss); ss += swz_xor<16>(ss);
            const float rs = (1.0f / sqrtf(ss * (1.f / DV) + RMS_EPS)) * (1.f - LAM_INIT); const int orow = crow(r, hio);
#pragma unroll
            for (int d0 = 0; d0 < 8; ++d0) { const float v = o[d0][r] * rs * sg[d0 * 32]; const float vn = swz_xor<1>(v);
                if ((r32 & 1) == 0) *(unsigned short*)(Ow + (size_t)orow * DM + d0 * 32) = (unsigned short)__builtin_amdgcn_cvt_pk_fp8_f32(v * SC_O, vn * SC_O, 0u, false); } }
    }
    WAIT_BAR0();
}

__device__ __forceinline__ void moba_sparse_unit(LAS unsigned char* lds, const bf16* QHb, const bf16* Kblk, const bf16* Vblk, const unsigned* listF, int cntF, const unsigned* listA, int cntA, int j,
                                                 bf16* PO, float* PM, const float* relb, int h) {
    const int tid = opaque_tid(), wid = __builtin_amdgcn_readfirstlane(tid >> 6), lane = tid & 63, r32 = lane & 31, hi = lane >> 5;
    LAS float* wsf = (LAS float*)(lds + LDSX_OFF) + wid * 64; LAS float* li_l = wsf; LAS float* al_l = wsf + 32;
    LAS float* lut = (LAS float*)(lds + LDSX_OFF + 2048);
    if (tid <= 128) lut[tid] = relb[(tid < 128 ? (int)T5_BUCKET[tid] : 31) * 12 + h] * LOG2E;
    const int krow = 4 * wid + (lane >> 4); const unsigned ksrc = (unsigned) krow * 256 + ((16 * (lane & 15)) ^ ((krow & 7) << 4));
    const int vkk = 8 * (wid >> 1) + ((lane & 31) >> 2); const unsigned vsrc = (unsigned) swap23(vkk) * 256 + (32 * (2 * (wid & 1) + (lane >> 5)) + 8 * (lane & 3)) * 2;
    const unsigned lds0 = (unsigned)(uintptr_t)(lds + RING_OFF);
    const char* Kg = (const char*)Kblk; const char* Vg = (const char*)Vblk;
    { const unsigned base_ = (unsigned)__builtin_amdgcn_readfirstlane(lds0 + wid * 1024);
#pragma unroll
      for (int t = 0; t < 4; ++t) { glds16(Kg + t * SHM_T, ksrc, base_ + t * SHM_T); glds16(Kg + t * SHM_T + 8192, ksrc, base_ + t * SHM_T + 8192);
                                    glds16(Vg + t * SHM_T, vsrc, base_ + 65536 + t * SHM_T); glds16(Vg + t * SHM_T + 8192, vsrc, base_ + 65536 + t * SHM_T + 8192); } }
    const int vb0 = (int)lds0 + 65536 + v_rd_base(lane);
    const int gF = (cntF + 31) >> 5, ng = gF + ((cntA + 31) >> 5);
    const float c31 = relb[31 * 12 + h] * LOG2E;
#define GRP_ENT(g_, ent_, val_) do { const bool fr_ = (g_) < gF; const int b0_ = fr_ ? (g_) * 32 : ((g_) - gF) * 32; const int n_ = fr_ ? cntF : cntA; const unsigned* l_ = fr_ ? listF : listA; \
        val_ = (b0_ + r32) < n_; ent_ = l_[val_ ? b0_ + r32 : b0_]; } while (0)
#define LOADQ(dst_, ent_) do { const bf16* qp_ = QHb + (size_t)((ent_) & 0xffffu) * DM + hi * 8; _Pragma("unroll") for (int d0 = 0; d0 < 8; ++d0) dst_[d0] = *(const bf16x8*)(qp_ + d0 * 16); } while (0)
    int g = wid; unsigned ent = 0u, entn = 0u; bool valid = false, validn = false; bf16x8 qr[8], qn[8];
    if (g < ng) { GRP_ENT(g, ent, valid); LOADQ(qr, ent); }
    if (g + 8 < ng) GRP_ENT(g + 8, entn, validn);
    WAIT_BAR0();
    for (; g < ng; g += 8) {
        const bool adj = g >= gF;
        unsigned entnn = 0u; bool validnn = false;
        if (g + 8 < ng) LOADQ(qn, entn);
        if (g + 16 < ng) GRP_ENT(g + 16, entnn, validnn);
        const int srow = (int)(ent & 0xffffu), slot = (int)(ent >> 16);
        float m_reg = -1e30f, l_reg = 0.f; f32x16 o[4];
#pragma unroll
        for (int d = 0; d < 4; ++d)
#pragma unroll
            for (int r = 0; r < 16; ++r) o[d][r] = 0.f;
#pragma unroll 1
        for (int t = 0; t < 4; ++t) {
            f32x16 p0, p1;
            qkt(p0, p1, (const LAS char*)(lds + RING_OFF + t * SHM_T), r32, hi, qr);
            if (adj) bias_mask_tile(p0, p1, srow - (j * 256 + t * 64) - 4 * hi, true, false, lut);
            float alpha; bf16x8 pa0, pa1, pa2, pa3;
            softmax_tile(p0, p1, m_reg, l_reg, alpha, pa0, pa1, pa2, pa3);
            RESC(o, 4, al_l, alpha);
            pv_tile(o, vb0 + t * SHM_T, pa0, pa1, pa2, pa3);
        }
        LAS int* rd = (LAS int*)al_l;
        const int rec = srow * 3 + slot;
        if (hi == 0) { li_l[r32] = l_reg; rd[r32] = valid ? rec : -1;
            if (valid) { PM[(size_t)rec * 2] = m_reg + (adj ? 0.f : c31); PM[(size_t)rec * 2 + 1] = l_reg; } }
        asm volatile("s_waitcnt lgkmcnt(0)" ::: "memory");
        int r32o = r32, hio = hi; asm volatile("" : "+v"(r32o), "+v"(hio));
#pragma unroll
        for (int r = 0; r < 16; ++r) { const int orow = crow(r, hio); const float rli = __builtin_amdgcn_rcpf(li_l[orow]); const int dst = rd[orow];
#pragma unroll
            for (int d0 = 0; d0 < 4; ++d0) { const float v = o[d0][r] * rli; const float vn = swz_xor<1>(v);
                if ((r32 & 1) == 0 && dst >= 0) *(unsigned*)(PO + (size_t)dst * HD + d0 * 32 + r32o) = cvtpk(v, vn); } }
        asm volatile("s_waitcnt lgkmcnt(0)" ::: "memory");
#pragma unroll
        for (int d0 = 0; d0 < 8; ++d0) qr[d0] = qn[d0];
        ent = entn; valid = validn; entn = entnn; validn = validnn;
    }
#undef GRP_ENT
#undef LOADQ
    WAIT_BAR0();
}

__device__ __forceinline__ void moba_final_unit(LAS unsigned char* lds, const bf16* Qrow0, const bf16* Kh, const bf16* Vh, bf16* Orow0, int qb, const unsigned* selrow, const float* relb, int h, const bf16* PO, const float* PM) {
    const int tid = opaque_tid(), wid = __builtin_amdgcn_readfirstlane(tid >> 6), lane = tid & 63, r32 = lane & 31, hi = lane >> 5;
    LAS float* wsf = (LAS float*)(lds + LDSX_OFF) + wid * 64; LAS float* al_l = wsf + 32;
    LAS float* lut = (LAS float*)(lds + LDSX_OFF + 2048);
    LAS float* ftab = (LAS float*)(lds + LDSX_OFF + 4352) + wid * 128;
    if (tid <= 128) lut[tid] = relb[(tid < 128 ? (int)T5_BUCKET[tid] : 31) * 12 + h] * LOG2E;
    bf16x8 qr[8];
#pragma unroll
    for (int d0 = 0; d0 < 8; ++d0) qr[d0] = *(const bf16x8*)(Qrow0 + (size_t)(wid * 32 + r32) * DM + d0 * 16 + hi * 8);
    const unsigned sel = selrow[wid * 32 + r32];
    const int krow = 4 * wid + (lane >> 4); const unsigned ksrc = (unsigned) krow * 256 + ((16 * (lane & 15)) ^ ((krow & 7) << 4));
    const int vkk = 8 * (wid >> 1) + ((lane & 31) >> 2); const unsigned vsrc = (unsigned) swap23(vkk) * 256 + (32 * (2 * (wid & 1) + (lane >> 5)) + 8 * (lane & 3)) * 2;
    const unsigned lds0 = (unsigned)(uintptr_t)(lds + RING_OFF);
    const char* Kg = (const char*)(Kh + (size_t)qb * 256 * HD); const char* Vg = (const char*)(Vh + (size_t)qb * 256 * HD);
    { const unsigned base_ = (unsigned)__builtin_amdgcn_readfirstlane(lds0 + wid * 1024);
#pragma unroll
      for (int t = 0; t < 4; ++t) { glds16(Kg + t * SHM_T, ksrc, base_ + t * SHM_T); glds16(Kg + t * SHM_T + 8192, ksrc, base_ + t * SHM_T + 8192);
                                    glds16(Vg + t * SHM_T, vsrc, base_ + 65536 + t * SHM_T); glds16(Vg + t * SHM_T + 8192, vsrc, base_ + 65536 + t * SHM_T + 8192); } }
    const int vb0 = (int)lds0 + 65536 + v_rd_base(lane);
    float m_reg = -1e30f, l_reg = 0.f; f32x16 o[4];
#pragma unroll
    for (int d = 0; d < 4; ++d)
#pragma unroll
        for (int r = 0; r < 16; ++r) o[d][r] = 0.f;
    const int qrel = wid * 32 + r32;
    WAIT_BAR0();
#pragma unroll 1
    for (int t = 0; t <= (wid >> 1); ++t) {
        f32x16 p0, p1;
        qkt(p0, p1, (const LAS char*)(lds + RING_OFF + t * SHM_T), r32, hi, qr);
        bias_mask_tile(p0, p1, qrel - t * 64 - 4 * hi, true, false, lut);
        float alpha; bf16x8 pa0, pa1, pa2, pa3;
        softmax_tile(p0, p1, m_reg, l_reg, alpha, pa0, pa1, pa2, pa3);
        RESC(o, 4, al_l, alpha);
        pv_tile(o, vb0 + t * SHM_T, pa0, pa1, pa2, pa3);
    }
    const int nsel = __builtin_popcount(sel); const size_t rec0 = (size_t)(qb * 256 + qrel) * 3;
    float mi[3], li[3]; float M = m_reg;
#pragma unroll
    for (int i = 0; i < 3; ++i) { mi[i] = -1e30f; li[i] = 0.f; if (i < nsel) { mi[i] = PM[(rec0 + i) * 2]; li[i] = PM[(rec0 + i) * 2 + 1]; } M = fmaxf(M, mi[i]); }
    const float wo = __builtin_amdgcn_exp2f(m_reg - M); float L = l_reg * wo; float wi[3];
#pragma unroll
    for (int i = 0; i < 3; ++i) { wi[i] = (i < nsel) ? li[i] * __builtin_amdgcn_exp2f(mi[i] - M) : 0.f; L += wi[i]; }
    const float rL = 1.f / L;
    if (hi == 0) { ftab[r32] = wo * rL; ftab[32 + r32] = wi[0] * rL; ftab[64 + r32] = wi[1] * rL; ftab[96 + r32] = wi[2] * rL; }
    WAIT_BAR0();
    int r32o = r32, hio = hi, laneo = lane; asm volatile("" : "+v"(r32o), "+v"(hio), "+v"(laneo));
    LAS float* X = (LAS float*)(lds + RING_OFF) + wid * 4096;
#pragma unroll
    for (int r = 0; r < 16; ++r) { const int orow = crow(r, hio); const float fo = ftab[orow];
#pragma unroll
        for (int d0 = 0; d0 < 4; ++d0) X[orow * 128 + d0 * 32 + r32o] = o[d0][r] * fo; }
    asm volatile("s_waitcnt lgkmcnt(0)" ::: "memory");
    { const int rg = laneo >> 4, c = laneo & 15;
      unsigned char* Ow = (unsigned char*)Orow0 + (size_t)(wid * 32) * DM + 8 * c;
      const bf16* Pw = PO + ((size_t)(qb * 256 + wid * 32) * 3) * HD + 8 * c;
#pragma unroll
      for (int hb = 0; hb < 2; ++hb) {
          v4u pw[4][3];
#pragma unroll
          for (int k = 0; k < 4; ++k) { const int row = (hb * 4 + k) * 4 + rg;
#pragma unroll
              for (int i = 0; i < 3; ++i) { const float f = ftab[32 * (i + 1) + row]; pw[k][i] = (v4u){0u, 0u, 0u, 0u}; if (f != 0.f) pw[k][i] = *(const v4u*)(Pw + ((size_t)row * 3 + i) * HD); } }
#pragma unroll
          for (int k = 0; k < 4; ++k) { const int row = (hb * 4 + k) * 4 + rg;
              const f32x4 x0 = *(const LAS f32x4*)(X + row * 128 + 8 * c), x1 = *(const LAS f32x4*)(X + row * 128 + 8 * c + 4);
              float v[8] = {x0[0], x0[1], x0[2], x0[3], x1[0], x1[1], x1[2], x1[3]};
#pragma unroll
              for (int i = 0; i < 3; ++i) { const float f = ftab[32 * (i + 1) + row]; const v4u w = pw[k][i];
                  v[0] += f * bflo(w.x); v[1] += f * bfhi(w.x); v[2] += f * bflo(w.y); v[3] += f * bfhi(w.y); v[4] += f * bflo(w.z); v[5] += f * bfhi(w.z); v[6] += f * bflo(w.w); v[7] += f * bfhi(w.w); }
              unsigned w0 = 0u, w1 = 0u;
              w0 = __builtin_amdgcn_cvt_pk_fp8_f32(v[0] * SC_O, v[1] * SC_O, w0, false); w0 = __builtin_amdgcn_cvt_pk_fp8_f32(v[2] * SC_O, v[3] * SC_O, w0, true);
              w1 = __builtin_amdgcn_cvt_pk_fp8_f32(v[4] * SC_O, v[5] * SC_O, w1, false); w1 = __builtin_amdgcn_cvt_pk_fp8_f32(v[6] * SC_O, v[7] * SC_O, w1, true);
              *(v2u*)(Ow + (size_t)row * DM) = (v2u){w0, w1}; } } }
    WAIT_BAR0();
}
#undef RESC
}

__device__ __forceinline__ int queue_next(gu32* ctr, LAS unsigned char* lds) {
    volatile LAS int* slot = (volatile LAS int*)(lds + LDSX_OFF + 4096);
    if (threadIdx.x == 0) slot[0] = (int)__hip_atomic_fetch_add(ctr, 1u, RLX_AGENT);
    __syncthreads();
    return __builtin_amdgcn_readfirstlane(slot[0]);
}

template <int PV>
__device__ __forceinline__ void phase_moba_sparse(const Args& a, LAS unsigned char* lds, gu32* qctr) {
    unsigned char* ws = opaque_ws(a.ws);
    const bf16* QH = (const bf16*)(ws + WS_QH); const bf16* KH = (const bf16*)(ws + WS_KH); const bf16* VH = (const bf16*)(ws + WS_VH);
    const unsigned* MC = (const unsigned*)(ws + WS_CTL) + CW_MC;
    for (;;) {
        const int uq = queue_next(qctr, lds);
        if (uq >= 744 + CONV_SP) break;
        const Mix mx = mix_decode(uq, 744, CONV_SP);
        if (mx.conv) { if (!(PV & 1)) conv_chunk(a, lds, 0, CONV_IN + mx.idx); else __syncthreads(); continue; }
        const int u = mx.idx;
        if (PV & 2) { __syncthreads(); continue; }
        const int j = u / 24, bh = u % 24, b = bh / 12, h = bh % 12;
        const int cntA = (int)MC[(bh * 32 + j) * 2], cntF = (int)MC[(bh * 32 + j) * 2 + 1];
        const bf16* QHb = QH + (size_t)b * SEQ * DM + h * HD; const bf16* Kblk = KH + ((size_t)bh * SEQ + j * 256) * HD; const bf16* Vblk = VH + ((size_t)bh * SEQ + j * 256) * HD;
        bf16* PO = (bf16*)(ws + WS_PO) + (size_t)bh * SEQ * 3 * HD; float* PM = (float*)(ws + WS_PM) + (size_t)bh * SEQ * 3 * 2;
        att::moba_sparse_unit(lds, QHb, Kblk, Vblk, (const unsigned*)(ws + WS_LISTF) + ((size_t)bh * 32 + j) * 8192, cntF, (const unsigned*)(ws + WS_LISTA) + ((size_t)bh * 32 + j) * 256, cntA, j, PO, PM, a.in[I_RELB], h);
    }
}
__device__ __forceinline__ void phase_attn_a(const Args& a, LAS unsigned char* lds, gu32* qctr) {
    unsigned char* ws = opaque_ws(a.ws);
    const bf16* QH = (const bf16*)(ws + WS_QH); const bf16* KH = (const bf16*)(ws + WS_KH); const bf16* VH = (const bf16*)(ws + WS_VH); bf16* OC = (bf16*)(ws + WS_OCAT);
    const unsigned* SEL = (const unsigned*)(ws + WS_SMALL + SM_SEL);
    for (;;) {
        const int uq = queue_next(qctr, lds);
        if (uq >= 768 + 256 + (CONV_NCH - CONV_IN - CONV_SP)) break;
        const Mix mx = mix_decode(uq, 768 + 256, CONV_NCH - CONV_IN - CONV_SP);
        if (mx.conv) { conv_chunk(a, lds, 0, CONV_IN + CONV_SP + mx.idx); continue; }
        const int u = mx.idx;
        if (u < 768) { const int qb = 31 - u / 24, bh = u % 24, b = bh / 12, h = bh % 12; const size_t row0 = (size_t)b * SEQ + qb * 256;
            att::moba_final_unit(lds, QH + row0 * DM + h * HD, KH + (size_t)bh * SEQ * HD, VH + (size_t)bh * SEQ * HD, (bf16*)((unsigned char*)OC + row0 * DM + h * HD), qb,
                                 SEL + (size_t)bh * SEQ + qb * 256, a.in[I_RELB], h, (const bf16*)(ws + WS_PO) + (size_t)bh * SEQ * 3 * HD, (const float*)(ws + WS_PM) + (size_t)bh * SEQ * 3 * 2);
        } else { const int v = u - 768, b = v >> 7, hm = (v >> 5) & 3, qb = v & 31; const size_t row0 = (size_t)b * SEQ + qb * 256;
            const size_t mo = (size_t)((0 * 2 + b) * 4 + hm) * NMEM * HD;
            att::attn128_unit<1, true>(lds, QH + row0 * DM + (12 + hm) * HD, (const bf16*)(ws + WS_SMALL + SM_KM) + mo, (const bf16*)(ws + WS_SMALL + SM_VM) + mo, (bf16*)((unsigned char*)OC + row0 * DM + MIXW + hm * HD), 4, 0, nullptr, nullptr, 0);
        }
    }
}
template <int VAR>
__device__ __forceinline__ void phase_attn_b(const Args& a, LAS unsigned char* lds, gu32* qctr, bf16* OC) {
    unsigned char* ws = opaque_ws(a.ws);
    const bf16* QH = (const bf16*)(ws + WS_QH); const bf16* KH = (const bf16*)(ws + WS_KH); const bf16* VH = (const bf16*)(ws + WS_VH);
    float lam;
    { const float* lb = a.in[I_LAMBDA]; const int lane = opaque_tid() & 63;
      float s1 = lb[lane] * lb[128 + lane] + lb[64 + lane] * lb[128 + 64 + lane], s2 = lb[256 + lane] * lb[384 + lane] + lb[256 + 64 + lane] * lb[384 + 64 + lane];
      s1 = wave_sum(s1); s2 = wave_sum(s2); lam = expf(s1) - expf(s2) + LAM_INIT; }
    for (;;) {
        const int uq = queue_next(qctr, lds);
        if (uq >= 768 + 256 + CONV_NCH) break;
        const Mix mx = mix_decode(uq, 768 + 256, CONV_NCH);
        if (mx.conv) { if (!(VAR & 8)) conv_chunk(a, lds, 1, mx.idx); else __syncthreads(); continue; }
        const int u = mx.idx;
        if (u < 768) { const int qblk = 63 - u / 12, bh = u % 12, b = bh / 6, h = bh % 6; const size_t row0 = (size_t)b * SEQ + qblk * 128;
            att::diff_unit<VAR>(lds, QH + row0 * DM, KH + (size_t)(b * 12 + h) * SEQ * HD, KH + (size_t)(b * 12 + 6 + h) * SEQ * HD, VH + (size_t)(b * 6 + h) * SEQ * DV, (bf16*)((unsigned char*)OC + row0 * DM + h * DV),
                           qblk, a.in[I_RELB], h, lam, a.in[I_SUBLN]);
        } else { const int v = u - 768, b = v >> 7, hm = (v >> 5) & 3, qb = v & 31; const size_t row0 = (size_t)b * SEQ + qb * 256;
            const size_t mo = (size_t)((1 * 2 + b) * 4 + hm) * NMEM * HD;
            att::attn128_unit<1, true>(lds, QH + row0 * DM + (12 + hm) * HD, (const bf16*)(ws + WS_SMALL + SM_KM) + mo, (const bf16*)(ws + WS_SMALL + SM_VM) + mo, (bf16*)((unsigned char*)OC + row0 * DM + MIXW + hm * HD), 4, 0, nullptr, nullptr, 0);
        }
    }
}

template <int RV>
__device__ __forceinline__ void phase_router(const Args& a, LAS unsigned char* lds, int G, int vb, int layer) {
    unsigned char* ws = opaque_ws(a.ws);
    const int tid = opaque_tid(), lane = tid & 63, wave = __builtin_amdgcn_readfirstlane(tid >> 6), i16 = lane & 15, g4 = lane >> 4, tg = wave & 1, kq = wave >> 1;
    const bf16* H = (const bf16*)(ws + WS_HB);
    const bf16* WRh = (const bf16*)(ws + WS_W_RT) + (size_t)layer * 2 * NRTP * DM;
    LAS float* L = (LAS float*)(lds + RING_OFF);
    LAS int* cnt = (LAS int*)(lds + RING_OFF + 4 * 64 * NRTP * 4);
    for (int blk = vb; blk < T / 64; blk += G) {
        if (tid < 64) cnt[tid] = 0;
        f32x4 acc[2][5];
#pragma unroll
        for (int t2 = 0; t2 < 2; ++t2)
#pragma unroll
            for (int j = 0; j < 5; ++j) acc[t2][j] = (f32x4){0.f, 0.f, 0.f, 0.f};
        const bf16* hrow = H + (size_t)(blk * 64 + tg * 32 + i16) * DM + kq * 512 + 8 * g4;
        const bf16* wh = WRh + (size_t)i16 * DM + kq * 512 + 8 * g4;
#pragma unroll 4
        for (int ks = 0; ks < ((RV & 1) ? 0 : 16); ++ks) {
            bf16x8 fa[2];
#pragma unroll
            for (int t2 = 0; t2 < 2; ++t2) fa[t2] = *(const bf16x8*)(hrow + (size_t)t2 * 16 * DM + ks * 32);
#pragma unroll
            for (int jt = 0; jt < 5; ++jt) {
                const bf16x8 bh = *(const bf16x8*)(wh + (size_t)jt * 16 * DM + ks * 32);
#pragma unroll
                for (int t2 = 0; t2 < 2; ++t2) acc[t2][jt] = __builtin_amdgcn_mfma_f32_16x16x32_bf16(fa[t2], bh, acc[t2][jt], 0, 0, 0);
            }
        }
#pragma unroll
        for (int t2 = 0; t2 < 2; ++t2)
#pragma unroll
            for (int jt = 0; jt < 5; ++jt)
#pragma unroll
                for (int r = 0; r < 4; ++r) L[(kq * 64 + tg * 32 + t2 * 16 + 4 * g4 + r) * NRTP + jt * 16 + i16] = acc[t2][jt][r];
        __syncthreads();
        if (tid < 64 && !(RV & 2)) {
            const int tok = blk * 64 + tid;
            const float* part = (const float*)(ws + WS_SMALL + SM_PART) + (size_t)tok * 32;
            float ss = 0.f;
#pragma unroll
            for (int i = 0; i < 32; ++i) ss += part[i];
            const float rstd = 1.0f / sqrtf(ss * (1.f / DM) + RMS_EPS);
            const LAS float* l0 = L + tid * NRTP;
            const float* brg = a.in[I_B_RG] + layer * 8; const float* bre = a.in[I_B_RE] + layer * 64;
            float gmax = -__builtin_inff(); int gi = 0; float gl[8];
#pragma unroll
            for (int j = 0; j < 8; ++j) { gl[j] = ((l0[j] + l0[64 * NRTP + j]) + (l0[128 * NRTP + j] + l0[192 * NRTP + j])) * rstd + brg[j]; if (gl[j] > gmax) { gmax = gl[j]; gi = j; } }
            float gs = 0.f;
#pragma unroll
            for (int j = 0; j < 8; ++j) gs += expf(gl[j] - gmax);
            const float pg = 1.f / gs;
            float v0 = -__builtin_inff(), v1 = -__builtin_inff(); int i0 = 0, i1 = 0;
#pragma unroll
            for (int j = 0; j < 8; ++j) { const int ix = 8 + gi * 8 + j; const float e = ((l0[ix] + l0[64 * NRTP + ix]) + (l0[128 * NRTP + ix] + l0[192 * NRTP + ix])) * rstd + bre[gi * 8 + j];
                if (e > v0) { v1 = v0; i1 = i0; v0 = e; i0 = j; } else if (e > v1) { v1 = e; i1 = j; } }
            const float dd = expf(v1 - v0), w0 = pg / (1.f + dd), w1 = pg * dd / (1.f + dd);
            const int e0 = gi * 8 + i0, e1 = gi * 8 + i1;
            v4u tr; tr.x = (unsigned)e0; tr.y = (unsigned)e1; tr.z = __float_as_uint(w0); tr.w = __float_as_uint(w1);
            *(v4u*)(ws + WS_SMALL + SM_TOKR + (size_t)tok * 16) = tr;
            ((float*)(ws + WS_SMALL + SM_RSTD))[tok] = rstd;
            __hip_atomic_fetch_add(cnt + e0, 1, __ATOMIC_RELAXED, __HIP_MEMORY_SCOPE_WORKGROUP);
            __hip_atomic_fetch_add(cnt + e1, 1, __ATOMIC_RELAXED, __HIP_MEMORY_SCOPE_WORKGROUP);
        }
        __syncthreads();
        if (tid < 64 && !(RV & 2)) ((int*)(ws + WS_SMALL + SM_CNT))[blk * 64 + tid] = cnt[tid];
        __syncthreads();
    }
}

__device__ __forceinline__ void phase_gather(const Args& a, LAS unsigned char* lds, int G, int vb) {
    unsigned char* ws = opaque_ws(a.ws);
    const int tid = opaque_tid(), lane = tid & 63, wave = __builtin_amdgcn_readfirstlane(tid >> 6);
    const int* CNT = (const int*)(ws + WS_SMALL + SM_CNT); int* BLKE = (int*)(ws + WS_SMALL + SM_BLKE); int* DEST = (int*)(ws + WS_SMALL + SM_DEST);
    const unsigned* TOKR = (const unsigned*)(ws + WS_SMALL + SM_TOKR);
    int* ROWTOK = (int*)(ws + WS_SMALL + SM_ROWTOK);
    LAS int* tot = (LAS int*)(lds + RING_OFF); LAS int* pre = tot + 64; LAS int* pst = tot + 128; LAS int* destl = tot + 192;
    LAS int* part8 = tot + 320;
    LAS int* tokl = tot + 320 + 1024;
    for (int blk = vb; blk < T / 64; blk += G) {
        { const int e = tid & 63, p8 = tid >> 6; int t_ = 0, p_ = 0;
#pragma unroll 8
          for (int b2 = p8 * 32; b2 < p8 * 32 + 32; ++b2) { const int c = CNT[b2 * 64 + e]; t_ += c; p_ += (b2 < blk) ? c : 0; }
          part8[(p8 * 64 + e) * 2] = t_; part8[(p8 * 64 + e) * 2 + 1] = p_;
          if (tid < 128) tokl[tid] = (int)TOKR[(size_t)(blk * 64 + (tid >> 1)) * 4 + (tid & 1)]; }
        __syncthreads();
        if (tid < 64) { int t_ = 0, p_ = 0;
#pragma unroll
            for (int p8 = 0; p8 < 8; ++p8) { t_ += part8[(p8 * 64 + tid) * 2]; p_ += part8[(p8 * 64 + tid) * 2 + 1]; }
            tot[tid] = t_; pre[tid] = p_;
            const int padded = ((t_ + 255) >> 8) << 8; int incl = padded;
#pragma unroll
            for (int o = 1; o < 64; o <<= 1) { const int up = __shfl_up(incl, o); if (tid >= o) incl += up; }
            pst[tid] = incl - padded;
            if (blk == 0 && tid == 63) BLKE[MAXRB] = incl >> 8; }
        __syncthreads();
        if (tid < 64) {
            if (blk == 0) { const int rb0 = pst[tid] >> 8, rb1 = (pst[tid] + (((tot[tid] + 255) >> 8) << 8)) >> 8; for (int rb = rb0; rb < rb1; ++rb) BLKE[rb] = tid; }
            int r = pst[tid] + pre[tid];
            for (int as = 0; as < 128; ++as) { if (tokl[as] == tid) destl[as] = r++; }
        }
        __syncthreads();
        if (tid < 128) { const int tok = blk * 64 + (tid >> 1), dest = destl[tid]; DEST[tok * 2 + (tid & 1)] = dest; ROWTOK[dest] = tok; }
        if (blk < 64) {
            const int r0 = pst[blk] + tot[blk], r1 = pst[blk] + (((tot[blk] + 255) >> 8) << 8);
            for (int r = r0 + tid; r < r1; r += 512) ROWTOK[r] = 0;
        }
        __syncthreads();
    }
}

__device__ __forceinline__ void phase_combine(const Args& a, int G, int vb, float* Fout  ) {
    unsigned char* ws = opaque_ws(a.ws);
    const int tid = opaque_tid(), lane = tid & 63, wave = __builtin_amdgcn_readfirstlane(tid >> 6);
    const int gw = vb * 8 + wave, NGW = G * 8;
    const bf16* YS = (const bf16*)(ws + WS_YS); const int* DEST = (const int*)(ws + WS_SMALL + SM_DEST); float* RSTD = (float*)(ws + WS_SMALL + SM_RSTD); bf16* HB = (bf16*)(ws + WS_HB);
    for (int tok = gw; tok < T; tok += NGW) {
        const v4u tr = *(const v4u*)(ws + WS_SMALL + SM_TOKR + (size_t)tok * 16); const float w0 = __uint_as_float(tr.z), w1 = __uint_as_float(tr.w);
        const int d0 = DEST[tok * 2], d1 = DEST[tok * 2 + 1];
        GAS v2u* hr = (GAS v2u*)(HB + (size_t)tok * DM) + lane;
        const GAS v2u* y0 = (const GAS v2u*)(YS + (size_t)d0 * DM) + lane; const GAS v2u* y1 = (const GAS v2u*)(YS + (size_t)d1 * DM) + lane;
        v2u hv[8], a0[8], a1[8];
#pragma unroll
        for (int j = 0; j < 8; ++j) { hv[j] = hr[64 * j]; a0[j] = y0[64 * j]; a1[j] = y1[64 * j]; }
        float ss = 0.f;
#pragma unroll
        for (int j = 0; j < 8; ++j) { f32x4 v;
            v.x = bflo(hv[j].x) + (w0 * bflo(a0[j].x) + w1 * bflo(a1[j].x)); v.y = bfhi(hv[j].x) + (w0 * bfhi(a0[j].x) + w1 * bfhi(a1[j].x));
            v.z = bflo(hv[j].y) + (w0 * bflo(a0[j].y) + w1 * bflo(a1[j].y)); v.w = bfhi(hv[j].y) + (w0 * bfhi(a0[j].y) + w1 * bfhi(a1[j].y));
            ss += (v.x * v.x + v.y * v.y) + (v.z * v.z + v.w * v.w);
            if (Fout) ((GAS f32x4*)(Fout + (size_t)tok * DM) + lane)[64 * j] = v;
            else { v2u o; o.x = pk2(v.x, v.y); o.y = pk2(v.z, v.w); hr[64 * j] = o;
                   unsigned w8 = 0u; w8 = __builtin_amdgcn_cvt_pk_fp8_f32(v.x, v.y, w8, false); w8 = __builtin_amdgcn_cvt_pk_fp8_f32(v.z, v.w, w8, true); ((GAS unsigned*)(ws + WS_HB8 + (size_t)tok * DM) + lane)[64 * j] = w8; } }
        if (!Fout) { const float rstd = 1.0f / sqrtf(wave_sum(ss) * (1.f / DM) + RMS_EPS); if (lane == 0) RSTD[tok] = rstd; }
    }
}

struct ZeroOrder { int n, G, c;
    __device__ __forceinline__ bool next(int i, pg8::Unit& u) const { if (i * G + c >= n) return false; u.pm = 0; u.pn = 0; return true; }
    __device__ __forceinline__ void a_ready(const pg8::Unit&) const {}
    __device__ __forceinline__ void done(const pg8::Unit&) const {} };
struct EpiNull { static constexpr bool PERM = false, AFTER_DRAIN = false;
    __device__ __forceinline__ void operator()(const f32x4 (&acc)[2][2][4][2], const pg8::Unit& u, int wr, int wc, int fr, int fq) const {} };
#ifndef MK_VAR
#define MK_VAR 0
#endif
namespace pg8 { template <> struct ProbeOf<EpiNull> { static constexpr int v = MK_VAR; }; }
#ifndef MK_DUP
#define MK_DUP -1
#endif
#define DUP(k) (MK_DUP == (k))
#ifndef MK_VAR
#define MK_VAR 0
#endif
#ifndef FP8IN_SP2
#define FP8IN_SP2 true
#endif
constexpr int NPH = 21;
__global__ void __launch_bounds__(512, 2) yoco_fwd(Args args) {
    extern __shared__ __attribute__((aligned(16))) unsigned char lds_raw[];
    LAS unsigned char* lds = (LAS unsigned char*)lds_raw;
    const int tid = opaque_tid();
    const int G = gridDim.x; const int bx0 = blockIdx.x; const int vb = (G % 8 == 0) ? (bx0 % 8) * (G / 8) + bx0 / 8 : bx0;
    unsigned char* ws = args.ws;
    gu32* ctl = (gu32*)(ws + WS_CTL);
    for (int u = tid; u < (LDS_BYTES - LDSCTL_OFF) / 4; u += 512) ((LAS unsigned*)(lds + LDSCTL_OFF))[u] = 0u;
    __syncthreads();
    volatile LAS unsigned* MISC = (volatile LAS unsigned*)(lds + MISC_OFF);
#if MK_N_LAUNCHES == 1
    constexpr int lo = 0, hi = NPH; constexpr bool one = true;
#else
    const int lo = args.ph_lo, hi = args.ph_hi;
    const bool one = (hi - lo) > 1;
#endif
    XcdBarrier bar; bar.bar = (unsigned*)(ctl + CW_BAR); bar.x = 0; bar.st = nullptr;
    if (one) bar = xcd_barrier_post((unsigned*)(ctl + CW_BAR), MISC + 8);
#define GBAR() do { XcdBarrier b2_ = bar; b2_.bar = (unsigned*)opaque_ws((unsigned char*)bar.bar); { unsigned x_ = bar.x; asm volatile("" : "+s"(x_)); b2_.x = x_; } xcd_barrier(b2_); } while (0)
#define IN(k) (lo <= (k) && (k) < hi)
#define SEAM(k) do { if (IN(k) && IN((k) + 1)) GBAR(); } while (0)

#define RUN(k, ...) do { if (IN(k)) { __VA_ARGS__ if (DUP(k)) { __syncthreads(); __VA_ARGS__ } } } while (0)
    RUN(0, phase_prep(args, lds, G, vb););
    SEAM(0);
    for (int l = 0; l < 2; ++l) {
        const int pb = 1 + 10 * l;
        int bx = bx0; asm volatile("" : "+s"(bx));
        RUN(pb + 0,
            { pg8::Gemm g{(const bf16*)(ws + WS_HB8), (const bf16*)(ws + (l == 0 ? WS_W_INA : WS_W_INB)), T, PROJW, DM / 2}; pg8::StaticOrder S; S.init(T, PROJW, G, bx);
              EpiHeadNorm E{ws, l, 1.f / SC_W1};
              const int nun = (T / 256) * (PROJW / 256), upc = (nun + G - 1) / G, ksp = (l == 0) ? bx % (upc + 1) : upc;
              { pg8::RangeOrder R{S, 0, ksp}; pg8::gemm_phase<EpiHeadNorm, pg8::RangeOrder, true, FP8IN_SP2, false, true>(lds + RING_OFF, g, R, E); }
              if (l == 0) { __syncthreads(); for (int ch = bx; ch < CONV_IN; ch += G) conv_chunk(args, lds, 0, ch);
                pg8::RangeOrder R{S, ksp, upc}; pg8::gemm_phase<EpiHeadNorm, pg8::RangeOrder, true, FP8IN_SP2, false, true>(lds + RING_OFF, g, R, E); } }
            );
        if (one) GBAR();
        if (l == 0) { if (IN(pb + 2)) {
                if (bx < 16) { pg8::Gemm g{(const bf16*)(ws + WS_SMALL + SM_MEMN), (const bf16*)(ws + WS_W_MKV), NB * NMEM, 2048, DM}; pg8::StaticOrder S; S.init(NB * NMEM, 2048, G, bx);
                    EpiRowScale E{(bf16*)(ws + WS_SMALL + SM_KVM), 2048, nullptr, 0, 1.f};
                    pg8::gemm_phase<EpiRowScale, pg8::StaticOrder, true, true>(lds + RING_OFF, g, S, E); }
                else phase_gate(args, lds, G - 16, bx - 16); }
            if (one) GBAR(); }
        if (IN(pb + 3)) { if (l == 0) { phase_post_mem(args, lds, G, vb); phase_moba_sparse<0>(args, lds, ctl + CW_Q + 256); if (DUP(40)) { __syncthreads(); phase_moba_sparse<MK_VAR>(args, lds, ctl + CW_Q + 320); } if (one) GBAR(); phase_attn_a(args, lds, ctl + CW_Q); if (DUP(41)) { __syncthreads(); phase_attn_a(args, lds, ctl + CW_Q + 128); } }
            else { phase_attn_b<0>(args, lds, ctl + CW_Q + 64, (bf16*)(ws + WS_OCAT)); if (DUP(14)) { __syncthreads(); phase_attn_b<MK_VAR>(args, lds, ctl + CW_Q + 192, (bf16*)(ws + WS_YS)); } } }
        SEAM(pb + 3);
        RUN(pb + 4,
            {
#ifdef MK_STAG
              if (bx0 & 1) { for (int i_ = 0; i_ < MK_STAG; ++i_) __builtin_amdgcn_s_sleep(127); }
#endif
              pg8::Gemm g8{(const bf16*)(ws + WS_OCAT), (const bf16*)(ws + WS_W_OUT + (size_t)l * DM * DM), T, DM, DM / 2}; pg8::StaticOrder S; S.init(T, DM, G, bx);
              if (l == 0) { EpiOutProj<true> E{args.in[I_X], (float*)(ws + WS_SMALL + SM_PART), (bf16*)(ws + WS_HB), ws + WS_HB8, 1.f / (SC_O * SC_W1)}; pg8::gemm_phase<EpiOutProj<true>, pg8::StaticOrder, true, true, false, true>(lds + RING_OFF, g8, S, E); }
              else { EpiOutProj<false> E{nullptr, (float*)(ws + WS_SMALL + SM_PART), (bf16*)(ws + WS_HB), ws + WS_HB8, 1.f / (SC_O * SC_W1)}; pg8::gemm_phase<EpiOutProj<false>, pg8::StaticOrder, true, true, false, true>(lds + RING_OFF, g8, S, E); } });
#if MK_DUP == 54
        if (l == 0) { __syncthreads();
            pg8::Gemm g9{(const bf16*)(ws + WS_OCAT), (const bf16*)(ws + WS_W_INA), T, PROJW, DM / 2}; ZeroOrder S9{1280, G, bx};
            EpiNull E9; pg8::gemm_phase<EpiNull, ZeroOrder, false, true, false, true>(lds + RING_OFF, g9, S9, E9); }
#endif
#if MK_DUP == 53
        if (l == 0) { __syncthreads();
            pg8::Gemm g9{(const bf16*)(ws + WS_OCAT), (const bf16*)(ws + WS_W_OUT), T, DM, DM / 2}; pg8::StaticOrder S9; S9.init(T, DM, G, bx);
            EpiOutProj<true, MK_VAR> E9{args.in[I_X], (float*)(ws + WS_YS + (size_t)(96 << 20)), (bf16*)(ws + WS_YS), ws + WS_YS + (size_t)(64 << 20), 1.f / (SC_O * SC_W1)};
            pg8::gemm_phase<EpiOutProj<true, MK_VAR>, pg8::StaticOrder, true, true, false, true>(lds + RING_OFF, g9, S9, E9); }
#endif
#if MK_DUP == 52
        if (l == 0) { __syncthreads();
            pg8::Gemm g9{(const bf16*)(ws + WS_OCAT), (const bf16*)(ws + WS_W_INA), T, PROJW, DM / 2}; pg8::StaticOrder S9; S9.init(T, PROJW, G, bx);
            EpiHeadNormT<MK_VAR> E9{ws, 0, 1.f / SC_W1}; pg8::gemm_phase<EpiHeadNormT<MK_VAR>, pg8::StaticOrder, true, true, false, true>(lds + RING_OFF, g9, S9, E9); }
#endif
#if MK_DUP == 50 || MK_DUP == 51
        if (l == 0) { __syncthreads(); constexpr int NN9 = (MK_DUP == 50) ? DM : PROJW;
            pg8::Gemm g9{(const bf16*)(ws + WS_OCAT), (const bf16*)(ws + (MK_DUP == 50 ? WS_W_OUT : WS_W_INA)), T, NN9, DM / 2}; pg8::StaticOrder S9; S9.init(T, NN9, G, bx);
            EpiNull E9; pg8::gemm_phase<EpiNull, pg8::StaticOrder, false, true, false, true>(lds + RING_OFF, g9, S9, E9); }
#endif
        SEAM(pb + 4);
        if (IN(pb + 5)) { phase_router<0>(args, lds, G, vb, l); if (DUP(pb + 5)) { __syncthreads(); phase_router<MK_VAR>(args, lds, G, vb, l); } }
        SEAM(pb + 5);
        RUN(pb + 6, phase_gather(args, lds, G, vb););
        SEAM(pb + 6);
        RUN(pb + 7,
            { const int* blke = (const int*)(ws + WS_SMALL + SM_BLKE);
              const int* rowtok = (const int*)(ws + WS_SMALL + SM_ROWTOK);
              pg8::Gemm g{(const bf16*)(ws + WS_HB8), (const bf16*)(ws + WS_W_E1 + (size_t)l * NEXP * 1024 * DM), MAXRB * 256, 1024, DM / 2, rowtok};
              MoeOrder S{blke, blke[MAXRB] * 4, 4, G, bx}; EpiSiluMul E{(bf16*)(ws + WS_HID), (const float*)(ws + WS_SMALL + SM_RSTD), rowtok};
              pg8::gemm_phase<EpiSiluMul, MoeOrder, true, true, true, true>(lds + RING_OFF, g, S, E); });
        SEAM(pb + 7);
        RUN(pb + 8,
            { const int* blke = (const int*)(ws + WS_SMALL + SM_BLKE);
              pg8::Gemm g{(const bf16*)(ws + WS_HID), (const bf16*)(ws + WS_W_E2 + (size_t)l * NEXP * DM * EFF), MAXRB * 256, DM, EFF / 2};
              MoeOrder S{blke, blke[MAXRB] * 8, 8, G, bx}; EpiRowScale E{(bf16*)(ws + WS_YS), DM, nullptr, 8, 1.f / (SC_HID * SC_W2)};
              pg8::gemm_phase<EpiRowScale, MoeOrder, true, true, false, true>(lds + RING_OFF, g, S, E); });
        SEAM(pb + 8);
        if (IN(pb + 9)) phase_combine(args, G, vb, l == 0 ? nullptr : args.out);
        if (l == 0) SEAM(pb + 9);
    }
#undef RUN
#undef IN
#undef SEAM
}

extern "C" void kernel_launch(void* const* d_in, const int* in_sizes, int n_in, void* d_out, int out_size, void* d_ws, size_t ws_size, hipStream_t stream) {
    static int grid = 0;
    if (grid == 0) {
        if (n_in != N_IN || out_size != T * DM || ws_size < WS_END) { fprintf(stderr, "kernel_launch: unexpected shapes (n_in %d out %d ws %zu)\n", n_in, out_size, ws_size); grid = -1; return; }
        int dev = 0, cus = 0;
        if (hipGetDevice(&dev) != hipSuccess || hipDeviceGetAttribute(&cus, hipDeviceAttributeMultiprocessorCount, dev) != hipSuccess) { grid = -1; return; }
        if (hipFuncSetAttribute((const void*)yoco_fwd, hipFuncAttributeMaxDynamicSharedMemorySize, LDS_BYTES) != hipSuccess) { fprintf(stderr, "kernel_launch: hipFuncSetAttribute failed\n"); grid = -1; return; }
        int per_cu = 0;
        if (hipOccupancyMaxActiveBlocksPerMultiprocessor(&per_cu, (const void*)yoco_fwd, 512, LDS_BYTES) != hipSuccess || per_cu < 1) fprintf(stderr, "kernel_launch: occupancy query reports %d\n", per_cu);
        (void)hipGetLastError();
        grid = cus;
    }
    if (grid < 0) return;
    (void)hipMemsetAsync((char*)d_ws + WS_CTL, 0, CTL_ZERO_BYTES, stream);
    Args a{};
    for (int i = 0; i < N_IN; ++i) a.in[i] = (const float*)d_in[i];
    a.out = (float*)d_out; a.ws = (unsigned char*)d_ws;
#if MK_N_LAUNCHES == 1
    a.ph_lo = 0; a.ph_hi = NPH;
    hipLaunchKernelGGL(yoco_fwd, dim3(grid), dim3(512), LDS_BYTES, stream, a);
#else
    for (int p = 0; p < NPH; ++p) { if (p == 13) continue; a.ph_lo = p; a.ph_hi = p + 1; hipLaunchKernelGGL(yoco_fwd, dim3(grid), dim3(512), LDS_BYTES, stream, a); }
#endif
}
```

```cpp
#include <hip/hip_runtime.h>
#include <cstdio>
#include <cstdint>

#ifndef MK_N_LAUNCHES
#define MK_N_LAUNCHES 1
#endif
#ifndef MK_CHECK
#define MK_CHECK 0
#endif

constexpr int NB = 2, SEQ = 8192, T = NB * SEQ, DM = 2048, HD = 128;
constexpr int NMEM = 256, MEMH = 4, MEMW = 512, MIXW = 1536, MOBA_H = 12, DIFF_H = 6, DV = 256;
constexpr int NEXP = 64, NGRP = 8, EPG = 8, EFF = 512, NRT = 72, NRTP = 80;
constexpr int PROJW = 5120;
constexpr float RMS_EPS = 1e-6f;
constexpr float LOG2E = 1.4426950408889634f;
constexpr float QSCALE = 0.08838834764831845f * LOG2E;
constexpr float LAM_INIT = 0.35550906759096926f;
constexpr int MAXRB = 192;
constexpr float SC_W1 = 64.f, SC_W2 = 32.f, SC_HID = 8.f, SC_O = 16.f;

constexpr size_t MiB = 1u << 20;
constexpr size_t WS_CTL = 0, CTL_ZERO_BYTES = 1 * MiB;
constexpr size_t WS_W_INA = 1 * MiB;
constexpr size_t WS_W_INB = 21 * MiB;
constexpr size_t WS_W_OUT = 41 * MiB;
constexpr size_t WS_W_MKV = 57 * MiB;
constexpr size_t WS_W_RT  = 65 * MiB;
constexpr size_t WS_W_E1  = 67 * MiB;
constexpr size_t WS_HB8   = 323 * MiB;
constexpr size_t WS_W_E2  = 579 * MiB;
constexpr size_t WS_SMALL = 835 * MiB;
constexpr size_t WS_HB    = 851 * MiB;
constexpr size_t WS_PROJ  = 915 * MiB;
constexpr size_t WS_QH    = 1075 * MiB;
constexpr size_t WS_KH    = 1139 * MiB;
constexpr size_t WS_VH    = 1187 * MiB;
constexpr size_t WS_XS    = WS_PROJ;
constexpr size_t WS_OCAT  = 1235 * MiB;
constexpr size_t WS_HID   = 1299 * MiB;
constexpr size_t WS_YS    = 1347 * MiB;
constexpr size_t WS_HA    = 1539 * MiB;
constexpr size_t WS_H2    = 1667 * MiB;
constexpr size_t WS_LISTF = 1795 * MiB;
constexpr size_t WS_LISTA = 1821 * MiB;
constexpr size_t WS_PM    = 1822 * MiB;
constexpr size_t WS_PO    = WS_PROJ;
constexpr size_t WS_END   = 1827 * MiB;
static_assert(WS_XS + (size_t)MAXRB * 256 * 2048 * 2 <= WS_VH, "XS alias");
constexpr size_t SM_RSTD  = 0;
constexpr size_t SM_PART  = 1 * MiB;
constexpr size_t SM_TOKR  = 3 * MiB;
constexpr size_t SM_DEST  = 4 * MiB;
constexpr size_t SM_CNT   = 5 * MiB;
constexpr size_t SM_BLKE  = 5 * MiB + 128 * 1024;
constexpr size_t SM_KMEAN = 6 * MiB;
constexpr size_t SM_SEL   = 7 * MiB;
constexpr size_t SM_MEMN  = 8 * MiB;
constexpr size_t SM_KVM   = 10 * MiB;
constexpr size_t SM_KM    = 12 * MiB;
constexpr size_t SM_VM    = 13 * MiB;
constexpr size_t SM_GAINTAB = 15 * MiB;
constexpr size_t SM_ROWTOK = 14 * MiB;
constexpr int CW_BAR = 4096;
constexpr int CW_Q = 8192;
constexpr int CW_MC = 16384;

constexpr int RING_OFF = 0, RING_BYTES = 131072;
constexpr int LDSX_OFF = RING_BYTES;
constexpr int LDSCTL_OFF = RING_BYTES + 12288, MISC_OFF = LDSCTL_OFF + 320;
constexpr int LDS_BYTES = 147456;
static_assert(MISC_OFF + 128 <= LDS_BYTES, "LDS map");

#define GAS __attribute__((address_space(1)))
#define LAS __attribute__((address_space(3)))
typedef unsigned short bf16;
typedef unsigned v4u __attribute__((ext_vector_type(4)));
typedef unsigned v2u __attribute__((ext_vector_type(2)));
typedef float f32x4 __attribute__((ext_vector_type(4)));
typedef float f32x16 __attribute__((ext_vector_type(16)));
typedef short bf16x8 __attribute__((ext_vector_type(8)));
typedef short s16x4 __attribute__((ext_vector_type(4)));
typedef GAS unsigned gu32;
#define RLX_AGENT __ATOMIC_RELAXED, __HIP_MEMORY_SCOPE_AGENT
#define LDS_WAIT() asm volatile("s_waitcnt lgkmcnt(0)" ::: "memory")
#define VM_WAIT() asm volatile("s_waitcnt vmcnt(0)" ::: "memory")
__device__ __forceinline__ unsigned f2bf(float f) { unsigned u = __builtin_bit_cast(unsigned, f); return (u + 0x7fffu + ((u >> 16) & 1u)) >> 16; }
__device__ __forceinline__ unsigned pk2(float lo, float hi) { return f2bf(lo) | (f2bf(hi) << 16); }
__device__ __forceinline__ float bf2f(unsigned short b) { return __builtin_bit_cast(float, (unsigned)b << 16); }
__device__ __forceinline__ float bflo(unsigned w) { return __builtin_bit_cast(float, w << 16); }
__device__ __forceinline__ float bfhi(unsigned w) { return __builtin_bit_cast(float, w & 0xffff0000u); }
template <int M> __device__ __forceinline__ float swz_xor(float v) { return __builtin_bit_cast(float, __builtin_amdgcn_ds_swizzle(__builtin_bit_cast(int, v), (M << 10) | 0x1F)); }
__device__ __forceinline__ float add_xor32(float v) {
    auto r = __builtin_amdgcn_permlane32_swap(__float_as_uint(v), __float_as_uint(v), false, false);
    return __uint_as_float(r[0]) + __uint_as_float(r[1]); }
__device__ __forceinline__ float wave_sum(float v) {
    v += swz_xor<1>(v); v += swz_xor<2>(v); v += swz_xor<4>(v); v += swz_xor<8>(v); v += swz_xor<16>(v);
    return add_xor32(v);
}
__device__ const unsigned char T5_BUCKET[128] = {
 0, 1, 2, 3, 4, 5, 6, 7, 8, 9, 10, 11, 12, 13, 14, 15, 16, 16, 16, 17, 17, 18, 18, 18, 19, 19, 19, 20, 20, 20, 20, 21, 21, 21, 21, 22, 22, 22, 22, 22, 23, 23, 23, 23, 23, 23, 24, 24, 24, 24, 24, 24, 25, 25, 25, 25, 25, 25, 25, 26, 26, 26, 26, 26, 26, 26, 26, 27, 27, 27, 27, 27, 27, 27, 27, 27, 27, 28, 28, 28, 28, 28, 28, 28, 28, 28, 28, 29, 29, 29, 29, 29, 29, 29, 29, 29, 29, 29, 29, 30, 30, 30, 30, 30, 30, 30, 30, 30, 30, 30, 30, 30, 30, 31, 31, 31, 31, 31, 31, 31, 31, 31, 31, 31, 31, 31, 31, 31};

__device__ __forceinline__ int opaque_tid() { int t = threadIdx.x; asm volatile("" : "+v"(t)); return t; }

__device__ __forceinline__ unsigned char* opaque_ws(unsigned char* p) { asm volatile("" : "+s"(p)); return p; }
namespace pg8 {
#define PG8_LAS __attribute__((address_space(3)))
typedef unsigned short bf16_t;
typedef short bf16x8 __attribute__((ext_vector_type(8)));
typedef float f32x4 __attribute__((ext_vector_type(4)));
typedef unsigned u32x4 __attribute__((ext_vector_type(4)));
constexpr int BM = 256, BK = 64, HALF = 128, HTB = HALF * BK * 2  , STAGE_BYTES = 8 * HTB, NXCD = 8, WGM = 8;

__host__ __device__ __forceinline__ int lds_byte(int r, int c) { const int st = (r >> 4) * 2 + (c >> 5), rr = r & 15, cc = c & 31, ob = rr * 64 + cc * 2; return st * 1024 + (ob ^ (((ob >> 9) & 1) << 5)); }
__host__ __device__ __forceinline__ void stage_rc(int b, int& R, int& C) { const int st = b / 1024, sb = b % 1024, swz = sb ^ (((sb >> 9) & 1) << 5); R = (st >> 1) * 16 + swz / 64; C = (st & 1) * 32 + (swz % 64) / 2; }
__host__ __device__ __forceinline__ int perm32(int rho) { const int n = rho >> 4, i = rho & 15; return 8 * (i >> 2) + 4 * n + (i & 3); }

struct Unit { int pm, pn; };
struct Gemm { const bf16_t* A; const bf16_t* Bt; int M, N, K; const int* rowtok; };

struct StaticOrder {
    int nM, nN, nwg, G, c;
    __host__ __device__ void init(int M, int N, int G_, int c_) { nM = M / BM; nN = N / BM; nwg = nM * nN; G = G_; c = c_; }
    __host__ __device__ bool next(int i, Unit& u) const {
        const long L = (long)i * G + c; if (L >= nwg) return false;
        int wgid = (int)L; { const int q = nwg / NXCD, r = nwg % NXCD, xcd = wgid % NXCD, off = wgid / NXCD; wgid = (xcd < r ? xcd * (q + 1) : r * (q + 1) + (xcd - r) * q) + off; }
        const int nig = WGM * nN, gid = wgid / nig, fm = gid * WGM, gsz = (nM - fm) < WGM ? (nM - fm) : WGM;
        u.pm = fm + ((wgid % nig) % gsz); u.pn = (wgid % nig) / gsz; return true;
    }
    __device__ __forceinline__ void a_ready(const Unit&) const {}
    __device__ __forceinline__ void done(const Unit&) const {}
};

__device__ __forceinline__ unsigned cvt_pk_bf16(float lo, float hi) { unsigned r; asm volatile("v_cvt_pk_bf16_f32 %0, %1, %2" : "=v"(r) : "v"(lo), "v"(hi)); return r; }
typedef float f32x2 __attribute__((ext_vector_type(2)));
struct RangeOrder {
    StaticOrder S; int i0, i1;
    __device__ __forceinline__ bool next(int i, Unit& u) const { return (i0 + i < i1) && S.next(i0 + i, u); }
    __device__ __forceinline__ void a_ready(const Unit&) const {}
    __device__ __forceinline__ void done(const Unit&) const {}
};
template <class E> struct ProbeOf { static constexpr int v = 0; };
template <class Epi, class Sched, bool ALIGN_EPI = false, bool SP2 = false, bool GATHER = false, bool FP8 = false>
__device__ __forceinline__ void gemm_phase(PG8_LAS unsigned char* lds, const Gemm g, const Sched& S, const Epi& E) {
    const int tid = opaque_tid(), wid = __builtin_amdgcn_readfirstlane(tid >> 6), lane = tid & 63, wr = wid >> 2, wc = wid & 3, fr = lane & 15, fq = lane >> 4;
    const int K = g.K, nt = K / BK;
    unsigned voffA[2], voffB[2]; int RA[2]; unsigned CA2[2];
#pragma unroll
    for (int i = 0; i < 2; ++i) { int R, C; stage_rc(tid * 16 + i * 8192, R, C); const int Rb = Epi::PERM ? ((R & ~31) + perm32(R & 31)) : R;
        voffA[i] = (unsigned)(R * K + C) * 2u; voffB[i] = (unsigned)(Rb * K + C) * 2u; RA[i] = R; CA2[i] = (unsigned)C * 2u; }
    const size_t kstep = (size_t)(BK * 2);
    const size_t hstep = (size_t)HALF * K * 2;
    const size_t tstep = 2 * hstep;
    const unsigned ldsw = (unsigned)wid * 1024u;
    const int aoff = lds_byte(wr * 64 + fr, fq * 8), boff = lds_byte(wc * 32 + fr, fq * 8);
#define PG8_SA(b, h) (((b) * 2 + (h)) * HTB)
#define PG8_SB(b, h) ((4 + (b) * 2 + (h)) * HTB)
#define PG8_STAGE(bufoff, gbase, voff) do { if constexpr (!(ProbeOf<Epi>::v & 4)) _Pragma("unroll") for (int _i = 0; _i < 2; ++_i) \
        __builtin_amdgcn_global_load_lds((const unsigned*)((const char*)(gbase) + (voff)[_i]), (PG8_LAS unsigned*)(lds + (bufoff) + ldsw + _i * 8192), 16, 0, 0); } while (0)
    unsigned gc[2][2], gn[2][2];
#define PG8_GOFF(dst, pm_) do { _Pragma("unroll") for (int _h = 0; _h < 2; ++_h) _Pragma("unroll") for (int _i = 0; _i < 2; ++_i) \
        dst[_h][_i] = (unsigned)g.rowtok[(pm_) * BM + _h * HALF + RA[_i]] * (unsigned)(K * 2) + CA2[_i]; } while (0)
#define PG8_STAGE_A(bufoff, ptr, half, usenext) do { if constexpr (GATHER) { _Pragma("unroll") for (int _i = 0; _i < 2; ++_i) \
        __builtin_amdgcn_global_load_lds((const unsigned*)((const char*)(ptr) + ((usenext) ? gn[half][_i] : gc[half][_i])), (PG8_LAS unsigned*)(lds + (bufoff) + ldsw + _i * 8192), 16, 0, 0); } \
        else { PG8_STAGE(bufoff, (ptr) + (half) * hstep, voffA); } } while (0)
#define PG8_LDA(dst, b, h) do { if constexpr (ProbeOf<Epi>::v & 2) {} else if constexpr (FP8) { _Pragma("unroll") for (int m = 0; m < 4; ++m) dst##8[m] = PG8_CAT(*(const PG8_LAS bf16x8*)(lds + PG8_SA(b, h) + aoff + m * 2048), *(const PG8_LAS bf16x8*)(lds + PG8_SA(b, h) + aoff + m * 2048 + 1024)); } \
        else { _Pragma("unroll") for (int m = 0; m < 4; ++m) _Pragma("unroll") for (int k = 0; k < 2; ++k) dst[m][k] = *(const PG8_LAS bf16x8*)(lds + PG8_SA(b, h) + aoff + m * 2048 + k * 1024); } } while (0)
#define PG8_LDB(dst, b, h) do { if constexpr (ProbeOf<Epi>::v & 2) {} else if constexpr (FP8) { _Pragma("unroll") for (int n = 0; n < 2; ++n) dst##8[n] = PG8_CAT(*(const PG8_LAS bf16x8*)(lds + PG8_SB(b, h) + boff + n * 2048), *(const PG8_LAS bf16x8*)(lds + PG8_SB(b, h) + boff + n * 2048 + 1024)); } \
        else { _Pragma("unroll") for (int n = 0; n < 2; ++n) _Pragma("unroll") for (int k = 0; k < 2; ++k) dst[n][k] = *(const PG8_LAS bf16x8*)(lds + PG8_SB(b, h) + boff + n * 2048 + k * 1024); } } while (0)
typedef int pg8_v8i __attribute__((ext_vector_type(8))); typedef int pg8_v4i __attribute__((ext_vector_type(4)));
#define PG8_CAT(x0, x1) __builtin_shufflevector(__builtin_bit_cast(pg8_v4i, x0), __builtin_bit_cast(pg8_v4i, x1), 0, 1, 2, 3, 4, 5, 6, 7)
#define PG8_MMA(ai, bj, At, Bt) do { __builtin_amdgcn_s_setprio(1); if constexpr (ProbeOf<Epi>::v & 1) {} else if constexpr (FP8) { _Pragma("unroll") for (int m = 0; m < 4; ++m) _Pragma("unroll") for (int n = 0; n < 2; ++n) \
        asm volatile("v_mfma_scale_f32_16x16x128_f8f6f4 %0, %1, %2, %0, %3, %3 op_sel_hi:[0,0,0]" : "+v"(acc[ai][bj][m][n]) : "v"(Bt##8[n]), "v"(At##8[m]), "v"(pg8_scale1)); } \
        else { _Pragma("unroll") for (int m = 0; m < 4; ++m) _Pragma("unroll") for (int n = 0; n < 2; ++n) _Pragma("unroll") for (int k = 0; k < 2; ++k) \
        acc[ai][bj][m][n] = __builtin_amdgcn_mfma_f32_16x16x32_bf16(Bt[n][k], At[m][k], acc[ai][bj][m][n], 0, 0, 0); } __builtin_amdgcn_s_setprio(0); } while (0)
#define PG8_WAIT_V(n) asm volatile("s_waitcnt vmcnt(" #n ")" ::: "memory")
#define PG8_WAIT_L(n) asm volatile("s_waitcnt lgkmcnt(" #n ")" ::: "memory")
#define PG8_BAR __builtin_amdgcn_s_barrier()
#define PG8_SCHED __builtin_amdgcn_sched_barrier(0)
    Unit cur, nxt; int ui = 0;
    if (!S.next(0, cur)) return;
    f32x4 acc[2][2][4][2];
#pragma unroll
    for (int a = 0; a < 2; ++a)
#pragma unroll
        for (int b = 0; b < 2; ++b)
#pragma unroll
            for (int m = 0; m < 4; ++m)
#pragma unroll
                for (int n = 0; n < 2; ++n) acc[a][b][m][n] = (f32x4){0.f, 0.f, 0.f, 0.f};
    int pg8_scale1 = 0x7F7F7F7F; asm volatile("" : "+v"(pg8_scale1));
    bf16x8 At[4][2], B0[2][2], B1[2][2]; pg8_v8i At8[4], B08[2], B18[2];
    if constexpr (ProbeOf<Epi>::v & 2) { _Pragma("unroll") for (int m = 0; m < 4; ++m) { At8[m] = (pg8_v8i){1, 2, 3, 4, 5, 6, 7, 8}; asm volatile("" : "+v"(At8[m])); } _Pragma("unroll") for (int n = 0; n < 2; ++n) { B08[n] = (pg8_v8i){1, 2, 3, 4, 5, 6, 7, 8}; B18[n] = B08[n]; asm volatile("" : "+v"(B08[n]), "+v"(B18[n])); } }
    const char* cA = GATHER ? (const char*)g.A : (const char*)g.A + (size_t)cur.pm * tstep; const char* cB = (const char*)g.Bt + (size_t)cur.pn * tstep;
    if constexpr (GATHER) { PG8_GOFF(gc, cur.pm); }
    S.a_ready(cur);
    if constexpr (SP2) {
        PG8_STAGE(PG8_SB(0, 0), cB, voffB); PG8_STAGE(PG8_SB(0, 1), cB + hstep, voffB); PG8_STAGE_A(PG8_SA(0, 0), cA, 0, false); PG8_STAGE_A(PG8_SA(0, 1), cA, 1, false);
        if (wr == 1) PG8_BAR;
        PG8_WAIT_V(2); PG8_BAR;
        PG8_STAGE(PG8_SB(1, 0), cB + kstep, voffB); PG8_STAGE_A(PG8_SA(1, 0), cA + kstep, 0, false); PG8_STAGE(PG8_SB(1, 1), cB + hstep + kstep, voffB);
        PG8_WAIT_V(6); PG8_BAR;
    } else {
        PG8_STAGE(PG8_SB(0, 0), cB, voffB); PG8_STAGE_A(PG8_SA(0, 0), cA, 0, false); PG8_STAGE(PG8_SB(0, 1), cB + hstep, voffB); PG8_STAGE_A(PG8_SA(0, 1), cA, 1, false);
        if (wr == 1) PG8_BAR;
        PG8_WAIT_V(4); PG8_BAR;
        PG8_STAGE(PG8_SB(1, 0), cB + kstep, voffB); PG8_STAGE_A(PG8_SA(1, 0), cA + kstep, 0, false); PG8_STAGE(PG8_SB(1, 1), cB + hstep + kstep, voffB);
        PG8_WAIT_V(6); PG8_BAR;
    }
    for (;;) {
        const bool has_next = S.next(ui + 1, nxt);
        const char* nA = GATHER ? (const char*)g.A : (has_next ? (const char*)g.A + (size_t)nxt.pm * tstep : cA);
        if constexpr (GATHER) { if (has_next) { PG8_GOFF(gn, nxt.pm); } else { _Pragma("unroll") for (int _h = 0; _h < 2; ++_h) _Pragma("unroll") for (int _i = 0; _i < 2; ++_i) gn[_h][_i] = gc[_h][_i]; } } const char* nB = has_next ? (const char*)g.Bt + (size_t)nxt.pn * tstep : cB;
#pragma nounroll
        for (int t = 0; t < nt; t += 2) {
            const bool last = (t == nt - 2);
            const char* a1 = cA + (size_t)(t + 1) * kstep;
            const char* a2 = last ? nA : cA + (size_t)(t + 2) * kstep; const char* b2 = last ? nB : cB + (size_t)(t + 2) * kstep;
            const char* a3 = a2 + kstep; const char* b3 = b2 + kstep;
            if (last && has_next) S.a_ready(nxt);
            if constexpr (SP2) {
            PG8_LDB(B0, 0, 0); PG8_LDB(B1, 0, 1); PG8_SCHED; PG8_LDA(At, 0, 0); PG8_STAGE_A(PG8_SA(1, 1), a1, 1, false);
            PG8_WAIT_V(8); PG8_WAIT_L(0); PG8_BAR; PG8_MMA(0, 0, At, B0); PG8_MMA(0, 1, At, B1); PG8_BAR; PG8_SCHED;
            PG8_LDA(At, 0, 1); PG8_STAGE(PG8_SB(0, 0), b2, voffB); PG8_STAGE(PG8_SB(0, 1), b2 + hstep, voffB); PG8_STAGE_A(PG8_SA(0, 0), a2, 0, last);
            PG8_WAIT_V(8); PG8_WAIT_L(0); PG8_BAR; PG8_MMA(1, 0, At, B0); PG8_MMA(1, 1, At, B1); PG8_BAR; PG8_SCHED;
            PG8_LDB(B0, 1, 0); PG8_LDB(B1, 1, 1); PG8_SCHED; PG8_LDA(At, 1, 0); PG8_STAGE_A(PG8_SA(0, 1), a2, 1, last);
            PG8_WAIT_V(8); PG8_WAIT_L(0); PG8_BAR; PG8_MMA(0, 0, At, B0); PG8_MMA(0, 1, At, B1); PG8_BAR; PG8_SCHED;
            PG8_LDA(At, 1, 1); PG8_STAGE(PG8_SB(1, 0), b3, voffB); PG8_STAGE(PG8_SB(1, 1), b3 + hstep, voffB); PG8_STAGE_A(PG8_SA(1, 0), a3, 0, last);
            PG8_WAIT_V(8); PG8_WAIT_L(0); PG8_BAR; PG8_MMA(1, 0, At, B0); PG8_MMA(1, 1, At, B1); PG8_BAR; PG8_SCHED;
            } else {
            PG8_LDB(B0, 0, 0); PG8_SCHED; PG8_LDA(At, 0, 0); PG8_STAGE_A(PG8_SA(1, 1), a1, 1, false);
            PG8_WAIT_L(8); PG8_BAR; PG8_WAIT_L(0); PG8_MMA(0, 0, At, B0); PG8_BAR; PG8_SCHED;
            PG8_LDB(B1, 0, 1); PG8_STAGE(PG8_SB(0, 0), b2, voffB);
            PG8_BAR; PG8_WAIT_L(0); PG8_MMA(0, 1, At, B1); PG8_BAR;
            PG8_LDA(At, 0, 1); PG8_STAGE_A(PG8_SA(0, 0), a2, 0, last);
            PG8_BAR; PG8_WAIT_L(0); PG8_MMA(1, 0, At, B0); PG8_BAR; PG8_SCHED;
            PG8_STAGE(PG8_SB(0, 1), b2 + hstep, voffB);
            PG8_WAIT_V(6); PG8_BAR; PG8_MMA(1, 1, At, B1); PG8_BAR;
            PG8_LDB(B0, 1, 0); PG8_SCHED; PG8_LDA(At, 1, 0); PG8_STAGE_A(PG8_SA(0, 1), a2, 1, last);
            PG8_WAIT_L(8); PG8_BAR; PG8_WAIT_L(0); PG8_MMA(0, 0, At, B0); PG8_BAR; PG8_SCHED;
            PG8_LDB(B1, 1, 1); PG8_STAGE(PG8_SB(1, 0), b3, voffB);
            PG8_BAR; PG8_WAIT_L(0); PG8_MMA(0, 1, At, B1); PG8_BAR;
            PG8_LDA(At, 1, 1); PG8_STAGE_A(PG8_SA(1, 0), a3, 0, last);
            PG8_BAR; PG8_WAIT_L(0); PG8_MMA(1, 0, At, B0); PG8_BAR; PG8_SCHED;
            PG8_STAGE(PG8_SB(1, 1), b3 + hstep, voffB);
            PG8_WAIT_V(6); PG8_BAR; PG8_MMA(1, 1, At, B1); PG8_BAR;
            }
        }
        if constexpr (FP8) asm volatile("s_nop 15\n\ts_nop 15" ::: "memory");
        if constexpr (ALIGN_EPI) { if (wr == 0) PG8_BAR; }
        if constexpr (!Epi::AFTER_DRAIN) { E(acc, cur, wr, wc, fr, fq); S.done(cur); }
        if (!has_next) break;
#pragma unroll
        for (int a = 0; a < 2; ++a)
#pragma unroll
            for (int b = 0; b < 2; ++b)
#pragma unroll
                for (int m = 0; m < 4; ++m)
#pragma unroll
                    for (int n = 0; n < 2; ++n) acc[a][b][m][n] = (f32x4){0.f, 0.f, 0.f, 0.f};
        cur = nxt; cA = nA; cB = nB; ++ui;
        if constexpr (GATHER) { _Pragma("unroll") for (int _h = 0; _h < 2; ++_h) _Pragma("unroll") for (int _i = 0; _i < 2; ++_i) gc[_h][_i] = gn[_h][_i]; }
        if constexpr (ALIGN_EPI) { if (wr == 1) PG8_BAR; }
    }
    PG8_WAIT_V(0);
    if constexpr (!ALIGN_EPI) { if (wr == 0) PG8_BAR; }
    PG8_BAR;
    if constexpr (Epi::AFTER_DRAIN) { E.fused(acc, cur, wr, wc, fr, fq, lds, wid, lane); S.done(cur); }
#undef PG8_SA
#undef PG8_SB
#undef PG8_STAGE
#undef PG8_STAGE_A
#undef PG8_GOFF
#undef PG8_LDA
#undef PG8_LDB
#undef PG8_MMA
#undef PG8_CAT
#undef PG8_WAIT_V
#undef PG8_WAIT_L
#undef PG8_BAR
#undef PG8_SCHED
}
}
#define XB_TMO      128
#define XB_XCNT(j)  (256  + 64 * (j))
#define XB_XSUB(j)  (1280 + 64 * (j))
#define XB_XGEN(j)  (2304 + 64 * (j))
#define XB_TOP      3328
#define XB_TOPGEN   3392
#define XCD_BAR_WORDS 3456
#define XB_SPIN_CAP (1u << 18)

__device__ __forceinline__ unsigned xb_ld(unsigned* p)              { return __hip_atomic_load(p, __ATOMIC_RELAXED, __HIP_MEMORY_SCOPE_AGENT); }
__device__ __forceinline__ unsigned xb_add(unsigned* p, unsigned v) { return __hip_atomic_fetch_add(p, v, __ATOMIC_RELAXED, __HIP_MEMORY_SCOPE_AGENT); }
__device__ __forceinline__ unsigned xb_xcc_id() { return (unsigned)__builtin_amdgcn_s_getreg((3 << 11) | 20) & 0xFu; }
#define XB_SPIN(cond, bar) do { unsigned _sp = 0; while (cond) { __builtin_amdgcn_s_sleep(1); \
    if ((++_sp & 255u) == 0u) { if (xb_ld(&(bar)[XB_TMO])) break; if (_sp > XB_SPIN_CAP) { atomicAdd(&(bar)[XB_TMO], 1u); break; } } } } while (0)

struct XcdBarrier {
    unsigned* bar; unsigned x;
    volatile LAS unsigned* st;
};

__device__ __forceinline__ XcdBarrier xcd_barrier_post(unsigned* bar, volatile LAS unsigned* st) {
    XcdBarrier b; b.bar = bar; b.x = xb_xcc_id(); b.st = st;
    if (threadIdx.x == 0) (void)xb_add(&bar[XB_XCNT(b.x)], 1u);
    return b;
}
__device__ __forceinline__ void xcd_barrier_complete(unsigned* bar, unsigned x, unsigned& nloc, unsigned& nx) {
    const unsigned G = gridDim.x * gridDim.y * gridDim.z;
    unsigned sum, cnt, mine, sp = 0u;
    for (;;) {
        sum = 0u; cnt = 0u; mine = 0u;
#pragma unroll
        for (unsigned j = 0; j < 16; ++j) { const unsigned c = xb_ld(&bar[XB_XCNT(j)]); sum += c; cnt += (c > 0u) ? 1u : 0u; mine = (j == x) ? c : mine; }
        if (sum == G) break;
        __builtin_amdgcn_s_sleep(1);
        if ((++sp & 255u) == 0u) { if (xb_ld(&bar[XB_TMO])) break; if (sp > XB_SPIN_CAP) { atomicAdd(&bar[XB_TMO], 1u); break; } }
    }
    nloc = mine > 0u ? mine : 1u; nx = cnt > 0u ? cnt : 1u;
}

__device__ __forceinline__ void xcd_barrier(const XcdBarrier& b) {
    asm volatile("s_waitcnt vmcnt(0)" ::: "memory");
    __syncthreads();
    if (threadIdx.x == 0) {
        unsigned* bar = b.bar;
        __builtin_amdgcn_s_waitcnt(0);
        unsigned nloc = b.st[0], nx = b.st[1];
        if (nloc == 0u) { xcd_barrier_complete(bar, b.x, nloc, nx); b.st[0] = nloc; b.st[1] = nx; }
        const unsigned old = xb_add(&bar[XB_XSUB(b.x)], 1u);
        const unsigned gen = old / nloc;
        if (old + 1u == (gen + 1u) * nloc) {
            __builtin_amdgcn_fence(__ATOMIC_RELEASE, "agent");
            asm volatile("s_waitcnt vmcnt(0)" ::: "memory");
            const unsigned og = xb_add(&bar[XB_TOP], 1u);
            const unsigned tg = og / nx;
            if (og + 1u == (tg + 1u) * nx) xb_add(&bar[XB_TOPGEN], 1u);
            else XB_SPIN(xb_ld(&bar[XB_TOPGEN]) == tg, bar);
            __builtin_amdgcn_fence(__ATOMIC_ACQUIRE, "agent");
            xb_add(&bar[XB_XGEN(b.x)], 1u);
            asm volatile("s_waitcnt vmcnt(0)" ::: "memory");
        } else {
            XB_SPIN(xb_ld(&bar[XB_XGEN(b.x)]) == gen, bar);
            __builtin_amdgcn_fence(__ATOMIC_ACQUIRE, "agent");
            asm volatile("s_waitcnt vmcnt(0)" ::: "memory");
        }
    }
    __syncthreads();
}

enum InIdx { I_X = 0, I_MEM, I_RELB, I_ATTN_G, I_FFN_G, I_MEM_G, I_W_MKV, I_QN_MEM, I_KN_MEM, I_W_OUT, I_W_INA, I_QN_A, I_KN_A, I_KV_G, I_W_KVB, I_KN_B, I_W_INB, I_QN_B,
             I_LAMBDA, I_SUBLN, I_W_RG, I_B_RG, I_W_RE, I_B_RE, I_W_GATE, I_W_UP, I_W_DOWN, N_IN };
struct Args { const float* in[N_IN]; float* out; unsigned char* ws; int ph_lo, ph_hi; };
static_assert(sizeof(Args) == N_IN * 8 + 8 + 8 + 8, "Args has no padding");

using pg8::cvt_pk_bf16;
struct EpiRowScale {
    static constexpr bool PERM = true, AFTER_DRAIN = false;
    bf16* O; int ldc; const float* rs; int ntn; float cs;
    __device__ __forceinline__ void operator()(const f32x4 (&acc)[2][2][4][2], const pg8::Unit& u, int wr, int wc, int fr, int fq) const {
        const int colt = ntn ? (u.pn % ntn) : u.pn;
        const int row0 = u.pm * 256 + wr * 64 + fr, col0 = colt * 256 + wc * 32 + 8 * fq;
#pragma unroll
        for (int ai = 0; ai < 2; ++ai)
#pragma unroll
            for (int m = 0; m < 4; ++m) { const int row = row0 + ai * 128 + m * 16; const float s = (rs ? rs[row] : 1.f) * cs; bf16* rowp = O + (size_t)row * ldc + col0;
#pragma unroll
                for (int bj = 0; bj < 2; ++bj) { const f32x4 v0 = acc[ai][bj][m][0] * s, v1 = acc[ai][bj][m][1] * s;
                    v4u w; w.x = cvt_pk_bf16(v0[0], v0[1]); w.y = cvt_pk_bf16(v0[2], v0[3]); w.z = cvt_pk_bf16(v1[0], v1[1]); w.w = cvt_pk_bf16(v1[2], v1[3]);
                    *(v4u*)(rowp + bj * 128) = w; } }
    }
};
template <bool RES_F32, int PV = 0>
struct EpiOutProj {
    static constexpr bool PERM = true, AFTER_DRAIN = false;
    const float* resid; float* part; bf16* HB; unsigned char* HB8; float cs;
    __device__ __forceinline__ void operator()(const f32x4 (&acc)[2][2][4][2], const pg8::Unit& u, int wr, int wc, int fr, int fq) const {
        const int row0 = u.pm * 256 + wr * 64 + fr, col0 = u.pn * 256 + wc * 32 + 8 * fq;
#pragma unroll
        for (int ai = 0; ai < 2; ++ai)
#pragma unroll
            for (int mp = 0; mp < 2; ++mp) {
                f32x4 rf[2][2][2]; v4u rb[2][2];
#pragma unroll
                for (int mm = 0; mm < 2; ++mm) { const size_t off = (size_t)(row0 + ai * 128 + (2 * mp + mm) * 16) * DM + col0;
#pragma unroll
                    for (int bj = 0; bj < 2; ++bj) {
                        if (PV & 1) { rf[mm][bj][0] = (f32x4){0.f, 0.f, 0.f, 0.f}; rf[mm][bj][1] = rf[mm][bj][0]; rb[mm][bj] = (v4u){0u, 0u, 0u, 0u}; }
                        else if (RES_F32) { rf[mm][bj][0] = *(const f32x4*)(resid + off + bj * 128); rf[mm][bj][1] = *(const f32x4*)(resid + off + bj * 128 + 4); }
                        else rb[mm][bj] = *(const v4u*)(HB + off + bj * 128); } }
#pragma unroll
                for (int mm = 0; mm < 2; ++mm) { const int m = 2 * mp + mm; const int row = row0 + ai * 128 + m * 16; const size_t off = (size_t)row * DM + col0; float ss = 0.f;
#pragma unroll
                    for (int bj = 0; bj < 2; ++bj) { f32x4 r0, r1;
                        if (RES_F32) { r0 = rf[mm][bj][0]; r1 = rf[mm][bj][1]; }
                        else { const v4u q = rb[mm][bj]; r0 = (f32x4){bflo(q.x), bfhi(q.x), bflo(q.y), bfhi(q.y)}; r1 = (f32x4){bflo(q.z), bfhi(q.z), bflo(q.w), bfhi(q.w)}; }
                        const f32x4 v0 = r0 + acc[ai][bj][m][0] * cs, v1 = r1 + acc[ai][bj][m][1] * cs;
                        ss += ((v0[0] * v0[0] + v0[1] * v0[1]) + (v0[2] * v0[2] + v0[3] * v0[3])) + ((v1[0] * v1[0] + v1[1] * v1[1]) + (v1[2] * v1[2] + v1[3] * v1[3]));
                        v4u hb; hb.x = cvt_pk_bf16(v0[0], v0[1]); hb.y = cvt_pk_bf16(v0[2], v0[3]); hb.z = cvt_pk_bf16(v1[0], v1[1]); hb.w = cvt_pk_bf16(v1[2], v1[3]);
                        if (!(PV & 2) || hb.x == 0x12345u) *(v4u*)(HB + off + bj * 128) = hb;
                        unsigned w0 = 0u, w1 = 0u; w0 = __builtin_amdgcn_cvt_pk_fp8_f32(v0[0], v0[1], w0, false); w0 = __builtin_amdgcn_cvt_pk_fp8_f32(v0[2], v0[3], w0, true);
                        w1 = __builtin_amdgcn_cvt_pk_fp8_f32(v1[0], v1[1], w1, false); w1 = __builtin_amdgcn_cvt_pk_fp8_f32(v1[2], v1[3], w1, true);
                        if (!(PV & 4) || w0 == 0x12345u) *(v2u*)(HB8 + off + bj * 128) = (v2u){w0, w1}; }
                    ss += swz_xor<16>(ss); ss = add_xor32(ss);
                    if (fq == 0) part[(size_t)row * 32 + u.pn * 4 + wc] = ss; } }
    }
};
struct EpiSiluMul {
    static constexpr bool PERM = true, AFTER_DRAIN = false;
    bf16* O; const float* rstd; const int* rowtok;
    __device__ __forceinline__ void operator()(const f32x4 (&acc)[2][2][4][2], const pg8::Unit& u, int wr, int wc, int fr, int fq) const {
        const int row0 = u.pm * 256 + wr * 64 + fr, col0 = (u.pn & 3) * 128 + wc * 32 + 8 * fq;
        int tk[2][4]; float rsv[2][4];
#pragma unroll
        for (int ai = 0; ai < 2; ++ai)
#pragma unroll
            for (int m = 0; m < 4; ++m) tk[ai][m] = rowtok[row0 + ai * 128 + m * 16];
#pragma unroll
        for (int ai = 0; ai < 2; ++ai)
#pragma unroll
            for (int m = 0; m < 4; ++m) rsv[ai][m] = rstd[tk[ai][m]] * (1.f / SC_W1);
#pragma unroll
        for (int ai = 0; ai < 2; ++ai)
#pragma unroll
            for (int m = 0; m < 4; ++m) { const int row = row0 + ai * 128 + m * 16; float h[8]; const float rs = rsv[ai][m];
#pragma unroll
                for (int n = 0; n < 2; ++n)
#pragma unroll
                    for (int e = 0; e < 4; ++e) { const float g = acc[ai][0][m][n][e] * rs, up = acc[ai][1][m][n][e] * (rs * SC_HID);
                        h[n * 4 + e] = g * up * __builtin_amdgcn_rcpf(1.f + __builtin_amdgcn_exp2f(-g * LOG2E)); }
                unsigned w0 = 0u, w1 = 0u; w0 = __builtin_amdgcn_cvt_pk_fp8_f32(h[0], h[1], w0, false); w0 = __builtin_amdgcn_cvt_pk_fp8_f32(h[2], h[3], w0, true);
                w1 = __builtin_amdgcn_cvt_pk_fp8_f32(h[4], h[5], w1, false); w1 = __builtin_amdgcn_cvt_pk_fp8_f32(h[6], h[7], w1, true);
                *(v2u*)((unsigned char*)O + (size_t)row * EFF + col0) = (v2u){w0, w1}; }
    }
};
struct MoeOrder {
    const int* blk_e; int nunits, ntn, G, c;
    __device__ __forceinline__ bool next(int i, pg8::Unit& u) const {
        const int L = i * G + c; if (L >= nunits) return false;
        const int rb = L / ntn; u.pm = rb; u.pn = blk_e[rb] * ntn + (L - rb * ntn); return true;
    }
    __device__ __forceinline__ void a_ready(const pg8::Unit&) const {}
    __device__ __forceinline__ void done(const pg8::Unit&) const {}
};

struct TrDesc { const float* src; int N; bf16* dst; int dstK; const float* gain; float f8; };
__device__ __forceinline__ TrDesc tr_decode(const Args& a, int r) {
    unsigned char* ws = opaque_ws(a.ws); TrDesc d; d.f8 = 0.f;
    constexpr int R0 = 2560, R1 = 1024, R2 = 1536, R3 = 2048, R4 = 1024, R5 = 32768, R6 = 32768;
    if (r < R0) { const int kb = r / 160, nb = r % 160; d.src = a.in[I_W_INA] + (size_t)(128 * kb) * 5120 + 32 * nb; d.N = 5120; d.dst = (bf16*)(ws + WS_W_INA + (size_t)(32 * nb) * DM + 128 * kb); d.dstK = DM; d.gain = a.in[I_ATTN_G] + 128 * kb; d.f8 = SC_W1; return d; } r -= R0;
    if (r < R1) { const int kb = r / 64, nb = r % 64; d.src = a.in[I_W_INB] + (size_t)(128 * kb) * 2048 + 32 * nb; d.N = 2048; d.dst = (bf16*)(ws + WS_W_INB + (size_t)(32 * nb) * DM + 128 * kb); d.dstK = DM; d.gain = a.in[I_ATTN_G] + DM + 128 * kb; d.f8 = SC_W1; return d; } r -= R1;
    if (r < R2) { const int kb = r / 96, nb = r % 96; d.src = a.in[I_W_KVB] + (size_t)(128 * kb) * 3072 + 32 * nb; d.N = 3072; d.dst = (bf16*)(ws + WS_W_INB + (size_t)(2048 + 32 * nb) * DM + 128 * kb); d.dstK = DM; d.gain = a.in[I_KV_G] + 128 * kb; d.f8 = SC_W1; return d; } r -= R2;
    if (r < R3) { const int l = r / 1024, rr = r % 1024, kb = rr / 64, nb = rr % 64; d.src = a.in[I_W_OUT] + (size_t)l * DM * DM + (size_t)(128 * kb) * 2048 + 32 * nb; d.N = 2048;
        d.dst = (bf16*)(ws + WS_W_OUT + (size_t)l * DM * DM + (size_t)(32 * nb) * DM + 128 * kb); d.f8 = SC_W1;
        d.dstK = DM; d.gain = nullptr; return d; } r -= R3;
    if (r < R4) { const int l = r / 512, rr = r % 512, kb = rr / 32, nb = rr % 32; d.src = a.in[I_W_MKV] + (size_t)l * DM * 1024 + (size_t)(128 * kb) * 1024 + 32 * nb; d.N = 1024;
        d.dst = (bf16*)(ws + WS_W_MKV) + (size_t)l * 1024 * DM + (size_t)(32 * nb) * DM + 128 * kb; d.dstK = DM; d.gain = a.in[I_MEM_G] + l * DM + 128 * kb; return d; } r -= R4;
    if (r < R5 + R6) { const int up = r >= R5 ? 1 : 0; if (up) r -= R5;
        const int le = r / 256, rr = r % 256, kb = rr / 16, nb = rr % 16, n0 = 32 * nb, drow = (n0 >> 7) * 256 + (n0 & 127) + up * 128;
        d.src = (up ? a.in[I_W_UP] : a.in[I_W_GATE]) + (size_t)le * DM * EFF + (size_t)(128 * kb) * EFF + n0; d.N = EFF;
        d.dst = (bf16*)(ws + WS_W_E1 + ((size_t)le * 1024 + drow) * DM + 128 * kb); d.dstK = DM; d.gain = a.in[I_FFN_G] + (le >> 6) * DM + 128 * kb; d.f8 = SC_W1; return d; } r -= R5 + R6;
    { const int le = r / 256, rr = r % 256, kb = rr / 64, nb = rr % 64; d.src = a.in[I_W_DOWN] + (size_t)le * EFF * DM + (size_t)(128 * kb) * DM + 32 * nb; d.N = DM;
        d.dst = (bf16*)(ws + WS_W_E2 + ((size_t)le * DM + 32 * nb) * EFF + 128 * kb); d.dstK = EFF; d.gain = nullptr; d.f8 = SC_W2; return d; }
}
__device__ __forceinline__ float row_to_fp8(const float* xrow, unsigned char* orow, int lane) {
    const GAS f32x4* xr = (const GAS f32x4*)xrow + lane;
    f32x4 v[8]; float s = 0.f;
#pragma unroll
    for (int j = 0; j < 8; ++j) { v[j] = xr[64 * j]; s += (v[j].x * v[j].x + v[j].y * v[j].y) + (v[j].z * v[j].z + v[j].w * v[j].w); }
    const float rstd = 1.0f / sqrtf(wave_sum(s) * (1.f / DM) + RMS_EPS);
    GAS unsigned* o4 = (GAS unsigned*)orow + lane;
#pragma unroll
    for (int j = 0; j < 8; ++j) { unsigned w = 0u; w = __builtin_amdgcn_cvt_pk_fp8_f32(v[j].x, v[j].y, w, false); w = __builtin_amdgcn_cvt_pk_fp8_f32(v[j].z, v[j].w, w, true); o4[64 * j] = w; }
    return rstd;
}
__device__ __forceinline__ float row_to_bf16(const float* xrow, bf16* orow, bool normalise, int lane) {
    const GAS f32x4* xr = (const GAS f32x4*)xrow + lane;
    f32x4 v[8]; float s = 0.f;
#pragma unroll
    for (int j = 0; j < 8; ++j) { v[j] = xr[64 * j]; s += (v[j].x * v[j].x + v[j].y * v[j].y) + (v[j].z * v[j].z + v[j].w * v[j].w); }
    const float rstd = 1.0f / sqrtf(wave_sum(s) * (1.f / DM) + RMS_EPS);
    const float f = normalise ? rstd : 1.f;
    GAS unsigned long long* o8 = (GAS unsigned long long*)orow + lane;
#pragma unroll
    for (int j = 0; j < 8; ++j) o8[64 * j] = (unsigned long long)pk2(v[j].x * f, v[j].y * f) | ((unsigned long long)pk2(v[j].z * f, v[j].w * f) << 32);
    return rstd;
}
#define TR_IDX(i) (layer < 0 ? (i) : 8192 + ((i) / 16384) * 32768 + layer * 16384 + ((i) % 16384))
__device__ __forceinline__ void tr_loop(const Args& a, LAS float* scr, int lane, int it, int end, int stride, int layer) {
    const int first0 = it < end ? it : 0;
    {
        float v[64];
        const int lr = lane >> 5, lc = lane & 31;
        TrDesc cur = tr_decode(a, TR_IDX(it < end ? it : first0));
        if (it < end) {
#pragma unroll
            for (int i = 0; i < 64; ++i) v[i] = __builtin_nontemporal_load(cur.src + (size_t)(2 * i + lr) * cur.N + lc);
        }
        for (; it < end; it += stride) {
#pragma unroll
            for (int i = 0; i < 64; ++i) scr[(2 * i + lr) * 33 + lc] = v[i];
            LDS_WAIT(); asm volatile("" ::: "memory");
            const int nx = it + stride; const bool has_next = nx < end;
            const TrDesc nd = tr_decode(a, TR_IDX(has_next ? nx : it));
            if (has_next) {
#pragma unroll
                for (int i = 0; i < 64; ++i) v[i] = __builtin_nontemporal_load(nd.src + (size_t)(2 * i + lr) * nd.N + lc);
            }
            if (cur.f8 != 0.f) {
                const int c = lane & 7, nq = lane >> 3; const float f = cur.f8;
                f32x4 g[4];
#pragma unroll
                for (int q = 0; q < 4; ++q) g[q] = cur.gain ? *(const f32x4*)(cur.gain + 16 * c + 4 * q) * f : (f32x4){f, f, f, f};
#pragma unroll
                for (int j = 0; j < 4; ++j) { const int n = nq + 8 * j; const LAS float* sp = scr + (16 * c) * 33 + n; v4u o;
#pragma unroll
                    for (int q = 0; q < 4; ++q) { unsigned w = 0u;
                        w = __builtin_amdgcn_cvt_pk_fp8_f32(sp[(4 * q + 0) * 33] * g[q][0], sp[(4 * q + 1) * 33] * g[q][1], w, false);
                        w = __builtin_amdgcn_cvt_pk_fp8_f32(sp[(4 * q + 2) * 33] * g[q][2], sp[(4 * q + 3) * 33] * g[q][3], w, true); o[q] = w; }
                    *(GAS v4u*)((unsigned char*)cur.dst + (size_t)n * cur.dstK + 16 * c) = o; }
            } else {
                const int c = lane & 15, nq = lane >> 4;
                f32x4 g0 = (f32x4){1.f, 1.f, 1.f, 1.f}, g1 = g0;
                if (cur.gain) { g0 = *(const f32x4*)(cur.gain + 8 * c); g1 = *(const f32x4*)(cur.gain + 8 * c + 4); }
#pragma unroll
                for (int j = 0; j < 8; ++j) { const int n = nq + 4 * j; const LAS float* sp = scr + (8 * c) * 33 + n;
                    v4u o; o.x = pk2(sp[0 * 33] * g0[0], sp[1 * 33] * g0[1]); o.y = pk2(sp[2 * 33] * g0[2], sp[3 * 33] * g0[3]); o.z = pk2(sp[4 * 33] * g1[0], sp[5 * 33] * g1[1]); o.w = pk2(sp[6 * 33] * g1[2], sp[7 * 33] * g1[3]);
                    *(GAS v4u*)(cur.dst + (size_t)n * cur.dstK + 8 * c) = o; }
            }
            LDS_WAIT(); asm volatile("" ::: "memory");
            cur = nd;
        }
    }
}
#undef TR_IDX
constexpr int EXP_ITEMS = 49152, CONV_CH = 48, CONV_NCH = EXP_ITEMS / CONV_CH, CONV_IN = 512, CONV_SP = 256;
__device__ __forceinline__ void conv_chunk(const Args& a, LAS unsigned char* lds, int layer, int c) {
    const int tid = opaque_tid(), lane = tid & 63, wave = __builtin_amdgcn_readfirstlane(tid >> 6);
    tr_loop(a, (LAS float*)(lds + RING_OFF + wave * 16896), lane, c * CONV_CH + wave, (c + 1) * CONV_CH, 8, layer);
    __syncthreads();
}
struct Mix { bool conv; int idx; };
__device__ __forceinline__ Mix mix_decode(int u, int NA, int NC) {
    const long U = NA + NC; const int cb = (int)(((long)u * NC) / U), cb1 = (int)(((long)(u + 1) * NC) / U);
    Mix m; m.conv = cb1 != cb; m.idx = m.conv ? cb : u - cb; return m;
}
__device__ __forceinline__ void phase_prep(const Args& a, LAS unsigned char* lds, int G, int vb) {
    const int tid = opaque_tid(), lane = tid & 63, wave = __builtin_amdgcn_readfirstlane(tid >> 6);
    unsigned char* ws = opaque_ws(a.ws);
    LAS float* scr = (LAS float*)(lds + RING_OFF + wave * 16896);
    const int gw = vb * 8 + wave, NGW = G * 8;
    tr_loop(a, scr, lane, gw, 8192, NGW, -1);
    for (int idx = vb * 512 + tid; idx < 2 * NRTP * DM; idx += G * 512) {
        const int l = idx / (NRTP * DM), j = (idx / DM) % NRTP, k = idx % DM;
        float v = 0.f;
        if (j < 8) v = a.in[I_W_RG][((size_t)l * DM + k) * 8 + j]; else if (j < NRT) v = a.in[I_W_RE][((size_t)l * DM + k) * 64 + (j - 8)];
        v *= a.in[I_FFN_G][l * DM + k];
        const unsigned hi = f2bf(v); const float lo = v - bf2f((unsigned short)hi);
        bf16* wr = (bf16*)(ws + WS_W_RT) + (size_t)l * 2 * NRTP * DM;
        wr[(size_t)j * DM + k] = (bf16)hi; wr[(size_t)(NRTP + j) * DM + k] = (bf16)f2bf(lo);
    }
    for (int idx = vb * 512 + tid; idx < 2 * 5 * HD; idx += G * 512) { const int l = idx / (5 * HD), w = (idx / HD) % 5, i = idx % HD; float v;
        if (l == 0) v = (w < 2) ? a.in[I_QN_A][i] : (w == 2) ? a.in[I_QN_MEM][i] : a.in[I_KN_A][i];
        else v = (w == 0) ? a.in[I_QN_B][i] : (w == 1) ? a.in[I_QN_B][HD + i] : (w == 2) ? a.in[I_QN_MEM][HD + i] : (w == 3) ? a.in[I_KN_B][i] : a.in[I_KN_B][HD + i];
        ((float*)(ws + WS_SMALL + SM_GAINTAB))[idx] = v; }
    float* rstd = (float*)(ws + WS_SMALL + SM_RSTD);
    for (int m = gw; m < T; m += NGW) { const float rs = row_to_fp8(a.in[I_X] + (size_t)m * DM, ws + WS_HB8 + (size_t)m * DM, lane); if (lane == 0) rstd[m] = rs; }
    for (int m = gw; m < NB * NMEM; m += NGW) (void)row_to_bf16(a.in[I_MEM] + (size_t)m * DM, (bf16*)(ws + WS_SMALL + SM_MEMN) + (size_t)m * DM, true, lane);
}

struct PostDesc { const bf16* src; int sp; bf16* dst; int dp; const float* gain; float scale; float* kmean; };
__device__ __forceinline__ void post_unit(const PostDesc& d, LAS unsigned char* lds) {
    const int tid = opaque_tid(), lane = tid & 63, wave = __builtin_amdgcn_readfirstlane(tid >> 6), c = lane & 15, rg = lane >> 4;
    float g8[8]; float cs[8];
#pragma unroll
    for (int i = 0; i < 8; ++i) { g8[i] = d.gain ? d.gain[8 * c + i] * d.scale : 1.f; cs[i] = 0.f; }
    v4u wv[8];
#pragma unroll
    for (int it = 0; it < 8; ++it) wv[it] = *(const v4u*)(d.src + (size_t)(wave * 32 + it * 4 + rg) * d.sp + 8 * c);
#pragma unroll
    for (int it = 0; it < 8; ++it) {
        const int row = wave * 32 + it * 4 + rg;
        const v4u w = wv[it];
        float f[8] = {bflo(w.x), bfhi(w.x), bflo(w.y), bfhi(w.y), bflo(w.z), bfhi(w.z), bflo(w.w), bfhi(w.w)};
        if (d.gain) {
            float ss = 0.f;
#pragma unroll
            for (int i = 0; i < 8; ++i) ss += f[i] * f[i];
            ss += swz_xor<1>(ss); ss += swz_xor<2>(ss); ss += swz_xor<4>(ss); ss += swz_xor<8>(ss);
            const float rstd = 1.0f / sqrtf(ss * (1.f / HD) + RMS_EPS);
#pragma unroll
            for (int i = 0; i < 8; ++i) { f[i] = f[i] * rstd * g8[i]; cs[i] += f[i]; }
        }
        v4u o; o.x = pk2(f[0], f[1]); o.y = pk2(f[2], f[3]); o.z = pk2(f[4], f[5]); o.w = pk2(f[6], f[7]);
        *(v4u*)(d.dst + (size_t)row * d.dp + 8 * c) = o;
    }
    if (d.kmean) {
        LAS float* ks = (LAS float*)(lds + RING_OFF);
#pragma unroll
        for (int i = 0; i < 8; ++i) { cs[i] += swz_xor<16>(cs[i]); cs[i] = add_xor32(cs[i]); }
        if (lane < 16) {
#pragma unroll
            for (int i = 0; i < 8; ++i) ks[wave * 128 + 8 * c + i] = cs[i]; }
        __syncthreads();
        if (tid < 128) { float s = 0.f;
#pragma unroll
            for (int w = 0; w < 8; ++w) s += ks[w * 128 + tid];
            d.kmean[tid] = s * (1.f / 256.f); }
        __syncthreads();
    }
}
__device__ __forceinline__ void phase_post_mem(const Args& a, LAS unsigned char* lds, int G, int vb) {
    unsigned char* ws = opaque_ws(a.ws);
    for (int v = vb; v < 32; v += G) {
        PostDesc d; d.kmean = nullptr; d.scale = 1.f; d.gain = nullptr;
        const int l = v >> 4, b = (v >> 3) & 1, s8 = v & 7;
        const bf16* srow = (const bf16*)(ws + WS_SMALL + SM_KVM) + ((size_t)b * 256) * 2048 + l * 1024; d.sp = 2048; d.dp = HD;
        if (s8 < 4) { d.src = srow + s8 * 128; d.dst = (bf16*)(ws + WS_SMALL + SM_KM) + ((size_t)((l * 2 + b) * 4 + s8) * NMEM) * HD; d.gain = a.in[I_KN_MEM] + l * HD; }
        else { d.src = srow + 512 + (s8 - 4) * 128; d.dst = (bf16*)(ws + WS_SMALL + SM_VM) + ((size_t)((l * 2 + b) * 4 + (s8 - 4)) * NMEM) * HD; }
        post_unit(d, lds);
    }
}
struct SlotDesc { bf16* dst; int dp; const float* gain; float scale; float* kmean; };
__device__ __forceinline__ SlotDesc slot_desc(unsigned char* ws, int layer, int sl, int pm) {
    const float* gt = (const float*)(ws + WS_SMALL + SM_GAINTAB) + layer * 5 * HD;
    bf16* QH = (bf16*)(ws + WS_QH); bf16* KH = (bf16*)(ws + WS_KH); bf16* VH = (bf16*)(ws + WS_VH);
    const int t0 = pm * 256, b = pm >> 5, s0 = (pm & 31) * 256;
    SlotDesc d; d.kmean = nullptr; d.scale = 1.f; d.gain = nullptr;
    if (layer == 0) {
        if (sl < 12) { d.dst = QH + (size_t)t0 * DM + sl * 128; d.dp = DM; d.gain = gt; d.scale = QSCALE; }
        else if (sl < 24) { const int h = sl - 12; d.dst = KH + ((size_t)(b * 12 + h) * SEQ + s0) * HD; d.dp = HD; d.gain = gt + 3 * HD;
            d.kmean = (float*)(ws + WS_SMALL + SM_KMEAN) + ((size_t)(b * 12 + h) * 32 + (pm & 31)) * HD; }
        else if (sl < 36) { const int h = sl - 24; d.dst = VH + ((size_t)(b * 12 + h) * SEQ + s0) * HD; d.dp = HD; }
        else { const int h = sl - 36; d.dst = QH + (size_t)t0 * DM + (12 + h) * 128; d.dp = DM; d.gain = gt + 2 * HD; d.scale = QSCALE; }
    } else {
        if (sl < 6) { d.dst = QH + (size_t)t0 * DM + sl * 128; d.dp = DM; d.gain = gt; d.scale = QSCALE; }
        else if (sl < 12) { d.dst = QH + (size_t)t0 * DM + sl * 128; d.dp = DM; d.gain = gt + HD; d.scale = QSCALE; }
        else if (sl < 16) { d.dst = QH + (size_t)t0 * DM + sl * 128; d.dp = DM; d.gain = gt + 2 * HD; d.scale = QSCALE; }
        else if (sl < 22) { const int h = sl - 16; d.dst = KH + ((size_t)(b * 12 + h) * SEQ + s0) * HD; d.dp = HD; d.gain = gt + 3 * HD; }
        else if (sl < 28) { const int h = sl - 22; d.dst = KH + ((size_t)(b * 12 + 6 + h) * SEQ + s0) * HD; d.dp = HD; d.gain = gt + 4 * HD; }
        else { const int vh = sl - 28, h = vh >> 1, cc = vh & 1; d.dst = VH + ((size_t)(b * 6 + h) * SEQ + s0) * DV + cc * 128; d.dp = DV; }
    }
    return d;
}
template <int PV>
struct EpiHeadNormT {
    static constexpr bool PERM = true, AFTER_DRAIN = false;
    unsigned char* ws; int layer; float cs;
    __device__ __forceinline__ void operator()(const f32x4 (&acc)[2][2][4][2], const pg8::Unit& u, int wr, int wc, int fr_in, int fq_in) const {
        int fr = fr_in, fq = fq_in; asm volatile("" : "+v"(fr), "+v"(fq));
        LAS float* P = (LAS float*)(uintptr_t)LDSX_OFF;
        LAS float* KS = (LAS float*)(uintptr_t)(LDSX_OFF + 8192);
        const float* rs = (const float*)(ws + WS_SMALL + SM_RSTD);
        const SlotDesc d0 = slot_desc(ws, layer, 2 * u.pn, u.pm), d1 = slot_desc(ws, layer, 2 * u.pn + 1, u.pm);
        const int rowl = wr * 64 + fr, coll = wc * 32 + 8 * fq;
        const float* rsr = rs + u.pm * 256 + rowl;
        float rt[2][4];
#pragma unroll
        for (int ai = 0; ai < 2; ++ai)
#pragma unroll
            for (int m = 0; m < 4; ++m) rt[ai][m] = rsr[ai * 128 + m * 16] * cs;
        f32x4 gg[2][2];
#pragma unroll
        for (int bj = 0; bj < 2; ++bj) { const SlotDesc& d = bj == 0 ? d0 : d1; gg[bj][0] = (f32x4){1.f, 1.f, 1.f, 1.f}; gg[bj][1] = gg[bj][0];
            if (d.gain) { gg[bj][0] = *(const f32x4*)(d.gain + coll) * d.scale; gg[bj][1] = *(const f32x4*)(d.gain + coll + 4) * d.scale; } }
#pragma unroll
        for (int ai = 0; ai < 2; ++ai)
#pragma unroll
            for (int m = 0; m < 4; ++m) { const int row = rowl + ai * 128 + m * 16; const float rtv = rt[ai][m];
#pragma unroll
                for (int bj = 0; bj < 2; ++bj) { if ((bj == 0 ? d0.gain : d1.gain) != nullptr) {
                    const f32x4 v0 = acc[ai][bj][m][0] * rtv, v1 = acc[ai][bj][m][1] * rtv;
                    float ss = (v0[0] * v0[0] + v0[1] * v0[1]) + (v0[2] * v0[2] + v0[3] * v0[3]) + (v1[0] * v1[0] + v1[1] * v1[1]) + (v1[2] * v1[2] + v1[3] * v1[3]);
                    ss += swz_xor<16>(ss); ss = add_xor32(ss);
                    if (fq == 0 && !(PV & 2)) P[(row * 2 + bj) * 4 + wc] = ss; } } }
        if (!(PV & 2)) { asm volatile("s_waitcnt lgkmcnt(0)" ::: "memory"); __builtin_amdgcn_s_barrier(); asm volatile("" ::: "memory"); }
#pragma unroll
        for (int bj = 0; bj < 2; ++bj) { const SlotDesc& d = bj == 0 ? d0 : d1;
            const f32x4 g0 = gg[bj][0], g1 = gg[bj][1];
            f32x4 c0 = (f32x4){0.f, 0.f, 0.f, 0.f}, c1 = c0;
#pragma unroll
            for (int ai = 0; ai < 2; ++ai)
#pragma unroll
                for (int m = 0; m < 4; ++m) { const int row = rowl + ai * 128 + m * 16; float f = rt[ai][m];
                    if (d.gain) { const f32x4 p4 = *(const LAS f32x4*)(P + (row * 2 + bj) * 4); f *= 1.0f / sqrtf(((p4[0] + p4[1]) + (p4[2] + p4[3])) * (1.f / HD) + RMS_EPS); }
                    const f32x4 v0 = acc[ai][bj][m][0] * f * g0, v1 = acc[ai][bj][m][1] * f * g1;
                    if (d.kmean) { c0 += v0; c1 += v1; }
                    v4u w; w.x = cvt_pk_bf16(v0[0], v0[1]); w.y = cvt_pk_bf16(v0[2], v0[3]); w.z = cvt_pk_bf16(v1[0], v1[1]); w.w = cvt_pk_bf16(v1[2], v1[3]);
                    if (!(PV & 1) || w.x == 0x12345u) *(v4u*)(d.dst + (size_t)row * d.dp + coll) = w; }
            if (d.kmean && !(PV & 4)) {
#pragma unroll
                for (int i = 0; i < 4; ++i) { float v = c0[i]; v += swz_xor<1>(v); v += swz_xor<2>(v); v += swz_xor<4>(v); v += swz_xor<8>(v); if (fr == 0) KS[wr * 256 + bj * 128 + coll + i] = v;
                                              float w_ = c1[i]; w_ += swz_xor<1>(w_); w_ += swz_xor<2>(w_); w_ += swz_xor<4>(w_); w_ += swz_xor<8>(w_); if (fr == 0) KS[wr * 256 + bj * 128 + coll + 4 + i] = w_; } } }
        if (d0.kmean && !(PV & 4)) {
            asm volatile("s_waitcnt lgkmcnt(0)" ::: "memory"); __builtin_amdgcn_s_barrier(); asm volatile("" ::: "memory");
            const int t = (wr * 4 + wc) * 64 + fq * 16 + fr;
            if (t < 256) { const float mean = (KS[t] + KS[256 + t]) * (1.f / 256.f); float* km = (t < 128) ? d0.kmean : d1.kmean; km[t & 127] = mean; }
        }
    }
};
using EpiHeadNorm = EpiHeadNormT<0>;
__device__ __forceinline__ void phase_gate(const Args& a, LAS unsigned char* lds, int G, int vb) {
    unsigned char* ws = opaque_ws(a.ws);
    const bf16* QH = (const bf16*)(ws + WS_QH); const float* KMEAN = (const float*)(ws + WS_SMALL + SM_KMEAN); unsigned* SEL = (unsigned*)(ws + WS_SMALL + SM_SEL);
    gu32* MC = (gu32*)(ws + WS_CTL) + CW_MC; unsigned* LISTF = (unsigned*)(ws + WS_LISTF); unsigned* LISTA = (unsigned*)(ws + WS_LISTA);
    const int tid_g = opaque_tid();
    LAS float* kml = (LAS float*)(lds + RING_OFF);
    for (int idx = vb * 512 + tid_g; idx < NB * MOBA_H * SEQ; idx += G * 512) {
        const int bh = idx / SEQ, s = idx % SEQ, b = bh / MOBA_H, h = bh % MOBA_H, own = s >> 8;
        __syncthreads();
        { const f32x4* src = (const f32x4*)(KMEAN + (size_t)bh * 32 * HD); ((LAS f32x4*)kml)[tid_g] = src[tid_g]; ((LAS f32x4*)kml)[512 + tid_g] = src[512 + tid_g]; }
        __syncthreads();
        unsigned mask = 0u;
        if (own <= 3) { mask = (1u << own) - 1u; }
        else {
            float acc[31];
#pragma unroll
            for (int j = 0; j < 31; ++j) acc[j] = 0.f;
            const bf16* q = QH + ((size_t)b * SEQ + s) * DM + h * HD;
            for (int c = 0; c < 16; ++c) {
                const v4u w = *(const v4u*)(q + 8 * c);
                const float f0 = bflo(w.x), f1 = bfhi(w.x), f2 = bflo(w.y), f3 = bfhi(w.y), f4 = bflo(w.z), f5 = bfhi(w.z), f6 = bflo(w.w), f7 = bfhi(w.w);
#pragma unroll
                for (int j = 0; j < 31; ++j) if (j < own) {
                    const f32x4 k0 = *(const LAS f32x4*)(kml + j * HD + 8 * c), k1 = *(const LAS f32x4*)(kml + j * HD + 8 * c + 4);
                    acc[j] += (f0 * k0[0] + f1 * k0[1]) + (f2 * k0[2] + f3 * k0[3]) + (f4 * k1[0] + f5 * k1[1]) + (f6 * k1[2] + f7 * k1[3]); }
            }
#pragma unroll
            for (int rnd = 0; rnd < 3; ++rnd) { float best = -__builtin_inff(); int bi = 0;
#pragma unroll
                for (int j = 0; j < 31; ++j) if (j < own && !((mask >> j) & 1u) && acc[j] > best) { best = acc[j]; bi = j; }
                mask |= 1u << bi; }
        }
        SEL[idx] = mask;
        { const int lane_ = tid_g & 63; const unsigned long long lt = (1ull << lane_) - 1ull;
          for (int j = 0; j < own; ++j) {
              const bool selj = (mask >> j) & 1u; const unsigned long long bal = __ballot(selj);
              if (bal == 0ull) continue;
              const int far = (j == own - 1) ? 0 : 1; const int lead = __builtin_ctzll(bal);
              unsigned base = 0u; if (lane_ == lead) base = __hip_atomic_fetch_add(MC + (bh * 32 + j) * 2 + far, (unsigned)__builtin_popcountll(bal), RLX_AGENT);
              base = __shfl(base, lead);
              if (selj) { const unsigned pos = base + (unsigned)__builtin_popcountll(bal & lt); const int slot = __builtin_popcount(mask & ((1u << j) - 1u));
                  const unsigned ent = (unsigned)s | ((unsigned)slot << 16);
                  if (far) LISTF[((size_t)bh * 32 + j) * 8192 + pos] = ent; else LISTA[((size_t)bh * 32 + j) * 256 + pos] = ent; } } }
    }
}

namespace att {
constexpr int SHM_T = 16384;
#define KLB(r32, hi) ((r32) * 256 + (((hi) * 16) ^ (((r32) & 15) << 4)))
#define SBAR() __builtin_amdgcn_sched_barrier(0)
__device__ __forceinline__ int v_rd_base(int lane) { return ((lane & 3) << 3) | (((lane >> 2) & 3) << 6) | (((lane >> 4) & 1) << 5) | (((lane >> 5) & 1) << 8); }
__device__ __forceinline__ int crow(int r, int hi) { return (r & 3) + 8 * (r >> 2) + 4 * hi; }
__device__ __forceinline__ unsigned cvtpk(float lo, float hi) { unsigned r; asm volatile("v_cvt_pk_bf16_f32 %0, %1, %2" : "=v"(r) : "v"(lo), "v"(hi)); return r; }
__device__ __forceinline__ int swap23(int k) { return (k & ~0xC) | ((k & 4) << 1) | ((k & 8) >> 1); }
__device__ __forceinline__ void glds16(const void* sbase  , unsigned voff, unsigned lds_dst) { unsigned keep;
    asm volatile("s_mov_b32 %0, m0\n\ts_mov_b32 m0, %3\n\ts_nop 0\n\tglobal_load_lds_dwordx4 %1, %2\n\ts_mov_b32 m0, %0" : "=&s"(keep) : "v"(voff), "s"(sbase), "s"(lds_dst) : "memory"); }
#define WAIT_BAR0() asm volatile("s_waitcnt vmcnt(0) lgkmcnt(0)\n\ts_barrier" ::: "memory")
constexpr float THR2 = 11.5f;

__device__ __forceinline__ void qkt(f32x16& p0, f32x16& p1, const LAS char* Kt, int r32, int hi, const bf16x8* qr) {
#pragma unroll
    for (int r = 0; r < 16; ++r) { p0[r] = 0.f; p1[r] = 0.f; }
    const int lb = KLB(r32, hi);
#pragma unroll
    for (int d0 = 0; d0 < 8; ++d0) { const LAS char* a = Kt + (lb ^ (d0 * 32));
        const bf16x8 b0 = *(const LAS bf16x8*)a;
        const bf16x8 b1 = *(const LAS bf16x8*)(a + 32 * 256);
        p0 = __builtin_amdgcn_mfma_f32_32x32x16_bf16(b0, qr[d0], p0, 0, 0, 0);
        p1 = __builtin_amdgcn_mfma_f32_32x32x16_bf16(b1, qr[d0], p1, 0, 0, 0); }
}
__device__ __forceinline__ void pv_tile(f32x16* o, int vb, bf16x8 pa0, bf16x8 pa1, bf16x8 pa2, bf16x8 pa3) {
#define TRRD(dst, off) asm volatile("ds_read_b64_tr_b16 %0, %1 offset:%2" : "=&v"(dst) : "v"(vb), "i"(off) : "memory")
#define PV_RD(S_, d0) do { constexpr int b_ = (d0) * 512; TRRD(S_##l0, b_); TRRD(S_##h0, b_ + 2048); TRRD(S_##l1, b_ + 4096); TRRD(S_##h1, b_ + 6144); \
        TRRD(S_##l2, b_ + 8192); TRRD(S_##h2, b_ + 10240); TRRD(S_##l3, b_ + 12288); TRRD(S_##h3, b_ + 14336); } while (0)
#define PV_MM(S_, d0) do { \
        o[d0] = __builtin_amdgcn_mfma_f32_32x32x16_bf16(pa0, (bf16x8){S_##l0[0], S_##l0[1], S_##l0[2], S_##l0[3], S_##h0[0], S_##h0[1], S_##h0[2], S_##h0[3]}, o[d0], 0, 0, 0); \
        o[d0] = __builtin_amdgcn_mfma_f32_32x32x16_bf16(pa1, (bf16x8){S_##l1[0], S_##l1[1], S_##l1[2], S_##l1[3], S_##h1[0], S_##h1[1], S_##h1[2], S_##h1[3]}, o[d0], 0, 0, 0); \
        o[d0] = __builtin_amdgcn_mfma_f32_32x32x16_bf16(pa2, (bf16x8){S_##l2[0], S_##l2[1], S_##l2[2], S_##l2[3], S_##h2[0], S_##h2[1], S_##h2[2], S_##h2[3]}, o[d0], 0, 0, 0); \
        o[d0] = __builtin_amdgcn_mfma_f32_32x32x16_bf16(pa3, (bf16x8){S_##l3[0], S_##l3[1], S_##l3[2], S_##l3[3], S_##h3[0], S_##h3[1], S_##h3[2], S_##h3[3]}, o[d0], 0, 0, 0); } while (0)
#define WL(n) asm volatile("s_waitcnt lgkmcnt(" #n ")" ::: "memory")
    s16x4 Al0, Al1, Al2, Al3, Ah0, Ah1, Ah2, Ah3, Bl0, Bl1, Bl2, Bl3, Bh0, Bh1, Bh2, Bh3;
    PV_RD(A, 0); SBAR();
    PV_RD(B, 1); WL(8); SBAR(); PV_MM(A, 0); SBAR();
    PV_RD(A, 2); WL(8); SBAR(); PV_MM(B, 1); SBAR();
    PV_RD(B, 3); WL(8); SBAR(); PV_MM(A, 2); SBAR();
    WL(0); SBAR(); PV_MM(B, 3);
#undef PV_RD
#undef PV_MM
#undef TRRD
}
__device__ __forceinline__ void softmax_tile(f32x16& p0, f32x16& p1, float& m_reg, float& l_reg, float& alpha, bf16x8& pa0, bf16x8& pa1, bf16x8& pa2, bf16x8& pa3) {
    float pmax = p0[0];
#pragma unroll
    for (int r = 1; r < 16; ++r) pmax = fmaxf(pmax, p0[r]);
#pragma unroll
    for (int r = 0; r < 16; ++r) pmax = fmaxf(pmax, p1[r]);
    { auto rr = __builtin_amdgcn_permlane32_swap(__float_as_uint(pmax), __float_as_uint(pmax), false, false);
      pmax = fmaxf(__uint_as_float(rr[0]), __uint_as_float(rr[1])); }
    const float mn = (pmax - m_reg <= THR2) ? m_reg : fmaxf(m_reg, pmax);
    alpha = __builtin_amdgcn_exp2f(m_reg - mn); m_reg = mn;
#pragma unroll
    for (int r = 0; r < 16; ++r) { p0[r] = __builtin_amdgcn_exp2f(p0[r] - mn); p1[r] = __builtin_amdgcn_exp2f(p1[r] - mn); }
    float ps = 0.f;
#pragma unroll
    for (int r = 0; r < 16; ++r) ps += p0[r] + p1[r];
    { auto rr = __builtin_amdgcn_permlane32_swap(__float_as_uint(ps), __float_as_uint(ps), false, false);
      ps = __uint_as_float(rr[0]) + __uint_as_float(rr[1]); }
    l_reg = l_reg * alpha + ps;
#define PK4(P, B_, OUT) do { unsigned a0 = cvtpk(P[B_+0], P[B_+1]), a1 = cvtpk(P[B_+2], P[B_+3]); \
        unsigned b0 = cvtpk(P[B_+4], P[B_+5]), b1 = cvtpk(P[B_+6], P[B_+7]); \
        auto r0 = __builtin_amdgcn_permlane32_swap(a0, b0, false, false); auto r1 = __builtin_amdgcn_permlane32_swap(a1, b1, false, false); \
        v4u w = {r0[0], r1[0], r0[1], r1[1]}; OUT = __builtin_bit_cast(bf16x8, w); } while (0)
    PK4(p0, 0, pa0); PK4(p0, 8, pa1); PK4(p1, 0, pa2); PK4(p1, 8, pa3);
#undef PK4
}
__device__ __forceinline__ void bias_mask_tile(f32x16& p0, f32x16& p1, int dq, bool on, bool far, const LAS float* lut) {
    const float NEG = -__builtin_inff();
    if (far) {
        const float c = on ? lut[128] : NEG;
#pragma unroll
        for (int r = 0; r < 16; ++r) { p0[r] += c; p1[r] += c; }
    } else {
#pragma unroll
        for (int r = 0; r < 16; ++r) { const int c = (r & 3) + 8 * (r >> 2); const int d0 = dq - c, d1 = dq - c - 32;
            const float b0 = lut[min(max(d0, 0), 128)], b1 = lut[min(max(d1, 0), 128)];
            p0[r] = (on && d0 >= 0) ? p0[r] + b0 : NEG; p1[r] = (on && d1 >= 0) ? p1[r] + b1 : NEG; }
    }
}

__device__ __forceinline__ void qkt_half(f32x16& p, const LAS char* Kt  , int r32, int hi, const bf16x8* qr) {
#pragma unroll
    for (int r = 0; r < 16; ++r) p[r] = 0.f;
    const int lb = KLB(r32, hi);
#pragma unroll
    for (int d0 = 0; d0 < 8; ++d0) { const LAS char* a = Kt + (lb ^ (d0 * 32));
        const bf16x8 b0 = *(const LAS bf16x8*)a;
        p = __builtin_amdgcn_mfma_f32_32x32x16_bf16(b0, qr[d0], p, 0, 0, 0); }
}
template <int HALF>
__device__ __forceinline__ void pv_half8(f32x16* o, int vb, bf16x8 pa0, bf16x8 pa1) {
#define TRRD(dst, off) asm volatile("ds_read_b64_tr_b16 %0, %1 offset:%2" : "=&v"(dst) : "v"(vb), "i"(off) : "memory")
#define PV_RD(S_, d0) do { constexpr int b_ = ((d0) & 3) * 512 + ((d0) >> 2) * SHM_T + HALF * 8192; TRRD(S_##l0, b_); TRRD(S_##h0, b_ + 2048); TRRD(S_##l1, b_ + 4096); TRRD(S_##h1, b_ + 6144); } while (0)
#define PV_MM(S_, d0) do { \
        o[d0] = __builtin_amdgcn_mfma_f32_32x32x16_bf16(pa0, (bf16x8){S_##l0[0], S_##l0[1], S_##l0[2], S_##l0[3], S_##h0[0], S_##h0[1], S_##h0[2], S_##h0[3]}, o[d0], 0, 0, 0); \
        o[d0] = __builtin_amdgcn_mfma_f32_32x32x16_bf16(pa1, (bf16x8){S_##l1[0], S_##l1[1], S_##l1[2], S_##l1[3], S_##h1[0], S_##h1[1], S_##h1[2], S_##h1[3]}, o[d0], 0, 0, 0); } while (0)
#define WL(n) asm volatile("s_waitcnt lgkmcnt(" #n ")" ::: "memory")
    s16x4 Al0, Al1, Ah0, Ah1, Bl0, Bl1, Bh0, Bh1;
    PV_RD(A, 0); SBAR();
    PV_RD(B, 1); WL(4); SBAR(); PV_MM(A, 0); SBAR();
    PV_RD(A, 2); WL(4); SBAR(); PV_MM(B, 1); SBAR();
    PV_RD(B, 3); WL(4); SBAR(); PV_MM(A, 2); SBAR();
    PV_RD(A, 4); WL(4); SBAR(); PV_MM(B, 3); SBAR();
    PV_RD(B, 5); WL(4); SBAR(); PV_MM(A, 4); SBAR();
    PV_RD(A, 6); WL(4); SBAR(); PV_MM(B, 5); SBAR();
    PV_RD(B, 7); WL(4); SBAR(); PV_MM(A, 6); SBAR();
    WL(0); SBAR(); PV_MM(B, 7);
#undef PV_RD
#undef PV_MM
#undef WL
#undef TRRD
}
__device__ __forceinline__ void softmax_half(f32x16& p0, float& m_reg, float& l_reg, float& alpha, bf16x8& pa0, bf16x8& pa1) {
    float pmax = p0[0];
#pragma unroll
    for (int r = 1; r < 16; ++r) pmax = fmaxf(pmax, p0[r]);
    { auto rr = __builtin_amdgcn_permlane32_swap(__float_as_uint(pmax), __float_as_uint(pmax), false, false);
      pmax = fmaxf(__uint_as_float(rr[0]), __uint_as_float(rr[1])); }
    const float mn = (pmax - m_reg <= THR2) ? m_reg : fmaxf(m_reg, pmax);
    alpha = __builtin_amdgcn_exp2f(m_reg - mn); m_reg = mn;
#pragma unroll
    for (int r = 0; r < 16; ++r) p0[r] = __builtin_amdgcn_exp2f(p0[r] - mn);
    float ps = 0.f;
#pragma unroll
    for (int r = 0; r < 16; ++r) ps += p0[r];
    { auto rr = __builtin_amdgcn_permlane32_swap(__float_as_uint(ps), __float_as_uint(ps), false, false);
      ps = __uint_as_float(rr[0]) + __uint_as_float(rr[1]); }
    l_reg = l_reg * alpha + ps;
#define PK4(P, B_, OUT) do { unsigned a0 = cvtpk(P[B_+0], P[B_+1]), a1 = cvtpk(P[B_+2], P[B_+3]); \
        unsigned b0 = cvtpk(P[B_+4], P[B_+5]), b1 = cvtpk(P[B_+6], P[B_+7]); \
        auto r0 = __builtin_amdgcn_permlane32_swap(a0, b0, false, false); auto r1 = __builtin_amdgcn_permlane32_swap(a1, b1, false, false); \
        v4u w = {r0[0], r1[0], r0[1], r1[1]}; OUT = __builtin_bit_cast(bf16x8, w); } while (0)
    PK4(p0, 0, pa0); PK4(p0, 8, pa1);
#undef PK4
}
__device__ __forceinline__ void bias_mask_half(f32x16& p0, int dq, bool far, const LAS float* lut) {
    const float NEG = -__builtin_inff();
    if (far) { const float c = lut[128];
#pragma unroll
        for (int r = 0; r < 16; ++r) p0[r] += c;
    } else {
#pragma unroll
        for (int r = 0; r < 16; ++r) { const int c = (r & 3) + 8 * (r >> 2); const int d0 = dq - c;
            const float b0 = lut[min(max(d0, 0), 128)]; p0[r] = (d0 >= 0) ? p0[r] + b0 : NEG; }
    }
}
#define RESC(o_, nd_, al_l_, alpha_) do { if (__any((alpha_) < 1.f)) { if (hi == 0) (al_l_)[r32] = (alpha_); asm volatile("s_waitcnt lgkmcnt(0)" ::: "memory"); \
        _Pragma("unroll") for (int r = 0; r < 16; ++r) { const float f_ = (al_l_)[crow(r, hi)]; _Pragma("unroll") for (int d_ = 0; d_ < (nd_); ++d_) (o_)[d_][r] *= f_; } } } while (0)

template <int MODE, bool F8OUT = false>
__device__ __forceinline__ void attn128_unit(LAS unsigned char* lds, const bf16* Qrow0, const bf16* Kh, const bf16* Vh, bf16* Orow0, int NT, int qb, const unsigned* selrow, const float* relb, int h) {
    const int tid = opaque_tid(), wid = __builtin_amdgcn_readfirstlane(tid >> 6), lane = tid & 63, r32 = lane & 31, hi = lane >> 5;
    LAS float* wsf = (LAS float*)(lds + LDSX_OFF) + wid * 64; LAS float* li_l = wsf; LAS float* al_l = wsf + 32;
    LAS float* lut = (LAS float*)(lds + LDSX_OFF + 2048);
    if (MODE == 0 && tid <= 128) lut[tid] = relb[(tid < 128 ? (int)T5_BUCKET[tid] : 31) * 12 + h] * LOG2E;
    bf16x8 qr[8];
#pragma unroll
    for (int d0 = 0; d0 < 8; ++d0) qr[d0] = *(const bf16x8*)(Qrow0 + (size_t)(wid * 32 + r32) * DM + d0 * 16 + hi * 8);
    unsigned sel = 0u; if (MODE == 0) sel = selrow[wid * 32 + r32];
    const int krow = 4 * wid + (lane >> 4); const unsigned ksrc = (unsigned) krow * 256 + ((16 * (lane & 15)) ^ ((krow & 15) << 4));
    const int vkk = 8 * (wid >> 1) + ((lane & 31) >> 2); const unsigned vsrc = (unsigned) swap23(vkk) * 256 + (32 * (2 * (wid & 1) + (lane >> 5)) + 8 * (lane & 3)) * 2;
    const unsigned lds0 = (unsigned)(uintptr_t)(lds + RING_OFF);
    const char* Kg = (const char*)Kh; const char* Vg = (const char*)Vh;
#define ISSUE(t, s) do { const unsigned base_ = (unsigned)__builtin_amdgcn_readfirstlane(lds0 + (s) * 32768 + wid * 1024); const size_t tb_ = (size_t)(t) * SHM_T; \
        glds16(Kg + tb_, ksrc, base_); glds16(Kg + tb_ + 8192, ksrc, base_ + 8192); glds16(Vg + tb_, vsrc, base_ + SHM_T); glds16(Vg + tb_ + 8192, vsrc, base_ + SHM_T + 8192); } while (0)
    const int vb0 = (int)lds0 + SHM_T + v_rd_base(lane);
    float m_reg = -1e30f, l_reg = 0.f; f32x16 o[4];
#pragma unroll
    for (int d = 0; d < 4; ++d)
#pragma unroll
        for (int r = 0; r < 16; ++r) o[d][r] = 0.f;
    const int q0w = qb * 256 + wid * 32, qpos = q0w + r32;
    ISSUE(0, 0);
    for (int t = 0; t < NT; ++t) {
        WAIT_BAR0();
        if (t + 1 < NT) ISSUE(t + 1, (t + 1) & 1);
        const int s = t & 1;
        f32x16 p0, p1;
        qkt(p0, p1, (const LAS char*)(lds + RING_OFF + s * 32768), r32, hi, qr);
        if (MODE == 0) { const int jb = t >> 2, tk0 = t * 64; const bool on = (jb >= qb) || ((sel >> jb) & 1u); const bool far = (q0w - (tk0 + 63)) >= 128;
            bias_mask_tile(p0, p1, qpos - tk0 - 4 * hi, on, far, lut); }
        float alpha; bf16x8 pa0, pa1, pa2, pa3;
        softmax_tile(p0, p1, m_reg, l_reg, alpha, pa0, pa1, pa2, pa3);
        RESC(o, 4, al_l, alpha);
        pv_tile(o, vb0 + s * 32768, pa0, pa1, pa2, pa3);
    }
#undef ISSUE
    if (hi == 0) li_l[r32] = l_reg; asm volatile("s_waitcnt lgkmcnt(0)" ::: "memory");
    int r32o = r32, hio = hi; asm volatile("" : "+v"(r32o), "+v"(hio));
    bf16* Ow = Orow0 + (size_t)(wid * 32) * DM + r32o;
#pragma unroll
    for (int r = 0; r < 16; ++r) { const int orow = crow(r, hio); const float rli = __builtin_amdgcn_rcpf(li_l[orow]);
#pragma unroll
        for (int d0 = 0; d0 < 4; ++d0) { const float v = o[d0][r] * rli; const float vn = swz_xor<1>(v);
            if (F8OUT) { if ((r32 & 1) == 0) *(unsigned short*)((unsigned char*)Orow0 + (size_t)(wid * 32 + orow) * DM + d0 * 32 + r32o) = (unsigned short)__builtin_amdgcn_cvt_pk_fp8_f32(v * SC_O, vn * SC_O, 0u, false); }
            else if ((r32 & 1) == 0) *(unsigned*)(Ow + (size_t)orow * DM + d0 * 32) = cvtpk(v, vn); } }
    WAIT_BAR0();
}

#define PK4X(P, B_, OUT) do { unsigned a0 = cvtpk(P[B_+0], P[B_+1]), a1 = cvtpk(P[B_+2], P[B_+3]); unsigned b0 = cvtpk(P[B_+4], P[B_+5]), b1 = cvtpk(P[B_+6], P[B_+7]); \
        auto r0 = __builtin_amdgcn_permlane32_swap(a0, b0, false, false); auto r1 = __builtin_amdgcn_permlane32_swap(a1, b1, false, false); v4u w = {r0[0], r1[0], r0[1], r1[1]}; OUT = __builtin_bit_cast(bf16x8, w); } while (0)
template <int VAR>
__device__ __forceinline__ void diff_unit(LAS unsigned char* lds, const bf16* Qrow0  , const bf16* K1h, const bf16* K2h, const bf16* Vh, bf16* Orow0  ,
                                          int qblk, const float* relb, int h, float lam, const float* subln) {
    const int tid = opaque_tid(), wid = __builtin_amdgcn_readfirstlane(tid >> 6), lane = tid & 63, r32 = lane & 31, hi = lane >> 5, mp = wid >> 2, w4 = wid & 3;
    LAS float* wsf = (LAS float*)(lds + LDSX_OFF) + wid * 64; LAS float* li_l = wsf; LAS float* al_l = wsf + 32;
    LAS float* lut2 = (LAS float*)(lds + LDSX_OFF + 2048);
    if (tid < 2 * 132) { const int m_ = tid / 132, i_ = tid % 132; if (i_ <= 128) lut2[tid] = relb[(i_ < 128 ? (int)T5_BUCKET[i_] : 31) * 12 + 2 * h + m_] * LOG2E; }
    const LAS float* lut = lut2 + mp * 132;
    bf16x8 qr[8];
#pragma unroll
    for (int d0 = 0; d0 < 8; ++d0) qr[d0] = *(const bf16x8*)(Qrow0 + (size_t)(w4 * 32 + r32) * DM + (h + 6 * mp) * HD + d0 * 16 + hi * 8);
    const int krow = 4 * wid + (lane >> 4); const unsigned ksrc = (unsigned) krow * 256 + ((16 * (lane & 15)) ^ ((krow & 15) << 4));
    const int vkk = 8 * (wid >> 1) + ((lane & 31) >> 2); const unsigned vsrc = (unsigned) swap23(vkk) * 512 + (32 * (2 * (wid & 1) + (lane >> 5)) + 8 * (lane & 3)) * 2;
    const unsigned lds0 = (unsigned)(uintptr_t)(lds + RING_OFF);
    const char* K1g = (const char*)K1h; const char* K2g = (const char*)K2h; const char* Vg = (const char*)Vh;
#define ISSUE(t, s) do { const unsigned base_ = (unsigned)__builtin_amdgcn_readfirstlane(lds0 + (s) * 65536 + wid * 1024); const size_t tb_ = (size_t)(t) * SHM_T; \
        glds16(K1g + tb_, ksrc, base_); glds16(K1g + tb_ + 8192, ksrc, base_ + 8192); glds16(K2g + tb_, ksrc, base_ + SHM_T); glds16(K2g + tb_ + 8192, ksrc, base_ + SHM_T + 8192); \
        glds16(Vg + 2 * tb_, vsrc, base_ + 2 * SHM_T); glds16(Vg + 2 * tb_ + 16384, vsrc, base_ + 2 * SHM_T + 8192); \
        glds16(Vg + 2 * tb_ + 256, vsrc, base_ + 3 * SHM_T); glds16(Vg + 2 * tb_ + 256 + 16384, vsrc, base_ + 3 * SHM_T + 8192); } while (0)
#define ISSUE_K(t, s) do { const unsigned base_ = (unsigned)__builtin_amdgcn_readfirstlane(lds0 + (s) * 65536 + wid * 1024); const size_t tb_ = (size_t)(t) * SHM_T; \
        glds16(K1g + tb_, ksrc, base_); glds16(K1g + tb_ + 8192, ksrc, base_ + 8192); glds16(K2g + tb_, ksrc, base_ + SHM_T); glds16(K2g + tb_ + 8192, ksrc, base_ + SHM_T + 8192); } while (0)
#define ISSUE_V(t, s) do { const unsigned base_ = (unsigned)__builtin_amdgcn_readfirstlane(lds0 + (s) * 65536 + wid * 1024); const size_t tb_ = (size_t)(t) * SHM_T; \
        glds16(Vg + 2 * tb_, vsrc, base_ + 2 * SHM_T); glds16(Vg + 2 * tb_ + 16384, vsrc, base_ + 2 * SHM_T + 8192); \
        glds16(Vg + 2 * tb_ + 256, vsrc, base_ + 3 * SHM_T); glds16(Vg + 2 * tb_ + 256 + 16384, vsrc, base_ + 3 * SHM_T + 8192); } while (0)
    const int vb0 = (int)lds0 + 2 * SHM_T + v_rd_base(lane);
    float m_reg = -1e30f, l_reg = 0.f; f32x16 o[8];
#pragma unroll
    for (int d = 0; d < 8; ++d)
#pragma unroll
        for (int r = 0; r < 16; ++r) o[d][r] = 0.f;
    const int q0w = qblk * 128 + w4 * 32, qpos = q0w + r32, NT = 2 * (qblk + 1);
    if (!(VAR & 1)) ISSUE(0, 0);
    for (int t = 0; t < NT; ++t) {
        WAIT_BAR0();
        if (!(VAR & 1)) if (t + 1 < NT) ISSUE(t + 1, (t + 1) & 1);
        const int s = t & 1, tk0 = t * 64;
        if (VAR & 2) continue;
        const bool far = (q0w - (tk0 + 63)) >= 128;
        { f32x16 p; float alpha; bf16x8 pa0, pa1;
          qkt_half(p, (const LAS char*)(lds + RING_OFF + s * 65536 + mp * SHM_T), r32, hi, qr);
          bias_mask_half(p, qpos - tk0 - 4 * hi, far, lut);
          if (VAR & 4) { alpha = 1.f; l_reg += p[0]; PK4X(p, 0, pa0); PK4X(p, 8, pa1); } else { softmax_half(p, m_reg, l_reg, alpha, pa0, pa1);
          RESC(o, 8, al_l, alpha); }
          pv_half8<0>(o, vb0 + s * 65536, pa0, pa1); }
        SBAR();
        { f32x16 p; float alpha; bf16x8 pa0, pa1;
          qkt_half(p, (const LAS char*)(lds + RING_OFF + s * 65536 + mp * SHM_T + 32 * 256), r32, hi, qr);
          bias_mask_half(p, qpos - tk0 - 32 - 4 * hi, far, lut);
          if (VAR & 4) { alpha = 1.f; l_reg += p[0]; PK4X(p, 0, pa0); PK4X(p, 8, pa1); } else { softmax_half(p, m_reg, l_reg, alpha, pa0, pa1);
          RESC(o, 8, al_l, alpha); }
          pv_half8<1>(o, vb0 + s * 65536, pa0, pa1); }
        SBAR();
    }
#undef ISSUE
#undef ISSUE_K
#undef ISSUE_V
    if (hi == 0) li_l[r32] = l_reg;
    WAIT_BAR0();
    int laneo = lane; asm volatile("" : "+v"(laneo));
    LAS float* X = (LAS float*)(lds + RING_OFF) + (w4 * 8 * 16 * 64 + laneo);
    if (mp == 1) {
#pragma unroll
        for (int r = 0; r < 16; ++r) { const float f = lam * __builtin_amdgcn_rcpf(li_l[crow(r, hi)]);
#pragma unroll
            for (int d0 = 0; d0 < 8; ++d0) X[(d0 * 16 + r) * 64] = o[d0][r] * f; }
    }
    WAIT_BAR0();
    if (mp == 0) {
        int r32o = r32, hio = hi; asm volatile("" : "+v"(r32o), "+v"(hio));
        unsigned char* Ow = (unsigned char*)Orow0 + (size_t)(w4 * 32) * DM + r32o; const float* sg = subln + r32o;
#pragma unroll
        for (int r = 0; r < 16; ++r) { const float rli = __builtin_amdgcn_rcpf(li_l[crow(r, hi)]); float ss = 0.f;
#pragma unroll
            for (int d0 = 0; d0 < 8; ++d0) { const float v = o[d0][r] * rli - X[(d0 * 16 + r) * 64]; o[d0][r] = v; ss += v * v; }
            ss += swz_xor<1>(ss); ss += swz_xor<2>(ss); ss += swz_xor<4>(ss); ss += swz_xor<8>(ss); ss += swz_xor<16>(ss);
            const float rs = (1.0f / sqrtf(ss * (1.f / DV) + RMS_EPS)) * (1.f - LAM_INIT); const int orow = crow(r, hio);
#pragma unroll
            for (int d0 = 0; d0 < 8; ++d0) { const float v = o[d0][r] * rs * sg[d0 * 32]; const float vn = swz_xor<1>(v);
                if ((r32 & 1) == 0) *(unsigned short*)(Ow + (size_t)orow * DM + d0 * 32) = (unsigned short)__builtin_amdgcn_cvt_pk_fp8_f32(v * SC_O, vn * SC_O, 0u, false); } }
    }
    WAIT_BAR0();
}

__device__ __forceinline__ void moba_sparse_unit(LAS unsigned char* lds, const bf16* QHb, const bf16* Kblk, const bf16* Vblk, const unsigned* listF, int cntF, const unsigned* listA, int cntA, int j,
                                                 bf16* PO, float* PM, const float* relb, int h) {
    const int tid = opaque_tid(), wid = __builtin_amdgcn_readfirstlane(tid >> 6), lane = tid & 63, r32 = lane & 31, hi = lane >> 5;
    LAS float* wsf = (LAS float*)(lds + LDSX_OFF) + wid * 64; LAS float* li_l = wsf; LAS float* al_l = wsf + 32;
    LAS float* lut = (LAS float*)(lds + LDSX_OFF + 2048);
    if (tid <= 128) lut[tid] = relb[(tid < 128 ? (int)T5_BUCKET[tid] : 31) * 12 + h] * LOG2E;
    const int krow = 4 * wid + (lane >> 4); const unsigned ksrc = (unsigned) krow * 256 + ((16 * (lane & 15)) ^ ((krow & 15) << 4));
    const int vkk = 8 * (wid >> 1) + ((lane & 31) >> 2); const unsigned vsrc = (unsigned) swap23(vkk) * 256 + (32 * (2 * (wid & 1) + (lane >> 5)) + 8 * (lane & 3)) * 2;
    const unsigned lds0 = (unsigned)(uintptr_t)(lds + RING_OFF);
    const char* Kg = (const char*)Kblk; const char* Vg = (const char*)Vblk;
    { const unsigned base_ = (unsigned)__builtin_amdgcn_readfirstlane(lds0 + wid * 1024);
#pragma unroll
      for (int t = 0; t < 4; ++t) { glds16(Kg + t * SHM_T, ksrc, base_ + t * SHM_T); glds16(Kg + t * SHM_T + 8192, ksrc, base_ + t * SHM_T + 8192);
                                    glds16(Vg + t * SHM_T, vsrc, base_ + 65536 + t * SHM_T); glds16(Vg + t * SHM_T + 8192, vsrc, base_ + 65536 + t * SHM_T + 8192); } }
    const int vb0 = (int)lds0 + 65536 + v_rd_base(lane);
    const int gF = (cntF + 31) >> 5, ng = gF + ((cntA + 31) >> 5);
    const float c31 = relb[31 * 12 + h] * LOG2E;
#define GRP_ENT(g_, ent_, val_) do { const bool fr_ = (g_) < gF; const int b0_ = fr_ ? (g_) * 32 : ((g_) - gF) * 32; const int n_ = fr_ ? cntF : cntA; const unsigned* l_ = fr_ ? listF : listA; \
        val_ = (b0_ + r32) < n_; ent_ = l_[val_ ? b0_ + r32 : b0_]; } while (0)
#define LOADQ(dst_, ent_) do { const bf16* qp_ = QHb + (size_t)((ent_) & 0xffffu) * DM + hi * 8; _Pragma("unroll") for (int d0 = 0; d0 < 8; ++d0) dst_[d0] = *(const bf16x8*)(qp_ + d0 * 16); } while (0)
    int g = wid; unsigned ent = 0u, entn = 0u; bool valid = false, validn = false; bf16x8 qr[8], qn[8];
    if (g < ng) { GRP_ENT(g, ent, valid); LOADQ(qr, ent); }
    if (g + 8 < ng) GRP_ENT(g + 8, entn, validn);
    WAIT_BAR0();
    for (; g < ng; g += 8) {
        const bool adj = g >= gF;
        unsigned entnn = 0u; bool validnn = false;
        if (g + 8 < ng) LOADQ(qn, entn);
        if (g + 16 < ng) GRP_ENT(g + 16, entnn, validnn);
        const int srow = (int)(ent & 0xffffu), slot = (int)(ent >> 16);
        float m_reg = -1e30f, l_reg = 0.f; f32x16 o[4];
#pragma unroll
        for (int d = 0; d < 4; ++d)
#pragma unroll
            for (int r = 0; r < 16; ++r) o[d][r] = 0.f;
#pragma unroll 1
        for (int t = 0; t < 4; ++t) {
            f32x16 p0, p1;
            qkt(p0, p1, (const LAS char*)(lds + RING_OFF + t * SHM_T), r32, hi, qr);
            if (adj) bias_mask_tile(p0, p1, srow - (j * 256 + t * 64) - 4 * hi, true, false, lut);
            float alpha; bf16x8 pa0, pa1, pa2, pa3;
            softmax_tile(p0, p1, m_reg, l_reg, alpha, pa0, pa1, pa2, pa3);
            RESC(o, 4, al_l, alpha);
            pv_tile(o, vb0 + t * SHM_T, pa0, pa1, pa2, pa3);
        }
        LAS int* rd = (LAS int*)al_l;
        const int rec = srow * 3 + slot;
        if (hi == 0) { li_l[r32] = l_reg; rd[r32] = valid ? rec : -1;
            if (valid) { PM[(size_t)rec * 2] = m_reg + (adj ? 0.f : c31); PM[(size_t)rec * 2 + 1] = l_reg; } }
        asm volatile("s_waitcnt lgkmcnt(0)" ::: "memory");
        int r32o = r32, hio = hi; asm volatile("" : "+v"(r32o), "+v"(hio));
#pragma unroll
        for (int r = 0; r < 16; ++r) { const int orow = crow(r, hio); const float rli = __builtin_amdgcn_rcpf(li_l[orow]); const int dst = rd[orow];
#pragma unroll
            for (int d0 = 0; d0 < 4; ++d0) { const float v = o[d0][r] * rli; const float vn = swz_xor<1>(v);
                if ((r32 & 1) == 0 && dst >= 0) *(unsigned*)(PO + (size_t)dst * HD + d0 * 32 + r32o) = cvtpk(v, vn); } }
        asm volatile("s_waitcnt lgkmcnt(0)" ::: "memory");
#pragma unroll
        for (int d0 = 0; d0 < 8; ++d0) qr[d0] = qn[d0];
        ent = entn; valid = validn; entn = entnn; validn = validnn;
    }
#undef GRP_ENT
#undef LOADQ
    WAIT_BAR0();
}

__device__ __forceinline__ void moba_final_unit(LAS unsigned char* lds, const bf16* Qrow0, const bf16* Kh, const bf16* Vh, bf16* Orow0, int qb, const unsigned* selrow, const float* relb, int h, const bf16* PO, const float* PM) {
    const int tid = opaque_tid(), wid = __builtin_amdgcn_readfirstlane(tid >> 6), lane = tid & 63, r32 = lane & 31, hi = lane >> 5;
    LAS float* wsf = (LAS float*)(lds + LDSX_OFF) + wid * 64; LAS float* al_l = wsf + 32;
    LAS float* lut = (LAS float*)(lds + LDSX_OFF + 2048);
    LAS float* ftab = (LAS float*)(lds + LDSX_OFF + 4352) + wid * 128;
    if (tid <= 128) lut[tid] = relb[(tid < 128 ? (int)T5_BUCKET[tid] : 31) * 12 + h] * LOG2E;
    bf16x8 qr[8];
#pragma unroll
    for (int d0 = 0; d0 < 8; ++d0) qr[d0] = *(const bf16x8*)(Qrow0 + (size_t)(wid * 32 + r32) * DM + d0 * 16 + hi * 8);
    const unsigned sel = selrow[wid * 32 + r32];
    const int krow = 4 * wid + (lane >> 4); const unsigned ksrc = (unsigned) krow * 256 + ((16 * (lane & 15)) ^ ((krow & 15) << 4));
    const int vkk = 8 * (wid >> 1) + ((lane & 31) >> 2); const unsigned vsrc = (unsigned) swap23(vkk) * 256 + (32 * (2 * (wid & 1) + (lane >> 5)) + 8 * (lane & 3)) * 2;
    const unsigned lds0 = (unsigned)(uintptr_t)(lds + RING_OFF);
    const char* Kg = (const char*)(Kh + (size_t)qb * 256 * HD); const char* Vg = (const char*)(Vh + (size_t)qb * 256 * HD);
    { const unsigned base_ = (unsigned)__builtin_amdgcn_readfirstlane(lds0 + wid * 1024);
#pragma unroll
      for (int t = 0; t < 4; ++t) { glds16(Kg + t * SHM_T, ksrc, base_ + t * SHM_T); glds16(Kg + t * SHM_T + 8192, ksrc, base_ + t * SHM_T + 8192);
                                    glds16(Vg + t * SHM_T, vsrc, base_ + 65536 + t * SHM_T); glds16(Vg + t * SHM_T + 8192, vsrc, base_ + 65536 + t * SHM_T + 8192); } }
    const int vb0 = (int)lds0 + 65536 + v_rd_base(lane);
    float m_reg = -1e30f, l_reg = 0.f; f32x16 o[4];
#pragma unroll
    for (int d = 0; d < 4; ++d)
#pragma unroll
        for (int r = 0; r < 16; ++r) o[d][r] = 0.f;
    const int qrel = wid * 32 + r32;
    WAIT_BAR0();
#pragma unroll 1
    for (int t = 0; t <= (wid >> 1); ++t) {
        f32x16 p0, p1;
        qkt(p0, p1, (const LAS char*)(lds + RING_OFF + t * SHM_T), r32, hi, qr);
        bias_mask_tile(p0, p1, qrel - t * 64 - 4 * hi, true, false, lut);
        float alpha; bf16x8 pa0, pa1, pa2, pa3;
        softmax_tile(p0, p1, m_reg, l_reg, alpha, pa0, pa1, pa2, pa3);
        RESC(o, 4, al_l, alpha);
        pv_tile(o, vb0 + t * SHM_T, pa0, pa1, pa2, pa3);
    }
    const int nsel = __builtin_popcount(sel); const size_t rec0 = (size_t)(qb * 256 + qrel) * 3;
    float mi[3], li[3]; float M = m_reg;
#pragma unroll
    for (int i = 0; i < 3; ++i) { mi[i] = -1e30f; li[i] = 0.f; if (i < nsel) { mi[i] = PM[(rec0 + i) * 2]; li[i] = PM[(rec0 + i) * 2 + 1]; } M = fmaxf(M, mi[i]); }
    const float wo = __builtin_amdgcn_exp2f(m_reg - M); float L = l_reg * wo; float wi[3];
#pragma unroll
    for (int i = 0; i < 3; ++i) { wi[i] = (i < nsel) ? li[i] * __builtin_amdgcn_exp2f(mi[i] - M) : 0.f; L += wi[i]; }
    const float rL = 1.f / L;
    if (hi == 0) { ftab[r32] = wo * rL; ftab[32 + r32] = wi[0] * rL; ftab[64 + r32] = wi[1] * rL; ftab[96 + r32] = wi[2] * rL; }
    WAIT_BAR0();
    int r32o = r32, hio = hi, laneo = lane; asm volatile("" : "+v"(r32o), "+v"(hio), "+v"(laneo));
    LAS float* X = (LAS float*)(lds + RING_OFF) + wid * 4096;
#pragma unroll
    for (int r = 0; r < 16; ++r) { const int orow = crow(r, hio); const float fo = ftab[orow];
#pragma unroll
        for (int d0 = 0; d0 < 4; ++d0) X[orow * 128 + d0 * 32 + r32o] = o[d0][r] * fo; }
    asm volatile("s_waitcnt lgkmcnt(0)" ::: "memory");
    { const int rg = laneo >> 4, c = laneo & 15;
      unsigned char* Ow = (unsigned char*)Orow0 + (size_t)(wid * 32) * DM + 8 * c;
      const bf16* Pw = PO + ((size_t)(qb * 256 + wid * 32) * 3) * HD + 8 * c;
#pragma unroll
      for (int hb = 0; hb < 2; ++hb) {
          v4u pw[4][3];
#pragma unroll
          for (int k = 0; k < 4; ++k) { const int row = (hb * 4 + k) * 4 + rg;
#pragma unroll
              for (int i = 0; i < 3; ++i) { const float f = ftab[32 * (i + 1) + row]; pw[k][i] = (v4u){0u, 0u, 0u, 0u}; if (f != 0.f) pw[k][i] = *(const v4u*)(Pw + ((size_t)row * 3 + i) * HD); } }
#pragma unroll
          for (int k = 0; k < 4; ++k) { const int row = (hb * 4 + k) * 4 + rg;
              const f32x4 x0 = *(const LAS f32x4*)(X + row * 128 + 8 * c), x1 = *(const LAS f32x4*)(X + row * 128 + 8 * c + 4);
              float v[8] = {x0[0], x0[1], x0[2], x0[3], x1[0], x1[1], x1[2], x1[3]};
#pragma unroll
              for (int i = 0; i < 3; ++i) { const float f = ftab[32 * (i + 1) + row]; const v4u w = pw[k][i];
                  v[0] += f * bflo(w.x); v[1] += f * bfhi(w.x); v[2] += f * bflo(w.y); v[3] += f * bfhi(w.y); v[4] += f * bflo(w.z); v[5] += f * bfhi(w.z); v[6] += f * bflo(w.w); v[7] += f * bfhi(w.w); }
              unsigned w0 = 0u, w1 = 0u;
              w0 = __builtin_amdgcn_cvt_pk_fp8_f32(v[0] * SC_O, v[1] * SC_O, w0, false); w0 = __builtin_amdgcn_cvt_pk_fp8_f32(v[2] * SC_O, v[3] * SC_O, w0, true);
              w1 = __builtin_amdgcn_cvt_pk_fp8_f32(v[4] * SC_O, v[5] * SC_O, w1, false); w1 = __builtin_amdgcn_cvt_pk_fp8_f32(v[6] * SC_O, v[7] * SC_O, w1, true);
              *(v2u*)(Ow + (size_t)row * DM) = (v2u){w0, w1}; } } }
    WAIT_BAR0();
}
#undef RESC
}

__device__ __forceinline__ int queue_next(gu32* ctr, LAS unsigned char* lds) {
    volatile LAS int* slot = (volatile LAS int*)(lds + LDSX_OFF + 4096);
    if (threadIdx.x == 0) slot[0] = (int)__hip_atomic_fetch_add(ctr, 1u, RLX_AGENT);
    __syncthreads();
    return __builtin_amdgcn_readfirstlane(slot[0]);
}

template <int PV>
__device__ __forceinline__ void phase_moba_sparse(const Args& a, LAS unsigned char* lds, gu32* qctr) {
    unsigned char* ws = opaque_ws(a.ws);
    const bf16* QH = (const bf16*)(ws + WS_QH); const bf16* KH = (const bf16*)(ws + WS_KH); const bf16* VH = (const bf16*)(ws + WS_VH);
    const unsigned* MC = (const unsigned*)(ws + WS_CTL) + CW_MC;
    for (;;) {
        const int uq = queue_next(qctr, lds);
        if (uq >= 744 + CONV_SP) break;
        const Mix mx = mix_decode(uq, 744, CONV_SP);
        if (mx.conv) { if (!(PV & 1)) conv_chunk(a, lds, 0, CONV_IN + mx.idx); else __syncthreads(); continue; }
        const int u = mx.idx;
        if (PV & 2) { __syncthreads(); continue; }
        const int j = u / 24, bh = u % 24, b = bh / 12, h = bh % 12;
        const int cntA = (int)MC[(bh * 32 + j) * 2], cntF = (int)MC[(bh * 32 + j) * 2 + 1];
        const bf16* QHb = QH + (size_t)b * SEQ * DM + h * HD; const bf16* Kblk = KH + ((size_t)bh * SEQ + j * 256) * HD; const bf16* Vblk = VH + ((size_t)bh * SEQ + j * 256) * HD;
        bf16* PO = (bf16*)(ws + WS_PO) + (size_t)bh * SEQ * 3 * HD; float* PM = (float*)(ws + WS_PM) + (size_t)bh * SEQ * 3 * 2;
        att::moba_sparse_unit(lds, QHb, Kblk, Vblk, (const unsigned*)(ws + WS_LISTF) + ((size_t)bh * 32 + j) * 8192, cntF, (const unsigned*)(ws + WS_LISTA) + ((size_t)bh * 32 + j) * 256, cntA, j, PO, PM, a.in[I_RELB], h);
    }
}
__device__ __forceinline__ void phase_attn_a(const Args& a, LAS unsigned char* lds, gu32* qctr) {
    unsigned char* ws = opaque_ws(a.ws);
    const bf16* QH = (const bf16*)(ws + WS_QH); const bf16* KH = (const bf16*)(ws + WS_KH); const bf16* VH = (const bf16*)(ws + WS_VH); bf16* OC = (bf16*)(ws + WS_OCAT);
    const unsigned* SEL = (const unsigned*)(ws + WS_SMALL + SM_SEL);
    for (;;) {
        const int uq = queue_next(qctr, lds);
        if (uq >= 768 + 256 + (CONV_NCH - CONV_IN - CONV_SP)) break;
        const Mix mx = mix_decode(uq, 768 + 256, CONV_NCH - CONV_IN - CONV_SP);
        if (mx.conv) { conv_chunk(a, lds, 0, CONV_IN + CONV_SP + mx.idx); continue; }
        const int u = mx.idx;
        if (u < 768) { const int qb = 31 - u / 24, bh = u % 24, b = bh / 12, h = bh % 12; const size_t row0 = (size_t)b * SEQ + qb * 256;
            att::moba_final_unit(lds, QH + row0 * DM + h * HD, KH + (size_t)bh * SEQ * HD, VH + (size_t)bh * SEQ * HD, (bf16*)((unsigned char*)OC + row0 * DM + h * HD), qb,
                                 SEL + (size_t)bh * SEQ + qb * 256, a.in[I_RELB], h, (const bf16*)(ws + WS_PO) + (size_t)bh * SEQ * 3 * HD, (const float*)(ws + WS_PM) + (size_t)bh * SEQ * 3 * 2);
        } else { const int v = u - 768, b = v >> 7, hm = (v >> 5) & 3, qb = v & 31; const size_t row0 = (size_t)b * SEQ + qb * 256;
            const size_t mo = (size_t)((0 * 2 + b) * 4 + hm) * NMEM * HD;
            att::attn128_unit<1, true>(lds, QH + row0 * DM + (12 + hm) * HD, (const bf16*)(ws + WS_SMALL + SM_KM) + mo, (const bf16*)(ws + WS_SMALL + SM_VM) + mo, (bf16*)((unsigned char*)OC + row0 * DM + MIXW + hm * HD), 4, 0, nullptr, nullptr, 0);
        }
    }
}
template <int VAR>
__device__ __forceinline__ void phase_attn_b(const Args& a, LAS unsigned char* lds, gu32* qctr, bf16* OC) {
    unsigned char* ws = opaque_ws(a.ws);
    const bf16* QH = (const bf16*)(ws + WS_QH); const bf16* KH = (const bf16*)(ws + WS_KH); const bf16* VH = (const bf16*)(ws + WS_VH);
    float lam;
    { const float* lb = a.in[I_LAMBDA]; const int lane = opaque_tid() & 63;
      float s1 = lb[lane] * lb[128 + lane] + lb[64 + lane] * lb[128 + 64 + lane], s2 = lb[256 + lane] * lb[384 + lane] + lb[256 + 64 + lane] * lb[384 + 64 + lane];
      s1 = wave_sum(s1); s2 = wave_sum(s2); lam = expf(s1) - expf(s2) + LAM_INIT; }
    for (;;) {
        const int uq = queue_next(qctr, lds);
        if (uq >= 768 + 256 + CONV_NCH) break;
        const Mix mx = mix_decode(uq, 768 + 256, CONV_NCH);
        if (mx.conv) { if (!(VAR & 8)) conv_chunk(a, lds, 1, mx.idx); else __syncthreads(); continue; }
        const int u = mx.idx;
        if (u < 768) { const int qblk = 63 - u / 12, bh = u % 12, b = bh / 6, h = bh % 6; const size_t row0 = (size_t)b * SEQ + qblk * 128;
            att::diff_unit<VAR>(lds, QH + row0 * DM, KH + (size_t)(b * 12 + h) * SEQ * HD, KH + (size_t)(b * 12 + 6 + h) * SEQ * HD, VH + (size_t)(b * 6 + h) * SEQ * DV, (bf16*)((unsigned char*)OC + row0 * DM + h * DV),
                           qblk, a.in[I_RELB], h, lam, a.in[I_SUBLN]);
        } else { const int v = u - 768, b = v >> 7, hm = (v >> 5) & 3, qb = v & 31; const size_t row0 = (size_t)b * SEQ + qb * 256;
            const size_t mo = (size_t)((1 * 2 + b) * 4 + hm) * NMEM * HD;
            att::attn128_unit<1, true>(lds, QH + row0 * DM + (12 + hm) * HD, (const bf16*)(ws + WS_SMALL + SM_KM) + mo, (const bf16*)(ws + WS_SMALL + SM_VM) + mo, (bf16*)((unsigned char*)OC + row0 * DM + MIXW + hm * HD), 4, 0, nullptr, nullptr, 0);
        }
    }
}

template <int RV>
__device__ __forceinline__ void phase_router(const Args& a, LAS unsigned char* lds, int G, int vb, int layer) {
    unsigned char* ws = opaque_ws(a.ws);
    const int tid = opaque_tid(), lane = tid & 63, wave = __builtin_amdgcn_readfirstlane(tid >> 6), i16 = lane & 15, g4 = lane >> 4, tg = wave & 1, kq = wave >> 1;
    const bf16* H = (const bf16*)(ws + WS_HB);
    const bf16* WRh = (const bf16*)(ws + WS_W_RT) + (size_t)layer * 2 * NRTP * DM;
    LAS float* L = (LAS float*)(lds + RING_OFF);
    LAS int* cnt = (LAS int*)(lds + RING_OFF + 4 * 64 * NRTP * 4);
    for (int blk = vb; blk < T / 64; blk += G) {
        if (tid < 64) cnt[tid] = 0;
        f32x4 acc[2][5];
#pragma unroll
        for (int t2 = 0; t2 < 2; ++t2)
#pragma unroll
            for (int j = 0; j < 5; ++j) acc[t2][j] = (f32x4){0.f, 0.f, 0.f, 0.f};
        const bf16* hrow = H + (size_t)(blk * 64 + tg * 32 + i16) * DM + kq * 512 + 8 * g4;
        const bf16* wh = WRh + (size_t)i16 * DM + kq * 512 + 8 * g4;
#pragma unroll 4
        for (int ks = 0; ks < ((RV & 1) ? 0 : 16); ++ks) {
            bf16x8 fa[2];
#pragma unroll
            for (int t2 = 0; t2 < 2; ++t2) fa[t2] = *(const bf16x8*)(hrow + (size_t)t2 * 16 * DM + ks * 32);
#pragma unroll
            for (int jt = 0; jt < 5; ++jt) {
                const bf16x8 bh = *(const bf16x8*)(wh + (size_t)jt * 16 * DM + ks * 32);
#pragma unroll
                for (int t2 = 0; t2 < 2; ++t2) acc[t2][jt] = __builtin_amdgcn_mfma_f32_16x16x32_bf16(fa[t2], bh, acc[t2][jt], 0, 0, 0);
            }
        }
#pragma unroll
        for (int t2 = 0; t2 < 2; ++t2)
#pragma unroll
            for (int jt = 0; jt < 5; ++jt)
#pragma unroll
                for (int r = 0; r < 4; ++r) L[(kq * 64 + tg * 32 + t2 * 16 + 4 * g4 + r) * NRTP + jt * 16 + i16] = acc[t2][jt][r];
        __syncthreads();
        if (tid < 64 && !(RV & 2)) {
            const int tok = blk * 64 + tid;
            const float* part = (const float*)(ws + WS_SMALL + SM_PART) + (size_t)tok * 32;
            float ss = 0.f;
#pragma unroll
            for (int i = 0; i < 32; ++i) ss += part[i];
            const float rstd = 1.0f / sqrtf(ss * (1.f / DM) + RMS_EPS);
            const LAS float* l0 = L + tid * NRTP;
            const float* brg = a.in[I_B_RG] + layer * 8; const float* bre = a.in[I_B_RE] + layer * 64;
            float gmax = -__builtin_inff(); int gi = 0; float gl[8];
#pragma unroll
            for (int j = 0; j < 8; ++j) { gl[j] = ((l0[j] + l0[64 * NRTP + j]) + (l0[128 * NRTP + j] + l0[192 * NRTP + j])) * rstd + brg[j]; if (gl[j] > gmax) { gmax = gl[j]; gi = j; } }
            float gs = 0.f;
#pragma unroll
            for (int j = 0; j < 8; ++j) gs += expf(gl[j] - gmax);
            const float pg = 1.f / gs;
            float v0 = -__builtin_inff(), v1 = -__builtin_inff(); int i0 = 0, i1 = 0;
#pragma unroll
            for (int j = 0; j < 8; ++j) { const int ix = 8 + gi * 8 + j; const float e = ((l0[ix] + l0[64 * NRTP + ix]) + (l0[128 * NRTP + ix] + l0[192 * NRTP + ix])) * rstd + bre[gi * 8 + j];
                if (e > v0) { v1 = v0; i1 = i0; v0 = e; i0 = j; } else if (e > v1) { v1 = e; i1 = j; } }
            const float dd = expf(v1 - v0), w0 = pg / (1.f + dd), w1 = pg * dd / (1.f + dd);
            const int e0 = gi * 8 + i0, e1 = gi * 8 + i1;
            v4u tr; tr.x = (unsigned)e0; tr.y = (unsigned)e1; tr.z = __float_as_uint(w0); tr.w = __float_as_uint(w1);
            *(v4u*)(ws + WS_SMALL + SM_TOKR + (size_t)tok * 16) = tr;
            ((float*)(ws + WS_SMALL + SM_RSTD))[tok] = rstd;
            __hip_atomic_fetch_add(cnt + e0, 1, __ATOMIC_RELAXED, __HIP_MEMORY_SCOPE_WORKGROUP);
            __hip_atomic_fetch_add(cnt + e1, 1, __ATOMIC_RELAXED, __HIP_MEMORY_SCOPE_WORKGROUP);
        }
        __syncthreads();
        if (tid < 64 && !(RV & 2)) ((int*)(ws + WS_SMALL + SM_CNT))[blk * 64 + tid] = cnt[tid];
        __syncthreads();
    }
}

__device__ __forceinline__ void phase_gather(const Args& a, LAS unsigned char* lds, int G, int vb) {
    unsigned char* ws = opaque_ws(a.ws);
    const int tid = opaque_tid(), lane = tid & 63, wave = __builtin_amdgcn_readfirstlane(tid >> 6);
    const int* CNT = (const int*)(ws + WS_SMALL + SM_CNT); int* BLKE = (int*)(ws + WS_SMALL + SM_BLKE); int* DEST = (int*)(ws + WS_SMALL + SM_DEST);
    const unsigned* TOKR = (const unsigned*)(ws + WS_SMALL + SM_TOKR);
    int* ROWTOK = (int*)(ws + WS_SMALL + SM_ROWTOK);
    LAS int* tot = (LAS int*)(lds + RING_OFF); LAS int* pre = tot + 64; LAS int* pst = tot + 128; LAS int* destl = tot + 192;
    LAS int* part8 = tot + 320;
    LAS int* tokl = tot + 320 + 1024;
    for (int blk = vb; blk < T / 64; blk += G) {
        { const int e = tid & 63, p8 = tid >> 6; int t_ = 0, p_ = 0;
#pragma unroll 8
          for (int b2 = p8 * 32; b2 < p8 * 32 + 32; ++b2) { const int c = CNT[b2 * 64 + e]; t_ += c; p_ += (b2 < blk) ? c : 0; }
          part8[(p8 * 64 + e) * 2] = t_; part8[(p8 * 64 + e) * 2 + 1] = p_;
          if (tid < 128) tokl[tid] = (int)TOKR[(size_t)(blk * 64 + (tid >> 1)) * 4 + (tid & 1)]; }
        __syncthreads();
        if (tid < 64) { int t_ = 0, p_ = 0;
#pragma unroll
            for (int p8 = 0; p8 < 8; ++p8) { t_ += part8[(p8 * 64 + tid) * 2]; p_ += part8[(p8 * 64 + tid) * 2 + 1]; }
            tot[tid] = t_; pre[tid] = p_;
            const int padded = ((t_ + 255) >> 8) << 8; int incl = padded;
#pragma unroll
            for (int o = 1; o < 64; o <<= 1) { const int up = __shfl_up(incl, o); if (tid >= o) incl += up; }
            pst[tid] = incl - padded;
            if (blk == 0 && tid == 63) BLKE[MAXRB] = incl >> 8; }
        __syncthreads();
        if (tid < 64) {
            if (blk == 0) { const int rb0 = pst[tid] >> 8, rb1 = (pst[tid] + (((tot[tid] + 255) >> 8) << 8)) >> 8; for (int rb = rb0; rb < rb1; ++rb) BLKE[rb] = tid; }
            int r = pst[tid] + pre[tid];
            for (int as = 0; as < 128; ++as) { if (tokl[as] == tid) destl[as] = r++; }
        }
        __syncthreads();
        if (tid < 128) { const int tok = blk * 64 + (tid >> 1), dest = destl[tid]; DEST[tok * 2 + (tid & 1)] = dest; ROWTOK[dest] = tok; }
        if (blk < 64) {
            const int r0 = pst[blk] + tot[blk], r1 = pst[blk] + (((tot[blk] + 255) >> 8) << 8);
            for (int r = r0 + tid; r < r1; r += 512) ROWTOK[r] = 0;
        }
        __syncthreads();
    }
}

__device__ __forceinline__ void phase_combine(const Args& a, int G, int vb, float* Fout  ) {
    unsigned char* ws = opaque_ws(a.ws);
    const int tid = opaque_tid(), lane = tid & 63, wave = __builtin_amdgcn_readfirstlane(tid >> 6);
    const int gw = vb * 8 + wave, NGW = G * 8;
    const bf16* YS = (const bf16*)(ws + WS_YS); const int* DEST = (const int*)(ws + WS_SMALL + SM_DEST); float* RSTD = (float*)(ws + WS_SMALL + SM_RSTD); bf16* HB = (bf16*)(ws + WS_HB);
    for (int tok = gw; tok < T; tok += NGW) {
        const v4u tr = *(const v4u*)(ws + WS_SMALL + SM_TOKR + (size_t)tok * 16); const float w0 = __uint_as_float(tr.z), w1 = __uint_as_float(tr.w);
        const int d0 = DEST[tok * 2], d1 = DEST[tok * 2 + 1];
        GAS v2u* hr = (GAS v2u*)(HB + (size_t)tok * DM) + lane;
        const GAS v2u* y0 = (const GAS v2u*)(YS + (size_t)d0 * DM) + lane; const GAS v2u* y1 = (const GAS v2u*)(YS + (size_t)d1 * DM) + lane;
        v2u hv[8], a0[8], a1[8];
#pragma unroll
        for (int j = 0; j < 8; ++j) { hv[j] = hr[64 * j]; a0[j] = y0[64 * j]; a1[j] = y1[64 * j]; }
        float ss = 0.f;
#pragma unroll
        for (int j = 0; j < 8; ++j) { f32x4 v;
            v.x = bflo(hv[j].x) + (w0 * bflo(a0[j].x) + w1 * bflo(a1[j].x)); v.y = bfhi(hv[j].x) + (w0 * bfhi(a0[j].x) + w1 * bfhi(a1[j].x));
            v.z = bflo(hv[j].y) + (w0 * bflo(a0[j].y) + w1 * bflo(a1[j].y)); v.w = bfhi(hv[j].y) + (w0 * bfhi(a0[j].y) + w1 * bfhi(a1[j].y));
            ss += (v.x * v.x + v.y * v.y) + (v.z * v.z + v.w * v.w);
            if (Fout) ((GAS f32x4*)(Fout + (size_t)tok * DM) + lane)[64 * j] = v;
            else { v2u o; o.x = pk2(v.x, v.y); o.y = pk2(v.z, v.w); hr[64 * j] = o;
                   unsigned w8 = 0u; w8 = __builtin_amdgcn_cvt_pk_fp8_f32(v.x, v.y, w8, false); w8 = __builtin_amdgcn_cvt_pk_fp8_f32(v.z, v.w, w8, true); ((GAS unsigned*)(ws + WS_HB8 + (size_t)tok * DM) + lane)[64 * j] = w8; } }
        if (!Fout) { const float rstd = 1.0f / sqrtf(wave_sum(ss) * (1.f / DM) + RMS_EPS); if (lane == 0) RSTD[tok] = rstd; }
    }
}

struct ZeroOrder { int n, G, c;
    __device__ __forceinline__ bool next(int i, pg8::Unit& u) const { if (i * G + c >= n) return false; u.pm = 0; u.pn = 0; return true; }
    __device__ __forceinline__ void a_ready(const pg8::Unit&) const {}
    __device__ __forceinline__ void done(const pg8::Unit&) const {} };
struct EpiNull { static constexpr bool PERM = false, AFTER_DRAIN = false;
    __device__ __forceinline__ void operator()(const f32x4 (&acc)[2][2][4][2], const pg8::Unit& u, int wr, int wc, int fr, int fq) const {} };
#ifndef MK_VAR
#define MK_VAR 0
#endif
namespace pg8 { template <> struct ProbeOf<EpiNull> { static constexpr int v = MK_VAR; }; }
#ifndef MK_DUP
#define MK_DUP -1
#endif
#define DUP(k) (MK_DUP == (k))
#ifndef MK_VAR
#define MK_VAR 0
#endif
#ifndef FP8IN_SP2
#define FP8IN_SP2 true
#endif
constexpr int NPH = 21;
__global__ void __launch_bounds__(512, 2) yoco_fwd(Args args) {
    extern __shared__ __attribute__((aligned(16))) unsigned char lds_raw[];
    LAS unsigned char* lds = (LAS unsigned char*)lds_raw;
    const int tid = opaque_tid();
    const int G = gridDim.x; const int bx0 = blockIdx.x; const int vb = (G % 8 == 0) ? (bx0 % 8) * (G / 8) + bx0 / 8 : bx0;
    unsigned char* ws = args.ws;
    gu32* ctl = (gu32*)(ws + WS_CTL);
    for (int u = tid; u < (LDS_BYTES - LDSCTL_OFF) / 4; u += 512) ((LAS unsigned*)(lds + LDSCTL_OFF))[u] = 0u;
    __syncthreads();
    volatile LAS unsigned* MISC = (volatile LAS unsigned*)(lds + MISC_OFF);
#if MK_N_LAUNCHES == 1
    constexpr int lo = 0, hi = NPH; constexpr bool one = true;
#else
    const int lo = args.ph_lo, hi = args.ph_hi;
    const bool one = (hi - lo) > 1;
#endif
    XcdBarrier bar; bar.bar = (unsigned*)(ctl + CW_BAR); bar.x = 0; bar.st = nullptr;
    if (one) bar = xcd_barrier_post((unsigned*)(ctl + CW_BAR), MISC + 8);
#define GBAR() do { XcdBarrier b2_ = bar; b2_.bar = (unsigned*)opaque_ws((unsigned char*)bar.bar); { unsigned x_ = bar.x; asm volatile("" : "+s"(x_)); b2_.x = x_; } xcd_barrier(b2_); } while (0)
#define IN(k) (lo <= (k) && (k) < hi)
#define SEAM(k) do { if (IN(k) && IN((k) + 1)) GBAR(); } while (0)

#define RUN(k, ...) do { if (IN(k)) { __VA_ARGS__ if (DUP(k)) { __syncthreads(); __VA_ARGS__ } } } while (0)
    RUN(0, phase_prep(args, lds, G, vb););
    SEAM(0);
    for (int l = 0; l < 2; ++l) {
        const int pb = 1 + 10 * l;
        int bx = bx0; asm volatile("" : "+s"(bx));
        RUN(pb + 0,
            { pg8::Gemm g{(const bf16*)(ws + WS_HB8), (const bf16*)(ws + (l == 0 ? WS_W_INA : WS_W_INB)), T, PROJW, DM / 2}; pg8::StaticOrder S; S.init(T, PROJW, G, bx);
              EpiHeadNorm E{ws, l, 1.f / SC_W1};
              const int nun = (T / 256) * (PROJW / 256), upc = (nun + G - 1) / G, ksp = (l == 0) ? bx % (upc + 1) : upc;
              { pg8::RangeOrder R{S, 0, ksp}; pg8::gemm_phase<EpiHeadNorm, pg8::RangeOrder, true, FP8IN_SP2, false, true>(lds + RING_OFF, g, R, E); }
              if (l == 0) { __syncthreads(); for (int ch = bx; ch < CONV_IN; ch += G) conv_chunk(args, lds, 0, ch);
                pg8::RangeOrder R{S, ksp, upc}; pg8::gemm_phase<EpiHeadNorm, pg8::RangeOrder, true, FP8IN_SP2, false, true>(lds + RING_OFF, g, R, E); } }
            );
        if (one) GBAR();
        if (l == 0) { if (IN(pb + 2)) {
                if (bx < 16) { pg8::Gemm g{(const bf16*)(ws + WS_SMALL + SM_MEMN), (const bf16*)(ws + WS_W_MKV), NB * NMEM, 2048, DM}; pg8::StaticOrder S; S.init(NB * NMEM, 2048, G, bx);
                    EpiRowScale E{(bf16*)(ws + WS_SMALL + SM_KVM), 2048, nullptr, 0, 1.f};
                    pg8::gemm_phase<EpiRowScale, pg8::StaticOrder, true, true>(lds + RING_OFF, g, S, E); }
                else phase_gate(args, lds, G - 16, bx - 16); }
            if (one) GBAR(); }
        if (IN(pb + 3)) { if (l == 0) { phase_post_mem(args, lds, G, vb); phase_moba_sparse<0>(args, lds, ctl + CW_Q + 256); if (DUP(40)) { __syncthreads(); phase_moba_sparse<MK_VAR>(args, lds, ctl + CW_Q + 320); } if (one) GBAR(); phase_attn_a(args, lds, ctl + CW_Q); if (DUP(41)) { __syncthreads(); phase_attn_a(args, lds, ctl + CW_Q + 128); } }
            else { phase_attn_b<0>(args, lds, ctl + CW_Q + 64, (bf16*)(ws + WS_OCAT)); if (DUP(14)) { __syncthreads(); phase_attn_b<MK_VAR>(args, lds, ctl + CW_Q + 192, (bf16*)(ws + WS_YS)); } } }
        SEAM(pb + 3);
        RUN(pb + 4,
            {
#ifdef MK_STAG
              if (bx0 & 1) { for (int i_ = 0; i_ < MK_STAG; ++i_) __builtin_amdgcn_s_sleep(127); }
#endif
              pg8::Gemm g8{(const bf16*)(ws + WS_OCAT), (const bf16*)(ws + WS_W_OUT + (size_t)l * DM * DM), T, DM, DM / 2}; pg8::StaticOrder S; S.init(T, DM, G, bx);
              if (l == 0) { EpiOutProj<true> E{args.in[I_X], (float*)(ws + WS_SMALL + SM_PART), (bf16*)(ws + WS_HB), ws + WS_HB8, 1.f / (SC_O * SC_W1)}; pg8::gemm_phase<EpiOutProj<true>, pg8::StaticOrder, true, true, false, true>(lds + RING_OFF, g8, S, E); }
              else { EpiOutProj<false> E{nullptr, (float*)(ws + WS_SMALL + SM_PART), (bf16*)(ws + WS_HB), ws + WS_HB8, 1.f / (SC_O * SC_W1)}; pg8::gemm_phase<EpiOutProj<false>, pg8::StaticOrder, true, true, false, true>(lds + RING_OFF, g8, S, E); } });
#if MK_DUP == 54
        if (l == 0) { __syncthreads();
            pg8::Gemm g9{(const bf16*)(ws + WS_OCAT), (const bf16*)(ws + WS_W_INA), T, PROJW, DM / 2}; ZeroOrder S9{1280, G, bx};
            EpiNull E9; pg8::gemm_phase<EpiNull, ZeroOrder, false, true, false, true>(lds + RING_OFF, g9, S9, E9); }
#endif
#if MK_DUP == 53
        if (l == 0) { __syncthreads();
            pg8::Gemm g9{(const bf16*)(ws + WS_OCAT), (const bf16*)(ws + WS_W_OUT), T, DM, DM / 2}; pg8::StaticOrder S9; S9.init(T, DM, G, bx);
            EpiOutProj<true, MK_VAR> E9{args.in[I_X], (float*)(ws + WS_YS + (size_t)(96 << 20)), (bf16*)(ws + WS_YS), ws + WS_YS + (size_t)(64 << 20), 1.f / (SC_O * SC_W1)};
            pg8::gemm_phase<EpiOutProj<true, MK_VAR>, pg8::StaticOrder, true, true, false, true>(lds + RING_OFF, g9, S9, E9); }
#endif
#if MK_DUP == 52
        if (l == 0) { __syncthreads();
            pg8::Gemm g9{(const bf16*)(ws + WS_OCAT), (const bf16*)(ws + WS_W_INA), T, PROJW, DM / 2}; pg8::StaticOrder S9; S9.init(T, PROJW, G, bx);
            EpiHeadNormT<MK_VAR> E9{ws, 0, 1.f / SC_W1}; pg8::gemm_phase<EpiHeadNormT<MK_VAR>, pg8::StaticOrder, true, true, false, true>(lds + RING_OFF, g9, S9, E9); }
#endif
#if MK_DUP == 50 || MK_DUP == 51
        if (l == 0) { __syncthreads(); constexpr int NN9 = (MK_DUP == 50) ? DM : PROJW;
            pg8::Gemm g9{(const bf16*)(ws + WS_OCAT), (const bf16*)(ws + (MK_DUP == 50 ? WS_W_OUT : WS_W_INA)), T, NN9, DM / 2}; pg8::StaticOrder S9; S9.init(T, NN9, G, bx);
            EpiNull E9; pg8::gemm_phase<EpiNull, pg8::StaticOrder, false, true, false, true>(lds + RING_OFF, g9, S9, E9); }
#endif
        SEAM(pb + 4);
        if (IN(pb + 5)) { phase_router<0>(args, lds, G, vb, l); if (DUP(pb + 5)) { __syncthreads(); phase_router<MK_VAR>(args, lds, G, vb, l); } }
        SEAM(pb + 5);
        RUN(pb + 6, phase_gather(args, lds, G, vb););
        SEAM(pb + 6);
        RUN(pb + 7,
            { const int* blke = (const int*)(ws + WS_SMALL + SM_BLKE);
              const int* rowtok = (const int*)(ws + WS_SMALL + SM_ROWTOK);
              pg8::Gemm g{(const bf16*)(ws + WS_HB8), (const bf16*)(ws + WS_W_E1 + (size_t)l * NEXP * 1024 * DM), MAXRB * 256, 1024, DM / 2, rowtok};
              MoeOrder S{blke, blke[MAXRB] * 4, 4, G, bx}; EpiSiluMul E{(bf16*)(ws + WS_HID), (const float*)(ws + WS_SMALL + SM_RSTD), rowtok};
              pg8::gemm_phase<EpiSiluMul, MoeOrder, true, true, true, true>(lds + RING_OFF, g, S, E); });
        SEAM(pb + 7);
        RUN(pb + 8,
            { const int* blke = (const int*)(ws + WS_SMALL + SM_BLKE);
              pg8::Gemm g{(const bf16*)(ws + WS_HID), (const bf16*)(ws + WS_W_E2 + (size_t)l * NEXP * DM * EFF), MAXRB * 256, DM, EFF / 2};
              MoeOrder S{blke, blke[MAXRB] * 8, 8, G, bx}; EpiRowScale E{(bf16*)(ws + WS_YS), DM, nullptr, 8, 1.f / (SC_HID * SC_W2)};
              pg8::gemm_phase<EpiRowScale, MoeOrder, true, true, false, true>(lds + RING_OFF, g, S, E); });
        SEAM(pb + 8);
        if (IN(pb + 9)) phase_combine(args, G, vb, l == 0 ? nullptr : args.out);
        if (l == 0) SEAM(pb + 9);
    }
#undef RUN
#undef IN
#undef SEAM
}

extern "C" void kernel_launch(void* const* d_in, const int* in_sizes, int n_in, void* d_out, int out_size, void* d_ws, size_t ws_size, hipStream_t stream) {
    static int grid = 0;
    if (grid == 0) {
        if (n_in != N_IN || out_size != T * DM || ws_size < WS_END) { fprintf(stderr, "kernel_launch: unexpected shapes (n_in %d out %d ws %zu)\n", n_in, out_size, ws_size); grid = -1; return; }
        int dev = 0, cus = 0;
        if (hipGetDevice(&dev) != hipSuccess || hipDeviceGetAttribute(&cus, hipDeviceAttributeMultiprocessorCount, dev) != hipSuccess) { grid = -1; return; }
        if (hipFuncSetAttribute((const void*)yoco_fwd, hipFuncAttributeMaxDynamicSharedMemorySize, LDS_BYTES) != hipSuccess) { fprintf(stderr, "kernel_launch: hipFuncSetAttribute failed\n"); grid = -1; return; }
        int per_cu = 0;
        if (hipOccupancyMaxActiveBlocksPerMultiprocessor(&per_cu, (const void*)yoco_fwd, 512, LDS_BYTES) != hipSuccess || per_cu < 1) fprintf(stderr, "kernel_launch: occupancy query reports %d\n", per_cu);
        (void)hipGetLastError();
        grid = cus;
    }
    if (grid < 0) return;
    (void)hipMemsetAsync((char*)d_ws + WS_CTL, 0, CTL_ZERO_BYTES, stream);
    Args a{};
    for (int i = 0; i < N_IN; ++i) a.in[i] = (const float*)d_in[i];
    a.out = (float*)d_out; a.ws = (unsigned char*)d_ws;
#if MK_N_LAUNCHES == 1
    a.ph_lo = 0; a.ph_hi = NPH;
    hipLaunchKernelGGL(yoco_fwd, dim3(grid), dim3(512), LDS_BYTES, stream, a);
#else
    for (int p = 0; p < NPH; ++p) { if (p == 13) continue; a.ph_lo = p; a.ph_hi = p + 1; hipLaunchKernelGGL(yoco_fwd, dim3(grid), dim3(512), LDS_BYTES, stream, a); }
#endif
}
```

```cpp
#include <hip/hip_runtime.h>
#include <cstdio>
#include <cstdint>

#ifndef MK_N_LAUNCHES
#define MK_N_LAUNCHES 1
#endif
#ifndef MK_CHECK
#define MK_CHECK 0
#endif

constexpr int NB = 2, SEQ = 8192, T = NB * SEQ, DM = 2048, HD = 128;
constexpr int NMEM = 256, MEMH = 4, MEMW = 512, MIXW = 1536, MOBA_H = 12, DIFF_H = 6, DV = 256;
constexpr int NEXP = 64, NGRP = 8, EPG = 8, EFF = 512, NRT = 72, NRTP = 80;
constexpr int PROJW = 5120;
constexpr float RMS_EPS = 1e-6f;
constexpr float LOG2E = 1.4426950408889634f;
constexpr float QSCALE = 0.08838834764831845f * LOG2E;
constexpr float LAM_INIT = 0.35550906759096926f;
constexpr int MAXRB = 192;
constexpr float SC_W1 = 64.f, SC_W2 = 32.f, SC_HID = 8.f, SC_O = 16.f;

constexpr size_t MiB = 1u << 20;
constexpr size_t WS_CTL = 0, CTL_ZERO_BYTES = 1 * MiB;
constexpr size_t WS_W_INA = 1 * MiB;
constexpr size_t WS_W_INB = 21 * MiB;
constexpr size_t WS_W_OUT = 41 * MiB;
constexpr size_t WS_W_MKV = 57 * MiB;
constexpr size_t WS_W_RT  = 65 * MiB;
constexpr size_t WS_W_E1  = 67 * MiB;
constexpr size_t WS_HB8   = 323 * MiB;
constexpr size_t WS_W_E2  = 579 * MiB;
constexpr size_t WS_SMALL = 835 * MiB;
constexpr size_t WS_HB    = 851 * MiB;
constexpr size_t WS_PROJ  = 915 * MiB;
constexpr size_t WS_QH    = 1075 * MiB;
constexpr size_t WS_KH    = 1139 * MiB;
constexpr size_t WS_VH    = 1187 * MiB;
constexpr size_t WS_XS    = WS_PROJ;
constexpr size_t WS_OCAT  = 1235 * MiB;
constexpr size_t WS_HID   = 1299 * MiB;
constexpr size_t WS_YS    = 1347 * MiB;
constexpr size_t WS_HA    = 1539 * MiB;
constexpr size_t WS_H2    = 1667 * MiB;
constexpr size_t WS_LISTF = 1795 * MiB;
constexpr size_t WS_LISTA = 1821 * MiB;
constexpr size_t WS_PM    = 1822 * MiB;
constexpr size_t WS_PO    = WS_PROJ;
constexpr size_t WS_END   = 1827 * MiB;
static_assert(WS_XS + (size_t)MAXRB * 256 * 2048 * 2 <= WS_VH, "XS alias");
constexpr size_t SM_RSTD  = 0;
constexpr size_t SM_PART  = 1 * MiB;
constexpr size_t SM_TOKR  = 3 * MiB;
constexpr size_t SM_DEST  = 4 * MiB;
constexpr size_t SM_CNT   = 5 * MiB;
constexpr size_t SM_BLKE  = 5 * MiB + 128 * 1024;
constexpr size_t SM_KMEAN = 6 * MiB;
constexpr size_t SM_SEL   = 7 * MiB;
constexpr size_t SM_MEMN  = 8 * MiB;
constexpr size_t SM_KVM   = 10 * MiB;
constexpr size_t SM_KM    = 12 * MiB;
constexpr size_t SM_VM    = 13 * MiB;
constexpr size_t SM_GAINTAB = 15 * MiB;
constexpr size_t SM_ROWTOK = 14 * MiB;
constexpr int CW_BAR = 4096;
constexpr int CW_Q = 8192;
constexpr int CW_MC = 16384;

constexpr int RING_OFF = 0, RING_BYTES = 131072;
constexpr int LDSX_OFF = RING_BYTES;
constexpr int LDSCTL_OFF = RING_BYTES + 12288, MISC_OFF = LDSCTL_OFF + 320;
constexpr int GT_OFF = 147456;
constexpr int LDS_BYTES = 155648;
static_assert(MISC_OFF + 128 <= GT_OFF - 4, "LDS map");

#define GAS __attribute__((address_space(1)))
#define LAS __attribute__((address_space(3)))
typedef unsigned short bf16;
typedef unsigned v4u __attribute__((ext_vector_type(4)));
typedef unsigned v2u __attribute__((ext_vector_type(2)));
typedef float f32x4 __attribute__((ext_vector_type(4)));
typedef float f32x16 __attribute__((ext_vector_type(16)));
typedef short bf16x8 __attribute__((ext_vector_type(8)));
typedef short s16x4 __attribute__((ext_vector_type(4)));
typedef GAS unsigned gu32;
#define RLX_AGENT __ATOMIC_RELAXED, __HIP_MEMORY_SCOPE_AGENT
#define LDS_WAIT() asm volatile("s_waitcnt lgkmcnt(0)" ::: "memory")
#define VM_WAIT() asm volatile("s_waitcnt vmcnt(0)" ::: "memory")
__device__ __forceinline__ unsigned f2bf(float f) { unsigned u = __builtin_bit_cast(unsigned, f); return (u + 0x7fffu + ((u >> 16) & 1u)) >> 16; }
__device__ __forceinline__ unsigned pk2(float lo, float hi) { return f2bf(lo) | (f2bf(hi) << 16); }
__device__ __forceinline__ float bf2f(unsigned short b) { return __builtin_bit_cast(float, (unsigned)b << 16); }
__device__ __forceinline__ float bflo(unsigned w) { return __builtin_bit_cast(float, w << 16); }
__device__ __forceinline__ float bfhi(unsigned w) { return __builtin_bit_cast(float, w & 0xffff0000u); }
template <int M> __device__ __forceinline__ float swz_xor(float v) { return __builtin_bit_cast(float, __builtin_amdgcn_ds_swizzle(__builtin_bit_cast(int, v), (M << 10) | 0x1F)); }
__device__ __forceinline__ float add_xor32(float v) {
    auto r = __builtin_amdgcn_permlane32_swap(__float_as_uint(v), __float_as_uint(v), false, false);
    return __uint_as_float(r[0]) + __uint_as_float(r[1]); }
__device__ __forceinline__ float wave_sum(float v) {
    v += swz_xor<1>(v); v += swz_xor<2>(v); v += swz_xor<4>(v); v += swz_xor<8>(v); v += swz_xor<16>(v);
    return add_xor32(v);
}
__device__ const unsigned char T5_BUCKET[128] = {
 0, 1, 2, 3, 4, 5, 6, 7, 8, 9, 10, 11, 12, 13, 14, 15, 16, 16, 16, 17, 17, 18, 18, 18, 19, 19, 19, 20, 20, 20, 20, 21, 21, 21, 21, 22, 22, 22, 22, 22, 23, 23, 23, 23, 23, 23, 24, 24, 24, 24, 24, 24, 25, 25, 25, 25, 25, 25, 25, 26, 26, 26, 26, 26, 26, 26, 26, 27, 27, 27, 27, 27, 27, 27, 27, 27, 27, 28, 28, 28, 28, 28, 28, 28, 28, 28, 28, 29, 29, 29, 29, 29, 29, 29, 29, 29, 29, 29, 29, 30, 30, 30, 30, 30, 30, 30, 30, 30, 30, 30, 30, 30, 30, 31, 31, 31, 31, 31, 31, 31, 31, 31, 31, 31, 31, 31, 31, 31};

__device__ __forceinline__ int opaque_tid() { int t = threadIdx.x; asm volatile("" : "+v"(t)); return t; }

__device__ __forceinline__ unsigned char* opaque_ws(unsigned char* p) { asm volatile("" : "+s"(p)); return p; }
namespace pg8 {
#define PG8_LAS __attribute__((address_space(3)))
typedef unsigned short bf16_t;
typedef short bf16x8 __attribute__((ext_vector_type(8)));
typedef float f32x4 __attribute__((ext_vector_type(4)));
typedef unsigned u32x4 __attribute__((ext_vector_type(4)));
constexpr int BM = 256, BK = 64, HALF = 128, HTB = HALF * BK * 2  , STAGE_BYTES = 8 * HTB, NXCD = 8, WGM = 8;

__host__ __device__ __forceinline__ int lds_byte(int r, int c) { const int st = (r >> 4) * 2 + (c >> 5), rr = r & 15, cc = c & 31, ob = rr * 64 + cc * 2; return st * 1024 + (ob ^ (((ob >> 9) & 1) << 5)); }
__host__ __device__ __forceinline__ void stage_rc(int b, int& R, int& C) { const int st = b / 1024, sb = b % 1024, swz = sb ^ (((sb >> 9) & 1) << 5); R = (st >> 1) * 16 + swz / 64; C = (st & 1) * 32 + (swz % 64) / 2; }
__host__ __device__ __forceinline__ int perm32(int rho) { const int n = rho >> 4, i = rho & 15; return 8 * (i >> 2) + 4 * n + (i & 3); }

struct Unit { int pm, pn; };
struct Gemm { const bf16_t* A; const bf16_t* Bt; int M, N, K; const int* rowtok; };

struct StaticOrder {
    int nM, nN, nwg, G, c;
    __host__ __device__ void init(int M, int N, int G_, int c_) { nM = M / BM; nN = N / BM; nwg = nM * nN; G = G_; c = c_; }
    __host__ __device__ bool next(int i, Unit& u) const {
        const long L = (long)i * G + c; if (L >= nwg) return false;
        int wgid = (int)L; { const int q = nwg / NXCD, r = nwg % NXCD, xcd = wgid % NXCD, off = wgid / NXCD; wgid = (xcd < r ? xcd * (q + 1) : r * (q + 1) + (xcd - r) * q) + off; }
        const int nig = WGM * nN, gid = wgid / nig, fm = gid * WGM, gsz = (nM - fm) < WGM ? (nM - fm) : WGM;
        u.pm = fm + ((wgid % nig) % gsz); u.pn = (wgid % nig) / gsz; return true;
    }
    __device__ __forceinline__ void a_ready(const Unit&) const {}
    __device__ __forceinline__ void done(const Unit&) const {}
};

__device__ __forceinline__ unsigned cvt_pk_bf16(float lo, float hi) { unsigned r; asm volatile("v_cvt_pk_bf16_f32 %0, %1, %2" : "=v"(r) : "v"(lo), "v"(hi)); return r; }
typedef float f32x2 __attribute__((ext_vector_type(2)));
struct RangeOrder {
    StaticOrder S; int i0, i1;
    __device__ __forceinline__ bool next(int i, Unit& u) const { return (i0 + i < i1) && S.next(i0 + i, u); }
    __device__ __forceinline__ void a_ready(const Unit&) const {}
    __device__ __forceinline__ void done(const Unit&) const {}
};
template <class E> struct ProbeOf { static constexpr int v = 0; };
template <class Epi, class Sched, bool ALIGN_EPI = false, bool SP2 = false, bool GATHER = false, bool FP8 = false>
__device__ __forceinline__ void gemm_phase(PG8_LAS unsigned char* lds, const Gemm g, const Sched& S, const Epi& E) {
    const int tid = opaque_tid(), wid = __builtin_amdgcn_readfirstlane(tid >> 6), lane = tid & 63, wr = wid >> 2, wc = wid & 3, fr = lane & 15, fq = lane >> 4;
    const int K = g.K, nt = K / BK;
    unsigned voffA[2], voffB[2]; int RA[2]; unsigned CA2[2];
#pragma unroll
    for (int i = 0; i < 2; ++i) { int R, C; stage_rc(tid * 16 + i * 8192, R, C); const int Rb = Epi::PERM ? ((R & ~31) + perm32(R & 31)) : R;
        voffA[i] = (unsigned)(R * K + C) * 2u; voffB[i] = (unsigned)(Rb * K + C) * 2u; RA[i] = R; CA2[i] = (unsigned)C * 2u; }
    const size_t kstep = (size_t)(BK * 2);
    const size_t hstep = (size_t)HALF * K * 2;
    const size_t tstep = 2 * hstep;
    const unsigned ldsw = (unsigned)wid * 1024u;
    const int aoff = lds_byte(wr * 64 + fr, fq * 8), boff = lds_byte(wc * 32 + fr, fq * 8);
#define PG8_SA(b, h) (((b) * 2 + (h)) * HTB)
#define PG8_SB(b, h) ((4 + (b) * 2 + (h)) * HTB)
#define PG8_STAGE(bufoff, gbase, voff) do { if constexpr (!(ProbeOf<Epi>::v & 4)) _Pragma("unroll") for (int _i = 0; _i < 2; ++_i) \
        __builtin_amdgcn_global_load_lds((const unsigned*)((const char*)(gbase) + (voff)[_i]), (PG8_LAS unsigned*)(lds + (bufoff) + ldsw + _i * 8192), 16, 0, 0); } while (0)
    unsigned gc[2][2], gn[2][2];
#define PG8_GOFF(dst, pm_) do { _Pragma("unroll") for (int _h = 0; _h < 2; ++_h) _Pragma("unroll") for (int _i = 0; _i < 2; ++_i) \
        dst[_h][_i] = ((unsigned)g.rowtok[(pm_) * BM + _h * HALF + RA[_i]] & 0x3FFFFFFFu) * (unsigned)(K * 2) + CA2[_i]; } while (0)
#define PG8_STAGE_A(bufoff, ptr, half, usenext) do { if constexpr (GATHER) { _Pragma("unroll") for (int _i = 0; _i < 2; ++_i) \
        __builtin_amdgcn_global_load_lds((const unsigned*)((const char*)(ptr) + ((usenext) ? gn[half][_i] : gc[half][_i])), (PG8_LAS unsigned*)(lds + (bufoff) + ldsw + _i * 8192), 16, 0, 0); } \
        else { PG8_STAGE(bufoff, (ptr) + (half) * hstep, voffA); } } while (0)
#define PG8_LDA(dst, b, h) do { if constexpr (ProbeOf<Epi>::v & 2) {} else if constexpr (FP8) { _Pragma("unroll") for (int m = 0; m < 4; ++m) dst##8[m] = PG8_CAT(*(const PG8_LAS bf16x8*)(lds + PG8_SA(b, h) + aoff + m * 2048), *(const PG8_LAS bf16x8*)(lds + PG8_SA(b, h) + aoff + m * 2048 + 1024)); } \
        else { _Pragma("unroll") for (int m = 0; m < 4; ++m) _Pragma("unroll") for (int k = 0; k < 2; ++k) dst[m][k] = *(const PG8_LAS bf16x8*)(lds + PG8_SA(b, h) + aoff + m * 2048 + k * 1024); } } while (0)
#define PG8_LDB(dst, b, h) do { if constexpr (ProbeOf<Epi>::v & 2) {} else if constexpr (FP8) { _Pragma("unroll") for (int n = 0; n < 2; ++n) dst##8[n] = PG8_CAT(*(const PG8_LAS bf16x8*)(lds + PG8_SB(b, h) + boff + n * 2048), *(const PG8_LAS bf16x8*)(lds + PG8_SB(b, h) + boff + n * 2048 + 1024)); } \
        else { _Pragma("unroll") for (int n = 0; n < 2; ++n) _Pragma("unroll") for (int k = 0; k < 2; ++k) dst[n][k] = *(const PG8_LAS bf16x8*)(lds + PG8_SB(b, h) + boff + n * 2048 + k * 1024); } } while (0)
typedef int pg8_v8i __attribute__((ext_vector_type(8))); typedef int pg8_v4i __attribute__((ext_vector_type(4)));
#define PG8_CAT(x0, x1) __builtin_shufflevector(__builtin_bit_cast(pg8_v4i, x0), __builtin_bit_cast(pg8_v4i, x1), 0, 1, 2, 3, 4, 5, 6, 7)
#define PG8_MMA(ai, bj, At, Bt) do { __builtin_amdgcn_s_setprio(1); if constexpr (ProbeOf<Epi>::v & 1) {} else if constexpr (FP8) { _Pragma("unroll") for (int m = 0; m < 4; ++m) _Pragma("unroll") for (int n = 0; n < 2; ++n) \
        asm volatile("v_mfma_scale_f32_16x16x128_f8f6f4 %0, %1, %2, %0, %3, %3 op_sel_hi:[0,0,0]" : "+v"(acc[ai][bj][m][n]) : "v"(Bt##8[n]), "v"(At##8[m]), "v"(pg8_scale1)); } \
        else { _Pragma("unroll") for (int m = 0; m < 4; ++m) _Pragma("unroll") for (int n = 0; n < 2; ++n) _Pragma("unroll") for (int k = 0; k < 2; ++k) \
        acc[ai][bj][m][n] = __builtin_amdgcn_mfma_f32_16x16x32_bf16(Bt[n][k], At[m][k], acc[ai][bj][m][n], 0, 0, 0); } __builtin_amdgcn_s_setprio(0); } while (0)
#define PG8_WAIT_V(n) asm volatile("s_waitcnt vmcnt(" #n ")" ::: "memory")
#define PG8_WAIT_L(n) asm volatile("s_waitcnt lgkmcnt(" #n ")" ::: "memory")
#define PG8_BAR __builtin_amdgcn_s_barrier()
#define PG8_SCHED __builtin_amdgcn_sched_barrier(0)
    Unit cur, nxt; int ui = 0;
    if (!S.next(0, cur)) return;
    f32x4 acc[2][2][4][2];
#pragma unroll
    for (int a = 0; a < 2; ++a)
#pragma unroll
        for (int b = 0; b < 2; ++b)
#pragma unroll
            for (int m = 0; m < 4; ++m)
#pragma unroll
                for (int n = 0; n < 2; ++n) acc[a][b][m][n] = (f32x4){0.f, 0.f, 0.f, 0.f};
    int pg8_scale1 = 0x7F7F7F7F; asm volatile("" : "+v"(pg8_scale1));
    bf16x8 At[4][2], B0[2][2], B1[2][2]; pg8_v8i At8[4], B08[2], B18[2];
    if constexpr (ProbeOf<Epi>::v & 2) { _Pragma("unroll") for (int m = 0; m < 4; ++m) { At8[m] = (pg8_v8i){1, 2, 3, 4, 5, 6, 7, 8}; asm volatile("" : "+v"(At8[m])); } _Pragma("unroll") for (int n = 0; n < 2; ++n) { B08[n] = (pg8_v8i){1, 2, 3, 4, 5, 6, 7, 8}; B18[n] = B08[n]; asm volatile("" : "+v"(B08[n]), "+v"(B18[n])); } }
    const char* cA = GATHER ? (const char*)g.A : (const char*)g.A + (size_t)cur.pm * tstep; const char* cB = (const char*)g.Bt + (size_t)cur.pn * tstep;
    if constexpr (GATHER) { PG8_GOFF(gc, cur.pm); }
    S.a_ready(cur);
    if constexpr (SP2) {
        PG8_STAGE(PG8_SB(0, 0), cB, voffB); PG8_STAGE(PG8_SB(0, 1), cB + hstep, voffB); PG8_STAGE_A(PG8_SA(0, 0), cA, 0, false); PG8_STAGE_A(PG8_SA(0, 1), cA, 1, false);
        if (wr == 1) PG8_BAR;
        PG8_WAIT_V(2); PG8_BAR;
        PG8_STAGE(PG8_SB(1, 0), cB + kstep, voffB); PG8_STAGE_A(PG8_SA(1, 0), cA + kstep, 0, false); PG8_STAGE(PG8_SB(1, 1), cB + hstep + kstep, voffB);
        PG8_WAIT_V(6); PG8_BAR;
    } else {
        PG8_STAGE(PG8_SB(0, 0), cB, voffB); PG8_STAGE_A(PG8_SA(0, 0), cA, 0, false); PG8_STAGE(PG8_SB(0, 1), cB + hstep, voffB); PG8_STAGE_A(PG8_SA(0, 1), cA, 1, false);
        if (wr == 1) PG8_BAR;
        PG8_WAIT_V(4); PG8_BAR;
        PG8_STAGE(PG8_SB(1, 0), cB + kstep, voffB); PG8_STAGE_A(PG8_SA(1, 0), cA + kstep, 0, false); PG8_STAGE(PG8_SB(1, 1), cB + hstep + kstep, voffB);
        PG8_WAIT_V(6); PG8_BAR;
    }
    for (;;) {
        const bool has_next = S.next(ui + 1, nxt);
        const char* nA = GATHER ? (const char*)g.A : (has_next ? (const char*)g.A + (size_t)nxt.pm * tstep : cA);
        if constexpr (GATHER) { if (has_next) { PG8_GOFF(gn, nxt.pm); } else { _Pragma("unroll") for (int _h = 0; _h < 2; ++_h) _Pragma("unroll") for (int _i = 0; _i < 2; ++_i) gn[_h][_i] = gc[_h][_i]; } } const char* nB = has_next ? (const char*)g.Bt + (size_t)nxt.pn * tstep : cB;
#pragma nounroll
        for (int t = 0; t < nt; t += 2) {
            const bool last = (t == nt - 2);
            const char* a1 = cA + (size_t)(t + 1) * kstep;
            const char* a2 = last ? nA : cA + (size_t)(t + 2) * kstep; const char* b2 = last ? nB : cB + (size_t)(t + 2) * kstep;
            const char* a3 = a2 + kstep; const char* b3 = b2 + kstep;
            if (last && has_next) S.a_ready(nxt);
            if constexpr (SP2) {
            PG8_LDB(B0, 0, 0); PG8_LDB(B1, 0, 1); PG8_SCHED; PG8_LDA(At, 0, 0); PG8_STAGE_A(PG8_SA(1, 1), a1, 1, false);
            PG8_WAIT_V(8); PG8_WAIT_L(0); PG8_BAR; PG8_MMA(0, 0, At, B0); PG8_MMA(0, 1, At, B1); PG8_BAR; PG8_SCHED;
            PG8_LDA(At, 0, 1); PG8_STAGE(PG8_SB(0, 0), b2, voffB); PG8_STAGE(PG8_SB(0, 1), b2 + hstep, voffB); PG8_STAGE_A(PG8_SA(0, 0), a2, 0, last);
            PG8_WAIT_V(8); PG8_WAIT_L(0); PG8_BAR; PG8_MMA(1, 0, At, B0); PG8_MMA(1, 1, At, B1); PG8_BAR; PG8_SCHED;
            PG8_LDB(B0, 1, 0); PG8_LDB(B1, 1, 1); PG8_SCHED; PG8_LDA(At, 1, 0); PG8_STAGE_A(PG8_SA(0, 1), a2, 1, last);
            PG8_WAIT_V(8); PG8_WAIT_L(0); PG8_BAR; PG8_MMA(0, 0, At, B0); PG8_MMA(0, 1, At, B1); PG8_BAR; PG8_SCHED;
            PG8_LDA(At, 1, 1); PG8_STAGE(PG8_SB(1, 0), b3, voffB); PG8_STAGE(PG8_SB(1, 1), b3 + hstep, voffB); PG8_STAGE_A(PG8_SA(1, 0), a3, 0, last);
            PG8_WAIT_V(8); PG8_WAIT_L(0); PG8_BAR; PG8_MMA(1, 0, At, B0); PG8_MMA(1, 1, At, B1); PG8_BAR; PG8_SCHED;
            } else {
            PG8_LDB(B0, 0, 0); PG8_SCHED; PG8_LDA(At, 0, 0); PG8_STAGE_A(PG8_SA(1, 1), a1, 1, false);
            PG8_WAIT_L(8); PG8_BAR; PG8_WAIT_L(0); PG8_MMA(0, 0, At, B0); PG8_BAR; PG8_SCHED;
            PG8_LDB(B1, 0, 1); PG8_STAGE(PG8_SB(0, 0), b2, voffB);
            PG8_BAR; PG8_WAIT_L(0); PG8_MMA(0, 1, At, B1); PG8_BAR;
            PG8_LDA(At, 0, 1); PG8_STAGE_A(PG8_SA(0, 0), a2, 0, last);
            PG8_BAR; PG8_WAIT_L(0); PG8_MMA(1, 0, At, B0); PG8_BAR; PG8_SCHED;
            PG8_STAGE(PG8_SB(0, 1), b2 + hstep, voffB);
            PG8_WAIT_V(6); PG8_BAR; PG8_MMA(1, 1, At, B1); PG8_BAR;
            PG8_LDB(B0, 1, 0); PG8_SCHED; PG8_LDA(At, 1, 0); PG8_STAGE_A(PG8_SA(0, 1), a2, 1, last);
            PG8_WAIT_L(8); PG8_BAR; PG8_WAIT_L(0); PG8_MMA(0, 0, At, B0); PG8_BAR; PG8_SCHED;
            PG8_LDB(B1, 1, 1); PG8_STAGE(PG8_SB(1, 0), b3, voffB);
            PG8_BAR; PG8_WAIT_L(0); PG8_MMA(0, 1, At, B1); PG8_BAR;
            PG8_LDA(At, 1, 1); PG8_STAGE_A(PG8_SA(1, 0), a3, 0, last);
            PG8_BAR; PG8_WAIT_L(0); PG8_MMA(1, 0, At, B0); PG8_BAR; PG8_SCHED;
            PG8_STAGE(PG8_SB(1, 1), b3 + hstep, voffB);
            PG8_WAIT_V(6); PG8_BAR; PG8_MMA(1, 1, At, B1); PG8_BAR;
            }
        }
        if constexpr (FP8) asm volatile("s_nop 15\n\ts_nop 15" ::: "memory");
        if constexpr (ALIGN_EPI) { if (wr == 0) PG8_BAR; }
        if constexpr (!Epi::AFTER_DRAIN) { E(acc, cur, wr, wc, fr, fq); S.done(cur); }
        if (!has_next) break;
#pragma unroll
        for (int a = 0; a < 2; ++a)
#pragma unroll
            for (int b = 0; b < 2; ++b)
#pragma unroll
                for (int m = 0; m < 4; ++m)
#pragma unroll
                    for (int n = 0; n < 2; ++n) acc[a][b][m][n] = (f32x4){0.f, 0.f, 0.f, 0.f};
        cur = nxt; cA = nA; cB = nB; ++ui;
        if constexpr (GATHER) { _Pragma("unroll") for (int _h = 0; _h < 2; ++_h) _Pragma("unroll") for (int _i = 0; _i < 2; ++_i) gc[_h][_i] = gn[_h][_i]; }
        if constexpr (ALIGN_EPI) { if (wr == 1) PG8_BAR; }
    }
    PG8_WAIT_V(0);
    if constexpr (!ALIGN_EPI) { if (wr == 0) PG8_BAR; }
    PG8_BAR;
    if constexpr (Epi::AFTER_DRAIN) { E.fused(acc, cur, wr, wc, fr, fq, lds, wid, lane); S.done(cur); }
#undef PG8_SA
#undef PG8_SB
#undef PG8_STAGE
#undef PG8_STAGE_A
#undef PG8_GOFF
#undef PG8_LDA
#undef PG8_LDB
#undef PG8_MMA
#undef PG8_CAT
#undef PG8_WAIT_V
#undef PG8_WAIT_L
#undef PG8_BAR
#undef PG8_SCHED
}
}
#define XB_TMO      128
#define XB_XCNT(j)  (256  + 64 * (j))
#define XB_XSUB(j)  (1280 + 64 * (j))
#define XB_XGEN(j)  (2304 + 64 * (j))
#define XB_TOP      3328
#define XB_TOPGEN   3392
#define XCD_BAR_WORDS 3456
#define XB_SPIN_CAP (1u << 18)

__device__ __forceinline__ unsigned xb_ld(unsigned* p)              { return __hip_atomic_load(p, __ATOMIC_RELAXED, __HIP_MEMORY_SCOPE_AGENT); }
__device__ __forceinline__ unsigned xb_add(unsigned* p, unsigned v) { return __hip_atomic_fetch_add(p, v, __ATOMIC_RELAXED, __HIP_MEMORY_SCOPE_AGENT); }
__device__ __forceinline__ unsigned xb_xcc_id() { return (unsigned)__builtin_amdgcn_s_getreg((3 << 11) | 20) & 0xFu; }
#define XB_SPIN(cond, bar) do { unsigned _sp = 0; while (cond) { __builtin_amdgcn_s_sleep(1); \
    if ((++_sp & 255u) == 0u) { if (xb_ld(&(bar)[XB_TMO])) break; if (_sp > XB_SPIN_CAP) { atomicAdd(&(bar)[XB_TMO], 1u); break; } } } } while (0)

struct XcdBarrier {
    unsigned* bar; unsigned x;
    volatile LAS unsigned* st;
};

__device__ __forceinline__ XcdBarrier xcd_barrier_post(unsigned* bar, volatile LAS unsigned* st) {
    XcdBarrier b; b.bar = bar; b.x = xb_xcc_id(); b.st = st;
    if (threadIdx.x == 0) (void)xb_add(&bar[XB_XCNT(b.x)], 1u);
    return b;
}
__device__ __forceinline__ void xcd_barrier_complete(unsigned* bar, unsigned x, unsigned& nloc, unsigned& nx) {
    const unsigned G = gridDim.x * gridDim.y * gridDim.z;
    unsigned sum, cnt, mine, sp = 0u;
    for (;;) {
        sum = 0u; cnt = 0u; mine = 0u;
#pragma unroll
        for (unsigned j = 0; j < 16; ++j) { const unsigned c = xb_ld(&bar[XB_XCNT(j)]); sum += c; cnt += (c > 0u) ? 1u : 0u; mine = (j == x) ? c : mine; }
        if (sum == G) break;
        __builtin_amdgcn_s_sleep(1);
        if ((++sp & 255u) == 0u) { if (xb_ld(&bar[XB_TMO])) break; if (sp > XB_SPIN_CAP) { atomicAdd(&bar[XB_TMO], 1u); break; } }
    }
    nloc = mine > 0u ? mine : 1u; nx = cnt > 0u ? cnt : 1u;
}

__device__ __forceinline__ void xcd_barrier(const XcdBarrier& b) {
    asm volatile("s_waitcnt vmcnt(0)" ::: "memory");
    __syncthreads();
    if (threadIdx.x == 0) {
        unsigned* bar = b.bar;
        __builtin_amdgcn_s_waitcnt(0);
        unsigned nloc = b.st[0], nx = b.st[1];
        if (nloc == 0u) { xcd_barrier_complete(bar, b.x, nloc, nx); b.st[0] = nloc; b.st[1] = nx; }
        const unsigned old = xb_add(&bar[XB_XSUB(b.x)], 1u);
        const unsigned gen = old / nloc;
        if (old + 1u == (gen + 1u) * nloc) {
            __builtin_amdgcn_fence(__ATOMIC_RELEASE, "agent");
            asm volatile("s_waitcnt vmcnt(0)" ::: "memory");
            const unsigned og = xb_add(&bar[XB_TOP], 1u);
            const unsigned tg = og / nx;
            if (og + 1u == (tg + 1u) * nx) xb_add(&bar[XB_TOPGEN], 1u);
            else XB_SPIN(xb_ld(&bar[XB_TOPGEN]) == tg, bar);
            __builtin_amdgcn_fence(__ATOMIC_ACQUIRE, "agent");
            xb_add(&bar[XB_XGEN(b.x)], 1u);
            asm volatile("s_waitcnt vmcnt(0)" ::: "memory");
        } else {
            XB_SPIN(xb_ld(&bar[XB_XGEN(b.x)]) == gen, bar);
            __builtin_amdgcn_fence(__ATOMIC_ACQUIRE, "agent");
            asm volatile("s_waitcnt vmcnt(0)" ::: "memory");
        }
    }
    __syncthreads();
}

enum InIdx { I_X = 0, I_MEM, I_RELB, I_ATTN_G, I_FFN_G, I_MEM_G, I_W_MKV, I_QN_MEM, I_KN_MEM, I_W_OUT, I_W_INA, I_QN_A, I_KN_A, I_KV_G, I_W_KVB, I_KN_B, I_W_INB, I_QN_B,
             I_LAMBDA, I_SUBLN, I_W_RG, I_B_RG, I_W_RE, I_B_RE, I_W_GATE, I_W_UP, I_W_DOWN, N_IN };
struct Args { const float* in[N_IN]; float* out; unsigned char* ws; int ph_lo, ph_hi; };
static_assert(sizeof(Args) == N_IN * 8 + 8 + 8 + 8, "Args has no padding");

using pg8::cvt_pk_bf16;
struct EpiRowScale {
    static constexpr bool PERM = true, AFTER_DRAIN = false;
    bf16* O; int ldc; const float* rs; int ntn; float cs;
    const int* rowtok;
    __device__ __forceinline__ void operator()(const f32x4 (&acc)[2][2][4][2], const pg8::Unit& u, int wr, int wc, int fr, int fq) const {
        const int colt = ntn ? (u.pn % ntn) : u.pn;
        const int row0 = u.pm * 256 + wr * 64 + fr, col0 = colt * 256 + wc * 32 + 8 * fq;
        int rt[2][4];
#pragma unroll
        for (int ai = 0; ai < 2; ++ai)
#pragma unroll
            for (int m = 0; m < 4; ++m) rt[ai][m] = rowtok ? rowtok[row0 + ai * 128 + m * 16] : 0;
#pragma unroll
        for (int ai = 0; ai < 2; ++ai)
#pragma unroll
            for (int m = 0; m < 4; ++m) { if (rt[ai][m] & 0x40000000) continue; const int row = row0 + ai * 128 + m * 16; const float s = (rs ? rs[row] : 1.f) * cs; bf16* rowp = O + (size_t)row * ldc + col0;
#pragma unroll
                for (int bj = 0; bj < 2; ++bj) { const f32x4 v0 = acc[ai][bj][m][0] * s, v1 = acc[ai][bj][m][1] * s;
                    v4u w; w.x = cvt_pk_bf16(v0[0], v0[1]); w.y = cvt_pk_bf16(v0[2], v0[3]); w.z = cvt_pk_bf16(v1[0], v1[1]); w.w = cvt_pk_bf16(v1[2], v1[3]);
                    *(v4u*)(rowp + bj * 128) = w; } }
    }
};
template <bool RES_F32, int PV = 0>
struct EpiOutProj {
    static constexpr bool PERM = true, AFTER_DRAIN = false;
    const float* resid; float* part; bf16* HB; unsigned char* HB8; float cs;
    __device__ __forceinline__ void operator()(const f32x4 (&acc)[2][2][4][2], const pg8::Unit& u, int wr, int wc, int fr, int fq) const {
        const int row0 = u.pm * 256 + wr * 64 + fr, col0 = u.pn * 256 + wc * 32 + 8 * fq;
#pragma unroll
        for (int ai = 0; ai < 2; ++ai)
#pragma unroll
            for (int mp = 0; mp < 2; ++mp) {
                f32x4 rf[2][2][2]; v4u rb[2][2];
#pragma unroll
                for (int mm = 0; mm < 2; ++mm) { const size_t off = (size_t)(row0 + ai * 128 + (2 * mp + mm) * 16) * DM + col0;
#pragma unroll
                    for (int bj = 0; bj < 2; ++bj) {
                        if (PV & 1) { rf[mm][bj][0] = (f32x4){0.f, 0.f, 0.f, 0.f}; rf[mm][bj][1] = rf[mm][bj][0]; rb[mm][bj] = (v4u){0u, 0u, 0u, 0u}; }
                        else if (RES_F32) { rf[mm][bj][0] = __builtin_nontemporal_load((const f32x4*)(resid + off + bj * 128)); rf[mm][bj][1] = __builtin_nontemporal_load((const f32x4*)(resid + off + bj * 128 + 4)); }
                        else rb[mm][bj] = __builtin_nontemporal_load((const v4u*)(HB + off + bj * 128)); } }
#pragma unroll
                for (int mm = 0; mm < 2; ++mm) { const int m = 2 * mp + mm; const int row = row0 + ai * 128 + m * 16; const size_t off = (size_t)row * DM + col0; float ss = 0.f;
#pragma unroll
                    for (int bj = 0; bj < 2; ++bj) { f32x4 r0, r1;
                        if (RES_F32) { r0 = rf[mm][bj][0]; r1 = rf[mm][bj][1]; }
                        else { const v4u q = rb[mm][bj]; r0 = (f32x4){bflo(q.x), bfhi(q.x), bflo(q.y), bfhi(q.y)}; r1 = (f32x4){bflo(q.z), bfhi(q.z), bflo(q.w), bfhi(q.w)}; }
                        const f32x4 v0 = r0 + acc[ai][bj][m][0] * cs, v1 = r1 + acc[ai][bj][m][1] * cs;
                        ss += ((v0[0] * v0[0] + v0[1] * v0[1]) + (v0[2] * v0[2] + v0[3] * v0[3])) + ((v1[0] * v1[0] + v1[1] * v1[1]) + (v1[2] * v1[2] + v1[3] * v1[3]));
                        v4u hb; hb.x = cvt_pk_bf16(v0[0], v0[1]); hb.y = cvt_pk_bf16(v0[2], v0[3]); hb.z = cvt_pk_bf16(v1[0], v1[1]); hb.w = cvt_pk_bf16(v1[2], v1[3]);
                        if (!(PV & 2) || hb.x == 0x12345u) *(v4u*)(HB + off + bj * 128) = hb;
                        unsigned w0 = 0u, w1 = 0u; w0 = __builtin_amdgcn_cvt_pk_fp8_f32(v0[0], v0[1], w0, false); w0 = __builtin_amdgcn_cvt_pk_fp8_f32(v0[2], v0[3], w0, true);
                        w1 = __builtin_amdgcn_cvt_pk_fp8_f32(v1[0], v1[1], w1, false); w1 = __builtin_amdgcn_cvt_pk_fp8_f32(v1[2], v1[3], w1, true);
                        if (!(PV & 4) || w0 == 0x12345u) *(v2u*)(HB8 + off + bj * 128) = (v2u){w0, w1}; }
                    ss += swz_xor<16>(ss); ss = add_xor32(ss);
                    if (fq == 0) part[(size_t)row * 32 + u.pn * 4 + wc] = ss; } }
    }
};
struct EpiSiluMul {
    static constexpr bool PERM = true, AFTER_DRAIN = false;
    bf16* O; const float* rstd; const int* rowtok;
    __device__ __forceinline__ void operator()(const f32x4 (&acc)[2][2][4][2], const pg8::Unit& u, int wr, int wc, int fr, int fq) const {
        const int row0 = u.pm * 256 + wr * 64 + fr, col0 = (u.pn & 3) * 128 + wc * 32 + 8 * fq;
        int tk[2][4]; float rsv[2][4];
#pragma unroll
        for (int ai = 0; ai < 2; ++ai)
#pragma unroll
            for (int m = 0; m < 4; ++m) tk[ai][m] = rowtok[row0 + ai * 128 + m * 16] & 0x3FFFFFFF;
#pragma unroll
        for (int ai = 0; ai < 2; ++ai)
#pragma unroll
            for (int m = 0; m < 4; ++m) rsv[ai][m] = rstd[tk[ai][m]] * (1.f / SC_W1);
#pragma unroll
        for (int ai = 0; ai < 2; ++ai)
#pragma unroll
            for (int m = 0; m < 4; ++m) { const int row = row0 + ai * 128 + m * 16; float h[8]; const float rs = rsv[ai][m];
#pragma unroll
                for (int n = 0; n < 2; ++n)
#pragma unroll
                    for (int e = 0; e < 4; ++e) { const float g = acc[ai][0][m][n][e] * rs, up = acc[ai][1][m][n][e] * (rs * SC_HID);
                        h[n * 4 + e] = g * up * __builtin_amdgcn_rcpf(1.f + __builtin_amdgcn_exp2f(-g * LOG2E)); }
                unsigned w0 = 0u, w1 = 0u; w0 = __builtin_amdgcn_cvt_pk_fp8_f32(h[0], h[1], w0, false); w0 = __builtin_amdgcn_cvt_pk_fp8_f32(h[2], h[3], w0, true);
                w1 = __builtin_amdgcn_cvt_pk_fp8_f32(h[4], h[5], w1, false); w1 = __builtin_amdgcn_cvt_pk_fp8_f32(h[6], h[7], w1, true);
                *(v2u*)((unsigned char*)O + (size_t)row * EFF + col0) = (v2u){w0, w1}; }
    }
};
struct MoeOrder {
    const int* blk_e; int nunits, ntn, G, c;
    __device__ __forceinline__ bool next(int i, pg8::Unit& u) const {
        const int L = i * G + c; if (L >= nunits) return false;
        const int rb = L / ntn; u.pm = rb; u.pn = blk_e[rb] * ntn + (L - rb * ntn); return true;
    }
    __device__ __forceinline__ void a_ready(const pg8::Unit&) const {}
    __device__ __forceinline__ void done(const pg8::Unit&) const {}
};

struct TrDesc { const float* src; int N; bf16* dst; int dstK; const float* gain; float f8; };
__device__ __forceinline__ TrDesc tr_decode(const Args& a, int r) {
    unsigned char* ws = opaque_ws(a.ws); TrDesc d; d.f8 = 0.f;
    constexpr int R0 = 2560, R1 = 1024, R2 = 1536, R3 = 2048, R4 = 1024, R5 = 32768, R6 = 32768;
    if (r < R0) { const int kb = r / 160, nb = r % 160; d.src = a.in[I_W_INA] + (size_t)(128 * kb) * 5120 + 32 * nb; d.N = 5120; d.dst = (bf16*)(ws + WS_W_INA + (size_t)(32 * nb) * DM + 128 * kb); d.dstK = DM; d.gain = a.in[I_ATTN_G] + 128 * kb; d.f8 = SC_W1; return d; } r -= R0;
    if (r < R1) { const int kb = r / 64, nb = r % 64; d.src = a.in[I_W_INB] + (size_t)(128 * kb) * 2048 + 32 * nb; d.N = 2048; d.dst = (bf16*)(ws + WS_W_INB + (size_t)(32 * nb) * DM + 128 * kb); d.dstK = DM; d.gain = a.in[I_ATTN_G] + DM + 128 * kb; d.f8 = SC_W1; return d; } r -= R1;
    if (r < R2) { const int kb = r / 96, nb = r % 96; d.src = a.in[I_W_KVB] + (size_t)(128 * kb) * 3072 + 32 * nb; d.N = 3072; d.dst = (bf16*)(ws + WS_W_INB + (size_t)(2048 + 32 * nb) * DM + 128 * kb); d.dstK = DM; d.gain = a.in[I_KV_G] + 128 * kb; d.f8 = SC_W1; return d; } r -= R2;
    if (r < R3) { const int l = r / 1024, rr = r % 1024, kb = rr / 64, nb = rr % 64; d.src = a.in[I_W_OUT] + (size_t)l * DM * DM + (size_t)(128 * kb) * 2048 + 32 * nb; d.N = 2048;
        d.dst = (bf16*)(ws + WS_W_OUT + (size_t)l * DM * DM + (size_t)(32 * nb) * DM + 128 * kb); d.f8 = SC_W1;
        d.dstK = DM; d.gain = nullptr; return d; } r -= R3;
    if (r < R4) { const int l = r / 512, rr = r % 512, kb = rr / 32, nb = rr % 32; d.src = a.in[I_W_MKV] + (size_t)l * DM * 1024 + (size_t)(128 * kb) * 1024 + 32 * nb; d.N = 1024;
        d.dst = (bf16*)(ws + WS_W_MKV) + (size_t)l * 1024 * DM + (size_t)(32 * nb) * DM + 128 * kb; d.dstK = DM; d.gain = a.in[I_MEM_G] + l * DM + 128 * kb; return d; } r -= R4;
    if (r < R5 + R6) { const int up = r >= R5 ? 1 : 0; if (up) r -= R5;
        const int le = r / 256, rr = r % 256, kb = rr / 16, nb = rr % 16, n0 = 32 * nb, drow = (n0 >> 7) * 256 + (n0 & 127) + up * 128;
        d.src = (up ? a.in[I_W_UP] : a.in[I_W_GATE]) + (size_t)le * DM * EFF + (size_t)(128 * kb) * EFF + n0; d.N = EFF;
        d.dst = (bf16*)(ws + WS_W_E1 + ((size_t)le * 1024 + drow) * DM + 128 * kb); d.dstK = DM; d.gain = a.in[I_FFN_G] + (le >> 6) * DM + 128 * kb; d.f8 = SC_W1; return d; } r -= R5 + R6;
    { const int le = r / 256, rr = r % 256, kb = rr / 64, nb = rr % 64; d.src = a.in[I_W_DOWN] + (size_t)le * EFF * DM + (size_t)(128 * kb) * DM + 32 * nb; d.N = DM;
        d.dst = (bf16*)(ws + WS_W_E2 + ((size_t)le * DM + 32 * nb) * EFF + 128 * kb); d.dstK = EFF; d.gain = nullptr; d.f8 = SC_W2; return d; }
}
__device__ __forceinline__ float row_to_fp8(const float* xrow, unsigned char* orow, int lane) {
    const GAS f32x4* xr = (const GAS f32x4*)xrow + lane;
    f32x4 v[8]; float s = 0.f;
#pragma unroll
    for (int j = 0; j < 8; ++j) { v[j] = __builtin_nontemporal_load(xr + 64 * j); s += (v[j].x * v[j].x + v[j].y * v[j].y) + (v[j].z * v[j].z + v[j].w * v[j].w); }
    const float rstd = 1.0f / sqrtf(wave_sum(s) * (1.f / DM) + RMS_EPS);
    GAS unsigned* o4 = (GAS unsigned*)orow + lane;
#pragma unroll
    for (int j = 0; j < 8; ++j) { unsigned w = 0u; w = __builtin_amdgcn_cvt_pk_fp8_f32(v[j].x, v[j].y, w, false); w = __builtin_amdgcn_cvt_pk_fp8_f32(v[j].z, v[j].w, w, true); o4[64 * j] = w; }
    return rstd;
}
__device__ __forceinline__ float row_to_bf16(const float* xrow, bf16* orow, bool normalise, int lane) {
    const GAS f32x4* xr = (const GAS f32x4*)xrow + lane;
    f32x4 v[8]; float s = 0.f;
#pragma unroll
    for (int j = 0; j < 8; ++j) { v[j] = __builtin_nontemporal_load(xr + 64 * j); s += (v[j].x * v[j].x + v[j].y * v[j].y) + (v[j].z * v[j].z + v[j].w * v[j].w); }
    const float rstd = 1.0f / sqrtf(wave_sum(s) * (1.f / DM) + RMS_EPS);
    const float f = normalise ? rstd : 1.f;
    GAS unsigned long long* o8 = (GAS unsigned long long*)orow + lane;
#pragma unroll
    for (int j = 0; j < 8; ++j) o8[64 * j] = (unsigned long long)pk2(v[j].x * f, v[j].y * f) | ((unsigned long long)pk2(v[j].z * f, v[j].w * f) << 32);
    return rstd;
}
#define TR_IDX(i) (layer < 0 ? (i) : 8192 + ((i) / 16384) * 32768 + layer * 16384 + ((i) % 16384))
__device__ __forceinline__ void tr_loop(const Args& a, LAS float* scr, int lane, int it, int end, int stride, int layer) {
    const int first0 = it < end ? it : 0;
    {
        float v[64];
        const int lr = lane >> 5, lc = lane & 31;
        TrDesc cur = tr_decode(a, TR_IDX(it < end ? it : first0));
        if (it < end) {
#pragma unroll
            for (int i = 0; i < 64; ++i) v[i] = __builtin_nontemporal_load(cur.src + (size_t)(2 * i + lr) * cur.N + lc);
        }
        for (; it < end; it += stride) {
#pragma unroll
            for (int i = 0; i < 64; ++i) scr[(2 * i + lr) * 33 + lc] = v[i];
            LDS_WAIT(); asm volatile("" ::: "memory");
            const int nx = it + stride; const bool has_next = nx < end;
            const TrDesc nd = tr_decode(a, TR_IDX(has_next ? nx : it));
            if (has_next) {
#pragma unroll
                for (int i = 0; i < 64; ++i) v[i] = __builtin_nontemporal_load(nd.src + (size_t)(2 * i + lr) * nd.N + lc);
            }
            if (cur.f8 != 0.f) {
                const int c = lane & 7, nq = lane >> 3; const float f = cur.f8;
                f32x4 g[4];
#pragma unroll
                for (int q = 0; q < 4; ++q) g[q] = cur.gain ? *(const f32x4*)(cur.gain + 16 * c + 4 * q) * f : (f32x4){f, f, f, f};
#pragma unroll
                for (int j = 0; j < 4; ++j) { const int n = nq + 8 * j; const LAS float* sp = scr + (16 * c) * 33 + n; v4u o;
#pragma unroll
                    for (int q = 0; q < 4; ++q) { unsigned w = 0u;
                        w = __builtin_amdgcn_cvt_pk_fp8_f32(sp[(4 * q + 0) * 33] * g[q][0], sp[(4 * q + 1) * 33] * g[q][1], w, false);
                        w = __builtin_amdgcn_cvt_pk_fp8_f32(sp[(4 * q + 2) * 33] * g[q][2], sp[(4 * q + 3) * 33] * g[q][3], w, true); o[q] = w; }
                    *(GAS v4u*)((unsigned char*)cur.dst + (size_t)n * cur.dstK + 16 * c) = o; }
            } else {
                const int c = lane & 15, nq = lane >> 4;
                f32x4 g0 = (f32x4){1.f, 1.f, 1.f, 1.f}, g1 = g0;
                if (cur.gain) { g0 = *(const f32x4*)(cur.gain + 8 * c); g1 = *(const f32x4*)(cur.gain + 8 * c + 4); }
#pragma unroll
                for (int j = 0; j < 8; ++j) { const int n = nq + 4 * j; const LAS float* sp = scr + (8 * c) * 33 + n;
                    v4u o; o.x = pk2(sp[0 * 33] * g0[0], sp[1 * 33] * g0[1]); o.y = pk2(sp[2 * 33] * g0[2], sp[3 * 33] * g0[3]); o.z = pk2(sp[4 * 33] * g1[0], sp[5 * 33] * g1[1]); o.w = pk2(sp[6 * 33] * g1[2], sp[7 * 33] * g1[3]);
                    *(GAS v4u*)(cur.dst + (size_t)n * cur.dstK + 8 * c) = o; }
            }
            LDS_WAIT(); asm volatile("" ::: "memory");
            cur = nd;
        }
    }
}
#undef TR_IDX
constexpr int EXP_ITEMS = 49152, CONV_CH = 48, CONV_NCH = EXP_ITEMS / CONV_CH, CONV_IN = 512, CONV_SP = 256;
__device__ __forceinline__ void tr_loop2(const Args& a, LAS float* scr, const LAS float* gt, int lane, int it, int end, int stride, int layer) {
#define TR_IDX(i) (8192 + ((i) / 16384) * 32768 + layer * 16384 + ((i) % 16384))
    const int lr8 = lane >> 3, lc4 = (lane & 7) * 4;
    const float* gbase = a.in[I_FFN_G] + layer * DM;
#define TR_LOADW(d_, w_) do { const GAS f32x4* p_ = (const GAS f32x4*)((d_).src + (size_t)lr8 * (d_).N + lc4); const size_t st_ = (size_t)2 * (d_).N; \
        _Pragma("unroll") for (int i = 0; i < 16; ++i) w_[i] = __builtin_nontemporal_load(p_ + i * st_); } while (0)
#define TR_STEP(w_, d_, itn_) do { \
        _Pragma("unroll") for (int i = 0; i < 16; ++i) _Pragma("unroll") for (int e = 0; e < 4; ++e) scr[(8 * i + lr8) * 33 + lc4 + e] = w_[i][e]; \
        LDS_WAIT(); asm volatile("" ::: "memory"); \
        const TrDesc cur_ = d_; \
        if ((itn_) < end) { d_ = tr_decode(a, TR_IDX(itn_)); TR_LOADW(d_, w_); } \
        { const int c = lane & 7, nq = lane >> 3; const float f = cur_.f8; f32x4 g[4]; \
          if (cur_.gain) { const LAS float* gp = gt + (int)(cur_.gain - gbase) + 16 * c; _Pragma("unroll") for (int q = 0; q < 4; ++q) g[q] = *(const LAS f32x4*)(gp + 4 * q) * f; } \
          else { _Pragma("unroll") for (int q = 0; q < 4; ++q) g[q] = (f32x4){f, f, f, f}; } \
          _Pragma("unroll") for (int j = 0; j < 4; ++j) { const int n = nq + 8 * j; const LAS float* sp = scr + (16 * c) * 33 + n; v4u o; \
              _Pragma("unroll") for (int q = 0; q < 4; ++q) { unsigned w = 0u; \
                  w = __builtin_amdgcn_cvt_pk_fp8_f32(sp[(4 * q + 0) * 33] * g[q][0], sp[(4 * q + 1) * 33] * g[q][1], w, false); \
                  w = __builtin_amdgcn_cvt_pk_fp8_f32(sp[(4 * q + 2) * 33] * g[q][2], sp[(4 * q + 3) * 33] * g[q][3], w, true); o[q] = w; } \
              *(GAS v4u*)((unsigned char*)cur_.dst + (size_t)n * cur_.dstK + 16 * c) = o; } } \
        LDS_WAIT(); asm volatile("" ::: "memory"); } while (0)
    int it0 = it, it1 = it + stride;
    f32x4 wa[16], wb[16];
    TrDesc da = tr_decode(a, TR_IDX(it0 < end ? it0 : 0)), db = tr_decode(a, TR_IDX(it1 < end ? it1 : 0));
    if (it0 < end) TR_LOADW(da, wa);
    if (it1 < end) TR_LOADW(db, wb);
    for (;;) {
        if (it0 >= end) break;
        TR_STEP(wa, da, it0 + 2 * stride); it0 += 2 * stride;
        if (it1 >= end) break;
        TR_STEP(wb, db, it1 + 2 * stride); it1 += 2 * stride;
    }
#undef TR_STEP
#undef TR_LOADW
#undef TR_IDX
}
__device__ __forceinline__ void conv_chunk(const Args& a, LAS unsigned char* lds, int layer, int c) {
    const int tid = opaque_tid(), lane = tid & 63, wave = __builtin_amdgcn_readfirstlane(tid >> 6);
    volatile LAS int* gtl = (volatile LAS int*)(lds + GT_OFF - 4); LAS float* gt = (LAS float*)(lds + GT_OFF);
    if (gtl[0] != layer + 1) {
        __syncthreads();
        ((LAS f32x4*)gt)[tid] = ((const f32x4*)(a.in[I_FFN_G] + layer * DM))[tid];
        if (tid == 0) gtl[0] = layer + 1;
        __syncthreads();
    }
    tr_loop2(a, (LAS float*)(lds + RING_OFF + wave * 16896), gt, lane, c * CONV_CH + wave, (c + 1) * CONV_CH, 8, layer);
    __syncthreads();
}
struct Mix { bool conv; int idx; };
__device__ __forceinline__ Mix mix_decode(int u, int NA, int NC) {
    const long U = NA + NC; const int cb = (int)(((long)u * NC) / U), cb1 = (int)(((long)(u + 1) * NC) / U);
    Mix m; m.conv = cb1 != cb; m.idx = m.conv ? cb : u - cb; return m;
}
__device__ __forceinline__ void phase_prep(const Args& a, LAS unsigned char* lds, int G, int vb) {
    const int tid = opaque_tid(), lane = tid & 63, wave = __builtin_amdgcn_readfirstlane(tid >> 6);
    unsigned char* ws = opaque_ws(a.ws);
    LAS float* scr = (LAS float*)(lds + RING_OFF + wave * 16896);
    const int gw = vb * 8 + wave, NGW = G * 8;
    tr_loop(a, scr, lane, gw, 8192, NGW, -1);
    for (int idx = vb * 512 + tid; idx < 2 * NRTP * DM; idx += G * 512) {
        const int l = idx / (NRTP * DM), j = (idx / DM) % NRTP, k = idx % DM;
        float v = 0.f;
        if (j < 8) v = a.in[I_W_RG][((size_t)l * DM + k) * 8 + j]; else if (j < NRT) v = a.in[I_W_RE][((size_t)l * DM + k) * 64 + (j - 8)];
        v *= a.in[I_FFN_G][l * DM + k];
        const unsigned hi = f2bf(v); const float lo = v - bf2f((unsigned short)hi);
        bf16* wr = (bf16*)(ws + WS_W_RT) + (size_t)l * 2 * NRTP * DM;
        wr[(size_t)j * DM + k] = (bf16)hi; wr[(size_t)(NRTP + j) * DM + k] = (bf16)f2bf(lo);
    }
    for (int idx = vb * 512 + tid; idx < 2 * 5 * HD; idx += G * 512) { const int l = idx / (5 * HD), w = (idx / HD) % 5, i = idx % HD; float v;
        if (l == 0) v = (w < 2) ? a.in[I_QN_A][i] : (w == 2) ? a.in[I_QN_MEM][i] : a.in[I_KN_A][i];
        else v = (w == 0) ? a.in[I_QN_B][i] : (w == 1) ? a.in[I_QN_B][HD + i] : (w == 2) ? a.in[I_QN_MEM][HD + i] : (w == 3) ? a.in[I_KN_B][i] : a.in[I_KN_B][HD + i];
        ((float*)(ws + WS_SMALL + SM_GAINTAB))[idx] = v; }
    float* rstd = (float*)(ws + WS_SMALL + SM_RSTD);
    for (int m = gw; m < T; m += NGW) { const float rs = row_to_fp8(a.in[I_X] + (size_t)m * DM, ws + WS_HB8 + (size_t)m * DM, lane); if (lane == 0) rstd[m] = rs; }
    for (int m = gw; m < NB * NMEM; m += NGW) (void)row_to_bf16(a.in[I_MEM] + (size_t)m * DM, (bf16*)(ws + WS_SMALL + SM_MEMN) + (size_t)m * DM, true, lane);
}

struct PostDesc { const bf16* src; int sp; bf16* dst; int dp; const float* gain; float scale; float* kmean; };
__device__ __forceinline__ void post_unit(const PostDesc& d, LAS unsigned char* lds) {
    const int tid = opaque_tid(), lane = tid & 63, wave = __builtin_amdgcn_readfirstlane(tid >> 6), c = lane & 15, rg = lane >> 4;
    float g8[8]; float cs[8];
#pragma unroll
    for (int i = 0; i < 8; ++i) { g8[i] = d.gain ? d.gain[8 * c + i] * d.scale : 1.f; cs[i] = 0.f; }
    v4u wv[8];
#pragma unroll
    for (int it = 0; it < 8; ++it) wv[it] = *(const v4u*)(d.src + (size_t)(wave * 32 + it * 4 + rg) * d.sp + 8 * c);
#pragma unroll
    for (int it = 0; it < 8; ++it) {
        const int row = wave * 32 + it * 4 + rg;
        const v4u w = wv[it];
        float f[8] = {bflo(w.x), bfhi(w.x), bflo(w.y), bfhi(w.y), bflo(w.z), bfhi(w.z), bflo(w.w), bfhi(w.w)};
        if (d.gain) {
            float ss = 0.f;
#pragma unroll
            for (int i = 0; i < 8; ++i) ss += f[i] * f[i];
            ss += swz_xor<1>(ss); ss += swz_xor<2>(ss); ss += swz_xor<4>(ss); ss += swz_xor<8>(ss);
            const float rstd = 1.0f / sqrtf(ss * (1.f / HD) + RMS_EPS);
#pragma unroll
            for (int i = 0; i < 8; ++i) { f[i] = f[i] * rstd * g8[i]; cs[i] += f[i]; }
        }
        v4u o; o.x = pk2(f[0], f[1]); o.y = pk2(f[2], f[3]); o.z = pk2(f[4], f[5]); o.w = pk2(f[6], f[7]);
        *(v4u*)(d.dst + (size_t)row * d.dp + 8 * c) = o;
    }
    if (d.kmean) {
        LAS float* ks = (LAS float*)(lds + RING_OFF);
#pragma unroll
        for (int i = 0; i < 8; ++i) { cs[i] += swz_xor<16>(cs[i]); cs[i] = add_xor32(cs[i]); }
        if (lane < 16) {
#pragma unroll
            for (int i = 0; i < 8; ++i) ks[wave * 128 + 8 * c + i] = cs[i]; }
        __syncthreads();
        if (tid < 128) { float s = 0.f;
#pragma unroll
            for (int w = 0; w < 8; ++w) s += ks[w * 128 + tid];
            d.kmean[tid] = s * (1.f / 256.f); }
        __syncthreads();
    }
}
__device__ __forceinline__ void phase_post_mem(const Args& a, LAS unsigned char* lds, int G, int vb) {
    unsigned char* ws = opaque_ws(a.ws);
    for (int v = vb; v < 32; v += G) {
        PostDesc d; d.kmean = nullptr; d.scale = 1.f; d.gain = nullptr;
        const int l = v >> 4, b = (v >> 3) & 1, s8 = v & 7;
        const bf16* srow = (const bf16*)(ws + WS_SMALL + SM_KVM) + ((size_t)b * 256) * 2048 + l * 1024; d.sp = 2048; d.dp = HD;
        if (s8 < 4) { d.src = srow + s8 * 128; d.dst = (bf16*)(ws + WS_SMALL + SM_KM) + ((size_t)((l * 2 + b) * 4 + s8) * NMEM) * HD; d.gain = a.in[I_KN_MEM] + l * HD; }
        else { d.src = srow + 512 + (s8 - 4) * 128; d.dst = (bf16*)(ws + WS_SMALL + SM_VM) + ((size_t)((l * 2 + b) * 4 + (s8 - 4)) * NMEM) * HD; }
        post_unit(d, lds);
    }
}
struct SlotDesc { bf16* dst; int dp; const float* gain; float scale; float* kmean; };
__device__ __forceinline__ SlotDesc slot_desc(unsigned char* ws, int layer, int sl, int pm) {
    const float* gt = (const float*)(ws + WS_SMALL + SM_GAINTAB) + layer * 5 * HD;
    bf16* QH = (bf16*)(ws + WS_QH); bf16* KH = (bf16*)(ws + WS_KH); bf16* VH = (bf16*)(ws + WS_VH);
    const int t0 = pm * 256, b = pm >> 5, s0 = (pm & 31) * 256;
    SlotDesc d; d.kmean = nullptr; d.scale = 1.f; d.gain = nullptr;
    if (layer == 0) {
        if (sl < 12) { d.dst = QH + (size_t)t0 * DM + sl * 128; d.dp = DM; d.gain = gt; d.scale = QSCALE; }
        else if (sl < 24) { const int h = sl - 12; d.dst = KH + ((size_t)(b * 12 + h) * SEQ + s0) * HD; d.dp = HD; d.gain = gt + 3 * HD;
            d.kmean = (float*)(ws + WS_SMALL + SM_KMEAN) + ((size_t)(b * 12 + h) * 32 + (pm & 31)) * HD; }
        else if (sl < 36) { const int h = sl - 24; d.dst = VH + ((size_t)(b * 12 + h) * SEQ + s0) * HD; d.dp = HD; }
        else { const int h = sl - 36; d.dst = QH + (size_t)t0 * DM + (12 + h) * 128; d.dp = DM; d.gain = gt + 2 * HD; d.scale = QSCALE; }
    } else {
        if (sl < 6) { d.dst = QH + (size_t)t0 * DM + sl * 128; d.dp = DM; d.gain = gt; d.scale = QSCALE; }
        else if (sl < 12) { d.dst = QH + (size_t)t0 * DM + sl * 128; d.dp = DM; d.gain = gt + HD; d.scale = QSCALE; }
        else if (sl < 16) { d.dst = QH + (size_t)t0 * DM + sl * 128; d.dp = DM; d.gain = gt + 2 * HD; d.scale = QSCALE; }
        else if (sl < 22) { const int h = sl - 16; d.dst = KH + ((size_t)(b * 12 + h) * SEQ + s0) * HD; d.dp = HD; d.gain = gt + 3 * HD; }
        else if (sl < 28) { const int h = sl - 22; d.dst = KH + ((size_t)(b * 12 + 6 + h) * SEQ + s0) * HD; d.dp = HD; d.gain = gt + 4 * HD; }
        else { const int vh = sl - 28, h = vh >> 1, cc = vh & 1; d.dst = VH + ((size_t)(b * 6 + h) * SEQ + s0) * DV + cc * 128; d.dp = DV; }
    }
    return d;
}
template <int PV>
struct EpiHeadNormT {
    static constexpr bool PERM = true, AFTER_DRAIN = false;
    unsigned char* ws; int layer; float cs;
    __device__ __forceinline__ void operator()(const f32x4 (&acc)[2][2][4][2], const pg8::Unit& u, int wr, int wc, int fr_in, int fq_in) const {
        int fr = fr_in, fq = fq_in; asm volatile("" : "+v"(fr), "+v"(fq));
        LAS float* P = (LAS float*)(uintptr_t)LDSX_OFF;
        LAS float* KS = (LAS float*)(uintptr_t)(LDSX_OFF + 8192);
        const float* rs = (const float*)(ws + WS_SMALL + SM_RSTD);
        const SlotDesc d0 = slot_desc(ws, layer, 2 * u.pn, u.pm), d1 = slot_desc(ws, layer, 2 * u.pn + 1, u.pm);
        const int rowl = wr * 64 + fr, coll = wc * 32 + 8 * fq;
        const float* rsr = rs + u.pm * 256 + rowl;
        float rt[2][4];
#pragma unroll
        for (int ai = 0; ai < 2; ++ai)
#pragma unroll
            for (int m = 0; m < 4; ++m) rt[ai][m] = rsr[ai * 128 + m * 16] * cs;
        f32x4 gg[2][2];
#pragma unroll
        for (int bj = 0; bj < 2; ++bj) { const SlotDesc& d = bj == 0 ? d0 : d1; gg[bj][0] = (f32x4){1.f, 1.f, 1.f, 1.f}; gg[bj][1] = gg[bj][0];
            if (d.gain) { gg[bj][0] = *(const f32x4*)(d.gain + coll) * d.scale; gg[bj][1] = *(const f32x4*)(d.gain + coll + 4) * d.scale; } }
#pragma unroll
        for (int ai = 0; ai < 2; ++ai)
#pragma unroll
            for (int m = 0; m < 4; ++m) { const int row = rowl + ai * 128 + m * 16; const float rtv = rt[ai][m];
#pragma unroll
                for (int bj = 0; bj < 2; ++bj) { if ((bj == 0 ? d0.gain : d1.gain) != nullptr) {
                    const f32x4 v0 = acc[ai][bj][m][0] * rtv, v1 = acc[ai][bj][m][1] * rtv;
                    float ss = (v0[0] * v0[0] + v0[1] * v0[1]) + (v0[2] * v0[2] + v0[3] * v0[3]) + (v1[0] * v1[0] + v1[1] * v1[1]) + (v1[2] * v1[2] + v1[3] * v1[3]);
                    ss += swz_xor<16>(ss); ss = add_xor32(ss);
                    if (fq == 0 && !(PV & 2)) P[(row * 2 + bj) * 4 + wc] = ss; } } }
        if (!(PV & 2)) { asm volatile("s_waitcnt lgkmcnt(0)" ::: "memory"); __builtin_amdgcn_s_barrier(); asm volatile("" ::: "memory"); }
#pragma unroll
        for (int bj = 0; bj < 2; ++bj) { const SlotDesc& d = bj == 0 ? d0 : d1;
            const f32x4 g0 = gg[bj][0], g1 = gg[bj][1];
            f32x4 c0 = (f32x4){0.f, 0.f, 0.f, 0.f}, c1 = c0;
#pragma unroll
            for (int ai = 0; ai < 2; ++ai)
#pragma unroll
                for (int m = 0; m < 4; ++m) { const int row = rowl + ai * 128 + m * 16; float f = rt[ai][m];
                    if (d.gain) { const f32x4 p4 = *(const LAS f32x4*)(P + (row * 2 + bj) * 4); f *= 1.0f / sqrtf(((p4[0] + p4[1]) + (p4[2] + p4[3])) * (1.f / HD) + RMS_EPS); }
                    const f32x4 v0 = acc[ai][bj][m][0] * f * g0, v1 = acc[ai][bj][m][1] * f * g1;
                    if (d.kmean) { c0 += v0; c1 += v1; }
                    v4u w; w.x = cvt_pk_bf16(v0[0], v0[1]); w.y = cvt_pk_bf16(v0[2], v0[3]); w.z = cvt_pk_bf16(v1[0], v1[1]); w.w = cvt_pk_bf16(v1[2], v1[3]);
                    if (!(PV & 1) || w.x == 0x12345u) *(v4u*)(d.dst + (size_t)row * d.dp + coll) = w; }
            if (d.kmean && !(PV & 4)) {
#pragma unroll
                for (int i = 0; i < 4; ++i) { float v = c0[i]; v += swz_xor<1>(v); v += swz_xor<2>(v); v += swz_xor<4>(v); v += swz_xor<8>(v); if (fr == 0) KS[wr * 256 + bj * 128 + coll + i] = v;
                                              float w_ = c1[i]; w_ += swz_xor<1>(w_); w_ += swz_xor<2>(w_); w_ += swz_xor<4>(w_); w_ += swz_xor<8>(w_); if (fr == 0) KS[wr * 256 + bj * 128 + coll + 4 + i] = w_; } } }
        if (d0.kmean && !(PV & 4)) {
            asm volatile("s_waitcnt lgkmcnt(0)" ::: "memory"); __builtin_amdgcn_s_barrier(); asm volatile("" ::: "memory");
            const int t = (wr * 4 + wc) * 64 + fq * 16 + fr;
            if (t < 256) { const float mean = (KS[t] + KS[256 + t]) * (1.f / 256.f); float* km = (t < 128) ? d0.kmean : d1.kmean; km[t & 127] = mean; }
        }
    }
};
using EpiHeadNorm = EpiHeadNormT<0>;
__device__ __forceinline__ void phase_gate(const Args& a, LAS unsigned char* lds, int G, int vb) {
    unsigned char* ws = opaque_ws(a.ws);
    const bf16* QH = (const bf16*)(ws + WS_QH); const float* KMEAN = (const float*)(ws + WS_SMALL + SM_KMEAN); unsigned* SEL = (unsigned*)(ws + WS_SMALL + SM_SEL);
    gu32* MC = (gu32*)(ws + WS_CTL) + CW_MC; unsigned* LISTF = (unsigned*)(ws + WS_LISTF); unsigned* LISTA = (unsigned*)(ws + WS_LISTA);
    const int tid_g = opaque_tid();
    LAS float* kml = (LAS float*)(lds + RING_OFF);
    gu32* gq = (gu32*)(ws + WS_CTL) + CW_Q + 400; volatile LAS int* gslot = (volatile LAS int*)(lds + LDSX_OFF + 4096);
    for (;;) {
        __syncthreads();
        if (tid_g == 0) gslot[0] = (int)__hip_atomic_fetch_add(gq, 1u, RLX_AGENT);
        __syncthreads();
        const int blkq = __builtin_amdgcn_readfirstlane(gslot[0]);
        if (blkq >= NB * MOBA_H * SEQ / 512) break;
        const int idx = ((blkq % (NB * MOBA_H)) * (SEQ / 512) + (SEQ / 512 - 1 - blkq / (NB * MOBA_H))) * 512 + tid_g;
        const int bh = idx / SEQ, s = idx % SEQ, b = bh / MOBA_H, h = bh % MOBA_H, own = s >> 8;
        { const f32x4* src = (const f32x4*)(KMEAN + (size_t)bh * 32 * HD); ((LAS f32x4*)kml)[tid_g] = src[tid_g]; ((LAS f32x4*)kml)[512 + tid_g] = src[512 + tid_g]; }
        __syncthreads();
        unsigned mask = 0u;
        if (own <= 3) { mask = (1u << own) - 1u; }
        else {
            float acc[31];
#pragma unroll
            for (int j = 0; j < 31; ++j) acc[j] = 0.f;
            const bf16* q = QH + ((size_t)b * SEQ + s) * DM + h * HD;
            v4u qw[4], qn[4];
#pragma unroll
            for (int i = 0; i < 4; ++i) qw[i] = *(const v4u*)(q + 8 * i);
#pragma unroll 1
            for (int c4 = 0; c4 < 4; ++c4) {
                if (c4 < 3) {
#pragma unroll
                    for (int i = 0; i < 4; ++i) qn[i] = *(const v4u*)(q + 8 * (4 * c4 + 4 + i)); }
#pragma unroll
                for (int i = 0; i < 4; ++i) { const int c = 4 * c4 + i; const v4u w = qw[i];
                    const float f0 = bflo(w.x), f1 = bfhi(w.x), f2 = bflo(w.y), f3 = bfhi(w.y), f4 = bflo(w.z), f5 = bfhi(w.z), f6 = bflo(w.w), f7 = bfhi(w.w);
#pragma unroll
                    for (int j = 0; j < 31; ++j) if (j < own) {
                        const f32x4 k0 = *(const LAS f32x4*)(kml + j * HD + 8 * c), k1 = *(const LAS f32x4*)(kml + j * HD + 8 * c + 4);
                        acc[j] += (f0 * k0[0] + f1 * k0[1]) + (f2 * k0[2] + f3 * k0[3]) + (f4 * k1[0] + f5 * k1[1]) + (f6 * k1[2] + f7 * k1[3]); } }
#pragma unroll
                for (int i = 0; i < 4; ++i) qw[i] = qn[i];
            }
#pragma unroll
            for (int rnd = 0; rnd < 3; ++rnd) { float best = -__builtin_inff(); int bi = 0;
#pragma unroll
                for (int j = 0; j < 31; ++j) if (j < own && !((mask >> j) & 1u) && acc[j] > best) { best = acc[j]; bi = j; }
                mask |= 1u << bi; }
        }
        SEL[idx] = mask;
        { const int lane_ = tid_g & 63; const unsigned long long lt = (1ull << lane_) - 1ull;
          for (int j = 0; j < own; ++j) {
              const bool selj = (mask >> j) & 1u; const unsigned long long bal = __ballot(selj);
              if (bal == 0ull) continue;
              const int far = (j == own - 1) ? 0 : 1; const int lead = __builtin_ctzll(bal);
              unsigned base = 0u; if (lane_ == lead) base = __hip_atomic_fetch_add(MC + (bh * 32 + j) * 2 + far, (unsigned)__builtin_popcountll(bal), RLX_AGENT);
              base = __shfl(base, lead);
              if (selj) { const unsigned pos = base + (unsigned)__builtin_popcountll(bal & lt); const int slot = __builtin_popcount(mask & ((1u << j) - 1u));
                  const unsigned ent = (unsigned)s | ((unsigned)slot << 16);
                  if (far) LISTF[((size_t)bh * 32 + j) * 8192 + pos] = ent; else LISTA[((size_t)bh * 32 + j) * 256 + pos] = ent; } } }
    }
}

namespace att {
constexpr int SHM_T = 16384;
#define KLB(r32, hi) ((r32) * 256 + (((hi) * 16) ^ (((r32) & 15) << 4)))
#define SBAR() __builtin_amdgcn_sched_barrier(0)
__device__ __forceinline__ int v_rd_base(int lane) { return ((lane & 3) << 3) | (((lane >> 2) & 3) << 6) | (((lane >> 4) & 1) << 5) | (((lane >> 5) & 1) << 8); }
__device__ __forceinline__ int crow(int r, int hi) { return (r & 3) + 8 * (r >> 2) + 4 * hi; }
__device__ __forceinline__ unsigned cvtpk(float lo, float hi) { unsigned r; asm volatile("v_cvt_pk_bf16_f32 %0, %1, %2" : "=v"(r) : "v"(lo), "v"(hi)); return r; }
__device__ __forceinline__ int swap23(int k) { return (k & ~0xC) | ((k & 4) << 1) | ((k & 8) >> 1); }
__device__ __forceinline__ void glds16(const void* sbase  , unsigned voff, unsigned lds_dst) { unsigned keep;
    asm volatile("s_mov_b32 %0, m0\n\ts_mov_b32 m0, %3\n\ts_nop 0\n\tglobal_load_lds_dwordx4 %1, %2\n\ts_mov_b32 m0, %0" : "=&s"(keep) : "v"(voff), "s"(sbase), "s"(lds_dst) : "memory"); }
#define WAIT_BAR0() asm volatile("s_waitcnt vmcnt(0) lgkmcnt(0)\n\ts_barrier" ::: "memory")
constexpr float THR2 = 11.5f;

__device__ __forceinline__ void qkt(f32x16& p0, f32x16& p1, const LAS char* Kt, int r32, int hi, const bf16x8* qr) {
#pragma unroll
    for (int r = 0; r < 16; ++r) { p0[r] = 0.f; p1[r] = 0.f; }
    const int lb = KLB(r32, hi);
#pragma unroll
    for (int d0 = 0; d0 < 8; ++d0) { const LAS char* a = Kt + (lb ^ (d0 * 32));
        const bf16x8 b0 = *(const LAS bf16x8*)a;
        const bf16x8 b1 = *(const LAS bf16x8*)(a + 32 * 256);
        p0 = __builtin_amdgcn_mfma_f32_32x32x16_bf16(b0, qr[d0], p0, 0, 0, 0);
        p1 = __builtin_amdgcn_mfma_f32_32x32x16_bf16(b1, qr[d0], p1, 0, 0, 0); }
}
__device__ __forceinline__ void pv_tile(f32x16* o, int vb, bf16x8 pa0, bf16x8 pa1, bf16x8 pa2, bf16x8 pa3) {
#define TRRD(dst, off) asm volatile("ds_read_b64_tr_b16 %0, %1 offset:%2" : "=&v"(dst) : "v"(vb), "i"(off) : "memory")
#define PV_RD(S_, d0) do { constexpr int b_ = (d0) * 512; TRRD(S_##l0, b_); TRRD(S_##h0, b_ + 2048); TRRD(S_##l1, b_ + 4096); TRRD(S_##h1, b_ + 6144); \
        TRRD(S_##l2, b_ + 8192); TRRD(S_##h2, b_ + 10240); TRRD(S_##l3, b_ + 12288); TRRD(S_##h3, b_ + 14336); } while (0)
#define PV_MM(S_, d0) do { \
        o[d0] = __builtin_amdgcn_mfma_f32_32x32x16_bf16(pa0, (bf16x8){S_##l0[0], S_##l0[1], S_##l0[2], S_##l0[3], S_##h0[0], S_##h0[1], S_##h0[2], S_##h0[3]}, o[d0], 0, 0, 0); \
        o[d0] = __builtin_amdgcn_mfma_f32_32x32x16_bf16(pa1, (bf16x8){S_##l1[0], S_##l1[1], S_##l1[2], S_##l1[3], S_##h1[0], S_##h1[1], S_##h1[2], S_##h1[3]}, o[d0], 0, 0, 0); \
        o[d0] = __builtin_amdgcn_mfma_f32_32x32x16_bf16(pa2, (bf16x8){S_##l2[0], S_##l2[1], S_##l2[2], S_##l2[3], S_##h2[0], S_##h2[1], S_##h2[2], S_##h2[3]}, o[d0], 0, 0, 0); \
        o[d0] = __builtin_amdgcn_mfma_f32_32x32x16_bf16(pa3, (bf16x8){S_##l3[0], S_##l3[1], S_##l3[2], S_##l3[3], S_##h3[0], S_##h3[1], S_##h3[2], S_##h3[3]}, o[d0], 0, 0, 0); } while (0)
#define WL(n) asm volatile("s_waitcnt lgkmcnt(" #n ")" ::: "memory")
    s16x4 Al0, Al1, Al2, Al3, Ah0, Ah1, Ah2, Ah3, Bl0, Bl1, Bl2, Bl3, Bh0, Bh1, Bh2, Bh3;
    PV_RD(A, 0); SBAR();
    PV_RD(B, 1); WL(8); SBAR(); PV_MM(A, 0); SBAR();
    PV_RD(A, 2); WL(8); SBAR(); PV_MM(B, 1); SBAR();
    PV_RD(B, 3); WL(8); SBAR(); PV_MM(A, 2); SBAR();
    WL(0); SBAR(); PV_MM(B, 3);
#undef PV_RD
#undef PV_MM
#undef TRRD
}
__device__ __forceinline__ void softmax_tile(f32x16& p0, f32x16& p1, float& m_reg, float& l_reg, float& alpha, bf16x8& pa0, bf16x8& pa1, bf16x8& pa2, bf16x8& pa3) {
    float pmax = p0[0];
#pragma unroll
    for (int r = 1; r < 16; ++r) pmax = fmaxf(pmax, p0[r]);
#pragma unroll
    for (int r = 0; r < 16; ++r) pmax = fmaxf(pmax, p1[r]);
    { auto rr = __builtin_amdgcn_permlane32_swap(__float_as_uint(pmax), __float_as_uint(pmax), false, false);
      pmax = fmaxf(__uint_as_float(rr[0]), __uint_as_float(rr[1])); }
    const float mn = (pmax - m_reg <= THR2) ? m_reg : fmaxf(m_reg, pmax);
    alpha = __builtin_amdgcn_exp2f(m_reg - mn); m_reg = mn;
#pragma unroll
    for (int r = 0; r < 16; ++r) { p0[r] = __builtin_amdgcn_exp2f(p0[r] - mn); p1[r] = __builtin_amdgcn_exp2f(p1[r] - mn); }
    float ps = 0.f;
#pragma unroll
    for (int r = 0; r < 16; ++r) ps += p0[r] + p1[r];
    { auto rr = __builtin_amdgcn_permlane32_swap(__float_as_uint(ps), __float_as_uint(ps), false, false);
      ps = __uint_as_float(rr[0]) + __uint_as_float(rr[1]); }
    l_reg = l_reg * alpha + ps;
#define PK4(P, B_, OUT) do { unsigned a0 = cvtpk(P[B_+0], P[B_+1]), a1 = cvtpk(P[B_+2], P[B_+3]); \
        unsigned b0 = cvtpk(P[B_+4], P[B_+5]), b1 = cvtpk(P[B_+6], P[B_+7]); \
        auto r0 = __builtin_amdgcn_permlane32_swap(a0, b0, false, false); auto r1 = __builtin_amdgcn_permlane32_swap(a1, b1, false, false); \
        v4u w = {r0[0], r1[0], r0[1], r1[1]}; OUT = __builtin_bit_cast(bf16x8, w); } while (0)
    PK4(p0, 0, pa0); PK4(p0, 8, pa1); PK4(p1, 0, pa2); PK4(p1, 8, pa3);
#undef PK4
}
__device__ __forceinline__ void bias_mask_tile(f32x16& p0, f32x16& p1, int dq, bool on, bool far, const LAS float* lut) {
    const float NEG = -__builtin_inff();
    if (far) {
        const float c = on ? lut[128] : NEG;
#pragma unroll
        for (int r = 0; r < 16; ++r) { p0[r] += c; p1[r] += c; }
    } else {
#pragma unroll
        for (int r = 0; r < 16; ++r) { const int c = (r & 3) + 8 * (r >> 2); const int d0 = dq - c, d1 = dq - c - 32;
            const float b0 = lut[min(max(d0, 0), 128)], b1 = lut[min(max(d1, 0), 128)];
            p0[r] = (on && d0 >= 0) ? p0[r] + b0 : NEG; p1[r] = (on && d1 >= 0) ? p1[r] + b1 : NEG; }
    }
}

__device__ __forceinline__ void qkt_half(f32x16& p, const LAS char* Kt  , int r32, int hi, const bf16x8* qr) {
#pragma unroll
    for (int r = 0; r < 16; ++r) p[r] = 0.f;
    const int lb = KLB(r32, hi);
#pragma unroll
    for (int d0 = 0; d0 < 8; ++d0) { const LAS char* a = Kt + (lb ^ (d0 * 32));
        const bf16x8 b0 = *(const LAS bf16x8*)a;
        p = __builtin_amdgcn_mfma_f32_32x32x16_bf16(b0, qr[d0], p, 0, 0, 0); }
}
template <int HALF>
__device__ __forceinline__ void pv_half8(f32x16* o, int vb, bf16x8 pa0, bf16x8 pa1) {
#define TRRD(dst, off) asm volatile("ds_read_b64_tr_b16 %0, %1 offset:%2" : "=&v"(dst) : "v"(vb), "i"(off) : "memory")
#define PV_RD(S_, d0) do { constexpr int b_ = ((d0) & 3) * 512 + ((d0) >> 2) * SHM_T + HALF * 8192; TRRD(S_##l0, b_); TRRD(S_##h0, b_ + 2048); TRRD(S_##l1, b_ + 4096); TRRD(S_##h1, b_ + 6144); } while (0)
#define PV_MM(S_, d0) do { \
        o[d0] = __builtin_amdgcn_mfma_f32_32x32x16_bf16(pa0, (bf16x8){S_##l0[0], S_##l0[1], S_##l0[2], S_##l0[3], S_##h0[0], S_##h0[1], S_##h0[2], S_##h0[3]}, o[d0], 0, 0, 0); \
        o[d0] = __builtin_amdgcn_mfma_f32_32x32x16_bf16(pa1, (bf16x8){S_##l1[0], S_##l1[1], S_##l1[2], S_##l1[3], S_##h1[0], S_##h1[1], S_##h1[2], S_##h1[3]}, o[d0], 0, 0, 0); } while (0)
#define WL(n) asm volatile("s_waitcnt lgkmcnt(" #n ")" ::: "memory")
    s16x4 Al0, Al1, Ah0, Ah1, Bl0, Bl1, Bh0, Bh1;
    PV_RD(A, 0); SBAR();
    PV_RD(B, 1); WL(4); SBAR(); PV_MM(A, 0); SBAR();
    PV_RD(A, 2); WL(4); SBAR(); PV_MM(B, 1); SBAR();
    PV_RD(B, 3); WL(4); SBAR(); PV_MM(A, 2); SBAR();
    PV_RD(A, 4); WL(4); SBAR(); PV_MM(B, 3); SBAR();
    PV_RD(B, 5); WL(4); SBAR(); PV_MM(A, 4); SBAR();
    PV_RD(A, 6); WL(4); SBAR(); PV_MM(B, 5); SBAR();
    PV_RD(B, 7); WL(4); SBAR(); PV_MM(A, 6); SBAR();
    WL(0); SBAR(); PV_MM(B, 7);
#undef PV_RD
#undef PV_MM
#undef WL
#undef TRRD
}
__device__ __forceinline__ void softmax_half(f32x16& p0, float& m_reg, float& l_reg, float& alpha, bf16x8& pa0, bf16x8& pa1) {
    float pmax = p0[0];
#pragma unroll
    for (int r = 1; r < 16; ++r) pmax = fmaxf(pmax, p0[r]);
    { auto rr = __builtin_amdgcn_permlane32_swap(__float_as_uint(pmax), __float_as_uint(pmax), false, false);
      pmax = fmaxf(__uint_as_float(rr[0]), __uint_as_float(rr[1])); }
    const float mn = (pmax - m_reg <= THR2) ? m_reg : fmaxf(m_reg, pmax);
    alpha = __builtin_amdgcn_exp2f(m_reg - mn); m_reg = mn;
#pragma unroll
    for (int r = 0; r < 16; ++r) p0[r] = __builtin_amdgcn_exp2f(p0[r] - mn);
    float ps = 0.f;
#pragma unroll
    for (int r = 0; r < 16; ++r) ps += p0[r];
    { auto rr = __builtin_amdgcn_permlane32_swap(__float_as_uint(ps), __float_as_uint(ps), false, false);
      ps = __uint_as_float(rr[0]) + __uint_as_float(rr[1]); }
    l_reg = l_reg * alpha + ps;
#define PK4(P, B_, OUT) do { unsigned a0 = cvtpk(P[B_+0], P[B_+1]), a1 = cvtpk(P[B_+2], P[B_+3]); \
        unsigned b0 = cvtpk(P[B_+4], P[B_+5]), b1 = cvtpk(P[B_+6], P[B_+7]); \
        auto r0 = __builtin_amdgcn_permlane32_swap(a0, b0, false, false); auto r1 = __builtin_amdgcn_permlane32_swap(a1, b1, false, false); \
        v4u w = {r0[0], r1[0], r0[1], r1[1]}; OUT = __builtin_bit_cast(bf16x8, w); } while (0)
    PK4(p0, 0, pa0); PK4(p0, 8, pa1);
#undef PK4
}
__device__ __forceinline__ void bias_mask_half(f32x16& p0, int dq, bool far, const LAS float* lut) {
    const float NEG = -__builtin_inff();
    if (far) { const float c = lut[128];
#pragma unroll
        for (int r = 0; r < 16; ++r) p0[r] += c;
    } else {
#pragma unroll
        for (int r = 0; r < 16; ++r) { const int c = (r & 3) + 8 * (r >> 2); const int d0 = dq - c;
            const float b0 = lut[min(max(d0, 0), 128)]; p0[r] = (d0 >= 0) ? p0[r] + b0 : NEG; }
    }
}
#define RESC(o_, nd_, al_l_, alpha_) do { if (__any((alpha_) < 1.f)) { if (hi == 0) (al_l_)[r32] = (alpha_); asm volatile("s_waitcnt lgkmcnt(0)" ::: "memory"); \
        _Pragma("unroll") for (int r = 0; r < 16; ++r) { const float f_ = (al_l_)[crow(r, hi)]; _Pragma("unroll") for (int d_ = 0; d_ < (nd_); ++d_) (o_)[d_][r] *= f_; } } } while (0)

template <int MODE, bool F8OUT = false>
__device__ __forceinline__ void attn128_unit(LAS unsigned char* lds, const bf16* Qrow0, const bf16* Kh, const bf16* Vh, bf16* Orow0, int NT, int qb, const unsigned* selrow, const float* relb, int h) {
    const int tid = opaque_tid(), wid = __builtin_amdgcn_readfirstlane(tid >> 6), lane = tid & 63, r32 = lane & 31, hi = lane >> 5;
    LAS float* wsf = (LAS float*)(lds + LDSX_OFF) + wid * 64; LAS float* li_l = wsf; LAS float* al_l = wsf + 32;
    LAS float* lut = (LAS float*)(lds + LDSX_OFF + 2048);
    if (MODE == 0 && tid <= 128) lut[tid] = relb[(tid < 128 ? (int)T5_BUCKET[tid] : 31) * 12 + h] * LOG2E;
    bf16x8 qr[8];
#pragma unroll
    for (int d0 = 0; d0 < 8; ++d0) qr[d0] = *(const bf16x8*)(Qrow0 + (size_t)(wid * 32 + r32) * DM + d0 * 16 + hi * 8);
    unsigned sel = 0u; if (MODE == 0) sel = selrow[wid * 32 + r32];
    const int krow = 4 * wid + (lane >> 4); const unsigned ksrc = (unsigned) krow * 256 + ((16 * (lane & 15)) ^ ((krow & 15) << 4));
    const int vkk = 8 * (wid >> 1) + ((lane & 31) >> 2); const unsigned vsrc = (unsigned) swap23(vkk) * 256 + (32 * (2 * (wid & 1) + (lane >> 5)) + 8 * (lane & 3)) * 2;
    const unsigned lds0 = (unsigned)(uintptr_t)(lds + RING_OFF);
    const char* Kg = (const char*)Kh; const char* Vg = (const char*)Vh;
#define ISSUE(t, s) do { const unsigned base_ = (unsigned)__builtin_amdgcn_readfirstlane(lds0 + (s) * 32768 + wid * 1024); const size_t tb_ = (size_t)(t) * SHM_T; \
        glds16(Kg + tb_, ksrc, base_); glds16(Kg + tb_ + 8192, ksrc, base_ + 8192); glds16(Vg + tb_, vsrc, base_ + SHM_T); glds16(Vg + tb_ + 8192, vsrc, base_ + SHM_T + 8192); } while (0)
    const int vb0 = (int)lds0 + SHM_T + v_rd_base(lane);
    float m_reg = -1e30f, l_reg = 0.f; f32x16 o[4];
#pragma unroll
    for (int d = 0; d < 4; ++d)
#pragma unroll
        for (int r = 0; r < 16; ++r) o[d][r] = 0.f;
    const int q0w = qb * 256 + wid * 32, qpos = q0w + r32;
    ISSUE(0, 0);
    for (int t = 0; t < NT; ++t) {
        WAIT_BAR0();
        if (t + 1 < NT) ISSUE(t + 1, (t + 1) & 1);
        const int s = t & 1;
        f32x16 p0, p1;
        qkt(p0, p1, (const LAS char*)(lds + RING_OFF + s * 32768), r32, hi, qr);
        if (MODE == 0) { const int jb = t >> 2, tk0 = t * 64; const bool on = (jb >= qb) || ((sel >> jb) & 1u); const bool far = (q0w - (tk0 + 63)) >= 128;
            bias_mask_tile(p0, p1, qpos - tk0 - 4 * hi, on, far, lut); }
        float alpha; bf16x8 pa0, pa1, pa2, pa3;
        softmax_tile(p0, p1, m_reg, l_reg, alpha, pa0, pa1, pa2, pa3);
        RESC(o, 4, al_l, alpha);
        pv_tile(o, vb0 + s * 32768, pa0, pa1, pa2, pa3);
    }
#undef ISSUE
    if (hi == 0) li_l[r32] = l_reg; asm volatile("s_waitcnt lgkmcnt(0)" ::: "memory");
    int r32o = r32, hio = hi; asm volatile("" : "+v"(r32o), "+v"(hio));
    bf16* Ow = Orow0 + (size_t)(wid * 32) * DM + r32o;
#pragma unroll
    for (int r = 0; r < 16; ++r) { const int orow = crow(r, hio); const float rli = __builtin_amdgcn_rcpf(li_l[orow]);
#pragma unroll
        for (int d0 = 0; d0 < 4; ++d0) { const float v = o[d0][r] * rli; const float vn = swz_xor<1>(v);
            if (F8OUT) { if ((r32 & 1) == 0) *(unsigned short*)((unsigned char*)Orow0 + (size_t)(wid * 32 + orow) * DM + d0 * 32 + r32o) = (unsigned short)__builtin_amdgcn_cvt_pk_fp8_f32(v * SC_O, vn * SC_O, 0u, false); }
            else if ((r32 & 1) == 0) *(unsigned*)(Ow + (size_t)orow * DM + d0 * 32) = cvtpk(v, vn); } }
    WAIT_BAR0();
}

#define PK4X(P, B_, OUT) do { unsigned a0 = cvtpk(P[B_+0], P[B_+1]), a1 = cvtpk(P[B_+2], P[B_+3]); unsigned b0 = cvtpk(P[B_+4], P[B_+5]), b1 = cvtpk(P[B_+6], P[B_+7]); \
        auto r0 = __builtin_amdgcn_permlane32_swap(a0, b0, false, false); auto r1 = __builtin_amdgcn_permlane32_swap(a1, b1, false, false); v4u w = {r0[0], r1[0], r0[1], r1[1]}; OUT = __builtin_bit_cast(bf16x8, w); } while (0)
template <int VAR>
__device__ __forceinline__ void diff_unit(LAS unsigned char* lds, const bf16* Qrow0  , const bf16* K1h, const bf16* K2h, const bf16* Vh, bf16* Orow0  ,
                                          int qblk, const float* relb, int h, float lam, const float* subln) {
    const int tid = opaque_tid(), wid = __builtin_amdgcn_readfirstlane(tid >> 6), lane = tid & 63, r32 = lane & 31, hi = lane >> 5, mp = wid >> 2, w4 = wid & 3;
    LAS float* wsf = (LAS float*)(lds + LDSX_OFF) + wid * 64; LAS float* li_l = wsf; LAS float* al_l = wsf + 32;
    LAS float* lut2 = (LAS float*)(lds + LDSX_OFF + 2048);
    if (tid < 2 * 132) { const int m_ = tid / 132, i_ = tid % 132; if (i_ <= 128) lut2[tid] = relb[(i_ < 128 ? (int)T5_BUCKET[i_] : 31) * 12 + 2 * h + m_] * LOG2E; }
    const LAS float* lut = lut2 + mp * 132;
    bf16x8 qr[8];
#pragma unroll
    for (int d0 = 0; d0 < 8; ++d0) qr[d0] = *(const bf16x8*)(Qrow0 + (size_t)(w4 * 32 + r32) * DM + (h + 6 * mp) * HD + d0 * 16 + hi * 8);
    const int krow = 4 * wid + (lane >> 4); const unsigned ksrc = (unsigned) krow * 256 + ((16 * (lane & 15)) ^ ((krow & 15) << 4));
    const int vkk = 8 * (wid >> 1) + ((lane & 31) >> 2); const unsigned vsrc = (unsigned) swap23(vkk) * 512 + (32 * (2 * (wid & 1) + (lane >> 5)) + 8 * (lane & 3)) * 2;
    const unsigned lds0 = (unsigned)(uintptr_t)(lds + RING_OFF);
    const char* K1g = (const char*)K1h; const char* K2g = (const char*)K2h; const char* Vg = (const char*)Vh;
#define ISSUE(t, s) do { const unsigned base_ = (unsigned)__builtin_amdgcn_readfirstlane(lds0 + (s) * 65536 + wid * 1024); const size_t tb_ = (size_t)(t) * SHM_T; \
        glds16(K1g + tb_, ksrc, base_); glds16(K1g + tb_ + 8192, ksrc, base_ + 8192); glds16(K2g + tb_, ksrc, base_ + SHM_T); glds16(K2g + tb_ + 8192, ksrc, base_ + SHM_T + 8192); \
        glds16(Vg + 2 * tb_, vsrc, base_ + 2 * SHM_T); glds16(Vg + 2 * tb_ + 16384, vsrc, base_ + 2 * SHM_T + 8192); \
        glds16(Vg + 2 * tb_ + 256, vsrc, base_ + 3 * SHM_T); glds16(Vg + 2 * tb_ + 256 + 16384, vsrc, base_ + 3 * SHM_T + 8192); } while (0)
#define ISSUE_K(t, s) do { const unsigned base_ = (unsigned)__builtin_amdgcn_readfirstlane(lds0 + (s) * 65536 + wid * 1024); const size_t tb_ = (size_t)(t) * SHM_T; \
        glds16(K1g + tb_, ksrc, base_); glds16(K1g + tb_ + 8192, ksrc, base_ + 8192); glds16(K2g + tb_, ksrc, base_ + SHM_T); glds16(K2g + tb_ + 8192, ksrc, base_ + SHM_T + 8192); } while (0)
#define ISSUE_V(t, s) do { const unsigned base_ = (unsigned)__builtin_amdgcn_readfirstlane(lds0 + (s) * 65536 + wid * 1024); const size_t tb_ = (size_t)(t) * SHM_T; \
        glds16(Vg + 2 * tb_, vsrc, base_ + 2 * SHM_T); glds16(Vg + 2 * tb_ + 16384, vsrc, base_ + 2 * SHM_T + 8192); \
        glds16(Vg + 2 * tb_ + 256, vsrc, base_ + 3 * SHM_T); glds16(Vg + 2 * tb_ + 256 + 16384, vsrc, base_ + 3 * SHM_T + 8192); } while (0)
    const int vb0 = (int)lds0 + 2 * SHM_T + v_rd_base(lane);
    float m_reg = -1e30f, l_reg = 0.f; f32x16 o[8];
#pragma unroll
    for (int d = 0; d < 8; ++d)
#pragma unroll
        for (int r = 0; r < 16; ++r) o[d][r] = 0.f;
    const int q0w = qblk * 128 + w4 * 32, qpos = q0w + r32, NT = 2 * (qblk + 1);
    if (!(VAR & 1)) ISSUE(0, 0);
    for (int t = 0; t < NT; ++t) {
        WAIT_BAR0();
        if (!(VAR & 1)) if (t + 1 < NT) ISSUE(t + 1, (t + 1) & 1);
        const int s = t & 1, tk0 = t * 64;
        if (VAR & 2) continue;
        const bool far = (q0w - (tk0 + 63)) >= 128;
        { f32x16 p; float alpha; bf16x8 pa0, pa1;
          qkt_half(p, (const LAS char*)(lds + RING_OFF + s * 65536 + mp * SHM_T), r32, hi, qr);
          bias_mask_half(p, qpos - tk0 - 4 * hi, far, lut);
          if (VAR & 4) { alpha = 1.f; l_reg += p[0]; PK4X(p, 0, pa0); PK4X(p, 8, pa1); } else { softmax_half(p, m_reg, l_reg, alpha, pa0, pa1);
          RESC(o, 8, al_l, alpha); }
          pv_half8<0>(o, vb0 + s * 65536, pa0, pa1); }
        SBAR();
        { f32x16 p; float alpha; bf16x8 pa0, pa1;
          qkt_half(p, (const LAS char*)(lds + RING_OFF + s * 65536 + mp * SHM_T + 32 * 256), r32, hi, qr);
          bias_mask_half(p, qpos - tk0 - 32 - 4 * hi, far, lut);
          if (VAR & 4) { alpha = 1.f; l_reg += p[0]; PK4X(p, 0, pa0); PK4X(p, 8, pa1); } else { softmax_half(p, m_reg, l_reg, alpha, pa0, pa1);
          RESC(o, 8, al_l, alpha); }
          pv_half8<1>(o, vb0 + s * 65536, pa0, pa1); }
        SBAR();
    }
#undef ISSUE
#undef ISSUE_K
#undef ISSUE_V
    if (hi == 0) li_l[r32] = l_reg;
    WAIT_BAR0();
    int laneo = lane; asm volatile("" : "+v"(laneo));
    LAS float* X = (LAS float*)(lds + RING_OFF) + (w4 * 8 * 16 * 64 + laneo);
    if (mp == 1) {
#pragma unroll
        for (int r = 0; r < 16; ++r) { const float f = lam * __builtin_amdgcn_rcpf(li_l[crow(r, hi)]);
#pragma unroll
            for (int d0 = 0; d0 < 8; ++d0) X[(d0 * 16 + r) * 64] = o[d0][r] * f; }
    }
    WAIT_BAR0();
    if (mp == 0) {
        int r32o = r32, hio = hi; asm volatile("" : "+v"(r32o), "+v"(hio));
        unsigned char* Ow = (unsigned char*)Orow0 + (size_t)(w4 * 32) * DM + r32o; const float* sg = subln + r32o;
#pragma unroll
        for (int r = 0; r < 16; ++r) { const float rli = __builtin_amdgcn_rcpf(li_l[crow(r, hi)]); float ss = 0.f;
#pragma unroll
            for (int d0 = 0; d0 < 8; ++d0) { const float v = o[d0][r] * rli - X[(d0 * 16 + r) * 64]; o[d0][r] = v; ss += v * v; }
            ss += swz_xor<1>(ss); ss += swz_xor<2>(ss); ss += swz_xor<4>(ss); ss += swz_xor<8>(ss); ss += swz_xor<16>(ss);
            const float rs = (1.0f / sqrtf(ss * (1.f / DV) + RMS_EPS)) * (1.f - LAM_INIT); const int orow = crow(r, hio);
#pragma unroll
            for (int d0 = 0; d0 < 8; ++d0) { const float v = o[d0][r] * rs * sg[d0 * 32]; const float vn = swz_xor<1>(v);
                if ((r32 & 1) == 0) *(unsigned short*)(Ow + (size_t)orow * DM + d0 * 32) = (unsigned short)__builtin_amdgcn_cvt_pk_fp8_f32(v * SC_O, vn * SC_O, 0u, false); } }
    }
    WAIT_BAR0();
}

__device__ __forceinline__ void moba_sparse_unit(LAS unsigned char* lds, const bf16* QHb, const bf16* Kblk, const bf16* Vblk, const unsigned* listF, int cntF, const unsigned* listA, int cntA, int j,
                                                 bf16* PO, float* PM, const float* relb, int h) {
    const int tid = opaque_tid(), wid = __builtin_amdgcn_readfirstlane(tid >> 6), lane = tid & 63, r32 = lane & 31, hi = lane >> 5;
    LAS float* wsf = (LAS float*)(lds + LDSX_OFF) + wid * 64; LAS float* li_l = wsf; LAS float* al_l = wsf + 32;
    LAS float* lut = (LAS float*)(lds + LDSX_OFF + 2048);
    if (tid <= 128) lut[tid] = relb[(tid < 128 ? (int)T5_BUCKET[tid] : 31) * 12 + h] * LOG2E;
    const int krow = 4 * wid + (lane >> 4); const unsigned ksrc = (unsigned) krow * 256 + ((16 * (lane & 15)) ^ ((krow & 15) << 4));
    const int vkk = 8 * (wid >> 1) + ((lane & 31) >> 2); const unsigned vsrc = (unsigned) swap23(vkk) * 256 + (32 * (2 * (wid & 1) + (lane >> 5)) + 8 * (lane & 3)) * 2;
    const unsigned lds0 = (unsigned)(uintptr_t)(lds + RING_OFF);
    const char* Kg = (const char*)Kblk; const char* Vg = (const char*)Vblk;
    { const unsigned base_ = (unsigned)__builtin_amdgcn_readfirstlane(lds0 + wid * 1024);
#pragma unroll
      for (int t = 0; t < 4; ++t) { glds16(Kg + t * SHM_T, ksrc, base_ + t * SHM_T); glds16(Kg + t * SHM_T + 8192, ksrc, base_ + t * SHM_T + 8192);
                                    glds16(Vg + t * SHM_T, vsrc, base_ + 65536 + t * SHM_T); glds16(Vg + t * SHM_T + 8192, vsrc, base_ + 65536 + t * SHM_T + 8192); } }
    const int vb0 = (int)lds0 + 65536 + v_rd_base(lane);
    const int gF = (cntF + 31) >> 5, ng = gF + ((cntA + 31) >> 5);
    const float c31 = relb[31 * 12 + h] * LOG2E;
#define GRP_ENT(g_, ent_, val_) do { const bool fr_ = (g_) < gF; const int b0_ = fr_ ? (g_) * 32 : ((g_) - gF) * 32; const int n_ = fr_ ? cntF : cntA; const unsigned* l_ = fr_ ? listF : listA; \
        val_ = (b0_ + r32) < n_; ent_ = l_[val_ ? b0_ + r32 : b0_]; } while (0)
#define LOADQ(dst_, ent_) do { const bf16* qp_ = QHb + (size_t)((ent_) & 0xffffu) * DM + hi * 8; _Pragma("unroll") for (int d0 = 0; d0 < 8; ++d0) dst_[d0] = *(const bf16x8*)(qp_ + d0 * 16); } while (0)
    int g = wid; unsigned ent = 0u, entn = 0u; bool valid = false, validn = false; bf16x8 qr[8], qn[8];
    if (g < ng) { GRP_ENT(g, ent, valid); LOADQ(qr, ent); }
    if (g + 8 < ng) GRP_ENT(g + 8, entn, validn);
    WAIT_BAR0();
    for (; g < ng; g += 8) {
        const bool adj = g >= gF;
        unsigned entnn = 0u; bool validnn = false;
        if (g + 8 < ng) LOADQ(qn, entn);
        if (g + 16 < ng) GRP_ENT(g + 16, entnn, validnn);
        const int srow = (int)(ent & 0xffffu), slot = (int)(ent >> 16);
        float m_reg = -1e30f, l_reg = 0.f; f32x16 o[4];
#pragma unroll
        for (int d = 0; d < 4; ++d)
#pragma unroll
            for (int r = 0; r < 16; ++r) o[d][r] = 0.f;
#pragma unroll 1
        for (int t = 0; t < 4; ++t) {
            f32x16 p0, p1;
            qkt(p0, p1, (const LAS char*)(lds + RING_OFF + t * SHM_T), r32, hi, qr);
            if (adj) bias_mask_tile(p0, p1, srow - (j * 256 + t * 64) - 4 * hi, true, false, lut);
            float alpha; bf16x8 pa0, pa1, pa2, pa3;
            softmax_tile(p0, p1, m_reg, l_reg, alpha, pa0, pa1, pa2, pa3);
            RESC(o, 4, al_l, alpha);
            pv_tile(o, vb0 + t * SHM_T, pa0, pa1, pa2, pa3);
        }
        LAS int* rd = (LAS int*)al_l;
        const int rec = srow * 3 + slot;
        if (hi == 0) { li_l[r32] = l_reg; rd[r32] = valid ? rec : -1;
            if (valid) { PM[(size_t)rec * 2] = m_reg + (adj ? 0.f : c31); PM[(size_t)rec * 2 + 1] = l_reg; } }
        asm volatile("s_waitcnt lgkmcnt(0)" ::: "memory");
        int r32o = r32, hio = hi; asm volatile("" : "+v"(r32o), "+v"(hio));
#pragma unroll
        for (int r = 0; r < 16; ++r) { const int orow = crow(r, hio); const float rli = __builtin_amdgcn_rcpf(li_l[orow]); const int dst = rd[orow];
#pragma unroll
            for (int d0 = 0; d0 < 4; ++d0) { const float v = o[d0][r] * rli; const float vn = swz_xor<1>(v);
                if ((r32 & 1) == 0 && dst >= 0) *(unsigned*)(PO + (size_t)dst * HD + d0 * 32 + r32o) = cvtpk(v, vn); } }
        asm volatile("s_waitcnt lgkmcnt(0)" ::: "memory");
#pragma unroll
        for (int d0 = 0; d0 < 8; ++d0) qr[d0] = qn[d0];
        ent = entn; valid = validn; entn = entnn; validn = validnn;
    }
#undef GRP_ENT
#undef LOADQ
    WAIT_BAR0();
}

__device__ __forceinline__ void moba_final_unit(LAS unsigned char* lds, const bf16* Qrow0, const bf16* Kh, const bf16* Vh, bf16* Orow0, int qb, const unsigned* selrow, const float* relb, int h, const bf16* PO, const float* PM) {
    const int tid = opaque_tid(), wid = __builtin_amdgcn_readfirstlane(tid >> 6), lane = tid & 63, r32 = lane & 31, hi = lane >> 5;
    LAS float* wsf = (LAS float*)(lds + LDSX_OFF) + wid * 64; LAS float* al_l = wsf + 32;
    LAS float* lut = (LAS float*)(lds + LDSX_OFF + 2048);
    LAS float* ftab = (LAS float*)(lds + LDSX_OFF + 4352) + wid * 128;
    if (tid <= 128) lut[tid] = relb[(tid < 128 ? (int)T5_BUCKET[tid] : 31) * 12 + h] * LOG2E;
    bf16x8 qr[8];
#pragma unroll
    for (int d0 = 0; d0 < 8; ++d0) qr[d0] = *(const bf16x8*)(Qrow0 + (size_t)(wid * 32 + r32) * DM + d0 * 16 + hi * 8);
    const unsigned sel = selrow[wid * 32 + r32];
    const int krow = 4 * wid + (lane >> 4); const unsigned ksrc = (unsigned) krow * 256 + ((16 * (lane & 15)) ^ ((krow & 15) << 4));
    const int vkk = 8 * (wid >> 1) + ((lane & 31) >> 2); const unsigned vsrc = (unsigned) swap23(vkk) * 256 + (32 * (2 * (wid & 1) + (lane >> 5)) + 8 * (lane & 3)) * 2;
    const unsigned lds0 = (unsigned)(uintptr_t)(lds + RING_OFF);
    const char* Kg = (const char*)(Kh + (size_t)qb * 256 * HD); const char* Vg = (const char*)(Vh + (size_t)qb * 256 * HD);
    { const unsigned base_ = (unsigned)__builtin_amdgcn_readfirstlane(lds0 + wid * 1024);
#pragma unroll
      for (int t = 0; t < 4; ++t) { glds16(Kg + t * SHM_T, ksrc, base_ + t * SHM_T); glds16(Kg + t * SHM_T + 8192, ksrc, base_ + t * SHM_T + 8192);
                                    glds16(Vg + t * SHM_T, vsrc, base_ + 65536 + t * SHM_T); glds16(Vg + t * SHM_T + 8192, vsrc, base_ + 65536 + t * SHM_T + 8192); } }
    const int vb0 = (int)lds0 + 65536 + v_rd_base(lane);
    float m_reg = -1e30f, l_reg = 0.f; f32x16 o[4];
#pragma unroll
    for (int d = 0; d < 4; ++d)
#pragma unroll
        for (int r = 0; r < 16; ++r) o[d][r] = 0.f;
    const int qrel = wid * 32 + r32;
    WAIT_BAR0();
#pragma unroll 1
    for (int t = 0; t <= (wid >> 1); ++t) {
        f32x16 p0, p1;
        qkt(p0, p1, (const LAS char*)(lds + RING_OFF + t * SHM_T), r32, hi, qr);
        bias_mask_tile(p0, p1, qrel - t * 64 - 4 * hi, true, false, lut);
        float alpha; bf16x8 pa0, pa1, pa2, pa3;
        softmax_tile(p0, p1, m_reg, l_reg, alpha, pa0, pa1, pa2, pa3);
        RESC(o, 4, al_l, alpha);
        pv_tile(o, vb0 + t * SHM_T, pa0, pa1, pa2, pa3);
    }
    const int nsel = __builtin_popcount(sel); const size_t rec0 = (size_t)(qb * 256 + qrel) * 3;
    float mi[3], li[3]; float M = m_reg;
#pragma unroll
    for (int i = 0; i < 3; ++i) { mi[i] = -1e30f; li[i] = 0.f; if (i < nsel) { mi[i] = PM[(rec0 + i) * 2]; li[i] = PM[(rec0 + i) * 2 + 1]; } M = fmaxf(M, mi[i]); }
    const float wo = __builtin_amdgcn_exp2f(m_reg - M); float L = l_reg * wo; float wi[3];
#pragma unroll
    for (int i = 0; i < 3; ++i) { wi[i] = (i < nsel) ? li[i] * __builtin_amdgcn_exp2f(mi[i] - M) : 0.f; L += wi[i]; }
    const float rL = 1.f / L;
    if (hi == 0) { ftab[r32] = wo * rL; ftab[32 + r32] = wi[0] * rL; ftab[64 + r32] = wi[1] * rL; ftab[96 + r32] = wi[2] * rL; }
    WAIT_BAR0();
    int r32o = r32, hio = hi, laneo = lane; asm volatile("" : "+v"(r32o), "+v"(hio), "+v"(laneo));
    LAS float* X = (LAS float*)(lds + RING_OFF) + wid * 4096;
#pragma unroll
    for (int r = 0; r < 16; ++r) { const int orow = crow(r, hio); const float fo = ftab[orow];
#pragma unroll
        for (int d0 = 0; d0 < 4; ++d0) X[orow * 128 + d0 * 32 + r32o] = o[d0][r] * fo; }
    asm volatile("s_waitcnt lgkmcnt(0)" ::: "memory");
    { const int rg = laneo >> 4, c = laneo & 15;
      unsigned char* Ow = (unsigned char*)Orow0 + (size_t)(wid * 32) * DM + 8 * c;
      const bf16* Pw = PO + ((size_t)(qb * 256 + wid * 32) * 3) * HD + 8 * c;
#pragma unroll
      for (int hb = 0; hb < 2; ++hb) {
          v4u pw[4][3];
#pragma unroll
          for (int k = 0; k < 4; ++k) { const int row = (hb * 4 + k) * 4 + rg;
#pragma unroll
              for (int i = 0; i < 3; ++i) { const float f = ftab[32 * (i + 1) + row]; pw[k][i] = (v4u){0u, 0u, 0u, 0u}; if (f != 0.f) pw[k][i] = __builtin_nontemporal_load((const v4u*)(Pw + ((size_t)row * 3 + i) * HD)); } }
#pragma unroll
          for (int k = 0; k < 4; ++k) { const int row = (hb * 4 + k) * 4 + rg;
              const f32x4 x0 = *(const LAS f32x4*)(X + row * 128 + 8 * c), x1 = *(const LAS f32x4*)(X + row * 128 + 8 * c + 4);
              float v[8] = {x0[0], x0[1], x0[2], x0[3], x1[0], x1[1], x1[2], x1[3]};
#pragma unroll
              for (int i = 0; i < 3; ++i) { const float f = ftab[32 * (i + 1) + row]; const v4u w = pw[k][i];
                  v[0] += f * bflo(w.x); v[1] += f * bfhi(w.x); v[2] += f * bflo(w.y); v[3] += f * bfhi(w.y); v[4] += f * bflo(w.z); v[5] += f * bfhi(w.z); v[6] += f * bflo(w.w); v[7] += f * bfhi(w.w); }
              unsigned w0 = 0u, w1 = 0u;
              w0 = __builtin_amdgcn_cvt_pk_fp8_f32(v[0] * SC_O, v[1] * SC_O, w0, false); w0 = __builtin_amdgcn_cvt_pk_fp8_f32(v[2] * SC_O, v[3] * SC_O, w0, true);
              w1 = __builtin_amdgcn_cvt_pk_fp8_f32(v[4] * SC_O, v[5] * SC_O, w1, false); w1 = __builtin_amdgcn_cvt_pk_fp8_f32(v[6] * SC_O, v[7] * SC_O, w1, true);
              *(v2u*)(Ow + (size_t)row * DM) = (v2u){w0, w1}; } } }
    WAIT_BAR0();
}
#undef RESC
}

__device__ __forceinline__ int queue_next(gu32* ctr, LAS unsigned char* lds) {
    volatile LAS int* slot = (volatile LAS int*)(lds + LDSX_OFF + 4096);
    if (threadIdx.x == 0) slot[0] = (int)__hip_atomic_fetch_add(ctr, 1u, RLX_AGENT);
    __syncthreads();
    return __builtin_amdgcn_readfirstlane(slot[0]);
}

template <int PV>
__device__ __forceinline__ void phase_moba_sparse(const Args& a, LAS unsigned char* lds, gu32* qctr) {
    unsigned char* ws = opaque_ws(a.ws);
    const bf16* QH = (const bf16*)(ws + WS_QH); const bf16* KH = (const bf16*)(ws + WS_KH); const bf16* VH = (const bf16*)(ws + WS_VH);
    const unsigned* MC = (const unsigned*)(ws + WS_CTL) + CW_MC;
    for (;;) {
        const int uq = queue_next(qctr, lds);
        if (uq >= 744 + CONV_SP) break;
        const Mix mx = mix_decode(uq, 744, CONV_SP);
        if (mx.conv) { if (!(PV & 1)) conv_chunk(a, lds, 0, CONV_IN + mx.idx); else __syncthreads(); continue; }
        const int u = mx.idx;
        if (PV & 2) { __syncthreads(); continue; }
        const int j = u / 24, bh = u % 24, b = bh / 12, h = bh % 12;
        const int cntA = (int)MC[(bh * 32 + j) * 2], cntF = (int)MC[(bh * 32 + j) * 2 + 1];
        const bf16* QHb = QH + (size_t)b * SEQ * DM + h * HD; const bf16* Kblk = KH + ((size_t)bh * SEQ + j * 256) * HD; const bf16* Vblk = VH + ((size_t)bh * SEQ + j * 256) * HD;
        bf16* PO = (bf16*)(ws + WS_PO) + (size_t)bh * SEQ * 3 * HD; float* PM = (float*)(ws + WS_PM) + (size_t)bh * SEQ * 3 * 2;
        att::moba_sparse_unit(lds, QHb, Kblk, Vblk, (const unsigned*)(ws + WS_LISTF) + ((size_t)bh * 32 + j) * 8192, cntF, (const unsigned*)(ws + WS_LISTA) + ((size_t)bh * 32 + j) * 256, cntA, j, PO, PM, a.in[I_RELB], h);
    }
}
__device__ __forceinline__ void phase_attn_a(const Args& a, LAS unsigned char* lds, gu32* qctr) {
    unsigned char* ws = opaque_ws(a.ws);
    const bf16* QH = (const bf16*)(ws + WS_QH); const bf16* KH = (const bf16*)(ws + WS_KH); const bf16* VH = (const bf16*)(ws + WS_VH); bf16* OC = (bf16*)(ws + WS_OCAT);
    const unsigned* SEL = (const unsigned*)(ws + WS_SMALL + SM_SEL);
    for (;;) {
        const int uq = queue_next(qctr, lds);
        if (uq >= 768 + 256 + (CONV_NCH - CONV_IN - CONV_SP)) break;
        const Mix mx = mix_decode(uq, 768 + 256, CONV_NCH - CONV_IN - CONV_SP);
        if (mx.conv) { conv_chunk(a, lds, 0, CONV_IN + CONV_SP + mx.idx); continue; }
        const int u = mx.idx;
        if (u < 768) { const int qb = 31 - u / 24, bh = u % 24, b = bh / 12, h = bh % 12; const size_t row0 = (size_t)b * SEQ + qb * 256;
            att::moba_final_unit(lds, QH + row0 * DM + h * HD, KH + (size_t)bh * SEQ * HD, VH + (size_t)bh * SEQ * HD, (bf16*)((unsigned char*)OC + row0 * DM + h * HD), qb,
                                 SEL + (size_t)bh * SEQ + qb * 256, a.in[I_RELB], h, (const bf16*)(ws + WS_PO) + (size_t)bh * SEQ * 3 * HD, (const float*)(ws + WS_PM) + (size_t)bh * SEQ * 3 * 2);
        } else { const int v = u - 768, b = v >> 7, hm = (v >> 5) & 3, qb = v & 31; const size_t row0 = (size_t)b * SEQ + qb * 256;
            const size_t mo = (size_t)((0 * 2 + b) * 4 + hm) * NMEM * HD;
            att::attn128_unit<1, true>(lds, QH + row0 * DM + (12 + hm) * HD, (const bf16*)(ws + WS_SMALL + SM_KM) + mo, (const bf16*)(ws + WS_SMALL + SM_VM) + mo, (bf16*)((unsigned char*)OC + row0 * DM + MIXW + hm * HD), 4, 0, nullptr, nullptr, 0);
        }
    }
}
template <int VAR>
__device__ __forceinline__ void phase_attn_b(const Args& a, LAS unsigned char* lds, gu32* qctr, bf16* OC) {
    unsigned char* ws = opaque_ws(a.ws);
    const bf16* QH = (const bf16*)(ws + WS_QH); const bf16* KH = (const bf16*)(ws + WS_KH); const bf16* VH = (const bf16*)(ws + WS_VH);
    float lam;
    { const float* lb = a.in[I_LAMBDA]; const int lane = opaque_tid() & 63;
      float s1 = lb[lane] * lb[128 + lane] + lb[64 + lane] * lb[128 + 64 + lane], s2 = lb[256 + lane] * lb[384 + lane] + lb[256 + 64 + lane] * lb[384 + 64 + lane];
      s1 = wave_sum(s1); s2 = wave_sum(s2); lam = expf(s1) - expf(s2) + LAM_INIT; }
    for (;;) {
        const int uq = queue_next(qctr, lds);
        if (uq >= 768 + 256 + CONV_NCH) break;
        const Mix mx = mix_decode(uq, 768 + 256, CONV_NCH);
        if (mx.conv) { if (!(VAR & 8)) conv_chunk(a, lds, 1, mx.idx); else __syncthreads(); continue; }
        const int u = mx.idx;
        if (u < 768) { const int qblk = 63 - u / 12, bh = u % 12, b = bh / 6, h = bh % 6; const size_t row0 = (size_t)b * SEQ + qblk * 128;
            att::diff_unit<VAR>(lds, QH + row0 * DM, KH + (size_t)(b * 12 + h) * SEQ * HD, KH + (size_t)(b * 12 + 6 + h) * SEQ * HD, VH + (size_t)(b * 6 + h) * SEQ * DV, (bf16*)((unsigned char*)OC + row0 * DM + h * DV),
                           qblk, a.in[I_RELB], h, lam, a.in[I_SUBLN]);
        } else { const int v = u - 768, b = v >> 7, hm = (v >> 5) & 3, qb = v & 31; const size_t row0 = (size_t)b * SEQ + qb * 256;
            const size_t mo = (size_t)((1 * 2 + b) * 4 + hm) * NMEM * HD;
            att::attn128_unit<1, true>(lds, QH + row0 * DM + (12 + hm) * HD, (const bf16*)(ws + WS_SMALL + SM_KM) + mo, (const bf16*)(ws + WS_SMALL + SM_VM) + mo, (bf16*)((unsigned char*)OC + row0 * DM + MIXW + hm * HD), 4, 0, nullptr, nullptr, 0);
        }
    }
}

template <int RV>
__device__ __forceinline__ void phase_router(const Args& a, LAS unsigned char* lds, int G, int vb, int layer) {
    unsigned char* ws = opaque_ws(a.ws);
    const int tid = opaque_tid(), lane = tid & 63, wave = __builtin_amdgcn_readfirstlane(tid >> 6), i16 = lane & 15, g4 = lane >> 4;
    const bf16* H = (const bf16*)(ws + WS_HB);
    const bf16* WRh = (const bf16*)(ws + WS_W_RT) + (size_t)layer * 2 * NRTP * DM;
    LAS float* L = (LAS float*)(lds + RING_OFF);
    LAS int* cnt = (LAS int*)(lds + RING_OFF + 4 * 64 * NRTP * 4);
    for (int blk = vb; blk < T / 64; blk += G) {
        if (tid < 64) cnt[tid] = 0;
        f32x4 acc[4][5];
#pragma unroll
        for (int t4 = 0; t4 < 4; ++t4)
#pragma unroll
            for (int j = 0; j < 5; ++j) acc[t4][j] = (f32x4){0.f, 0.f, 0.f, 0.f};
        const bf16* hrow = H + (size_t)(blk * 64 + i16) * DM + wave * 256 + 8 * g4;
        const bf16* wh = WRh + (size_t)i16 * DM + wave * 256 + 8 * g4;
#pragma unroll 2
        for (int ks = 0; ks < ((RV & 1) ? 0 : 8); ++ks) {
            bf16x8 fa[4];
#pragma unroll
            for (int t4 = 0; t4 < 4; ++t4) fa[t4] = *(const bf16x8*)(hrow + (size_t)t4 * 16 * DM + ks * 32);
#pragma unroll
            for (int jt = 0; jt < 5; ++jt) {
                const bf16x8 bh = *(const bf16x8*)(wh + (size_t)jt * 16 * DM + ks * 32);
#pragma unroll
                for (int t4 = 0; t4 < 4; ++t4) acc[t4][jt] = __builtin_amdgcn_mfma_f32_16x16x32_bf16(fa[t4], bh, acc[t4][jt], 0, 0, 0);
            }
        }
        LAS float* Lw = L + ((wave & 3) * 64 + 4 * g4) * NRTP + i16;
        if (wave >= 4) {
#pragma unroll
            for (int t4 = 0; t4 < 4; ++t4)
#pragma unroll
                for (int jt = 0; jt < 5; ++jt)
#pragma unroll
                    for (int r = 0; r < 4; ++r) Lw[(t4 * 16 + r) * NRTP + jt * 16] = acc[t4][jt][r];
        }
        __syncthreads();
        if (wave < 4) {
#pragma unroll
            for (int t4 = 0; t4 < 4; ++t4)
#pragma unroll
                for (int jt = 0; jt < 5; ++jt)
#pragma unroll
                    for (int r = 0; r < 4; ++r) { LAS float* q = Lw + (t4 * 16 + r) * NRTP + jt * 16; *q = *q + acc[t4][jt][r]; }
        }
        __syncthreads();
        if (tid < 64 && !(RV & 2)) {
            const int tok = blk * 64 + tid;
            const float* part = (const float*)(ws + WS_SMALL + SM_PART) + (size_t)tok * 32;
            float ss = 0.f;
#pragma unroll
            for (int i = 0; i < 32; ++i) ss += part[i];
            const float rstd = 1.0f / sqrtf(ss * (1.f / DM) + RMS_EPS);
            const LAS float* l0 = L + tid * NRTP;
            const float* brg = a.in[I_B_RG] + layer * 8; const float* bre = a.in[I_B_RE] + layer * 64;
            float gmax = -__builtin_inff(); int gi = 0; float gl[8];
#pragma unroll
            for (int j = 0; j < 8; ++j) { gl[j] = ((l0[j] + l0[64 * NRTP + j]) + (l0[128 * NRTP + j] + l0[192 * NRTP + j])) * rstd + brg[j]; if (gl[j] > gmax) { gmax = gl[j]; gi = j; } }
            float gs = 0.f;
#pragma unroll
            for (int j = 0; j < 8; ++j) gs += expf(gl[j] - gmax);
            const float pg = 1.f / gs;
            float v0 = -__builtin_inff(), v1 = -__builtin_inff(); int i0 = 0, i1 = 0;
#pragma unroll
            for (int j = 0; j < 8; ++j) { const int ix = 8 + gi * 8 + j; const float e = ((l0[ix] + l0[64 * NRTP + ix]) + (l0[128 * NRTP + ix] + l0[192 * NRTP + ix])) * rstd + bre[gi * 8 + j];
                if (e > v0) { v1 = v0; i1 = i0; v0 = e; i0 = j; } else if (e > v1) { v1 = e; i1 = j; } }
            const float dd = expf(v1 - v0), w0 = pg / (1.f + dd), w1 = pg * dd / (1.f + dd);
            const int e0 = gi * 8 + i0, e1 = gi * 8 + i1;
            v4u tr; tr.x = (unsigned)e0; tr.y = (unsigned)e1; tr.z = __float_as_uint(w0); tr.w = __float_as_uint(w1);
            *(v4u*)(ws + WS_SMALL + SM_TOKR + (size_t)tok * 16) = tr;
            ((float*)(ws + WS_SMALL + SM_RSTD))[tok] = rstd;
            __hip_atomic_fetch_add(cnt + e0, 1, __ATOMIC_RELAXED, __HIP_MEMORY_SCOPE_WORKGROUP);
            __hip_atomic_fetch_add(cnt + e1, 1, __ATOMIC_RELAXED, __HIP_MEMORY_SCOPE_WORKGROUP);
        }
        __syncthreads();
        if (tid < 64 && !(RV & 2)) ((int*)(ws + WS_SMALL + SM_CNT))[blk * 64 + tid] = cnt[tid];
        __syncthreads();
    }
}

__device__ __forceinline__ void phase_gather(const Args& a, LAS unsigned char* lds, int G, int vb) {
    unsigned char* ws = opaque_ws(a.ws);
    const int tid = opaque_tid(), lane = tid & 63, wave = __builtin_amdgcn_readfirstlane(tid >> 6);
    const int* CNT = (const int*)(ws + WS_SMALL + SM_CNT); int* BLKE = (int*)(ws + WS_SMALL + SM_BLKE); int* DEST = (int*)(ws + WS_SMALL + SM_DEST);
    const unsigned* TOKR = (const unsigned*)(ws + WS_SMALL + SM_TOKR);
    int* ROWTOK = (int*)(ws + WS_SMALL + SM_ROWTOK);
    LAS int* tot = (LAS int*)(lds + RING_OFF); LAS int* pre = tot + 64; LAS int* pst = tot + 128; LAS int* destl = tot + 192;
    LAS int* part8 = tot + 320;
    LAS int* tokl = tot + 320 + 1024;
    for (int blk = vb; blk < T / 64; blk += G) {
        { const int e = tid & 63, p8 = tid >> 6; int t_ = 0, p_ = 0;
#pragma unroll 8
          for (int b2 = p8 * 32; b2 < p8 * 32 + 32; ++b2) { const int c = CNT[b2 * 64 + e]; t_ += c; p_ += (b2 < blk) ? c : 0; }
          part8[(p8 * 64 + e) * 2] = t_; part8[(p8 * 64 + e) * 2 + 1] = p_;
          if (tid < 128) tokl[tid] = (int)TOKR[(size_t)(blk * 64 + (tid >> 1)) * 4 + (tid & 1)]; }
        __syncthreads();
        if (tid < 64) { int t_ = 0, p_ = 0;
#pragma unroll
            for (int p8 = 0; p8 < 8; ++p8) { t_ += part8[(p8 * 64 + tid) * 2]; p_ += part8[(p8 * 64 + tid) * 2 + 1]; }
            tot[tid] = t_; pre[tid] = p_;
            const int padded = ((t_ + 255) >> 8) << 8; int incl = padded;
#pragma unroll
            for (int o = 1; o < 64; o <<= 1) { const int up = __shfl_up(incl, o); if (tid >= o) incl += up; }
            pst[tid] = incl - padded;
            if (blk == 0 && tid == 63) BLKE[MAXRB] = incl >> 8; }
        __syncthreads();
        if (tid < 64) {
            if (blk == 0) { const int rb0 = pst[tid] >> 8, rb1 = (pst[tid] + (((tot[tid] + 255) >> 8) << 8)) >> 8; for (int rb = rb0; rb < rb1; ++rb) BLKE[rb] = tid; }
            int r = pst[tid] + pre[tid];
            for (int as = 0; as < 128; ++as) { if (tokl[as] == tid) destl[as] = r++; }
        }
        __syncthreads();
        if (tid < 128) { const int tok = blk * 64 + (tid >> 1), dest = destl[tid]; DEST[tok * 2 + (tid & 1)] = dest; ROWTOK[dest] = tok; }
        if (blk < 64) {
            const int r0 = pst[blk] + tot[blk], r1 = pst[blk] + (((tot[blk] + 255) >> 8) << 8);
            for (int r = r0 + tid; r < r1; r += 512) ROWTOK[r] = 0x40000000;
        }
        __syncthreads();
    }
}

__device__ __forceinline__ void phase_combine(const Args& a, int G, int vb, float* Fout  ) {
    unsigned char* ws = opaque_ws(a.ws);
    const int tid = opaque_tid(), lane = tid & 63, wave = __builtin_amdgcn_readfirstlane(tid >> 6);
    const int gw = vb * 8 + wave, NGW = G * 8;
    const bf16* YS = (const bf16*)(ws + WS_YS); const int* DEST = (const int*)(ws + WS_SMALL + SM_DEST); float* RSTD = (float*)(ws + WS_SMALL + SM_RSTD); bf16* HB = (bf16*)(ws + WS_HB);
    for (int tok = gw; tok < T; tok += NGW) {
        const v4u tr = *(const v4u*)(ws + WS_SMALL + SM_TOKR + (size_t)tok * 16); const float w0 = __uint_as_float(tr.z), w1 = __uint_as_float(tr.w);
        const int d0 = DEST[tok * 2], d1 = DEST[tok * 2 + 1];
        GAS v2u* hr = (GAS v2u*)(HB + (size_t)tok * DM) + lane;
        const GAS v2u* y0 = (const GAS v2u*)(YS + (size_t)d0 * DM) + lane; const GAS v2u* y1 = (const GAS v2u*)(YS + (size_t)d1 * DM) + lane;
        v2u hv[8], a0[8], a1[8];
#pragma unroll
        for (int j = 0; j < 8; ++j) { hv[j] = __builtin_nontemporal_load(hr + 64 * j); a0[j] = __builtin_nontemporal_load(y0 + 64 * j); a1[j] = __builtin_nontemporal_load(y1 + 64 * j); }
        float ss = 0.f;
#pragma unroll
        for (int j = 0; j < 8; ++j) { f32x4 v;
            v.x = bflo(hv[j].x) + (w0 * bflo(a0[j].x) + w1 * bflo(a1[j].x)); v.y = bfhi(hv[j].x) + (w0 * bfhi(a0[j].x) + w1 * bfhi(a1[j].x));
            v.z = bflo(hv[j].y) + (w0 * bflo(a0[j].y) + w1 * bflo(a1[j].y)); v.w = bfhi(hv[j].y) + (w0 * bfhi(a0[j].y) + w1 * bfhi(a1[j].y));
            ss += (v.x * v.x + v.y * v.y) + (v.z * v.z + v.w * v.w);
            if (Fout) ((GAS f32x4*)(Fout + (size_t)tok * DM) + lane)[64 * j] = v;
            else { v2u o; o.x = pk2(v.x, v.y); o.y = pk2(v.z, v.w); hr[64 * j] = o;
                   unsigned w8 = 0u; w8 = __builtin_amdgcn_cvt_pk_fp8_f32(v.x, v.y, w8, false); w8 = __builtin_amdgcn_cvt_pk_fp8_f32(v.z, v.w, w8, true); ((GAS unsigned*)(ws + WS_HB8 + (size_t)tok * DM) + lane)[64 * j] = w8; } }
        if (!Fout) { const float rstd = 1.0f / sqrtf(wave_sum(ss) * (1.f / DM) + RMS_EPS); if (lane == 0) RSTD[tok] = rstd; }
    }
}

struct ZeroOrder { int n, G, c;
    __device__ __forceinline__ bool next(int i, pg8::Unit& u) const { if (i * G + c >= n) return false; u.pm = 0; u.pn = 0; return true; }
    __device__ __forceinline__ void a_ready(const pg8::Unit&) const {}
    __device__ __forceinline__ void done(const pg8::Unit&) const {} };
struct EpiNull { static constexpr bool PERM = false, AFTER_DRAIN = false;
    __device__ __forceinline__ void operator()(const f32x4 (&acc)[2][2][4][2], const pg8::Unit& u, int wr, int wc, int fr, int fq) const {} };
#ifndef MK_VAR
#define MK_VAR 0
#endif
namespace pg8 { template <> struct ProbeOf<EpiNull> { static constexpr int v = MK_VAR; }; }
#ifndef MK_DUP
#define MK_DUP -1
#endif
#define DUP(k) (MK_DUP == (k))
#ifndef MK_VAR
#define MK_VAR 0
#endif
#ifndef FP8IN_SP2
#define FP8IN_SP2 true
#endif
constexpr int NPH = 21;
__global__ void __launch_bounds__(512, 2) yoco_fwd(Args args) {
    extern __shared__ __attribute__((aligned(16))) unsigned char lds_raw[];
    LAS unsigned char* lds = (LAS unsigned char*)lds_raw;
    const int tid = opaque_tid();
    const int G = gridDim.x; const int bx0 = blockIdx.x; const int vb = (G % 8 == 0) ? (bx0 % 8) * (G / 8) + bx0 / 8 : bx0;
    unsigned char* ws = args.ws;
    gu32* ctl = (gu32*)(ws + WS_CTL);
    for (int u = tid; u < (LDS_BYTES - LDSCTL_OFF) / 4; u += 512) ((LAS unsigned*)(lds + LDSCTL_OFF))[u] = 0u;
    __syncthreads();
    volatile LAS unsigned* MISC = (volatile LAS unsigned*)(lds + MISC_OFF);
#if MK_N_LAUNCHES == 1
    constexpr int lo = 0, hi = NPH; constexpr bool one = true;
#else
    const int lo = args.ph_lo, hi = args.ph_hi;
    const bool one = (hi - lo) > 1;
#endif
    XcdBarrier bar; bar.bar = (unsigned*)(ctl + CW_BAR); bar.x = 0; bar.st = nullptr;
    if (one) bar = xcd_barrier_post((unsigned*)(ctl + CW_BAR), MISC + 8);
#define GBAR() do { XcdBarrier b2_ = bar; b2_.bar = (unsigned*)opaque_ws((unsigned char*)bar.bar); { unsigned x_ = bar.x; asm volatile("" : "+s"(x_)); b2_.x = x_; } xcd_barrier(b2_); } while (0)
#define IN(k) (lo <= (k) && (k) < hi)
#define SEAM(k) do { if (IN(k) && IN((k) + 1)) GBAR(); } while (0)

#define RUN(k, ...) do { if (IN(k)) { __VA_ARGS__ if (DUP(k)) { __syncthreads(); __VA_ARGS__ } } } while (0)
    RUN(0, phase_prep(args, lds, G, vb););
    SEAM(0);
    for (int l = 0; l < 2; ++l) {
        const int pb = 1 + 10 * l;
        int bx = bx0; asm volatile("" : "+s"(bx));
        RUN(pb + 0,
            { pg8::Gemm g{(const bf16*)(ws + WS_HB8), (const bf16*)(ws + (l == 0 ? WS_W_INA : WS_W_INB)), T, PROJW, DM / 2}; pg8::StaticOrder S; S.init(T, PROJW, G, bx);
              EpiHeadNorm E{ws, l, 1.f / SC_W1};
              const int nun = (T / 256) * (PROJW / 256), upc = (nun + G - 1) / G, ksp = (l == 0) ? (bx / 8 + bx) % (upc + 1) : upc;
              { pg8::RangeOrder R{S, 0, ksp}; pg8::gemm_phase<EpiHeadNorm, pg8::RangeOrder, true, FP8IN_SP2, false, true>(lds + RING_OFF, g, R, E); }
              if (l == 0) { __syncthreads(); for (int ch = bx; ch < CONV_IN; ch += G) conv_chunk(args, lds, 0, ch);
                pg8::RangeOrder R{S, ksp, upc}; pg8::gemm_phase<EpiHeadNorm, pg8::RangeOrder, true, FP8IN_SP2, false, true>(lds + RING_OFF, g, R, E); } }
            );
        if (one) GBAR();
        if (l == 0) { if (IN(pb + 2)) {
                if (bx < 16) { pg8::Gemm g{(const bf16*)(ws + WS_SMALL + SM_MEMN), (const bf16*)(ws + WS_W_MKV), NB * NMEM, 2048, DM}; pg8::StaticOrder S; S.init(NB * NMEM, 2048, G, bx);
                    EpiRowScale E{(bf16*)(ws + WS_SMALL + SM_KVM), 2048, nullptr, 0, 1.f};
                    pg8::gemm_phase<EpiRowScale, pg8::StaticOrder, true, true>(lds + RING_OFF, g, S, E); }
                else phase_gate(args, lds, G - 16, bx - 16); }
            if (one) GBAR(); }
        if (IN(pb + 3)) { if (l == 0) { phase_post_mem(args, lds, G, vb); phase_moba_sparse<0>(args, lds, ctl + CW_Q + 256); if (DUP(40)) { __syncthreads(); phase_moba_sparse<MK_VAR>(args, lds, ctl + CW_Q + 320); } if (one) GBAR(); phase_attn_a(args, lds, ctl + CW_Q); if (DUP(41)) { __syncthreads(); phase_attn_a(args, lds, ctl + CW_Q + 128); } }
            else { phase_attn_b<0>(args, lds, ctl + CW_Q + 64, (bf16*)(ws + WS_OCAT)); if (DUP(14)) { __syncthreads(); phase_attn_b<MK_VAR>(args, lds, ctl + CW_Q + 192, (bf16*)(ws + WS_YS)); } } }
        SEAM(pb + 3);
        RUN(pb + 4,
            {
#ifdef MK_STAG
              if (bx0 & 1) { for (int i_ = 0; i_ < MK_STAG; ++i_) __builtin_amdgcn_s_sleep(127); }
#endif
              pg8::Gemm g8{(const bf16*)(ws + WS_OCAT), (const bf16*)(ws + WS_W_OUT + (size_t)l * DM * DM), T, DM, DM / 2}; pg8::StaticOrder S; S.init(T, DM, G, bx);
              if (l == 0) { EpiOutProj<true> E{args.in[I_X], (float*)(ws + WS_SMALL + SM_PART), (bf16*)(ws + WS_HB), ws + WS_HB8, 1.f / (SC_O * SC_W1)}; pg8::gemm_phase<EpiOutProj<true>, pg8::StaticOrder, true, true, false, true>(lds + RING_OFF, g8, S, E); }
              else { EpiOutProj<false> E{nullptr, (float*)(ws + WS_SMALL + SM_PART), (bf16*)(ws + WS_HB), ws + WS_HB8, 1.f / (SC_O * SC_W1)}; pg8::gemm_phase<EpiOutProj<false>, pg8::StaticOrder, true, true, false, true>(lds + RING_OFF, g8, S, E); } });
#if MK_DUP == 54
        if (l == 0) { __syncthreads();
            pg8::Gemm g9{(const bf16*)(ws + WS_OCAT), (const bf16*)(ws + WS_W_INA), T, PROJW, DM / 2}; ZeroOrder S9{1280, G, bx};
            EpiNull E9; pg8::gemm_phase<EpiNull, ZeroOrder, false, true, false, true>(lds + RING_OFF, g9, S9, E9); }
#endif
#if MK_DUP == 53
        if (l == 0) { __syncthreads();
            pg8::Gemm g9{(const bf16*)(ws + WS_OCAT), (const bf16*)(ws + WS_W_OUT), T, DM, DM / 2}; pg8::StaticOrder S9; S9.init(T, DM, G, bx);
            EpiOutProj<true, MK_VAR> E9{args.in[I_X], (float*)(ws + WS_YS + (size_t)(96 << 20)), (bf16*)(ws + WS_YS), ws + WS_YS + (size_t)(64 << 20), 1.f / (SC_O * SC_W1)};
            pg8::gemm_phase<EpiOutProj<true, MK_VAR>, pg8::StaticOrder, true, true, false, true>(lds + RING_OFF, g9, S9, E9); }
#endif
#if MK_DUP == 52
        if (l == 0) { __syncthreads();
            pg8::Gemm g9{(const bf16*)(ws + WS_OCAT), (const bf16*)(ws + WS_W_INA), T, PROJW, DM / 2}; pg8::StaticOrder S9; S9.init(T, PROJW, G, bx);
            EpiHeadNormT<MK_VAR> E9{ws, 0, 1.f / SC_W1}; pg8::gemm_phase<EpiHeadNormT<MK_VAR>, pg8::StaticOrder, true, true, false, true>(lds + RING_OFF, g9, S9, E9); }
#endif
#if MK_DUP == 50 || MK_DUP == 51
        if (l == 0) { __syncthreads(); constexpr int NN9 = (MK_DUP == 50) ? DM : PROJW;
            pg8::Gemm g9{(const bf16*)(ws + WS_OCAT), (const bf16*)(ws + (MK_DUP == 50 ? WS_W_OUT : WS_W_INA)), T, NN9, DM / 2}; pg8::StaticOrder S9; S9.init(T, NN9, G, bx);
            EpiNull E9; pg8::gemm_phase<EpiNull, pg8::StaticOrder, false, true, false, true>(lds + RING_OFF, g9, S9, E9); }
#endif
        SEAM(pb + 4);
        if (IN(pb + 5)) { phase_router<0>(args, lds, G, vb, l); if (DUP(pb + 5)) { __syncthreads(); phase_router<MK_VAR>(args, lds, G, vb, l); } }
        SEAM(pb + 5);
        RUN(pb + 6, phase_gather(args, lds, G, vb););
        SEAM(pb + 6);
        RUN(pb + 7,
            { const int* blke = (const int*)(ws + WS_SMALL + SM_BLKE);
              const int* rowtok = (const int*)(ws + WS_SMALL + SM_ROWTOK);
              pg8::Gemm g{(const bf16*)(ws + WS_HB8), (const bf16*)(ws + WS_W_E1 + (size_t)l * NEXP * 1024 * DM), MAXRB * 256, 1024, DM / 2, rowtok};
              MoeOrder S{blke, blke[MAXRB] * 4, 4, G, vb};
              EpiSiluMul E{(bf16*)(ws + WS_HID), (const float*)(ws + WS_SMALL + SM_RSTD), rowtok};
              pg8::gemm_phase<EpiSiluMul, MoeOrder, true, true, true, true>(lds + RING_OFF, g, S, E); });
        SEAM(pb + 7);
        RUN(pb + 8,
            { const int* blke = (const int*)(ws + WS_SMALL + SM_BLKE);
              pg8::Gemm g{(const bf16*)(ws + WS_HID), (const bf16*)(ws + WS_W_E2 + (size_t)l * NEXP * DM * EFF), MAXRB * 256, DM, EFF / 2};
              MoeOrder S{blke, blke[MAXRB] * 8, 8, G, vb}; EpiRowScale E{(bf16*)(ws + WS_YS), DM, nullptr, 8, 1.f / (SC_HID * SC_W2), (const int*)(ws + WS_SMALL + SM_ROWTOK)};
              pg8::gemm_phase<EpiRowScale, MoeOrder, true, true, false, true>(lds + RING_OFF, g, S, E); });
        SEAM(pb + 8);
        if (IN(pb + 9)) phase_combine(args, G, vb, l == 0 ? nullptr : args.out);
        if (l == 0) SEAM(pb + 9);
    }
#undef RUN
#undef IN
#undef SEAM
}

extern "C" void kernel_launch(void* const* d_in, const int* in_sizes, int n_in, void* d_out, int out_size, void* d_ws, size_t ws_size, hipStream_t stream) {
    static int grid = 0;
    if (grid == 0) {
        if (n_in != N_IN || out_size != T * DM || ws_size < WS_END) { fprintf(stderr, "kernel_launch: unexpected shapes (n_in %d out %d ws %zu)\n", n_in, out_size, ws_size); grid = -1; return; }
        int dev = 0, cus = 0;
        if (hipGetDevice(&dev) != hipSuccess || hipDeviceGetAttribute(&cus, hipDeviceAttributeMultiprocessorCount, dev) != hipSuccess) { grid = -1; return; }
        if (hipFuncSetAttribute((const void*)yoco_fwd, hipFuncAttributeMaxDynamicSharedMemorySize, LDS_BYTES) != hipSuccess) { fprintf(stderr, "kernel_launch: hipFuncSetAttribute failed\n"); grid = -1; return; }
        int per_cu = 0;
        if (hipOccupancyMaxActiveBlocksPerMultiprocessor(&per_cu, (const void*)yoco_fwd, 512, LDS_BYTES) != hipSuccess || per_cu < 1) fprintf(stderr, "kernel_launch: occupancy query reports %d\n", per_cu);
        (void)hipGetLastError();
        grid = cus;
    }
    if (grid < 0) return;
    (void)hipMemsetAsync((char*)d_ws + WS_CTL, 0, CTL_ZERO_BYTES, stream);
    Args a{};
    for (int i = 0; i < N_IN; ++i) a.in[i] = (const float*)d_in[i];
    a.out = (float*)d_out; a.ws = (unsigned char*)d_ws;
#if MK_N_LAUNCHES == 1
    a.ph_lo = 0; a.ph_hi = NPH;
    hipLaunchKernelGGL(yoco_fwd, dim3(grid), dim3(512), LDS_BYTES, stream, a);
#else
    for (int p = 0; p < NPH; ++p) { if (p == 13) continue; a.ph_lo = p; a.ph_hi = p + 1; hipLaunchKernelGGL(yoco_fwd, dim3(grid), dim3(512), LDS_BYTES, stream, a); }
#endif
}
```
